# Optimizing an MI355X kernel written in HIP

```python
import math
import jax, jax.numpy as jnp
from jax import lax
import numpy as np

D_MODEL = 2048
BATCH = 4
SEQ = 2048
DEPTH = 4
DEC_BATCH = 32
DEC_SEQ = 4
PAST_LEN = 16384
PAGE_SIZE = 128

HEAD_DIM = 64
ATT_WIDTH = D_MODEL // 4
ATT_HEADS = ATT_WIDTH // HEAD_DIM
ATT_KV_HEADS = ATT_HEADS // 4
ATT_GROUP = ATT_HEADS // ATT_KV_HEADS
ATT_KV_WIDTH = ATT_KV_HEADS * HEAD_DIM
WINDOW = 128
N_BUCKETS = 32
MAX_DISTANCE = 128
POOL_WIDTH = D_MODEL // 4
POOL_WINDOWS = (2, 4, 8, 16)
POOL_GROUPS = len(POOL_WINDOWS)
POOL_GROUP_DIM = POOL_WIDTH // POOL_GROUPS
POOL_BUF = max(POOL_WINDOWS) - 1
GLA_HEADS = 4
GLA_VALUE_WIDTH = D_MODEL // 2
GLA_KEY_WIDTH = GLA_VALUE_WIDTH // 2
GLA_DK = GLA_KEY_WIDTH // GLA_HEADS
GLA_DV = GLA_VALUE_WIDTH // GLA_HEADS
GLA_GATE_RANK = 16
GLA_GATE_TAU = 16.0
GLA_CHUNK = 32
MIX_WIDTH = ATT_WIDTH + POOL_WIDTH + GLA_VALUE_WIDTH
IN_SPLITS = (ATT_WIDTH, ATT_KV_WIDTH, ATT_KV_WIDTH, POOL_WIDTH,
             GLA_KEY_WIDTH, GLA_KEY_WIDTH, GLA_VALUE_WIDTH, GLA_VALUE_WIDTH)
IN_WIDTH = sum(IN_SPLITS) + GLA_GATE_RANK
D_FF = -(-8 * D_MODEL // (3 * 256)) * 256
N_MOD = 6
EPS = 1e-6

kernel_name = 'hymba_swa_pool_gla_decode_step'


def rmsnorm(x, g):
    xf = x.astype(jnp.float32)
    y = xf * lax.rsqrt(jnp.mean(xf * xf, axis=-1, keepdims=True) + EPS)
    return (y * g.astype(jnp.float32)).astype(x.dtype)


def t5_bucket(dist):
    n = jnp.maximum(dist, 0)
    max_exact = N_BUCKETS // 2
    nf = jnp.maximum(n, max_exact).astype(jnp.float32)
    large = max_exact + (jnp.log(nf / max_exact) / math.log(MAX_DISTANCE / max_exact)
                         * (N_BUCKETS - max_exact)).astype(jnp.int32)
    large = jnp.minimum(large, N_BUCKETS - 1)
    return jnp.where(n < max_exact, n, large)


def sink_attention(q, k, v, dist, valid, rel_bias, sinks):
    f32 = jnp.float32
    logits = jnp.einsum('...qhgd,...khd->...hgqk', q.astype(f32), k.astype(f32)) * (HEAD_DIM ** -0.5)
    bias = rel_bias.astype(f32)[t5_bucket(dist)]
    bias = jnp.moveaxis(bias, -1, 0).reshape(ATT_KV_HEADS, ATT_GROUP, *dist.shape)
    logits = jnp.where(valid, logits + bias, -jnp.inf)
    sink = sinks.astype(f32).reshape(ATT_KV_HEADS, ATT_GROUP, 1, 1)
    m = jnp.maximum(jnp.max(logits, axis=-1, keepdims=True), sink)
    p = jnp.exp(logits - m)
    denom = jnp.sum(p, axis=-1, keepdims=True) + jnp.exp(sink - m)
    return jnp.einsum('...hgqk,...khd->...qhgd', p / denom, v.astype(f32))


def window_attn_prompt(q, k, v, rel_bias, sinks):
    B, T = q.shape[:2]
    nb = T // WINDOW
    qb = q.reshape(B, nb, WINDOW, ATT_KV_HEADS, ATT_GROUP, HEAD_DIM)

    def band(t):
        cur = t.reshape(B, nb, WINDOW, ATT_KV_HEADS, HEAD_DIM)
        prev = jnp.concatenate([jnp.zeros_like(cur[:, :1]), cur[:, :-1]], axis=1)
        return jnp.concatenate([prev, cur], axis=2)

    kb, vb = band(k), band(v)
    r = jnp.arange(WINDOW)
    j = jnp.arange(2 * WINDOW)
    dist = WINDOW + r[:, None] - j[None, :]
    kpos = (jnp.arange(nb)[:, None] - 1) * WINDOW + j[None, :]
    valid = ((dist >= 0) & (dist < WINDOW))[None] & (kpos >= 0)[:, None, :]
    valid = valid[:, None, None]
    o = sink_attention(qb, kb, vb, dist, valid, rel_bias, sinks)
    return o.reshape(B, T, ATT_WIDTH)


def window_attn_sample(q, k, v, k_past, v_past, rel_bias, sinks):
    B, T = q.shape[:2]
    lb = k_past.shape[1]
    kk = jnp.concatenate([k_past.astype(k.dtype), k], axis=1)
    vv = jnp.concatenate([v_past.astype(v.dtype), v], axis=1)
    krel = jnp.arange(-lb, T)
    qrel = jnp.arange(T)
    dist = qrel[:, None] - krel[None, :]
    valid = (dist >= 0) & (dist < WINDOW)
    o = sink_attention(q, kk, vv, dist, valid, rel_bias, sinks)
    return o.reshape(B, T, ATT_WIDTH), kk[:, -lb:], vv[:, -lb:]


def pool_mixer(u, buf, pos0, w_pool, scale):
    B, T, _ = u.shape
    L = POOL_BUF
    ext = jnp.concatenate([buf.astype(u.dtype), u], axis=1).astype(jnp.float32)
    cs = jnp.cumsum(ext, axis=1)
    cs = jnp.concatenate([jnp.zeros_like(cs[:, :1]), cs], axis=1)
    pos = pos0 + jnp.arange(T)
    groups = []
    for gi, w in enumerate(POOL_WINDOWS):
        sl = slice(gi * POOL_GROUP_DIM, (gi + 1) * POOL_GROUP_DIM)
        s = cs[:, L + 1:L + 1 + T, sl] - cs[:, L + 1 - w:L + 1 - w + T, sl]
        cnt = jnp.minimum(w, pos + 1).astype(jnp.float32)
        groups.append(s / cnt[None, :, None])
    pooled = jnp.concatenate(groups, axis=-1)
    d = (pooled - u.astype(jnp.float32)).reshape(B, T, POOL_GROUPS, POOL_GROUP_DIM)
    y = jnp.einsum('btgc,gcd->btgd', d, w_pool.astype(jnp.float32)).reshape(B, T, POOL_WIDTH)
    return y * scale.astype(jnp.float32), ext[:, -L:].astype(u.dtype)


def gla_mixer(q, k, v, log_a, S0):
    B, T, H, dk = q.shape
    dv = v.shape[-1]
    C = GLA_CHUNK
    n = -(-T // C)
    pad = n * C - T

    def prep(t):
        t = jnp.pad(t.astype(jnp.float32), ((0, 0), (0, pad), (0, 0), (0, 0)))
        return t.reshape(B, n, C, H, t.shape[-1]).transpose(1, 0, 3, 2, 4)

    q, k, v, g = prep(q), prep(k), prep(v), prep(log_a)
    b = jnp.cumsum(g, axis=3)
    qd = q * jnp.exp(b) * (dk ** -0.5)
    kd = k * jnp.exp(-b)
    b_last = b[:, :, :, -1:]
    kdec = k * jnp.exp(b_last - b)
    mask = jnp.tril(jnp.ones((C, C), dtype=bool))
    A = jnp.where(mask, jnp.einsum('nbhtd,nbhsd->nbhts', qd, kd), 0.0)
    o_intra = jnp.einsum('nbhts,nbhse->nbhte', A, v)

    def step(S, xs):
        qd_i, kdec_i, v_i, bl_i = xs
        o_i = jnp.einsum('bhtd,bhde->bhte', qd_i, S)
        S = jnp.exp(bl_i)[:, :, 0, :, None] * S + jnp.einsum('bhsd,bhse->bhde', kdec_i, v_i)
        return S, o_i

    S, o_inter = lax.scan(step, S0.astype(jnp.float32), (qd, kdec, v, b_last))
    o = (o_intra + o_inter).transpose(1, 0, 3, 2, 4).reshape(B, n * C, H, dv)[:, :T]
    return o, S


def run_trunk(x, c, win_k, win_v, pool_buf, gla_state, pos0,
              w_ada, b_ada, g_mix, g_ffn, w_in, w_out, rel_bias, sinks, w_pool, pool_scale,
              w_a2, b_a2, g_gla, w_gu, w_down, g_final):
    B, T, _ = x.shape
    split_idx = [int(s) for s in np.cumsum(IN_SPLITS)]
    lb = min(WINDOW, PAST_LEN)
    new_k, new_v, new_pool, new_gla = [], [], [], []
    for l in range(DEPTH):
        mod = jnp.dot(jax.nn.silu(c), w_ada[l]) + b_ada[l]
        sh1, sc1, g1, sh2, sc2, g2 = jnp.split(mod[:, None, :], N_MOD, axis=-1)
        h = rmsnorm(x, g_mix[l]) * (1 + sc1) + sh1
        z = jnp.dot(h, w_in[l])
        zq, zk, zv, zu, gq, gk, gv, gg, ga = jnp.split(z, split_idx, axis=-1)

        q = zq.reshape(B, T, ATT_KV_HEADS, ATT_GROUP, HEAD_DIM)
        k = zk.reshape(B, T, ATT_KV_HEADS, HEAD_DIM)
        v = zv.reshape(B, T, ATT_KV_HEADS, HEAD_DIM)
        if win_k is None:
            o_a = window_attn_prompt(q, k, v, rel_bias, sinks[l])
            nk, nv = k[:, -lb:], v[:, -lb:]
        else:
            o_a, nk, nv = window_attn_sample(q, k, v, win_k[l], win_v[l], rel_bias, sinks[l])

        buf = jnp.zeros((B, POOL_BUF, POOL_WIDTH), x.dtype) if pool_buf is None else pool_buf[l]
        o_b, nbuf = pool_mixer(zu, buf, pos0, w_pool[l], pool_scale[l])

        log_a = jax.nn.log_sigmoid(jnp.dot(ga, w_a2[l]).astype(jnp.float32)
                                   + b_a2[l].astype(jnp.float32)) / GLA_GATE_TAU
        S0 = (jnp.zeros((B, GLA_HEADS, GLA_DK, GLA_DV), jnp.float32)
              if gla_state is None else gla_state[l])
        o_c, S = gla_mixer(gq.reshape(B, T, GLA_HEADS, GLA_DK), gk.reshape(B, T, GLA_HEADS, GLA_DK),
                           gv.reshape(B, T, GLA_HEADS, GLA_DV), log_a.reshape(B, T, GLA_HEADS, GLA_DK), S0)
        o_c = rmsnorm(o_c, g_gla[l].reshape(GLA_HEADS, GLA_DV)) * jax.nn.silu(
            gg.reshape(B, T, GLA_HEADS, GLA_DV).astype(jnp.float32))
        o_c = o_c.reshape(B, T, GLA_VALUE_WIDTH)

        mix = jnp.concatenate([o_a, o_b, o_c], axis=-1).astype(x.dtype)
        x = x + g1 * jnp.dot(mix, w_out[l])

        h2 = rmsnorm(x, g_ffn[l]) * (1 + sc2) + sh2
        gate, up = jnp.split(jnp.dot(h2, w_gu[l]), 2, axis=-1)
        x = x + g2 * jnp.dot(jax.nn.silu(gate) * up, w_down[l])

        new_k.append(nk)
        new_v.append(nv)
        new_pool.append(nbuf)
        new_gla.append(S.astype(jnp.float32))
    y = rmsnorm(x, g_final)
    return y, jnp.stack(new_k), jnp.stack(new_v), jnp.stack(new_pool), jnp.stack(new_gla)


def setup_inputs(seed: int = 0) -> dict:
    key = jax.random.key(seed)
    ks = jax.random.split(key, 24)
    f32 = jnp.float32

    def nrm(k, shape, s=1.0):
        return jax.random.normal(k, shape, f32) * s

    lb = min(WINDOW, PAST_LEN)
    return {
        'x_prompt': nrm(ks[0], (BATCH, SEQ, D_MODEL)),
        'x_sample': nrm(ks[1], (DEC_BATCH, DEC_SEQ, D_MODEL)),
        'cache_win_k': nrm(ks[2], (DEPTH, DEC_BATCH, lb, ATT_KV_HEADS, HEAD_DIM)),
        'cache_win_v': nrm(ks[3], (DEPTH, DEC_BATCH, lb, ATT_KV_HEADS, HEAD_DIM)),
        'state_pool': nrm(ks[4], (DEPTH, DEC_BATCH, POOL_BUF, POOL_WIDTH)),
        'state_gla': nrm(ks[5], (DEPTH, DEC_BATCH, GLA_HEADS, GLA_DK, GLA_DV), 4.0),
        'c_prompt': nrm(ks[6], (BATCH, D_MODEL)),
        'c_sample': nrm(ks[7], (DEC_BATCH, D_MODEL)),
        'w_ada': nrm(ks[8], (DEPTH, D_MODEL, N_MOD * D_MODEL), 0.5 * D_MODEL ** -0.5),
        'b_ada': nrm(ks[9], (DEPTH, N_MOD * D_MODEL), 0.02),
        'g_mix': 1.0 + nrm(ks[10], (DEPTH, D_MODEL), 0.05),
        'g_ffn': 1.0 + nrm(ks[11], (DEPTH, D_MODEL), 0.05),
        'w_in': nrm(ks[12], (DEPTH, D_MODEL, IN_WIDTH), D_MODEL ** -0.5),
        'w_out': nrm(ks[13], (DEPTH, MIX_WIDTH, D_MODEL), MIX_WIDTH ** -0.5),
        'rel_bias': nrm(ks[14], (N_BUCKETS, ATT_HEADS), 0.5),
        'sinks': nrm(ks[15], (DEPTH, ATT_HEADS)),
        'w_pool': nrm(ks[16], (DEPTH, POOL_GROUPS, POOL_GROUP_DIM, POOL_GROUP_DIM), POOL_GROUP_DIM ** -0.5),
        'pool_scale': 1.0 + nrm(ks[17], (DEPTH, POOL_WIDTH), 0.1),
        'w_a2': nrm(ks[18], (DEPTH, GLA_GATE_RANK, GLA_KEY_WIDTH), GLA_GATE_RANK ** -0.5),
        'b_a2': nrm(ks[19], (DEPTH, GLA_KEY_WIDTH), 0.1),
        'g_gla': 1.0 + nrm(ks[20], (DEPTH, GLA_VALUE_WIDTH), 0.05),
        'w_gu': nrm(ks[21], (DEPTH, D_MODEL, 2 * D_FF), D_MODEL ** -0.5),
        'w_down': nrm(ks[22], (DEPTH, D_FF, D_MODEL), D_FF ** -0.5),
        'g_final': 1.0 + nrm(ks[23], (D_MODEL,), 0.05),
    }


def reference(x_prompt, x_sample, cache_win_k, cache_win_v, state_pool, state_gla, c_prompt, c_sample,
              w_ada, b_ada, g_mix, g_ffn, w_in, w_out, rel_bias, sinks, w_pool, pool_scale,
              w_a2, b_a2, g_gla, w_gu, w_down, g_final):
    y_prompt, kp, vp, pp, sp = run_trunk(
        x_prompt, c_prompt, None, None, None, None, 0,
        w_ada, b_ada, g_mix, g_ffn, w_in, w_out, rel_bias, sinks, w_pool, pool_scale,
        w_a2, b_a2, g_gla, w_gu, w_down, g_final)
    y_sample, ks_, vs_, ps_, ss_ = run_trunk(
        x_sample, c_sample, cache_win_k, cache_win_v, state_pool, state_gla, PAST_LEN,
        w_ada, b_ada, g_mix, g_ffn, w_in, w_out, rel_bias, sinks, w_pool, pool_scale,
        w_a2, b_a2, g_gla, w_gu, w_down, g_final)
    return (y_prompt, y_sample, kp, vp, pp, sp, ks_, vs_, ps_, ss_)
```

```cpp
#include <hip/hip_runtime.h>
#include <cstdio>
#include <cstdint>
#include <cmath>
namespace pg8 {
#define PG8_LAS __attribute__((address_space(3)))
typedef unsigned short bf16_t;
typedef short bf16x8 __attribute__((ext_vector_type(8)));
typedef float f32x4 __attribute__((ext_vector_type(4)));
typedef unsigned u32x4 __attribute__((ext_vector_type(4)));
constexpr int BM = 256, BK = 64, HALF = 128, HTB = HALF * BK * 2  , STAGE_BYTES = 8 * HTB, NXCD = 8, WGM = 8;

__host__ __device__ __forceinline__ int lds_byte(int r, int c) { const int st = (r >> 4) * 2 + (c >> 5), rr = r & 15, cc = c & 31, ob = rr * 64 + cc * 2; return st * 1024 + (ob ^ (((ob >> 9) & 1) << 5)); }
__host__ __device__ __forceinline__ void stage_rc(int b, int& R, int& C) { const int st = b / 1024, sb = b % 1024, swz = sb ^ (((sb >> 9) & 1) << 5); R = (st >> 1) * 16 + swz / 64; C = (st & 1) * 32 + (swz % 64) / 2; }
__host__ __device__ __forceinline__ int perm32(int rho) { const int n = rho >> 4, i = rho & 15; return 8 * (i >> 2) + 4 * n + (i & 3); }

struct Unit { int pm, pn; };
struct Gemm { const bf16_t* A; const bf16_t* Bt; int M, N, K; };

struct StaticOrder {
    int nM, nN, nwg, G, c;
    __host__ __device__ void init(int M, int N, int G_, int c_) { nM = M / BM; nN = N / BM; nwg = nM * nN; G = G_; c = c_; }
    __host__ __device__ bool next(int i, Unit& u) const {
        const long L = (long)i * G + c; if (L >= nwg) return false;
        int wgid = (int)L; { const int q = nwg / NXCD, r = nwg % NXCD, xcd = wgid % NXCD, off = wgid / NXCD; wgid = (xcd < r ? xcd * (q + 1) : r * (q + 1) + (xcd - r) * q) + off; }
        const int nig = WGM * nN, gid = wgid / nig, fm = gid * WGM, gsz = (nM - fm) < WGM ? (nM - fm) : WGM;
        u.pm = fm + ((wgid % nig) % gsz); u.pn = (wgid % nig) / gsz; return true;
    }
    __device__ __forceinline__ void a_ready(const Unit&) const {}
    __device__ __forceinline__ void done(const Unit&) const {}
};

__device__ __forceinline__ unsigned cvt_pk_bf16(float lo, float hi) { unsigned r; asm volatile("v_cvt_pk_bf16_f32 %0, %1, %2" : "=v"(r) : "v"(lo), "v"(hi)); return r; }
typedef float f32x2 __attribute__((ext_vector_type(2)));
constexpr int MODLD_ = 49152;
__device__ __forceinline__ float fast_sigmoid(float x) { return __builtin_amdgcn_rcpf(1.0f + __expf(-x)); }
struct EpiZ {
    static constexpr bool PERM = true, AFTER_DRAIN = false;
    bf16_t* O; int ldc;
    __device__ __forceinline__ void operator()(const f32x4 (&acc)[2][2][4][2], const Unit& u, int wr, int wc, int fr, int fq) const {
        const int row0 = u.pm * BM + wr * 64 + fr, col0 = u.pn * BM + wc * 32 + 8 * fq;
#pragma unroll
        for (int ai = 0; ai < 2; ++ai)
#pragma unroll
            for (int m = 0; m < 4; ++m) { bf16_t* rowp = O + (size_t)(row0 + ai * HALF + m * 16) * ldc + col0;
#pragma unroll
                for (int bj = 0; bj < 2; ++bj) { const f32x4 v0 = acc[ai][bj][m][0], v1 = acc[ai][bj][m][1];
                    u32x4 w; w.x = cvt_pk_bf16(v0[0], v0[1]); w.y = cvt_pk_bf16(v0[2], v0[3]); w.z = cvt_pk_bf16(v1[0], v1[1]); w.w = cvt_pk_bf16(v1[2], v1[3]);
                    *(u32x4*)(rowp + bj * HALF) = w; } }
    }
};
struct EpiSwiGLU {
    static constexpr bool PERM = true, AFTER_DRAIN = false;
    bf16_t* O; int ldc;
    __device__ __forceinline__ void operator()(const f32x4 (&acc)[2][2][4][2], const Unit& u, int wr, int wc, int fr, int fq) const {
        const int row0 = u.pm * BM + wr * 64 + fr, col0 = u.pn * HALF + wc * 32 + 8 * fq;
#pragma unroll
        for (int ai = 0; ai < 2; ++ai)
#pragma unroll
            for (int m = 0; m < 4; ++m) { bf16_t* rowp = O + (size_t)(row0 + ai * HALF + m * 16) * ldc + col0;
                float r[8];
#pragma unroll
                for (int n = 0; n < 2; ++n)
#pragma unroll
                    for (int i = 0; i < 4; ++i) { const float g = acc[ai][0][m][n][i], up = acc[ai][1][m][n][i]; r[n * 4 + i] = g * fast_sigmoid(g) * up; }
                u32x4 w; w.x = cvt_pk_bf16(r[0], r[1]); w.y = cvt_pk_bf16(r[2], r[3]); w.z = cvt_pk_bf16(r[4], r[5]); w.w = cvt_pk_bf16(r[6], r[7]);
                *(u32x4*)rowp = w; }
    }
};
struct EpiResid {
    static constexpr bool PERM = false, AFTER_DRAIN = false;
    float* X; const float* gate;
    __device__ __forceinline__ void operator()(const f32x4 (&acc)[2][2][4][2], const Unit& u, int wr, int wc, int fr, int fq) const {
        const int col0 = u.pn * BM + wc * 32 + 4 * fq;
        if (u.pm < 32) {
            const float* g = gate + (size_t)(u.pm >> 3) * MODLD_ + col0;
            f32x4 gv[2][2];
#pragma unroll
            for (int bj = 0; bj < 2; ++bj)
#pragma unroll
                for (int n = 0; n < 2; ++n) gv[bj][n] = *(const f32x4*)(g + bj * HALF + n * 16);
#pragma unroll
            for (int ai = 0; ai < 2; ++ai)
#pragma unroll
                for (int m = 0; m < 4; ++m) { float* xp = X + (size_t)(u.pm * BM + ai * HALF + wr * 64 + m * 16 + fr) * 2048 + col0;
#pragma unroll
                    for (int bj = 0; bj < 2; ++bj)
#pragma unroll
                        for (int n = 0; n < 2; ++n) { f32x4 xv = *(const f32x4*)(xp + bj * HALF + n * 16); xv = xv + gv[bj][n] * acc[ai][bj][m][n]; *(f32x4*)(xp + bj * HALF + n * 16) = xv; } }
        } else {
#pragma unroll
            for (int m = 0; m < 4; ++m) { const int rl = wr * 64 + m * 16 + fr;
                const float* g = gate + (size_t)(4 + (rl >> 2)) * MODLD_ + col0; float* xp = X + (size_t)(8192 + rl) * 2048 + col0;
#pragma unroll
                for (int bj = 0; bj < 2; ++bj)
#pragma unroll
                    for (int n = 0; n < 2; ++n) { const f32x4 gvv = *(const f32x4*)(g + bj * HALF + n * 16); f32x4 xv = *(const f32x4*)(xp + bj * HALF + n * 16);
                        xv = xv + gvv * acc[0][bj][m][n]; *(f32x4*)(xp + bj * HALF + n * 16) = xv; } }
        }
    }
};
struct EpiMod {
    static constexpr bool PERM = false, AFTER_DRAIN = false;
    float* M; const float* bias;
    __device__ __forceinline__ void operator()(const f32x4 (&acc)[2][2][4][2], const Unit& u, int wr, int wc, int fr, int fq) const {
        if (wr != 0) return;
        const int col0 = u.pn * BM + wc * 32 + 4 * fq;
#pragma unroll
        for (int m = 0; m < 3; ++m) { const int r = m * 16 + fr;
            if (r < 36) {
#pragma unroll
                for (int bj = 0; bj < 2; ++bj)
#pragma unroll
                    for (int n = 0; n < 2; ++n) { const f32x4 bv = *(const f32x4*)(bias + col0 + bj * HALF + n * 16);
                        *(f32x4*)(M + (size_t)r * MODLD_ + col0 + bj * HALF + n * 16) = acc[0][bj][m][n] + bv; } } }
    }
};

template <class Epi, class Sched, bool ALIGN_EPI = false, bool SP2 = false>
__device__ __forceinline__ void gemm_phase(PG8_LAS unsigned char* lds, const Gemm g, const Sched& S, const Epi& E, int wid_in) {
    int lane_ = (int)__builtin_amdgcn_mbcnt_hi(~0u, __builtin_amdgcn_mbcnt_lo(~0u, 0u)); asm volatile("" : "+v"(lane_));
    const int wid = __builtin_amdgcn_readfirstlane(wid_in), lane = lane_, tid = wid * 64 + lane, wr = wid >> 2, wc = wid & 3, fr = lane & 15, fq = lane >> 4;
    int K_ = g.K; asm volatile("" : "+s"(K_));
    const int K = K_, nt = K / BK;
    unsigned voffA[2], voffB[2];
#pragma unroll
    for (int i = 0; i < 2; ++i) { int R, C; stage_rc(tid * 16 + i * 8192, R, C); const int Rb = Epi::PERM ? ((R & ~31) + perm32(R & 31)) : R;
        voffA[i] = (unsigned)(R * K + C) * 2u; voffB[i] = (unsigned)(Rb * K + C) * 2u; }
    const size_t kstep = (size_t)(BK * 2);
    const size_t hstep = (size_t)HALF * K * 2;
    const size_t tstep = 2 * hstep;
    const unsigned ldsw = (unsigned)wid * 1024u;
    const int aoff = lds_byte(wr * 64 + fr, fq * 8), boff = lds_byte(wc * 32 + fr, fq * 8);
#define PG8_SA(b, h) (((b) * 2 + (h)) * HTB)
#define PG8_SB(b, h) ((4 + (b) * 2 + (h)) * HTB)
#define PG8_STAGE(bufoff, gbase, voff) do { _Pragma("unroll") for (int _i = 0; _i < 2; ++_i) \
        __builtin_amdgcn_global_load_lds((const unsigned*)((const char*)(gbase) + (voff)[_i]), (PG8_LAS unsigned*)(lds + (bufoff) + ldsw + _i * 8192), 16, 0, 0); } while (0)
#define PG8_LDA(dst, b, h) do { _Pragma("unroll") for (int m = 0; m < 4; ++m) _Pragma("unroll") for (int k = 0; k < 2; ++k) dst[m][k] = *(const PG8_LAS bf16x8*)(lds + PG8_SA(b, h) + aoff + m * 2048 + k * 1024); } while (0)
#define PG8_LDB(dst, b, h) do { _Pragma("unroll") for (int n = 0; n < 2; ++n) _Pragma("unroll") for (int k = 0; k < 2; ++k) dst[n][k] = *(const PG8_LAS bf16x8*)(lds + PG8_SB(b, h) + boff + n * 2048 + k * 1024); } while (0)
#define PG8_MMA(ai, bj, At, Bt) do { __builtin_amdgcn_s_setprio(1); _Pragma("unroll") for (int m = 0; m < 4; ++m) _Pragma("unroll") for (int n = 0; n < 2; ++n) _Pragma("unroll") for (int k = 0; k < 2; ++k) \
        acc[ai][bj][m][n] = __builtin_amdgcn_mfma_f32_16x16x32_bf16(Bt[n][k], At[m][k], acc[ai][bj][m][n], 0, 0, 0); __builtin_amdgcn_s_setprio(0); } while (0)
#define PG8_WAIT_V(n) asm volatile("s_waitcnt vmcnt(" #n ")" ::: "memory")
#define PG8_WAIT_L(n) asm volatile("s_waitcnt lgkmcnt(" #n ")" ::: "memory")
#define PG8_BAR __builtin_amdgcn_s_barrier()
#define PG8_SCHED __builtin_amdgcn_sched_barrier(0)
    Unit cur, nxt; int ui = 0;
    if (!S.next(0, cur)) return;
    f32x4 acc[2][2][4][2];
#pragma unroll
    for (int a = 0; a < 2; ++a)
#pragma unroll
        for (int b = 0; b < 2; ++b)
#pragma unroll
            for (int m = 0; m < 4; ++m)
#pragma unroll
                for (int n = 0; n < 2; ++n) acc[a][b][m][n] = (f32x4){0.f, 0.f, 0.f, 0.f};
    bf16x8 At[4][2], B0[2][2], B1[2][2];
    const char* cA = (const char*)g.A + (size_t)cur.pm * tstep; const char* cB = (const char*)g.Bt + (size_t)cur.pn * tstep;
    S.a_ready(cur);
    if constexpr (SP2) {
        PG8_STAGE(PG8_SB(0, 0), cB, voffB); PG8_STAGE(PG8_SB(0, 1), cB + hstep, voffB); PG8_STAGE(PG8_SA(0, 0), cA, voffA); PG8_STAGE(PG8_SA(0, 1), cA + hstep, voffA);
        if (wr == 1) PG8_BAR;
        PG8_WAIT_V(2); PG8_BAR;
        PG8_STAGE(PG8_SB(1, 0), cB + kstep, voffB); PG8_STAGE(PG8_SA(1, 0), cA + kstep, voffA); PG8_STAGE(PG8_SB(1, 1), cB + hstep + kstep, voffB);
        PG8_WAIT_V(6); PG8_BAR;
    } else {
        PG8_STAGE(PG8_SB(0, 0), cB, voffB); PG8_STAGE(PG8_SA(0, 0), cA, voffA); PG8_STAGE(PG8_SB(0, 1), cB + hstep, voffB); PG8_STAGE(PG8_SA(0, 1), cA + hstep, voffA);
        if (wr == 1) PG8_BAR;
        PG8_WAIT_V(4); PG8_BAR;
        PG8_STAGE(PG8_SB(1, 0), cB + kstep, voffB); PG8_STAGE(PG8_SA(1, 0), cA + kstep, voffA); PG8_STAGE(PG8_SB(1, 1), cB + hstep + kstep, voffB);
        PG8_WAIT_V(6); PG8_BAR;
    }
    for (;;) {
        const bool has_next = S.next(ui + 1, nxt);
        const char* nA = has_next ? (const char*)g.A + (size_t)nxt.pm * tstep : cA; const char* nB = has_next ? (const char*)g.Bt + (size_t)nxt.pn * tstep : cB;
        for (int t = 0; t < nt; t += 2) {
            const bool last = (t == nt - 2);
            const char* a1 = cA + (size_t)(t + 1) * kstep;
            const char* a2 = last ? nA : cA + (size_t)(t + 2) * kstep; const char* b2 = last ? nB : cB + (size_t)(t + 2) * kstep;
            const char* a3 = a2 + kstep; const char* b3 = b2 + kstep;
            if (last && has_next) S.a_ready(nxt);
            if constexpr (SP2) {
            PG8_LDB(B0, 0, 0); PG8_LDB(B1, 0, 1); PG8_SCHED; PG8_LDA(At, 0, 0); PG8_STAGE(PG8_SA(1, 1), a1 + hstep, voffA);
            PG8_WAIT_V(8); PG8_WAIT_L(0); PG8_BAR; PG8_MMA(0, 0, At, B0); PG8_MMA(0, 1, At, B1); PG8_BAR; PG8_SCHED;
            PG8_LDA(At, 0, 1); PG8_STAGE(PG8_SB(0, 0), b2, voffB); PG8_STAGE(PG8_SB(0, 1), b2 + hstep, voffB); PG8_STAGE(PG8_SA(0, 0), a2, voffA);
            PG8_WAIT_V(8); PG8_WAIT_L(0); PG8_BAR; PG8_MMA(1, 0, At, B0); PG8_MMA(1, 1, At, B1); PG8_BAR; PG8_SCHED;
            PG8_LDB(B0, 1, 0); PG8_LDB(B1, 1, 1); PG8_SCHED; PG8_LDA(At, 1, 0); PG8_STAGE(PG8_SA(0, 1), a2 + hstep, voffA);
            PG8_WAIT_V(8); PG8_WAIT_L(0); PG8_BAR; PG8_MMA(0, 0, At, B0); PG8_MMA(0, 1, At, B1); PG8_BAR; PG8_SCHED;
            PG8_LDA(At, 1, 1); PG8_STAGE(PG8_SB(1, 0), b3, voffB); PG8_STAGE(PG8_SB(1, 1), b3 + hstep, voffB); PG8_STAGE(PG8_SA(1, 0), a3, voffA);
            PG8_WAIT_V(8); PG8_WAIT_L(0); PG8_BAR; PG8_MMA(1, 0, At, B0); PG8_MMA(1, 1, At, B1); PG8_BAR; PG8_SCHED;
            } else {
            PG8_LDB(B0, 0, 0); PG8_SCHED; PG8_LDA(At, 0, 0); PG8_STAGE(PG8_SA(1, 1), a1 + hstep, voffA);
            PG8_WAIT_L(8); PG8_BAR; PG8_WAIT_L(0); PG8_MMA(0, 0, At, B0); PG8_BAR; PG8_SCHED;
            PG8_LDB(B1, 0, 1); PG8_STAGE(PG8_SB(0, 0), b2, voffB);
            PG8_BAR; PG8_WAIT_L(0); PG8_MMA(0, 1, At, B1); PG8_BAR;
            PG8_LDA(At, 0, 1); PG8_STAGE(PG8_SA(0, 0), a2, voffA);
            PG8_BAR; PG8_WAIT_L(0); PG8_MMA(1, 0, At, B0); PG8_BAR; PG8_SCHED;
            PG8_STAGE(PG8_SB(0, 1), b2 + hstep, voffB);
            PG8_WAIT_V(6); PG8_BAR; PG8_MMA(1, 1, At, B1); PG8_BAR;
            PG8_LDB(B0, 1, 0); PG8_SCHED; PG8_LDA(At, 1, 0); PG8_STAGE(PG8_SA(0, 1), a2 + hstep, voffA);
            PG8_WAIT_L(8); PG8_BAR; PG8_WAIT_L(0); PG8_MMA(0, 0, At, B0); PG8_BAR; PG8_SCHED;
            PG8_LDB(B1, 1, 1); PG8_STAGE(PG8_SB(1, 0), b3, voffB);
            PG8_BAR; PG8_WAIT_L(0); PG8_MMA(0, 1, At, B1); PG8_BAR;
            PG8_LDA(At, 1, 1); PG8_STAGE(PG8_SA(1, 0), a3, voffA);
            PG8_BAR; PG8_WAIT_L(0); PG8_MMA(1, 0, At, B0); PG8_BAR; PG8_SCHED;
            PG8_STAGE(PG8_SB(1, 1), b3 + hstep, voffB);
            PG8_WAIT_V(6); PG8_BAR; PG8_MMA(1, 1, At, B1); PG8_BAR;
            }
        }
        if constexpr (ALIGN_EPI) { if (wr == 0) PG8_BAR; }
        if constexpr (!Epi::AFTER_DRAIN) { E(acc, cur, wr, wc, fr, fq); S.done(cur); }
        if (!has_next) break;
#pragma unroll
        for (int a = 0; a < 2; ++a)
#pragma unroll
            for (int b = 0; b < 2; ++b)
#pragma unroll
                for (int m = 0; m < 4; ++m)
#pragma unroll
                    for (int n = 0; n < 2; ++n) acc[a][b][m][n] = (f32x4){0.f, 0.f, 0.f, 0.f};
        cur = nxt; cA = nA; cB = nB; ++ui;
        if constexpr (ALIGN_EPI) { if (wr == 1) PG8_BAR; }
    }
    PG8_WAIT_V(0);
    if constexpr (!ALIGN_EPI) { if (wr == 0) PG8_BAR; }
    PG8_BAR;
    if constexpr (Epi::AFTER_DRAIN) { E.fused(acc, cur, wr, wc, fr, fq, lds, wid, lane); S.done(cur); }
#undef PG8_SA
#undef PG8_SB
#undef PG8_STAGE
#undef PG8_LDA
#undef PG8_LDB
#undef PG8_MMA
#undef PG8_WAIT_V
#undef PG8_WAIT_L
#undef PG8_BAR
#undef PG8_SCHED
}
}
#define GAS __attribute__((address_space(1)))
#define LAS __attribute__((address_space(3)))
typedef unsigned short bf16;
typedef unsigned v4u __attribute__((ext_vector_type(4)));
typedef float f32x4 __attribute__((ext_vector_type(4)));
typedef short bf16x8 __attribute__((ext_vector_type(8)));
typedef GAS unsigned gu32;
typedef GAS unsigned long long gu64;
#define RLX_AGENT __ATOMIC_RELAXED, __HIP_MEMORY_SCOPE_AGENT
#define LDS_WAIT() asm volatile("s_waitcnt lgkmcnt(0)" ::: "memory")
#define VM_WAIT() asm volatile("s_waitcnt vmcnt(0)" ::: "memory")
__device__ __forceinline__ unsigned long long rt() { return __builtin_amdgcn_s_memrealtime(); }
__device__ __forceinline__ unsigned f2bf(float f) { unsigned u = __builtin_bit_cast(unsigned, f); return (u + 0x7fffu + ((u >> 16) & 1u)) >> 16; }
__device__ __forceinline__ unsigned pk2(float lo, float hi) { return f2bf(lo) | (f2bf(hi) << 16); }

#define XB_TMO      128
#define XB_XCNT(j)  (256  + 64 * (j))
#define XB_XSUB(j)  (1280 + 64 * (j))
#define XB_XGEN(j)  (2304 + 64 * (j))
#define XB_TOP      3328
#define XB_TOPGEN   3392
#define XCD_BAR_WORDS 3456
#define XB_SPIN_CAP (1u << 18)

__device__ __forceinline__ unsigned xb_ld(unsigned* p)              { return __hip_atomic_load(p, __ATOMIC_RELAXED, __HIP_MEMORY_SCOPE_AGENT); }
__device__ __forceinline__ unsigned xb_add(unsigned* p, unsigned v) { return __hip_atomic_fetch_add(p, v, __ATOMIC_RELAXED, __HIP_MEMORY_SCOPE_AGENT); }
__device__ __forceinline__ unsigned xb_xcc_id() { return (unsigned)__builtin_amdgcn_s_getreg((3 << 11) | 20) & 0xFu; }
#define XB_SPIN(cond, bar) do { unsigned _sp = 0; while (cond) { __builtin_amdgcn_s_sleep(1); \
    if ((++_sp & 255u) == 0u) { if (xb_ld(&(bar)[XB_TMO])) break; if (_sp > XB_SPIN_CAP) { atomicAdd(&(bar)[XB_TMO], 1u); break; } } } } while (0)

struct XcdBarrier {
    unsigned* bar; unsigned x;
    volatile LAS unsigned* st;
};

__device__ __forceinline__ XcdBarrier xcd_barrier_post(unsigned* bar, volatile LAS unsigned* st) {
    XcdBarrier b; b.bar = bar; b.x = xb_xcc_id(); b.st = st;
    if (threadIdx.x == 0) (void)xb_add(&bar[XB_XCNT(b.x)], 1u);
    return b;
}
__device__ __forceinline__ void xcd_barrier_complete(unsigned* bar, unsigned x, unsigned& nloc, unsigned& nx) {
    const unsigned G = gridDim.x * gridDim.y * gridDim.z;
    unsigned sum, cnt, mine, sp = 0u;
    for (;;) {
        sum = 0u; cnt = 0u; mine = 0u;
#pragma unroll
        for (unsigned j = 0; j < 16; ++j) { const unsigned c = xb_ld(&bar[XB_XCNT(j)]); sum += c; cnt += (c > 0u) ? 1u : 0u; mine = (j == x) ? c : mine; }
        if (sum == G) break;
        __builtin_amdgcn_s_sleep(1);
        if ((++sp & 255u) == 0u) { if (xb_ld(&bar[XB_TMO])) break; if (sp > XB_SPIN_CAP) { atomicAdd(&bar[XB_TMO], 1u); break; } }
    }
    nloc = mine > 0u ? mine : 1u; nx = cnt > 0u ? cnt : 1u;
}

__device__ __forceinline__ void xcd_barrier(const XcdBarrier& b) {
    asm volatile("s_waitcnt vmcnt(0)" ::: "memory");
    __syncthreads();
    if (threadIdx.x == 0) {
        unsigned* bar = b.bar;
        __builtin_amdgcn_s_waitcnt(0);
        unsigned nloc = b.st[0], nx = b.st[1];
        if (nloc == 0u) { xcd_barrier_complete(bar, b.x, nloc, nx); b.st[0] = nloc; b.st[1] = nx; }
        const unsigned old = xb_add(&bar[XB_XSUB(b.x)], 1u);
        const unsigned gen = old / nloc;
        if (old + 1u == (gen + 1u) * nloc) {
            __builtin_amdgcn_fence(__ATOMIC_RELEASE, "agent");
            asm volatile("s_waitcnt vmcnt(0)" ::: "memory");
            const unsigned og = xb_add(&bar[XB_TOP], 1u);
            const unsigned tg = og / nx;
            if (og + 1u == (tg + 1u) * nx) xb_add(&bar[XB_TOPGEN], 1u);
            else XB_SPIN(xb_ld(&bar[XB_TOPGEN]) == tg, bar);
            __builtin_amdgcn_fence(__ATOMIC_ACQUIRE, "agent");
            xb_add(&bar[XB_XGEN(b.x)], 1u);
            asm volatile("s_waitcnt vmcnt(0)" ::: "memory");
        } else {
            XB_SPIN(xb_ld(&bar[XB_XGEN(b.x)]) == gen, bar);
            __builtin_amdgcn_fence(__ATOMIC_ACQUIRE, "agent");
            asm volatile("s_waitcnt vmcnt(0)" ::: "memory");
        }
    }
    __syncthreads();
}

constexpr int NWAVES = 8, NTHREADS = 512;
constexpr int DM = 2048, NP_ROWS = 8192, NS_ROWS = 128, NROWS = 8320, MPAD = 8448;
constexpr int DEPTH = 4, NBATCH = 36;
constexpr int INW = 4368, ZW = 4608;
constexpr int ZQ = 0, ZK = 512, ZV = 640, ZU = 768, GQ = 1280, GK = 1792, GV = 2304, GG = 3328, GA = 4352;
constexpr int DFF = 5632, NGU = 11264, MODW = 12288, MODLD = 49152;
constexpr float EPS = 1e-6f;
constexpr size_t O_Y = 0, O_WK_P = 17039360, O_WV_P = 17301504, O_POOL_P = 17563648, O_GLA_P = 17686528,
                 O_WK_S = 19783680, O_WV_S = 21880832, O_POOL_S = 23977984, O_GLA_S = 24961024, O_END = 41738240;
constexpr size_t MiB = 1u << 20;
constexpr size_t WS_CTL = 0, CTL_ZERO_BYTES = 1 * MiB;
constexpr size_t WS_WADA = 1 * MiB;
constexpr size_t WS_WIN  = WS_WADA + 192 * MiB;
constexpr size_t WS_WOUT = WS_WIN + 72 * MiB;
constexpr size_t WS_WGU  = WS_WOUT + 32 * MiB;
constexpr size_t WS_WDN  = WS_WGU + 176 * MiB;
constexpr size_t WS_X    = WS_WDN + 88 * MiB;
constexpr size_t WS_H    = WS_X + 66 * MiB;
constexpr size_t WS_Z    = WS_H + 33 * MiB;
constexpr size_t WS_MIX  = WS_Z + 75 * MiB;
constexpr size_t WS_ACT  = WS_MIX + 33 * MiB;
constexpr size_t WS_OGLA = WS_ACT + 91 * MiB;
constexpr size_t WS_LA   = WS_OGLA + 33 * MiB;
constexpr size_t WS_MOD  = WS_LA + 17 * MiB;
constexpr size_t WS_SC   = WS_MOD + 7 * MiB;
constexpr size_t WS_BTAB = WS_SC + 1 * MiB;
constexpr size_t WS_END  = WS_BTAB + 1 * MiB;
constexpr int CW_BAR = 4096;
constexpr int RING_OFF = 0, RING_BYTES = 131072;
constexpr int LDSCTL_OFF = RING_BYTES, MISC_OFF = LDSCTL_OFF + 320;
constexpr int LDS_BYTES = 147456;

struct Args { const float* in[24]; float* out; unsigned char* ws; int ph_lo, ph_hi; };
struct Frame {
    LAS unsigned char* lds;
    volatile LAS unsigned* MISC;
    int wave, vcu, G; int zo;
    __device__ __forceinline__ int lane_id() const { return (int)__builtin_amdgcn_mbcnt_hi(~0u, __builtin_amdgcn_mbcnt_lo(~0u, 0u)); }
    unsigned char* ws; float* out;
    __device__ __forceinline__ bf16* Wada_t() const { return (bf16*)(ws + WS_WADA); }
    __device__ __forceinline__ bf16* Win_t() const { return (bf16*)(ws + WS_WIN); }
    __device__ __forceinline__ bf16* Wout_t() const { return (bf16*)(ws + WS_WOUT); }
    __device__ __forceinline__ bf16* Wgu_t() const { return (bf16*)(ws + WS_WGU); }
    __device__ __forceinline__ bf16* Wdn_t() const { return (bf16*)(ws + WS_WDN); }
    __device__ __forceinline__ float* X() const { return (float*)(ws + WS_X); }
    __device__ __forceinline__ bf16* H() const { return (bf16*)(ws + WS_H); }
    __device__ __forceinline__ bf16* Z() const { return (bf16*)(ws + WS_Z); }
    __device__ __forceinline__ bf16* MIX() const { return (bf16*)(ws + WS_MIX); }
    __device__ __forceinline__ bf16* ACT() const { return (bf16*)(ws + WS_ACT); }
    __device__ __forceinline__ float* OGLA() const { return (float*)(ws + WS_OGLA); }
    __device__ __forceinline__ float* LA() const { return (float*)(ws + WS_LA); }
    __device__ __forceinline__ float* MOD() const { return (float*)(ws + WS_MOD); }
    __device__ __forceinline__ bf16* SC() const { return (bf16*)(ws + WS_SC); }
    __device__ __forceinline__ float* BTAB() const { return (float*)(ws + WS_BTAB); }
};
enum { I_XP = 0, I_XS, I_CK, I_CV, I_SPOOL, I_SGLA, I_CP, I_CS, I_WADA, I_BADA, I_GMIX, I_GFFN, I_WIN, I_WOUT, I_RELB, I_SINKS, I_WPOOL, I_PSCALE, I_WA2, I_BA2, I_GGLA, I_WGU, I_WDN, I_GFIN };

__device__ __forceinline__ float bf2f(unsigned short b) { return __uint_as_float((unsigned)b << 16); }
__device__ __forceinline__ float bflo(unsigned w) { return __uint_as_float(w << 16); }
__device__ __forceinline__ float bfhi(unsigned w) { return __uint_as_float(w & 0xffff0000u); }
__device__ __forceinline__ float wave_sum(float v) {
#pragma unroll
    for (int o = 1; o < 64; o <<= 1) v += __shfl_xor(v, o);
    return v;
}
__device__ __forceinline__ float wave_max(float v) {
#pragma unroll
    for (int o = 1; o < 64; o <<= 1) v = fmaxf(v, __shfl_xor(v, o));
    return v;
}
__device__ __forceinline__ int t5_bucket(int n) {
    if (n < 16) return n;
    return 16 + (n >= 19) + (n >= 21) + (n >= 24) + (n >= 27) + (n >= 31) + (n >= 35) + (n >= 40) + (n >= 46) + (n >= 52) + (n >= 59) + (n >= 67) + (n >= 77) + (n >= 87) + (n >= 99) + (n >= 113);
}

template <int MODE>
__device__ __forceinline__ void transpose_item(const float* W, int K, int N, int nblk, bf16* WT, int row_off, LAS float* scr, int item, int lane) {
    const int kb = item / nblk, nb = item % nblk, k0 = 64 * kb, n0 = 32 * nb;
    const int nn = n0 + (lane & 31); const bool ok = nn < N;
#pragma unroll 8
    for (int i = 0; i < 32; ++i) { const int kk = 2 * i + (lane >> 5); scr[kk * 33 + (lane & 31)] = ok ? W[(size_t)(k0 + kk) * N + nn] : 0.f; }
    LDS_WAIT(); asm volatile("" ::: "memory");
    const int c = lane & 7;
#pragma unroll
    for (int j = 0; j < 4; ++j) { const int n = (lane >> 3) + 8 * j; const LAS float* s = scr + (8 * c) * 33 + n;
        v4u o; o.x = pk2(s[0 * 33], s[1 * 33]); o.y = pk2(s[2 * 33], s[3 * 33]); o.z = pk2(s[4 * 33], s[5 * 33]); o.w = pk2(s[6 * 33], s[7 * 33]);
        int orow = n0 + n;
        if (MODE == 1) { orow = (orow < DFF) ? ((orow >> 7) * 256 + (orow & 127)) : (((orow - DFF) >> 7) * 256 + 128 + ((orow - DFF) & 127)); }
        *(GAS v4u*)(WT + (size_t)(row_off + orow) * K + k0 + 8 * c) = o; }
    LDS_WAIT(); asm volatile("" ::: "memory");
}
__device__ __forceinline__ void p0_prologue(Frame& F, const Args& A) {
    LAS float* scr = (LAS float*)(F.lds + RING_OFF + F.wave * 16384);
    const int gw = F.vcu * NWAVES + F.wave, NGW = F.G * NWAVES;
    const int gt = gw * 64 + F.lane_id(), NGT = NGW * 64;
    constexpr int I_ADA = 32 * 384, I_IN = 32 * 137, I_OUT = 32 * 64, I_GU = 32 * 352, I_DN = 88 * 64, I_L = I_ADA + I_IN + I_OUT + I_GU + I_DN;
    for (int it = gw; it < DEPTH * I_L; it += NGW) {
        const int l = it / I_L; int r = it - l * I_L;
        if (r < I_ADA) { transpose_item<0>(A.in[F.zo + I_WADA] + (size_t)l * DM * MODW, DM, MODW, 384, F.Wada_t(), l * MODW, scr, r, F.lane_id()); continue; } r -= I_ADA;
        if (r < I_IN)  { transpose_item<0>(A.in[F.zo + I_WIN] + (size_t)l * DM * INW, DM, INW, 137, F.Win_t() + (size_t)l * ZW * DM, 0, scr, r, F.lane_id()); continue; } r -= I_IN;
        if (r < I_OUT) { transpose_item<0>(A.in[F.zo + I_WOUT] + (size_t)l * DM * DM, DM, DM, 64, F.Wout_t() + (size_t)l * DM * DM, 0, scr, r, F.lane_id()); continue; } r -= I_OUT;
        if (r < I_GU)  { transpose_item<1>(A.in[F.zo + I_WGU] + (size_t)l * DM * NGU, DM, NGU, 352, F.Wgu_t() + (size_t)l * NGU * DM, 0, scr, r, F.lane_id()); continue; } r -= I_GU;
        transpose_item<0>(A.in[F.zo + I_WDN] + (size_t)l * DFF * DM, DFF, DM, 64, F.Wdn_t() + (size_t)l * DM * DFF, 0, scr, r, F.lane_id());
    }
    const v4u z4 = {0u, 0u, 0u, 0u};
    for (int i = gt; i < DEPTH * 224 * 256; i += NGT) { const int l = i / (224 * 256), r = i - l * (224 * 256); *((GAS v4u*)(F.Win_t() + ((size_t)l * ZW + 4384) * DM) + r) = z4; }
    for (int i = gt; i < 128 * 256; i += NGT) { *((GAS v4u*)(F.H() + (size_t)NROWS * DM) + i) = z4; *((GAS v4u*)(F.MIX() + (size_t)NROWS * DM) + i) = z4; }
    for (int i = gt; i < 128 * 704; i += NGT) *((GAS v4u*)(F.ACT() + (size_t)NROWS * DFF) + i) = z4;
    for (int i = gt; i < NP_ROWS * 512; i += NGT) ((GAS f32x4*)F.X())[i] = ((const GAS f32x4*)A.in[F.zo + I_XP])[i];
    for (int i = gt; i < NS_ROWS * 512; i += NGT) ((GAS f32x4*)(F.X() + (size_t)NP_ROWS * DM))[i] = ((const GAS f32x4*)A.in[F.zo + I_XS])[i];
    for (int i = gt; i < 256 * 1024; i += NGT) { const int r = i >> 10, cp = (i & 1023) * 2; unsigned w = 0u;
        if (r < NBATCH) { const float* c = (r < 4) ? (A.in[F.zo + I_CP] + (size_t)r * DM) : (A.in[F.zo + I_CS] + (size_t)(r - 4) * DM); const float a = c[cp], b = c[cp + 1];
            w = pk2(a / (1.0f + __expf(-a)), b / (1.0f + __expf(-b))); }
        ((GAS unsigned*)F.SC())[i] = w; }
    for (int i = gt; i < 8 * 128; i += NGT) { const int h = i >> 7, dist = i & 127; F.BTAB()[i] = A.in[F.zo + I_RELB][t5_bucket(dist) * 8 + h]; }
}

__device__ __forceinline__ void norm_mod_rows(Frame& F, const float* g, const float* modl  ) {
    const int gw = F.vcu * NWAVES + F.wave, NGW = F.G * NWAVES;
    for (int r = gw; r < NROWS; r += NGW) {
        const int b = r < NP_ROWS ? (r >> 11) : 4 + ((r - NP_ROWS) >> 2);
        const float* xr = F.X() + (size_t)r * DM + 4 * F.lane_id(); const float* sh = modl + (size_t)b * MODLD + 4 * F.lane_id(); const float* gg = g + 4 * F.lane_id();
        f32x4 v[8]; float ss = 0.f;
#pragma unroll
        for (int j = 0; j < 8; ++j) { v[j] = *(const f32x4*)(xr + 256 * j); ss += (v[j].x * v[j].x + v[j].y * v[j].y) + (v[j].z * v[j].z + v[j].w * v[j].w); }
        const float rstd = 1.0f / sqrtf(wave_sum(ss) * (1.0f / DM) + EPS);
        bf16* hr = F.H() + (size_t)r * DM + 4 * F.lane_id();
#pragma unroll
        for (int j = 0; j < 8; ++j) { const f32x4 gv = *(const f32x4*)(gg + 256 * j), sv = *(const f32x4*)(sh + 256 * j), cv = *(const f32x4*)(sh + 2048 + 256 * j);
            const f32x4 y = (v[j] * rstd * gv) * (1.0f + cv) + sv;
            uint2 w; w.x = pk2(y.x, y.y); w.y = pk2(y.z, y.w); *(uint2*)(hr + 256 * j) = w; }
    }
}
__device__ __forceinline__ void final_norm_rows(Frame& F, const Args& A) {
    const int gw = F.vcu * NWAVES + F.wave, NGW = F.G * NWAVES; const float* g = A.in[F.zo + I_GFIN] + 4 * F.lane_id();
    for (int r = gw; r < NROWS; r += NGW) {
        const float* xr = F.X() + (size_t)r * DM + 4 * F.lane_id();
        f32x4 v[8]; float ss = 0.f;
#pragma unroll
        for (int j = 0; j < 8; ++j) { v[j] = *(const f32x4*)(xr + 256 * j); ss += (v[j].x * v[j].x + v[j].y * v[j].y) + (v[j].z * v[j].z + v[j].w * v[j].w); }
        const float rstd = 1.0f / sqrtf(wave_sum(ss) * (1.0f / DM) + EPS);
        float* yr = F.out + O_Y + (size_t)r * DM + 4 * F.lane_id();
#pragma unroll
        for (int j = 0; j < 8; ++j) { const f32x4 gv = *(const f32x4*)(g + 256 * j); *(f32x4*)(yr + 256 * j) = v[j] * rstd * gv; }
    }
}

__device__ __forceinline__ void attn_item(Frame& F, const Args& A, int l, int r, int hd, LAS float* ps) {
    const int lane = F.lane_id(), g = hd >> 2; const bool smp = r >= NP_ROWS;
    const int t = r & 2047, sb = smp ? ((r - NP_ROWS) >> 2) : 0, si = (r - NP_ROWS) & 3;
    LAS float* qs = ps + 128;
    { const unsigned w = ((const unsigned*)(F.Z() + (size_t)r * ZW + ZQ + hd * 64))[lane & 31]; if (lane < 32) { qs[2 * lane] = bflo(w); qs[2 * lane + 1] = bfhi(w); } }
    LDS_WAIT(); asm volatile("" ::: "memory");
    const float* ck = A.in[F.zo + I_CK] + ((size_t)(l * 32 + sb) * 128) * 128 + g * 64;
    const float* cv = A.in[F.zo + I_CV] + ((size_t)(l * 32 + sb) * 128) * 128 + g * 64;
    const int jmin = smp ? 0 : (t >= 127 ? 0 : 127 - t);
    float sc[2];
#pragma unroll 1
    for (int jj = 0; jj < 2; ++jj) {
        const int j = lane + 64 * jj, dist = 127 - j; float dot = 0.f; bool valid = j >= jmin;
        if (valid) {
            const int krel = si - dist;
            if (smp && krel < 0) {
                const f32x4* kp = (const f32x4*)(ck + (size_t)(krel + 128) * 128);
#pragma unroll 4
                for (int c = 0; c < 16; ++c) { const f32x4 kv = kp[c]; const f32x4 qv = *(const LAS f32x4*)(qs + 4 * c); dot += qv.x * kv.x + qv.y * kv.y + qv.z * kv.z + qv.w * kv.w; }
            } else {
                const int krow = smp ? (NP_ROWS + sb * 4 + krel) : (r - dist);
                const v4u* kp = (const v4u*)(F.Z() + (size_t)krow * ZW + ZK + g * 64);
#pragma unroll 4
                for (int c = 0; c < 8; ++c) { const v4u w = kp[c];
                    const f32x4 qa = *(const LAS f32x4*)(qs + 8 * c), qb = *(const LAS f32x4*)(qs + 8 * c + 4);
                    dot += qa.x * bflo(w.x) + qa.y * bfhi(w.x) + qa.z * bflo(w.y) + qa.w * bfhi(w.y) + qb.x * bflo(w.z) + qb.y * bfhi(w.z) + qb.z * bflo(w.w) + qb.w * bfhi(w.w); }
            }
        }
        const float sv = valid ? dot * 0.125f + F.BTAB()[hd * 128 + dist] : -INFINITY;
        if (jj == 0) sc[0] = sv; else sc[1] = sv;
    }
    const float sink = A.in[F.zo + I_SINKS][l * 8 + hd];
    const float m = fmaxf(wave_max(fmaxf(sc[0], sc[1])), sink);
    const float p0 = __expf(sc[0] - m), p1 = __expf(sc[1] - m);
    const float denom = wave_sum(p0 + p1) + __expf(sink - m);
    ps[lane] = p0; ps[lane + 64] = p1;
    LDS_WAIT(); asm volatile("" ::: "memory");
    float o = 0.f;
    for (int j = jmin; j < 128; ++j) {
        const float pj = ps[j]; const int dist = 127 - j; float vv;
        const int krel = si - dist;
        if (smp && krel < 0) vv = cv[(size_t)(krel + 128) * 128 + lane];
        else { const int krow = smp ? (NP_ROWS + sb * 4 + krel) : (r - dist); vv = bf2f(F.Z()[(size_t)krow * ZW + ZV + g * 64 + lane]); }
        o += pj * vv;
    }
    F.MIX()[(size_t)r * DM + hd * 64 + lane] = (bf16)f2bf(o / denom);
    LDS_WAIT(); asm volatile("" ::: "memory");
}
__device__ __forceinline__ void pool_item(Frame& F, const Args& A, int l, int r, int gi, LAS float* ds) {
    const int lane = F.lane_id(), w = 2 << gi; const bool smp = r >= NP_ROWS;
    const int t = r & 2047, sb = (r - NP_ROWS) >> 2, si = (r - NP_ROWS) & 3;
    const float* pbuf = A.in[F.zo + I_SPOOL] + ((size_t)(l * 32 + sb) * 15) * 512 + gi * 128;
    float s0 = 0.f, s1 = 0.f, u0 = 0.f, u1 = 0.f;
    for (int o = 0; o < w; ++o) {
        float a0 = 0.f, a1 = 0.f;
        if (!smp) { if (t - o >= 0) { const bf16* zp = F.Z() + (size_t)(r - o) * ZW + ZU + gi * 128; a0 = bf2f(zp[lane]); a1 = bf2f(zp[lane + 64]); } }
        else { const int idx = si - o;
            if (idx >= 0) { const bf16* zp = F.Z() + (size_t)(NP_ROWS + sb * 4 + idx) * ZW + ZU + gi * 128; a0 = bf2f(zp[lane]); a1 = bf2f(zp[lane + 64]); }
            else { const float* bp = pbuf + (size_t)(15 + idx) * 512; a0 = bp[lane]; a1 = bp[lane + 64]; } }
        if (o == 0) { u0 = a0; u1 = a1; }
        s0 += a0; s1 += a1;
    }
    const float cnt = smp ? (float)w : (float)((t + 1) < w ? (t + 1) : w);
    ds[lane] = s0 / cnt - u0; ds[lane + 64] = s1 / cnt - u1;
    LDS_WAIT(); asm volatile("" ::: "memory");
    const float* wp = A.in[F.zo + I_WPOOL] + ((size_t)(l * 4 + gi) * 128) * 128;
    float y0 = 0.f, y1 = 0.f;
#pragma unroll 4
    for (int c = 0; c < 128; ++c) { const float dv = ds[c]; y0 += dv * wp[c * 128 + lane]; y1 += dv * wp[c * 128 + lane + 64]; }
    const float* psc = A.in[F.zo + I_PSCALE] + l * 512 + gi * 128;
    bf16* mp = F.MIX() + (size_t)r * DM + 512 + gi * 128;
    mp[lane] = (bf16)f2bf(y0 * psc[lane]); mp[lane + 64] = (bf16)f2bf(y1 * psc[lane + 64]);
    LDS_WAIT(); asm volatile("" ::: "memory");
}
__device__ __forceinline__ void gate_row(Frame& F, const Args& A, int l, int r) {
    const int lane = F.lane_id();
    float ga[16];
    { const v4u* gp = (const v4u*)(F.Z() + (size_t)r * ZW + GA);
#pragma unroll
      for (int c = 0; c < 2; ++c) { const v4u w = gp[c]; ga[8 * c] = bflo(w.x); ga[8 * c + 1] = bfhi(w.x); ga[8 * c + 2] = bflo(w.y); ga[8 * c + 3] = bfhi(w.y); ga[8 * c + 4] = bflo(w.z); ga[8 * c + 5] = bfhi(w.z); ga[8 * c + 6] = bflo(w.w); ga[8 * c + 7] = bfhi(w.w); } }
    const float* wa = A.in[F.zo + I_WA2] + (size_t)l * 16 * 512; const float* ba = A.in[F.zo + I_BA2] + l * 512;
#pragma unroll 2
    for (int cc = 0; cc < 8; ++cc) { const int c = lane + 64 * cc; float x = ba[c];
#pragma unroll
        for (int j = 0; j < 16; ++j) x += ga[j] * wa[j * 512 + c];
        const float ls = fminf(x, 0.f) - log1pf(__expf(-fabsf(x)));
        F.LA()[(size_t)r * 512 + c] = ls * (1.0f / 16.0f); }
}
__device__ __forceinline__ void cache_outputs(Frame& F, const Args& A, int l) {
    const int gt = (F.vcu * NWAVES + F.wave) * 64 + F.lane_id(), NGT = F.G * NWAVES * 64;
    for (int i = gt; i < 4 * 128 * 128; i += NGT) { const int b = i >> 14, j = (i >> 7) & 127, c = i & 127; const bf16* zr = F.Z() + (size_t)(b * 2048 + 1920 + j) * ZW;
        F.out[O_WK_P + (size_t)l * 65536 + i] = bf2f(zr[ZK + c]); F.out[O_WV_P + (size_t)l * 65536 + i] = bf2f(zr[ZV + c]); }
    for (int i = gt; i < 4 * 15 * 512; i += NGT) { const int b = i / 7680, rem = i - b * 7680, j = rem >> 9, c = rem & 511;
        F.out[O_POOL_P + (size_t)l * 30720 + i] = bf2f(F.Z()[(size_t)(b * 2048 + 2033 + j) * ZW + ZU + c]); }
    for (int i = gt; i < 32 * 128 * 128; i += NGT) { const int sb = i >> 14, p = (i >> 7) & 127, c = i & 127; float kv, vv;
        if (p < 124) { const size_t src = ((size_t)(l * 32 + sb) * 128 + p + 4) * 128 + c; kv = A.in[F.zo + I_CK][src]; vv = A.in[F.zo + I_CV][src]; }
        else { const bf16* zr = F.Z() + (size_t)(NP_ROWS + sb * 4 + p - 124) * ZW; kv = bf2f(zr[ZK + c]); vv = bf2f(zr[ZV + c]); }
        F.out[O_WK_S + (size_t)l * 524288 + i] = kv; F.out[O_WV_S + (size_t)l * 524288 + i] = vv; }
    for (int i = gt; i < 32 * 15 * 512; i += NGT) { const int sb = i / 7680, rem = i - sb * 7680, j = rem >> 9, c = rem & 511; float v;
        if (j < 11) v = A.in[F.zo + I_SPOOL][((size_t)(l * 32 + sb) * 15 + j + 4) * 512 + c];
        else v = bf2f(F.Z()[(size_t)(NP_ROWS + sb * 4 + j - 11) * ZW + ZU + c]);
        F.out[O_POOL_S + (size_t)l * 245760 + i] = v; }
}
struct GlaStepIn { float la0, la1, k0, k1, q0, q1; uint2 v; };
__device__ __forceinline__ GlaStepIn gla_load(Frame& F, int row, int hh, int e0, int lane) {
    GlaStepIn s; const float* lar = F.LA() + (size_t)row * 512 + hh * 128; const bf16* zr = F.Z() + (size_t)row * ZW;
    s.la0 = lar[lane]; s.la1 = lar[lane + 64];
    s.k0 = bf2f(zr[GK + hh * 128 + lane]); s.k1 = bf2f(zr[GK + hh * 128 + lane + 64]);
    s.q0 = bf2f(zr[GQ + hh * 128 + lane]); s.q1 = bf2f(zr[GQ + hh * 128 + lane + 64]);
    s.v = *(const uint2*)(zr + GV + hh * 256 + e0);
    return s;
}
__device__ __forceinline__ void gla_seq_item(Frame& F, int row0, int T, int hh, int e0, const float* S0, float* Sout) {
    const int lane = F.lane_id();
    float s[2][4];
    if (S0) { const f32x4 a = *(const f32x4*)(S0 + (size_t)lane * 256 + e0), b = *(const f32x4*)(S0 + (size_t)(lane + 64) * 256 + e0);
        s[0][0] = a.x; s[0][1] = a.y; s[0][2] = a.z; s[0][3] = a.w; s[1][0] = b.x; s[1][1] = b.y; s[1][2] = b.z; s[1][3] = b.w; }
    else {
#pragma unroll
        for (int j = 0; j < 4; ++j) { s[0][j] = 0.f; s[1][j] = 0.f; } }
    GlaStepIn cur = gla_load(F, row0, hh, e0, lane);
    for (int t = 0; t < T; ++t) {
        GlaStepIn nxt = cur;
        if (t + 1 < T) nxt = gla_load(F, row0 + t + 1, hh, e0, lane);
        const float a0 = __expf(cur.la0), a1 = __expf(cur.la1);
        const float v[4] = {bflo(cur.v.x), bfhi(cur.v.x), bflo(cur.v.y), bfhi(cur.v.y)};
        float p[4];
#pragma unroll
        for (int j = 0; j < 4; ++j) { s[0][j] = a0 * s[0][j] + cur.k0 * v[j]; s[1][j] = a1 * s[1][j] + cur.k1 * v[j]; p[j] = cur.q0 * s[0][j] + cur.q1 * s[1][j]; }
#pragma unroll
        for (int j = 0; j < 4; ++j) p[j] = wave_sum(p[j]);
        if (lane == 0) { const float sc = 0.08838834764831845f; *(f32x4*)(F.OGLA() + (size_t)(row0 + t) * 1024 + hh * 256 + e0) = (f32x4){p[0] * sc, p[1] * sc, p[2] * sc, p[3] * sc}; }
        cur = nxt;
    }
    *(f32x4*)(Sout + (size_t)lane * 256 + e0) = (f32x4){s[0][0], s[0][1], s[0][2], s[0][3]};
    *(f32x4*)(Sout + (size_t)(lane + 64) * 256 + e0) = (f32x4){s[1][0], s[1][1], s[1][2], s[1][3]};
}
__device__ __forceinline__ void gla_out_item(Frame& F, const Args& A, int l, int r, int hh) {
    const int lane = F.lane_id();
    const f32x4 o = *(const f32x4*)(F.OGLA() + (size_t)r * 1024 + hh * 256 + 4 * lane);
    const float ss = wave_sum((o.x * o.x + o.y * o.y) + (o.z * o.z + o.w * o.w));
    const float rstd = 1.0f / sqrtf(ss * (1.0f / 256.0f) + EPS);
    const f32x4 gv = *(const f32x4*)(A.in[F.zo + I_GGLA] + l * 1024 + hh * 256 + 4 * lane);
    const uint2 gw = *(const uint2*)(F.Z() + (size_t)r * ZW + GG + hh * 256 + 4 * lane);
    const float g0 = bflo(gw.x), g1 = bfhi(gw.x), g2 = bflo(gw.y), g3 = bfhi(gw.y);
    const float y0 = o.x * rstd * gv.x * (g0 / (1.0f + __expf(-g0))), y1 = o.y * rstd * gv.y * (g1 / (1.0f + __expf(-g1)));
    const float y2 = o.z * rstd * gv.z * (g2 / (1.0f + __expf(-g2))), y3 = o.w * rstd * gv.w * (g3 / (1.0f + __expf(-g3)));
    uint2 w; w.x = pk2(y0, y1); w.y = pk2(y2, y3);
    *(uint2*)(F.MIX() + (size_t)r * DM + 1024 + hh * 256 + 4 * lane) = w;
}

#ifndef EN_P0
#define EN_P0 1
#endif
#ifndef EN_G
#define EN_G 1
#endif
#ifndef EN_N
#define EN_N 1
#endif
#ifndef EN_M2
#define EN_M2 1
#endif
#ifndef EN_M3
#define EN_M3 1
#endif
#ifndef EN_M4
#define EN_M4 1
#endif
#ifndef EN_G1
#define EN_G1 1
#endif
#ifndef EN_GIN
#define EN_GIN 1
#endif
#ifndef EN_GOUT
#define EN_GOUT 1
#endif
#ifndef EN_GGU
#define EN_GGU 1
#endif
#ifndef EN_GDN
#define EN_GDN 1
#endif
#ifndef MK_SINGLE
#define MK_SINGLE 0
#endif
constexpr int PH_PER_LAYER = 9, PH_LAYER0 = 2, PH_FINAL = PH_LAYER0 + DEPTH * PH_PER_LAYER, PH_COUNT = PH_FINAL + 1;
__global__ void __launch_bounds__(NTHREADS, 2) hymba_fwd(Args args) {
    extern __shared__ __attribute__((aligned(16))) unsigned char lds[];
    Frame F;
    F.lds = (LAS unsigned char*)lds;
    F.MISC = (volatile LAS unsigned*)(F.lds + MISC_OFF);
    F.wave = __builtin_amdgcn_readfirstlane((int)threadIdx.x >> 6); F.zo = 0;
    F.G = gridDim.x; { const int bx = blockIdx.x; F.vcu = (F.G % 8 == 0) ? (bx % 8) * (F.G / 8) + bx / 8 : bx; }
    F.ws = args.ws; F.out = args.out;
    gu32* const ctl = (gu32*)(F.ws + WS_CTL);
    for (int u = threadIdx.x; u < (LDS_BYTES - LDSCTL_OFF) / 4; u += NTHREADS) ((LAS unsigned*)(F.lds + LDSCTL_OFF))[u] = 0u;
    __syncthreads();
#if MK_SINGLE
    XcdBarrier bar = xcd_barrier_post((unsigned*)(ctl + CW_BAR), F.MISC + 8);
#define GRID_BAR() xcd_barrier(bar)
#else
#define GRID_BAR() do { } while (0)
#endif
    const int lo = args.ph_lo, hi = args.ph_hi;
#define IN(k) (lo <= (k) && (k) < hi)
#define BOTH(k) (IN(k) && IN((k) + 1))
#define PHASE_BEGIN() asm volatile("s_mov_b32 %0, 0" : "=s"(F.zo), "+s"(F.G), "+s"(F.vcu), "+s"(F.wave))
#define gw (F.vcu * NWAVES + F.wave)
#define NGW (F.G * NWAVES)
#define wscr ((LAS float*)(F.lds + RING_OFF + F.wave * 16384))

    if (EN_P0 && IN(0)) { PHASE_BEGIN(); p0_prologue(F, args); if (BOTH(0)) GRID_BAR(); }
    if (EN_G && EN_G1 && IN(1)) { PHASE_BEGIN();
        pg8::Gemm g{F.SC(), F.Wada_t(), 256, DEPTH * MODW, DM}; pg8::StaticOrder S; S.init(256, DEPTH * MODW, F.G, (int)blockIdx.x);
        pg8::EpiMod E{F.MOD(), args.in[F.zo + I_BADA]};
        pg8::gemm_phase<pg8::EpiMod, pg8::StaticOrder, true, true>(F.lds + RING_OFF, g, S, E, F.wave);
        if (BOTH(1)) GRID_BAR();
    }
    for (int l = 0; l < DEPTH; ++l) {
        const int pb = PH_LAYER0 + l * PH_PER_LAYER;
        const float* modl = F.MOD() + (size_t)l * MODW;
        if (EN_N && IN(pb + 0)) { PHASE_BEGIN(); norm_mod_rows(F, args.in[F.zo + I_GMIX] + l * DM, modl); if (BOTH(pb + 0)) GRID_BAR(); }
        if (EN_G && EN_GIN && IN(pb + 1)) { PHASE_BEGIN();
            pg8::Gemm g{F.H(), F.Win_t() + (size_t)l * ZW * DM, MPAD, ZW, DM}; pg8::StaticOrder S; S.init(MPAD, ZW, F.G, (int)blockIdx.x);
            pg8::EpiZ E{F.Z(), ZW};
            pg8::gemm_phase<pg8::EpiZ, pg8::StaticOrder, true, true>(F.lds + RING_OFF, g, S, E, F.wave);
            if (BOTH(pb + 1)) GRID_BAR();
        }
        if (EN_M2 && IN(pb + 2)) { PHASE_BEGIN();
            for (int it = gw; it < NROWS * 8; it += NGW) attn_item(F, args, l, it >> 3, it & 7, wscr);
            for (int it = gw; it < NROWS * 4; it += NGW) pool_item(F, args, l, it >> 2, it & 3, wscr);
            for (int r = gw; r < NROWS; r += NGW) gate_row(F, args, l, r);
            cache_outputs(F, args, l);
            if (BOTH(pb + 2)) GRID_BAR();
        }
        if (EN_M3 && IN(pb + 3)) { PHASE_BEGIN();
            if (F.wave < 4) {
                for (int it = F.vcu * 4 + F.wave; it < 1024; it += F.G * 4) { const int b = it >> 8, hh = (it >> 6) & 3, sl = it & 63;
                    gla_seq_item(F, b * 2048, 2048, hh, sl * 4, nullptr, F.out + O_GLA_P + ((size_t)((l * 4 + b) * 4 + hh)) * 32768); }
            } else {
                for (int it = F.vcu * 4 + (F.wave - 4); it < 8192; it += F.G * 4) { const int sb = it >> 8, hh = (it >> 6) & 3, sl = it & 63; const size_t so = ((size_t)((l * 32 + sb) * 4 + hh)) * 32768;
                    gla_seq_item(F, NP_ROWS + sb * 4, 4, hh, sl * 4, args.in[F.zo + I_SGLA] + so, F.out + O_GLA_S + so); }
            }
            if (BOTH(pb + 3)) GRID_BAR();
        }
        if (EN_M4 && IN(pb + 4)) { PHASE_BEGIN(); for (int it = gw; it < NROWS * 4; it += NGW) gla_out_item(F, args, l, it >> 2, it & 3); if (BOTH(pb + 4)) GRID_BAR(); }
        if (EN_G && EN_GOUT && IN(pb + 5)) { PHASE_BEGIN();
            pg8::Gemm g{F.MIX(), F.Wout_t() + (size_t)l * DM * DM, MPAD, DM, DM}; pg8::StaticOrder S; S.init(MPAD, DM, F.G, (int)blockIdx.x);
            pg8::EpiResid E{F.X(), modl + 4096};
            pg8::gemm_phase<pg8::EpiResid, pg8::StaticOrder, true, true>(F.lds + RING_OFF, g, S, E, F.wave);
            if (BOTH(pb + 5)) GRID_BAR();
        }
        if (EN_N && IN(pb + 6)) { PHASE_BEGIN(); norm_mod_rows(F, args.in[F.zo + I_GFFN] + l * DM, modl + 6144); if (BOTH(pb + 6)) GRID_BAR(); }
        if (EN_G && EN_GGU && IN(pb + 7)) { PHASE_BEGIN();
            pg8::Gemm g{F.H(), F.Wgu_t() + (size_t)l * NGU * DM, MPAD, NGU, DM}; pg8::StaticOrder S; S.init(MPAD, NGU, F.G, (int)blockIdx.x);
            pg8::EpiSwiGLU E{F.ACT(), DFF};
            pg8::gemm_phase<pg8::EpiSwiGLU, pg8::StaticOrder, true, true>(F.lds + RING_OFF, g, S, E, F.wave);
            if (BOTH(pb + 7)) GRID_BAR();
        }
        if (EN_G && EN_GDN && IN(pb + 8)) { PHASE_BEGIN();
            pg8::Gemm g{F.ACT(), F.Wdn_t() + (size_t)l * DM * DFF, MPAD, DM, DFF}; pg8::StaticOrder S; S.init(MPAD, DM, F.G, (int)blockIdx.x);
            pg8::EpiResid E{F.X(), modl + 10240};
            pg8::gemm_phase<pg8::EpiResid, pg8::StaticOrder, true, true>(F.lds + RING_OFF, g, S, E, F.wave);
            if (BOTH(pb + 8)) GRID_BAR();
        }
    }
    if (IN(PH_FINAL)) { PHASE_BEGIN(); final_norm_rows(F, args); }
#undef IN
#undef BOTH
#undef gw
#undef NGW
#undef wscr
}

extern "C" void kernel_launch(void* const* d_in, const int* in_sizes, int n_in, void* d_out, int out_size, void* d_ws, size_t ws_size, hipStream_t stream) {
    static int grid = 0;
    if (grid == 0) {
        if (n_in != 24 || out_size != (int)O_END || ws_size < WS_END) { fprintf(stderr, "kernel_launch: unexpected sizes n_in %d out %d ws %zu\n", n_in, out_size, ws_size); grid = -1; return; }
        int dev = 0, cus = 0;
        if (hipGetDevice(&dev) != hipSuccess || hipDeviceGetAttribute(&cus, hipDeviceAttributeMultiprocessorCount, dev) != hipSuccess) { grid = -1; return; }
        if (hipFuncSetAttribute((const void*)hymba_fwd, hipFuncAttributeMaxDynamicSharedMemorySize, LDS_BYTES) != hipSuccess) { fprintf(stderr, "kernel_launch: hipFuncSetAttribute failed\n"); grid = -1; return; }
        (void)hipGetLastError();
        grid = cus;
    }
    if (grid < 0) return;
    (void)hipMemsetAsync((char*)d_ws + WS_CTL, 0, CTL_ZERO_BYTES, stream);
    Args a{};
    for (int i = 0; i < 24; ++i) a.in[i] = (const float*)d_in[i];
    a.out = (float*)d_out; a.ws = (unsigned char*)d_ws;
#if MK_SINGLE
    a.ph_lo = 0; a.ph_hi = PH_COUNT;
    hipLaunchKernelGGL(hymba_fwd, dim3(grid), dim3(NTHREADS), LDS_BYTES, stream, a);
#else
    for (int p = 0; p < PH_COUNT; ++p) { a.ph_lo = p; a.ph_hi = p + 1; hipLaunchKernelGGL(hymba_fwd, dim3(grid), dim3(NTHREADS), LDS_BYTES, stream, a); }
#endif
}
```

```cpp
#include <hip/hip_runtime.h>
#include <cstdio>
#include <cstdint>
#include <cmath>
namespace pg8 {
#define PG8_LAS __attribute__((address_space(3)))
typedef unsigned short bf16_t;
typedef short bf16x8 __attribute__((ext_vector_type(8)));
typedef float f32x4 __attribute__((ext_vector_type(4)));
typedef unsigned u32x4 __attribute__((ext_vector_type(4)));
constexpr int BM = 256, BK = 64, HALF = 128, HTB = HALF * BK * 2  , STAGE_BYTES = 8 * HTB, NXCD = 8, WGM = 8;

__host__ __device__ __forceinline__ int lds_byte(int r, int c) { const int st = (r >> 4) * 2 + (c >> 5), rr = r & 15, cc = c & 31, ob = rr * 64 + cc * 2; return st * 1024 + (ob ^ (((ob >> 9) & 1) << 5)); }
__host__ __device__ __forceinline__ void stage_rc(int b, int& R, int& C) { const int st = b / 1024, sb = b % 1024, swz = sb ^ (((sb >> 9) & 1) << 5); R = (st >> 1) * 16 + swz / 64; C = (st & 1) * 32 + (swz % 64) / 2; }
__host__ __device__ __forceinline__ int perm32(int rho) { const int n = rho >> 4, i = rho & 15; return 8 * (i >> 2) + 4 * n + (i & 3); }

struct Unit { int pm, pn; };
struct Gemm { const bf16_t* A; const bf16_t* Bt; int M, N, K; };

struct StaticOrder {
    int nM, nN, nwg, G, c;
    __host__ __device__ void init(int M, int N, int G_, int c_) { nM = M / BM; nN = N / BM; nwg = nM * nN; G = G_; c = c_; }
    __host__ __device__ bool next(int i, Unit& u) const {
        const long L = (long)i * G + c; if (L >= nwg) return false;
        int wgid = (int)L; { const int q = nwg / NXCD, r = nwg % NXCD, xcd = wgid % NXCD, off = wgid / NXCD; wgid = (xcd < r ? xcd * (q + 1) : r * (q + 1) + (xcd - r) * q) + off; }
        const int nig = WGM * nN, gid = wgid / nig, fm = gid * WGM, gsz = (nM - fm) < WGM ? (nM - fm) : WGM;
        u.pm = fm + ((wgid % nig) % gsz); u.pn = (wgid % nig) / gsz; return true;
    }
    __device__ __forceinline__ void a_ready(const Unit&) const {}
    __device__ __forceinline__ void done(const Unit&) const {}
};

__device__ __forceinline__ unsigned cvt_pk_bf16(float lo, float hi) { unsigned r; asm volatile("v_cvt_pk_bf16_f32 %0, %1, %2" : "=v"(r) : "v"(lo), "v"(hi)); return r; }
typedef float f32x2 __attribute__((ext_vector_type(2)));
constexpr int MODLD_ = 49152;
__device__ __forceinline__ float fast_sigmoid(float x) { return __builtin_amdgcn_rcpf(1.0f + __expf(-x)); }
struct EpiZ {
    static constexpr bool PERM = true, AFTER_DRAIN = false;
    bf16_t* O; int ldc;
    __device__ __forceinline__ void operator()(const f32x4 (&acc)[2][2][4][2], const Unit& u, int wr, int wc, int fr, int fq) const {
        const int row0 = u.pm * BM + wr * 64 + fr, col0 = u.pn * BM + wc * 32 + 8 * fq;
#pragma unroll
        for (int ai = 0; ai < 2; ++ai)
#pragma unroll
            for (int m = 0; m < 4; ++m) { bf16_t* rowp = O + (size_t)(row0 + ai * HALF + m * 16) * ldc + col0;
#pragma unroll
                for (int bj = 0; bj < 2; ++bj) { const f32x4 v0 = acc[ai][bj][m][0], v1 = acc[ai][bj][m][1];
                    u32x4 w; w.x = cvt_pk_bf16(v0[0], v0[1]); w.y = cvt_pk_bf16(v0[2], v0[3]); w.z = cvt_pk_bf16(v1[0], v1[1]); w.w = cvt_pk_bf16(v1[2], v1[3]);
                    *(u32x4*)(rowp + bj * HALF) = w; } }
    }
};
struct EpiSwiGLU {
    static constexpr bool PERM = true, AFTER_DRAIN = false;
    bf16_t* O; int ldc;
    __device__ __forceinline__ void operator()(const f32x4 (&acc)[2][2][4][2], const Unit& u, int wr, int wc, int fr, int fq) const {
        const int row0 = u.pm * BM + wr * 64 + fr, col0 = u.pn * HALF + wc * 32 + 8 * fq;
#pragma unroll
        for (int ai = 0; ai < 2; ++ai)
#pragma unroll
            for (int m = 0; m < 4; ++m) { bf16_t* rowp = O + (size_t)(row0 + ai * HALF + m * 16) * ldc + col0;
                float r[8];
#pragma unroll
                for (int n = 0; n < 2; ++n)
#pragma unroll
                    for (int i = 0; i < 4; ++i) { const float g = acc[ai][0][m][n][i], up = acc[ai][1][m][n][i]; r[n * 4 + i] = g * fast_sigmoid(g) * up; }
                u32x4 w; w.x = cvt_pk_bf16(r[0], r[1]); w.y = cvt_pk_bf16(r[2], r[3]); w.z = cvt_pk_bf16(r[4], r[5]); w.w = cvt_pk_bf16(r[6], r[7]);
                *(u32x4*)rowp = w; }
    }
};
struct EpiResid {
    static constexpr bool PERM = false, AFTER_DRAIN = false;
    float* X; const float* gate;
    __device__ __forceinline__ void operator()(const f32x4 (&acc)[2][2][4][2], const Unit& u, int wr, int wc, int fr, int fq) const {
        const int col0 = u.pn * BM + wc * 32 + 4 * fq;
        if (u.pm < 32) {
            const float* g = gate + (size_t)(u.pm >> 3) * MODLD_ + col0;
            f32x4 gv[2][2];
#pragma unroll
            for (int bj = 0; bj < 2; ++bj)
#pragma unroll
                for (int n = 0; n < 2; ++n) gv[bj][n] = *(const f32x4*)(g + bj * HALF + n * 16);
#pragma unroll
            for (int ai = 0; ai < 2; ++ai)
#pragma unroll
                for (int m = 0; m < 4; ++m) { float* xp = X + (size_t)(u.pm * BM + ai * HALF + wr * 64 + m * 16 + fr) * 2048 + col0;
#pragma unroll
                    for (int bj = 0; bj < 2; ++bj)
#pragma unroll
                        for (int n = 0; n < 2; ++n) { f32x4 xv = *(const f32x4*)(xp + bj * HALF + n * 16); xv = xv + gv[bj][n] * acc[ai][bj][m][n]; *(f32x4*)(xp + bj * HALF + n * 16) = xv; } }
        } else {
#pragma unroll
            for (int m = 0; m < 4; ++m) { const int rl = wr * 64 + m * 16 + fr;
                const float* g = gate + (size_t)(4 + (rl >> 2)) * MODLD_ + col0; float* xp = X + (size_t)(8192 + rl) * 2048 + col0;
#pragma unroll
                for (int bj = 0; bj < 2; ++bj)
#pragma unroll
                    for (int n = 0; n < 2; ++n) { const f32x4 gvv = *(const f32x4*)(g + bj * HALF + n * 16); f32x4 xv = *(const f32x4*)(xp + bj * HALF + n * 16);
                        xv = xv + gvv * acc[0][bj][m][n]; *(f32x4*)(xp + bj * HALF + n * 16) = xv; } }
        }
    }
};
struct EpiMod {
    static constexpr bool PERM = false, AFTER_DRAIN = false;
    float* M; const float* bias;
    __device__ __forceinline__ void operator()(const f32x4 (&acc)[2][2][4][2], const Unit& u, int wr, int wc, int fr, int fq) const {
        if (wr != 0) return;
        const int col0 = u.pn * BM + wc * 32 + 4 * fq;
#pragma unroll
        for (int m = 0; m < 3; ++m) { const int r = m * 16 + fr;
            if (r < 36) {
#pragma unroll
                for (int bj = 0; bj < 2; ++bj)
#pragma unroll
                    for (int n = 0; n < 2; ++n) { const f32x4 bv = *(const f32x4*)(bias + col0 + bj * HALF + n * 16);
                        *(f32x4*)(M + (size_t)r * MODLD_ + col0 + bj * HALF + n * 16) = acc[0][bj][m][n] + bv; } } }
    }
};

template <class Epi, class Sched, bool ALIGN_EPI = false, bool SP2 = false>
__device__ __forceinline__ void gemm_phase(PG8_LAS unsigned char* lds, const Gemm g, const Sched& S, const Epi& E, int wid_in) {
    int lane_ = (int)__builtin_amdgcn_mbcnt_hi(~0u, __builtin_amdgcn_mbcnt_lo(~0u, 0u)); asm volatile("" : "+v"(lane_));
    const int wid = __builtin_amdgcn_readfirstlane(wid_in), lane = lane_, tid = wid * 64 + lane, wr = wid >> 2, wc = wid & 3, fr = lane & 15, fq = lane >> 4;
    int K_ = g.K; asm volatile("" : "+s"(K_));
    const int K = K_, nt = K / BK;
    unsigned voffA[2], voffB[2];
#pragma unroll
    for (int i = 0; i < 2; ++i) { int R, C; stage_rc(tid * 16 + i * 8192, R, C); const int Rb = Epi::PERM ? ((R & ~31) + perm32(R & 31)) : R;
        voffA[i] = (unsigned)(R * K + C) * 2u; voffB[i] = (unsigned)(Rb * K + C) * 2u; }
    const size_t kstep = (size_t)(BK * 2);
    const size_t hstep = (size_t)HALF * K * 2;
    const size_t tstep = 2 * hstep;
    const unsigned ldsw = (unsigned)wid * 1024u;
    const int aoff = lds_byte(wr * 64 + fr, fq * 8), boff = lds_byte(wc * 32 + fr, fq * 8);
#define PG8_SA(b, h) (((b) * 2 + (h)) * HTB)
#define PG8_SB(b, h) ((4 + (b) * 2 + (h)) * HTB)
#define PG8_STAGE(bufoff, gbase, voff) do { _Pragma("unroll") for (int _i = 0; _i < 2; ++_i) \
        __builtin_amdgcn_global_load_lds((const unsigned*)((const char*)(gbase) + (voff)[_i]), (PG8_LAS unsigned*)(lds + (bufoff) + ldsw + _i * 8192), 16, 0, 0); } while (0)
#define PG8_LDA(dst, b, h) do { _Pragma("unroll") for (int m = 0; m < 4; ++m) _Pragma("unroll") for (int k = 0; k < 2; ++k) dst[m][k] = *(const PG8_LAS bf16x8*)(lds + PG8_SA(b, h) + aoff + m * 2048 + k * 1024); } while (0)
#define PG8_LDB(dst, b, h) do { _Pragma("unroll") for (int n = 0; n < 2; ++n) _Pragma("unroll") for (int k = 0; k < 2; ++k) dst[n][k] = *(const PG8_LAS bf16x8*)(lds + PG8_SB(b, h) + boff + n * 2048 + k * 1024); } while (0)
#define PG8_MMA(ai, bj, At, Bt) do { __builtin_amdgcn_s_setprio(1); _Pragma("unroll") for (int m = 0; m < 4; ++m) _Pragma("unroll") for (int n = 0; n < 2; ++n) _Pragma("unroll") for (int k = 0; k < 2; ++k) \
        acc[ai][bj][m][n] = __builtin_amdgcn_mfma_f32_16x16x32_bf16(Bt[n][k], At[m][k], acc[ai][bj][m][n], 0, 0, 0); __builtin_amdgcn_s_setprio(0); } while (0)
#define PG8_WAIT_V(n) asm volatile("s_waitcnt vmcnt(" #n ")" ::: "memory")
#define PG8_WAIT_L(n) asm volatile("s_waitcnt lgkmcnt(" #n ")" ::: "memory")
#define PG8_BAR __builtin_amdgcn_s_barrier()
#define PG8_SCHED __builtin_amdgcn_sched_barrier(0)
    Unit cur, nxt; int ui = 0;
    if (!S.next(0, cur)) return;
    f32x4 acc[2][2][4][2];
#pragma unroll
    for (int a = 0; a < 2; ++a)
#pragma unroll
        for (int b = 0; b < 2; ++b)
#pragma unroll
            for (int m = 0; m < 4; ++m)
#pragma unroll
                for (int n = 0; n < 2; ++n) acc[a][b][m][n] = (f32x4){0.f, 0.f, 0.f, 0.f};
    bf16x8 At[4][2], B0[2][2], B1[2][2];
    const char* cA = (const char*)g.A + (size_t)cur.pm * tstep; const char* cB = (const char*)g.Bt + (size_t)cur.pn * tstep;
    S.a_ready(cur);
    if constexpr (SP2) {
        PG8_STAGE(PG8_SB(0, 0), cB, voffB); PG8_STAGE(PG8_SB(0, 1), cB + hstep, voffB); PG8_STAGE(PG8_SA(0, 0), cA, voffA); PG8_STAGE(PG8_SA(0, 1), cA + hstep, voffA);
        if (wr == 1) PG8_BAR;
        PG8_WAIT_V(2); PG8_BAR;
        PG8_STAGE(PG8_SB(1, 0), cB + kstep, voffB); PG8_STAGE(PG8_SA(1, 0), cA + kstep, voffA); PG8_STAGE(PG8_SB(1, 1), cB + hstep + kstep, voffB);
        PG8_WAIT_V(6); PG8_BAR;
    } else {
        PG8_STAGE(PG8_SB(0, 0), cB, voffB); PG8_STAGE(PG8_SA(0, 0), cA, voffA); PG8_STAGE(PG8_SB(0, 1), cB + hstep, voffB); PG8_STAGE(PG8_SA(0, 1), cA + hstep, voffA);
        if (wr == 1) PG8_BAR;
        PG8_WAIT_V(4); PG8_BAR;
        PG8_STAGE(PG8_SB(1, 0), cB + kstep, voffB); PG8_STAGE(PG8_SA(1, 0), cA + kstep, voffA); PG8_STAGE(PG8_SB(1, 1), cB + hstep + kstep, voffB);
        PG8_WAIT_V(6); PG8_BAR;
    }
    for (;;) {
        const bool has_next = S.next(ui + 1, nxt);
        const char* nA = has_next ? (const char*)g.A + (size_t)nxt.pm * tstep : cA; const char* nB = has_next ? (const char*)g.Bt + (size_t)nxt.pn * tstep : cB;
        for (int t = 0; t < nt; t += 2) {
            const bool last = (t == nt - 2);
            const char* a1 = cA + (size_t)(t + 1) * kstep;
            const char* a2 = last ? nA : cA + (size_t)(t + 2) * kstep; const char* b2 = last ? nB : cB + (size_t)(t + 2) * kstep;
            const char* a3 = a2 + kstep; const char* b3 = b2 + kstep;
            if (last && has_next) S.a_ready(nxt);
            if constexpr (SP2) {
            PG8_LDB(B0, 0, 0); PG8_LDB(B1, 0, 1); PG8_SCHED; PG8_LDA(At, 0, 0); PG8_STAGE(PG8_SA(1, 1), a1 + hstep, voffA);
            PG8_WAIT_V(8); PG8_WAIT_L(0); PG8_BAR; PG8_MMA(0, 0, At, B0); PG8_MMA(0, 1, At, B1); PG8_BAR; PG8_SCHED;
            PG8_LDA(At, 0, 1); PG8_STAGE(PG8_SB(0, 0), b2, voffB); PG8_STAGE(PG8_SB(0, 1), b2 + hstep, voffB); PG8_STAGE(PG8_SA(0, 0), a2, voffA);
            PG8_WAIT_V(8); PG8_WAIT_L(0); PG8_BAR; PG8_MMA(1, 0, At, B0); PG8_MMA(1, 1, At, B1); PG8_BAR; PG8_SCHED;
            PG8_LDB(B0, 1, 0); PG8_LDB(B1, 1, 1); PG8_SCHED; PG8_LDA(At, 1, 0); PG8_STAGE(PG8_SA(0, 1), a2 + hstep, voffA);
            PG8_WAIT_V(8); PG8_WAIT_L(0); PG8_BAR; PG8_MMA(0, 0, At, B0); PG8_MMA(0, 1, At, B1); PG8_BAR; PG8_SCHED;
            PG8_LDA(At, 1, 1); PG8_STAGE(PG8_SB(1, 0), b3, voffB); PG8_STAGE(PG8_SB(1, 1), b3 + hstep, voffB); PG8_STAGE(PG8_SA(1, 0), a3, voffA);
            PG8_WAIT_V(8); PG8_WAIT_L(0); PG8_BAR; PG8_MMA(1, 0, At, B0); PG8_MMA(1, 1, At, B1); PG8_BAR; PG8_SCHED;
            } else {
            PG8_LDB(B0, 0, 0); PG8_SCHED; PG8_LDA(At, 0, 0); PG8_STAGE(PG8_SA(1, 1), a1 + hstep, voffA);
            PG8_WAIT_L(8); PG8_BAR; PG8_WAIT_L(0); PG8_MMA(0, 0, At, B0); PG8_BAR; PG8_SCHED;
            PG8_LDB(B1, 0, 1); PG8_STAGE(PG8_SB(0, 0), b2, voffB);
            PG8_BAR; PG8_WAIT_L(0); PG8_MMA(0, 1, At, B1); PG8_BAR;
            PG8_LDA(At, 0, 1); PG8_STAGE(PG8_SA(0, 0), a2, voffA);
            PG8_BAR; PG8_WAIT_L(0); PG8_MMA(1, 0, At, B0); PG8_BAR; PG8_SCHED;
            PG8_STAGE(PG8_SB(0, 1), b2 + hstep, voffB);
            PG8_WAIT_V(6); PG8_BAR; PG8_MMA(1, 1, At, B1); PG8_BAR;
            PG8_LDB(B0, 1, 0); PG8_SCHED; PG8_LDA(At, 1, 0); PG8_STAGE(PG8_SA(0, 1), a2 + hstep, voffA);
            PG8_WAIT_L(8); PG8_BAR; PG8_WAIT_L(0); PG8_MMA(0, 0, At, B0); PG8_BAR; PG8_SCHED;
            PG8_LDB(B1, 1, 1); PG8_STAGE(PG8_SB(1, 0), b3, voffB);
            PG8_BAR; PG8_WAIT_L(0); PG8_MMA(0, 1, At, B1); PG8_BAR;
            PG8_LDA(At, 1, 1); PG8_STAGE(PG8_SA(1, 0), a3, voffA);
            PG8_BAR; PG8_WAIT_L(0); PG8_MMA(1, 0, At, B0); PG8_BAR; PG8_SCHED;
            PG8_STAGE(PG8_SB(1, 1), b3 + hstep, voffB);
            PG8_WAIT_V(6); PG8_BAR; PG8_MMA(1, 1, At, B1); PG8_BAR;
            }
        }
        if constexpr (ALIGN_EPI) { if (wr == 0) PG8_BAR; }
        if constexpr (!Epi::AFTER_DRAIN) { E(acc, cur, wr, wc, fr, fq); S.done(cur); }
        if (!has_next) break;
#pragma unroll
        for (int a = 0; a < 2; ++a)
#pragma unroll
            for (int b = 0; b < 2; ++b)
#pragma unroll
                for (int m = 0; m < 4; ++m)
#pragma unroll
                    for (int n = 0; n < 2; ++n) acc[a][b][m][n] = (f32x4){0.f, 0.f, 0.f, 0.f};
        cur = nxt; cA = nA; cB = nB; ++ui;
        if constexpr (ALIGN_EPI) { if (wr == 1) PG8_BAR; }
    }
    PG8_WAIT_V(0);
    if constexpr (!ALIGN_EPI) { if (wr == 0) PG8_BAR; }
    PG8_BAR;
    if constexpr (Epi::AFTER_DRAIN) { E.fused(acc, cur, wr, wc, fr, fq, lds, wid, lane); S.done(cur); }
#undef PG8_SA
#undef PG8_SB
#undef PG8_STAGE
#undef PG8_LDA
#undef PG8_LDB
#undef PG8_MMA
#undef PG8_WAIT_V
#undef PG8_WAIT_L
#undef PG8_BAR
#undef PG8_SCHED
}
}
#define GAS __attribute__((address_space(1)))
#define LAS __attribute__((address_space(3)))
typedef unsigned short bf16;
typedef unsigned v4u __attribute__((ext_vector_type(4)));
typedef float f32x4 __attribute__((ext_vector_type(4)));
typedef short bf16x8 __attribute__((ext_vector_type(8)));
typedef GAS unsigned gu32;
typedef GAS unsigned long long gu64;
#define RLX_AGENT __ATOMIC_RELAXED, __HIP_MEMORY_SCOPE_AGENT
#define LDS_WAIT() asm volatile("s_waitcnt lgkmcnt(0)" ::: "memory")
#define VM_WAIT() asm volatile("s_waitcnt vmcnt(0)" ::: "memory")
__device__ __forceinline__ unsigned long long rt() { return __builtin_amdgcn_s_memrealtime(); }
__device__ __forceinline__ unsigned f2bf(float f) { unsigned u = __builtin_bit_cast(unsigned, f); return (u + 0x7fffu + ((u >> 16) & 1u)) >> 16; }
__device__ __forceinline__ unsigned pk2(float lo, float hi) { return f2bf(lo) | (f2bf(hi) << 16); }

#define XB_TMO      128
#define XB_XCNT(j)  (256  + 64 * (j))
#define XB_XSUB(j)  (1280 + 64 * (j))
#define XB_XGEN(j)  (2304 + 64 * (j))
#define XB_TOP      3328
#define XB_TOPGEN   3392
#define XCD_BAR_WORDS 3456
#define XB_SPIN_CAP (1u << 18)

__device__ __forceinline__ unsigned xb_ld(unsigned* p)              { return __hip_atomic_load(p, __ATOMIC_RELAXED, __HIP_MEMORY_SCOPE_AGENT); }
__device__ __forceinline__ unsigned xb_add(unsigned* p, unsigned v) { return __hip_atomic_fetch_add(p, v, __ATOMIC_RELAXED, __HIP_MEMORY_SCOPE_AGENT); }
__device__ __forceinline__ unsigned xb_xcc_id() { return (unsigned)__builtin_amdgcn_s_getreg((3 << 11) | 20) & 0xFu; }
#define XB_SPIN(cond, bar) do { unsigned _sp = 0; while (cond) { __builtin_amdgcn_s_sleep(1); \
    if ((++_sp & 255u) == 0u) { if (xb_ld(&(bar)[XB_TMO])) break; if (_sp > XB_SPIN_CAP) { atomicAdd(&(bar)[XB_TMO], 1u); break; } } } } while (0)

struct XcdBarrier {
    unsigned* bar; unsigned x;
    volatile LAS unsigned* st;
};

__device__ __forceinline__ XcdBarrier xcd_barrier_post(unsigned* bar, volatile LAS unsigned* st) {
    XcdBarrier b; b.bar = bar; b.x = xb_xcc_id(); b.st = st;
    if (threadIdx.x == 0) (void)xb_add(&bar[XB_XCNT(b.x)], 1u);
    return b;
}
__device__ __forceinline__ void xcd_barrier_complete(unsigned* bar, unsigned x, unsigned& nloc, unsigned& nx) {
    const unsigned G = gridDim.x * gridDim.y * gridDim.z;
    unsigned sum, cnt, mine, sp = 0u;
    for (;;) {
        sum = 0u; cnt = 0u; mine = 0u;
#pragma unroll
        for (unsigned j = 0; j < 16; ++j) { const unsigned c = xb_ld(&bar[XB_XCNT(j)]); sum += c; cnt += (c > 0u) ? 1u : 0u; mine = (j == x) ? c : mine; }
        if (sum == G) break;
        __builtin_amdgcn_s_sleep(1);
        if ((++sp & 255u) == 0u) { if (xb_ld(&bar[XB_TMO])) break; if (sp > XB_SPIN_CAP) { atomicAdd(&bar[XB_TMO], 1u); break; } }
    }
    nloc = mine > 0u ? mine : 1u; nx = cnt > 0u ? cnt : 1u;
}

__device__ __forceinline__ void xcd_barrier(const XcdBarrier& b) {
    asm volatile("s_waitcnt vmcnt(0)" ::: "memory");
    __syncthreads();
    if (threadIdx.x == 0) {
        unsigned* bar = b.bar;
        __builtin_amdgcn_s_waitcnt(0);
        unsigned nloc = b.st[0], nx = b.st[1];
        if (nloc == 0u) { xcd_barrier_complete(bar, b.x, nloc, nx); b.st[0] = nloc; b.st[1] = nx; }
        const unsigned old = xb_add(&bar[XB_XSUB(b.x)], 1u);
        const unsigned gen = old / nloc;
        if (old + 1u == (gen + 1u) * nloc) {
            __builtin_amdgcn_fence(__ATOMIC_RELEASE, "agent");
            asm volatile("s_waitcnt vmcnt(0)" ::: "memory");
            const unsigned og = xb_add(&bar[XB_TOP], 1u);
            const unsigned tg = og / nx;
            if (og + 1u == (tg + 1u) * nx) xb_add(&bar[XB_TOPGEN], 1u);
            else XB_SPIN(xb_ld(&bar[XB_TOPGEN]) == tg, bar);
            __builtin_amdgcn_fence(__ATOMIC_ACQUIRE, "agent");
            xb_add(&bar[XB_XGEN(b.x)], 1u);
            asm volatile("s_waitcnt vmcnt(0)" ::: "memory");
        } else {
            XB_SPIN(xb_ld(&bar[XB_XGEN(b.x)]) == gen, bar);
            __builtin_amdgcn_fence(__ATOMIC_ACQUIRE, "agent");
            asm volatile("s_waitcnt vmcnt(0)" ::: "memory");
        }
    }
    __syncthreads();
}

constexpr int NWAVES = 8, NTHREADS = 512;
constexpr int DM = 2048, NP_ROWS = 8192, NS_ROWS = 128, NROWS = 8320, MPAD = 8448;
constexpr int DEPTH = 4, NBATCH = 36;
constexpr int INW = 4368, ZW = 4608;
constexpr int ZQ = 0, ZK = 512, ZV = 640, ZU = 768, GQ = 1280, GK = 1792, GV = 2304, GG = 3328, GA = 4352;
constexpr int DFF = 5632, NGU = 11264, MODW = 12288, MODLD = 49152;
constexpr float EPS = 1e-6f;
constexpr size_t O_Y = 0, O_WK_P = 17039360, O_WV_P = 17301504, O_POOL_P = 17563648, O_GLA_P = 17686528,
                 O_WK_S = 19783680, O_WV_S = 21880832, O_POOL_S = 23977984, O_GLA_S = 24961024, O_END = 41738240;
constexpr size_t MiB = 1u << 20;
constexpr size_t WS_CTL = 0, CTL_ZERO_BYTES = 1 * MiB;
constexpr size_t WS_WADA = 1 * MiB;
constexpr size_t WS_WIN  = WS_WADA + 192 * MiB;
constexpr size_t WS_WOUT = WS_WIN + 72 * MiB;
constexpr size_t WS_WGU  = WS_WOUT + 32 * MiB;
constexpr size_t WS_WDN  = WS_WGU + 176 * MiB;
constexpr size_t WS_X    = WS_WDN + 88 * MiB;
constexpr size_t WS_H    = WS_X + 66 * MiB;
constexpr size_t WS_Z    = WS_H + 33 * MiB;
constexpr size_t WS_MIX  = WS_Z + 75 * MiB;
constexpr size_t WS_ACT  = WS_MIX + 33 * MiB;
constexpr size_t WS_OGLA = WS_ACT + 91 * MiB;
constexpr size_t WS_LA   = WS_OGLA + 33 * MiB;
constexpr size_t WS_MOD  = WS_LA + 17 * MiB;
constexpr size_t WS_SC   = WS_MOD + 7 * MiB;
constexpr size_t WS_BTAB = WS_SC + 1 * MiB;
constexpr size_t WS_END  = WS_BTAB + 1 * MiB;
constexpr int CW_BAR = 4096;
constexpr int RING_OFF = 0, RING_BYTES = 131072;
constexpr int LDSCTL_OFF = RING_BYTES, MISC_OFF = LDSCTL_OFF + 320;
constexpr int LDS_BYTES = 147456;

struct Args { const float* in[24]; float* out; unsigned char* ws; int ph_lo, ph_hi; };
struct Frame {
    LAS unsigned char* lds;
    volatile LAS unsigned* MISC;
    int wave, vcu, G; int zo;
    __device__ __forceinline__ int lane_id() const { return (int)__builtin_amdgcn_mbcnt_hi(~0u, __builtin_amdgcn_mbcnt_lo(~0u, 0u)); }
    unsigned char* ws; float* out;
    __device__ __forceinline__ bf16* Wada_t() const { return (bf16*)(ws + WS_WADA); }
    __device__ __forceinline__ bf16* Win_t() const { return (bf16*)(ws + WS_WIN); }
    __device__ __forceinline__ bf16* Wout_t() const { return (bf16*)(ws + WS_WOUT); }
    __device__ __forceinline__ bf16* Wgu_t() const { return (bf16*)(ws + WS_WGU); }
    __device__ __forceinline__ bf16* Wdn_t() const { return (bf16*)(ws + WS_WDN); }
    __device__ __forceinline__ float* X() const { return (float*)(ws + WS_X); }
    __device__ __forceinline__ bf16* H() const { return (bf16*)(ws + WS_H); }
    __device__ __forceinline__ bf16* Z() const { return (bf16*)(ws + WS_Z); }
    __device__ __forceinline__ bf16* MIX() const { return (bf16*)(ws + WS_MIX); }
    __device__ __forceinline__ bf16* ACT() const { return (bf16*)(ws + WS_ACT); }
    __device__ __forceinline__ float* OGLA() const { return (float*)(ws + WS_OGLA); }
    __device__ __forceinline__ float* LA() const { return (float*)(ws + WS_LA); }
    __device__ __forceinline__ float* MOD() const { return (float*)(ws + WS_MOD); }
    __device__ __forceinline__ bf16* SC() const { return (bf16*)(ws + WS_SC); }
    __device__ __forceinline__ float* BTAB() const { return (float*)(ws + WS_BTAB); }
};
enum { I_XP = 0, I_XS, I_CK, I_CV, I_SPOOL, I_SGLA, I_CP, I_CS, I_WADA, I_BADA, I_GMIX, I_GFFN, I_WIN, I_WOUT, I_RELB, I_SINKS, I_WPOOL, I_PSCALE, I_WA2, I_BA2, I_GGLA, I_WGU, I_WDN, I_GFIN };

__device__ __forceinline__ float bf2f(unsigned short b) { return __uint_as_float((unsigned)b << 16); }
__device__ __forceinline__ float bflo(unsigned w) { return __uint_as_float(w << 16); }
__device__ __forceinline__ float bfhi(unsigned w) { return __uint_as_float(w & 0xffff0000u); }
__device__ __forceinline__ float wave_sum(float v) {
#pragma unroll
    for (int o = 1; o < 64; o <<= 1) v += __shfl_xor(v, o);
    return v;
}
__device__ __forceinline__ float wave_max(float v) {
#pragma unroll
    for (int o = 1; o < 64; o <<= 1) v = fmaxf(v, __shfl_xor(v, o));
    return v;
}
__device__ __forceinline__ int t5_bucket(int n) {
    if (n < 16) return n;
    return 16 + (n >= 19) + (n >= 21) + (n >= 24) + (n >= 27) + (n >= 31) + (n >= 35) + (n >= 40) + (n >= 46) + (n >= 52) + (n >= 59) + (n >= 67) + (n >= 77) + (n >= 87) + (n >= 99) + (n >= 113);
}

template <int MODE>
__device__ __forceinline__ void transpose_item(const float* W, int K, int N, int nblk, bf16* WT, int row_off, LAS float* scr, int item, int lane) {
    const int kb = item / nblk, nb = item % nblk, k0 = 64 * kb, n0 = 32 * nb;
    const int nn = n0 + (lane & 31); const bool ok = nn < N;
#pragma unroll 8
    for (int i = 0; i < 32; ++i) { const int kk = 2 * i + (lane >> 5); scr[kk * 33 + (lane & 31)] = ok ? W[(size_t)(k0 + kk) * N + nn] : 0.f; }
    LDS_WAIT(); asm volatile("" ::: "memory");
    const int c = lane & 7;
#pragma unroll
    for (int j = 0; j < 4; ++j) { const int n = (lane >> 3) + 8 * j; const LAS float* s = scr + (8 * c) * 33 + n;
        v4u o; o.x = pk2(s[0 * 33], s[1 * 33]); o.y = pk2(s[2 * 33], s[3 * 33]); o.z = pk2(s[4 * 33], s[5 * 33]); o.w = pk2(s[6 * 33], s[7 * 33]);
        int orow = n0 + n;
        if (MODE == 1) { orow = (orow < DFF) ? ((orow >> 7) * 256 + (orow & 127)) : (((orow - DFF) >> 7) * 256 + 128 + ((orow - DFF) & 127)); }
        *(GAS v4u*)(WT + (size_t)(row_off + orow) * K + k0 + 8 * c) = o; }
    LDS_WAIT(); asm volatile("" ::: "memory");
}
__device__ __forceinline__ void p0_prologue(Frame& F, const Args& A) {
    LAS float* scr = (LAS float*)(F.lds + RING_OFF + F.wave * 16384);
    const int gw = F.vcu * NWAVES + F.wave, NGW = F.G * NWAVES;
    const int gt = gw * 64 + F.lane_id(), NGT = NGW * 64;
    constexpr int I_ADA = 32 * 384, I_IN = 32 * 137, I_OUT = 32 * 64, I_GU = 32 * 352, I_DN = 88 * 64, I_L = I_ADA + I_IN + I_OUT + I_GU + I_DN;
    for (int it = gw; it < DEPTH * I_L; it += NGW) {
        const int l = it / I_L; int r = it - l * I_L;
        if (r < I_ADA) { transpose_item<0>(A.in[F.zo + I_WADA] + (size_t)l * DM * MODW, DM, MODW, 384, F.Wada_t(), l * MODW, scr, r, F.lane_id()); continue; } r -= I_ADA;
        if (r < I_IN)  { transpose_item<0>(A.in[F.zo + I_WIN] + (size_t)l * DM * INW, DM, INW, 137, F.Win_t() + (size_t)l * ZW * DM, 0, scr, r, F.lane_id()); continue; } r -= I_IN;
        if (r < I_OUT) { transpose_item<0>(A.in[F.zo + I_WOUT] + (size_t)l * DM * DM, DM, DM, 64, F.Wout_t() + (size_t)l * DM * DM, 0, scr, r, F.lane_id()); continue; } r -= I_OUT;
        if (r < I_GU)  { transpose_item<1>(A.in[F.zo + I_WGU] + (size_t)l * DM * NGU, DM, NGU, 352, F.Wgu_t() + (size_t)l * NGU * DM, 0, scr, r, F.lane_id()); continue; } r -= I_GU;
        transpose_item<0>(A.in[F.zo + I_WDN] + (size_t)l * DFF * DM, DFF, DM, 64, F.Wdn_t() + (size_t)l * DM * DFF, 0, scr, r, F.lane_id());
    }
    const v4u z4 = {0u, 0u, 0u, 0u};
    for (int i = gt; i < DEPTH * 224 * 256; i += NGT) { const int l = i / (224 * 256), r = i - l * (224 * 256); *((GAS v4u*)(F.Win_t() + ((size_t)l * ZW + 4384) * DM) + r) = z4; }
    for (int i = gt; i < 128 * 256; i += NGT) { *((GAS v4u*)(F.H() + (size_t)NROWS * DM) + i) = z4; *((GAS v4u*)(F.MIX() + (size_t)NROWS * DM) + i) = z4; }
    for (int i = gt; i < 128 * 704; i += NGT) *((GAS v4u*)(F.ACT() + (size_t)NROWS * DFF) + i) = z4;
    for (int i = gt; i < NP_ROWS * 512; i += NGT) ((GAS f32x4*)F.X())[i] = ((const GAS f32x4*)A.in[F.zo + I_XP])[i];
    for (int i = gt; i < NS_ROWS * 512; i += NGT) ((GAS f32x4*)(F.X() + (size_t)NP_ROWS * DM))[i] = ((const GAS f32x4*)A.in[F.zo + I_XS])[i];
    for (int i = gt; i < 256 * 1024; i += NGT) { const int r = i >> 10, cp = (i & 1023) * 2; unsigned w = 0u;
        if (r < NBATCH) { const float* c = (r < 4) ? (A.in[F.zo + I_CP] + (size_t)r * DM) : (A.in[F.zo + I_CS] + (size_t)(r - 4) * DM); const float a = c[cp], b = c[cp + 1];
            w = pk2(a / (1.0f + __expf(-a)), b / (1.0f + __expf(-b))); }
        ((GAS unsigned*)F.SC())[i] = w; }
    for (int i = gt; i < 8 * 128; i += NGT) { const int h = i >> 7, dist = i & 127; F.BTAB()[i] = A.in[F.zo + I_RELB][t5_bucket(dist) * 8 + h]; }
}

__device__ __forceinline__ void norm_mod_rows(Frame& F, const float* g, const float* modl  ) {
    const int gw = F.vcu * NWAVES + F.wave, NGW = F.G * NWAVES;
    for (int r = gw; r < NROWS; r += NGW) {
        const int b = r < NP_ROWS ? (r >> 11) : 4 + ((r - NP_ROWS) >> 2);
        const float* xr = F.X() + (size_t)r * DM + 4 * F.lane_id(); const float* sh = modl + (size_t)b * MODLD + 4 * F.lane_id(); const float* gg = g + 4 * F.lane_id();
        f32x4 v[8]; float ss = 0.f;
#pragma unroll
        for (int j = 0; j < 8; ++j) { v[j] = *(const f32x4*)(xr + 256 * j); ss += (v[j].x * v[j].x + v[j].y * v[j].y) + (v[j].z * v[j].z + v[j].w * v[j].w); }
        const float rstd = 1.0f / sqrtf(wave_sum(ss) * (1.0f / DM) + EPS);
        bf16* hr = F.H() + (size_t)r * DM + 4 * F.lane_id();
#pragma unroll
        for (int j = 0; j < 8; ++j) { const f32x4 gv = *(const f32x4*)(gg + 256 * j), sv = *(const f32x4*)(sh + 256 * j), cv = *(const f32x4*)(sh + 2048 + 256 * j);
            const f32x4 y = (v[j] * rstd * gv) * (1.0f + cv) + sv;
            uint2 w; w.x = pk2(y.x, y.y); w.y = pk2(y.z, y.w); *(uint2*)(hr + 256 * j) = w; }
    }
}
__device__ __forceinline__ void final_norm_rows(Frame& F, const Args& A) {
    const int gw = F.vcu * NWAVES + F.wave, NGW = F.G * NWAVES; const float* g = A.in[F.zo + I_GFIN] + 4 * F.lane_id();
    for (int r = gw; r < NROWS; r += NGW) {
        const float* xr = F.X() + (size_t)r * DM + 4 * F.lane_id();
        f32x4 v[8]; float ss = 0.f;
#pragma unroll
        for (int j = 0; j < 8; ++j) { v[j] = *(const f32x4*)(xr + 256 * j); ss += (v[j].x * v[j].x + v[j].y * v[j].y) + (v[j].z * v[j].z + v[j].w * v[j].w); }
        const float rstd = 1.0f / sqrtf(wave_sum(ss) * (1.0f / DM) + EPS);
        float* yr = F.out + O_Y + (size_t)r * DM + 4 * F.lane_id();
#pragma unroll
        for (int j = 0; j < 8; ++j) { const f32x4 gv = *(const f32x4*)(g + 256 * j); *(f32x4*)(yr + 256 * j) = v[j] * rstd * gv; }
    }
}

__device__ __forceinline__ void attn_item(Frame& F, const Args& A, int l, int r, int hd, LAS float* ps) {
    const int lane = F.lane_id(), g = hd >> 2; const bool smp = r >= NP_ROWS;
    const int t = r & 2047, sb = smp ? ((r - NP_ROWS) >> 2) : 0, si = (r - NP_ROWS) & 3;
    LAS float* qs = ps + 128;
    { const unsigned w = ((const unsigned*)(F.Z() + (size_t)r * ZW + ZQ + hd * 64))[lane & 31]; if (lane < 32) { qs[2 * lane] = bflo(w); qs[2 * lane + 1] = bfhi(w); } }
    LDS_WAIT(); asm volatile("" ::: "memory");
    const float* ck = A.in[F.zo + I_CK] + ((size_t)(l * 32 + sb) * 128) * 128 + g * 64;
    const float* cv = A.in[F.zo + I_CV] + ((size_t)(l * 32 + sb) * 128) * 128 + g * 64;
    const int jmin = smp ? 0 : (t >= 127 ? 0 : 127 - t);
    float sc[2];
#pragma unroll 1
    for (int jj = 0; jj < 2; ++jj) {
        const int j = lane + 64 * jj, dist = 127 - j; float dot = 0.f; bool valid = j >= jmin;
        if (valid) {
            const int krel = si - dist;
            if (smp && krel < 0) {
                const f32x4* kp = (const f32x4*)(ck + (size_t)(krel + 128) * 128);
#pragma unroll 4
                for (int c = 0; c < 16; ++c) { const f32x4 kv = kp[c]; const f32x4 qv = *(const LAS f32x4*)(qs + 4 * c); dot += qv.x * kv.x + qv.y * kv.y + qv.z * kv.z + qv.w * kv.w; }
            } else {
                const int krow = smp ? (NP_ROWS + sb * 4 + krel) : (r - dist);
                const v4u* kp = (const v4u*)(F.Z() + (size_t)krow * ZW + ZK + g * 64);
#pragma unroll 4
                for (int c = 0; c < 8; ++c) { const v4u w = kp[c];
                    const f32x4 qa = *(const LAS f32x4*)(qs + 8 * c), qb = *(const LAS f32x4*)(qs + 8 * c + 4);
                    dot += qa.x * bflo(w.x) + qa.y * bfhi(w.x) + qa.z * bflo(w.y) + qa.w * bfhi(w.y) + qb.x * bflo(w.z) + qb.y * bfhi(w.z) + qb.z * bflo(w.w) + qb.w * bfhi(w.w); }
            }
        }
        const float sv = valid ? dot * 0.125f + F.BTAB()[hd * 128 + dist] : -INFINITY;
        if (jj == 0) sc[0] = sv; else sc[1] = sv;
    }
    const float sink = A.in[F.zo + I_SINKS][l * 8 + hd];
    const float m = fmaxf(wave_max(fmaxf(sc[0], sc[1])), sink);
    const float p0 = __expf(sc[0] - m), p1 = __expf(sc[1] - m);
    const float denom = wave_sum(p0 + p1) + __expf(sink - m);
    ps[lane] = p0; ps[lane + 64] = p1;
    LDS_WAIT(); asm volatile("" ::: "memory");
    float o = 0.f;
    for (int j = jmin; j < 128; ++j) {
        const float pj = ps[j]; const int dist = 127 - j; float vv;
        const int krel = si - dist;
        if (smp && krel < 0) vv = cv[(size_t)(krel + 128) * 128 + lane];
        else { const int krow = smp ? (NP_ROWS + sb * 4 + krel) : (r - dist); vv = bf2f(F.Z()[(size_t)krow * ZW + ZV + g * 64 + lane]); }
        o += pj * vv;
    }
    F.MIX()[(size_t)r * DM + hd * 64 + lane] = (bf16)f2bf(o / denom);
    LDS_WAIT(); asm volatile("" ::: "memory");
}
__device__ __forceinline__ void pool_item(Frame& F, const Args& A, int l, int r, int gi, LAS float* ds) {
    const int lane = F.lane_id(), w = 2 << gi; const bool smp = r >= NP_ROWS;
    const int t = r & 2047, sb = (r - NP_ROWS) >> 2, si = (r - NP_ROWS) & 3;
    const float* pbuf = A.in[F.zo + I_SPOOL] + ((size_t)(l * 32 + sb) * 15) * 512 + gi * 128;
    float s0 = 0.f, s1 = 0.f, u0 = 0.f, u1 = 0.f;
    for (int o = 0; o < w; ++o) {
        float a0 = 0.f, a1 = 0.f;
        if (!smp) { if (t - o >= 0) { const bf16* zp = F.Z() + (size_t)(r - o) * ZW + ZU + gi * 128; a0 = bf2f(zp[lane]); a1 = bf2f(zp[lane + 64]); } }
        else { const int idx = si - o;
            if (idx >= 0) { const bf16* zp = F.Z() + (size_t)(NP_ROWS + sb * 4 + idx) * ZW + ZU + gi * 128; a0 = bf2f(zp[lane]); a1 = bf2f(zp[lane + 64]); }
            else { const float* bp = pbuf + (size_t)(15 + idx) * 512; a0 = bp[lane]; a1 = bp[lane + 64]; } }
        if (o == 0) { u0 = a0; u1 = a1; }
        s0 += a0; s1 += a1;
    }
    const float cnt = smp ? (float)w : (float)((t + 1) < w ? (t + 1) : w);
    ds[lane] = s0 / cnt - u0; ds[lane + 64] = s1 / cnt - u1;
    LDS_WAIT(); asm volatile("" ::: "memory");
    const float* wp = A.in[F.zo + I_WPOOL] + ((size_t)(l * 4 + gi) * 128) * 128;
    float y0 = 0.f, y1 = 0.f;
#pragma unroll 4
    for (int c = 0; c < 128; ++c) { const float dv = ds[c]; y0 += dv * wp[c * 128 + lane]; y1 += dv * wp[c * 128 + lane + 64]; }
    const float* psc = A.in[F.zo + I_PSCALE] + l * 512 + gi * 128;
    bf16* mp = F.MIX() + (size_t)r * DM + 512 + gi * 128;
    mp[lane] = (bf16)f2bf(y0 * psc[lane]); mp[lane + 64] = (bf16)f2bf(y1 * psc[lane + 64]);
    LDS_WAIT(); asm volatile("" ::: "memory");
}
__device__ __forceinline__ void gate_row(Frame& F, const Args& A, int l, int r) {
    const int lane = F.lane_id();
    float ga[16];
    { const v4u* gp = (const v4u*)(F.Z() + (size_t)r * ZW + GA);
#pragma unroll
      for (int c = 0; c < 2; ++c) { const v4u w = gp[c]; ga[8 * c] = bflo(w.x); ga[8 * c + 1] = bfhi(w.x); ga[8 * c + 2] = bflo(w.y); ga[8 * c + 3] = bfhi(w.y); ga[8 * c + 4] = bflo(w.z); ga[8 * c + 5] = bfhi(w.z); ga[8 * c + 6] = bflo(w.w); ga[8 * c + 7] = bfhi(w.w); } }
    const float* wa = A.in[F.zo + I_WA2] + (size_t)l * 16 * 512; const float* ba = A.in[F.zo + I_BA2] + l * 512;
#pragma unroll 2
    for (int cc = 0; cc < 8; ++cc) { const int c = lane + 64 * cc; float x = ba[c];
#pragma unroll
        for (int j = 0; j < 16; ++j) x += ga[j] * wa[j * 512 + c];
        const float ls = fminf(x, 0.f) - log1pf(__expf(-fabsf(x)));
        F.LA()[(size_t)r * 512 + c] = ls * (1.0f / 16.0f); }
}
__device__ __forceinline__ void cache_outputs(Frame& F, const Args& A, int l) {
    const int gt = (F.vcu * NWAVES + F.wave) * 64 + F.lane_id(), NGT = F.G * NWAVES * 64;
    for (int i = gt; i < 4 * 128 * 128; i += NGT) { const int b = i >> 14, j = (i >> 7) & 127, c = i & 127; const bf16* zr = F.Z() + (size_t)(b * 2048 + 1920 + j) * ZW;
        F.out[O_WK_P + (size_t)l * 65536 + i] = bf2f(zr[ZK + c]); F.out[O_WV_P + (size_t)l * 65536 + i] = bf2f(zr[ZV + c]); }
    for (int i = gt; i < 4 * 15 * 512; i += NGT) { const int b = i / 7680, rem = i - b * 7680, j = rem >> 9, c = rem & 511;
        F.out[O_POOL_P + (size_t)l * 30720 + i] = bf2f(F.Z()[(size_t)(b * 2048 + 2033 + j) * ZW + ZU + c]); }
    for (int i = gt; i < 32 * 128 * 128; i += NGT) { const int sb = i >> 14, p = (i >> 7) & 127, c = i & 127; float kv, vv;
        if (p < 124) { const size_t src = ((size_t)(l * 32 + sb) * 128 + p + 4) * 128 + c; kv = A.in[F.zo + I_CK][src]; vv = A.in[F.zo + I_CV][src]; }
        else { const bf16* zr = F.Z() + (size_t)(NP_ROWS + sb * 4 + p - 124) * ZW; kv = bf2f(zr[ZK + c]); vv = bf2f(zr[ZV + c]); }
        F.out[O_WK_S + (size_t)l * 524288 + i] = kv; F.out[O_WV_S + (size_t)l * 524288 + i] = vv; }
    for (int i = gt; i < 32 * 15 * 512; i += NGT) { const int sb = i / 7680, rem = i - sb * 7680, j = rem >> 9, c = rem & 511; float v;
        if (j < 11) v = A.in[F.zo + I_SPOOL][((size_t)(l * 32 + sb) * 15 + j + 4) * 512 + c];
        else v = bf2f(F.Z()[(size_t)(NP_ROWS + sb * 4 + j - 11) * ZW + ZU + c]);
        F.out[O_POOL_S + (size_t)l * 245760 + i] = v; }
}
struct GlaStepIn { float la0, la1, k0, k1, q0, q1; uint2 v; };
__device__ __forceinline__ GlaStepIn gla_load(Frame& F, int row, int hh, int e0, int lane) {
    GlaStepIn s; const float* lar = F.LA() + (size_t)row * 512 + hh * 128; const bf16* zr = F.Z() + (size_t)row * ZW;
    s.la0 = lar[lane]; s.la1 = lar[lane + 64];
    s.k0 = bf2f(zr[GK + hh * 128 + lane]); s.k1 = bf2f(zr[GK + hh * 128 + lane + 64]);
    s.q0 = bf2f(zr[GQ + hh * 128 + lane]); s.q1 = bf2f(zr[GQ + hh * 128 + lane + 64]);
    s.v = *(const uint2*)(zr + GV + hh * 256 + e0);
    return s;
}
__device__ __forceinline__ void gla_seq_item(Frame& F, int row0, int T, int hh, int e0, const float* S0, float* Sout) {
    const int lane = F.lane_id();
    float s[2][4];
    if (S0) { const f32x4 a = *(const f32x4*)(S0 + (size_t)lane * 256 + e0), b = *(const f32x4*)(S0 + (size_t)(lane + 64) * 256 + e0);
        s[0][0] = a.x; s[0][1] = a.y; s[0][2] = a.z; s[0][3] = a.w; s[1][0] = b.x; s[1][1] = b.y; s[1][2] = b.z; s[1][3] = b.w; }
    else {
#pragma unroll
        for (int j = 0; j < 4; ++j) { s[0][j] = 0.f; s[1][j] = 0.f; } }
    GlaStepIn cur = gla_load(F, row0, hh, e0, lane);
    for (int t = 0; t < T; ++t) {
        GlaStepIn nxt = cur;
        if (t + 1 < T) nxt = gla_load(F, row0 + t + 1, hh, e0, lane);
        const float a0 = __expf(cur.la0), a1 = __expf(cur.la1);
        const float v[4] = {bflo(cur.v.x), bfhi(cur.v.x), bflo(cur.v.y), bfhi(cur.v.y)};
        float p[4];
#pragma unroll
        for (int j = 0; j < 4; ++j) { s[0][j] = a0 * s[0][j] + cur.k0 * v[j]; s[1][j] = a1 * s[1][j] + cur.k1 * v[j]; p[j] = cur.q0 * s[0][j] + cur.q1 * s[1][j]; }
#pragma unroll
        for (int j = 0; j < 4; ++j) p[j] = wave_sum(p[j]);
        if (lane == 0) { const float sc = 0.08838834764831845f; *(f32x4*)(F.OGLA() + (size_t)(row0 + t) * 1024 + hh * 256 + e0) = (f32x4){p[0] * sc, p[1] * sc, p[2] * sc, p[3] * sc}; }
        cur = nxt;
    }
    *(f32x4*)(Sout + (size_t)lane * 256 + e0) = (f32x4){s[0][0], s[0][1], s[0][2], s[0][3]};
    *(f32x4*)(Sout + (size_t)(lane + 64) * 256 + e0) = (f32x4){s[1][0], s[1][1], s[1][2], s[1][3]};
}
__device__ __forceinline__ void gla_out_item(Frame& F, const Args& A, int l, int r, int hh) {
    const int lane = F.lane_id();
    const f32x4 o = *(const f32x4*)(F.OGLA() + (size_t)r * 1024 + hh * 256 + 4 * lane);
    const float ss = wave_sum((o.x * o.x + o.y * o.y) + (o.z * o.z + o.w * o.w));
    const float rstd = 1.0f / sqrtf(ss * (1.0f / 256.0f) + EPS);
    const f32x4 gv = *(const f32x4*)(A.in[F.zo + I_GGLA] + l * 1024 + hh * 256 + 4 * lane);
    const uint2 gw = *(const uint2*)(F.Z() + (size_t)r * ZW + GG + hh * 256 + 4 * lane);
    const float g0 = bflo(gw.x), g1 = bfhi(gw.x), g2 = bflo(gw.y), g3 = bfhi(gw.y);
    const float y0 = o.x * rstd * gv.x * (g0 / (1.0f + __expf(-g0))), y1 = o.y * rstd * gv.y * (g1 / (1.0f + __expf(-g1)));
    const float y2 = o.z * rstd * gv.z * (g2 / (1.0f + __expf(-g2))), y3 = o.w * rstd * gv.w * (g3 / (1.0f + __expf(-g3)));
    uint2 w; w.x = pk2(y0, y1); w.y = pk2(y2, y3);
    *(uint2*)(F.MIX() + (size_t)r * DM + 1024 + hh * 256 + 4 * lane) = w;
}

#ifndef EN_P0
#define EN_P0 1
#endif
#ifndef EN_G
#define EN_G 1
#endif
#ifndef EN_N
#define EN_N 1
#endif
#ifndef EN_M2
#define EN_M2 1
#endif
#ifndef EN_M3
#define EN_M3 1
#endif
#ifndef EN_M4
#define EN_M4 1
#endif
#ifndef EN_G1
#define EN_G1 1
#endif
#ifndef EN_GIN
#define EN_GIN 1
#endif
#ifndef EN_GOUT
#define EN_GOUT 1
#endif
#ifndef EN_GGU
#define EN_GGU 1
#endif
#ifndef EN_GDN
#define EN_GDN 1
#endif
#ifndef MK_SINGLE
#define MK_SINGLE 1
#endif
constexpr int PH_PER_LAYER = 9, PH_LAYER0 = 2, PH_FINAL = PH_LAYER0 + DEPTH * PH_PER_LAYER, PH_COUNT = PH_FINAL + 1;
__global__ void __launch_bounds__(NTHREADS, 2) hymba_fwd(Args args) {
    extern __shared__ __attribute__((aligned(16))) unsigned char lds[];
    Frame F;
    F.lds = (LAS unsigned char*)lds;
    F.MISC = (volatile LAS unsigned*)(F.lds + MISC_OFF);
    F.wave = __builtin_amdgcn_readfirstlane((int)threadIdx.x >> 6); F.zo = 0;
    F.G = gridDim.x; { const int bx = blockIdx.x; F.vcu = (F.G % 8 == 0) ? (bx % 8) * (F.G / 8) + bx / 8 : bx; }
    F.ws = args.ws; F.out = args.out;
    gu32* const ctl = (gu32*)(F.ws + WS_CTL);
    for (int u = threadIdx.x; u < (LDS_BYTES - LDSCTL_OFF) / 4; u += NTHREADS) ((LAS unsigned*)(F.lds + LDSCTL_OFF))[u] = 0u;
    __syncthreads();
#if MK_SINGLE
    XcdBarrier bar = xcd_barrier_post((unsigned*)(ctl + CW_BAR), F.MISC + 8);
#define GRID_BAR() xcd_barrier(bar)
#else
#define GRID_BAR() do { } while (0)
#endif
    const int lo = args.ph_lo, hi = args.ph_hi;
#define IN(k) (lo <= (k) && (k) < hi)
#define BOTH(k) (IN(k) && IN((k) + 1))
#define PHASE_BEGIN() asm volatile("s_mov_b32 %0, 0" : "=s"(F.zo), "+s"(F.G), "+s"(F.vcu), "+s"(F.wave))
#define gw (F.vcu * NWAVES + F.wave)
#define NGW (F.G * NWAVES)
#define wscr ((LAS float*)(F.lds + RING_OFF + F.wave * 16384))

    if (EN_P0 && IN(0)) { PHASE_BEGIN(); p0_prologue(F, args); if (BOTH(0)) GRID_BAR(); }
    if (EN_G && EN_G1 && IN(1)) { PHASE_BEGIN();
        pg8::Gemm g{F.SC(), F.Wada_t(), 256, DEPTH * MODW, DM}; pg8::StaticOrder S; S.init(256, DEPTH * MODW, F.G, (int)blockIdx.x);
        pg8::EpiMod E{F.MOD(), args.in[F.zo + I_BADA]};
        pg8::gemm_phase<pg8::EpiMod, pg8::StaticOrder, true, true>(F.lds + RING_OFF, g, S, E, F.wave);
        if (BOTH(1)) GRID_BAR();
    }
    for (int l = 0; l < DEPTH; ++l) {
        const int pb = PH_LAYER0 + l * PH_PER_LAYER;
        const float* modl = F.MOD() + (size_t)l * MODW;
        if (EN_N && IN(pb + 0)) { PHASE_BEGIN(); norm_mod_rows(F, args.in[F.zo + I_GMIX] + l * DM, modl); if (BOTH(pb + 0)) GRID_BAR(); }
        if (EN_G && EN_GIN && IN(pb + 1)) { PHASE_BEGIN();
            pg8::Gemm g{F.H(), F.Win_t() + (size_t)l * ZW * DM, MPAD, ZW, DM}; pg8::StaticOrder S; S.init(MPAD, ZW, F.G, (int)blockIdx.x);
            pg8::EpiZ E{F.Z(), ZW};
            pg8::gemm_phase<pg8::EpiZ, pg8::StaticOrder, true, true>(F.lds + RING_OFF, g, S, E, F.wave);
            if (BOTH(pb + 1)) GRID_BAR();
        }
        if (EN_M2 && IN(pb + 2)) { PHASE_BEGIN();
            for (int it = gw; it < NROWS * 8; it += NGW) attn_item(F, args, l, it >> 3, it & 7, wscr);
            for (int it = gw; it < NROWS * 4; it += NGW) pool_item(F, args, l, it >> 2, it & 3, wscr);
            for (int r = gw; r < NROWS; r += NGW) gate_row(F, args, l, r);
            cache_outputs(F, args, l);
            if (BOTH(pb + 2)) GRID_BAR();
        }
        if (EN_M3 && IN(pb + 3)) { PHASE_BEGIN();
            if (F.wave < 4) {
                for (int it = F.vcu * 4 + F.wave; it < 1024; it += F.G * 4) { const int b = it >> 8, hh = (it >> 6) & 3, sl = it & 63;
                    gla_seq_item(F, b * 2048, 2048, hh, sl * 4, nullptr, F.out + O_GLA_P + ((size_t)((l * 4 + b) * 4 + hh)) * 32768); }
            } else {
                for (int it = F.vcu * 4 + (F.wave - 4); it < 8192; it += F.G * 4) { const int sb = it >> 8, hh = (it >> 6) & 3, sl = it & 63; const size_t so = ((size_t)((l * 32 + sb) * 4 + hh)) * 32768;
                    gla_seq_item(F, NP_ROWS + sb * 4, 4, hh, sl * 4, args.in[F.zo + I_SGLA] + so, F.out + O_GLA_S + so); }
            }
            if (BOTH(pb + 3)) GRID_BAR();
        }
        if (EN_M4 && IN(pb + 4)) { PHASE_BEGIN(); for (int it = gw; it < NROWS * 4; it += NGW) gla_out_item(F, args, l, it >> 2, it & 3); if (BOTH(pb + 4)) GRID_BAR(); }
        if (EN_G && EN_GOUT && IN(pb + 5)) { PHASE_BEGIN();
            pg8::Gemm g{F.MIX(), F.Wout_t() + (size_t)l * DM * DM, MPAD, DM, DM}; pg8::StaticOrder S; S.init(MPAD, DM, F.G, (int)blockIdx.x);
            pg8::EpiResid E{F.X(), modl + 4096};
            pg8::gemm_phase<pg8::EpiResid, pg8::StaticOrder, true, true>(F.lds + RING_OFF, g, S, E, F.wave);
            if (BOTH(pb + 5)) GRID_BAR();
        }
        if (EN_N && IN(pb + 6)) { PHASE_BEGIN(); norm_mod_rows(F, args.in[F.zo + I_GFFN] + l * DM, modl + 6144); if (BOTH(pb + 6)) GRID_BAR(); }
        if (EN_G && EN_GGU && IN(pb + 7)) { PHASE_BEGIN();
            pg8::Gemm g{F.H(), F.Wgu_t() + (size_t)l * NGU * DM, MPAD, NGU, DM}; pg8::StaticOrder S; S.init(MPAD, NGU, F.G, (int)blockIdx.x);
            pg8::EpiSwiGLU E{F.ACT(), DFF};
            pg8::gemm_phase<pg8::EpiSwiGLU, pg8::StaticOrder, true, true>(F.lds + RING_OFF, g, S, E, F.wave);
            if (BOTH(pb + 7)) GRID_BAR();
        }
        if (EN_G && EN_GDN && IN(pb + 8)) { PHASE_BEGIN();
            pg8::Gemm g{F.ACT(), F.Wdn_t() + (size_t)l * DM * DFF, MPAD, DM, DFF}; pg8::StaticOrder S; S.init(MPAD, DM, F.G, (int)blockIdx.x);
            pg8::EpiResid E{F.X(), modl + 10240};
            pg8::gemm_phase<pg8::EpiResid, pg8::StaticOrder, true, true>(F.lds + RING_OFF, g, S, E, F.wave);
            if (BOTH(pb + 8)) GRID_BAR();
        }
    }
    if (IN(PH_FINAL)) { PHASE_BEGIN(); final_norm_rows(F, args); }
#undef IN
#undef BOTH
#undef gw
#undef NGW
#undef wscr
}

extern "C" void kernel_launch(void* const* d_in, const int* in_sizes, int n_in, void* d_out, int out_size, void* d_ws, size_t ws_size, hipStream_t stream) {
    static int grid = 0;
    if (grid == 0) {
        if (n_in != 24 || out_size != (int)O_END || ws_size < WS_END) { fprintf(stderr, "kernel_launch: unexpected sizes n_in %d out %d ws %zu\n", n_in, out_size, ws_size); grid = -1; return; }
        int dev = 0, cus = 0;
        if (hipGetDevice(&dev) != hipSuccess || hipDeviceGetAttribute(&cus, hipDeviceAttributeMultiprocessorCount, dev) != hipSuccess) { grid = -1; return; }
        if (hipFuncSetAttribute((const void*)hymba_fwd, hipFuncAttributeMaxDynamicSharedMemorySize, LDS_BYTES) != hipSuccess) { fprintf(stderr, "kernel_launch: hipFuncSetAttribute failed\n"); grid = -1; return; }
        (void)hipGetLastError();
        grid = cus;
    }
    if (grid < 0) return;
    (void)hipMemsetAsync((char*)d_ws + WS_CTL, 0, CTL_ZERO_BYTES, stream);
    Args a{};
    for (int i = 0; i < 24; ++i) a.in[i] = (const float*)d_in[i];
    a.out = (float*)d_out; a.ws = (unsigned char*)d_ws;
#if MK_SINGLE
    a.ph_lo = 0; a.ph_hi = PH_COUNT;
    hipLaunchKernelGGL(hymba_fwd, dim3(grid), dim3(NTHREADS), LDS_BYTES, stream, a);
#else
    for (int p = 0; p < PH_COUNT; ++p) { a.ph_lo = p; a.ph_hi = p + 1; hipLaunchKernelGGL(hymba_fwd, dim3(grid), dim3(NTHREADS), LDS_BYTES, stream, a); }
#endif
}
```

```cpp
#include <hip/hip_runtime.h>
#include <cstdio>
#include <cstdint>
#include <cmath>
namespace pg8 {
#define PG8_LAS __attribute__((address_space(3)))
typedef unsigned short bf16_t;
typedef short bf16x8 __attribute__((ext_vector_type(8)));
typedef float f32x4 __attribute__((ext_vector_type(4)));
typedef unsigned u32x4 __attribute__((ext_vector_type(4)));
constexpr int BM = 256, BK = 64, HALF = 128, HTB = HALF * BK * 2  , STAGE_BYTES = 8 * HTB, NXCD = 8, WGM = 8;

__host__ __device__ __forceinline__ int lds_byte(int r, int c) { const int st = (r >> 4) * 2 + (c >> 5), rr = r & 15, cc = c & 31, ob = rr * 64 + cc * 2; return st * 1024 + (ob ^ (((ob >> 9) & 1) << 5)); }
__host__ __device__ __forceinline__ void stage_rc(int b, int& R, int& C) { const int st = b / 1024, sb = b % 1024, swz = sb ^ (((sb >> 9) & 1) << 5); R = (st >> 1) * 16 + swz / 64; C = (st & 1) * 32 + (swz % 64) / 2; }
__host__ __device__ __forceinline__ int perm32(int rho) { const int n = rho >> 4, i = rho & 15; return 8 * (i >> 2) + 4 * n + (i & 3); }

struct Unit { int pm, pn; };
struct Gemm { const bf16_t* A; const bf16_t* Bt; int M, N, K; };

struct StaticOrder {
    int nM, nN, nwg, G, c;
    __host__ __device__ void init(int M, int N, int G_, int c_) { nM = M / BM; nN = N / BM; nwg = nM * nN; G = G_; c = c_; }
    __host__ __device__ bool next(int i, Unit& u) const {
        const long L = (long)i * G + c; if (L >= nwg) return false;
        int wgid = (int)L; { const int q = nwg / NXCD, r = nwg % NXCD, xcd = wgid % NXCD, off = wgid / NXCD; wgid = (xcd < r ? xcd * (q + 1) : r * (q + 1) + (xcd - r) * q) + off; }
        const int nig = WGM * nN, gid = wgid / nig, fm = gid * WGM, gsz = (nM - fm) < WGM ? (nM - fm) : WGM;
        u.pm = fm + ((wgid % nig) % gsz); u.pn = (wgid % nig) / gsz; return true;
    }
    __device__ __forceinline__ void a_ready(const Unit&) const {}
    __device__ __forceinline__ void done(const Unit&) const {}
};

__device__ __forceinline__ unsigned cvt_pk_bf16(float lo, float hi) { unsigned r; asm volatile("v_cvt_pk_bf16_f32 %0, %1, %2" : "=v"(r) : "v"(lo), "v"(hi)); return r; }
typedef float f32x2 __attribute__((ext_vector_type(2)));
constexpr int MODLD_ = 49152;
__device__ __forceinline__ float fast_sigmoid(float x) { return __builtin_amdgcn_rcpf(1.0f + __expf(-x)); }
struct EpiZ {
    static constexpr bool PERM = true, AFTER_DRAIN = false;
    bf16_t* O; int ldc;
    __device__ __forceinline__ void operator()(const f32x4 (&acc)[2][2][4][2], const Unit& u, int wr, int wc, int fr, int fq) const {
        const int row0 = u.pm * BM + wr * 64 + fr, col0 = u.pn * BM + wc * 32 + 8 * fq;
#pragma unroll
        for (int ai = 0; ai < 2; ++ai)
#pragma unroll
            for (int m = 0; m < 4; ++m) { bf16_t* rowp = O + (size_t)(row0 + ai * HALF + m * 16) * ldc + col0;
#pragma unroll
                for (int bj = 0; bj < 2; ++bj) { const f32x4 v0 = acc[ai][bj][m][0], v1 = acc[ai][bj][m][1];
                    u32x4 w; w.x = cvt_pk_bf16(v0[0], v0[1]); w.y = cvt_pk_bf16(v0[2], v0[3]); w.z = cvt_pk_bf16(v1[0], v1[1]); w.w = cvt_pk_bf16(v1[2], v1[3]);
                    *(u32x4*)(rowp + bj * HALF) = w; } }
    }
};
struct EpiSwiGLU {
    static constexpr bool PERM = true, AFTER_DRAIN = false;
    bf16_t* O; int ldc;
    __device__ __forceinline__ void operator()(const f32x4 (&acc)[2][2][4][2], const Unit& u, int wr, int wc, int fr, int fq) const {
        const int row0 = u.pm * BM + wr * 64 + fr, col0 = u.pn * HALF + wc * 32 + 8 * fq;
#pragma unroll
        for (int ai = 0; ai < 2; ++ai)
#pragma unroll
            for (int m = 0; m < 4; ++m) { bf16_t* rowp = O + (size_t)(row0 + ai * HALF + m * 16) * ldc + col0;
                float r[8];
#pragma unroll
                for (int n = 0; n < 2; ++n)
#pragma unroll
                    for (int i = 0; i < 4; ++i) { const float g = acc[ai][0][m][n][i], up = acc[ai][1][m][n][i]; r[n * 4 + i] = g * fast_sigmoid(g) * up; }
                u32x4 w; w.x = cvt_pk_bf16(r[0], r[1]); w.y = cvt_pk_bf16(r[2], r[3]); w.z = cvt_pk_bf16(r[4], r[5]); w.w = cvt_pk_bf16(r[6], r[7]);
                *(u32x4*)rowp = w; }
    }
};
struct EpiResid {
    static constexpr bool PERM = false, AFTER_DRAIN = false;
    float* X; const float* gate;
    __device__ __forceinline__ void operator()(const f32x4 (&acc)[2][2][4][2], const Unit& u, int wr, int wc, int fr, int fq) const {
        const int col0 = u.pn * BM + wc * 32 + 4 * fq;
        if (u.pm < 32) {
            const float* g = gate + (size_t)(u.pm >> 3) * MODLD_ + col0;
            f32x4 gv[2][2];
#pragma unroll
            for (int bj = 0; bj < 2; ++bj)
#pragma unroll
                for (int n = 0; n < 2; ++n) gv[bj][n] = *(const f32x4*)(g + bj * HALF + n * 16);
#pragma unroll
            for (int ai = 0; ai < 2; ++ai)
#pragma unroll
                for (int m = 0; m < 4; ++m) { float* xp = X + (size_t)(u.pm * BM + ai * HALF + wr * 64 + m * 16 + fr) * 2048 + col0;
#pragma unroll
                    for (int bj = 0; bj < 2; ++bj)
#pragma unroll
                        for (int n = 0; n < 2; ++n) { f32x4 xv = *(const f32x4*)(xp + bj * HALF + n * 16); xv = xv + gv[bj][n] * acc[ai][bj][m][n]; *(f32x4*)(xp + bj * HALF + n * 16) = xv; } }
        } else {
#pragma unroll
            for (int m = 0; m < 4; ++m) { const int rl = wr * 64 + m * 16 + fr;
                const float* g = gate + (size_t)(4 + (rl >> 2)) * MODLD_ + col0; float* xp = X + (size_t)(8192 + rl) * 2048 + col0;
#pragma unroll
                for (int bj = 0; bj < 2; ++bj)
#pragma unroll
                    for (int n = 0; n < 2; ++n) { const f32x4 gvv = *(const f32x4*)(g + bj * HALF + n * 16); f32x4 xv = *(const f32x4*)(xp + bj * HALF + n * 16);
                        xv = xv + gvv * acc[0][bj][m][n]; *(f32x4*)(xp + bj * HALF + n * 16) = xv; } }
        }
    }
};
struct EpiMod {
    static constexpr bool PERM = false, AFTER_DRAIN = false;
    float* M; const float* bias;
    __device__ __forceinline__ void operator()(const f32x4 (&acc)[2][2][4][2], const Unit& u, int wr, int wc, int fr, int fq) const {
        if (wr != 0) return;
        const int col0 = u.pn * BM + wc * 32 + 4 * fq;
#pragma unroll
        for (int m = 0; m < 3; ++m) { const int r = m * 16 + fr;
            if (r < 36) {
#pragma unroll
                for (int bj = 0; bj < 2; ++bj)
#pragma unroll
                    for (int n = 0; n < 2; ++n) { const f32x4 bv = *(const f32x4*)(bias + col0 + bj * HALF + n * 16);
                        *(f32x4*)(M + (size_t)r * MODLD_ + col0 + bj * HALF + n * 16) = acc[0][bj][m][n] + bv; } } }
    }
};

template <class Epi, class Sched, bool ALIGN_EPI = false, bool SP2 = false>
__device__ __forceinline__ void gemm_phase(PG8_LAS unsigned char* lds, const Gemm g, const Sched& S, const Epi& E, int wid_in) {
    int lane_ = (int)__builtin_amdgcn_mbcnt_hi(~0u, __builtin_amdgcn_mbcnt_lo(~0u, 0u)); asm volatile("" : "+v"(lane_));
    const int wid = __builtin_amdgcn_readfirstlane(wid_in), lane = lane_, tid = wid * 64 + lane, wr = wid >> 2, wc = wid & 3, fr = lane & 15, fq = lane >> 4;
    int K_ = g.K; asm volatile("" : "+s"(K_));
    const int K = K_, nt = K / BK;
    unsigned voffA[2], voffB[2];
#pragma unroll
    for (int i = 0; i < 2; ++i) { int R, C; stage_rc(tid * 16 + i * 8192, R, C); const int Rb = Epi::PERM ? ((R & ~31) + perm32(R & 31)) : R;
        voffA[i] = (unsigned)(R * K + C) * 2u; voffB[i] = (unsigned)(Rb * K + C) * 2u; }
    const size_t kstep = (size_t)(BK * 2);
    const size_t hstep = (size_t)HALF * K * 2;
    const size_t tstep = 2 * hstep;
    const unsigned ldsw = (unsigned)wid * 1024u;
    const int aoff = lds_byte(wr * 64 + fr, fq * 8), boff = lds_byte(wc * 32 + fr, fq * 8);
#define PG8_SA(b, h) (((b) * 2 + (h)) * HTB)
#define PG8_SB(b, h) ((4 + (b) * 2 + (h)) * HTB)
#define PG8_STAGE(bufoff, gbase, voff) do { _Pragma("unroll") for (int _i = 0; _i < 2; ++_i) \
        __builtin_amdgcn_global_load_lds((const unsigned*)((const char*)(gbase) + (voff)[_i]), (PG8_LAS unsigned*)(lds + (bufoff) + ldsw + _i * 8192), 16, 0, 0); } while (0)
#define PG8_LDA(dst, b, h) do { _Pragma("unroll") for (int m = 0; m < 4; ++m) _Pragma("unroll") for (int k = 0; k < 2; ++k) dst[m][k] = *(const PG8_LAS bf16x8*)(lds + PG8_SA(b, h) + aoff + m * 2048 + k * 1024); } while (0)
#define PG8_LDB(dst, b, h) do { _Pragma("unroll") for (int n = 0; n < 2; ++n) _Pragma("unroll") for (int k = 0; k < 2; ++k) dst[n][k] = *(const PG8_LAS bf16x8*)(lds + PG8_SB(b, h) + boff + n * 2048 + k * 1024); } while (0)
#define PG8_MMA(ai, bj, At, Bt) do { __builtin_amdgcn_s_setprio(1); _Pragma("unroll") for (int m = 0; m < 4; ++m) _Pragma("unroll") for (int n = 0; n < 2; ++n) _Pragma("unroll") for (int k = 0; k < 2; ++k) \
        acc[ai][bj][m][n] = __builtin_amdgcn_mfma_f32_16x16x32_bf16(Bt[n][k], At[m][k], acc[ai][bj][m][n], 0, 0, 0); __builtin_amdgcn_s_setprio(0); } while (0)
#define PG8_WAIT_V(n) asm volatile("s_waitcnt vmcnt(" #n ")" ::: "memory")
#define PG8_WAIT_L(n) asm volatile("s_waitcnt lgkmcnt(" #n ")" ::: "memory")
#define PG8_BAR __builtin_amdgcn_s_barrier()
#define PG8_SCHED __builtin_amdgcn_sched_barrier(0)
    Unit cur, nxt; int ui = 0;
    if (!S.next(0, cur)) return;
    f32x4 acc[2][2][4][2];
#pragma unroll
    for (int a = 0; a < 2; ++a)
#pragma unroll
        for (int b = 0; b < 2; ++b)
#pragma unroll
            for (int m = 0; m < 4; ++m)
#pragma unroll
                for (int n = 0; n < 2; ++n) acc[a][b][m][n] = (f32x4){0.f, 0.f, 0.f, 0.f};
    bf16x8 At[4][2], B0[2][2], B1[2][2];
    const char* cA = (const char*)g.A + (size_t)cur.pm * tstep; const char* cB = (const char*)g.Bt + (size_t)cur.pn * tstep;
    S.a_ready(cur);
    if constexpr (SP2) {
        PG8_STAGE(PG8_SB(0, 0), cB, voffB); PG8_STAGE(PG8_SB(0, 1), cB + hstep, voffB); PG8_STAGE(PG8_SA(0, 0), cA, voffA); PG8_STAGE(PG8_SA(0, 1), cA + hstep, voffA);
        if (wr == 1) PG8_BAR;
        PG8_WAIT_V(2); PG8_BAR;
        PG8_STAGE(PG8_SB(1, 0), cB + kstep, voffB); PG8_STAGE(PG8_SA(1, 0), cA + kstep, voffA); PG8_STAGE(PG8_SB(1, 1), cB + hstep + kstep, voffB);
        PG8_WAIT_V(6); PG8_BAR;
    } else {
        PG8_STAGE(PG8_SB(0, 0), cB, voffB); PG8_STAGE(PG8_SA(0, 0), cA, voffA); PG8_STAGE(PG8_SB(0, 1), cB + hstep, voffB); PG8_STAGE(PG8_SA(0, 1), cA + hstep, voffA);
        if (wr == 1) PG8_BAR;
        PG8_WAIT_V(4); PG8_BAR;
        PG8_STAGE(PG8_SB(1, 0), cB + kstep, voffB); PG8_STAGE(PG8_SA(1, 0), cA + kstep, voffA); PG8_STAGE(PG8_SB(1, 1), cB + hstep + kstep, voffB);
        PG8_WAIT_V(6); PG8_BAR;
    }
    for (;;) {
        const bool has_next = S.next(ui + 1, nxt);
        const char* nA = has_next ? (const char*)g.A + (size_t)nxt.pm * tstep : cA; const char* nB = has_next ? (const char*)g.Bt + (size_t)nxt.pn * tstep : cB;
        for (int t = 0; t < nt; t += 2) {
            const bool last = (t == nt - 2);
            const char* a1 = cA + (size_t)(t + 1) * kstep;
            const char* a2 = last ? nA : cA + (size_t)(t + 2) * kstep; const char* b2 = last ? nB : cB + (size_t)(t + 2) * kstep;
            const char* a3 = a2 + kstep; const char* b3 = b2 + kstep;
            if (last && has_next) S.a_ready(nxt);
            if constexpr (SP2) {
            PG8_LDB(B0, 0, 0); PG8_LDB(B1, 0, 1); PG8_SCHED; PG8_LDA(At, 0, 0); PG8_STAGE(PG8_SA(1, 1), a1 + hstep, voffA);
            PG8_WAIT_V(8); PG8_WAIT_L(0); PG8_BAR; PG8_MMA(0, 0, At, B0); PG8_MMA(0, 1, At, B1); PG8_BAR; PG8_SCHED;
            PG8_LDA(At, 0, 1); PG8_STAGE(PG8_SB(0, 0), b2, voffB); PG8_STAGE(PG8_SB(0, 1), b2 + hstep, voffB); PG8_STAGE(PG8_SA(0, 0), a2, voffA);
            PG8_WAIT_V(8); PG8_WAIT_L(0); PG8_BAR; PG8_MMA(1, 0, At, B0); PG8_MMA(1, 1, At, B1); PG8_BAR; PG8_SCHED;
            PG8_LDB(B0, 1, 0); PG8_LDB(B1, 1, 1); PG8_SCHED; PG8_LDA(At, 1, 0); PG8_STAGE(PG8_SA(0, 1), a2 + hstep, voffA);
            PG8_WAIT_V(8); PG8_WAIT_L(0); PG8_BAR; PG8_MMA(0, 0, At, B0); PG8_MMA(0, 1, At, B1); PG8_BAR; PG8_SCHED;
            PG8_LDA(At, 1, 1); PG8_STAGE(PG8_SB(1, 0), b3, voffB); PG8_STAGE(PG8_SB(1, 1), b3 + hstep, voffB); PG8_STAGE(PG8_SA(1, 0), a3, voffA);
            PG8_WAIT_V(8); PG8_WAIT_L(0); PG8_BAR; PG8_MMA(1, 0, At, B0); PG8_MMA(1, 1, At, B1); PG8_BAR; PG8_SCHED;
            } else {
            PG8_LDB(B0, 0, 0); PG8_SCHED; PG8_LDA(At, 0, 0); PG8_STAGE(PG8_SA(1, 1), a1 + hstep, voffA);
            PG8_WAIT_L(8); PG8_BAR; PG8_WAIT_L(0); PG8_MMA(0, 0, At, B0); PG8_BAR; PG8_SCHED;
            PG8_LDB(B1, 0, 1); PG8_STAGE(PG8_SB(0, 0), b2, voffB);
            PG8_BAR; PG8_WAIT_L(0); PG8_MMA(0, 1, At, B1); PG8_BAR;
            PG8_LDA(At, 0, 1); PG8_STAGE(PG8_SA(0, 0), a2, voffA);
            PG8_BAR; PG8_WAIT_L(0); PG8_MMA(1, 0, At, B0); PG8_BAR; PG8_SCHED;
            PG8_STAGE(PG8_SB(0, 1), b2 + hstep, voffB);
            PG8_WAIT_V(6); PG8_BAR; PG8_MMA(1, 1, At, B1); PG8_BAR;
            PG8_LDB(B0, 1, 0); PG8_SCHED; PG8_LDA(At, 1, 0); PG8_STAGE(PG8_SA(0, 1), a2 + hstep, voffA);
            PG8_WAIT_L(8); PG8_BAR; PG8_WAIT_L(0); PG8_MMA(0, 0, At, B0); PG8_BAR; PG8_SCHED;
            PG8_LDB(B1, 1, 1); PG8_STAGE(PG8_SB(1, 0), b3, voffB);
            PG8_BAR; PG8_WAIT_L(0); PG8_MMA(0, 1, At, B1); PG8_BAR;
            PG8_LDA(At, 1, 1); PG8_STAGE(PG8_SA(1, 0), a3, voffA);
            PG8_BAR; PG8_WAIT_L(0); PG8_MMA(1, 0, At, B0); PG8_BAR; PG8_SCHED;
            PG8_STAGE(PG8_SB(1, 1), b3 + hstep, voffB);
            PG8_WAIT_V(6); PG8_BAR; PG8_MMA(1, 1, At, B1); PG8_BAR;
            }
        }
        if constexpr (ALIGN_EPI) { if (wr == 0) PG8_BAR; }
        if constexpr (!Epi::AFTER_DRAIN) { E(acc, cur, wr, wc, fr, fq); S.done(cur); }
        if (!has_next) break;
#pragma unroll
        for (int a = 0; a < 2; ++a)
#pragma unroll
            for (int b = 0; b < 2; ++b)
#pragma unroll
                for (int m = 0; m < 4; ++m)
#pragma unroll
                    for (int n = 0; n < 2; ++n) acc[a][b][m][n] = (f32x4){0.f, 0.f, 0.f, 0.f};
        cur = nxt; cA = nA; cB = nB; ++ui;
        if constexpr (ALIGN_EPI) { if (wr == 1) PG8_BAR; }
    }
    PG8_WAIT_V(0);
    if constexpr (!ALIGN_EPI) { if (wr == 0) PG8_BAR; }
    PG8_BAR;
    if constexpr (Epi::AFTER_DRAIN) { E.fused(acc, cur, wr, wc, fr, fq, lds, wid, lane); S.done(cur); }
#undef PG8_SA
#undef PG8_SB
#undef PG8_STAGE
#undef PG8_LDA
#undef PG8_LDB
#undef PG8_MMA
#undef PG8_WAIT_V
#undef PG8_WAIT_L
#undef PG8_BAR
#undef PG8_SCHED
}
}
#define GAS __attribute__((address_space(1)))
#define LAS __attribute__((address_space(3)))
typedef unsigned short bf16;
typedef unsigned v4u __attribute__((ext_vector_type(4)));
typedef float f32x4 __attribute__((ext_vector_type(4)));
typedef short bf16x8 __attribute__((ext_vector_type(8)));
typedef GAS unsigned gu32;
typedef GAS unsigned long long gu64;
#define RLX_AGENT __ATOMIC_RELAXED, __HIP_MEMORY_SCOPE_AGENT
#define LDS_WAIT() asm volatile("s_waitcnt lgkmcnt(0)" ::: "memory")
#define VM_WAIT() asm volatile("s_waitcnt vmcnt(0)" ::: "memory")
__device__ __forceinline__ unsigned long long rt() { return __builtin_amdgcn_s_memrealtime(); }
__device__ __forceinline__ unsigned f2bf(float f) { unsigned u = __builtin_bit_cast(unsigned, f); return (u + 0x7fffu + ((u >> 16) & 1u)) >> 16; }
__device__ __forceinline__ unsigned pk2(float lo, float hi) { return f2bf(lo) | (f2bf(hi) << 16); }

#define XB_TMO      128
#define XB_XCNT(j)  (256  + 64 * (j))
#define XB_XSUB(j)  (1280 + 64 * (j))
#define XB_XGEN(j)  (2304 + 64 * (j))
#define XB_TOP      3328
#define XB_TOPGEN   3392
#define XCD_BAR_WORDS 3456
#define XB_SPIN_CAP (1u << 18)

__device__ __forceinline__ unsigned xb_ld(unsigned* p)              { return __hip_atomic_load(p, __ATOMIC_RELAXED, __HIP_MEMORY_SCOPE_AGENT); }
__device__ __forceinline__ unsigned xb_add(unsigned* p, unsigned v) { return __hip_atomic_fetch_add(p, v, __ATOMIC_RELAXED, __HIP_MEMORY_SCOPE_AGENT); }
__device__ __forceinline__ unsigned xb_xcc_id() { return (unsigned)__builtin_amdgcn_s_getreg((3 << 11) | 20) & 0xFu; }
#define XB_SPIN(cond, bar) do { unsigned _sp = 0; while (cond) { __builtin_amdgcn_s_sleep(1); \
    if ((++_sp & 255u) == 0u) { if (xb_ld(&(bar)[XB_TMO])) break; if (_sp > XB_SPIN_CAP) { atomicAdd(&(bar)[XB_TMO], 1u); break; } } } } while (0)

struct XcdBarrier {
    unsigned* bar; unsigned x;
    volatile LAS unsigned* st;
};

__device__ __forceinline__ XcdBarrier xcd_barrier_post(unsigned* bar, volatile LAS unsigned* st) {
    XcdBarrier b; b.bar = bar; b.x = xb_xcc_id(); b.st = st;
    if (threadIdx.x == 0) (void)xb_add(&bar[XB_XCNT(b.x)], 1u);
    return b;
}
__device__ __forceinline__ void xcd_barrier_complete(unsigned* bar, unsigned x, unsigned& nloc, unsigned& nx) {
    const unsigned G = gridDim.x * gridDim.y * gridDim.z;
    unsigned sum, cnt, mine, sp = 0u;
    for (;;) {
        sum = 0u; cnt = 0u; mine = 0u;
#pragma unroll
        for (unsigned j = 0; j < 16; ++j) { const unsigned c = xb_ld(&bar[XB_XCNT(j)]); sum += c; cnt += (c > 0u) ? 1u : 0u; mine = (j == x) ? c : mine; }
        if (sum == G) break;
        __builtin_amdgcn_s_sleep(1);
        if ((++sp & 255u) == 0u) { if (xb_ld(&bar[XB_TMO])) break; if (sp > XB_SPIN_CAP) { atomicAdd(&bar[XB_TMO], 1u); break; } }
    }
    nloc = mine > 0u ? mine : 1u; nx = cnt > 0u ? cnt : 1u;
}

__device__ __forceinline__ void xcd_barrier(const XcdBarrier& b) {
    asm volatile("s_waitcnt vmcnt(0)" ::: "memory");
    __syncthreads();
    if (threadIdx.x == 0) {
        unsigned* bar = b.bar;
        __builtin_amdgcn_s_waitcnt(0);
        unsigned nloc = b.st[0], nx = b.st[1];
        if (nloc == 0u) { xcd_barrier_complete(bar, b.x, nloc, nx); b.st[0] = nloc; b.st[1] = nx; }
        const unsigned old = xb_add(&bar[XB_XSUB(b.x)], 1u);
        const unsigned gen = old / nloc;
        if (old + 1u == (gen + 1u) * nloc) {
            __builtin_amdgcn_fence(__ATOMIC_RELEASE, "agent");
            asm volatile("s_waitcnt vmcnt(0)" ::: "memory");
            const unsigned og = xb_add(&bar[XB_TOP], 1u);
            const unsigned tg = og / nx;
            if (og + 1u == (tg + 1u) * nx) xb_add(&bar[XB_TOPGEN], 1u);
            else XB_SPIN(xb_ld(&bar[XB_TOPGEN]) == tg, bar);
            __builtin_amdgcn_fence(__ATOMIC_ACQUIRE, "agent");
            xb_add(&bar[XB_XGEN(b.x)], 1u);
            asm volatile("s_waitcnt vmcnt(0)" ::: "memory");
        } else {
            XB_SPIN(xb_ld(&bar[XB_XGEN(b.x)]) == gen, bar);
            __builtin_amdgcn_fence(__ATOMIC_ACQUIRE, "agent");
            asm volatile("s_waitcnt vmcnt(0)" ::: "memory");
        }
    }
    __syncthreads();
}

constexpr int NWAVES = 8, NTHREADS = 512;
constexpr int DM = 2048, NP_ROWS = 8192, NS_ROWS = 128, NROWS = 8320, MPAD = 8448;
constexpr int DEPTH = 4, NBATCH = 36;
constexpr int INW = 4368, ZW = 4608;
constexpr int ZQ = 0, ZK = 512, ZV = 640, ZU = 768, GQ = 1280, GK = 1792, GV = 2304, GG = 3328, GA = 4352;
constexpr int DFF = 5632, NGU = 11264, MODW = 12288, MODLD = 49152;
constexpr float EPS = 1e-6f;
constexpr size_t O_Y = 0, O_WK_P = 17039360, O_WV_P = 17301504, O_POOL_P = 17563648, O_GLA_P = 17686528,
                 O_WK_S = 19783680, O_WV_S = 21880832, O_POOL_S = 23977984, O_GLA_S = 24961024, O_END = 41738240;
constexpr size_t MiB = 1u << 20;
constexpr size_t WS_CTL = 0, CTL_ZERO_BYTES = 1 * MiB;
constexpr size_t WS_WADA = 1 * MiB;
constexpr size_t WS_WIN  = WS_WADA + 192 * MiB;
constexpr size_t WS_WOUT = WS_WIN + 72 * MiB;
constexpr size_t WS_WGU  = WS_WOUT + 32 * MiB;
constexpr size_t WS_WDN  = WS_WGU + 176 * MiB;
constexpr size_t WS_X    = WS_WDN + 88 * MiB;
constexpr size_t WS_H    = WS_X + 66 * MiB;
constexpr size_t WS_Z    = WS_H + 33 * MiB;
constexpr size_t WS_MIX  = WS_Z + 75 * MiB;
constexpr size_t WS_ACT  = WS_MIX + 33 * MiB;
constexpr size_t WS_OGLA = WS_ACT + 91 * MiB;
constexpr size_t WS_LA   = WS_OGLA + 33 * MiB;
constexpr size_t WS_MOD  = WS_LA + 17 * MiB;
constexpr size_t WS_SC   = WS_MOD + 7 * MiB;
constexpr size_t WS_BTAB = WS_SC + 1 * MiB;
constexpr size_t WS_END  = WS_BTAB + 1 * MiB;
constexpr int CW_BAR = 4096;
constexpr int RING_OFF = 0, RING_BYTES = 131072;
constexpr int LDSCTL_OFF = RING_BYTES, MISC_OFF = LDSCTL_OFF + 320;
constexpr int LDS_BYTES = 147456;

struct Args { const float* in[24]; float* out; unsigned char* ws; int ph_lo, ph_hi; };
struct Frame {
    LAS unsigned char* lds;
    volatile LAS unsigned* MISC;
    int wave, vcu, G; int zo;
    __device__ __forceinline__ int lane_id() const { return (int)__builtin_amdgcn_mbcnt_hi(~0u, __builtin_amdgcn_mbcnt_lo(~0u, 0u)); }
    unsigned char* ws; float* out;
    __device__ __forceinline__ bf16* Wada_t() const { return (bf16*)(ws + WS_WADA); }
    __device__ __forceinline__ bf16* Win_t() const { return (bf16*)(ws + WS_WIN); }
    __device__ __forceinline__ bf16* Wout_t() const { return (bf16*)(ws + WS_WOUT); }
    __device__ __forceinline__ bf16* Wgu_t() const { return (bf16*)(ws + WS_WGU); }
    __device__ __forceinline__ bf16* Wdn_t() const { return (bf16*)(ws + WS_WDN); }
    __device__ __forceinline__ float* X() const { return (float*)(ws + WS_X); }
    __device__ __forceinline__ bf16* H() const { return (bf16*)(ws + WS_H); }
    __device__ __forceinline__ bf16* Z() const { return (bf16*)(ws + WS_Z); }
    __device__ __forceinline__ bf16* MIX() const { return (bf16*)(ws + WS_MIX); }
    __device__ __forceinline__ bf16* ACT() const { return (bf16*)(ws + WS_ACT); }
    __device__ __forceinline__ float* OGLA() const { return (float*)(ws + WS_OGLA); }
    __device__ __forceinline__ float* SLOC() const { return (float*)(ws + WS_LA); }
    __device__ __forceinline__ float* DSEG() const { return (float*)(ws + WS_LA + 16 * MiB); }
    __device__ __forceinline__ float* MOD() const { return (float*)(ws + WS_MOD); }
    __device__ __forceinline__ bf16* SC() const { return (bf16*)(ws + WS_SC); }
    __device__ __forceinline__ float* BTAB() const { return (float*)(ws + WS_BTAB); }
};
enum { I_XP = 0, I_XS, I_CK, I_CV, I_SPOOL, I_SGLA, I_CP, I_CS, I_WADA, I_BADA, I_GMIX, I_GFFN, I_WIN, I_WOUT, I_RELB, I_SINKS, I_WPOOL, I_PSCALE, I_WA2, I_BA2, I_GGLA, I_WGU, I_WDN, I_GFIN };

__device__ __forceinline__ float bf2f(unsigned short b) { return __uint_as_float((unsigned)b << 16); }
__device__ __forceinline__ float bflo(unsigned w) { return __uint_as_float(w << 16); }
__device__ __forceinline__ float bfhi(unsigned w) { return __uint_as_float(w & 0xffff0000u); }
__device__ __forceinline__ float wave_sum(float v) {
#pragma unroll
    for (int o = 1; o < 64; o <<= 1) v += __shfl_xor(v, o);
    return v;
}
__device__ __forceinline__ float wave_max(float v) {
#pragma unroll
    for (int o = 1; o < 64; o <<= 1) v = fmaxf(v, __shfl_xor(v, o));
    return v;
}
__device__ __forceinline__ int t5_bucket(int n) {
    if (n < 16) return n;
    return 16 + (n >= 19) + (n >= 21) + (n >= 24) + (n >= 27) + (n >= 31) + (n >= 35) + (n >= 40) + (n >= 46) + (n >= 52) + (n >= 59) + (n >= 67) + (n >= 77) + (n >= 87) + (n >= 99) + (n >= 113);
}

template <int MODE>
__device__ __forceinline__ void transpose_item(const float* W, int K, int N, int nblk, bf16* WT, int row_off, LAS float* scr, int item, int lane) {
    const int kb = item / nblk, nb = item % nblk, k0 = 64 * kb, n0 = 32 * nb;
    const int nn = n0 + (lane & 31); const bool ok = nn < N;
#pragma unroll 8
    for (int i = 0; i < 32; ++i) { const int kk = 2 * i + (lane >> 5); scr[kk * 33 + (lane & 31)] = ok ? W[(size_t)(k0 + kk) * N + nn] : 0.f; }
    LDS_WAIT(); asm volatile("" ::: "memory");
    const int c = lane & 7;
#pragma unroll
    for (int j = 0; j < 4; ++j) { const int n = (lane >> 3) + 8 * j; const LAS float* s = scr + (8 * c) * 33 + n;
        v4u o; o.x = pk2(s[0 * 33], s[1 * 33]); o.y = pk2(s[2 * 33], s[3 * 33]); o.z = pk2(s[4 * 33], s[5 * 33]); o.w = pk2(s[6 * 33], s[7 * 33]);
        int orow = n0 + n;
        if (MODE == 1) { orow = (orow < DFF) ? ((orow >> 7) * 256 + (orow & 127)) : (((orow - DFF) >> 7) * 256 + 128 + ((orow - DFF) & 127)); }
        *(GAS v4u*)(WT + (size_t)(row_off + orow) * K + k0 + 8 * c) = o; }
    LDS_WAIT(); asm volatile("" ::: "memory");
}
__device__ __forceinline__ void p0_prologue(Frame& F, const Args& A) {
    LAS float* scr = (LAS float*)(F.lds + RING_OFF + F.wave * 16384);
    const int gw = F.vcu * NWAVES + F.wave, NGW = F.G * NWAVES;
    const int gt = gw * 64 + F.lane_id(), NGT = NGW * 64;
    constexpr int I_ADA = 32 * 384, I_IN = 32 * 137, I_OUT = 32 * 64, I_GU = 32 * 352, I_DN = 88 * 64, I_L = I_ADA + I_IN + I_OUT + I_GU + I_DN;
    for (int it = gw; it < DEPTH * I_L; it += NGW) {
        const int l = it / I_L; int r = it - l * I_L;
        if (r < I_ADA) { transpose_item<0>(A.in[F.zo + I_WADA] + (size_t)l * DM * MODW, DM, MODW, 384, F.Wada_t(), l * MODW, scr, r, F.lane_id()); continue; } r -= I_ADA;
        if (r < I_IN)  { transpose_item<0>(A.in[F.zo + I_WIN] + (size_t)l * DM * INW, DM, INW, 137, F.Win_t() + (size_t)l * ZW * DM, 0, scr, r, F.lane_id()); continue; } r -= I_IN;
        if (r < I_OUT) { transpose_item<0>(A.in[F.zo + I_WOUT] + (size_t)l * DM * DM, DM, DM, 64, F.Wout_t() + (size_t)l * DM * DM, 0, scr, r, F.lane_id()); continue; } r -= I_OUT;
        if (r < I_GU)  { transpose_item<1>(A.in[F.zo + I_WGU] + (size_t)l * DM * NGU, DM, NGU, 352, F.Wgu_t() + (size_t)l * NGU * DM, 0, scr, r, F.lane_id()); continue; } r -= I_GU;
        transpose_item<0>(A.in[F.zo + I_WDN] + (size_t)l * DFF * DM, DFF, DM, 64, F.Wdn_t() + (size_t)l * DM * DFF, 0, scr, r, F.lane_id());
    }
    const v4u z4 = {0u, 0u, 0u, 0u};
    for (int i = gt; i < DEPTH * 224 * 256; i += NGT) { const int l = i / (224 * 256), r = i - l * (224 * 256); *((GAS v4u*)(F.Win_t() + ((size_t)l * ZW + 4384) * DM) + r) = z4; }
    for (int i = gt; i < 128 * 256; i += NGT) { *((GAS v4u*)(F.H() + (size_t)NROWS * DM) + i) = z4; *((GAS v4u*)(F.MIX() + (size_t)NROWS * DM) + i) = z4; }
    for (int i = gt; i < 128 * 704; i += NGT) *((GAS v4u*)(F.ACT() + (size_t)NROWS * DFF) + i) = z4;
    for (int i = gt; i < NP_ROWS * 512; i += NGT) ((GAS f32x4*)F.X())[i] = ((const GAS f32x4*)A.in[F.zo + I_XP])[i];
    for (int i = gt; i < NS_ROWS * 512; i += NGT) ((GAS f32x4*)(F.X() + (size_t)NP_ROWS * DM))[i] = ((const GAS f32x4*)A.in[F.zo + I_XS])[i];
    for (int i = gt; i < 256 * 1024; i += NGT) { const int r = i >> 10, cp = (i & 1023) * 2; unsigned w = 0u;
        if (r < NBATCH) { const float* c = (r < 4) ? (A.in[F.zo + I_CP] + (size_t)r * DM) : (A.in[F.zo + I_CS] + (size_t)(r - 4) * DM); const float a = c[cp], b = c[cp + 1];
            w = pk2(a / (1.0f + __expf(-a)), b / (1.0f + __expf(-b))); }
        ((GAS unsigned*)F.SC())[i] = w; }
    for (int i = gt; i < 8 * 128; i += NGT) { const int h = i >> 7, dist = i & 127; F.BTAB()[i] = A.in[F.zo + I_RELB][t5_bucket(dist) * 8 + h]; }
}

__device__ __forceinline__ void norm_mod_rows(Frame& F, const float* g, const float* modl  ) {
    const int gw = F.vcu * NWAVES + F.wave, NGW = F.G * NWAVES;
    for (int r = gw; r < NROWS; r += NGW) {
        const int b = r < NP_ROWS ? (r >> 11) : 4 + ((r - NP_ROWS) >> 2);
        const float* xr = F.X() + (size_t)r * DM + 4 * F.lane_id(); const float* sh = modl + (size_t)b * MODLD + 4 * F.lane_id(); const float* gg = g + 4 * F.lane_id();
        f32x4 v[8]; float ss = 0.f;
#pragma unroll
        for (int j = 0; j < 8; ++j) { v[j] = *(const f32x4*)(xr + 256 * j); ss += (v[j].x * v[j].x + v[j].y * v[j].y) + (v[j].z * v[j].z + v[j].w * v[j].w); }
        const float rstd = 1.0f / sqrtf(wave_sum(ss) * (1.0f / DM) + EPS);
        bf16* hr = F.H() + (size_t)r * DM + 4 * F.lane_id();
#pragma unroll
        for (int j = 0; j < 8; ++j) { const f32x4 gv = *(const f32x4*)(gg + 256 * j), sv = *(const f32x4*)(sh + 256 * j), cv = *(const f32x4*)(sh + 2048 + 256 * j);
            const f32x4 y = (v[j] * rstd * gv) * (1.0f + cv) + sv;
            uint2 w; w.x = pk2(y.x, y.y); w.y = pk2(y.z, y.w); *(uint2*)(hr + 256 * j) = w; }
    }
}
__device__ __forceinline__ void final_norm_rows(Frame& F, const Args& A) {
    const int gw = F.vcu * NWAVES + F.wave, NGW = F.G * NWAVES; const float* g = A.in[F.zo + I_GFIN] + 4 * F.lane_id();
    for (int r = gw; r < NROWS; r += NGW) {
        const float* xr = F.X() + (size_t)r * DM + 4 * F.lane_id();
        f32x4 v[8]; float ss = 0.f;
#pragma unroll
        for (int j = 0; j < 8; ++j) { v[j] = *(const f32x4*)(xr + 256 * j); ss += (v[j].x * v[j].x + v[j].y * v[j].y) + (v[j].z * v[j].z + v[j].w * v[j].w); }
        const float rstd = 1.0f / sqrtf(wave_sum(ss) * (1.0f / DM) + EPS);
        float* yr = F.out + O_Y + (size_t)r * DM + 4 * F.lane_id();
#pragma unroll
        for (int j = 0; j < 8; ++j) { const f32x4 gv = *(const f32x4*)(g + 256 * j); *(f32x4*)(yr + 256 * j) = v[j] * rstd * gv; }
    }
}

__device__ __forceinline__ void attn_item(Frame& F, const Args& A, int l, int r, int hd, LAS float* ps) {
    const int lane = F.lane_id(), g = hd >> 2; const bool smp = r >= NP_ROWS;
    const int t = r & 2047, sb = smp ? ((r - NP_ROWS) >> 2) : 0, si = (r - NP_ROWS) & 3;
    LAS float* qs = ps + 128;
    { const unsigned w = ((const unsigned*)(F.Z() + (size_t)r * ZW + ZQ + hd * 64))[lane & 31]; if (lane < 32) { qs[2 * lane] = bflo(w); qs[2 * lane + 1] = bfhi(w); } }
    LDS_WAIT(); asm volatile("" ::: "memory");
    const float* ck = A.in[F.zo + I_CK] + ((size_t)(l * 32 + sb) * 128) * 128 + g * 64;
    const float* cv = A.in[F.zo + I_CV] + ((size_t)(l * 32 + sb) * 128) * 128 + g * 64;
    const int jmin = smp ? 0 : (t >= 127 ? 0 : 127 - t);
    float sc[2];
#pragma unroll 1
    for (int jj = 0; jj < 2; ++jj) {
        const int j = lane + 64 * jj, dist = 127 - j; float dot = 0.f; bool valid = j >= jmin;
        if (valid) {
            const int krel = si - dist;
            if (smp && krel < 0) {
                const f32x4* kp = (const f32x4*)(ck + (size_t)(krel + 128) * 128);
#pragma unroll 4
                for (int c = 0; c < 16; ++c) { const f32x4 kv = kp[c]; const f32x4 qv = *(const LAS f32x4*)(qs + 4 * c); dot += qv.x * kv.x + qv.y * kv.y + qv.z * kv.z + qv.w * kv.w; }
            } else {
                const int krow = smp ? (NP_ROWS + sb * 4 + krel) : (r - dist);
                const v4u* kp = (const v4u*)(F.Z() + (size_t)krow * ZW + ZK + g * 64);
#pragma unroll 4
                for (int c = 0; c < 8; ++c) { const v4u w = kp[c];
                    const f32x4 qa = *(const LAS f32x4*)(qs + 8 * c), qb = *(const LAS f32x4*)(qs + 8 * c + 4);
                    dot += qa.x * bflo(w.x) + qa.y * bfhi(w.x) + qa.z * bflo(w.y) + qa.w * bfhi(w.y) + qb.x * bflo(w.z) + qb.y * bfhi(w.z) + qb.z * bflo(w.w) + qb.w * bfhi(w.w); }
            }
        }
        const float sv = valid ? dot * 0.125f + F.BTAB()[hd * 128 + dist] : -INFINITY;
        if (jj == 0) sc[0] = sv; else sc[1] = sv;
    }
    const float sink = A.in[F.zo + I_SINKS][l * 8 + hd];
    const float m = fmaxf(wave_max(fmaxf(sc[0], sc[1])), sink);
    const float p0 = __expf(sc[0] - m), p1 = __expf(sc[1] - m);
    const float denom = wave_sum(p0 + p1) + __expf(sink - m);
    ps[lane] = p0; ps[lane + 64] = p1;
    LDS_WAIT(); asm volatile("" ::: "memory");
    float o = 0.f;
    for (int j = jmin; j < 128; ++j) {
        const float pj = ps[j]; const int dist = 127 - j; float vv;
        const int krel = si - dist;
        if (smp && krel < 0) vv = cv[(size_t)(krel + 128) * 128 + lane];
        else { const int krow = smp ? (NP_ROWS + sb * 4 + krel) : (r - dist); vv = bf2f(F.Z()[(size_t)krow * ZW + ZV + g * 64 + lane]); }
        o += pj * vv;
    }
    F.MIX()[(size_t)r * DM + hd * 64 + lane] = (bf16)f2bf(o / denom);
    LDS_WAIT(); asm volatile("" ::: "memory");
}
__device__ __forceinline__ void pool_item(Frame& F, const Args& A, int l, int r, int gi, LAS float* ds) {
    const int lane = F.lane_id(), w = 2 << gi; const bool smp = r >= NP_ROWS;
    const int t = r & 2047, sb = (r - NP_ROWS) >> 2, si = (r - NP_ROWS) & 3;
    const float* pbuf = A.in[F.zo + I_SPOOL] + ((size_t)(l * 32 + sb) * 15) * 512 + gi * 128;
    float s0 = 0.f, s1 = 0.f, u0 = 0.f, u1 = 0.f;
    for (int o = 0; o < w; ++o) {
        float a0 = 0.f, a1 = 0.f;
        if (!smp) { if (t - o >= 0) { const bf16* zp = F.Z() + (size_t)(r - o) * ZW + ZU + gi * 128; a0 = bf2f(zp[lane]); a1 = bf2f(zp[lane + 64]); } }
        else { const int idx = si - o;
            if (idx >= 0) { const bf16* zp = F.Z() + (size_t)(NP_ROWS + sb * 4 + idx) * ZW + ZU + gi * 128; a0 = bf2f(zp[lane]); a1 = bf2f(zp[lane + 64]); }
            else { const float* bp = pbuf + (size_t)(15 + idx) * 512; a0 = bp[lane]; a1 = bp[lane + 64]; } }
        if (o == 0) { u0 = a0; u1 = a1; }
        s0 += a0; s1 += a1;
    }
    const float cnt = smp ? (float)w : (float)((t + 1) < w ? (t + 1) : w);
    ds[lane] = s0 / cnt - u0; ds[lane + 64] = s1 / cnt - u1;
    LDS_WAIT(); asm volatile("" ::: "memory");
    const float* wp = A.in[F.zo + I_WPOOL] + ((size_t)(l * 4 + gi) * 128) * 128;
    float y0 = 0.f, y1 = 0.f;
#pragma unroll 4
    for (int c = 0; c < 128; ++c) { const float dv = ds[c]; y0 += dv * wp[c * 128 + lane]; y1 += dv * wp[c * 128 + lane + 64]; }
    const float* psc = A.in[F.zo + I_PSCALE] + l * 512 + gi * 128;
    bf16* mp = F.MIX() + (size_t)r * DM + 512 + gi * 128;
    mp[lane] = (bf16)f2bf(y0 * psc[lane]); mp[lane + 64] = (bf16)f2bf(y1 * psc[lane + 64]);
    LDS_WAIT(); asm volatile("" ::: "memory");
}
__device__ __forceinline__ void cache_outputs(Frame& F, const Args& A, int l) {
    const int gt = (F.vcu * NWAVES + F.wave) * 64 + F.lane_id(), NGT = F.G * NWAVES * 64;
    for (int i = gt; i < 4 * 128 * 128; i += NGT) { const int b = i >> 14, j = (i >> 7) & 127, c = i & 127; const bf16* zr = F.Z() + (size_t)(b * 2048 + 1920 + j) * ZW;
        F.out[O_WK_P + (size_t)l * 65536 + i] = bf2f(zr[ZK + c]); F.out[O_WV_P + (size_t)l * 65536 + i] = bf2f(zr[ZV + c]); }
    for (int i = gt; i < 4 * 15 * 512; i += NGT) { const int b = i / 7680, rem = i - b * 7680, j = rem >> 9, c = rem & 511;
        F.out[O_POOL_P + (size_t)l * 30720 + i] = bf2f(F.Z()[(size_t)(b * 2048 + 2033 + j) * ZW + ZU + c]); }
    for (int i = gt; i < 32 * 128 * 128; i += NGT) { const int sb = i >> 14, p = (i >> 7) & 127, c = i & 127; float kv, vv;
        if (p < 124) { const size_t src = ((size_t)(l * 32 + sb) * 128 + p + 4) * 128 + c; kv = A.in[F.zo + I_CK][src]; vv = A.in[F.zo + I_CV][src]; }
        else { const bf16* zr = F.Z() + (size_t)(NP_ROWS + sb * 4 + p - 124) * ZW; kv = bf2f(zr[ZK + c]); vv = bf2f(zr[ZV + c]); }
        F.out[O_WK_S + (size_t)l * 524288 + i] = kv; F.out[O_WV_S + (size_t)l * 524288 + i] = vv; }
    for (int i = gt; i < 32 * 15 * 512; i += NGT) { const int sb = i / 7680, rem = i - sb * 7680, j = rem >> 9, c = rem & 511; float v;
        if (j < 11) v = A.in[F.zo + I_SPOOL][((size_t)(l * 32 + sb) * 15 + j + 4) * 512 + c];
        else v = bf2f(F.Z()[(size_t)(NP_ROWS + sb * 4 + j - 11) * ZW + ZU + c]);
        F.out[O_POOL_S + (size_t)l * 245760 + i] = v; }
}
__device__ __forceinline__ void gla_out_item(Frame& F, const Args& A, int l, int r, int hh) {
    const int lane = F.lane_id();
    const f32x4 o = *(const f32x4*)(F.OGLA() + (size_t)r * 1024 + hh * 256 + 4 * lane);
    const float ss = wave_sum((o.x * o.x + o.y * o.y) + (o.z * o.z + o.w * o.w));
    const float rstd = 1.0f / sqrtf(ss * (1.0f / 256.0f) + EPS);
    const f32x4 gv = *(const f32x4*)(A.in[F.zo + I_GGLA] + l * 1024 + hh * 256 + 4 * lane);
    const uint2 gw = *(const uint2*)(F.Z() + (size_t)r * ZW + GG + hh * 256 + 4 * lane);
    const float g0 = bflo(gw.x), g1 = bfhi(gw.x), g2 = bflo(gw.y), g3 = bfhi(gw.y);
    const float y0 = o.x * rstd * gv.x * (g0 / (1.0f + __expf(-g0))), y1 = o.y * rstd * gv.y * (g1 / (1.0f + __expf(-g1)));
    const float y2 = o.z * rstd * gv.z * (g2 / (1.0f + __expf(-g2))), y3 = o.w * rstd * gv.w * (g3 / (1.0f + __expf(-g3)));
    uint2 w; w.x = pk2(y0, y1); w.y = pk2(y2, y3);
    *(uint2*)(F.MIX() + (size_t)r * DM + 1024 + hh * 256 + 4 * lane) = w;
}
constexpr int GL_QD = 0, GL_KD = 17408, GL_KDT = 34816, GL_VT = 53248, GL_AM = 71680, GL_ST = 80896, GL_DL = 115712, GL_BS = 116224, GL_END = 118272;
static_assert(GL_END <= RING_BYTES, "GLA LDS map");
typedef unsigned u32x2 __attribute__((ext_vector_type(2)));
__device__ __forceinline__ u32x2 pack4bf(const f32x4 v) { u32x2 w; w.x = pk2(v.x, v.y); w.y = pk2(v.z, v.w); return w; }
__device__ __forceinline__ void gla_chunks(Frame& F, const Args& A, int l, int row0, int nchunks, int nvalid, int hh, int eh, bool do_out, f32x4 (&sacc)[8], float& btot) {
    const int lane = F.lane_id(), wave = F.wave, tid = wave * 64 + lane, fr = lane & 15, fq = lane >> 4;
    const int d = tid & 127, qtr = tid >> 7, cg = hh * 128 + d;
    LAS bf16* QD = (LAS bf16*)(F.lds + GL_QD); LAS bf16* KD = (LAS bf16*)(F.lds + GL_KD); LAS bf16* KDT = (LAS bf16*)(F.lds + GL_KDT); LAS bf16* VT = (LAS bf16*)(F.lds + GL_VT);
    LAS bf16* AM = (LAS bf16*)(F.lds + GL_AM); LAS bf16* ST = (LAS bf16*)(F.lds + GL_ST); LAS float* DL = (LAS float*)(F.lds + GL_DL); LAS float* BS = (LAS float*)(F.lds + GL_BS);
    const bf16* Z = F.Z();
    float wa[16];
    { const float* wp = A.in[F.zo + I_WA2] + (size_t)l * 16 * 512 + cg;
#pragma unroll
      for (int j = 0; j < 16; ++j) wa[j] = wp[j * 512]; }
    const float ba = A.in[F.zo + I_BA2][l * 512 + cg];
    btot = 0.f;
    if (do_out) {
#pragma unroll
        for (int db = 0; db < 8; ++db) *(LAS u32x2*)(ST + (wave * 16 + fr) * 136 + db * 16 + 4 * fq) = pack4bf(sacc[db]);
    }
    for (int c = 0; c < nchunks; ++c) {
        const int r0 = row0 + c * 64;
        float bl[16]; float run = 0.f;
#pragma unroll
        for (int i = 0; i < 16; ++i) { const int t = 16 * qtr + i; float la = 0.f;
            if (t < nvalid) { const v4u* gp = (const v4u*)(Z + (size_t)(r0 + t) * ZW + GA); const v4u g0 = gp[0], g1 = gp[1];
                float x = ba + bflo(g0.x) * wa[0] + bfhi(g0.x) * wa[1] + bflo(g0.y) * wa[2] + bfhi(g0.y) * wa[3] + bflo(g0.z) * wa[4] + bfhi(g0.z) * wa[5] + bflo(g0.w) * wa[6] + bfhi(g0.w) * wa[7];
                x += bflo(g1.x) * wa[8] + bfhi(g1.x) * wa[9] + bflo(g1.y) * wa[10] + bfhi(g1.y) * wa[11] + bflo(g1.z) * wa[12] + bfhi(g1.z) * wa[13] + bflo(g1.w) * wa[14] + bfhi(g1.w) * wa[15];
                la = (fminf(x, 0.f) - log1pf(__expf(-fabsf(x)))) * (1.0f / 16.0f); }
            run += la; bl[i] = run; }
        BS[qtr * 128 + d] = run;
        __syncthreads();
        float pre = 0.f, tot = 0.f;
#pragma unroll
        for (int q2 = 0; q2 < 4; ++q2) { const float v = BS[q2 * 128 + d]; tot += v; if (q2 < qtr) pre += v; }
#pragma unroll
        for (int i = 0; i < 16; ++i) { const int t = 16 * qtr + i; const float b = pre + bl[i]; float qv = 0.f, kv = 0.f;
            if (t < nvalid) { const bf16* zr = Z + (size_t)(r0 + t) * ZW; qv = bf2f(zr[GQ + cg]); kv = bf2f(zr[GK + cg]); }
            QD[t * 136 + d] = (bf16)f2bf(qv * __expf(b) * 0.08838834764831845f); KD[t * 136 + d] = (bf16)f2bf(kv * __expf(-b)); KDT[d * 72 + t] = (bf16)f2bf(kv * __expf(tot - b)); }
        if (qtr == 0) DL[d] = __expf(tot);
        btot += tot;
        { const int s = tid >> 3, ec = tid & 7; v4u v0 = {0u, 0u, 0u, 0u}, v1 = {0u, 0u, 0u, 0u};
          if (s < nvalid) { const v4u* vp = (const v4u*)(Z + (size_t)(r0 + s) * ZW + GV + hh * 256 + eh * 128 + ec * 16); v0 = vp[0]; v1 = vp[1]; }
          LAS bf16* vt = VT + (ec * 16) * 72 + s;
          vt[0 * 72] = (bf16)(v0.x & 0xffffu); vt[1 * 72] = (bf16)(v0.x >> 16); vt[2 * 72] = (bf16)(v0.y & 0xffffu); vt[3 * 72] = (bf16)(v0.y >> 16);
          vt[4 * 72] = (bf16)(v0.z & 0xffffu); vt[5 * 72] = (bf16)(v0.z >> 16); vt[6 * 72] = (bf16)(v0.w & 0xffffu); vt[7 * 72] = (bf16)(v0.w >> 16);
          vt[8 * 72] = (bf16)(v1.x & 0xffffu); vt[9 * 72] = (bf16)(v1.x >> 16); vt[10 * 72] = (bf16)(v1.y & 0xffffu); vt[11 * 72] = (bf16)(v1.y >> 16);
          vt[12 * 72] = (bf16)(v1.z & 0xffffu); vt[13 * 72] = (bf16)(v1.z >> 16); vt[14 * 72] = (bf16)(v1.w & 0xffffu); vt[15 * 72] = (bf16)(v1.w >> 16); }
        __syncthreads();
        if (do_out) {
#pragma unroll
            for (int bi = 0; bi < 2; ++bi) { const int blk = 2 * wave + bi, tb = blk >> 2, sbk = blk & 3;
                f32x4 acc = {0.f, 0.f, 0.f, 0.f};
                if (sbk <= tb) {
#pragma unroll
                    for (int ks = 0; ks < 4; ++ks) { const bf16x8 a = *(const LAS bf16x8*)(KD + (sbk * 16 + fr) * 136 + ks * 32 + fq * 8), b = *(const LAS bf16x8*)(QD + (tb * 16 + fr) * 136 + ks * 32 + fq * 8);
                        acc = __builtin_amdgcn_mfma_f32_16x16x32_bf16(a, b, acc, 0, 0, 0); } }
                const int t = tb * 16 + fr, s0 = sbk * 16 + 4 * fq;
                f32x4 m; m.x = (s0 + 0 <= t) ? acc.x : 0.f; m.y = (s0 + 1 <= t) ? acc.y : 0.f; m.z = (s0 + 2 <= t) ? acc.z : 0.f; m.w = (s0 + 3 <= t) ? acc.w : 0.f;
                *(LAS u32x2*)(AM + t * 72 + s0) = pack4bf(m); }
            __syncthreads();
#pragma unroll
            for (int tb = 0; tb < 4; ++tb) { f32x4 o = {0.f, 0.f, 0.f, 0.f};
#pragma unroll
                for (int ks = 0; ks < 2; ++ks) { const bf16x8 a = *(const LAS bf16x8*)(VT + (wave * 16 + fr) * 72 + ks * 32 + fq * 8), b = *(const LAS bf16x8*)(AM + (tb * 16 + fr) * 72 + ks * 32 + fq * 8);
                    o = __builtin_amdgcn_mfma_f32_16x16x32_bf16(a, b, o, 0, 0, 0); }
#pragma unroll
                for (int ks = 0; ks < 4; ++ks) { const bf16x8 a = *(const LAS bf16x8*)(ST + (wave * 16 + fr) * 136 + ks * 32 + fq * 8), b = *(const LAS bf16x8*)(QD + (tb * 16 + fr) * 136 + ks * 32 + fq * 8);
                    o = __builtin_amdgcn_mfma_f32_16x16x32_bf16(a, b, o, 0, 0, 0); }
                const int t = tb * 16 + fr;
                if (t < nvalid) *(f32x4*)(F.OGLA() + (size_t)(r0 + t) * 1024 + hh * 256 + eh * 128 + wave * 16 + 4 * fq) = o; }
        }
#pragma unroll
        for (int db = 0; db < 8; ++db) { const f32x4 dl = *(const LAS f32x4*)(DL + db * 16 + 4 * fq); sacc[db] = sacc[db] * dl;
#pragma unroll
            for (int ks = 0; ks < 2; ++ks) { const bf16x8 a = *(const LAS bf16x8*)(KDT + (db * 16 + fr) * 72 + ks * 32 + fq * 8), b = *(const LAS bf16x8*)(VT + (wave * 16 + fr) * 72 + ks * 32 + fq * 8);
                sacc[db] = __builtin_amdgcn_mfma_f32_16x16x32_bf16(a, b, sacc[db], 0, 0, 0); } }
        if (do_out) {
#pragma unroll
            for (int db = 0; db < 8; ++db) *(LAS u32x2*)(ST + (wave * 16 + fr) * 136 + db * 16 + 4 * fq) = pack4bf(sacc[db]);
        }
        __syncthreads();
    }
}
__device__ __forceinline__ void gla_phase1(Frame& F, const Args& A, int l) {
    const int lane = F.lane_id(), wave = F.wave, tid = wave * 64 + lane, fr = lane & 15, fq = lane >> 4;
    for (int u = F.vcu; u < 256; u += F.G) { const int bh = u >> 4, seg = (u >> 1) & 7, eh = u & 1;
        if (seg == 7) continue;
        f32x4 sacc[8];
#pragma unroll
        for (int db = 0; db < 8; ++db) sacc[db] = (f32x4){0.f, 0.f, 0.f, 0.f};
        float btot;
        gla_chunks(F, A, l, (bh >> 2) * 2048 + seg * 256, 4, 64, bh & 3, eh, false, sacc, btot);
        float* sl = F.SLOC() + ((size_t)(bh * 8 + seg) * 128) * 256 + eh * 128 + wave * 16 + fr;
#pragma unroll
        for (int db = 0; db < 8; ++db) { const int d0 = db * 16 + 4 * fq; sl[(size_t)(d0 + 0) * 256] = sacc[db].x; sl[(size_t)(d0 + 1) * 256] = sacc[db].y; sl[(size_t)(d0 + 2) * 256] = sacc[db].z; sl[(size_t)(d0 + 3) * 256] = sacc[db].w; }
        if (eh == 0 && tid < 128) F.DSEG()[(bh * 8 + seg) * 128 + tid] = __expf(btot);
    }
    for (int u = F.vcu; u < 256; u += F.G) { const int sb = u >> 3, hh = (u >> 1) & 3, eh = u & 1; const size_t so = ((size_t)((l * 32 + sb) * 4 + hh)) * 32768 + eh * 128 + wave * 16 + fr;
        const float* s0 = A.in[F.zo + I_SGLA] + so;
        f32x4 sacc[8];
#pragma unroll
        for (int db = 0; db < 8; ++db) { const int d0 = db * 16 + 4 * fq; sacc[db].x = s0[(size_t)(d0 + 0) * 256]; sacc[db].y = s0[(size_t)(d0 + 1) * 256]; sacc[db].z = s0[(size_t)(d0 + 2) * 256]; sacc[db].w = s0[(size_t)(d0 + 3) * 256]; }
        float btot;
        gla_chunks(F, A, l, NP_ROWS + sb * 4, 1, 4, hh, eh, true, sacc, btot);
        float* so_ = F.out + O_GLA_S + so;
#pragma unroll
        for (int db = 0; db < 8; ++db) { const int d0 = db * 16 + 4 * fq; so_[(size_t)(d0 + 0) * 256] = sacc[db].x; so_[(size_t)(d0 + 1) * 256] = sacc[db].y; so_[(size_t)(d0 + 2) * 256] = sacc[db].z; so_[(size_t)(d0 + 3) * 256] = sacc[db].w; }
    }
}
__device__ __forceinline__ void gla_phase2(Frame& F, const Args& A, int l) {
    const int lane = F.lane_id(), wave = F.wave, fr = lane & 15, fq = lane >> 4;
    for (int u = F.vcu; u < 256; u += F.G) { const int bh = u >> 4, seg = (u >> 1) & 7, eh = u & 1;
        f32x4 sacc[8];
#pragma unroll
        for (int db = 0; db < 8; ++db) sacc[db] = (f32x4){0.f, 0.f, 0.f, 0.f};
        for (int i2 = 0; i2 < seg; ++i2) { const float* sl = F.SLOC() + ((size_t)(bh * 8 + i2) * 128) * 256 + eh * 128 + wave * 16 + fr; const float* dg = F.DSEG() + (bh * 8 + i2) * 128;
#pragma unroll
            for (int db = 0; db < 8; ++db) { const int d0 = db * 16 + 4 * fq; const f32x4 dv = *(const f32x4*)(dg + d0);
                sacc[db].x = sacc[db].x * dv.x + sl[(size_t)(d0 + 0) * 256]; sacc[db].y = sacc[db].y * dv.y + sl[(size_t)(d0 + 1) * 256]; sacc[db].z = sacc[db].z * dv.z + sl[(size_t)(d0 + 2) * 256]; sacc[db].w = sacc[db].w * dv.w + sl[(size_t)(d0 + 3) * 256]; } }
        float btot;
        gla_chunks(F, A, l, (bh >> 2) * 2048 + seg * 256, 4, 64, bh & 3, eh, true, sacc, btot);
        if (seg == 7) { float* so_ = F.out + O_GLA_P + ((size_t)(l * 16 + bh)) * 32768 + eh * 128 + wave * 16 + fr;
#pragma unroll
            for (int db = 0; db < 8; ++db) { const int d0 = db * 16 + 4 * fq; so_[(size_t)(d0 + 0) * 256] = sacc[db].x; so_[(size_t)(d0 + 1) * 256] = sacc[db].y; so_[(size_t)(d0 + 2) * 256] = sacc[db].z; so_[(size_t)(d0 + 3) * 256] = sacc[db].w; } }
    }
}

#ifndef EN_P0
#define EN_P0 1
#endif
#ifndef EN_G
#define EN_G 1
#endif
#ifndef EN_N
#define EN_N 1
#endif
#ifndef EN_M2
#define EN_M2 1
#endif
#ifndef EN_M3
#define EN_M3 1
#endif
#ifndef EN_M4
#define EN_M4 1
#endif
#ifndef EN_G1
#define EN_G1 1
#endif
#ifndef EN_GIN
#define EN_GIN 1
#endif
#ifndef EN_GOUT
#define EN_GOUT 1
#endif
#ifndef EN_GGU
#define EN_GGU 1
#endif
#ifndef EN_GDN
#define EN_GDN 1
#endif
#ifndef MK_SINGLE
#define MK_SINGLE 1
#endif
constexpr int PH_PER_LAYER = 9, PH_LAYER0 = 2, PH_FINAL = PH_LAYER0 + DEPTH * PH_PER_LAYER, PH_COUNT = PH_FINAL + 1;
__global__ void __launch_bounds__(NTHREADS, 2) hymba_fwd(Args args) {
    extern __shared__ __attribute__((aligned(16))) unsigned char lds[];
    Frame F;
    F.lds = (LAS unsigned char*)lds;
    F.MISC = (volatile LAS unsigned*)(F.lds + MISC_OFF);
    F.wave = __builtin_amdgcn_readfirstlane((int)threadIdx.x >> 6); F.zo = 0;
    F.G = gridDim.x; { const int bx = blockIdx.x; F.vcu = (F.G % 8 == 0) ? (bx % 8) * (F.G / 8) + bx / 8 : bx; }
    F.ws = args.ws; F.out = args.out;
    gu32* const ctl = (gu32*)(F.ws + WS_CTL);
    for (int u = threadIdx.x; u < (LDS_BYTES - LDSCTL_OFF) / 4; u += NTHREADS) ((LAS unsigned*)(F.lds + LDSCTL_OFF))[u] = 0u;
    __syncthreads();
#if MK_SINGLE
    XcdBarrier bar = xcd_barrier_post((unsigned*)(ctl + CW_BAR), F.MISC + 8);
#define GRID_BAR() xcd_barrier(bar)
#else
#define GRID_BAR() do { } while (0)
#endif
    const int lo = args.ph_lo, hi = args.ph_hi;
#define IN(k) (lo <= (k) && (k) < hi)
#define BOTH(k) (IN(k) && IN((k) + 1))
#define PHASE_BEGIN() asm volatile("s_mov_b32 %0, 0" : "=s"(F.zo), "+s"(F.G), "+s"(F.vcu), "+s"(F.wave))
#define gw (F.vcu * NWAVES + F.wave)
#define NGW (F.G * NWAVES)
#define wscr ((LAS float*)(F.lds + RING_OFF + F.wave * 16384))

    if (EN_P0 && IN(0)) { PHASE_BEGIN(); p0_prologue(F, args); if (BOTH(0)) GRID_BAR(); }
    if (EN_G && EN_G1 && IN(1)) { PHASE_BEGIN();
        pg8::Gemm g{F.SC(), F.Wada_t(), 256, DEPTH * MODW, DM}; pg8::StaticOrder S; S.init(256, DEPTH * MODW, F.G, (int)blockIdx.x);
        pg8::EpiMod E{F.MOD(), args.in[F.zo + I_BADA]};
        pg8::gemm_phase<pg8::EpiMod, pg8::StaticOrder, true, true>(F.lds + RING_OFF, g, S, E, F.wave);
        if (BOTH(1)) GRID_BAR();
    }
    for (int l = 0; l < DEPTH; ++l) {
        const int pb = PH_LAYER0 + l * PH_PER_LAYER;
        const float* modl = F.MOD() + (size_t)l * MODW;
        if (EN_N && IN(pb + 0)) { PHASE_BEGIN(); norm_mod_rows(F, args.in[F.zo + I_GMIX] + l * DM, modl); if (BOTH(pb + 0)) GRID_BAR(); }
        if (EN_G && EN_GIN && IN(pb + 1)) { PHASE_BEGIN();
            pg8::Gemm g{F.H(), F.Win_t() + (size_t)l * ZW * DM, MPAD, ZW, DM}; pg8::StaticOrder S; S.init(MPAD, ZW, F.G, (int)blockIdx.x);
            pg8::EpiZ E{F.Z(), ZW};
            pg8::gemm_phase<pg8::EpiZ, pg8::StaticOrder, true, true>(F.lds + RING_OFF, g, S, E, F.wave);
            if (BOTH(pb + 1)) GRID_BAR();
        }
        if (EN_M2 && IN(pb + 2)) { PHASE_BEGIN();
            gla_phase1(F, args, l);
            for (int it = gw; it < NROWS * 8; it += NGW) attn_item(F, args, l, it >> 3, it & 7, wscr);
            for (int it = gw; it < NROWS * 4; it += NGW) pool_item(F, args, l, it >> 2, it & 3, wscr);
            cache_outputs(F, args, l);
            if (BOTH(pb + 2)) GRID_BAR();
        }
        if (EN_M3 && IN(pb + 3)) { PHASE_BEGIN();
            gla_phase2(F, args, l);
            if (BOTH(pb + 3)) GRID_BAR();
        }
        if (EN_M4 && IN(pb + 4)) { PHASE_BEGIN(); for (int it = gw; it < NROWS * 4; it += NGW) gla_out_item(F, args, l, it >> 2, it & 3); if (BOTH(pb + 4)) GRID_BAR(); }
        if (EN_G && EN_GOUT && IN(pb + 5)) { PHASE_BEGIN();
            pg8::Gemm g{F.MIX(), F.Wout_t() + (size_t)l * DM * DM, MPAD, DM, DM}; pg8::StaticOrder S; S.init(MPAD, DM, F.G, (int)blockIdx.x);
            pg8::EpiResid E{F.X(), modl + 4096};
            pg8::gemm_phase<pg8::EpiResid, pg8::StaticOrder, true, true>(F.lds + RING_OFF, g, S, E, F.wave);
            if (BOTH(pb + 5)) GRID_BAR();
        }
        if (EN_N && IN(pb + 6)) { PHASE_BEGIN(); norm_mod_rows(F, args.in[F.zo + I_GFFN] + l * DM, modl + 6144); if (BOTH(pb + 6)) GRID_BAR(); }
        if (EN_G && EN_GGU && IN(pb + 7)) { PHASE_BEGIN();
            pg8::Gemm g{F.H(), F.Wgu_t() + (size_t)l * NGU * DM, MPAD, NGU, DM}; pg8::StaticOrder S; S.init(MPAD, NGU, F.G, (int)blockIdx.x);
            pg8::EpiSwiGLU E{F.ACT(), DFF};
            pg8::gemm_phase<pg8::EpiSwiGLU, pg8::StaticOrder, true, true>(F.lds + RING_OFF, g, S, E, F.wave);
            if (BOTH(pb + 7)) GRID_BAR();
        }
        if (EN_G && EN_GDN && IN(pb + 8)) { PHASE_BEGIN();
            pg8::Gemm g{F.ACT(), F.Wdn_t() + (size_t)l * DM * DFF, MPAD, DM, DFF}; pg8::StaticOrder S; S.init(MPAD, DM, F.G, (int)blockIdx.x);
            pg8::EpiResid E{F.X(), modl + 10240};
            pg8::gemm_phase<pg8::EpiResid, pg8::StaticOrder, true, true>(F.lds + RING_OFF, g, S, E, F.wave);
            if (BOTH(pb + 8)) GRID_BAR();
        }
    }
    if (IN(PH_FINAL)) { PHASE_BEGIN(); final_norm_rows(F, args); }
#undef IN
#undef BOTH
#undef gw
#undef NGW
#undef wscr
}

extern "C" void kernel_launch(void* const* d_in, const int* in_sizes, int n_in, void* d_out, int out_size, void* d_ws, size_t ws_size, hipStream_t stream) {
    static int grid = 0;
    if (grid == 0) {
        if (n_in != 24 || out_size != (int)O_END || ws_size < WS_END) { fprintf(stderr, "kernel_launch: unexpected sizes n_in %d out %d ws %zu\n", n_in, out_size, ws_size); grid = -1; return; }
        int dev = 0, cus = 0;
        if (hipGetDevice(&dev) != hipSuccess || hipDeviceGetAttribute(&cus, hipDeviceAttributeMultiprocessorCount, dev) != hipSuccess) { grid = -1; return; }
        if (hipFuncSetAttribute((const void*)hymba_fwd, hipFuncAttributeMaxDynamicSharedMemorySize, LDS_BYTES) != hipSuccess) { fprintf(stderr, "kernel_launch: hipFuncSetAttribute failed\n"); grid = -1; return; }
        (void)hipGetLastError();
        grid = cus;
    }
    if (grid < 0) return;
    (void)hipMemsetAsync((char*)d_ws + WS_CTL, 0, CTL_ZERO_BYTES, stream);
    Args a{};
    for (int i = 0; i < 24; ++i) a.in[i] = (const float*)d_in[i];
    a.out = (float*)d_out; a.ws = (unsigned char*)d_ws;
#if MK_SINGLE
    a.ph_lo = 0; a.ph_hi = PH_COUNT;
    hipLaunchKernelGGL(hymba_fwd, dim3(grid), dim3(NTHREADS), LDS_BYTES, stream, a);
#else
    for (int p = 0; p < PH_COUNT; ++p) { a.ph_lo = p; a.ph_hi = p + 1; hipLaunchKernelGGL(hymba_fwd, dim3(grid), dim3(NTHREADS), LDS_BYTES, stream, a); }
#endif
}
```

```cpp
#include <hip/hip_runtime.h>
#include <cstdio>
#include <cstdint>
#include <cmath>
namespace pg8 {
#define PG8_LAS __attribute__((address_space(3)))
typedef unsigned short bf16_t;
typedef short bf16x8 __attribute__((ext_vector_type(8)));
typedef float f32x4 __attribute__((ext_vector_type(4)));
typedef unsigned u32x4 __attribute__((ext_vector_type(4)));
constexpr int BM = 256, BK = 64, HALF = 128, HTB = HALF * BK * 2  , STAGE_BYTES = 8 * HTB, NXCD = 8, WGM = 8;

__host__ __device__ __forceinline__ int lds_byte(int r, int c) { const int st = (r >> 4) * 2 + (c >> 5), rr = r & 15, cc = c & 31, ob = rr * 64 + cc * 2; return st * 1024 + (ob ^ (((ob >> 9) & 1) << 5)); }
__host__ __device__ __forceinline__ void stage_rc(int b, int& R, int& C) { const int st = b / 1024, sb = b % 1024, swz = sb ^ (((sb >> 9) & 1) << 5); R = (st >> 1) * 16 + swz / 64; C = (st & 1) * 32 + (swz % 64) / 2; }
__host__ __device__ __forceinline__ int perm32(int rho) { const int n = rho >> 4, i = rho & 15; return 8 * (i >> 2) + 4 * n + (i & 3); }

struct Unit { int pm, pn; };
struct Gemm { const bf16_t* A; const bf16_t* Bt; int M, N, K; };

struct StaticOrder {
    int nM, nN, nwg, G, c;
    __host__ __device__ void init(int M, int N, int G_, int c_) { nM = M / BM; nN = N / BM; nwg = nM * nN; G = G_; c = c_; }
    __host__ __device__ bool next(int i, Unit& u) const {
        const long L = (long)i * G + c; if (L >= nwg) return false;
        int wgid = (int)L; { const int q = nwg / NXCD, r = nwg % NXCD, xcd = wgid % NXCD, off = wgid / NXCD; wgid = (xcd < r ? xcd * (q + 1) : r * (q + 1) + (xcd - r) * q) + off; }
        const int nig = WGM * nN, gid = wgid / nig, fm = gid * WGM, gsz = (nM - fm) < WGM ? (nM - fm) : WGM;
        u.pm = fm + ((wgid % nig) % gsz); u.pn = (wgid % nig) / gsz; return true;
    }
    __device__ __forceinline__ void a_ready(const Unit&) const {}
    __device__ __forceinline__ void done(const Unit&) const {}
};

__device__ __forceinline__ unsigned cvt_pk_bf16(float lo, float hi) { unsigned r; asm volatile("v_cvt_pk_bf16_f32 %0, %1, %2" : "=v"(r) : "v"(lo), "v"(hi)); return r; }
typedef float f32x2 __attribute__((ext_vector_type(2)));
constexpr int MODLD_ = 49152;
__device__ __forceinline__ float fast_sigmoid(float x) { return __builtin_amdgcn_rcpf(1.0f + __expf(-x)); }
struct EpiZ {
    static constexpr bool PERM = true, AFTER_DRAIN = false;
    bf16_t* O; int ldc;
    __device__ __forceinline__ void operator()(const f32x4 (&acc)[2][2][4][2], const Unit& u, int wr, int wc, int fr, int fq) const {
        const int row0 = u.pm * BM + wr * 64 + fr, col0 = u.pn * BM + wc * 32 + 8 * fq;
#pragma unroll
        for (int ai = 0; ai < 2; ++ai)
#pragma unroll
            for (int m = 0; m < 4; ++m) { bf16_t* rowp = O + (size_t)(row0 + ai * HALF + m * 16) * ldc + col0;
#pragma unroll
                for (int bj = 0; bj < 2; ++bj) { const f32x4 v0 = acc[ai][bj][m][0], v1 = acc[ai][bj][m][1];
                    u32x4 w; w.x = cvt_pk_bf16(v0[0], v0[1]); w.y = cvt_pk_bf16(v0[2], v0[3]); w.z = cvt_pk_bf16(v1[0], v1[1]); w.w = cvt_pk_bf16(v1[2], v1[3]);
                    *(u32x4*)(rowp + bj * HALF) = w; } }
    }
};
struct EpiSwiGLU {
    static constexpr bool PERM = true, AFTER_DRAIN = false;
    bf16_t* O; int ldc;
    __device__ __forceinline__ void operator()(const f32x4 (&acc)[2][2][4][2], const Unit& u, int wr, int wc, int fr, int fq) const {
        const int row0 = u.pm * BM + wr * 64 + fr, col0 = u.pn * HALF + wc * 32 + 8 * fq;
#pragma unroll
        for (int ai = 0; ai < 2; ++ai)
#pragma unroll
            for (int m = 0; m < 4; ++m) { bf16_t* rowp = O + (size_t)(row0 + ai * HALF + m * 16) * ldc + col0;
                float r[8];
#pragma unroll
                for (int n = 0; n < 2; ++n)
#pragma unroll
                    for (int i = 0; i < 4; ++i) { const float g = acc[ai][0][m][n][i], up = acc[ai][1][m][n][i]; r[n * 4 + i] = g * fast_sigmoid(g) * up; }
                u32x4 w; w.x = cvt_pk_bf16(r[0], r[1]); w.y = cvt_pk_bf16(r[2], r[3]); w.z = cvt_pk_bf16(r[4], r[5]); w.w = cvt_pk_bf16(r[6], r[7]);
                *(u32x4*)rowp = w; }
    }
};
struct EpiResid {
    static constexpr bool PERM = false, AFTER_DRAIN = false;
    float* X; const float* gate;
    __device__ __forceinline__ void operator()(const f32x4 (&acc)[2][2][4][2], const Unit& u, int wr, int wc, int fr, int fq) const {
        const int col0 = u.pn * BM + wc * 32 + 4 * fq;
        if (u.pm < 32) {
            const float* g = gate + (size_t)(u.pm >> 3) * MODLD_ + col0;
            f32x4 gv[2][2];
#pragma unroll
            for (int bj = 0; bj < 2; ++bj)
#pragma unroll
                for (int n = 0; n < 2; ++n) gv[bj][n] = *(const f32x4*)(g + bj * HALF + n * 16);
#pragma unroll
            for (int ai = 0; ai < 2; ++ai)
#pragma unroll
                for (int m = 0; m < 4; ++m) { float* xp = X + (size_t)(u.pm * BM + ai * HALF + wr * 64 + m * 16 + fr) * 2048 + col0;
#pragma unroll
                    for (int bj = 0; bj < 2; ++bj)
#pragma unroll
                        for (int n = 0; n < 2; ++n) { f32x4 xv = *(const f32x4*)(xp + bj * HALF + n * 16); xv = xv + gv[bj][n] * acc[ai][bj][m][n]; *(f32x4*)(xp + bj * HALF + n * 16) = xv; } }
        } else {
#pragma unroll
            for (int m = 0; m < 4; ++m) { const int rl = wr * 64 + m * 16 + fr;
                const float* g = gate + (size_t)(4 + (rl >> 2)) * MODLD_ + col0; float* xp = X + (size_t)(8192 + rl) * 2048 + col0;
#pragma unroll
                for (int bj = 0; bj < 2; ++bj)
#pragma unroll
                    for (int n = 0; n < 2; ++n) { const f32x4 gvv = *(const f32x4*)(g + bj * HALF + n * 16); f32x4 xv = *(const f32x4*)(xp + bj * HALF + n * 16);
                        xv = xv + gvv * acc[0][bj][m][n]; *(f32x4*)(xp + bj * HALF + n * 16) = xv; } }
        }
    }
};
struct EpiMod {
    static constexpr bool PERM = false, AFTER_DRAIN = false;
    float* M; const float* bias;
    __device__ __forceinline__ void operator()(const f32x4 (&acc)[2][2][4][2], const Unit& u, int wr, int wc, int fr, int fq) const {
        if (wr != 0) return;
        const int col0 = u.pn * BM + wc * 32 + 4 * fq;
#pragma unroll
        for (int m = 0; m < 3; ++m) { const int r = m * 16 + fr;
            if (r < 36) {
#pragma unroll
                for (int bj = 0; bj < 2; ++bj)
#pragma unroll
                    for (int n = 0; n < 2; ++n) { const f32x4 bv = *(const f32x4*)(bias + col0 + bj * HALF + n * 16);
                        *(f32x4*)(M + (size_t)r * MODLD_ + col0 + bj * HALF + n * 16) = acc[0][bj][m][n] + bv; } } }
    }
};

template <class Epi, class Sched, bool ALIGN_EPI = false, bool SP2 = false>
__device__ __forceinline__ void gemm_phase(PG8_LAS unsigned char* lds, const Gemm g, const Sched& S, const Epi& E, int wid_in) {
    int lane_ = (int)__builtin_amdgcn_mbcnt_hi(~0u, __builtin_amdgcn_mbcnt_lo(~0u, 0u)); asm volatile("" : "+v"(lane_));
    const int wid = __builtin_amdgcn_readfirstlane(wid_in), lane = lane_, tid = wid * 64 + lane, wr = wid >> 2, wc = wid & 3, fr = lane & 15, fq = lane >> 4;
    int K_ = g.K; asm volatile("" : "+s"(K_));
    const int K = K_, nt = K / BK;
    unsigned voffA[2], voffB[2];
#pragma unroll
    for (int i = 0; i < 2; ++i) { int R, C; stage_rc(tid * 16 + i * 8192, R, C); const int Rb = Epi::PERM ? ((R & ~31) + perm32(R & 31)) : R;
        voffA[i] = (unsigned)(R * K + C) * 2u; voffB[i] = (unsigned)(Rb * K + C) * 2u; }
    const size_t kstep = (size_t)(BK * 2);
    const size_t hstep = (size_t)HALF * K * 2;
    const size_t tstep = 2 * hstep;
    const unsigned ldsw = (unsigned)wid * 1024u;
    const int aoff = lds_byte(wr * 64 + fr, fq * 8), boff = lds_byte(wc * 32 + fr, fq * 8);
#define PG8_SA(b, h) (((b) * 2 + (h)) * HTB)
#define PG8_SB(b, h) ((4 + (b) * 2 + (h)) * HTB)
#define PG8_STAGE(bufoff, gbase, voff) do { _Pragma("unroll") for (int _i = 0; _i < 2; ++_i) \
        __builtin_amdgcn_global_load_lds((const unsigned*)((const char*)(gbase) + (voff)[_i]), (PG8_LAS unsigned*)(lds + (bufoff) + ldsw + _i * 8192), 16, 0, 0); } while (0)
#define PG8_LDA(dst, b, h) do { _Pragma("unroll") for (int m = 0; m < 4; ++m) _Pragma("unroll") for (int k = 0; k < 2; ++k) dst[m][k] = *(const PG8_LAS bf16x8*)(lds + PG8_SA(b, h) + aoff + m * 2048 + k * 1024); } while (0)
#define PG8_LDB(dst, b, h) do { _Pragma("unroll") for (int n = 0; n < 2; ++n) _Pragma("unroll") for (int k = 0; k < 2; ++k) dst[n][k] = *(const PG8_LAS bf16x8*)(lds + PG8_SB(b, h) + boff + n * 2048 + k * 1024); } while (0)
#define PG8_MMA(ai, bj, At, Bt) do { __builtin_amdgcn_s_setprio(1); _Pragma("unroll") for (int m = 0; m < 4; ++m) _Pragma("unroll") for (int n = 0; n < 2; ++n) _Pragma("unroll") for (int k = 0; k < 2; ++k) \
        acc[ai][bj][m][n] = __builtin_amdgcn_mfma_f32_16x16x32_bf16(Bt[n][k], At[m][k], acc[ai][bj][m][n], 0, 0, 0); __builtin_amdgcn_s_setprio(0); } while (0)
#define PG8_WAIT_V(n) asm volatile("s_waitcnt vmcnt(" #n ")" ::: "memory")
#define PG8_WAIT_L(n) asm volatile("s_waitcnt lgkmcnt(" #n ")" ::: "memory")
#define PG8_BAR __builtin_amdgcn_s_barrier()
#define PG8_SCHED __builtin_amdgcn_sched_barrier(0)
    Unit cur, nxt; int ui = 0;
    if (!S.next(0, cur)) return;
    f32x4 acc[2][2][4][2];
#pragma unroll
    for (int a = 0; a < 2; ++a)
#pragma unroll
        for (int b = 0; b < 2; ++b)
#pragma unroll
            for (int m = 0; m < 4; ++m)
#pragma unroll
                for (int n = 0; n < 2; ++n) acc[a][b][m][n] = (f32x4){0.f, 0.f, 0.f, 0.f};
    bf16x8 At[4][2], B0[2][2], B1[2][2];
    const char* cA = (const char*)g.A + (size_t)cur.pm * tstep; const char* cB = (const char*)g.Bt + (size_t)cur.pn * tstep;
    S.a_ready(cur);
    if constexpr (SP2) {
        PG8_STAGE(PG8_SB(0, 0), cB, voffB); PG8_STAGE(PG8_SB(0, 1), cB + hstep, voffB); PG8_STAGE(PG8_SA(0, 0), cA, voffA); PG8_STAGE(PG8_SA(0, 1), cA + hstep, voffA);
        if (wr == 1) PG8_BAR;
        PG8_WAIT_V(2); PG8_BAR;
        PG8_STAGE(PG8_SB(1, 0), cB + kstep, voffB); PG8_STAGE(PG8_SA(1, 0), cA + kstep, voffA); PG8_STAGE(PG8_SB(1, 1), cB + hstep + kstep, voffB);
        PG8_WAIT_V(6); PG8_BAR;
    } else {
        PG8_STAGE(PG8_SB(0, 0), cB, voffB); PG8_STAGE(PG8_SA(0, 0), cA, voffA); PG8_STAGE(PG8_SB(0, 1), cB + hstep, voffB); PG8_STAGE(PG8_SA(0, 1), cA + hstep, voffA);
        if (wr == 1) PG8_BAR;
        PG8_WAIT_V(4); PG8_BAR;
        PG8_STAGE(PG8_SB(1, 0), cB + kstep, voffB); PG8_STAGE(PG8_SA(1, 0), cA + kstep, voffA); PG8_STAGE(PG8_SB(1, 1), cB + hstep + kstep, voffB);
        PG8_WAIT_V(6); PG8_BAR;
    }
    for (;;) {
        const bool has_next = S.next(ui + 1, nxt);
        const char* nA = has_next ? (const char*)g.A + (size_t)nxt.pm * tstep : cA; const char* nB = has_next ? (const char*)g.Bt + (size_t)nxt.pn * tstep : cB;
        for (int t = 0; t < nt; t += 2) {
            const bool last = (t == nt - 2);
            const char* a1 = cA + (size_t)(t + 1) * kstep;
            const char* a2 = last ? nA : cA + (size_t)(t + 2) * kstep; const char* b2 = last ? nB : cB + (size_t)(t + 2) * kstep;
            const char* a3 = a2 + kstep; const char* b3 = b2 + kstep;
            if (last && has_next) S.a_ready(nxt);
            if constexpr (SP2) {
            PG8_LDB(B0, 0, 0); PG8_LDB(B1, 0, 1); PG8_SCHED; PG8_LDA(At, 0, 0); PG8_STAGE(PG8_SA(1, 1), a1 + hstep, voffA);
            PG8_WAIT_V(8); PG8_WAIT_L(0); PG8_BAR; PG8_MMA(0, 0, At, B0); PG8_MMA(0, 1, At, B1); PG8_BAR; PG8_SCHED;
            PG8_LDA(At, 0, 1); PG8_STAGE(PG8_SB(0, 0), b2, voffB); PG8_STAGE(PG8_SB(0, 1), b2 + hstep, voffB); PG8_STAGE(PG8_SA(0, 0), a2, voffA);
            PG8_WAIT_V(8); PG8_WAIT_L(0); PG8_BAR; PG8_MMA(1, 0, At, B0); PG8_MMA(1, 1, At, B1); PG8_BAR; PG8_SCHED;
            PG8_LDB(B0, 1, 0); PG8_LDB(B1, 1, 1); PG8_SCHED; PG8_LDA(At, 1, 0); PG8_STAGE(PG8_SA(0, 1), a2 + hstep, voffA);
            PG8_WAIT_V(8); PG8_WAIT_L(0); PG8_BAR; PG8_MMA(0, 0, At, B0); PG8_MMA(0, 1, At, B1); PG8_BAR; PG8_SCHED;
            PG8_LDA(At, 1, 1); PG8_STAGE(PG8_SB(1, 0), b3, voffB); PG8_STAGE(PG8_SB(1, 1), b3 + hstep, voffB); PG8_STAGE(PG8_SA(1, 0), a3, voffA);
            PG8_WAIT_V(8); PG8_WAIT_L(0); PG8_BAR; PG8_MMA(1, 0, At, B0); PG8_MMA(1, 1, At, B1); PG8_BAR; PG8_SCHED;
            } else {
            PG8_LDB(B0, 0, 0); PG8_SCHED; PG8_LDA(At, 0, 0); PG8_STAGE(PG8_SA(1, 1), a1 + hstep, voffA);
            PG8_WAIT_L(8); PG8_BAR; PG8_WAIT_L(0); PG8_MMA(0, 0, At, B0); PG8_BAR; PG8_SCHED;
            PG8_LDB(B1, 0, 1); PG8_STAGE(PG8_SB(0, 0), b2, voffB);
            PG8_BAR; PG8_WAIT_L(0); PG8_MMA(0, 1, At, B1); PG8_BAR;
            PG8_LDA(At, 0, 1); PG8_STAGE(PG8_SA(0, 0), a2, voffA);
            PG8_BAR; PG8_WAIT_L(0); PG8_MMA(1, 0, At, B0); PG8_BAR; PG8_SCHED;
            PG8_STAGE(PG8_SB(0, 1), b2 + hstep, voffB);
            PG8_WAIT_V(6); PG8_BAR; PG8_MMA(1, 1, At, B1); PG8_BAR;
            PG8_LDB(B0, 1, 0); PG8_SCHED; PG8_LDA(At, 1, 0); PG8_STAGE(PG8_SA(0, 1), a2 + hstep, voffA);
            PG8_WAIT_L(8); PG8_BAR; PG8_WAIT_L(0); PG8_MMA(0, 0, At, B0); PG8_BAR; PG8_SCHED;
            PG8_LDB(B1, 1, 1); PG8_STAGE(PG8_SB(1, 0), b3, voffB);
            PG8_BAR; PG8_WAIT_L(0); PG8_MMA(0, 1, At, B1); PG8_BAR;
            PG8_LDA(At, 1, 1); PG8_STAGE(PG8_SA(1, 0), a3, voffA);
            PG8_BAR; PG8_WAIT_L(0); PG8_MMA(1, 0, At, B0); PG8_BAR; PG8_SCHED;
            PG8_STAGE(PG8_SB(1, 1), b3 + hstep, voffB);
            PG8_WAIT_V(6); PG8_BAR; PG8_MMA(1, 1, At, B1); PG8_BAR;
            }
        }
        if constexpr (ALIGN_EPI) { if (wr == 0) PG8_BAR; }
        if constexpr (!Epi::AFTER_DRAIN) { E(acc, cur, wr, wc, fr, fq); S.done(cur); }
        if (!has_next) break;
#pragma unroll
        for (int a = 0; a < 2; ++a)
#pragma unroll
            for (int b = 0; b < 2; ++b)
#pragma unroll
                for (int m = 0; m < 4; ++m)
#pragma unroll
                    for (int n = 0; n < 2; ++n) acc[a][b][m][n] = (f32x4){0.f, 0.f, 0.f, 0.f};
        cur = nxt; cA = nA; cB = nB; ++ui;
        if constexpr (ALIGN_EPI) { if (wr == 1) PG8_BAR; }
    }
    PG8_WAIT_V(0);
    if constexpr (!ALIGN_EPI) { if (wr == 0) PG8_BAR; }
    PG8_BAR;
    if constexpr (Epi::AFTER_DRAIN) { E.fused(acc, cur, wr, wc, fr, fq, lds, wid, lane); S.done(cur); }
#undef PG8_SA
#undef PG8_SB
#undef PG8_STAGE
#undef PG8_LDA
#undef PG8_LDB
#undef PG8_MMA
#undef PG8_WAIT_V
#undef PG8_WAIT_L
#undef PG8_BAR
#undef PG8_SCHED
}
}
#define GAS __attribute__((address_space(1)))
#define LAS __attribute__((address_space(3)))
typedef unsigned short bf16;
typedef unsigned v4u __attribute__((ext_vector_type(4)));
typedef float f32x4 __attribute__((ext_vector_type(4)));
typedef short bf16x8 __attribute__((ext_vector_type(8)));
typedef GAS unsigned gu32;
typedef GAS unsigned long long gu64;
#define RLX_AGENT __ATOMIC_RELAXED, __HIP_MEMORY_SCOPE_AGENT
#define LDS_WAIT() asm volatile("s_waitcnt lgkmcnt(0)" ::: "memory")
#define VM_WAIT() asm volatile("s_waitcnt vmcnt(0)" ::: "memory")
__device__ __forceinline__ unsigned long long rt() { return __builtin_amdgcn_s_memrealtime(); }
__device__ __forceinline__ unsigned f2bf(float f) { unsigned u = __builtin_bit_cast(unsigned, f); return (u + 0x7fffu + ((u >> 16) & 1u)) >> 16; }
__device__ __forceinline__ unsigned pk2(float lo, float hi) { return f2bf(lo) | (f2bf(hi) << 16); }

#define XB_TMO      128
#define XB_XCNT(j)  (256  + 64 * (j))
#define XB_XSUB(j)  (1280 + 64 * (j))
#define XB_XGEN(j)  (2304 + 64 * (j))
#define XB_TOP      3328
#define XB_TOPGEN   3392
#define XCD_BAR_WORDS 3456
#define XB_SPIN_CAP (1u << 18)

__device__ __forceinline__ unsigned xb_ld(unsigned* p)              { return __hip_atomic_load(p, __ATOMIC_RELAXED, __HIP_MEMORY_SCOPE_AGENT); }
__device__ __forceinline__ unsigned xb_add(unsigned* p, unsigned v) { return __hip_atomic_fetch_add(p, v, __ATOMIC_RELAXED, __HIP_MEMORY_SCOPE_AGENT); }
__device__ __forceinline__ unsigned xb_xcc_id() { return (unsigned)__builtin_amdgcn_s_getreg((3 << 11) | 20) & 0xFu; }
#define XB_SPIN(cond, bar) do { unsigned _sp = 0; while (cond) { __builtin_amdgcn_s_sleep(1); \
    if ((++_sp & 255u) == 0u) { if (xb_ld(&(bar)[XB_TMO])) break; if (_sp > XB_SPIN_CAP) { atomicAdd(&(bar)[XB_TMO], 1u); break; } } } } while (0)

struct XcdBarrier {
    unsigned* bar; unsigned x;
    volatile LAS unsigned* st;
};

__device__ __forceinline__ XcdBarrier xcd_barrier_post(unsigned* bar, volatile LAS unsigned* st) {
    XcdBarrier b; b.bar = bar; b.x = xb_xcc_id(); b.st = st;
    if (threadIdx.x == 0) (void)xb_add(&bar[XB_XCNT(b.x)], 1u);
    return b;
}
__device__ __forceinline__ void xcd_barrier_complete(unsigned* bar, unsigned x, unsigned& nloc, unsigned& nx) {
    const unsigned G = gridDim.x * gridDim.y * gridDim.z;
    unsigned sum, cnt, mine, sp = 0u;
    for (;;) {
        sum = 0u; cnt = 0u; mine = 0u;
#pragma unroll
        for (unsigned j = 0; j < 16; ++j) { const unsigned c = xb_ld(&bar[XB_XCNT(j)]); sum += c; cnt += (c > 0u) ? 1u : 0u; mine = (j == x) ? c : mine; }
        if (sum == G) break;
        __builtin_amdgcn_s_sleep(1);
        if ((++sp & 255u) == 0u) { if (xb_ld(&bar[XB_TMO])) break; if (sp > XB_SPIN_CAP) { atomicAdd(&bar[XB_TMO], 1u); break; } }
    }
    nloc = mine > 0u ? mine : 1u; nx = cnt > 0u ? cnt : 1u;
}

__device__ __forceinline__ void xcd_barrier(const XcdBarrier& b) {
    asm volatile("s_waitcnt vmcnt(0)" ::: "memory");
    __syncthreads();
    if (threadIdx.x == 0) {
        unsigned* bar = b.bar;
        __builtin_amdgcn_s_waitcnt(0);
        unsigned nloc = b.st[0], nx = b.st[1];
        if (nloc == 0u) { xcd_barrier_complete(bar, b.x, nloc, nx); b.st[0] = nloc; b.st[1] = nx; }
        const unsigned old = xb_add(&bar[XB_XSUB(b.x)], 1u);
        const unsigned gen = old / nloc;
        if (old + 1u == (gen + 1u) * nloc) {
            __builtin_amdgcn_fence(__ATOMIC_RELEASE, "agent");
            asm volatile("s_waitcnt vmcnt(0)" ::: "memory");
            const unsigned og = xb_add(&bar[XB_TOP], 1u);
            const unsigned tg = og / nx;
            if (og + 1u == (tg + 1u) * nx) xb_add(&bar[XB_TOPGEN], 1u);
            else XB_SPIN(xb_ld(&bar[XB_TOPGEN]) == tg, bar);
            __builtin_amdgcn_fence(__ATOMIC_ACQUIRE, "agent");
            xb_add(&bar[XB_XGEN(b.x)], 1u);
            asm volatile("s_waitcnt vmcnt(0)" ::: "memory");
        } else {
            XB_SPIN(xb_ld(&bar[XB_XGEN(b.x)]) == gen, bar);
            __builtin_amdgcn_fence(__ATOMIC_ACQUIRE, "agent");
            asm volatile("s_waitcnt vmcnt(0)" ::: "memory");
        }
    }
    __syncthreads();
}

constexpr int NWAVES = 8, NTHREADS = 512;
constexpr int DM = 2048, NP_ROWS = 8192, NS_ROWS = 128, NROWS = 8320, MPAD = 8448;
constexpr int DEPTH = 4, NBATCH = 36;
constexpr int INW = 4368, ZW = 4608;
constexpr int ZQ = 0, ZK = 512, ZV = 640, ZU = 768, GQ = 1280, GK = 1792, GV = 2304, GG = 3328, GA = 4352;
constexpr int DFF = 5632, NGU = 11264, MODW = 12288, MODLD = 49152;
constexpr float EPS = 1e-6f;
constexpr size_t O_Y = 0, O_WK_P = 17039360, O_WV_P = 17301504, O_POOL_P = 17563648, O_GLA_P = 17686528,
                 O_WK_S = 19783680, O_WV_S = 21880832, O_POOL_S = 23977984, O_GLA_S = 24961024, O_END = 41738240;
constexpr size_t MiB = 1u << 20;
constexpr size_t WS_CTL = 0, CTL_ZERO_BYTES = 1 * MiB;
constexpr size_t WS_WADA = 1 * MiB;
constexpr size_t WS_WIN  = WS_WADA + 192 * MiB;
constexpr size_t WS_WOUT = WS_WIN + 72 * MiB;
constexpr size_t WS_WGU  = WS_WOUT + 32 * MiB;
constexpr size_t WS_WDN  = WS_WGU + 176 * MiB;
constexpr size_t WS_X    = WS_WDN + 88 * MiB;
constexpr size_t WS_H    = WS_X + 66 * MiB;
constexpr size_t WS_Z    = WS_H + 33 * MiB;
constexpr size_t WS_MIX  = WS_Z + 75 * MiB;
constexpr size_t WS_ACT  = WS_MIX + 33 * MiB;
constexpr size_t WS_OGLA = WS_ACT + 91 * MiB;
constexpr size_t WS_LA   = WS_OGLA + 33 * MiB;
constexpr size_t WS_MOD  = WS_LA + 17 * MiB;
constexpr size_t WS_SC   = WS_MOD + 7 * MiB;
constexpr size_t WS_BTAB = WS_SC + 1 * MiB;
constexpr size_t WS_WPT  = WS_BTAB + 1 * MiB;
constexpr size_t WS_END  = WS_WPT + 1 * MiB;
constexpr int CW_BAR = 4096;
constexpr int RING_OFF = 0, RING_BYTES = 131072;
constexpr int LDSCTL_OFF = RING_BYTES, MISC_OFF = LDSCTL_OFF + 320;
constexpr int LDS_BYTES = 147456;

struct Args { const float* in[24]; float* out; unsigned char* ws; int ph_lo, ph_hi; };
struct Frame {
    LAS unsigned char* lds;
    volatile LAS unsigned* MISC;
    int wave, vcu, G; int zo;
    __device__ __forceinline__ int lane_id() const { return (int)__builtin_amdgcn_mbcnt_hi(~0u, __builtin_amdgcn_mbcnt_lo(~0u, 0u)); }
    unsigned char* ws; float* out;
    __device__ __forceinline__ bf16* Wada_t() const { return (bf16*)(ws + WS_WADA); }
    __device__ __forceinline__ bf16* Win_t() const { return (bf16*)(ws + WS_WIN); }
    __device__ __forceinline__ bf16* Wout_t() const { return (bf16*)(ws + WS_WOUT); }
    __device__ __forceinline__ bf16* Wgu_t() const { return (bf16*)(ws + WS_WGU); }
    __device__ __forceinline__ bf16* Wdn_t() const { return (bf16*)(ws + WS_WDN); }
    __device__ __forceinline__ float* X() const { return (float*)(ws + WS_X); }
    __device__ __forceinline__ bf16* H() const { return (bf16*)(ws + WS_H); }
    __device__ __forceinline__ bf16* Z() const { return (bf16*)(ws + WS_Z); }
    __device__ __forceinline__ bf16* MIX() const { return (bf16*)(ws + WS_MIX); }
    __device__ __forceinline__ bf16* ACT() const { return (bf16*)(ws + WS_ACT); }
    __device__ __forceinline__ float* OGLA() const { return (float*)(ws + WS_OGLA); }
    __device__ __forceinline__ float* SLOC() const { return (float*)(ws + WS_LA); }
    __device__ __forceinline__ float* DSEG() const { return (float*)(ws + WS_LA + 16 * MiB); }
    __device__ __forceinline__ float* MOD() const { return (float*)(ws + WS_MOD); }
    __device__ __forceinline__ bf16* SC() const { return (bf16*)(ws + WS_SC); }
    __device__ __forceinline__ float* BTAB() const { return (float*)(ws + WS_BTAB); }
    __device__ __forceinline__ bf16* WPT() const { return (bf16*)(ws + WS_WPT); }
};
enum { I_XP = 0, I_XS, I_CK, I_CV, I_SPOOL, I_SGLA, I_CP, I_CS, I_WADA, I_BADA, I_GMIX, I_GFFN, I_WIN, I_WOUT, I_RELB, I_SINKS, I_WPOOL, I_PSCALE, I_WA2, I_BA2, I_GGLA, I_WGU, I_WDN, I_GFIN };

__device__ __forceinline__ float bf2f(unsigned short b) { return __uint_as_float((unsigned)b << 16); }
__device__ __forceinline__ float bflo(unsigned w) { return __uint_as_float(w << 16); }
__device__ __forceinline__ float bfhi(unsigned w) { return __uint_as_float(w & 0xffff0000u); }
__device__ __forceinline__ float wave_sum(float v) {
#pragma unroll
    for (int o = 1; o < 64; o <<= 1) v += __shfl_xor(v, o);
    return v;
}
__device__ __forceinline__ float wave_max(float v) {
#pragma unroll
    for (int o = 1; o < 64; o <<= 1) v = fmaxf(v, __shfl_xor(v, o));
    return v;
}
__device__ __forceinline__ int t5_bucket(int n) {
    if (n < 16) return n;
    return 16 + (n >= 19) + (n >= 21) + (n >= 24) + (n >= 27) + (n >= 31) + (n >= 35) + (n >= 40) + (n >= 46) + (n >= 52) + (n >= 59) + (n >= 67) + (n >= 77) + (n >= 87) + (n >= 99) + (n >= 113);
}

template <int MODE>
__device__ __forceinline__ void transpose_item(const float* W, int K, int N, int nblk, bf16* WT, int row_off, LAS float* scr, int item, int lane) {
    const int kb = item / nblk, nb = item % nblk, k0 = 64 * kb, n0 = 32 * nb;
    const int nn = n0 + (lane & 31); const bool ok = nn < N;
#pragma unroll 8
    for (int i = 0; i < 32; ++i) { const int kk = 2 * i + (lane >> 5); scr[kk * 33 + (lane & 31)] = ok ? W[(size_t)(k0 + kk) * N + nn] : 0.f; }
    LDS_WAIT(); asm volatile("" ::: "memory");
    const int c = lane & 7;
#pragma unroll
    for (int j = 0; j < 4; ++j) { const int n = (lane >> 3) + 8 * j; const LAS float* s = scr + (8 * c) * 33 + n;
        v4u o; o.x = pk2(s[0 * 33], s[1 * 33]); o.y = pk2(s[2 * 33], s[3 * 33]); o.z = pk2(s[4 * 33], s[5 * 33]); o.w = pk2(s[6 * 33], s[7 * 33]);
        int orow = n0 + n;
        if (MODE == 1) { orow = (orow < DFF) ? ((orow >> 7) * 256 + (orow & 127)) : (((orow - DFF) >> 7) * 256 + 128 + ((orow - DFF) & 127)); }
        *(GAS v4u*)(WT + (size_t)(row_off + orow) * K + k0 + 8 * c) = o; }
    LDS_WAIT(); asm volatile("" ::: "memory");
}
__device__ __forceinline__ void p0_prologue(Frame& F, const Args& A) {
    LAS float* scr = (LAS float*)(F.lds + RING_OFF + F.wave * 16384);
    const int gw = F.vcu * NWAVES + F.wave, NGW = F.G * NWAVES;
    const int gt = gw * 64 + F.lane_id(), NGT = NGW * 64;
    constexpr int I_ADA = 32 * 384, I_IN = 32 * 137, I_OUT = 32 * 64, I_GU = 32 * 352, I_DN = 88 * 64, I_L = I_ADA + I_IN + I_OUT + I_GU + I_DN;
    for (int it = gw; it < DEPTH * I_L; it += NGW) {
        const int l = it / I_L; int r = it - l * I_L;
        if (r < I_ADA) { transpose_item<0>(A.in[F.zo + I_WADA] + (size_t)l * DM * MODW, DM, MODW, 384, F.Wada_t(), l * MODW, scr, r, F.lane_id()); continue; } r -= I_ADA;
        if (r < I_IN)  { transpose_item<0>(A.in[F.zo + I_WIN] + (size_t)l * DM * INW, DM, INW, 137, F.Win_t() + (size_t)l * ZW * DM, 0, scr, r, F.lane_id()); continue; } r -= I_IN;
        if (r < I_OUT) { transpose_item<0>(A.in[F.zo + I_WOUT] + (size_t)l * DM * DM, DM, DM, 64, F.Wout_t() + (size_t)l * DM * DM, 0, scr, r, F.lane_id()); continue; } r -= I_OUT;
        if (r < I_GU)  { transpose_item<1>(A.in[F.zo + I_WGU] + (size_t)l * DM * NGU, DM, NGU, 352, F.Wgu_t() + (size_t)l * NGU * DM, 0, scr, r, F.lane_id()); continue; } r -= I_GU;
        transpose_item<0>(A.in[F.zo + I_WDN] + (size_t)l * DFF * DM, DFF, DM, 64, F.Wdn_t() + (size_t)l * DM * DFF, 0, scr, r, F.lane_id());
    }
    const v4u z4 = {0u, 0u, 0u, 0u};
    for (int i = gt; i < DEPTH * 224 * 256; i += NGT) { const int l = i / (224 * 256), r = i - l * (224 * 256); *((GAS v4u*)(F.Win_t() + ((size_t)l * ZW + 4384) * DM) + r) = z4; }
    for (int i = gt; i < 128 * 256; i += NGT) { *((GAS v4u*)(F.H() + (size_t)NROWS * DM) + i) = z4; *((GAS v4u*)(F.MIX() + (size_t)NROWS * DM) + i) = z4; }
    for (int i = gt; i < 128 * 704; i += NGT) *((GAS v4u*)(F.ACT() + (size_t)NROWS * DFF) + i) = z4;
    for (int i = gt; i < NP_ROWS * 512; i += NGT) ((GAS f32x4*)F.X())[i] = ((const GAS f32x4*)A.in[F.zo + I_XP])[i];
    for (int i = gt; i < NS_ROWS * 512; i += NGT) ((GAS f32x4*)(F.X() + (size_t)NP_ROWS * DM))[i] = ((const GAS f32x4*)A.in[F.zo + I_XS])[i];
    for (int i = gt; i < 256 * 1024; i += NGT) { const int r = i >> 10, cp = (i & 1023) * 2; unsigned w = 0u;
        if (r < NBATCH) { const float* c = (r < 4) ? (A.in[F.zo + I_CP] + (size_t)r * DM) : (A.in[F.zo + I_CS] + (size_t)(r - 4) * DM); const float a = c[cp], b = c[cp + 1];
            w = pk2(a / (1.0f + __expf(-a)), b / (1.0f + __expf(-b))); }
        ((GAS unsigned*)F.SC())[i] = w; }
    for (int i = gt; i < 4 * 4 * 128 * 128; i += NGT) { const int lg = i >> 14, dcol = (i >> 7) & 127, c = i & 127; F.WPT()[i] = (bf16)f2bf(A.in[F.zo + I_WPOOL][((size_t)lg * 128 + c) * 128 + dcol]); }
    for (int i = gt; i < 8 * 128; i += NGT) { const int h = i >> 7, dist = i & 127; F.BTAB()[i] = A.in[F.zo + I_RELB][t5_bucket(dist) * 8 + h]; }
}

__device__ __forceinline__ void norm_mod_rows(Frame& F, const float* g, const float* modl  ) {
    const int gw = F.vcu * NWAVES + F.wave, NGW = F.G * NWAVES;
    for (int r = gw; r < NROWS; r += NGW) {
        const int b = r < NP_ROWS ? (r >> 11) : 4 + ((r - NP_ROWS) >> 2);
        const float* xr = F.X() + (size_t)r * DM + 4 * F.lane_id(); const float* sh = modl + (size_t)b * MODLD + 4 * F.lane_id(); const float* gg = g + 4 * F.lane_id();
        f32x4 v[8]; float ss = 0.f;
#pragma unroll
        for (int j = 0; j < 8; ++j) { v[j] = *(const f32x4*)(xr + 256 * j); ss += (v[j].x * v[j].x + v[j].y * v[j].y) + (v[j].z * v[j].z + v[j].w * v[j].w); }
        const float rstd = 1.0f / sqrtf(wave_sum(ss) * (1.0f / DM) + EPS);
        bf16* hr = F.H() + (size_t)r * DM + 4 * F.lane_id();
#pragma unroll
        for (int j = 0; j < 8; ++j) { const f32x4 gv = *(const f32x4*)(gg + 256 * j), sv = *(const f32x4*)(sh + 256 * j), cv = *(const f32x4*)(sh + 2048 + 256 * j);
            const f32x4 y = (v[j] * rstd * gv) * (1.0f + cv) + sv;
            uint2 w; w.x = pk2(y.x, y.y); w.y = pk2(y.z, y.w); *(uint2*)(hr + 256 * j) = w; }
    }
}
__device__ __forceinline__ void final_norm_rows(Frame& F, const Args& A) {
    const int gw = F.vcu * NWAVES + F.wave, NGW = F.G * NWAVES; const float* g = A.in[F.zo + I_GFIN] + 4 * F.lane_id();
    for (int r = gw; r < NROWS; r += NGW) {
        const float* xr = F.X() + (size_t)r * DM + 4 * F.lane_id();
        f32x4 v[8]; float ss = 0.f;
#pragma unroll
        for (int j = 0; j < 8; ++j) { v[j] = *(const f32x4*)(xr + 256 * j); ss += (v[j].x * v[j].x + v[j].y * v[j].y) + (v[j].z * v[j].z + v[j].w * v[j].w); }
        const float rstd = 1.0f / sqrtf(wave_sum(ss) * (1.0f / DM) + EPS);
        float* yr = F.out + O_Y + (size_t)r * DM + 4 * F.lane_id();
#pragma unroll
        for (int j = 0; j < 8; ++j) { const f32x4 gv = *(const f32x4*)(g + 256 * j); *(f32x4*)(yr + 256 * j) = v[j] * rstd * gv; }
    }
}

__device__ __forceinline__ void attn_item(Frame& F, const Args& A, int l, int r, int hd, LAS float* ps) {
    const int lane = F.lane_id(), g = hd >> 2; const bool smp = r >= NP_ROWS;
    const int t = r & 2047, sb = smp ? ((r - NP_ROWS) >> 2) : 0, si = (r - NP_ROWS) & 3;
    LAS float* qs = ps + 128;
    { const unsigned w = ((const unsigned*)(F.Z() + (size_t)r * ZW + ZQ + hd * 64))[lane & 31]; if (lane < 32) { qs[2 * lane] = bflo(w); qs[2 * lane + 1] = bfhi(w); } }
    LDS_WAIT(); asm volatile("" ::: "memory");
    const float* ck = A.in[F.zo + I_CK] + ((size_t)(l * 32 + sb) * 128) * 128 + g * 64;
    const float* cv = A.in[F.zo + I_CV] + ((size_t)(l * 32 + sb) * 128) * 128 + g * 64;
    const int jmin = smp ? 0 : (t >= 127 ? 0 : 127 - t);
    float sc[2];
#pragma unroll 1
    for (int jj = 0; jj < 2; ++jj) {
        const int j = lane + 64 * jj, dist = 127 - j; float dot = 0.f; bool valid = j >= jmin;
        if (valid) {
            const int krel = si - dist;
            if (smp && krel < 0) {
                const f32x4* kp = (const f32x4*)(ck + (size_t)(krel + 128) * 128);
#pragma unroll 4
                for (int c = 0; c < 16; ++c) { const f32x4 kv = kp[c]; const f32x4 qv = *(const LAS f32x4*)(qs + 4 * c); dot += qv.x * kv.x + qv.y * kv.y + qv.z * kv.z + qv.w * kv.w; }
            } else {
                const int krow = smp ? (NP_ROWS + sb * 4 + krel) : (r - dist);
                const v4u* kp = (const v4u*)(F.Z() + (size_t)krow * ZW + ZK + g * 64);
#pragma unroll 4
                for (int c = 0; c < 8; ++c) { const v4u w = kp[c];
                    const f32x4 qa = *(const LAS f32x4*)(qs + 8 * c), qb = *(const LAS f32x4*)(qs + 8 * c + 4);
                    dot += qa.x * bflo(w.x) + qa.y * bfhi(w.x) + qa.z * bflo(w.y) + qa.w * bfhi(w.y) + qb.x * bflo(w.z) + qb.y * bfhi(w.z) + qb.z * bflo(w.w) + qb.w * bfhi(w.w); }
            }
        }
        const float sv = valid ? dot * 0.125f + F.BTAB()[hd * 128 + dist] : -INFINITY;
        if (jj == 0) sc[0] = sv; else sc[1] = sv;
    }
    const float sink = A.in[F.zo + I_SINKS][l * 8 + hd];
    const float m = fmaxf(wave_max(fmaxf(sc[0], sc[1])), sink);
    const float p0 = __expf(sc[0] - m), p1 = __expf(sc[1] - m);
    const float denom = wave_sum(p0 + p1) + __expf(sink - m);
    ps[lane] = p0; ps[lane + 64] = p1;
    LDS_WAIT(); asm volatile("" ::: "memory");
    float o = 0.f;
    for (int j = jmin; j < 128; ++j) {
        const float pj = ps[j]; const int dist = 127 - j; float vv;
        const int krel = si - dist;
        if (smp && krel < 0) vv = cv[(size_t)(krel + 128) * 128 + lane];
        else { const int krow = smp ? (NP_ROWS + sb * 4 + krel) : (r - dist); vv = bf2f(F.Z()[(size_t)krow * ZW + ZV + g * 64 + lane]); }
        o += pj * vv;
    }
    F.MIX()[(size_t)r * DM + hd * 64 + lane] = (bf16)f2bf(o / denom);
    LDS_WAIT(); asm volatile("" ::: "memory");
}
__device__ __forceinline__ void pool_item(Frame& F, const Args& A, int l, int r, int gi, LAS float* ds) {
    const int lane = F.lane_id(), w = 2 << gi; const bool smp = r >= NP_ROWS;
    const int t = r & 2047, sb = (r - NP_ROWS) >> 2, si = (r - NP_ROWS) & 3;
    const float* pbuf = A.in[F.zo + I_SPOOL] + ((size_t)(l * 32 + sb) * 15) * 512 + gi * 128;
    float s0 = 0.f, s1 = 0.f, u0 = 0.f, u1 = 0.f;
    for (int o = 0; o < w; ++o) {
        float a0 = 0.f, a1 = 0.f;
        if (!smp) { if (t - o >= 0) { const bf16* zp = F.Z() + (size_t)(r - o) * ZW + ZU + gi * 128; a0 = bf2f(zp[lane]); a1 = bf2f(zp[lane + 64]); } }
        else { const int idx = si - o;
            if (idx >= 0) { const bf16* zp = F.Z() + (size_t)(NP_ROWS + sb * 4 + idx) * ZW + ZU + gi * 128; a0 = bf2f(zp[lane]); a1 = bf2f(zp[lane + 64]); }
            else { const float* bp = pbuf + (size_t)(15 + idx) * 512; a0 = bp[lane]; a1 = bp[lane + 64]; } }
        if (o == 0) { u0 = a0; u1 = a1; }
        s0 += a0; s1 += a1;
    }
    const float cnt = smp ? (float)w : (float)((t + 1) < w ? (t + 1) : w);
    ds[lane] = s0 / cnt - u0; ds[lane + 64] = s1 / cnt - u1;
    LDS_WAIT(); asm volatile("" ::: "memory");
    const float* wp = A.in[F.zo + I_WPOOL] + ((size_t)(l * 4 + gi) * 128) * 128;
    float y0 = 0.f, y1 = 0.f;
#pragma unroll 4
    for (int c = 0; c < 128; ++c) { const float dv = ds[c]; y0 += dv * wp[c * 128 + lane]; y1 += dv * wp[c * 128 + lane + 64]; }
    const float* psc = A.in[F.zo + I_PSCALE] + l * 512 + gi * 128;
    bf16* mp = F.MIX() + (size_t)r * DM + 512 + gi * 128;
    mp[lane] = (bf16)f2bf(y0 * psc[lane]); mp[lane + 64] = (bf16)f2bf(y1 * psc[lane + 64]);
    LDS_WAIT(); asm volatile("" ::: "memory");
}
__device__ __forceinline__ void cache_outputs(Frame& F, const Args& A, int l) {
    const int gt = (F.vcu * NWAVES + F.wave) * 64 + F.lane_id(), NGT = F.G * NWAVES * 64;
    for (int i = gt; i < 4 * 128 * 128; i += NGT) { const int b = i >> 14, j = (i >> 7) & 127, c = i & 127; const bf16* zr = F.Z() + (size_t)(b * 2048 + 1920 + j) * ZW;
        F.out[O_WK_P + (size_t)l * 65536 + i] = bf2f(zr[ZK + c]); F.out[O_WV_P + (size_t)l * 65536 + i] = bf2f(zr[ZV + c]); }
    for (int i = gt; i < 4 * 15 * 512; i += NGT) { const int b = i / 7680, rem = i - b * 7680, j = rem >> 9, c = rem & 511;
        F.out[O_POOL_P + (size_t)l * 30720 + i] = bf2f(F.Z()[(size_t)(b * 2048 + 2033 + j) * ZW + ZU + c]); }
    for (int i = gt; i < 32 * 128 * 128; i += NGT) { const int sb = i >> 14, p = (i >> 7) & 127, c = i & 127; float kv, vv;
        if (p < 124) { const size_t src = ((size_t)(l * 32 + sb) * 128 + p + 4) * 128 + c; kv = A.in[F.zo + I_CK][src]; vv = A.in[F.zo + I_CV][src]; }
        else { const bf16* zr = F.Z() + (size_t)(NP_ROWS + sb * 4 + p - 124) * ZW; kv = bf2f(zr[ZK + c]); vv = bf2f(zr[ZV + c]); }
        F.out[O_WK_S + (size_t)l * 524288 + i] = kv; F.out[O_WV_S + (size_t)l * 524288 + i] = vv; }
    for (int i = gt; i < 32 * 15 * 512; i += NGT) { const int sb = i / 7680, rem = i - sb * 7680, j = rem >> 9, c = rem & 511; float v;
        if (j < 11) v = A.in[F.zo + I_SPOOL][((size_t)(l * 32 + sb) * 15 + j + 4) * 512 + c];
        else v = bf2f(F.Z()[(size_t)(NP_ROWS + sb * 4 + j - 11) * ZW + ZU + c]);
        F.out[O_POOL_S + (size_t)l * 245760 + i] = v; }
}
__device__ __forceinline__ void gla_out_item(Frame& F, const Args& A, int l, int r, int hh) {
    const int lane = F.lane_id();
    const f32x4 o = *(const f32x4*)(F.OGLA() + (size_t)r * 1024 + hh * 256 + 4 * lane);
    const float ss = wave_sum((o.x * o.x + o.y * o.y) + (o.z * o.z + o.w * o.w));
    const float rstd = 1.0f / sqrtf(ss * (1.0f / 256.0f) + EPS);
    const f32x4 gv = *(const f32x4*)(A.in[F.zo + I_GGLA] + l * 1024 + hh * 256 + 4 * lane);
    const uint2 gw = *(const uint2*)(F.Z() + (size_t)r * ZW + GG + hh * 256 + 4 * lane);
    const float g0 = bflo(gw.x), g1 = bfhi(gw.x), g2 = bflo(gw.y), g3 = bfhi(gw.y);
    const float y0 = o.x * rstd * gv.x * (g0 / (1.0f + __expf(-g0))), y1 = o.y * rstd * gv.y * (g1 / (1.0f + __expf(-g1)));
    const float y2 = o.z * rstd * gv.z * (g2 / (1.0f + __expf(-g2))), y3 = o.w * rstd * gv.w * (g3 / (1.0f + __expf(-g3)));
    uint2 w; w.x = pk2(y0, y1); w.y = pk2(y2, y3);
    *(uint2*)(F.MIX() + (size_t)r * DM + 1024 + hh * 256 + 4 * lane) = w;
}
constexpr int GL_QD = 0, GL_KD = 17408, GL_KDT = 34816, GL_VT = 53248, GL_AM = 71680, GL_ST = 80896, GL_DL = 115712, GL_BS = 116224, GL_END = 118272;
static_assert(GL_END <= RING_BYTES, "GLA LDS map");
typedef unsigned u32x2 __attribute__((ext_vector_type(2)));
__device__ __forceinline__ u32x2 pack4bf(const f32x4 v) { u32x2 w; w.x = pk2(v.x, v.y); w.y = pk2(v.z, v.w); return w; }
__device__ __forceinline__ void gla_chunks(Frame& F, const Args& A, int l, int row0, int nchunks, int nvalid, int hh, int eh, bool do_out, f32x4 (&sacc)[8], float& btot) {
    const int lane = F.lane_id(), wave = F.wave, tid = wave * 64 + lane, fr = lane & 15, fq = lane >> 4;
    const int d = tid & 127, qtr = tid >> 7, cg = hh * 128 + d;
    LAS bf16* QD = (LAS bf16*)(F.lds + GL_QD); LAS bf16* KD = (LAS bf16*)(F.lds + GL_KD); LAS bf16* KDT = (LAS bf16*)(F.lds + GL_KDT); LAS bf16* VT = (LAS bf16*)(F.lds + GL_VT);
    LAS bf16* AM = (LAS bf16*)(F.lds + GL_AM); LAS bf16* ST = (LAS bf16*)(F.lds + GL_ST); LAS float* DL = (LAS float*)(F.lds + GL_DL); LAS float* BS = (LAS float*)(F.lds + GL_BS);
    const bf16* Z = F.Z();
    float wa[16];
    { const float* wp = A.in[F.zo + I_WA2] + (size_t)l * 16 * 512 + cg;
#pragma unroll
      for (int j = 0; j < 16; ++j) wa[j] = wp[j * 512]; }
    const float ba = A.in[F.zo + I_BA2][l * 512 + cg];
    btot = 0.f;
    if (do_out) {
#pragma unroll
        for (int db = 0; db < 8; ++db) *(LAS u32x2*)(ST + (wave * 16 + fr) * 136 + db * 16 + 4 * fq) = pack4bf(sacc[db]);
    }
    for (int c = 0; c < nchunks; ++c) {
        const int r0 = row0 + c * 64;
        float bl[16]; float run = 0.f;
#pragma unroll
        for (int i = 0; i < 16; ++i) { const int t = 16 * qtr + i; float la = 0.f;
            if (t < nvalid) { const v4u* gp = (const v4u*)(Z + (size_t)(r0 + t) * ZW + GA); const v4u g0 = gp[0], g1 = gp[1];
                float x = ba + bflo(g0.x) * wa[0] + bfhi(g0.x) * wa[1] + bflo(g0.y) * wa[2] + bfhi(g0.y) * wa[3] + bflo(g0.z) * wa[4] + bfhi(g0.z) * wa[5] + bflo(g0.w) * wa[6] + bfhi(g0.w) * wa[7];
                x += bflo(g1.x) * wa[8] + bfhi(g1.x) * wa[9] + bflo(g1.y) * wa[10] + bfhi(g1.y) * wa[11] + bflo(g1.z) * wa[12] + bfhi(g1.z) * wa[13] + bflo(g1.w) * wa[14] + bfhi(g1.w) * wa[15];
                la = (fminf(x, 0.f) - log1pf(__expf(-fabsf(x)))) * (1.0f / 16.0f); }
            run += la; bl[i] = run; }
        BS[qtr * 128 + d] = run;
        __syncthreads();
        float pre = 0.f, tot = 0.f;
#pragma unroll
        for (int q2 = 0; q2 < 4; ++q2) { const float v = BS[q2 * 128 + d]; tot += v; if (q2 < qtr) pre += v; }
#pragma unroll
        for (int i = 0; i < 16; ++i) { const int t = 16 * qtr + i; const float b = pre + bl[i]; float qv = 0.f, kv = 0.f;
            if (t < nvalid) { const bf16* zr = Z + (size_t)(r0 + t) * ZW; qv = bf2f(zr[GQ + cg]); kv = bf2f(zr[GK + cg]); }
            QD[t * 136 + d] = (bf16)f2bf(qv * __expf(b) * 0.08838834764831845f); KD[t * 136 + d] = (bf16)f2bf(kv * __expf(-b)); KDT[d * 72 + t] = (bf16)f2bf(kv * __expf(tot - b)); }
        if (qtr == 0) DL[d] = __expf(tot);
        btot += tot;
        { const int s = tid >> 3, ec = tid & 7; v4u v0 = {0u, 0u, 0u, 0u}, v1 = {0u, 0u, 0u, 0u};
          if (s < nvalid) { const v4u* vp = (const v4u*)(Z + (size_t)(r0 + s) * ZW + GV + hh * 256 + eh * 128 + ec * 16); v0 = vp[0]; v1 = vp[1]; }
          LAS bf16* vt = VT + (ec * 16) * 72 + s;
          vt[0 * 72] = (bf16)(v0.x & 0xffffu); vt[1 * 72] = (bf16)(v0.x >> 16); vt[2 * 72] = (bf16)(v0.y & 0xffffu); vt[3 * 72] = (bf16)(v0.y >> 16);
          vt[4 * 72] = (bf16)(v0.z & 0xffffu); vt[5 * 72] = (bf16)(v0.z >> 16); vt[6 * 72] = (bf16)(v0.w & 0xffffu); vt[7 * 72] = (bf16)(v0.w >> 16);
          vt[8 * 72] = (bf16)(v1.x & 0xffffu); vt[9 * 72] = (bf16)(v1.x >> 16); vt[10 * 72] = (bf16)(v1.y & 0xffffu); vt[11 * 72] = (bf16)(v1.y >> 16);
          vt[12 * 72] = (bf16)(v1.z & 0xffffu); vt[13 * 72] = (bf16)(v1.z >> 16); vt[14 * 72] = (bf16)(v1.w & 0xffffu); vt[15 * 72] = (bf16)(v1.w >> 16); }
        __syncthreads();
        if (do_out) {
#pragma unroll
            for (int bi = 0; bi < 2; ++bi) { const int blk = 2 * wave + bi, tb = blk >> 2, sbk = blk & 3;
                f32x4 acc = {0.f, 0.f, 0.f, 0.f};
                if (sbk <= tb) {
#pragma unroll
                    for (int ks = 0; ks < 4; ++ks) { const bf16x8 a = *(const LAS bf16x8*)(KD + (sbk * 16 + fr) * 136 + ks * 32 + fq * 8), b = *(const LAS bf16x8*)(QD + (tb * 16 + fr) * 136 + ks * 32 + fq * 8);
                        acc = __builtin_amdgcn_mfma_f32_16x16x32_bf16(a, b, acc, 0, 0, 0); } }
                const int t = tb * 16 + fr, s0 = sbk * 16 + 4 * fq;
                f32x4 m; m.x = (s0 + 0 <= t) ? acc.x : 0.f; m.y = (s0 + 1 <= t) ? acc.y : 0.f; m.z = (s0 + 2 <= t) ? acc.z : 0.f; m.w = (s0 + 3 <= t) ? acc.w : 0.f;
                *(LAS u32x2*)(AM + t * 72 + s0) = pack4bf(m); }
            __syncthreads();
#pragma unroll
            for (int tb = 0; tb < 4; ++tb) { f32x4 o = {0.f, 0.f, 0.f, 0.f};
#pragma unroll
                for (int ks = 0; ks < 2; ++ks) { const bf16x8 a = *(const LAS bf16x8*)(VT + (wave * 16 + fr) * 72 + ks * 32 + fq * 8), b = *(const LAS bf16x8*)(AM + (tb * 16 + fr) * 72 + ks * 32 + fq * 8);
                    o = __builtin_amdgcn_mfma_f32_16x16x32_bf16(a, b, o, 0, 0, 0); }
#pragma unroll
                for (int ks = 0; ks < 4; ++ks) { const bf16x8 a = *(const LAS bf16x8*)(ST + (wave * 16 + fr) * 136 + ks * 32 + fq * 8), b = *(const LAS bf16x8*)(QD + (tb * 16 + fr) * 136 + ks * 32 + fq * 8);
                    o = __builtin_amdgcn_mfma_f32_16x16x32_bf16(a, b, o, 0, 0, 0); }
                const int t = tb * 16 + fr;
                if (t < nvalid) *(f32x4*)(F.OGLA() + (size_t)(r0 + t) * 1024 + hh * 256 + eh * 128 + wave * 16 + 4 * fq) = o; }
        }
#pragma unroll
        for (int db = 0; db < 8; ++db) { const f32x4 dl = *(const LAS f32x4*)(DL + db * 16 + 4 * fq); sacc[db] = sacc[db] * dl;
#pragma unroll
            for (int ks = 0; ks < 2; ++ks) { const bf16x8 a = *(const LAS bf16x8*)(KDT + (db * 16 + fr) * 72 + ks * 32 + fq * 8), b = *(const LAS bf16x8*)(VT + (wave * 16 + fr) * 72 + ks * 32 + fq * 8);
                sacc[db] = __builtin_amdgcn_mfma_f32_16x16x32_bf16(a, b, sacc[db], 0, 0, 0); } }
        if (do_out) {
#pragma unroll
            for (int db = 0; db < 8; ++db) *(LAS u32x2*)(ST + (wave * 16 + fr) * 136 + db * 16 + 4 * fq) = pack4bf(sacc[db]);
        }
        __syncthreads();
    }
}
__device__ __forceinline__ void gla_phase1(Frame& F, const Args& A, int l) {
    const int lane = F.lane_id(), wave = F.wave, tid = wave * 64 + lane, fr = lane & 15, fq = lane >> 4;
    for (int u = F.vcu; u < 256; u += F.G) { const int bh = u >> 4, seg = (u >> 1) & 7, eh = u & 1;
        if (seg == 7) continue;
        f32x4 sacc[8];
#pragma unroll
        for (int db = 0; db < 8; ++db) sacc[db] = (f32x4){0.f, 0.f, 0.f, 0.f};
        float btot;
        gla_chunks(F, A, l, (bh >> 2) * 2048 + seg * 256, 4, 64, bh & 3, eh, false, sacc, btot);
        float* sl = F.SLOC() + ((size_t)(bh * 8 + seg) * 128) * 256 + eh * 128 + wave * 16 + fr;
#pragma unroll
        for (int db = 0; db < 8; ++db) { const int d0 = db * 16 + 4 * fq; sl[(size_t)(d0 + 0) * 256] = sacc[db].x; sl[(size_t)(d0 + 1) * 256] = sacc[db].y; sl[(size_t)(d0 + 2) * 256] = sacc[db].z; sl[(size_t)(d0 + 3) * 256] = sacc[db].w; }
        if (eh == 0 && tid < 128) F.DSEG()[(bh * 8 + seg) * 128 + tid] = __expf(btot);
    }
    for (int u = F.vcu; u < 256; u += F.G) { const int sb = u >> 3, hh = (u >> 1) & 3, eh = u & 1; const size_t so = ((size_t)((l * 32 + sb) * 4 + hh)) * 32768 + eh * 128 + wave * 16 + fr;
        const float* s0 = A.in[F.zo + I_SGLA] + so;
        f32x4 sacc[8];
#pragma unroll
        for (int db = 0; db < 8; ++db) { const int d0 = db * 16 + 4 * fq; sacc[db].x = s0[(size_t)(d0 + 0) * 256]; sacc[db].y = s0[(size_t)(d0 + 1) * 256]; sacc[db].z = s0[(size_t)(d0 + 2) * 256]; sacc[db].w = s0[(size_t)(d0 + 3) * 256]; }
        float btot;
        gla_chunks(F, A, l, NP_ROWS + sb * 4, 1, 4, hh, eh, true, sacc, btot);
        float* so_ = F.out + O_GLA_S + so;
#pragma unroll
        for (int db = 0; db < 8; ++db) { const int d0 = db * 16 + 4 * fq; so_[(size_t)(d0 + 0) * 256] = sacc[db].x; so_[(size_t)(d0 + 1) * 256] = sacc[db].y; so_[(size_t)(d0 + 2) * 256] = sacc[db].z; so_[(size_t)(d0 + 3) * 256] = sacc[db].w; }
    }
}
__device__ __forceinline__ void gla_phase2(Frame& F, const Args& A, int l) {
    const int lane = F.lane_id(), wave = F.wave, fr = lane & 15, fq = lane >> 4;
    for (int u = F.vcu; u < 256; u += F.G) { const int bh = u >> 4, seg = (u >> 1) & 7, eh = u & 1;
        f32x4 sacc[8];
#pragma unroll
        for (int db = 0; db < 8; ++db) sacc[db] = (f32x4){0.f, 0.f, 0.f, 0.f};
        for (int i2 = 0; i2 < seg; ++i2) { const float* sl = F.SLOC() + ((size_t)(bh * 8 + i2) * 128) * 256 + eh * 128 + wave * 16 + fr; const float* dg = F.DSEG() + (bh * 8 + i2) * 128;
#pragma unroll
            for (int db = 0; db < 8; ++db) { const int d0 = db * 16 + 4 * fq; const f32x4 dv = *(const f32x4*)(dg + d0);
                sacc[db].x = sacc[db].x * dv.x + sl[(size_t)(d0 + 0) * 256]; sacc[db].y = sacc[db].y * dv.y + sl[(size_t)(d0 + 1) * 256]; sacc[db].z = sacc[db].z * dv.z + sl[(size_t)(d0 + 2) * 256]; sacc[db].w = sacc[db].w * dv.w + sl[(size_t)(d0 + 3) * 256]; } }
        float btot;
        gla_chunks(F, A, l, (bh >> 2) * 2048 + seg * 256, 4, 64, bh & 3, eh, true, sacc, btot);
        if (seg == 7) { float* so_ = F.out + O_GLA_P + ((size_t)(l * 16 + bh)) * 32768 + eh * 128 + wave * 16 + fr;
#pragma unroll
            for (int db = 0; db < 8; ++db) { const int d0 = db * 16 + 4 * fq; so_[(size_t)(d0 + 0) * 256] = sacc[db].x; so_[(size_t)(d0 + 1) * 256] = sacc[db].y; so_[(size_t)(d0 + 2) * 256] = sacc[db].z; so_[(size_t)(d0 + 3) * 256] = sacc[db].w; } }
    }
}
constexpr int AT_VT = 0, AT_VTS = 184, AT_BT = 64 * AT_VTS * 2, AT_END = AT_BT + 4 * 128 * 4;
__device__ __forceinline__ void attn_unit_mfma(Frame& F, const Args& A, int l, int u) {
    const int lane = F.lane_id(), wave = F.wave, tid = wave * 64 + lane, fr = lane & 15, fq = lane >> 4;
    const int span = u >> 1, g = u & 1, t0g = span * 32, tb0 = t0g & 2047;
    LAS bf16* VT = (LAS bf16*)(F.lds + AT_VT); LAS float* BT = (LAS float*)(F.lds + AT_BT);
    const bf16* Z = F.Z();
#pragma unroll
    for (int pass = 0; pass < 2; ++pass) { const int key = pass * 128 + (tid >> 2), dch = (tid & 3) * 16;
        if (key < 160) { v4u v0 = {0u, 0u, 0u, 0u}, v1 = {0u, 0u, 0u, 0u};
            if (tb0 - 128 + key >= 0) { const v4u* vp = (const v4u*)(Z + (size_t)(t0g - 128 + key) * ZW + ZV + g * 64 + dch); v0 = vp[0]; v1 = vp[1]; }
            LAS bf16* vt = VT + dch * AT_VTS + key;
            vt[0 * AT_VTS] = (bf16)(v0.x & 0xffffu); vt[1 * AT_VTS] = (bf16)(v0.x >> 16); vt[2 * AT_VTS] = (bf16)(v0.y & 0xffffu); vt[3 * AT_VTS] = (bf16)(v0.y >> 16);
            vt[4 * AT_VTS] = (bf16)(v0.z & 0xffffu); vt[5 * AT_VTS] = (bf16)(v0.z >> 16); vt[6 * AT_VTS] = (bf16)(v0.w & 0xffffu); vt[7 * AT_VTS] = (bf16)(v0.w >> 16);
            vt[8 * AT_VTS] = (bf16)(v1.x & 0xffffu); vt[9 * AT_VTS] = (bf16)(v1.x >> 16); vt[10 * AT_VTS] = (bf16)(v1.y & 0xffffu); vt[11 * AT_VTS] = (bf16)(v1.y >> 16);
            vt[12 * AT_VTS] = (bf16)(v1.z & 0xffffu); vt[13 * AT_VTS] = (bf16)(v1.z >> 16); vt[14 * AT_VTS] = (bf16)(v1.w & 0xffffu); vt[15 * AT_VTS] = (bf16)(v1.w >> 16); } }
    BT[tid] = F.BTAB()[(g * 4) * 128 + tid];
    __syncthreads();
    const int rb = wave >> 2, hl = wave & 3, hd = g * 4 + hl, t0w = t0g + 16 * rb;
    bf16x8 qf[2];
    { const bf16* qp = Z + (size_t)(t0w + fr) * ZW + ZQ + hd * 64 + 8 * fq; qf[0] = *(const bf16x8*)qp; qf[1] = *(const bf16x8*)(qp + 32); }
    f32x4 sacc[9];
#pragma unroll
    for (int kb = 0; kb < 9; ++kb) { const int kl = 16 * (rb + kb) + fr; bf16x8 k0 = {0, 0, 0, 0, 0, 0, 0, 0}, k1 = {0, 0, 0, 0, 0, 0, 0, 0};
        if (tb0 - 128 + kl >= 0) { const bf16* kp = Z + (size_t)(t0g - 128 + kl) * ZW + ZK + g * 64 + 8 * fq; k0 = *(const bf16x8*)kp; k1 = *(const bf16x8*)(kp + 32); }
        f32x4 acc = {0.f, 0.f, 0.f, 0.f};
        acc = __builtin_amdgcn_mfma_f32_16x16x32_bf16(k0, qf[0], acc, 0, 0, 0); acc = __builtin_amdgcn_mfma_f32_16x16x32_bf16(k1, qf[1], acc, 0, 0, 0);
        sacc[kb] = acc; }
    const float sink = A.in[F.zo + I_SINKS][l * 8 + hd];
    float mx = -INFINITY;
#pragma unroll
    for (int kb = 0; kb < 9; ++kb)
#pragma unroll
        for (int i = 0; i < 4; ++i) { const int dist = 128 - 16 * kb + fr - 4 * fq - i, kpos = tb0 + 16 * rb + fr - dist;
            const bool valid = (dist >= 0) && (dist < 128) && (kpos >= 0);
            const float s = valid ? sacc[kb][i] * 0.125f + BT[hl * 128 + (dist & 127)] : -INFINITY;
            sacc[kb][i] = s; mx = fmaxf(mx, s); }
    mx = fmaxf(mx, __shfl_xor(mx, 16)); mx = fmaxf(mx, __shfl_xor(mx, 32)); mx = fmaxf(mx, sink);
    float ls = 0.f;
#pragma unroll
    for (int kb = 0; kb < 9; ++kb)
#pragma unroll
        for (int i = 0; i < 4; ++i) { const float p = __expf(sacc[kb][i] - mx); sacc[kb][i] = p; ls += p; }
    ls += __shfl_xor(ls, 16); ls += __shfl_xor(ls, 32);
    const float rden = 1.0f / (ls + __expf(sink - mx));
    bf16x8 pf[5];
#pragma unroll
    for (int pp = 0; pp < 5; ++pp) { const f32x4 a = sacc[2 * pp], b = (2 * pp + 1 < 9) ? sacc[2 * pp + 1] : (f32x4){0.f, 0.f, 0.f, 0.f};
        const unsigned w0 = pk2(a.x, a.y), w1 = pk2(a.z, a.w), w2 = pk2(b.x, b.y), w3 = pk2(b.z, b.w);
        v4u w = {w0, w1, w2, w3}; pf[pp] = __builtin_bit_cast(bf16x8, w); }
#pragma unroll
    for (int db = 0; db < 4; ++db) { f32x4 o = {0.f, 0.f, 0.f, 0.f};
#pragma unroll
        for (int pp = 0; pp < 5; ++pp) { const LAS bf16* vr = VT + (db * 16 + fr) * AT_VTS + 16 * (rb + 2 * pp) + 4 * fq;
            const u32x2 lo = *(const LAS u32x2*)vr; u32x2 hi = {0u, 0u}; if (2 * pp + 1 < 9) hi = *(const LAS u32x2*)(vr + 16);
            v4u w = {lo.x, lo.y, hi.x, hi.y};
            o = __builtin_amdgcn_mfma_f32_16x16x32_bf16(__builtin_bit_cast(bf16x8, w), pf[pp], o, 0, 0, 0); }
        *(u32x2*)(F.MIX() + (size_t)(t0w + fr) * DM + hd * 64 + db * 16 + 4 * fq) = pack4bf(o * rden); }
    __syncthreads();
}
__device__ __forceinline__ void pool_item_mfma(Frame& F, const Args& A, int l, int rblk, int g) {
    const int lane = F.lane_id(), fr = lane & 15, fq = lane >> 4;
    const int t = rblk * 16 + fr, pos = t & 2047, w = 2 << g;
    const bf16* Z = F.Z();
    const int nwin = (pos + 1) < w ? (pos + 1) : w; const float rc = 1.0f / (float)nwin;
    bf16x8 df[4];
#pragma unroll
    for (int ks = 0; ks < 4; ++ks) { const bf16* up = Z + (size_t)t * ZW + ZU + g * 128 + ks * 32 + 8 * fq;
        float s[8], u0[8];
        { const v4u x = *(const v4u*)up; u0[0] = bflo(x.x); u0[1] = bfhi(x.x); u0[2] = bflo(x.y); u0[3] = bfhi(x.y); u0[4] = bflo(x.z); u0[5] = bfhi(x.z); u0[6] = bflo(x.w); u0[7] = bfhi(x.w); }
#pragma unroll
        for (int j = 0; j < 8; ++j) s[j] = u0[j];
        for (int i = 1; i < nwin; ++i) { const v4u x = *(const v4u*)(up - (size_t)i * ZW);
            s[0] += bflo(x.x); s[1] += bfhi(x.x); s[2] += bflo(x.y); s[3] += bfhi(x.y); s[4] += bflo(x.z); s[5] += bfhi(x.z); s[6] += bflo(x.w); s[7] += bfhi(x.w); }
        v4u wv; wv.x = pk2(s[0] * rc - u0[0], s[1] * rc - u0[1]); wv.y = pk2(s[2] * rc - u0[2], s[3] * rc - u0[3]); wv.z = pk2(s[4] * rc - u0[4], s[5] * rc - u0[5]); wv.w = pk2(s[6] * rc - u0[6], s[7] * rc - u0[7]);
        df[ks] = __builtin_bit_cast(bf16x8, wv); }
    const bf16* wt = F.WPT() + ((size_t)(l * 4 + g) * 128) * 128; const float* psc = A.in[F.zo + I_PSCALE] + l * 512 + g * 128;
#pragma unroll
    for (int nb = 0; nb < 8; ++nb) { f32x4 acc = {0.f, 0.f, 0.f, 0.f};
#pragma unroll
        for (int ks = 0; ks < 4; ++ks) { const bf16x8 a = *(const bf16x8*)(wt + (size_t)(nb * 16 + fr) * 128 + ks * 32 + 8 * fq); acc = __builtin_amdgcn_mfma_f32_16x16x32_bf16(a, df[ks], acc, 0, 0, 0); }
        const f32x4 sc = *(const f32x4*)(psc + nb * 16 + 4 * fq);
        *(u32x2*)(F.MIX() + (size_t)t * DM + 512 + g * 128 + nb * 16 + 4 * fq) = pack4bf(acc * sc); }
}

#ifndef EN_P0
#define EN_P0 1
#endif
#ifndef EN_G
#define EN_G 1
#endif
#ifndef EN_N
#define EN_N 1
#endif
#ifndef EN_M2
#define EN_M2 1
#endif
#ifndef EN_M3
#define EN_M3 1
#endif
#ifndef EN_M4
#define EN_M4 1
#endif
#ifndef EN_G1
#define EN_G1 1
#endif
#ifndef EN_GIN
#define EN_GIN 1
#endif
#ifndef EN_GOUT
#define EN_GOUT 1
#endif
#ifndef EN_GGU
#define EN_GGU 1
#endif
#ifndef EN_GDN
#define EN_GDN 1
#endif
#ifndef MK_SINGLE
#define MK_SINGLE 1
#endif
constexpr int PH_PER_LAYER = 9, PH_LAYER0 = 2, PH_FINAL = PH_LAYER0 + DEPTH * PH_PER_LAYER, PH_COUNT = PH_FINAL + 1;
__global__ void __launch_bounds__(NTHREADS, 2) hymba_fwd(Args args) {
    extern __shared__ __attribute__((aligned(16))) unsigned char lds[];
    Frame F;
    F.lds = (LAS unsigned char*)lds;
    F.MISC = (volatile LAS unsigned*)(F.lds + MISC_OFF);
    F.wave = __builtin_amdgcn_readfirstlane((int)threadIdx.x >> 6); F.zo = 0;
    F.G = gridDim.x; { const int bx = blockIdx.x; F.vcu = (F.G % 8 == 0) ? (bx % 8) * (F.G / 8) + bx / 8 : bx; }
    F.ws = args.ws; F.out = args.out;
    gu32* const ctl = (gu32*)(F.ws + WS_CTL);
    for (int u = threadIdx.x; u < (LDS_BYTES - LDSCTL_OFF) / 4; u += NTHREADS) ((LAS unsigned*)(F.lds + LDSCTL_OFF))[u] = 0u;
    __syncthreads();
#if MK_SINGLE
    XcdBarrier bar = xcd_barrier_post((unsigned*)(ctl + CW_BAR), F.MISC + 8);
#define GRID_BAR() xcd_barrier(bar)
#else
#define GRID_BAR() do { } while (0)
#endif
    const int lo = args.ph_lo, hi = args.ph_hi;
#define IN(k) (lo <= (k) && (k) < hi)
#define BOTH(k) (IN(k) && IN((k) + 1))
#define PHASE_BEGIN() asm volatile("s_mov_b32 %0, 0" : "=s"(F.zo), "+s"(F.G), "+s"(F.vcu), "+s"(F.wave))
#define gw (F.vcu * NWAVES + F.wave)
#define NGW (F.G * NWAVES)
#define wscr ((LAS float*)(F.lds + RING_OFF + F.wave * 16384))

    if (EN_P0 && IN(0)) { PHASE_BEGIN(); p0_prologue(F, args); if (BOTH(0)) GRID_BAR(); }
    if (EN_G && EN_G1 && IN(1)) { PHASE_BEGIN();
        pg8::Gemm g{F.SC(), F.Wada_t(), 256, DEPTH * MODW, DM}; pg8::StaticOrder S; S.init(256, DEPTH * MODW, F.G, (int)blockIdx.x);
        pg8::EpiMod E{F.MOD(), args.in[F.zo + I_BADA]};
        pg8::gemm_phase<pg8::EpiMod, pg8::StaticOrder, true, true>(F.lds + RING_OFF, g, S, E, F.wave);
        if (BOTH(1)) GRID_BAR();
    }
    for (int l = 0; l < DEPTH; ++l) {
        const int pb = PH_LAYER0 + l * PH_PER_LAYER;
        const float* modl = F.MOD() + (size_t)l * MODW;
        if (EN_N && IN(pb + 0)) { PHASE_BEGIN(); norm_mod_rows(F, args.in[F.zo + I_GMIX] + l * DM, modl); if (BOTH(pb + 0)) GRID_BAR(); }
        if (EN_G && EN_GIN && IN(pb + 1)) { PHASE_BEGIN();
            pg8::Gemm g{F.H(), F.Win_t() + (size_t)l * ZW * DM, MPAD, ZW, DM}; pg8::StaticOrder S; S.init(MPAD, ZW, F.G, (int)blockIdx.x);
            pg8::EpiZ E{F.Z(), ZW};
            pg8::gemm_phase<pg8::EpiZ, pg8::StaticOrder, true, true>(F.lds + RING_OFF, g, S, E, F.wave);
            if (BOTH(pb + 1)) GRID_BAR();
        }
        if (EN_M2 && IN(pb + 2)) { PHASE_BEGIN();
            gla_phase1(F, args, l);
            for (int u = F.vcu; u < 512; u += F.G) attn_unit_mfma(F, args, l, u);
            for (int it = gw; it < 512 * 4; it += NGW) pool_item_mfma(F, args, l, it >> 2, it & 3);
            for (int it = gw; it < NS_ROWS * 8; it += NGW) attn_item(F, args, l, NP_ROWS + (it >> 3), it & 7, wscr);
            for (int it = gw; it < NS_ROWS * 4; it += NGW) pool_item(F, args, l, NP_ROWS + (it >> 2), it & 3, wscr);
            cache_outputs(F, args, l);
            if (BOTH(pb + 2)) GRID_BAR();
        }
        if (EN_M3 && IN(pb + 3)) { PHASE_BEGIN();
            gla_phase2(F, args, l);
            if (BOTH(pb + 3)) GRID_BAR();
        }
        if (EN_M4 && IN(pb + 4)) { PHASE_BEGIN(); for (int it = gw; it < NROWS * 4; it += NGW) gla_out_item(F, args, l, it >> 2, it & 3); if (BOTH(pb + 4)) GRID_BAR(); }
        if (EN_G && EN_GOUT && IN(pb + 5)) { PHASE_BEGIN();
            pg8::Gemm g{F.MIX(), F.Wout_t() + (size_t)l * DM * DM, MPAD, DM, DM}; pg8::StaticOrder S; S.init(MPAD, DM, F.G, (int)blockIdx.x);
            pg8::EpiResid E{F.X(), modl + 4096};
            pg8::gemm_phase<pg8::EpiResid, pg8::StaticOrder, true, true>(F.lds + RING_OFF, g, S, E, F.wave);
            if (BOTH(pb + 5)) GRID_BAR();
        }
        if (EN_N && IN(pb + 6)) { PHASE_BEGIN(); norm_mod_rows(F, args.in[F.zo + I_GFFN] + l * DM, modl + 6144); if (BOTH(pb + 6)) GRID_BAR(); }
        if (EN_G && EN_GGU && IN(pb + 7)) { PHASE_BEGIN();
            pg8::Gemm g{F.H(), F.Wgu_t() + (size_t)l * NGU * DM, MPAD, NGU, DM}; pg8::StaticOrder S; S.init(MPAD, NGU, F.G, (int)blockIdx.x);
            pg8::EpiSwiGLU E{F.ACT(), DFF};
            pg8::gemm_phase<pg8::EpiSwiGLU, pg8::StaticOrder, true, true>(F.lds + RING_OFF, g, S, E, F.wave);
            if (BOTH(pb + 7)) GRID_BAR();
        }
        if (EN_G && EN_GDN && IN(pb + 8)) { PHASE_BEGIN();
            pg8::Gemm g{F.ACT(), F.Wdn_t() + (size_t)l * DM * DFF, MPAD, DM, DFF}; pg8::StaticOrder S; S.init(MPAD, DM, F.G, (int)blockIdx.x);
            pg8::EpiResid E{F.X(), modl + 10240};
            pg8::gemm_phase<pg8::EpiResid, pg8::StaticOrder, true, true>(F.lds + RING_OFF, g, S, E, F.wave);
            if (BOTH(pb + 8)) GRID_BAR();
        }
    }
    if (IN(PH_FINAL)) { PHASE_BEGIN(); final_norm_rows(F, args); }
#undef IN
#undef BOTH
#undef gw
#undef NGW
#undef wscr
}

extern "C" void kernel_launch(void* const* d_in, const int* in_sizes, int n_in, void* d_out, int out_size, void* d_ws, size_t ws_size, hipStream_t stream) {
    static int grid = 0;
    if (grid == 0) {
        if (n_in != 24 || out_size != (int)O_END || ws_size < WS_END) { fprintf(stderr, "kernel_launch: unexpected sizes n_in %d out %d ws %zu\n", n_in, out_size, ws_size); grid = -1; return; }
        int dev = 0, cus = 0;
        if (hipGetDevice(&dev) != hipSuccess || hipDeviceGetAttribute(&cus, hipDeviceAttributeMultiprocessorCount, dev) != hipSuccess) { grid = -1; return; }
        if (hipFuncSetAttribute((const void*)hymba_fwd, hipFuncAttributeMaxDynamicSharedMemorySize, LDS_BYTES) != hipSuccess) { fprintf(stderr, "kernel_launch: hipFuncSetAttribute failed\n"); grid = -1; return; }
        (void)hipGetLastError();
        grid = cus;
    }
    if (grid < 0) return;
    (void)hipMemsetAsync((char*)d_ws + WS_CTL, 0, CTL_ZERO_BYTES, stream);
    Args a{};
    for (int i = 0; i < 24; ++i) a.in[i] = (const float*)d_in[i];
    a.out = (float*)d_out; a.ws = (unsigned char*)d_ws;
#if MK_SINGLE
    a.ph_lo = 0; a.ph_hi = PH_COUNT;
    hipLaunchKernelGGL(hymba_fwd, dim3(grid), dim3(NTHREADS), LDS_BYTES, stream, a);
#else
    for (int p = 0; p < PH_COUNT; ++p) { a.ph_lo = p; a.ph_hi = p + 1; hipLaunchKernelGGL(hymba_fwd, dim3(grid), dim3(NTHREADS), LDS_BYTES, stream, a); }
#endif
}
```

```cpp
#include <hip/hip_runtime.h>
#include <cstdio>
#include <cstdint>
#include <cmath>
namespace pg8 {
#define PG8_LAS __attribute__((address_space(3)))
typedef unsigned short bf16_t;
typedef short bf16x8 __attribute__((ext_vector_type(8)));
typedef float f32x4 __attribute__((ext_vector_type(4)));
typedef unsigned u32x4 __attribute__((ext_vector_type(4)));
constexpr int BM = 256, BK = 64, HALF = 128, HTB = HALF * BK * 2  , STAGE_BYTES = 8 * HTB, NXCD = 8, WGM = 8;

__host__ __device__ __forceinline__ int lds_byte(int r, int c) { const int st = (r >> 4) * 2 + (c >> 5), rr = r & 15, cc = c & 31, ob = rr * 64 + cc * 2; return st * 1024 + (ob ^ (((ob >> 9) & 1) << 5)); }
__host__ __device__ __forceinline__ void stage_rc(int b, int& R, int& C) { const int st = b / 1024, sb = b % 1024, swz = sb ^ (((sb >> 9) & 1) << 5); R = (st >> 1) * 16 + swz / 64; C = (st & 1) * 32 + (swz % 64) / 2; }
__host__ __device__ __forceinline__ int perm32(int rho) { const int n = rho >> 4, i = rho & 15; return 8 * (i >> 2) + 4 * n + (i & 3); }

struct Unit { int pm, pn; };
struct Gemm { const bf16_t* A; const bf16_t* Bt; int M, N, K; };

struct StaticOrder {
    int nM, nN, nwg, G, c;
    __host__ __device__ void init(int M, int N, int G_, int c_) { nM = M / BM; nN = N / BM; nwg = nM * nN; G = G_; c = c_; }
    __host__ __device__ bool next(int i, Unit& u) const {
        const long L = (long)i * G + c; if (L >= nwg) return false;
        int wgid = (int)L; { const int q = nwg / NXCD, r = nwg % NXCD, xcd = wgid % NXCD, off = wgid / NXCD; wgid = (xcd < r ? xcd * (q + 1) : r * (q + 1) + (xcd - r) * q) + off; }
        const int nig = WGM * nN, gid = wgid / nig, fm = gid * WGM, gsz = (nM - fm) < WGM ? (nM - fm) : WGM;
        u.pm = fm + ((wgid % nig) % gsz); u.pn = (wgid % nig) / gsz; return true;
    }
    __device__ __forceinline__ void a_ready(const Unit&) const {}
    __device__ __forceinline__ void done(const Unit&) const {}
};

__device__ __forceinline__ unsigned cvt_pk_bf16(float lo, float hi) { unsigned r; asm volatile("v_cvt_pk_bf16_f32 %0, %1, %2" : "=v"(r) : "v"(lo), "v"(hi)); return r; }
typedef float f32x2 __attribute__((ext_vector_type(2)));
constexpr int MODLD_ = 49152;
__device__ __forceinline__ float fast_sigmoid(float x) { return __builtin_amdgcn_rcpf(1.0f + __expf(-x)); }
struct EpiZ {
    static constexpr bool PERM = true, AFTER_DRAIN = false;
    bf16_t* O; int ldc;
    __device__ __forceinline__ void operator()(const f32x4 (&acc)[2][2][4][2], const Unit& u, int wr, int wc, int fr, int fq) const {
        const int row0 = u.pm * BM + wr * 64 + fr, col0 = u.pn * BM + wc * 32 + 8 * fq;
#pragma unroll
        for (int ai = 0; ai < 2; ++ai)
#pragma unroll
            for (int m = 0; m < 4; ++m) { bf16_t* rowp = O + (size_t)(row0 + ai * HALF + m * 16) * ldc + col0;
#pragma unroll
                for (int bj = 0; bj < 2; ++bj) { const f32x4 v0 = acc[ai][bj][m][0], v1 = acc[ai][bj][m][1];
                    u32x4 w; w.x = cvt_pk_bf16(v0[0], v0[1]); w.y = cvt_pk_bf16(v0[2], v0[3]); w.z = cvt_pk_bf16(v1[0], v1[1]); w.w = cvt_pk_bf16(v1[2], v1[3]);
                    *(u32x4*)(rowp + bj * HALF) = w; } }
    }
};
struct EpiSwiGLU {
    static constexpr bool PERM = true, AFTER_DRAIN = false;
    bf16_t* O; int ldc;
    __device__ __forceinline__ void operator()(const f32x4 (&acc)[2][2][4][2], const Unit& u, int wr, int wc, int fr, int fq) const {
        const int row0 = u.pm * BM + wr * 64 + fr, col0 = u.pn * HALF + wc * 32 + 8 * fq;
#pragma unroll
        for (int ai = 0; ai < 2; ++ai)
#pragma unroll
            for (int m = 0; m < 4; ++m) { bf16_t* rowp = O + (size_t)(row0 + ai * HALF + m * 16) * ldc + col0;
                float r[8];
#pragma unroll
                for (int n = 0; n < 2; ++n)
#pragma unroll
                    for (int i = 0; i < 4; ++i) { const float g = acc[ai][0][m][n][i], up = acc[ai][1][m][n][i]; r[n * 4 + i] = g * fast_sigmoid(g) * up; }
                u32x4 w; w.x = cvt_pk_bf16(r[0], r[1]); w.y = cvt_pk_bf16(r[2], r[3]); w.z = cvt_pk_bf16(r[4], r[5]); w.w = cvt_pk_bf16(r[6], r[7]);
                *(u32x4*)rowp = w; }
    }
};
struct EpiResid {
    static constexpr bool PERM = false, AFTER_DRAIN = false;
    float* X; const float* gate;
    __device__ __forceinline__ void operator()(const f32x4 (&acc)[2][2][4][2], const Unit& u, int wr, int wc, int fr, int fq) const {
        const int col0 = u.pn * BM + wc * 32 + 4 * fq;
        if (u.pm < 32) {
            const float* g = gate + (size_t)(u.pm >> 3) * MODLD_ + col0;
            f32x4 gv[2][2];
#pragma unroll
            for (int bj = 0; bj < 2; ++bj)
#pragma unroll
                for (int n = 0; n < 2; ++n) gv[bj][n] = *(const f32x4*)(g + bj * HALF + n * 16);
#pragma unroll
            for (int ai = 0; ai < 2; ++ai)
#pragma unroll
                for (int m = 0; m < 4; ++m) { float* xp = X + (size_t)(u.pm * BM + ai * HALF + wr * 64 + m * 16 + fr) * 2048 + col0;
#pragma unroll
                    for (int bj = 0; bj < 2; ++bj)
#pragma unroll
                        for (int n = 0; n < 2; ++n) { f32x4 xv = *(const f32x4*)(xp + bj * HALF + n * 16); xv = xv + gv[bj][n] * acc[ai][bj][m][n]; *(f32x4*)(xp + bj * HALF + n * 16) = xv; } }
        } else {
#pragma unroll
            for (int m = 0; m < 4; ++m) { const int rl = wr * 64 + m * 16 + fr;
                const float* g = gate + (size_t)(4 + (rl >> 2)) * MODLD_ + col0; float* xp = X + (size_t)(8192 + rl) * 2048 + col0;
#pragma unroll
                for (int bj = 0; bj < 2; ++bj)
#pragma unroll
                    for (int n = 0; n < 2; ++n) { const f32x4 gvv = *(const f32x4*)(g + bj * HALF + n * 16); f32x4 xv = *(const f32x4*)(xp + bj * HALF + n * 16);
                        xv = xv + gvv * acc[0][bj][m][n]; *(f32x4*)(xp + bj * HALF + n * 16) = xv; } }
        }
    }
};
struct EpiMod {
    static constexpr bool PERM = false, AFTER_DRAIN = false;
    float* M; const float* bias;
    __device__ __forceinline__ void operator()(const f32x4 (&acc)[2][2][4][2], const Unit& u, int wr, int wc, int fr, int fq) const {
        if (wr != 0) return;
        const int col0 = u.pn * BM + wc * 32 + 4 * fq;
#pragma unroll
        for (int m = 0; m < 3; ++m) { const int r = m * 16 + fr;
            if (r < 36) {
#pragma unroll
                for (int bj = 0; bj < 2; ++bj)
#pragma unroll
                    for (int n = 0; n < 2; ++n) { const f32x4 bv = *(const f32x4*)(bias + col0 + bj * HALF + n * 16);
                        *(f32x4*)(M + (size_t)r * MODLD_ + col0 + bj * HALF + n * 16) = acc[0][bj][m][n] + bv; } } }
    }
};

template <class Epi, class Sched, bool ALIGN_EPI = false, bool SP2 = false>
__device__ __forceinline__ void gemm_phase(PG8_LAS unsigned char* lds, const Gemm g, const Sched& S, const Epi& E, int wid_in) {
    int lane_ = (int)__builtin_amdgcn_mbcnt_hi(~0u, __builtin_amdgcn_mbcnt_lo(~0u, 0u)); asm volatile("" : "+v"(lane_));
    const int wid = __builtin_amdgcn_readfirstlane(wid_in), lane = lane_, tid = wid * 64 + lane, wr = wid >> 2, wc = wid & 3, fr = lane & 15, fq = lane >> 4;
    int K_ = g.K; asm volatile("" : "+s"(K_));
    const int K = K_, nt = K / BK;
    unsigned voffA[2], voffB[2];
#pragma unroll
    for (int i = 0; i < 2; ++i) { int R, C; stage_rc(tid * 16 + i * 8192, R, C); const int Rb = Epi::PERM ? ((R & ~31) + perm32(R & 31)) : R;
        voffA[i] = (unsigned)(R * K + C) * 2u; voffB[i] = (unsigned)(Rb * K + C) * 2u; }
    const size_t kstep = (size_t)(BK * 2);
    const size_t hstep = (size_t)HALF * K * 2;
    const size_t tstep = 2 * hstep;
    const unsigned ldsw = (unsigned)wid * 1024u;
    const int aoff = lds_byte(wr * 64 + fr, fq * 8), boff = lds_byte(wc * 32 + fr, fq * 8);
#define PG8_SA(b, h) (((b) * 2 + (h)) * HTB)
#define PG8_SB(b, h) ((4 + (b) * 2 + (h)) * HTB)
#define PG8_STAGE(bufoff, gbase, voff) do { _Pragma("unroll") for (int _i = 0; _i < 2; ++_i) \
        __builtin_amdgcn_global_load_lds((const unsigned*)((const char*)(gbase) + (voff)[_i]), (PG8_LAS unsigned*)(lds + (bufoff) + ldsw + _i * 8192), 16, 0, 0); } while (0)
#define PG8_LDA(dst, b, h) do { _Pragma("unroll") for (int m = 0; m < 4; ++m) _Pragma("unroll") for (int k = 0; k < 2; ++k) dst[m][k] = *(const PG8_LAS bf16x8*)(lds + PG8_SA(b, h) + aoff + m * 2048 + k * 1024); } while (0)
#define PG8_LDB(dst, b, h) do { _Pragma("unroll") for (int n = 0; n < 2; ++n) _Pragma("unroll") for (int k = 0; k < 2; ++k) dst[n][k] = *(const PG8_LAS bf16x8*)(lds + PG8_SB(b, h) + boff + n * 2048 + k * 1024); } while (0)
#define PG8_MMA(ai, bj, At, Bt) do { __builtin_amdgcn_s_setprio(1); _Pragma("unroll") for (int m = 0; m < 4; ++m) _Pragma("unroll") for (int n = 0; n < 2; ++n) _Pragma("unroll") for (int k = 0; k < 2; ++k) \
        acc[ai][bj][m][n] = __builtin_amdgcn_mfma_f32_16x16x32_bf16(Bt[n][k], At[m][k], acc[ai][bj][m][n], 0, 0, 0); __builtin_amdgcn_s_setprio(0); } while (0)
#define PG8_WAIT_V(n) asm volatile("s_waitcnt vmcnt(" #n ")" ::: "memory")
#define PG8_WAIT_L(n) asm volatile("s_waitcnt lgkmcnt(" #n ")" ::: "memory")
#define PG8_BAR __builtin_amdgcn_s_barrier()
#define PG8_SCHED __builtin_amdgcn_sched_barrier(0)
    Unit cur, nxt; int ui = 0;
    if (!S.next(0, cur)) return;
    f32x4 acc[2][2][4][2];
#pragma unroll
    for (int a = 0; a < 2; ++a)
#pragma unroll
        for (int b = 0; b < 2; ++b)
#pragma unroll
            for (int m = 0; m < 4; ++m)
#pragma unroll
                for (int n = 0; n < 2; ++n) acc[a][b][m][n] = (f32x4){0.f, 0.f, 0.f, 0.f};
    bf16x8 At[4][2], B0[2][2], B1[2][2];
    const char* cA = (const char*)g.A + (size_t)cur.pm * tstep; const char* cB = (const char*)g.Bt + (size_t)cur.pn * tstep;
    S.a_ready(cur);
    if constexpr (SP2) {
        PG8_STAGE(PG8_SB(0, 0), cB, voffB); PG8_STAGE(PG8_SB(0, 1), cB + hstep, voffB); PG8_STAGE(PG8_SA(0, 0), cA, voffA); PG8_STAGE(PG8_SA(0, 1), cA + hstep, voffA);
        if (wr == 1) PG8_BAR;
        PG8_WAIT_V(2); PG8_BAR;
        PG8_STAGE(PG8_SB(1, 0), cB + kstep, voffB); PG8_STAGE(PG8_SA(1, 0), cA + kstep, voffA); PG8_STAGE(PG8_SB(1, 1), cB + hstep + kstep, voffB);
        PG8_WAIT_V(6); PG8_BAR;
    } else {
        PG8_STAGE(PG8_SB(0, 0), cB, voffB); PG8_STAGE(PG8_SA(0, 0), cA, voffA); PG8_STAGE(PG8_SB(0, 1), cB + hstep, voffB); PG8_STAGE(PG8_SA(0, 1), cA + hstep, voffA);
        if (wr == 1) PG8_BAR;
        PG8_WAIT_V(4); PG8_BAR;
        PG8_STAGE(PG8_SB(1, 0), cB + kstep, voffB); PG8_STAGE(PG8_SA(1, 0), cA + kstep, voffA); PG8_STAGE(PG8_SB(1, 1), cB + hstep + kstep, voffB);
        PG8_WAIT_V(6); PG8_BAR;
    }
    for (;;) {
        const bool has_next = S.next(ui + 1, nxt);
        const char* nA = has_next ? (const char*)g.A + (size_t)nxt.pm * tstep : cA; const char* nB = has_next ? (const char*)g.Bt + (size_t)nxt.pn * tstep : cB;
        for (int t = 0; t < nt; t += 2) {
            const bool last = (t == nt - 2);
            const char* a1 = cA + (size_t)(t + 1) * kstep;
            const char* a2 = last ? nA : cA + (size_t)(t + 2) * kstep; const char* b2 = last ? nB : cB + (size_t)(t + 2) * kstep;
            const char* a3 = a2 + kstep; const char* b3 = b2 + kstep;
            if (last && has_next) S.a_ready(nxt);
            if constexpr (SP2) {
            PG8_LDB(B0, 0, 0); PG8_LDB(B1, 0, 1); PG8_SCHED; PG8_LDA(At, 0, 0); PG8_STAGE(PG8_SA(1, 1), a1 + hstep, voffA);
            PG8_WAIT_V(8); PG8_WAIT_L(0); PG8_BAR; PG8_MMA(0, 0, At, B0); PG8_MMA(0, 1, At, B1); PG8_BAR; PG8_SCHED;
            PG8_LDA(At, 0, 1); PG8_STAGE(PG8_SB(0, 0), b2, voffB); PG8_STAGE(PG8_SB(0, 1), b2 + hstep, voffB); PG8_STAGE(PG8_SA(0, 0), a2, voffA);
            PG8_WAIT_V(8); PG8_WAIT_L(0); PG8_BAR; PG8_MMA(1, 0, At, B0); PG8_MMA(1, 1, At, B1); PG8_BAR; PG8_SCHED;
            PG8_LDB(B0, 1, 0); PG8_LDB(B1, 1, 1); PG8_SCHED; PG8_LDA(At, 1, 0); PG8_STAGE(PG8_SA(0, 1), a2 + hstep, voffA);
            PG8_WAIT_V(8); PG8_WAIT_L(0); PG8_BAR; PG8_MMA(0, 0, At, B0); PG8_MMA(0, 1, At, B1); PG8_BAR; PG8_SCHED;
            PG8_LDA(At, 1, 1); PG8_STAGE(PG8_SB(1, 0), b3, voffB); PG8_STAGE(PG8_SB(1, 1), b3 + hstep, voffB); PG8_STAGE(PG8_SA(1, 0), a3, voffA);
            PG8_WAIT_V(8); PG8_WAIT_L(0); PG8_BAR; PG8_MMA(1, 0, At, B0); PG8_MMA(1, 1, At, B1); PG8_BAR; PG8_SCHED;
            } else {
            PG8_LDB(B0, 0, 0); PG8_SCHED; PG8_LDA(At, 0, 0); PG8_STAGE(PG8_SA(1, 1), a1 + hstep, voffA);
            PG8_WAIT_L(8); PG8_BAR; PG8_WAIT_L(0); PG8_MMA(0, 0, At, B0); PG8_BAR; PG8_SCHED;
            PG8_LDB(B1, 0, 1); PG8_STAGE(PG8_SB(0, 0), b2, voffB);
            PG8_BAR; PG8_WAIT_L(0); PG8_MMA(0, 1, At, B1); PG8_BAR;
            PG8_LDA(At, 0, 1); PG8_STAGE(PG8_SA(0, 0), a2, voffA);
            PG8_BAR; PG8_WAIT_L(0); PG8_MMA(1, 0, At, B0); PG8_BAR; PG8_SCHED;
            PG8_STAGE(PG8_SB(0, 1), b2 + hstep, voffB);
            PG8_WAIT_V(6); PG8_BAR; PG8_MMA(1, 1, At, B1); PG8_BAR;
            PG8_LDB(B0, 1, 0); PG8_SCHED; PG8_LDA(At, 1, 0); PG8_STAGE(PG8_SA(0, 1), a2 + hstep, voffA);
            PG8_WAIT_L(8); PG8_BAR; PG8_WAIT_L(0); PG8_MMA(0, 0, At, B0); PG8_BAR; PG8_SCHED;
            PG8_LDB(B1, 1, 1); PG8_STAGE(PG8_SB(1, 0), b3, voffB);
            PG8_BAR; PG8_WAIT_L(0); PG8_MMA(0, 1, At, B1); PG8_BAR;
            PG8_LDA(At, 1, 1); PG8_STAGE(PG8_SA(1, 0), a3, voffA);
            PG8_BAR; PG8_WAIT_L(0); PG8_MMA(1, 0, At, B0); PG8_BAR; PG8_SCHED;
            PG8_STAGE(PG8_SB(1, 1), b3 + hstep, voffB);
            PG8_WAIT_V(6); PG8_BAR; PG8_MMA(1, 1, At, B1); PG8_BAR;
            }
        }
        if constexpr (ALIGN_EPI) { if (wr == 0) PG8_BAR; }
        if constexpr (!Epi::AFTER_DRAIN) { E(acc, cur, wr, wc, fr, fq); S.done(cur); }
        if (!has_next) break;
#pragma unroll
        for (int a = 0; a < 2; ++a)
#pragma unroll
            for (int b = 0; b < 2; ++b)
#pragma unroll
                for (int m = 0; m < 4; ++m)
#pragma unroll
                    for (int n = 0; n < 2; ++n) acc[a][b][m][n] = (f32x4){0.f, 0.f, 0.f, 0.f};
        cur = nxt; cA = nA; cB = nB; ++ui;
        if constexpr (ALIGN_EPI) { if (wr == 1) PG8_BAR; }
    }
    PG8_WAIT_V(0);
    if constexpr (!ALIGN_EPI) { if (wr == 0) PG8_BAR; }
    PG8_BAR;
    if constexpr (Epi::AFTER_DRAIN) { E.fused(acc, cur, wr, wc, fr, fq, lds, wid, lane); S.done(cur); }
#undef PG8_SA
#undef PG8_SB
#undef PG8_STAGE
#undef PG8_LDA
#undef PG8_LDB
#undef PG8_MMA
#undef PG8_WAIT_V
#undef PG8_WAIT_L
#undef PG8_BAR
#undef PG8_SCHED
}
}
#define GAS __attribute__((address_space(1)))
#define LAS __attribute__((address_space(3)))
typedef unsigned short bf16;
typedef unsigned v4u __attribute__((ext_vector_type(4)));
typedef float f32x4 __attribute__((ext_vector_type(4)));
typedef short bf16x8 __attribute__((ext_vector_type(8)));
typedef GAS unsigned gu32;
typedef GAS unsigned long long gu64;
#define RLX_AGENT __ATOMIC_RELAXED, __HIP_MEMORY_SCOPE_AGENT
#define LDS_WAIT() asm volatile("s_waitcnt lgkmcnt(0)" ::: "memory")
#define VM_WAIT() asm volatile("s_waitcnt vmcnt(0)" ::: "memory")
__device__ __forceinline__ unsigned long long rt() { return __builtin_amdgcn_s_memrealtime(); }
__device__ __forceinline__ unsigned f2bf(float f) { unsigned u = __builtin_bit_cast(unsigned, f); return (u + 0x7fffu + ((u >> 16) & 1u)) >> 16; }
__device__ __forceinline__ unsigned pk2(float lo, float hi) { return f2bf(lo) | (f2bf(hi) << 16); }

#define XB_TMO      128
#define XB_XCNT(j)  (256  + 64 * (j))
#define XB_XSUB(j)  (1280 + 64 * (j))
#define XB_XGEN(j)  (2304 + 64 * (j))
#define XB_TOP      3328
#define XB_TOPGEN   3392
#define XCD_BAR_WORDS 3456
#define XB_SPIN_CAP (1u << 18)

__device__ __forceinline__ unsigned xb_ld(unsigned* p)              { return __hip_atomic_load(p, __ATOMIC_RELAXED, __HIP_MEMORY_SCOPE_AGENT); }
__device__ __forceinline__ unsigned xb_add(unsigned* p, unsigned v) { return __hip_atomic_fetch_add(p, v, __ATOMIC_RELAXED, __HIP_MEMORY_SCOPE_AGENT); }
__device__ __forceinline__ unsigned xb_xcc_id() { return (unsigned)__builtin_amdgcn_s_getreg((3 << 11) | 20) & 0xFu; }
#define XB_SPIN(cond, bar) do { unsigned _sp = 0; while (cond) { __builtin_amdgcn_s_sleep(1); \
    if ((++_sp & 255u) == 0u) { if (xb_ld(&(bar)[XB_TMO])) break; if (_sp > XB_SPIN_CAP) { atomicAdd(&(bar)[XB_TMO], 1u); break; } } } } while (0)

struct XcdBarrier {
    unsigned* bar; unsigned x;
    volatile LAS unsigned* st;
};

__device__ __forceinline__ XcdBarrier xcd_barrier_post(unsigned* bar, volatile LAS unsigned* st) {
    XcdBarrier b; b.bar = bar; b.x = xb_xcc_id(); b.st = st;
    if (threadIdx.x == 0) (void)xb_add(&bar[XB_XCNT(b.x)], 1u);
    return b;
}
__device__ __forceinline__ void xcd_barrier_complete(unsigned* bar, unsigned x, unsigned& nloc, unsigned& nx) {
    const unsigned G = gridDim.x * gridDim.y * gridDim.z;
    unsigned sum, cnt, mine, sp = 0u;
    for (;;) {
        sum = 0u; cnt = 0u; mine = 0u;
#pragma unroll
        for (unsigned j = 0; j < 16; ++j) { const unsigned c = xb_ld(&bar[XB_XCNT(j)]); sum += c; cnt += (c > 0u) ? 1u : 0u; mine = (j == x) ? c : mine; }
        if (sum == G) break;
        __builtin_amdgcn_s_sleep(1);
        if ((++sp & 255u) == 0u) { if (xb_ld(&bar[XB_TMO])) break; if (sp > XB_SPIN_CAP) { atomicAdd(&bar[XB_TMO], 1u); break; } }
    }
    nloc = mine > 0u ? mine : 1u; nx = cnt > 0u ? cnt : 1u;
}

__device__ __forceinline__ void xcd_barrier(const XcdBarrier& b) {
    asm volatile("s_waitcnt vmcnt(0)" ::: "memory");
    __syncthreads();
    if (threadIdx.x == 0) {
        unsigned* bar = b.bar;
        __builtin_amdgcn_s_waitcnt(0);
        unsigned nloc = b.st[0], nx = b.st[1];
        if (nloc == 0u) { xcd_barrier_complete(bar, b.x, nloc, nx); b.st[0] = nloc; b.st[1] = nx; }
        const unsigned old = xb_add(&bar[XB_XSUB(b.x)], 1u);
        const unsigned gen = old / nloc;
        if (old + 1u == (gen + 1u) * nloc) {
            __builtin_amdgcn_fence(__ATOMIC_RELEASE, "agent");
            asm volatile("s_waitcnt vmcnt(0)" ::: "memory");
            const unsigned og = xb_add(&bar[XB_TOP], 1u);
            const unsigned tg = og / nx;
            if (og + 1u == (tg + 1u) * nx) xb_add(&bar[XB_TOPGEN], 1u);
            else XB_SPIN(xb_ld(&bar[XB_TOPGEN]) == tg, bar);
            __builtin_amdgcn_fence(__ATOMIC_ACQUIRE, "agent");
            xb_add(&bar[XB_XGEN(b.x)], 1u);
            asm volatile("s_waitcnt vmcnt(0)" ::: "memory");
        } else {
            XB_SPIN(xb_ld(&bar[XB_XGEN(b.x)]) == gen, bar);
            __builtin_amdgcn_fence(__ATOMIC_ACQUIRE, "agent");
            asm volatile("s_waitcnt vmcnt(0)" ::: "memory");
        }
    }
    __syncthreads();
}

constexpr int NWAVES = 8, NTHREADS = 512;
constexpr int DM = 2048, NP_ROWS = 8192, NS_ROWS = 128, NROWS = 8320, MPAD = 8448;
constexpr int DEPTH = 4, NBATCH = 36;
constexpr int INW = 4368, ZW = 4608;
constexpr int ZQ = 0, ZK = 512, ZV = 640, ZU = 768, GQ = 1280, GK = 1792, GV = 2304, GG = 3328, GA = 4352;
constexpr int DFF = 5632, NGU = 11264, MODW = 12288, MODLD = 49152;
constexpr float EPS = 1e-6f;
constexpr size_t O_Y = 0, O_WK_P = 17039360, O_WV_P = 17301504, O_POOL_P = 17563648, O_GLA_P = 17686528,
                 O_WK_S = 19783680, O_WV_S = 21880832, O_POOL_S = 23977984, O_GLA_S = 24961024, O_END = 41738240;
constexpr size_t MiB = 1u << 20;
constexpr size_t WS_CTL = 0, CTL_ZERO_BYTES = 1 * MiB;
constexpr size_t WS_WADA = 1 * MiB;
constexpr size_t WS_WIN  = WS_WADA + 192 * MiB;
constexpr size_t WS_WOUT = WS_WIN + 72 * MiB;
constexpr size_t WS_WGU  = WS_WOUT + 32 * MiB;
constexpr size_t WS_WDN  = WS_WGU + 176 * MiB;
constexpr size_t WS_X    = WS_WDN + 88 * MiB;
constexpr size_t WS_H    = WS_X + 66 * MiB;
constexpr size_t WS_Z    = WS_H + 33 * MiB;
constexpr size_t WS_MIX  = WS_Z + 75 * MiB;
constexpr size_t WS_ACT  = WS_MIX + 33 * MiB;
constexpr size_t WS_OGLA = WS_ACT + 91 * MiB;
constexpr size_t WS_LA   = WS_OGLA + 33 * MiB;
constexpr size_t WS_MOD  = WS_LA + 17 * MiB;
constexpr size_t WS_SC   = WS_MOD + 7 * MiB;
constexpr size_t WS_BTAB = WS_SC + 1 * MiB;
constexpr size_t WS_WPT  = WS_BTAB + 1 * MiB;
constexpr size_t WS_END  = WS_WPT + 1 * MiB;
constexpr int CW_BAR = 4096;
constexpr int RING_OFF = 0, RING_BYTES = 131072;
constexpr int LDSCTL_OFF = RING_BYTES, MISC_OFF = LDSCTL_OFF + 320;
constexpr int LDS_BYTES = 147456;

struct Args { const float* in[24]; float* out; unsigned char* ws; int ph_lo, ph_hi; };
struct Frame {
    LAS unsigned char* lds;
    volatile LAS unsigned* MISC;
    int wave, vcu, G; int zo;
    __device__ __forceinline__ int lane_id() const { return (int)__builtin_amdgcn_mbcnt_hi(~0u, __builtin_amdgcn_mbcnt_lo(~0u, 0u)); }
    unsigned char* ws; float* out;
    __device__ __forceinline__ bf16* Wada_t() const { return (bf16*)(ws + WS_WADA); }
    __device__ __forceinline__ bf16* Win_t() const { return (bf16*)(ws + WS_WIN); }
    __device__ __forceinline__ bf16* Wout_t() const { return (bf16*)(ws + WS_WOUT); }
    __device__ __forceinline__ bf16* Wgu_t() const { return (bf16*)(ws + WS_WGU); }
    __device__ __forceinline__ bf16* Wdn_t() const { return (bf16*)(ws + WS_WDN); }
    __device__ __forceinline__ float* X() const { return (float*)(ws + WS_X); }
    __device__ __forceinline__ bf16* H() const { return (bf16*)(ws + WS_H); }
    __device__ __forceinline__ bf16* Z() const { return (bf16*)(ws + WS_Z); }
    __device__ __forceinline__ bf16* MIX() const { return (bf16*)(ws + WS_MIX); }
    __device__ __forceinline__ bf16* ACT() const { return (bf16*)(ws + WS_ACT); }
    __device__ __forceinline__ float* OGLA() const { return (float*)(ws + WS_OGLA); }
    __device__ __forceinline__ float* SLOC() const { return (float*)(ws + WS_LA); }
    __device__ __forceinline__ float* DSEG() const { return (float*)(ws + WS_LA + 16 * MiB); }
    __device__ __forceinline__ float* MOD() const { return (float*)(ws + WS_MOD); }
    __device__ __forceinline__ bf16* SC() const { return (bf16*)(ws + WS_SC); }
    __device__ __forceinline__ float* BTAB() const { return (float*)(ws + WS_BTAB); }
    __device__ __forceinline__ bf16* WPT() const { return (bf16*)(ws + WS_WPT); }
};
enum { I_XP = 0, I_XS, I_CK, I_CV, I_SPOOL, I_SGLA, I_CP, I_CS, I_WADA, I_BADA, I_GMIX, I_GFFN, I_WIN, I_WOUT, I_RELB, I_SINKS, I_WPOOL, I_PSCALE, I_WA2, I_BA2, I_GGLA, I_WGU, I_WDN, I_GFIN };

__device__ __forceinline__ float bf2f(unsigned short b) { return __uint_as_float((unsigned)b << 16); }
__device__ __forceinline__ float bflo(unsigned w) { return __uint_as_float(w << 16); }
__device__ __forceinline__ float bfhi(unsigned w) { return __uint_as_float(w & 0xffff0000u); }
__device__ __forceinline__ float wave_sum(float v) {
#pragma unroll
    for (int o = 1; o < 64; o <<= 1) v += __shfl_xor(v, o);
    return v;
}
__device__ __forceinline__ float wave_max(float v) {
#pragma unroll
    for (int o = 1; o < 64; o <<= 1) v = fmaxf(v, __shfl_xor(v, o));
    return v;
}
__device__ __forceinline__ int t5_bucket(int n) {
    if (n < 16) return n;
    return 16 + (n >= 19) + (n >= 21) + (n >= 24) + (n >= 27) + (n >= 31) + (n >= 35) + (n >= 40) + (n >= 46) + (n >= 52) + (n >= 59) + (n >= 67) + (n >= 77) + (n >= 87) + (n >= 99) + (n >= 113);
}

template <int MODE>
__device__ __forceinline__ void transpose_item(const float* W, int K, int N, int nblk, bf16* WT, int row_off, LAS float* scr, int item, int lane) {
    const int kb = item / nblk, nb = item % nblk, k0 = 64 * kb, n0 = 32 * nb;
    const int nn = n0 + (lane & 31); const bool ok = nn < N;
#pragma unroll 8
    for (int i = 0; i < 32; ++i) { const int kk = 2 * i + (lane >> 5); scr[kk * 33 + (lane & 31)] = ok ? W[(size_t)(k0 + kk) * N + nn] : 0.f; }
    LDS_WAIT(); asm volatile("" ::: "memory");
    const int c = lane & 7;
#pragma unroll
    for (int j = 0; j < 4; ++j) { const int n = (lane >> 3) + 8 * j; const LAS float* s = scr + (8 * c) * 33 + n;
        v4u o; o.x = pk2(s[0 * 33], s[1 * 33]); o.y = pk2(s[2 * 33], s[3 * 33]); o.z = pk2(s[4 * 33], s[5 * 33]); o.w = pk2(s[6 * 33], s[7 * 33]);
        int orow = n0 + n;
        if (MODE == 1) { orow = (orow < DFF) ? ((orow >> 7) * 256 + (orow & 127)) : (((orow - DFF) >> 7) * 256 + 128 + ((orow - DFF) & 127)); }
        *(GAS v4u*)(WT + (size_t)(row_off + orow) * K + k0 + 8 * c) = o; }
    LDS_WAIT(); asm volatile("" ::: "memory");
}
__device__ __forceinline__ void p0_prologue(Frame& F, const Args& A) {
    LAS float* scr = (LAS float*)(F.lds + RING_OFF + F.wave * 16384);
    const int gw = F.vcu * NWAVES + F.wave, NGW = F.G * NWAVES;
    const int gt = gw * 64 + F.lane_id(), NGT = NGW * 64;
    constexpr int I_ADA = 32 * 384, I_IN = 32 * 137, I_OUT = 32 * 64, I_GU = 32 * 352, I_DN = 88 * 64, I_L = I_ADA + I_IN + I_OUT + I_GU + I_DN;
    for (int it = gw; it < DEPTH * I_L; it += NGW) {
        const int l = it / I_L; int r = it - l * I_L;
        if (r < I_ADA) { transpose_item<0>(A.in[F.zo + I_WADA] + (size_t)l * DM * MODW, DM, MODW, 384, F.Wada_t(), l * MODW, scr, r, F.lane_id()); continue; } r -= I_ADA;
        if (r < I_IN)  { transpose_item<0>(A.in[F.zo + I_WIN] + (size_t)l * DM * INW, DM, INW, 137, F.Win_t() + (size_t)l * ZW * DM, 0, scr, r, F.lane_id()); continue; } r -= I_IN;
        if (r < I_OUT) { transpose_item<0>(A.in[F.zo + I_WOUT] + (size_t)l * DM * DM, DM, DM, 64, F.Wout_t() + (size_t)l * DM * DM, 0, scr, r, F.lane_id()); continue; } r -= I_OUT;
        if (r < I_GU)  { transpose_item<1>(A.in[F.zo + I_WGU] + (size_t)l * DM * NGU, DM, NGU, 352, F.Wgu_t() + (size_t)l * NGU * DM, 0, scr, r, F.lane_id()); continue; } r -= I_GU;
        transpose_item<0>(A.in[F.zo + I_WDN] + (size_t)l * DFF * DM, DFF, DM, 64, F.Wdn_t() + (size_t)l * DM * DFF, 0, scr, r, F.lane_id());
    }
    const v4u z4 = {0u, 0u, 0u, 0u};
    for (int i = gt; i < DEPTH * 224 * 256; i += NGT) { const int l = i / (224 * 256), r = i - l * (224 * 256); *((GAS v4u*)(F.Win_t() + ((size_t)l * ZW + 4384) * DM) + r) = z4; }
    for (int i = gt; i < 128 * 256; i += NGT) { *((GAS v4u*)(F.H() + (size_t)NROWS * DM) + i) = z4; *((GAS v4u*)(F.MIX() + (size_t)NROWS * DM) + i) = z4; }
    for (int i = gt; i < 128 * 704; i += NGT) *((GAS v4u*)(F.ACT() + (size_t)NROWS * DFF) + i) = z4;
    for (int i = gt; i < NP_ROWS * 512; i += NGT) ((GAS f32x4*)F.X())[i] = ((const GAS f32x4*)A.in[F.zo + I_XP])[i];
    for (int i = gt; i < NS_ROWS * 512; i += NGT) ((GAS f32x4*)(F.X() + (size_t)NP_ROWS * DM))[i] = ((const GAS f32x4*)A.in[F.zo + I_XS])[i];
    for (int i = gt; i < 256 * 1024; i += NGT) { const int r = i >> 10, cp = (i & 1023) * 2; unsigned w = 0u;
        if (r < NBATCH) { const float* c = (r < 4) ? (A.in[F.zo + I_CP] + (size_t)r * DM) : (A.in[F.zo + I_CS] + (size_t)(r - 4) * DM); const float a = c[cp], b = c[cp + 1];
            w = pk2(a / (1.0f + __expf(-a)), b / (1.0f + __expf(-b))); }
        ((GAS unsigned*)F.SC())[i] = w; }
    for (int i = gt; i < 4 * 4 * 128 * 128; i += NGT) { const int lg = i >> 14, dcol = (i >> 7) & 127, c = i & 127; F.WPT()[i] = (bf16)f2bf(A.in[F.zo + I_WPOOL][((size_t)lg * 128 + c) * 128 + dcol]); }
    for (int i = gt; i < 8 * 128; i += NGT) { const int h = i >> 7, dist = i & 127; F.BTAB()[i] = A.in[F.zo + I_RELB][t5_bucket(dist) * 8 + h]; }
}

__device__ __forceinline__ void norm_mod_rows(Frame& F, const float* g, const float* modl  ) {
    const int gw = F.vcu * NWAVES + F.wave, NGW = F.G * NWAVES;
    for (int r = gw; r < NROWS; r += NGW) {
        const int b = r < NP_ROWS ? (r >> 11) : 4 + ((r - NP_ROWS) >> 2);
        const float* xr = F.X() + (size_t)r * DM + 4 * F.lane_id(); const float* sh = modl + (size_t)b * MODLD + 4 * F.lane_id(); const float* gg = g + 4 * F.lane_id();
        f32x4 v[8]; float ss = 0.f;
#pragma unroll
        for (int j = 0; j < 8; ++j) { v[j] = *(const f32x4*)(xr + 256 * j); ss += (v[j].x * v[j].x + v[j].y * v[j].y) + (v[j].z * v[j].z + v[j].w * v[j].w); }
        const float rstd = 1.0f / sqrtf(wave_sum(ss) * (1.0f / DM) + EPS);
        bf16* hr = F.H() + (size_t)r * DM + 4 * F.lane_id();
#pragma unroll
        for (int j = 0; j < 8; ++j) { const f32x4 gv = *(const f32x4*)(gg + 256 * j), sv = *(const f32x4*)(sh + 256 * j), cv = *(const f32x4*)(sh + 2048 + 256 * j);
            const f32x4 y = (v[j] * rstd * gv) * (1.0f + cv) + sv;
            uint2 w; w.x = pk2(y.x, y.y); w.y = pk2(y.z, y.w); *(uint2*)(hr + 256 * j) = w; }
    }
}
__device__ __forceinline__ void final_norm_rows(Frame& F, const Args& A) {
    const int gw = F.vcu * NWAVES + F.wave, NGW = F.G * NWAVES; const float* g = A.in[F.zo + I_GFIN] + 4 * F.lane_id();
    for (int r = gw; r < NROWS; r += NGW) {
        const float* xr = F.X() + (size_t)r * DM + 4 * F.lane_id();
        f32x4 v[8]; float ss = 0.f;
#pragma unroll
        for (int j = 0; j < 8; ++j) { v[j] = *(const f32x4*)(xr + 256 * j); ss += (v[j].x * v[j].x + v[j].y * v[j].y) + (v[j].z * v[j].z + v[j].w * v[j].w); }
        const float rstd = 1.0f / sqrtf(wave_sum(ss) * (1.0f / DM) + EPS);
        float* yr = F.out + O_Y + (size_t)r * DM + 4 * F.lane_id();
#pragma unroll
        for (int j = 0; j < 8; ++j) { const f32x4 gv = *(const f32x4*)(g + 256 * j); *(f32x4*)(yr + 256 * j) = v[j] * rstd * gv; }
    }
}

__device__ __forceinline__ void attn_item(Frame& F, const Args& A, int l, int r, int hd, LAS float* ps) {
    const int lane = F.lane_id(), g = hd >> 2; const bool smp = r >= NP_ROWS;
    const int t = r & 2047, sb = smp ? ((r - NP_ROWS) >> 2) : 0, si = (r - NP_ROWS) & 3;
    LAS float* qs = ps + 128;
    { const unsigned w = ((const unsigned*)(F.Z() + (size_t)r * ZW + ZQ + hd * 64))[lane & 31]; if (lane < 32) { qs[2 * lane] = bflo(w); qs[2 * lane + 1] = bfhi(w); } }
    LDS_WAIT(); asm volatile("" ::: "memory");
    const float* ck = A.in[F.zo + I_CK] + ((size_t)(l * 32 + sb) * 128) * 128 + g * 64;
    const float* cv = A.in[F.zo + I_CV] + ((size_t)(l * 32 + sb) * 128) * 128 + g * 64;
    const int jmin = smp ? 0 : (t >= 127 ? 0 : 127 - t);
    float sc[2];
#pragma unroll 1
    for (int jj = 0; jj < 2; ++jj) {
        const int j = lane + 64 * jj, dist = 127 - j; float dot = 0.f; bool valid = j >= jmin;
        if (valid) {
            const int krel = si - dist;
            if (smp && krel < 0) {
                const f32x4* kp = (const f32x4*)(ck + (size_t)(krel + 128) * 128);
#pragma unroll 4
                for (int c = 0; c < 16; ++c) { const f32x4 kv = kp[c]; const f32x4 qv = *(const LAS f32x4*)(qs + 4 * c); dot += qv.x * kv.x + qv.y * kv.y + qv.z * kv.z + qv.w * kv.w; }
            } else {
                const int krow = smp ? (NP_ROWS + sb * 4 + krel) : (r - dist);
                const v4u* kp = (const v4u*)(F.Z() + (size_t)krow * ZW + ZK + g * 64);
#pragma unroll 4
                for (int c = 0; c < 8; ++c) { const v4u w = kp[c];
                    const f32x4 qa = *(const LAS f32x4*)(qs + 8 * c), qb = *(const LAS f32x4*)(qs + 8 * c + 4);
                    dot += qa.x * bflo(w.x) + qa.y * bfhi(w.x) + qa.z * bflo(w.y) + qa.w * bfhi(w.y) + qb.x * bflo(w.z) + qb.y * bfhi(w.z) + qb.z * bflo(w.w) + qb.w * bfhi(w.w); }
            }
        }
        const float sv = valid ? dot * 0.125f + F.BTAB()[hd * 128 + dist] : -INFINITY;
        if (jj == 0) sc[0] = sv; else sc[1] = sv;
    }
    const float sink = A.in[F.zo + I_SINKS][l * 8 + hd];
    const float m = fmaxf(wave_max(fmaxf(sc[0], sc[1])), sink);
    const float p0 = __expf(sc[0] - m), p1 = __expf(sc[1] - m);
    const float denom = wave_sum(p0 + p1) + __expf(sink - m);
    ps[lane] = p0; ps[lane + 64] = p1;
    LDS_WAIT(); asm volatile("" ::: "memory");
    float o = 0.f;
    for (int j = jmin; j < 128; ++j) {
        const float pj = ps[j]; const int dist = 127 - j; float vv;
        const int krel = si - dist;
        if (smp && krel < 0) vv = cv[(size_t)(krel + 128) * 128 + lane];
        else { const int krow = smp ? (NP_ROWS + sb * 4 + krel) : (r - dist); vv = bf2f(F.Z()[(size_t)krow * ZW + ZV + g * 64 + lane]); }
        o += pj * vv;
    }
    F.MIX()[(size_t)r * DM + hd * 64 + lane] = (bf16)f2bf(o / denom);
    LDS_WAIT(); asm volatile("" ::: "memory");
}
__device__ __forceinline__ void pool_item(Frame& F, const Args& A, int l, int r, int gi, LAS float* ds) {
    const int lane = F.lane_id(), w = 2 << gi; const bool smp = r >= NP_ROWS;
    const int t = r & 2047, sb = (r - NP_ROWS) >> 2, si = (r - NP_ROWS) & 3;
    const float* pbuf = A.in[F.zo + I_SPOOL] + ((size_t)(l * 32 + sb) * 15) * 512 + gi * 128;
    float s0 = 0.f, s1 = 0.f, u0 = 0.f, u1 = 0.f;
    for (int o = 0; o < w; ++o) {
        float a0 = 0.f, a1 = 0.f;
        if (!smp) { if (t - o >= 0) { const bf16* zp = F.Z() + (size_t)(r - o) * ZW + ZU + gi * 128; a0 = bf2f(zp[lane]); a1 = bf2f(zp[lane + 64]); } }
        else { const int idx = si - o;
            if (idx >= 0) { const bf16* zp = F.Z() + (size_t)(NP_ROWS + sb * 4 + idx) * ZW + ZU + gi * 128; a0 = bf2f(zp[lane]); a1 = bf2f(zp[lane + 64]); }
            else { const float* bp = pbuf + (size_t)(15 + idx) * 512; a0 = bp[lane]; a1 = bp[lane + 64]; } }
        if (o == 0) { u0 = a0; u1 = a1; }
        s0 += a0; s1 += a1;
    }
    const float cnt = smp ? (float)w : (float)((t + 1) < w ? (t + 1) : w);
    ds[lane] = s0 / cnt - u0; ds[lane + 64] = s1 / cnt - u1;
    LDS_WAIT(); asm volatile("" ::: "memory");
    const float* wp = A.in[F.zo + I_WPOOL] + ((size_t)(l * 4 + gi) * 128) * 128;
    float y0 = 0.f, y1 = 0.f;
#pragma unroll 4
    for (int c = 0; c < 128; ++c) { const float dv = ds[c]; y0 += dv * wp[c * 128 + lane]; y1 += dv * wp[c * 128 + lane + 64]; }
    const float* psc = A.in[F.zo + I_PSCALE] + l * 512 + gi * 128;
    bf16* mp = F.MIX() + (size_t)r * DM + 512 + gi * 128;
    mp[lane] = (bf16)f2bf(y0 * psc[lane]); mp[lane + 64] = (bf16)f2bf(y1 * psc[lane + 64]);
    LDS_WAIT(); asm volatile("" ::: "memory");
}
__device__ __forceinline__ void cache_outputs(Frame& F, const Args& A, int l) {
    const int gt = (F.vcu * NWAVES + F.wave) * 64 + F.lane_id(), NGT = F.G * NWAVES * 64;
    for (int i = gt; i < 4 * 128 * 128; i += NGT) { const int b = i >> 14, j = (i >> 7) & 127, c = i & 127; const bf16* zr = F.Z() + (size_t)(b * 2048 + 1920 + j) * ZW;
        F.out[O_WK_P + (size_t)l * 65536 + i] = bf2f(zr[ZK + c]); F.out[O_WV_P + (size_t)l * 65536 + i] = bf2f(zr[ZV + c]); }
    for (int i = gt; i < 4 * 15 * 512; i += NGT) { const int b = i / 7680, rem = i - b * 7680, j = rem >> 9, c = rem & 511;
        F.out[O_POOL_P + (size_t)l * 30720 + i] = bf2f(F.Z()[(size_t)(b * 2048 + 2033 + j) * ZW + ZU + c]); }
    for (int i = gt; i < 32 * 128 * 128; i += NGT) { const int sb = i >> 14, p = (i >> 7) & 127, c = i & 127; float kv, vv;
        if (p < 124) { const size_t src = ((size_t)(l * 32 + sb) * 128 + p + 4) * 128 + c; kv = A.in[F.zo + I_CK][src]; vv = A.in[F.zo + I_CV][src]; }
        else { const bf16* zr = F.Z() + (size_t)(NP_ROWS + sb * 4 + p - 124) * ZW; kv = bf2f(zr[ZK + c]); vv = bf2f(zr[ZV + c]); }
        F.out[O_WK_S + (size_t)l * 524288 + i] = kv; F.out[O_WV_S + (size_t)l * 524288 + i] = vv; }
    for (int i = gt; i < 32 * 15 * 512; i += NGT) { const int sb = i / 7680, rem = i - sb * 7680, j = rem >> 9, c = rem & 511; float v;
        if (j < 11) v = A.in[F.zo + I_SPOOL][((size_t)(l * 32 + sb) * 15 + j + 4) * 512 + c];
        else v = bf2f(F.Z()[(size_t)(NP_ROWS + sb * 4 + j - 11) * ZW + ZU + c]);
        F.out[O_POOL_S + (size_t)l * 245760 + i] = v; }
}
__device__ __forceinline__ void gla_out_item(Frame& F, const Args& A, int l, int r, int hh) {
    const int lane = F.lane_id();
    const f32x4 o = *(const f32x4*)(F.OGLA() + (size_t)r * 1024 + hh * 256 + 4 * lane);
    const float ss = wave_sum((o.x * o.x + o.y * o.y) + (o.z * o.z + o.w * o.w));
    const float rstd = 1.0f / sqrtf(ss * (1.0f / 256.0f) + EPS);
    const f32x4 gv = *(const f32x4*)(A.in[F.zo + I_GGLA] + l * 1024 + hh * 256 + 4 * lane);
    const uint2 gw = *(const uint2*)(F.Z() + (size_t)r * ZW + GG + hh * 256 + 4 * lane);
    const float g0 = bflo(gw.x), g1 = bfhi(gw.x), g2 = bflo(gw.y), g3 = bfhi(gw.y);
    const float y0 = o.x * rstd * gv.x * (g0 / (1.0f + __expf(-g0))), y1 = o.y * rstd * gv.y * (g1 / (1.0f + __expf(-g1)));
    const float y2 = o.z * rstd * gv.z * (g2 / (1.0f + __expf(-g2))), y3 = o.w * rstd * gv.w * (g3 / (1.0f + __expf(-g3)));
    uint2 w; w.x = pk2(y0, y1); w.y = pk2(y2, y3);
    *(uint2*)(F.MIX() + (size_t)r * DM + 1024 + hh * 256 + 4 * lane) = w;
}
constexpr int GL_QD = 0, GL_KD = 17408, GL_KDT = 34816, GL_VT = 53248, GL_AM = 71680, GL_ST = 80896, GL_DL = 115712, GL_BS = 116224, GL_END = 118272;
static_assert(GL_END <= RING_BYTES, "GLA LDS map");
typedef unsigned u32x2 __attribute__((ext_vector_type(2)));
__device__ __forceinline__ u32x2 pack4bf(const f32x4 v) { u32x2 w; w.x = pk2(v.x, v.y); w.y = pk2(v.z, v.w); return w; }
__device__ __forceinline__ void gla_chunks(Frame& F, const Args& A, int l, int row0, int nchunks, int nvalid, int hh, int eh, bool do_out, f32x4 (&sacc)[8], float& btot) {
    const int lane = F.lane_id(), wave = F.wave, tid = wave * 64 + lane, fr = lane & 15, fq = lane >> 4;
    const int d = tid & 127, qtr = tid >> 7, cg = hh * 128 + d;
    LAS bf16* QD = (LAS bf16*)(F.lds + GL_QD); LAS bf16* KD = (LAS bf16*)(F.lds + GL_KD); LAS bf16* KDT = (LAS bf16*)(F.lds + GL_KDT); LAS bf16* VT = (LAS bf16*)(F.lds + GL_VT);
    LAS bf16* AM = (LAS bf16*)(F.lds + GL_AM); LAS bf16* ST = (LAS bf16*)(F.lds + GL_ST); LAS float* DL = (LAS float*)(F.lds + GL_DL); LAS float* BS = (LAS float*)(F.lds + GL_BS);
    const bf16* Z = F.Z();
    float wa[16];
    { const float* wp = A.in[F.zo + I_WA2] + (size_t)l * 16 * 512 + cg;
#pragma unroll
      for (int j = 0; j < 16; ++j) wa[j] = wp[j * 512]; }
    const float ba = A.in[F.zo + I_BA2][l * 512 + cg];
    btot = 0.f;
    if (do_out) {
#pragma unroll
        for (int db = 0; db < 8; ++db) *(LAS u32x2*)(ST + (wave * 16 + fr) * 136 + db * 16 + 4 * fq) = pack4bf(sacc[db]);
    }
    for (int c = 0; c < nchunks; ++c) {
        const int r0 = row0 + c * 64;
        float bl[16]; float run = 0.f;
#pragma unroll
        for (int i = 0; i < 16; ++i) { const int t = 16 * qtr + i; float la = 0.f;
            if (t < nvalid) { const v4u* gp = (const v4u*)(Z + (size_t)(r0 + t) * ZW + GA); const v4u g0 = gp[0], g1 = gp[1];
                float x = ba + bflo(g0.x) * wa[0] + bfhi(g0.x) * wa[1] + bflo(g0.y) * wa[2] + bfhi(g0.y) * wa[3] + bflo(g0.z) * wa[4] + bfhi(g0.z) * wa[5] + bflo(g0.w) * wa[6] + bfhi(g0.w) * wa[7];
                x += bflo(g1.x) * wa[8] + bfhi(g1.x) * wa[9] + bflo(g1.y) * wa[10] + bfhi(g1.y) * wa[11] + bflo(g1.z) * wa[12] + bfhi(g1.z) * wa[13] + bflo(g1.w) * wa[14] + bfhi(g1.w) * wa[15];
                la = (fminf(x, 0.f) - log1pf(__expf(-fabsf(x)))) * (1.0f / 16.0f); }
            run += la; bl[i] = run; }
        BS[qtr * 128 + d] = run;
        __syncthreads();
        float pre = 0.f, tot = 0.f;
#pragma unroll
        for (int q2 = 0; q2 < 4; ++q2) { const float v = BS[q2 * 128 + d]; tot += v; if (q2 < qtr) pre += v; }
#pragma unroll
        for (int i = 0; i < 16; ++i) { const int t = 16 * qtr + i; const float b = pre + bl[i]; float qv = 0.f, kv = 0.f;
            if (t < nvalid) { const bf16* zr = Z + (size_t)(r0 + t) * ZW; qv = bf2f(zr[GQ + cg]); kv = bf2f(zr[GK + cg]); }
            QD[t * 136 + d] = (bf16)f2bf(qv * __expf(b) * 0.08838834764831845f); KD[t * 136 + d] = (bf16)f2bf(kv * __expf(-b)); KDT[d * 72 + t] = (bf16)f2bf(kv * __expf(tot - b)); }
        if (qtr == 0) DL[d] = __expf(tot);
        btot += tot;
        { const int s = tid >> 3, ec = tid & 7; v4u v0 = {0u, 0u, 0u, 0u}, v1 = {0u, 0u, 0u, 0u};
          if (s < nvalid) { const v4u* vp = (const v4u*)(Z + (size_t)(r0 + s) * ZW + GV + hh * 256 + eh * 128 + ec * 16); v0 = vp[0]; v1 = vp[1]; }
          LAS bf16* vt = VT + (ec * 16) * 72 + s;
          vt[0 * 72] = (bf16)(v0.x & 0xffffu); vt[1 * 72] = (bf16)(v0.x >> 16); vt[2 * 72] = (bf16)(v0.y & 0xffffu); vt[3 * 72] = (bf16)(v0.y >> 16);
          vt[4 * 72] = (bf16)(v0.z & 0xffffu); vt[5 * 72] = (bf16)(v0.z >> 16); vt[6 * 72] = (bf16)(v0.w & 0xffffu); vt[7 * 72] = (bf16)(v0.w >> 16);
          vt[8 * 72] = (bf16)(v1.x & 0xffffu); vt[9 * 72] = (bf16)(v1.x >> 16); vt[10 * 72] = (bf16)(v1.y & 0xffffu); vt[11 * 72] = (bf16)(v1.y >> 16);
          vt[12 * 72] = (bf16)(v1.z & 0xffffu); vt[13 * 72] = (bf16)(v1.z >> 16); vt[14 * 72] = (bf16)(v1.w & 0xffffu); vt[15 * 72] = (bf16)(v1.w >> 16); }
        __syncthreads();
        if (do_out) {
#pragma unroll
            for (int bi = 0; bi < 2; ++bi) { const int blk = 2 * wave + bi, tb = blk >> 2, sbk = blk & 3;
                f32x4 acc = {0.f, 0.f, 0.f, 0.f};
                if (sbk <= tb) {
#pragma unroll
                    for (int ks = 0; ks < 4; ++ks) { const bf16x8 a = *(const LAS bf16x8*)(KD + (sbk * 16 + fr) * 136 + ks * 32 + fq * 8), b = *(const LAS bf16x8*)(QD + (tb * 16 + fr) * 136 + ks * 32 + fq * 8);
                        acc = __builtin_amdgcn_mfma_f32_16x16x32_bf16(a, b, acc, 0, 0, 0); } }
                const int t = tb * 16 + fr, s0 = sbk * 16 + 4 * fq;
                f32x4 m; m.x = (s0 + 0 <= t) ? acc.x : 0.f; m.y = (s0 + 1 <= t) ? acc.y : 0.f; m.z = (s0 + 2 <= t) ? acc.z : 0.f; m.w = (s0 + 3 <= t) ? acc.w : 0.f;
                *(LAS u32x2*)(AM + t * 72 + s0) = pack4bf(m); }
            __syncthreads();
#pragma unroll
            for (int tb = 0; tb < 4; ++tb) { f32x4 o = {0.f, 0.f, 0.f, 0.f};
#pragma unroll
                for (int ks = 0; ks < 2; ++ks) { const bf16x8 a = *(const LAS bf16x8*)(VT + (wave * 16 + fr) * 72 + ks * 32 + fq * 8), b = *(const LAS bf16x8*)(AM + (tb * 16 + fr) * 72 + ks * 32 + fq * 8);
                    o = __builtin_amdgcn_mfma_f32_16x16x32_bf16(a, b, o, 0, 0, 0); }
#pragma unroll
                for (int ks = 0; ks < 4; ++ks) { const bf16x8 a = *(const LAS bf16x8*)(ST + (wave * 16 + fr) * 136 + ks * 32 + fq * 8), b = *(const LAS bf16x8*)(QD + (tb * 16 + fr) * 136 + ks * 32 + fq * 8);
                    o = __builtin_amdgcn_mfma_f32_16x16x32_bf16(a, b, o, 0, 0, 0); }
                const int t = tb * 16 + fr;
                if (t < nvalid) *(f32x4*)(F.OGLA() + (size_t)(r0 + t) * 1024 + hh * 256 + eh * 128 + wave * 16 + 4 * fq) = o; }
        }
#pragma unroll
        for (int db = 0; db < 8; ++db) { const f32x4 dl = *(const LAS f32x4*)(DL + db * 16 + 4 * fq); sacc[db] = sacc[db] * dl;
#pragma unroll
            for (int ks = 0; ks < 2; ++ks) { const bf16x8 a = *(const LAS bf16x8*)(KDT + (db * 16 + fr) * 72 + ks * 32 + fq * 8), b = *(const LAS bf16x8*)(VT + (wave * 16 + fr) * 72 + ks * 32 + fq * 8);
                sacc[db] = __builtin_amdgcn_mfma_f32_16x16x32_bf16(a, b, sacc[db], 0, 0, 0); } }
        if (do_out) {
#pragma unroll
            for (int db = 0; db < 8; ++db) *(LAS u32x2*)(ST + (wave * 16 + fr) * 136 + db * 16 + 4 * fq) = pack4bf(sacc[db]);
        }
        __syncthreads();
    }
}
__device__ __forceinline__ void gla_phase1(Frame& F, const Args& A, int l) {
    const int lane = F.lane_id(), wave = F.wave, tid = wave * 64 + lane, fr = lane & 15, fq = lane >> 4;
    for (int u = F.vcu; u < 256; u += F.G) { const int bh = u >> 4, seg = (u >> 1) & 7, eh = u & 1;
        if (seg == 7) continue;
        f32x4 sacc[8];
#pragma unroll
        for (int db = 0; db < 8; ++db) sacc[db] = (f32x4){0.f, 0.f, 0.f, 0.f};
        float btot;
        gla_chunks(F, A, l, (bh >> 2) * 2048 + seg * 256, 4, 64, bh & 3, eh, false, sacc, btot);
        float* sl = F.SLOC() + ((size_t)(bh * 8 + seg) * 128) * 256 + eh * 128 + wave * 16 + fr;
#pragma unroll
        for (int db = 0; db < 8; ++db) { const int d0 = db * 16 + 4 * fq; sl[(size_t)(d0 + 0) * 256] = sacc[db].x; sl[(size_t)(d0 + 1) * 256] = sacc[db].y; sl[(size_t)(d0 + 2) * 256] = sacc[db].z; sl[(size_t)(d0 + 3) * 256] = sacc[db].w; }
        if (eh == 0 && tid < 128) F.DSEG()[(bh * 8 + seg) * 128 + tid] = __expf(btot);
    }
    for (int u = F.vcu; u < 256; u += F.G) { const int sb = u >> 3, hh = (u >> 1) & 3, eh = u & 1; const size_t so = ((size_t)((l * 32 + sb) * 4 + hh)) * 32768 + eh * 128 + wave * 16 + fr;
        const float* s0 = A.in[F.zo + I_SGLA] + so;
        f32x4 sacc[8];
#pragma unroll
        for (int db = 0; db < 8; ++db) { const int d0 = db * 16 + 4 * fq; sacc[db].x = s0[(size_t)(d0 + 0) * 256]; sacc[db].y = s0[(size_t)(d0 + 1) * 256]; sacc[db].z = s0[(size_t)(d0 + 2) * 256]; sacc[db].w = s0[(size_t)(d0 + 3) * 256]; }
        float btot;
        gla_chunks(F, A, l, NP_ROWS + sb * 4, 1, 4, hh, eh, true, sacc, btot);
        float* so_ = F.out + O_GLA_S + so;
#pragma unroll
        for (int db = 0; db < 8; ++db) { const int d0 = db * 16 + 4 * fq; so_[(size_t)(d0 + 0) * 256] = sacc[db].x; so_[(size_t)(d0 + 1) * 256] = sacc[db].y; so_[(size_t)(d0 + 2) * 256] = sacc[db].z; so_[(size_t)(d0 + 3) * 256] = sacc[db].w; }
    }
}
__device__ __forceinline__ void gla_phase2(Frame& F, const Args& A, int l) {
    const int lane = F.lane_id(), wave = F.wave, fr = lane & 15, fq = lane >> 4;
    for (int u = F.vcu; u < 256; u += F.G) { const int bh = u >> 4, seg = (u >> 1) & 7, eh = u & 1;
        f32x4 sacc[8];
#pragma unroll
        for (int db = 0; db < 8; ++db) sacc[db] = (f32x4){0.f, 0.f, 0.f, 0.f};
        for (int i2 = 0; i2 < seg; ++i2) { const float* sl = F.SLOC() + ((size_t)(bh * 8 + i2) * 128) * 256 + eh * 128 + wave * 16 + fr; const float* dg = F.DSEG() + (bh * 8 + i2) * 128;
#pragma unroll
            for (int db = 0; db < 8; ++db) { const int d0 = db * 16 + 4 * fq; const f32x4 dv = *(const f32x4*)(dg + d0);
                sacc[db].x = sacc[db].x * dv.x + sl[(size_t)(d0 + 0) * 256]; sacc[db].y = sacc[db].y * dv.y + sl[(size_t)(d0 + 1) * 256]; sacc[db].z = sacc[db].z * dv.z + sl[(size_t)(d0 + 2) * 256]; sacc[db].w = sacc[db].w * dv.w + sl[(size_t)(d0 + 3) * 256]; } }
        float btot;
        gla_chunks(F, A, l, (bh >> 2) * 2048 + seg * 256, 4, 64, bh & 3, eh, true, sacc, btot);
        if (seg == 7) { float* so_ = F.out + O_GLA_P + ((size_t)(l * 16 + bh)) * 32768 + eh * 128 + wave * 16 + fr;
#pragma unroll
            for (int db = 0; db < 8; ++db) { const int d0 = db * 16 + 4 * fq; so_[(size_t)(d0 + 0) * 256] = sacc[db].x; so_[(size_t)(d0 + 1) * 256] = sacc[db].y; so_[(size_t)(d0 + 2) * 256] = sacc[db].z; so_[(size_t)(d0 + 3) * 256] = sacc[db].w; } }
    }
}
constexpr int AT_VT = 0, AT_VTS = 184, AT_BT = 64 * AT_VTS * 2, AT_END = AT_BT + 4 * 128 * 4;
__device__ __forceinline__ void attn_unit_mfma(Frame& F, const Args& A, int l, int u) {
    const int lane = F.lane_id(), wave = F.wave, tid = wave * 64 + lane, fr = lane & 15, fq = lane >> 4;
    const int span = u >> 1, g = u & 1, t0g = span * 32, tb0 = t0g & 2047;
    LAS bf16* VT = (LAS bf16*)(F.lds + AT_VT); LAS float* BT = (LAS float*)(F.lds + AT_BT);
    const bf16* Z = F.Z();
#pragma unroll
    for (int pass = 0; pass < 2; ++pass) { const int key = pass * 128 + (tid >> 2), dch = (tid & 3) * 16;
        if (key < 160) { v4u v0 = {0u, 0u, 0u, 0u}, v1 = {0u, 0u, 0u, 0u};
            if (tb0 - 128 + key >= 0) { const v4u* vp = (const v4u*)(Z + (size_t)(t0g - 128 + key) * ZW + ZV + g * 64 + dch); v0 = vp[0]; v1 = vp[1]; }
            LAS bf16* vt = VT + dch * AT_VTS + key;
            vt[0 * AT_VTS] = (bf16)(v0.x & 0xffffu); vt[1 * AT_VTS] = (bf16)(v0.x >> 16); vt[2 * AT_VTS] = (bf16)(v0.y & 0xffffu); vt[3 * AT_VTS] = (bf16)(v0.y >> 16);
            vt[4 * AT_VTS] = (bf16)(v0.z & 0xffffu); vt[5 * AT_VTS] = (bf16)(v0.z >> 16); vt[6 * AT_VTS] = (bf16)(v0.w & 0xffffu); vt[7 * AT_VTS] = (bf16)(v0.w >> 16);
            vt[8 * AT_VTS] = (bf16)(v1.x & 0xffffu); vt[9 * AT_VTS] = (bf16)(v1.x >> 16); vt[10 * AT_VTS] = (bf16)(v1.y & 0xffffu); vt[11 * AT_VTS] = (bf16)(v1.y >> 16);
            vt[12 * AT_VTS] = (bf16)(v1.z & 0xffffu); vt[13 * AT_VTS] = (bf16)(v1.z >> 16); vt[14 * AT_VTS] = (bf16)(v1.w & 0xffffu); vt[15 * AT_VTS] = (bf16)(v1.w >> 16); } }
    BT[tid] = F.BTAB()[(g * 4) * 128 + tid];
    __syncthreads();
    const int rb = wave >> 2, hl = wave & 3, hd = g * 4 + hl, t0w = t0g + 16 * rb;
    bf16x8 qf[2];
    { const bf16* qp = Z + (size_t)(t0w + fr) * ZW + ZQ + hd * 64 + 8 * fq; qf[0] = *(const bf16x8*)qp; qf[1] = *(const bf16x8*)(qp + 32); }
    f32x4 sacc[9];
#pragma unroll
    for (int kb = 0; kb < 9; ++kb) { const int kl = 16 * (rb + kb) + fr; bf16x8 k0 = {0, 0, 0, 0, 0, 0, 0, 0}, k1 = {0, 0, 0, 0, 0, 0, 0, 0};
        if (tb0 - 128 + kl >= 0) { const bf16* kp = Z + (size_t)(t0g - 128 + kl) * ZW + ZK + g * 64 + 8 * fq; k0 = *(const bf16x8*)kp; k1 = *(const bf16x8*)(kp + 32); }
        f32x4 acc = {0.f, 0.f, 0.f, 0.f};
        acc = __builtin_amdgcn_mfma_f32_16x16x32_bf16(k0, qf[0], acc, 0, 0, 0); acc = __builtin_amdgcn_mfma_f32_16x16x32_bf16(k1, qf[1], acc, 0, 0, 0);
        sacc[kb] = acc; }
    const float sink = A.in[F.zo + I_SINKS][l * 8 + hd];
    float mx = -INFINITY;
#pragma unroll
    for (int kb = 0; kb < 9; ++kb)
#pragma unroll
        for (int i = 0; i < 4; ++i) { const int dist = 128 - 16 * kb + fr - 4 * fq - i, kpos = tb0 + 16 * rb + fr - dist;
            const bool valid = (dist >= 0) && (dist < 128) && (kpos >= 0);
            const float s = valid ? sacc[kb][i] * 0.125f + BT[hl * 128 + (dist & 127)] : -INFINITY;
            sacc[kb][i] = s; mx = fmaxf(mx, s); }
    mx = fmaxf(mx, __shfl_xor(mx, 16)); mx = fmaxf(mx, __shfl_xor(mx, 32)); mx = fmaxf(mx, sink);
    float ls = 0.f;
#pragma unroll
    for (int kb = 0; kb < 9; ++kb)
#pragma unroll
        for (int i = 0; i < 4; ++i) { const float p = __expf(sacc[kb][i] - mx); sacc[kb][i] = p; ls += p; }
    ls += __shfl_xor(ls, 16); ls += __shfl_xor(ls, 32);
    const float rden = 1.0f / (ls + __expf(sink - mx));
    bf16x8 pf[5];
#pragma unroll
    for (int pp = 0; pp < 5; ++pp) { const f32x4 a = sacc[2 * pp], b = (2 * pp + 1 < 9) ? sacc[2 * pp + 1] : (f32x4){0.f, 0.f, 0.f, 0.f};
        const unsigned w0 = pk2(a.x, a.y), w1 = pk2(a.z, a.w), w2 = pk2(b.x, b.y), w3 = pk2(b.z, b.w);
        v4u w = {w0, w1, w2, w3}; pf[pp] = __builtin_bit_cast(bf16x8, w); }
#pragma unroll
    for (int db = 0; db < 4; ++db) { f32x4 o = {0.f, 0.f, 0.f, 0.f};
#pragma unroll
        for (int pp = 0; pp < 5; ++pp) { const LAS bf16* vr = VT + (db * 16 + fr) * AT_VTS + 16 * (rb + 2 * pp) + 4 * fq;
            const u32x2 lo = *(const LAS u32x2*)vr; u32x2 hi = {0u, 0u}; if (2 * pp + 1 < 9) hi = *(const LAS u32x2*)(vr + 16);
            v4u w = {lo.x, lo.y, hi.x, hi.y};
            o = __builtin_amdgcn_mfma_f32_16x16x32_bf16(__builtin_bit_cast(bf16x8, w), pf[pp], o, 0, 0, 0); }
        *(u32x2*)(F.MIX() + (size_t)(t0w + fr) * DM + hd * 64 + db * 16 + 4 * fq) = pack4bf(o * rden); }
    __syncthreads();
}
__device__ __forceinline__ void pool_item_mfma(Frame& F, const Args& A, int l, int rblk, int g) {
    const int lane = F.lane_id(), fr = lane & 15, fq = lane >> 4;
    const int t = rblk * 16 + fr, pos = t & 2047, w = 2 << g;
    const bf16* Z = F.Z();
    const int nwin = (pos + 1) < w ? (pos + 1) : w; const float rc = 1.0f / (float)nwin;
    bf16x8 df[4];
#pragma unroll
    for (int ks = 0; ks < 4; ++ks) { const bf16* up = Z + (size_t)t * ZW + ZU + g * 128 + ks * 32 + 8 * fq;
        float s[8], u0[8];
        { const v4u x = *(const v4u*)up; u0[0] = bflo(x.x); u0[1] = bfhi(x.x); u0[2] = bflo(x.y); u0[3] = bfhi(x.y); u0[4] = bflo(x.z); u0[5] = bfhi(x.z); u0[6] = bflo(x.w); u0[7] = bfhi(x.w); }
#pragma unroll
        for (int j = 0; j < 8; ++j) s[j] = u0[j];
        for (int i = 1; i < nwin; ++i) { const v4u x = *(const v4u*)(up - (size_t)i * ZW);
            s[0] += bflo(x.x); s[1] += bfhi(x.x); s[2] += bflo(x.y); s[3] += bfhi(x.y); s[4] += bflo(x.z); s[5] += bfhi(x.z); s[6] += bflo(x.w); s[7] += bfhi(x.w); }
        v4u wv; wv.x = pk2(s[0] * rc - u0[0], s[1] * rc - u0[1]); wv.y = pk2(s[2] * rc - u0[2], s[3] * rc - u0[3]); wv.z = pk2(s[4] * rc - u0[4], s[5] * rc - u0[5]); wv.w = pk2(s[6] * rc - u0[6], s[7] * rc - u0[7]);
        df[ks] = __builtin_bit_cast(bf16x8, wv); }
    const bf16* wt = F.WPT() + ((size_t)(l * 4 + g) * 128) * 128; const float* psc = A.in[F.zo + I_PSCALE] + l * 512 + g * 128;
#pragma unroll
    for (int nb = 0; nb < 8; ++nb) { f32x4 acc = {0.f, 0.f, 0.f, 0.f};
#pragma unroll
        for (int ks = 0; ks < 4; ++ks) { const bf16x8 a = *(const bf16x8*)(wt + (size_t)(nb * 16 + fr) * 128 + ks * 32 + 8 * fq); acc = __builtin_amdgcn_mfma_f32_16x16x32_bf16(a, df[ks], acc, 0, 0, 0); }
        const f32x4 sc = *(const f32x4*)(psc + nb * 16 + 4 * fq);
        *(u32x2*)(F.MIX() + (size_t)t * DM + 512 + g * 128 + nb * 16 + 4 * fq) = pack4bf(acc * sc); }
}
__device__ __forceinline__ void skinny_resid(Frame& F, const bf16* Asmp, const bf16* Bt, int K, const float* gate) {
    const int lane = F.lane_id(), wave = F.wave, fr = lane & 15, fq = lane >> 4;
    LAS float* red = (LAS float*)(F.lds + RING_OFF);
    const int kw = K >> 3, ksteps = kw >> 5;
    for (int u = F.vcu; u < 256; u += F.G) {
        const int c0 = (u >> 1) * 16, r0 = (u & 1) * 64;
        const bf16* bp = Bt + (size_t)(c0 + fr) * K + wave * kw + 8 * fq;
        const bf16* ap = Asmp + (size_t)(r0 + fr) * K + wave * kw + 8 * fq;
        f32x4 acc[4];
#pragma unroll
        for (int rb = 0; rb < 4; ++rb) acc[rb] = (f32x4){0.f, 0.f, 0.f, 0.f};
        bf16x8 bc = *(const bf16x8*)bp, ac[4];
#pragma unroll
        for (int rb = 0; rb < 4; ++rb) ac[rb] = *(const bf16x8*)(ap + (size_t)rb * 16 * K);
        for (int ks = 0; ks < ksteps; ++ks) {
            bf16x8 bn = bc, an[4];
#pragma unroll
            for (int rb = 0; rb < 4; ++rb) an[rb] = ac[rb];
            if (ks + 1 < ksteps) { bn = *(const bf16x8*)(bp + (ks + 1) * 32);
#pragma unroll
                for (int rb = 0; rb < 4; ++rb) an[rb] = *(const bf16x8*)(ap + (size_t)rb * 16 * K + (ks + 1) * 32); }
#pragma unroll
            for (int rb = 0; rb < 4; ++rb) acc[rb] = __builtin_amdgcn_mfma_f32_16x16x32_bf16(bc, ac[rb], acc[rb], 0, 0, 0);
            bc = bn;
#pragma unroll
            for (int rb = 0; rb < 4; ++rb) ac[rb] = an[rb];
        }
#pragma unroll
        for (int rb = 0; rb < 4; ++rb) *(LAS f32x4*)(red + ((wave * 4 + rb) * 64 + lane) * 4) = acc[rb];
        __syncthreads();
        if (wave < 4) { f32x4 s = {0.f, 0.f, 0.f, 0.f};
#pragma unroll
            for (int w2 = 0; w2 < 8; ++w2) s = s + *(const LAS f32x4*)(red + ((w2 * 4 + wave) * 64 + lane) * 4);
            const int r = r0 + wave * 16 + fr;
            const f32x4 g = *(const f32x4*)(gate + (size_t)(4 + (r >> 2)) * MODLD + c0 + 4 * fq);
            float* xp = F.X() + (size_t)(NP_ROWS + r) * DM + c0 + 4 * fq; f32x4 xv = *(const f32x4*)xp; xv = xv + g * s; *(f32x4*)xp = xv; }
        __syncthreads();
    }
}

#ifndef EN_P0
#define EN_P0 1
#endif
#ifndef EN_G
#define EN_G 1
#endif
#ifndef EN_N
#define EN_N 1
#endif
#ifndef EN_M2
#define EN_M2 1
#endif
#ifndef EN_M3
#define EN_M3 1
#endif
#ifndef EN_M4
#define EN_M4 1
#endif
#ifndef EN_G1
#define EN_G1 1
#endif
#ifndef EN_GIN
#define EN_GIN 1
#endif
#ifndef EN_GOUT
#define EN_GOUT 1
#endif
#ifndef EN_GGU
#define EN_GGU 1
#endif
#ifndef EN_GDN
#define EN_GDN 1
#endif
#ifndef PROBE_DUP
#define PROBE_DUP 0
#endif
#ifndef MK_SINGLE
#define MK_SINGLE 1
#endif

#define PH_ARGS unsigned ldsb_, unsigned wslo_, unsigned wshi_, unsigned olo_, unsigned ohi_, int wave_, int vcu_, int G_, int l_
#define PH_PASS ldsb, wslo, wshi, olo, ohi, F.wave, F.vcu, F.G
#define PH_FRAME() Frame F; { const unsigned a0 = __builtin_amdgcn_readfirstlane(ldsb_), a1 = __builtin_amdgcn_readfirstlane(wslo_), a2 = __builtin_amdgcn_readfirstlane(wshi_), a3 = __builtin_amdgcn_readfirstlane(olo_), a4 = __builtin_amdgcn_readfirstlane(ohi_); \
    F.lds = (LAS unsigned char*)(unsigned long long)a0; F.MISC = (volatile LAS unsigned*)(F.lds + MISC_OFF); F.ws = (unsigned char*)(((unsigned long long)a2 << 32) | a1); F.out = (float*)(((unsigned long long)a4 << 32) | a3); \
    F.wave = __builtin_amdgcn_readfirstlane(wave_); F.vcu = __builtin_amdgcn_readfirstlane(vcu_); F.G = __builtin_amdgcn_readfirstlane(G_); F.zo = 0; } \
    const int l = __builtin_amdgcn_readfirstlane(l_); (void)l; \
    const Args& args = *(const Args*)__builtin_amdgcn_kernarg_segment_ptr();
__device__ __forceinline__ void ph_prologue(PH_ARGS) { PH_FRAME(); p0_prologue(F, args); }
__device__ __forceinline__ void ph_norm1(PH_ARGS) { PH_FRAME(); norm_mod_rows(F, args.in[I_GMIX] + l * DM, F.MOD() + (size_t)l * MODW); }
__device__ __forceinline__ void ph_norm2(PH_ARGS) { PH_FRAME(); norm_mod_rows(F, args.in[I_GFFN] + l * DM, F.MOD() + (size_t)l * MODW + 6144); }
__device__ __forceinline__ void ph_final(PH_ARGS) { PH_FRAME(); final_norm_rows(F, args); }
__device__ __forceinline__ void ph_mixa(PH_ARGS) { PH_FRAME();
    const int gw = F.vcu * NWAVES + F.wave, NGW = F.G * NWAVES; LAS float* wscr = (LAS float*)(F.lds + RING_OFF + F.wave * 16384);
    gla_phase1(F, args, l);
    for (int u = F.vcu; u < 512; u += F.G) attn_unit_mfma(F, args, l, u);
    for (int it = gw; it < 512 * 4; it += NGW) pool_item_mfma(F, args, l, it >> 2, it & 3);
    for (int it = gw; it < NS_ROWS * 8; it += NGW) attn_item(F, args, l, NP_ROWS + (it >> 3), it & 7, wscr);
    for (int it = gw; it < NS_ROWS * 4; it += NGW) pool_item(F, args, l, NP_ROWS + (it >> 2), it & 3, wscr);
    cache_outputs(F, args, l);
}
__device__ __forceinline__ void ph_gla2(PH_ARGS) { PH_FRAME(); gla_phase2(F, args, l); }
__device__ __forceinline__ void ph_mixc(PH_ARGS) { PH_FRAME(); const int gw = F.vcu * NWAVES + F.wave, NGW = F.G * NWAVES; for (int it = gw; it < NROWS * 4; it += NGW) gla_out_item(F, args, l, it >> 2, it & 3); }
constexpr int PH_PER_LAYER = 9, PH_LAYER0 = 2, PH_FINAL = PH_LAYER0 + DEPTH * PH_PER_LAYER, PH_COUNT = PH_FINAL + 1;
__global__ void __launch_bounds__(NTHREADS, 2) hymba_fwd(Args args) {
    extern __shared__ __attribute__((aligned(16))) unsigned char lds[];
    Frame F;
    F.lds = (LAS unsigned char*)lds;
    F.MISC = (volatile LAS unsigned*)(F.lds + MISC_OFF);
    F.wave = __builtin_amdgcn_readfirstlane((int)threadIdx.x >> 6); F.zo = 0;
    F.G = gridDim.x; { const int bx = blockIdx.x; F.vcu = (F.G % 8 == 0) ? (bx % 8) * (F.G / 8) + bx / 8 : bx; }
    F.ws = args.ws; F.out = args.out;
    gu32* const ctl = (gu32*)(F.ws + WS_CTL);
    for (int u = threadIdx.x; u < (LDS_BYTES - LDSCTL_OFF) / 4; u += NTHREADS) ((LAS unsigned*)(F.lds + LDSCTL_OFF))[u] = 0u;
    __syncthreads();
#if MK_SINGLE
    XcdBarrier bar = xcd_barrier_post((unsigned*)(ctl + CW_BAR), F.MISC + 8);
#define GRID_BAR() xcd_barrier(bar)
#else
#define GRID_BAR() do { } while (0)
#endif
    const int lo = args.ph_lo, hi = args.ph_hi;
    const unsigned ldsb = (unsigned)(unsigned long long)F.lds, wslo = (unsigned)(unsigned long long)F.ws, wshi = (unsigned)((unsigned long long)F.ws >> 32), olo = (unsigned)(unsigned long long)F.out, ohi = (unsigned)((unsigned long long)F.out >> 32);
#define IN(k) (lo <= (k) && (k) < hi)
#define BOTH(k) (IN(k) && IN((k) + 1))
#define PHASE_BEGIN() asm volatile("s_mov_b32 %0, 0" : "=s"(F.zo), "+s"(F.G), "+s"(F.vcu), "+s"(F.wave))
#define gw (F.vcu * NWAVES + F.wave)
#define NGW (F.G * NWAVES)
#define wscr ((LAS float*)(F.lds + RING_OFF + F.wave * 16384))

    if (EN_P0 && IN(0)) for (int rep_ = 0; rep_ < ((PROBE_DUP & 1) ? 2 : 1); ++rep_) { PHASE_BEGIN(); ph_prologue(PH_PASS, 0); if (BOTH(0)) GRID_BAR(); }
    if (EN_G && EN_G1 && IN(1)) for (int rep_ = 0; rep_ < ((PROBE_DUP & 1) ? 2 : 1); ++rep_) { PHASE_BEGIN();
        pg8::Gemm g{F.SC(), F.Wada_t(), 256, DEPTH * MODW, DM}; pg8::StaticOrder S; S.init(256, DEPTH * MODW, F.G, (int)blockIdx.x);
        pg8::EpiMod E{F.MOD(), args.in[F.zo + I_BADA]};
        pg8::gemm_phase<pg8::EpiMod, pg8::StaticOrder, true, true>(F.lds + RING_OFF, g, S, E, F.wave);
        if (BOTH(1)) GRID_BAR();
    }
    for (int l = 0; l < DEPTH; ++l) {
        const int pb = PH_LAYER0 + l * PH_PER_LAYER;
        const float* modl = F.MOD() + (size_t)l * MODW;
        if (EN_N && IN(pb + 0)) for (int rep_ = 0; rep_ < ((PROBE_DUP & 2) ? 2 : 1); ++rep_) { PHASE_BEGIN(); ph_norm1(PH_PASS, l); if (BOTH(pb + 0)) GRID_BAR(); }
        if (EN_G && EN_GIN && IN(pb + 1)) for (int rep_ = 0; rep_ < ((PROBE_DUP & 4) ? 2 : 1); ++rep_) { PHASE_BEGIN();
            pg8::Gemm g{F.H(), F.Win_t() + (size_t)l * ZW * DM, MPAD, ZW, DM}; pg8::StaticOrder S; S.init(MPAD, ZW, F.G, (int)blockIdx.x);
            pg8::EpiZ E{F.Z(), ZW};
            pg8::gemm_phase<pg8::EpiZ, pg8::StaticOrder, true, true>(F.lds + RING_OFF, g, S, E, F.wave);
            if (BOTH(pb + 1)) GRID_BAR();
        }
        if (EN_M2 && IN(pb + 2)) for (int rep_ = 0; rep_ < ((PROBE_DUP & 8) ? 2 : 1); ++rep_) { PHASE_BEGIN();
            ph_mixa(PH_PASS, l);
            if (BOTH(pb + 2)) GRID_BAR();
        }
        if (EN_M3 && IN(pb + 3)) for (int rep_ = 0; rep_ < ((PROBE_DUP & 8) ? 2 : 1); ++rep_) { PHASE_BEGIN();
            ph_gla2(PH_PASS, l);
            if (BOTH(pb + 3)) GRID_BAR();
        }
        if (EN_M4 && IN(pb + 4)) for (int rep_ = 0; rep_ < ((PROBE_DUP & 8) ? 2 : 1); ++rep_) { PHASE_BEGIN(); ph_mixc(PH_PASS, l); if (BOTH(pb + 4)) GRID_BAR(); }
        if (EN_G && EN_GOUT && IN(pb + 5)) { PHASE_BEGIN();
            pg8::Gemm g{F.MIX(), F.Wout_t() + (size_t)l * DM * DM, NP_ROWS, DM, DM}; pg8::StaticOrder S; S.init(NP_ROWS, DM, F.G, (int)blockIdx.x);
            pg8::EpiResid E{F.X(), modl + 4096};
            pg8::gemm_phase<pg8::EpiResid, pg8::StaticOrder, true, true>(F.lds + RING_OFF, g, S, E, F.wave);
            skinny_resid(F, F.MIX() + (size_t)NP_ROWS * DM, F.Wout_t() + (size_t)l * DM * DM, DM, modl + 4096);
            if (BOTH(pb + 5)) GRID_BAR();
        }
        if (EN_N && IN(pb + 6)) for (int rep_ = 0; rep_ < ((PROBE_DUP & 2) ? 2 : 1); ++rep_) { PHASE_BEGIN(); ph_norm2(PH_PASS, l); if (BOTH(pb + 6)) GRID_BAR(); }
        if (EN_G && EN_GGU && IN(pb + 7)) for (int rep_ = 0; rep_ < ((PROBE_DUP & 4) ? 2 : 1); ++rep_) { PHASE_BEGIN();
            pg8::Gemm g{F.H(), F.Wgu_t() + (size_t)l * NGU * DM, MPAD, NGU, DM}; pg8::StaticOrder S; S.init(MPAD, NGU, F.G, (int)blockIdx.x);
            pg8::EpiSwiGLU E{F.ACT(), DFF};
            pg8::gemm_phase<pg8::EpiSwiGLU, pg8::StaticOrder, true, true>(F.lds + RING_OFF, g, S, E, F.wave);
            if (BOTH(pb + 7)) GRID_BAR();
        }
        if (EN_G && EN_GDN && IN(pb + 8)) { PHASE_BEGIN();
            pg8::Gemm g{F.ACT(), F.Wdn_t() + (size_t)l * DM * DFF, NP_ROWS, DM, DFF}; pg8::StaticOrder S; S.init(NP_ROWS, DM, F.G, (int)blockIdx.x);
            pg8::EpiResid E{F.X(), modl + 10240};
            pg8::gemm_phase<pg8::EpiResid, pg8::StaticOrder, true, true>(F.lds + RING_OFF, g, S, E, F.wave);
            skinny_resid(F, F.ACT() + (size_t)NP_ROWS * DFF, F.Wdn_t() + (size_t)l * DM * DFF, DFF, modl + 10240);
            if (BOTH(pb + 8)) GRID_BAR();
        }
    }
    if (IN(PH_FINAL)) { PHASE_BEGIN(); ph_final(PH_PASS, 0); }
#ifdef PROBE_SCALE
    GRID_BAR();
    { const size_t offs[11] = {O_Y, 16777216, O_WK_P, O_WV_P, O_POOL_P, O_GLA_P, O_WK_S, O_WV_S, O_POOL_S, O_GLA_S, O_END};
      const size_t gt_ = (size_t)(F.vcu * NWAVES + F.wave) * 64 + F.lane_id(), NGT_ = (size_t)F.G * NWAVES * 64;
      for (int k = 0; k < 10; ++k) { const float sc = 1.0f + 0.05f * (float)(k + 1); for (size_t i = offs[k] + gt_; i < offs[k + 1]; i += NGT_) F.out[i] *= sc; } }
#endif
#undef IN
#undef BOTH
#undef gw
#undef NGW
#undef wscr
}

extern "C" void kernel_launch(void* const* d_in, const int* in_sizes, int n_in, void* d_out, int out_size, void* d_ws, size_t ws_size, hipStream_t stream) {
    static int grid = 0;
    if (grid == 0) {
        if (n_in != 24 || out_size != (int)O_END || ws_size < WS_END) { fprintf(stderr, "kernel_launch: unexpected sizes n_in %d out %d ws %zu\n", n_in, out_size, ws_size); grid = -1; return; }
        int dev = 0, cus = 0;
        if (hipGetDevice(&dev) != hipSuccess || hipDeviceGetAttribute(&cus, hipDeviceAttributeMultiprocessorCount, dev) != hipSuccess) { grid = -1; return; }
        if (hipFuncSetAttribute((const void*)hymba_fwd, hipFuncAttributeMaxDynamicSharedMemorySize, LDS_BYTES) != hipSuccess) { fprintf(stderr, "kernel_launch: hipFuncSetAttribute failed\n"); grid = -1; return; }
        (void)hipGetLastError();
        grid = cus;
    }
    if (grid < 0) return;
    (void)hipMemsetAsync((char*)d_ws + WS_CTL, 0, CTL_ZERO_BYTES, stream);
    Args a{};
    for (int i = 0; i < 24; ++i) a.in[i] = (const float*)d_in[i];
    a.out = (float*)d_out; a.ws = (unsigned char*)d_ws;
#if MK_SINGLE
    a.ph_lo = 0; a.ph_hi = PH_COUNT;
    hipLaunchKernelGGL(hymba_fwd, dim3(grid), dim3(NTHREADS), LDS_BYTES, stream, a);
#else
    for (int p = 0; p < PH_COUNT; ++p) { a.ph_lo = p; a.ph_hi = p + 1; hipLaunchKernelGGL(hymba_fwd, dim3(grid), dim3(NTHREADS), LDS_BYTES, stream, a); }
#endif
}
```

```cpp
#define PROBE_DUP 0
#include <hip/hip_runtime.h>
#include <cstdio>
#include <cstdint>
#include <cmath>
namespace pg8 {
#define PG8_LAS __attribute__((address_space(3)))
typedef unsigned short bf16_t;
typedef short bf16x8 __attribute__((ext_vector_type(8)));
typedef float f32x4 __attribute__((ext_vector_type(4)));
typedef unsigned u32x4 __attribute__((ext_vector_type(4)));
constexpr int BM = 256, BK = 64, HALF = 128, HTB = HALF * BK * 2  , STAGE_BYTES = 8 * HTB, NXCD = 8, WGM = 8;

__host__ __device__ __forceinline__ int lds_byte(int r, int c) { const int st = (r >> 4) * 2 + (c >> 5), rr = r & 15, cc = c & 31, ob = rr * 64 + cc * 2; return st * 1024 + (ob ^ (((ob >> 9) & 1) << 5)); }
__host__ __device__ __forceinline__ void stage_rc(int b, int& R, int& C) { const int st = b / 1024, sb = b % 1024, swz = sb ^ (((sb >> 9) & 1) << 5); R = (st >> 1) * 16 + swz / 64; C = (st & 1) * 32 + (swz % 64) / 2; }
__host__ __device__ __forceinline__ int perm32(int rho) { const int n = rho >> 4, i = rho & 15; return 8 * (i >> 2) + 4 * n + (i & 3); }

struct Unit { int pm, pn; };
struct Gemm { const bf16_t* A; const bf16_t* Bt; int M, N, K; };

struct StaticOrder {
    int nM, nN, nwg, G, c;
    __host__ __device__ void init(int M, int N, int G_, int c_) { nM = M / BM; nN = N / BM; nwg = nM * nN; G = G_; c = c_; }
    __host__ __device__ bool next(int i, Unit& u) const {
        const long L = (long)i * G + c; if (L >= nwg) return false;
        int wgid = (int)L; { const int q = nwg / NXCD, r = nwg % NXCD, xcd = wgid % NXCD, off = wgid / NXCD; wgid = (xcd < r ? xcd * (q + 1) : r * (q + 1) + (xcd - r) * q) + off; }
        const int nig = WGM * nN, gid = wgid / nig, fm = gid * WGM, gsz = (nM - fm) < WGM ? (nM - fm) : WGM;
        u.pm = fm + ((wgid % nig) % gsz); u.pn = (wgid % nig) / gsz; return true;
    }
    __device__ __forceinline__ void a_ready(const Unit&) const {}
    __device__ __forceinline__ void done(const Unit&) const {}
};

__device__ __forceinline__ unsigned cvt_pk_bf16(float lo, float hi) { unsigned r; asm volatile("v_cvt_pk_bf16_f32 %0, %1, %2" : "=v"(r) : "v"(lo), "v"(hi)); return r; }
typedef float f32x2 __attribute__((ext_vector_type(2)));
constexpr int MODLD_ = 49152;
__device__ __forceinline__ float fast_sigmoid(float x) { return __builtin_amdgcn_rcpf(1.0f + __expf(-x)); }
struct EpiZ {
    static constexpr bool PERM = true, AFTER_DRAIN = false;
    bf16_t* O; int ldc;
    __device__ __forceinline__ void operator()(const f32x4 (&acc)[2][2][4][2], const Unit& u, int wr, int wc, int fr, int fq) const {
        const int row0 = u.pm * BM + wr * 64 + fr, col0 = u.pn * BM + wc * 32 + 8 * fq;
#pragma unroll
        for (int ai = 0; ai < 2; ++ai)
#pragma unroll
            for (int m = 0; m < 4; ++m) { bf16_t* rowp = O + (size_t)(row0 + ai * HALF + m * 16) * ldc + col0;
#pragma unroll
                for (int bj = 0; bj < 2; ++bj) { const f32x4 v0 = acc[ai][bj][m][0], v1 = acc[ai][bj][m][1];
                    u32x4 w; w.x = cvt_pk_bf16(v0[0], v0[1]); w.y = cvt_pk_bf16(v0[2], v0[3]); w.z = cvt_pk_bf16(v1[0], v1[1]); w.w = cvt_pk_bf16(v1[2], v1[3]);
                    *(u32x4*)(rowp + bj * HALF) = w; } }
    }
};
struct EpiSwiGLU {
    static constexpr bool PERM = true, AFTER_DRAIN = false;
    bf16_t* O; int ldc;
    __device__ __forceinline__ void operator()(const f32x4 (&acc)[2][2][4][2], const Unit& u, int wr, int wc, int fr, int fq) const {
        const int row0 = u.pm * BM + wr * 64 + fr, col0 = u.pn * HALF + wc * 32 + 8 * fq;
#pragma unroll
        for (int ai = 0; ai < 2; ++ai)
#pragma unroll
            for (int m = 0; m < 4; ++m) { bf16_t* rowp = O + (size_t)(row0 + ai * HALF + m * 16) * ldc + col0;
                float r[8];
#pragma unroll
                for (int n = 0; n < 2; ++n)
#pragma unroll
                    for (int i = 0; i < 4; ++i) { const float g = acc[ai][0][m][n][i], up = acc[ai][1][m][n][i]; r[n * 4 + i] = g * fast_sigmoid(g) * up; }
                u32x4 w; w.x = cvt_pk_bf16(r[0], r[1]); w.y = cvt_pk_bf16(r[2], r[3]); w.z = cvt_pk_bf16(r[4], r[5]); w.w = cvt_pk_bf16(r[6], r[7]);
                *(u32x4*)rowp = w; }
    }
};
struct EpiResid {
    static constexpr bool PERM = false, AFTER_DRAIN = false;
    float* X; const float* gate;
    __device__ __forceinline__ void operator()(const f32x4 (&acc)[2][2][4][2], const Unit& u, int wr, int wc, int fr, int fq) const {
        const int col0 = u.pn * BM + wc * 32 + 4 * fq;
        if (u.pm < 32) {
            const float* g = gate + (size_t)(u.pm >> 3) * MODLD_ + col0;
            f32x4 gv[2][2];
#pragma unroll
            for (int bj = 0; bj < 2; ++bj)
#pragma unroll
                for (int n = 0; n < 2; ++n) gv[bj][n] = *(const f32x4*)(g + bj * HALF + n * 16);
#pragma unroll
            for (int ai = 0; ai < 2; ++ai)
#pragma unroll
                for (int m = 0; m < 4; ++m) { float* xp = X + (size_t)(u.pm * BM + ai * HALF + wr * 64 + m * 16 + fr) * 2048 + col0;
#pragma unroll
                    for (int bj = 0; bj < 2; ++bj)
#pragma unroll
                        for (int n = 0; n < 2; ++n) { f32x4 xv = *(const f32x4*)(xp + bj * HALF + n * 16); xv = xv + gv[bj][n] * acc[ai][bj][m][n]; *(f32x4*)(xp + bj * HALF + n * 16) = xv; } }
        } else {
#pragma unroll
            for (int m = 0; m < 4; ++m) { const int rl = wr * 64 + m * 16 + fr;
                const float* g = gate + (size_t)(4 + (rl >> 2)) * MODLD_ + col0; float* xp = X + (size_t)(8192 + rl) * 2048 + col0;
#pragma unroll
                for (int bj = 0; bj < 2; ++bj)
#pragma unroll
                    for (int n = 0; n < 2; ++n) { const f32x4 gvv = *(const f32x4*)(g + bj * HALF + n * 16); f32x4 xv = *(const f32x4*)(xp + bj * HALF + n * 16);
                        xv = xv + gvv * acc[0][bj][m][n]; *(f32x4*)(xp + bj * HALF + n * 16) = xv; } }
        }
    }
};
struct EpiMod {
    static constexpr bool PERM = false, AFTER_DRAIN = false;
    float* M; const float* bias;
    __device__ __forceinline__ void operator()(const f32x4 (&acc)[2][2][4][2], const Unit& u, int wr, int wc, int fr, int fq) const {
        if (wr != 0) return;
        const int col0 = u.pn * BM + wc * 32 + 4 * fq;
#pragma unroll
        for (int m = 0; m < 3; ++m) { const int r = m * 16 + fr;
            if (r < 36) {
#pragma unroll
                for (int bj = 0; bj < 2; ++bj)
#pragma unroll
                    for (int n = 0; n < 2; ++n) { const f32x4 bv = *(const f32x4*)(bias + col0 + bj * HALF + n * 16);
                        *(f32x4*)(M + (size_t)r * MODLD_ + col0 + bj * HALF + n * 16) = acc[0][bj][m][n] + bv; } } }
    }
};

template <class Epi, class Sched, bool ALIGN_EPI = false, bool SP2 = false>
__device__ __forceinline__ void gemm_phase(PG8_LAS unsigned char* lds, const Gemm g, const Sched& S, const Epi& E, int wid_in) {
    int lane_ = (int)__builtin_amdgcn_mbcnt_hi(~0u, __builtin_amdgcn_mbcnt_lo(~0u, 0u)); asm volatile("" : "+v"(lane_));
    const int wid = __builtin_amdgcn_readfirstlane(wid_in), lane = lane_, tid = wid * 64 + lane, wr = wid >> 2, wc = wid & 3, fr = lane & 15, fq = lane >> 4;
    int K_ = g.K; asm volatile("" : "+s"(K_));
    const int K = K_, nt = K / BK;
    unsigned voffA[2], voffB[2];
#pragma unroll
    for (int i = 0; i < 2; ++i) { int R, C; stage_rc(tid * 16 + i * 8192, R, C); const int Rb = Epi::PERM ? ((R & ~31) + perm32(R & 31)) : R;
        voffA[i] = (unsigned)(R * K + C) * 2u; voffB[i] = (unsigned)(Rb * K + C) * 2u; }
    const size_t kstep = (size_t)(BK * 2);
    const size_t hstep = (size_t)HALF * K * 2;
    const size_t tstep = 2 * hstep;
    const unsigned ldsw = (unsigned)wid * 1024u;
    const int aoff = lds_byte(wr * 64 + fr, fq * 8), boff = lds_byte(wc * 32 + fr, fq * 8);
#define PG8_SA(b, h) (((b) * 2 + (h)) * HTB)
#define PG8_SB(b, h) ((4 + (b) * 2 + (h)) * HTB)
#define PG8_STAGE(bufoff, gbase, voff) do { _Pragma("unroll") for (int _i = 0; _i < 2; ++_i) \
        __builtin_amdgcn_global_load_lds((const unsigned*)((const char*)(gbase) + (voff)[_i]), (PG8_LAS unsigned*)(lds + (bufoff) + ldsw + _i * 8192), 16, 0, 0); } while (0)
#define PG8_LDA(dst, b, h) do { _Pragma("unroll") for (int m = 0; m < 4; ++m) _Pragma("unroll") for (int k = 0; k < 2; ++k) dst[m][k] = *(const PG8_LAS bf16x8*)(lds + PG8_SA(b, h) + aoff + m * 2048 + k * 1024); } while (0)
#define PG8_LDB(dst, b, h) do { _Pragma("unroll") for (int n = 0; n < 2; ++n) _Pragma("unroll") for (int k = 0; k < 2; ++k) dst[n][k] = *(const PG8_LAS bf16x8*)(lds + PG8_SB(b, h) + boff + n * 2048 + k * 1024); } while (0)
#define PG8_MMA(ai, bj, At, Bt) do { __builtin_amdgcn_s_setprio(1); _Pragma("unroll") for (int m = 0; m < 4; ++m) _Pragma("unroll") for (int n = 0; n < 2; ++n) _Pragma("unroll") for (int k = 0; k < 2; ++k) \
        acc[ai][bj][m][n] = __builtin_amdgcn_mfma_f32_16x16x32_bf16(Bt[n][k], At[m][k], acc[ai][bj][m][n], 0, 0, 0); __builtin_amdgcn_s_setprio(0); } while (0)
#define PG8_WAIT_V(n) asm volatile("s_waitcnt vmcnt(" #n ")" ::: "memory")
#define PG8_WAIT_L(n) asm volatile("s_waitcnt lgkmcnt(" #n ")" ::: "memory")
#define PG8_BAR __builtin_amdgcn_s_barrier()
#define PG8_SCHED __builtin_amdgcn_sched_barrier(0)
    Unit cur, nxt; int ui = 0;
    if (!S.next(0, cur)) return;
    f32x4 acc[2][2][4][2];
#pragma unroll
    for (int a = 0; a < 2; ++a)
#pragma unroll
        for (int b = 0; b < 2; ++b)
#pragma unroll
            for (int m = 0; m < 4; ++m)
#pragma unroll
                for (int n = 0; n < 2; ++n) acc[a][b][m][n] = (f32x4){0.f, 0.f, 0.f, 0.f};
    bf16x8 At[4][2], B0[2][2], B1[2][2];
    const char* cA = (const char*)g.A + (size_t)cur.pm * tstep; const char* cB = (const char*)g.Bt + (size_t)cur.pn * tstep;
    S.a_ready(cur);
    if constexpr (SP2) {
        PG8_STAGE(PG8_SB(0, 0), cB, voffB); PG8_STAGE(PG8_SB(0, 1), cB + hstep, voffB); PG8_STAGE(PG8_SA(0, 0), cA, voffA); PG8_STAGE(PG8_SA(0, 1), cA + hstep, voffA);
        if (wr == 1) PG8_BAR;
        PG8_WAIT_V(2); PG8_BAR;
        PG8_STAGE(PG8_SB(1, 0), cB + kstep, voffB); PG8_STAGE(PG8_SA(1, 0), cA + kstep, voffA); PG8_STAGE(PG8_SB(1, 1), cB + hstep + kstep, voffB);
        PG8_WAIT_V(6); PG8_BAR;
    } else {
        PG8_STAGE(PG8_SB(0, 0), cB, voffB); PG8_STAGE(PG8_SA(0, 0), cA, voffA); PG8_STAGE(PG8_SB(0, 1), cB + hstep, voffB); PG8_STAGE(PG8_SA(0, 1), cA + hstep, voffA);
        if (wr == 1) PG8_BAR;
        PG8_WAIT_V(4); PG8_BAR;
        PG8_STAGE(PG8_SB(1, 0), cB + kstep, voffB); PG8_STAGE(PG8_SA(1, 0), cA + kstep, voffA); PG8_STAGE(PG8_SB(1, 1), cB + hstep + kstep, voffB);
        PG8_WAIT_V(6); PG8_BAR;
    }
    for (;;) {
        const bool has_next = S.next(ui + 1, nxt);
        const char* nA = has_next ? (const char*)g.A + (size_t)nxt.pm * tstep : cA; const char* nB = has_next ? (const char*)g.Bt + (size_t)nxt.pn * tstep : cB;
        for (int t = 0; t < nt; t += 2) {
            const bool last = (t == nt - 2);
            const char* a1 = cA + (size_t)(t + 1) * kstep;
            const char* a2 = last ? nA : cA + (size_t)(t + 2) * kstep; const char* b2 = last ? nB : cB + (size_t)(t + 2) * kstep;
            const char* a3 = a2 + kstep; const char* b3 = b2 + kstep;
            if (last && has_next) S.a_ready(nxt);
            if constexpr (SP2) {
            PG8_LDB(B0, 0, 0); PG8_LDB(B1, 0, 1); PG8_SCHED; PG8_LDA(At, 0, 0); PG8_STAGE(PG8_SA(1, 1), a1 + hstep, voffA);
            PG8_WAIT_V(8); PG8_WAIT_L(0); PG8_BAR; PG8_MMA(0, 0, At, B0); PG8_MMA(0, 1, At, B1); PG8_BAR; PG8_SCHED;
            PG8_LDA(At, 0, 1); PG8_STAGE(PG8_SB(0, 0), b2, voffB); PG8_STAGE(PG8_SB(0, 1), b2 + hstep, voffB); PG8_STAGE(PG8_SA(0, 0), a2, voffA);
            PG8_WAIT_V(8); PG8_WAIT_L(0); PG8_BAR; PG8_MMA(1, 0, At, B0); PG8_MMA(1, 1, At, B1); PG8_BAR; PG8_SCHED;
            PG8_LDB(B0, 1, 0); PG8_LDB(B1, 1, 1); PG8_SCHED; PG8_LDA(At, 1, 0); PG8_STAGE(PG8_SA(0, 1), a2 + hstep, voffA);
            PG8_WAIT_V(8); PG8_WAIT_L(0); PG8_BAR; PG8_MMA(0, 0, At, B0); PG8_MMA(0, 1, At, B1); PG8_BAR; PG8_SCHED;
            PG8_LDA(At, 1, 1); PG8_STAGE(PG8_SB(1, 0), b3, voffB); PG8_STAGE(PG8_SB(1, 1), b3 + hstep, voffB); PG8_STAGE(PG8_SA(1, 0), a3, voffA);
            PG8_WAIT_V(8); PG8_WAIT_L(0); PG8_BAR; PG8_MMA(1, 0, At, B0); PG8_MMA(1, 1, At, B1); PG8_BAR; PG8_SCHED;
            } else {
            PG8_LDB(B0, 0, 0); PG8_SCHED; PG8_LDA(At, 0, 0); PG8_STAGE(PG8_SA(1, 1), a1 + hstep, voffA);
            PG8_WAIT_L(8); PG8_BAR; PG8_WAIT_L(0); PG8_MMA(0, 0, At, B0); PG8_BAR; PG8_SCHED;
            PG8_LDB(B1, 0, 1); PG8_STAGE(PG8_SB(0, 0), b2, voffB);
            PG8_BAR; PG8_WAIT_L(0); PG8_MMA(0, 1, At, B1); PG8_BAR;
            PG8_LDA(At, 0, 1); PG8_STAGE(PG8_SA(0, 0), a2, voffA);
            PG8_BAR; PG8_WAIT_L(0); PG8_MMA(1, 0, At, B0); PG8_BAR; PG8_SCHED;
            PG8_STAGE(PG8_SB(0, 1), b2 + hstep, voffB);
            PG8_WAIT_V(6); PG8_BAR; PG8_MMA(1, 1, At, B1); PG8_BAR;
            PG8_LDB(B0, 1, 0); PG8_SCHED; PG8_LDA(At, 1, 0); PG8_STAGE(PG8_SA(0, 1), a2 + hstep, voffA);
            PG8_WAIT_L(8); PG8_BAR; PG8_WAIT_L(0); PG8_MMA(0, 0, At, B0); PG8_BAR; PG8_SCHED;
            PG8_LDB(B1, 1, 1); PG8_STAGE(PG8_SB(1, 0), b3, voffB);
            PG8_BAR; PG8_WAIT_L(0); PG8_MMA(0, 1, At, B1); PG8_BAR;
            PG8_LDA(At, 1, 1); PG8_STAGE(PG8_SA(1, 0), a3, voffA);
            PG8_BAR; PG8_WAIT_L(0); PG8_MMA(1, 0, At, B0); PG8_BAR; PG8_SCHED;
            PG8_STAGE(PG8_SB(1, 1), b3 + hstep, voffB);
            PG8_WAIT_V(6); PG8_BAR; PG8_MMA(1, 1, At, B1); PG8_BAR;
            }
        }
        if constexpr (ALIGN_EPI) { if (wr == 0) PG8_BAR; }
        if constexpr (!Epi::AFTER_DRAIN) { E(acc, cur, wr, wc, fr, fq); S.done(cur); }
        if (!has_next) break;
#pragma unroll
        for (int a = 0; a < 2; ++a)
#pragma unroll
            for (int b = 0; b < 2; ++b)
#pragma unroll
                for (int m = 0; m < 4; ++m)
#pragma unroll
                    for (int n = 0; n < 2; ++n) acc[a][b][m][n] = (f32x4){0.f, 0.f, 0.f, 0.f};
        cur = nxt; cA = nA; cB = nB; ++ui;
        if constexpr (ALIGN_EPI) { if (wr == 1) PG8_BAR; }
    }
    PG8_WAIT_V(0);
    if constexpr (!ALIGN_EPI) { if (wr == 0) PG8_BAR; }
    PG8_BAR;
    if constexpr (Epi::AFTER_DRAIN) { E.fused(acc, cur, wr, wc, fr, fq, lds, wid, lane); S.done(cur); }
#undef PG8_SA
#undef PG8_SB
#undef PG8_STAGE
#undef PG8_LDA
#undef PG8_LDB
#undef PG8_MMA
#undef PG8_WAIT_V
#undef PG8_WAIT_L
#undef PG8_BAR
#undef PG8_SCHED
}
}
#define GAS __attribute__((address_space(1)))
#define LAS __attribute__((address_space(3)))
typedef unsigned short bf16;
typedef unsigned v4u __attribute__((ext_vector_type(4)));
typedef float f32x4 __attribute__((ext_vector_type(4)));
typedef short bf16x8 __attribute__((ext_vector_type(8)));
typedef GAS unsigned gu32;
typedef GAS unsigned long long gu64;
#define RLX_AGENT __ATOMIC_RELAXED, __HIP_MEMORY_SCOPE_AGENT
#define LDS_WAIT() asm volatile("s_waitcnt lgkmcnt(0)" ::: "memory")
#define VM_WAIT() asm volatile("s_waitcnt vmcnt(0)" ::: "memory")
__device__ __forceinline__ unsigned long long rt() { return __builtin_amdgcn_s_memrealtime(); }
__device__ __forceinline__ unsigned f2bf(float f) { unsigned u = __builtin_bit_cast(unsigned, f); return (u + 0x7fffu + ((u >> 16) & 1u)) >> 16; }
__device__ __forceinline__ unsigned pk2(float lo, float hi) { return f2bf(lo) | (f2bf(hi) << 16); }

#define XB_TMO      128
#define XB_XCNT(j)  (256  + 64 * (j))
#define XB_XSUB(j)  (1280 + 64 * (j))
#define XB_XGEN(j)  (2304 + 64 * (j))
#define XB_TOP      3328
#define XB_TOPGEN   3392
#define XCD_BAR_WORDS 3456
#define XB_SPIN_CAP (1u << 18)

__device__ __forceinline__ unsigned xb_ld(unsigned* p)              { return __hip_atomic_load(p, __ATOMIC_RELAXED, __HIP_MEMORY_SCOPE_AGENT); }
__device__ __forceinline__ unsigned xb_add(unsigned* p, unsigned v) { return __hip_atomic_fetch_add(p, v, __ATOMIC_RELAXED, __HIP_MEMORY_SCOPE_AGENT); }
__device__ __forceinline__ unsigned xb_xcc_id() { return (unsigned)__builtin_amdgcn_s_getreg((3 << 11) | 20) & 0xFu; }
#define XB_SPIN(cond, bar) do { unsigned _sp = 0; while (cond) { __builtin_amdgcn_s_sleep(1); \
    if ((++_sp & 255u) == 0u) { if (xb_ld(&(bar)[XB_TMO])) break; if (_sp > XB_SPIN_CAP) { atomicAdd(&(bar)[XB_TMO], 1u); break; } } } } while (0)

struct XcdBarrier {
    unsigned* bar; unsigned x;
    volatile LAS unsigned* st;
};

__device__ __forceinline__ XcdBarrier xcd_barrier_post(unsigned* bar, volatile LAS unsigned* st) {
    XcdBarrier b; b.bar = bar; b.x = xb_xcc_id(); b.st = st;
    if (threadIdx.x == 0) (void)xb_add(&bar[XB_XCNT(b.x)], 1u);
    return b;
}
__device__ __forceinline__ void xcd_barrier_complete(unsigned* bar, unsigned x, unsigned& nloc, unsigned& nx) {
    const unsigned G = gridDim.x * gridDim.y * gridDim.z;
    unsigned sum, cnt, mine, sp = 0u;
    for (;;) {
        sum = 0u; cnt = 0u; mine = 0u;
#pragma unroll
        for (unsigned j = 0; j < 16; ++j) { const unsigned c = xb_ld(&bar[XB_XCNT(j)]); sum += c; cnt += (c > 0u) ? 1u : 0u; mine = (j == x) ? c : mine; }
        if (sum == G) break;
        __builtin_amdgcn_s_sleep(1);
        if ((++sp & 255u) == 0u) { if (xb_ld(&bar[XB_TMO])) break; if (sp > XB_SPIN_CAP) { atomicAdd(&bar[XB_TMO], 1u); break; } }
    }
    nloc = mine > 0u ? mine : 1u; nx = cnt > 0u ? cnt : 1u;
}

__device__ __forceinline__ void xcd_barrier(const XcdBarrier& b) {
    asm volatile("s_waitcnt vmcnt(0)" ::: "memory");
    __syncthreads();
    if (threadIdx.x == 0) {
        unsigned* bar = b.bar;
        __builtin_amdgcn_s_waitcnt(0);
        unsigned nloc = b.st[0], nx = b.st[1];
        if (nloc == 0u) { xcd_barrier_complete(bar, b.x, nloc, nx); b.st[0] = nloc; b.st[1] = nx; }
        const unsigned old = xb_add(&bar[XB_XSUB(b.x)], 1u);
        const unsigned gen = old / nloc;
        if (old + 1u == (gen + 1u) * nloc) {
            __builtin_amdgcn_fence(__ATOMIC_RELEASE, "agent");
            asm volatile("s_waitcnt vmcnt(0)" ::: "memory");
            const unsigned og = xb_add(&bar[XB_TOP], 1u);
            const unsigned tg = og / nx;
            if (og + 1u == (tg + 1u) * nx) xb_add(&bar[XB_TOPGEN], 1u);
            else XB_SPIN(xb_ld(&bar[XB_TOPGEN]) == tg, bar);
            __builtin_amdgcn_fence(__ATOMIC_ACQUIRE, "agent");
            xb_add(&bar[XB_XGEN(b.x)], 1u);
            asm volatile("s_waitcnt vmcnt(0)" ::: "memory");
        } else {
            XB_SPIN(xb_ld(&bar[XB_XGEN(b.x)]) == gen, bar);
            __builtin_amdgcn_fence(__ATOMIC_ACQUIRE, "agent");
            asm volatile("s_waitcnt vmcnt(0)" ::: "memory");
        }
    }
    __syncthreads();
}

constexpr int NWAVES = 8, NTHREADS = 512;
constexpr int DM = 2048, NP_ROWS = 8192, NS_ROWS = 128, NROWS = 8320, MPAD = 8448;
constexpr int DEPTH = 4, NBATCH = 36;
constexpr int INW = 4368, ZW = 4608;
constexpr int ZQ = 0, ZK = 512, ZV = 640, ZU = 768, GQ = 1280, GK = 1792, GV = 2304, GG = 3328, GA = 4352;
constexpr int DFF = 5632, NGU = 11264, MODW = 12288, MODLD = 49152;
constexpr float EPS = 1e-6f;
constexpr size_t O_Y = 0, O_WK_P = 17039360, O_WV_P = 17301504, O_POOL_P = 17563648, O_GLA_P = 17686528,
                 O_WK_S = 19783680, O_WV_S = 21880832, O_POOL_S = 23977984, O_GLA_S = 24961024, O_END = 41738240;
constexpr size_t MiB = 1u << 20;
constexpr size_t WS_CTL = 0, CTL_ZERO_BYTES = 1 * MiB;
constexpr size_t WS_WADA = 1 * MiB;
constexpr size_t WS_WIN  = WS_WADA + 192 * MiB;
constexpr size_t WS_WOUT = WS_WIN + 72 * MiB;
constexpr size_t WS_WGU  = WS_WOUT + 32 * MiB;
constexpr size_t WS_WDN  = WS_WGU + 176 * MiB;
constexpr size_t WS_X    = WS_WDN + 88 * MiB;
constexpr size_t WS_H    = WS_X + 66 * MiB;
constexpr size_t WS_Z    = WS_H + 33 * MiB;
constexpr size_t WS_MIX  = WS_Z + 75 * MiB;
constexpr size_t WS_ACT  = WS_MIX + 33 * MiB;
constexpr size_t WS_OGLA = WS_ACT + 91 * MiB;
constexpr size_t WS_LA   = WS_OGLA + 33 * MiB;
constexpr size_t WS_MOD  = WS_LA + 17 * MiB;
constexpr size_t WS_SC   = WS_MOD + 7 * MiB;
constexpr size_t WS_BTAB = WS_SC + 1 * MiB;
constexpr size_t WS_WPT  = WS_BTAB + 1 * MiB;
constexpr size_t WS_QDG  = WS_WPT + 1 * MiB;
constexpr size_t WS_KDTG = WS_QDG + 9 * MiB;
constexpr size_t WS_VTG  = WS_KDTG + 11 * MiB;
constexpr size_t WS_DLG  = WS_VTG + 21 * MiB;
constexpr size_t WS_DUMMY = WS_DLG + 1 * MiB;
constexpr size_t WS_END  = WS_DUMMY + 33 * MiB;
constexpr int CW_BAR = 4096;
constexpr int RING_OFF = 0, RING_BYTES = 131072;
constexpr int LDSCTL_OFF = RING_BYTES, MISC_OFF = LDSCTL_OFF + 320;
constexpr int LDS_BYTES = 147456;

struct Args { const float* in[24]; float* out; unsigned char* ws; int ph_lo, ph_hi; };
struct Frame {
    LAS unsigned char* lds;
    volatile LAS unsigned* MISC;
    int wave, vcu, G; int zo; int probe;
    __device__ __forceinline__ float* OGLA_ST() const { return (float*)(ws + (probe ? WS_DUMMY : WS_OGLA)); }
    __device__ __forceinline__ int lane_id() const { return (int)__builtin_amdgcn_mbcnt_hi(~0u, __builtin_amdgcn_mbcnt_lo(~0u, 0u)); }
    unsigned char* ws; float* out;
    __device__ __forceinline__ bf16* Wada_t() const { return (bf16*)(ws + WS_WADA); }
    __device__ __forceinline__ bf16* Win_t() const { return (bf16*)(ws + WS_WIN); }
    __device__ __forceinline__ bf16* Wout_t() const { return (bf16*)(ws + WS_WOUT); }
    __device__ __forceinline__ bf16* Wgu_t() const { return (bf16*)(ws + WS_WGU); }
    __device__ __forceinline__ bf16* Wdn_t() const { return (bf16*)(ws + WS_WDN); }
    __device__ __forceinline__ float* X() const { return (float*)(ws + WS_X); }
    __device__ __forceinline__ bf16* H() const { return (bf16*)(ws + WS_H); }
    __device__ __forceinline__ bf16* Z() const { return (bf16*)(ws + WS_Z); }
    __device__ __forceinline__ bf16* MIX() const { return (bf16*)(ws + WS_MIX); }
    __device__ __forceinline__ bf16* ACT() const { return (bf16*)(ws + WS_ACT); }
    __device__ __forceinline__ float* OGLA() const { return (float*)(ws + WS_OGLA); }
    __device__ __forceinline__ float* SLOC() const { return (float*)(ws + WS_LA); }
    __device__ __forceinline__ float* DSEG() const { return (float*)(ws + WS_LA + 16 * MiB); }
    __device__ __forceinline__ float* MOD() const { return (float*)(ws + WS_MOD); }
    __device__ __forceinline__ bf16* SC() const { return (bf16*)(ws + WS_SC); }
    __device__ __forceinline__ float* BTAB() const { return (float*)(ws + WS_BTAB); }
    __device__ __forceinline__ bf16* WPT() const { return (bf16*)(ws + WS_WPT); }
    __device__ __forceinline__ bf16* QDG() const { return (bf16*)(ws + WS_QDG); }
    __device__ __forceinline__ bf16* KDTG() const { return (bf16*)(ws + WS_KDTG); }
    __device__ __forceinline__ bf16* VTG() const { return (bf16*)(ws + WS_VTG); }
    __device__ __forceinline__ float* DLG() const { return (float*)(ws + WS_DLG); }
};
enum { I_XP = 0, I_XS, I_CK, I_CV, I_SPOOL, I_SGLA, I_CP, I_CS, I_WADA, I_BADA, I_GMIX, I_GFFN, I_WIN, I_WOUT, I_RELB, I_SINKS, I_WPOOL, I_PSCALE, I_WA2, I_BA2, I_GGLA, I_WGU, I_WDN, I_GFIN };

__device__ __forceinline__ float bf2f(unsigned short b) { return __uint_as_float((unsigned)b << 16); }
__device__ __forceinline__ float bflo(unsigned w) { return __uint_as_float(w << 16); }
__device__ __forceinline__ float bfhi(unsigned w) { return __uint_as_float(w & 0xffff0000u); }
__device__ __forceinline__ float wave_sum(float v) {
#pragma unroll
    for (int o = 1; o < 64; o <<= 1) v += __shfl_xor(v, o);
    return v;
}
__device__ __forceinline__ float wave_max(float v) {
#pragma unroll
    for (int o = 1; o < 64; o <<= 1) v = fmaxf(v, __shfl_xor(v, o));
    return v;
}
__device__ __forceinline__ int t5_bucket(int n) {
    if (n < 16) return n;
    return 16 + (n >= 19) + (n >= 21) + (n >= 24) + (n >= 27) + (n >= 31) + (n >= 35) + (n >= 40) + (n >= 46) + (n >= 52) + (n >= 59) + (n >= 67) + (n >= 77) + (n >= 87) + (n >= 99) + (n >= 113);
}

template <int MODE>
__device__ __forceinline__ void transpose_item(const float* W, int K, int N, int nblk, bf16* WT, int row_off, LAS float* scr, int item, int lane) {
    const int kb = item / nblk, nb = item % nblk, k0 = 64 * kb, n0 = 32 * nb;
    const int nn = n0 + (lane & 31); const bool ok = nn < N;
#pragma unroll 8
    for (int i = 0; i < 32; ++i) { const int kk = 2 * i + (lane >> 5); scr[kk * 33 + (lane & 31)] = ok ? W[(size_t)(k0 + kk) * N + nn] : 0.f; }
    LDS_WAIT(); asm volatile("" ::: "memory");
    const int c = lane & 7;
#pragma unroll
    for (int j = 0; j < 4; ++j) { const int n = (lane >> 3) + 8 * j; const LAS float* s = scr + (8 * c) * 33 + n;
        v4u o; o.x = pk2(s[0 * 33], s[1 * 33]); o.y = pk2(s[2 * 33], s[3 * 33]); o.z = pk2(s[4 * 33], s[5 * 33]); o.w = pk2(s[6 * 33], s[7 * 33]);
        int orow = n0 + n;
        if (MODE == 1) { orow = (orow < DFF) ? ((orow >> 7) * 256 + (orow & 127)) : (((orow - DFF) >> 7) * 256 + 128 + ((orow - DFF) & 127)); }
        *(GAS v4u*)(WT + (size_t)(row_off + orow) * K + k0 + 8 * c) = o; }
    LDS_WAIT(); asm volatile("" ::: "memory");
}
__device__ __forceinline__ void p0_prologue(Frame& F, const Args& A) {
    LAS float* scr = (LAS float*)(F.lds + RING_OFF + F.wave * 16384);
    const int gw = F.vcu * NWAVES + F.wave, NGW = F.G * NWAVES;
    const int gt = gw * 64 + F.lane_id(), NGT = NGW * 64;
    constexpr int I_ADA = 32 * 384, I_IN = 32 * 137, I_OUT = 32 * 64, I_GU = 32 * 352, I_DN = 88 * 64, I_L = I_ADA + I_IN + I_OUT + I_GU + I_DN;
    for (int it = gw; it < DEPTH * I_L; it += NGW) {
        const int l = it / I_L; int r = it - l * I_L;
        if (r < I_ADA) { transpose_item<0>(A.in[F.zo + I_WADA] + (size_t)l * DM * MODW, DM, MODW, 384, F.Wada_t(), l * MODW, scr, r, F.lane_id()); continue; } r -= I_ADA;
        if (r < I_IN)  { transpose_item<0>(A.in[F.zo + I_WIN] + (size_t)l * DM * INW, DM, INW, 137, F.Win_t() + (size_t)l * ZW * DM, 0, scr, r, F.lane_id()); continue; } r -= I_IN;
        if (r < I_OUT) { transpose_item<0>(A.in[F.zo + I_WOUT] + (size_t)l * DM * DM, DM, DM, 64, F.Wout_t() + (size_t)l * DM * DM, 0, scr, r, F.lane_id()); continue; } r -= I_OUT;
        if (r < I_GU)  { transpose_item<1>(A.in[F.zo + I_WGU] + (size_t)l * DM * NGU, DM, NGU, 352, F.Wgu_t() + (size_t)l * NGU * DM, 0, scr, r, F.lane_id()); continue; } r -= I_GU;
        transpose_item<0>(A.in[F.zo + I_WDN] + (size_t)l * DFF * DM, DFF, DM, 64, F.Wdn_t() + (size_t)l * DM * DFF, 0, scr, r, F.lane_id());
    }
    const v4u z4 = {0u, 0u, 0u, 0u};
    for (int i = gt; i < DEPTH * 224 * 256; i += NGT) { const int l = i / (224 * 256), r = i - l * (224 * 256); *((GAS v4u*)(F.Win_t() + ((size_t)l * ZW + 4384) * DM) + r) = z4; }
    for (int i = gt; i < 128 * 256; i += NGT) { *((GAS v4u*)(F.H() + (size_t)NROWS * DM) + i) = z4; *((GAS v4u*)(F.MIX() + (size_t)NROWS * DM) + i) = z4; }
    for (int i = gt; i < 128 * 704; i += NGT) *((GAS v4u*)(F.ACT() + (size_t)NROWS * DFF) + i) = z4;
    for (int i = gt; i < NP_ROWS * 512; i += NGT) ((GAS f32x4*)F.X())[i] = ((const GAS f32x4*)A.in[F.zo + I_XP])[i];
    for (int i = gt; i < NS_ROWS * 512; i += NGT) ((GAS f32x4*)(F.X() + (size_t)NP_ROWS * DM))[i] = ((const GAS f32x4*)A.in[F.zo + I_XS])[i];
    for (int i = gt; i < 256 * 1024; i += NGT) { const int r = i >> 10, cp = (i & 1023) * 2; unsigned w = 0u;
        if (r < NBATCH) { const float* c = (r < 4) ? (A.in[F.zo + I_CP] + (size_t)r * DM) : (A.in[F.zo + I_CS] + (size_t)(r - 4) * DM); const float a = c[cp], b = c[cp + 1];
            w = pk2(a / (1.0f + __expf(-a)), b / (1.0f + __expf(-b))); }
        ((GAS unsigned*)F.SC())[i] = w; }
    for (int i = gt; i < 4 * 4 * 128 * 128; i += NGT) { const int lg = i >> 14, dcol = (i >> 7) & 127, c = i & 127; F.WPT()[i] = (bf16)f2bf(A.in[F.zo + I_WPOOL][((size_t)lg * 128 + c) * 128 + dcol]); }
    for (int i = gt; i < 8 * 128; i += NGT) { const int h = i >> 7, dist = i & 127; F.BTAB()[i] = A.in[F.zo + I_RELB][t5_bucket(dist) * 8 + h]; }
}

__device__ __forceinline__ void norm_mod_rows(Frame& F, const float* g, const float* modl  ) {
    const int gw = F.vcu * NWAVES + F.wave, NGW = F.G * NWAVES;
    for (int r = gw; r < NROWS; r += NGW) {
        const int b = r < NP_ROWS ? (r >> 11) : 4 + ((r - NP_ROWS) >> 2);
        const float* xr = F.X() + (size_t)r * DM + 4 * F.lane_id(); const float* sh = modl + (size_t)b * MODLD + 4 * F.lane_id(); const float* gg = g + 4 * F.lane_id();
        f32x4 v[8]; float ss = 0.f;
#pragma unroll
        for (int j = 0; j < 8; ++j) { v[j] = *(const f32x4*)(xr + 256 * j); ss += (v[j].x * v[j].x + v[j].y * v[j].y) + (v[j].z * v[j].z + v[j].w * v[j].w); }
        const float rstd = 1.0f / sqrtf(wave_sum(ss) * (1.0f / DM) + EPS);
        bf16* hr = F.H() + (size_t)r * DM + 4 * F.lane_id();
#pragma unroll
        for (int j = 0; j < 8; ++j) { const f32x4 gv = *(const f32x4*)(gg + 256 * j), sv = *(const f32x4*)(sh + 256 * j), cv = *(const f32x4*)(sh + 2048 + 256 * j);
            const f32x4 y = (v[j] * rstd * gv) * (1.0f + cv) + sv;
            uint2 w; w.x = pk2(y.x, y.y); w.y = pk2(y.z, y.w); *(uint2*)(hr + 256 * j) = w; }
    }
}
__device__ __forceinline__ void final_norm_rows(Frame& F, const Args& A) {
    const int gw = F.vcu * NWAVES + F.wave, NGW = F.G * NWAVES; const float* g = A.in[F.zo + I_GFIN] + 4 * F.lane_id();
    for (int r = gw; r < NROWS; r += NGW) {
        const float* xr = F.X() + (size_t)r * DM + 4 * F.lane_id();
        f32x4 v[8]; float ss = 0.f;
#pragma unroll
        for (int j = 0; j < 8; ++j) { v[j] = *(const f32x4*)(xr + 256 * j); ss += (v[j].x * v[j].x + v[j].y * v[j].y) + (v[j].z * v[j].z + v[j].w * v[j].w); }
        const float rstd = 1.0f / sqrtf(wave_sum(ss) * (1.0f / DM) + EPS);
        float* yr = F.out + O_Y + (size_t)r * DM + 4 * F.lane_id();
#pragma unroll
        for (int j = 0; j < 8; ++j) { const f32x4 gv = *(const f32x4*)(g + 256 * j); *(f32x4*)(yr + 256 * j) = v[j] * rstd * gv; }
    }
}

__device__ __forceinline__ void attn_item(Frame& F, const Args& A, int l, int r, int hd, LAS float* ps) {
    const int lane = F.lane_id(), g = hd >> 2; const bool smp = r >= NP_ROWS;
    const int t = r & 2047, sb = smp ? ((r - NP_ROWS) >> 2) : 0, si = (r - NP_ROWS) & 3;
    LAS float* qs = ps + 128;
    { const unsigned w = ((const unsigned*)(F.Z() + (size_t)r * ZW + ZQ + hd * 64))[lane & 31]; if (lane < 32) { qs[2 * lane] = bflo(w); qs[2 * lane + 1] = bfhi(w); } }
    LDS_WAIT(); asm volatile("" ::: "memory");
    const float* ck = A.in[F.zo + I_CK] + ((size_t)(l * 32 + sb) * 128) * 128 + g * 64;
    const float* cv = A.in[F.zo + I_CV] + ((size_t)(l * 32 + sb) * 128) * 128 + g * 64;
    const int jmin = smp ? 0 : (t >= 127 ? 0 : 127 - t);
    float sc[2];
#pragma unroll 1
    for (int jj = 0; jj < 2; ++jj) {
        const int j = lane + 64 * jj, dist = 127 - j; float dot = 0.f; bool valid = j >= jmin;
        if (valid) {
            const int krel = si - dist;
            if (smp && krel < 0) {
                const f32x4* kp = (const f32x4*)(ck + (size_t)(krel + 128) * 128);
#pragma unroll 4
                for (int c = 0; c < 16; ++c) { const f32x4 kv = kp[c]; const f32x4 qv = *(const LAS f32x4*)(qs + 4 * c); dot += qv.x * kv.x + qv.y * kv.y + qv.z * kv.z + qv.w * kv.w; }
            } else {
                const int krow = smp ? (NP_ROWS + sb * 4 + krel) : (r - dist);
                const v4u* kp = (const v4u*)(F.Z() + (size_t)krow * ZW + ZK + g * 64);
#pragma unroll 4
                for (int c = 0; c < 8; ++c) { const v4u w = kp[c];
                    const f32x4 qa = *(const LAS f32x4*)(qs + 8 * c), qb = *(const LAS f32x4*)(qs + 8 * c + 4);
                    dot += qa.x * bflo(w.x) + qa.y * bfhi(w.x) + qa.z * bflo(w.y) + qa.w * bfhi(w.y) + qb.x * bflo(w.z) + qb.y * bfhi(w.z) + qb.z * bflo(w.w) + qb.w * bfhi(w.w); }
            }
        }
        const float sv = valid ? dot * 0.125f + F.BTAB()[hd * 128 + dist] : -INFINITY;
        if (jj == 0) sc[0] = sv; else sc[1] = sv;
    }
    const float sink = A.in[F.zo + I_SINKS][l * 8 + hd];
    const float m = fmaxf(wave_max(fmaxf(sc[0], sc[1])), sink);
    const float p0 = __expf(sc[0] - m), p1 = __expf(sc[1] - m);
    const float denom = wave_sum(p0 + p1) + __expf(sink - m);
    ps[lane] = p0; ps[lane + 64] = p1;
    LDS_WAIT(); asm volatile("" ::: "memory");
    float o = 0.f;
    for (int j = jmin; j < 128; ++j) {
        const float pj = ps[j]; const int dist = 127 - j; float vv;
        const int krel = si - dist;
        if (smp && krel < 0) vv = cv[(size_t)(krel + 128) * 128 + lane];
        else { const int krow = smp ? (NP_ROWS + sb * 4 + krel) : (r - dist); vv = bf2f(F.Z()[(size_t)krow * ZW + ZV + g * 64 + lane]); }
        o += pj * vv;
    }
    F.MIX()[(size_t)r * DM + hd * 64 + lane] = (bf16)f2bf(o / denom);
    LDS_WAIT(); asm volatile("" ::: "memory");
}
__device__ __forceinline__ void pool_item(Frame& F, const Args& A, int l, int r, int gi, LAS float* ds) {
    const int lane = F.lane_id(), w = 2 << gi; const bool smp = r >= NP_ROWS;
    const int t = r & 2047, sb = (r - NP_ROWS) >> 2, si = (r - NP_ROWS) & 3;
    const float* pbuf = A.in[F.zo + I_SPOOL] + ((size_t)(l * 32 + sb) * 15) * 512 + gi * 128;
    float s0 = 0.f, s1 = 0.f, u0 = 0.f, u1 = 0.f;
    for (int o = 0; o < w; ++o) {
        float a0 = 0.f, a1 = 0.f;
        if (!smp) { if (t - o >= 0) { const bf16* zp = F.Z() + (size_t)(r - o) * ZW + ZU + gi * 128; a0 = bf2f(zp[lane]); a1 = bf2f(zp[lane + 64]); } }
        else { const int idx = si - o;
            if (idx >= 0) { const bf16* zp = F.Z() + (size_t)(NP_ROWS + sb * 4 + idx) * ZW + ZU + gi * 128; a0 = bf2f(zp[lane]); a1 = bf2f(zp[lane + 64]); }
            else { const float* bp = pbuf + (size_t)(15 + idx) * 512; a0 = bp[lane]; a1 = bp[lane + 64]; } }
        if (o == 0) { u0 = a0; u1 = a1; }
        s0 += a0; s1 += a1;
    }
    const float cnt = smp ? (float)w : (float)((t + 1) < w ? (t + 1) : w);
    ds[lane] = s0 / cnt - u0; ds[lane + 64] = s1 / cnt - u1;
    LDS_WAIT(); asm volatile("" ::: "memory");
    const float* wp = A.in[F.zo + I_WPOOL] + ((size_t)(l * 4 + gi) * 128) * 128;
    float y0 = 0.f, y1 = 0.f;
#pragma unroll 4
    for (int c = 0; c < 128; ++c) { const float dv = ds[c]; y0 += dv * wp[c * 128 + lane]; y1 += dv * wp[c * 128 + lane + 64]; }
    const float* psc = A.in[F.zo + I_PSCALE] + l * 512 + gi * 128;
    bf16* mp = F.MIX() + (size_t)r * DM + 512 + gi * 128;
    mp[lane] = (bf16)f2bf(y0 * psc[lane]); mp[lane + 64] = (bf16)f2bf(y1 * psc[lane + 64]);
    LDS_WAIT(); asm volatile("" ::: "memory");
}
__device__ __forceinline__ void cache_outputs(Frame& F, const Args& A, int l) {
    const int gt = (F.vcu * NWAVES + F.wave) * 64 + F.lane_id(), NGT = F.G * NWAVES * 64;
    for (int i = gt; i < 4 * 128 * 128; i += NGT) { const int b = i >> 14, j = (i >> 7) & 127, c = i & 127; const bf16* zr = F.Z() + (size_t)(b * 2048 + 1920 + j) * ZW;
        F.out[O_WK_P + (size_t)l * 65536 + i] = bf2f(zr[ZK + c]); F.out[O_WV_P + (size_t)l * 65536 + i] = bf2f(zr[ZV + c]); }
    for (int i = gt; i < 4 * 15 * 512; i += NGT) { const int b = i / 7680, rem = i - b * 7680, j = rem >> 9, c = rem & 511;
        F.out[O_POOL_P + (size_t)l * 30720 + i] = bf2f(F.Z()[(size_t)(b * 2048 + 2033 + j) * ZW + ZU + c]); }
    for (int i = gt; i < 32 * 128 * 128; i += NGT) { const int sb = i >> 14, p = (i >> 7) & 127, c = i & 127; float kv, vv;
        if (p < 124) { const size_t src = ((size_t)(l * 32 + sb) * 128 + p + 4) * 128 + c; kv = A.in[F.zo + I_CK][src]; vv = A.in[F.zo + I_CV][src]; }
        else { const bf16* zr = F.Z() + (size_t)(NP_ROWS + sb * 4 + p - 124) * ZW; kv = bf2f(zr[ZK + c]); vv = bf2f(zr[ZV + c]); }
        F.out[O_WK_S + (size_t)l * 524288 + i] = kv; F.out[O_WV_S + (size_t)l * 524288 + i] = vv; }
    for (int i = gt; i < 32 * 15 * 512; i += NGT) { const int sb = i / 7680, rem = i - sb * 7680, j = rem >> 9, c = rem & 511; float v;
        if (j < 11) v = A.in[F.zo + I_SPOOL][((size_t)(l * 32 + sb) * 15 + j + 4) * 512 + c];
        else v = bf2f(F.Z()[(size_t)(NP_ROWS + sb * 4 + j - 11) * ZW + ZU + c]);
        F.out[O_POOL_S + (size_t)l * 245760 + i] = v; }
}
__device__ __forceinline__ void gla_out_item(Frame& F, const Args& A, int l, int r, int hh) {
    const int lane = F.lane_id();
    const f32x4 o = *(const f32x4*)(F.OGLA() + (size_t)r * 1024 + hh * 256 + 4 * lane);
    const float ss = wave_sum((o.x * o.x + o.y * o.y) + (o.z * o.z + o.w * o.w));
    const float rstd = 1.0f / sqrtf(ss * (1.0f / 256.0f) + EPS);
    const f32x4 gv = *(const f32x4*)(A.in[F.zo + I_GGLA] + l * 1024 + hh * 256 + 4 * lane);
    const uint2 gw = *(const uint2*)(F.Z() + (size_t)r * ZW + GG + hh * 256 + 4 * lane);
    const float g0 = bflo(gw.x), g1 = bfhi(gw.x), g2 = bflo(gw.y), g3 = bfhi(gw.y);
    const float y0 = o.x * rstd * gv.x * (g0 / (1.0f + __expf(-g0))), y1 = o.y * rstd * gv.y * (g1 / (1.0f + __expf(-g1)));
    const float y2 = o.z * rstd * gv.z * (g2 / (1.0f + __expf(-g2))), y3 = o.w * rstd * gv.w * (g3 / (1.0f + __expf(-g3)));
    uint2 w; w.x = pk2(y0, y1); w.y = pk2(y2, y3);
    *(uint2*)(F.MIX() + (size_t)r * DM + 1024 + hh * 256 + 4 * lane) = w;
}
typedef unsigned u32x2 __attribute__((ext_vector_type(2)));
__device__ __forceinline__ u32x2 pack4bf(const f32x4 v) { u32x2 w; w.x = pk2(v.x, v.y); w.y = pk2(v.z, v.w); return w; }
constexpr int GL_QD = 0, GL_KD = 17408, GL_VT = 34816, GL_AM = 71680, GL_BS = 80896, GL_GS = 82944, GL_END = 87040;
static_assert(GL_END <= RING_BYTES, "GLA LDS map");
constexpr int GL_NSLOT = 640;
__device__ __forceinline__ void gla_prep_unit(Frame& F, const Args& A, int l, int slot) {
    const int lane = F.lane_id(), wave = F.wave, tid = wave * 64 + lane, fr = lane & 15, fq = lane >> 4;
    const bool smp = slot >= 512; const int hh = slot & 3;
    const int row0 = smp ? (NP_ROWS + ((slot - 512) >> 2) * 4) : ((slot >> 7) * 2048 + ((slot >> 2) & 31) * 64), nvalid = smp ? 4 : 64;
    const int d = tid & 127, qtr = tid >> 7, cg = hh * 128 + d;
    LAS bf16* QD = (LAS bf16*)(F.lds + GL_QD); LAS bf16* KD = (LAS bf16*)(F.lds + GL_KD); LAS bf16* VT = (LAS bf16*)(F.lds + GL_VT); LAS bf16* AM = (LAS bf16*)(F.lds + GL_AM);
    LAS float* BS = (LAS float*)(F.lds + GL_BS); LAS float* GS = (LAS float*)(F.lds + GL_GS);
    const bf16* Z = F.Z();
    { const int t = tid >> 3, j0 = (tid & 7) * 2; float g0 = 0.f, g1 = 0.f;
      if (t < nvalid) { const unsigned w = *(const unsigned*)(Z + (size_t)(row0 + t) * ZW + GA + j0); g0 = bflo(w); g1 = bfhi(w); }
      GS[t * 16 + j0] = g0; GS[t * 16 + j0 + 1] = g1; }
    float wa[16];
    { const float* wp = A.in[F.zo + I_WA2] + (size_t)l * 16 * 512 + cg;
#pragma unroll
      for (int j = 0; j < 16; ++j) wa[j] = wp[j * 512]; }
    const float ba = A.in[F.zo + I_BA2][l * 512 + cg];
    __syncthreads();
    float bl[16]; float run = 0.f;
#pragma unroll
    for (int i = 0; i < 16; ++i) { const int t = 16 * qtr + i; const LAS f32x4* gp = (const LAS f32x4*)(GS + t * 16); const f32x4 g0 = gp[0], g1 = gp[1], g2 = gp[2], g3 = gp[3];
        float x = ba + g0.x * wa[0] + g0.y * wa[1] + g0.z * wa[2] + g0.w * wa[3] + g1.x * wa[4] + g1.y * wa[5] + g1.z * wa[6] + g1.w * wa[7];
        x += g2.x * wa[8] + g2.y * wa[9] + g2.z * wa[10] + g2.w * wa[11] + g3.x * wa[12] + g3.y * wa[13] + g3.z * wa[14] + g3.w * wa[15];
        float la = (fminf(x, 0.f) - __logf(1.0f + __expf(-fabsf(x)))) * (1.0f / 16.0f);
        if (t >= nvalid) la = 0.f;
        run += la; bl[i] = run; }
    BS[qtr * 128 + d] = run;
    __syncthreads();
    float pre = 0.f, tot = 0.f;
#pragma unroll
    for (int q2 = 0; q2 < 4; ++q2) { const float v = BS[q2 * 128 + d]; tot += v; if (q2 < qtr) pre += v; }
    { const bf16* zq = Z + (size_t)(row0 + 16 * qtr) * ZW + GQ + cg; const bf16* zk = zq + (GK - GQ);
      bf16* qg = F.QDG() + (size_t)(row0 + 16 * qtr) * 512 + cg;
      unsigned kt[8];
#pragma unroll
      for (int i = 0; i < 16; ++i) { const int t = 16 * qtr + i; const float b = pre + bl[i]; float qv = 0.f, kv = 0.f;
          if (t < nvalid) { qv = bf2f(zq[(size_t)i * ZW]); kv = bf2f(zk[(size_t)i * ZW]); }
          const unsigned qd = f2bf(qv * __expf(b) * 0.08838834764831845f), kd = f2bf(kv * __expf(-b)), kdt = f2bf(kv * __expf(tot - b));
          QD[t * 136 + d] = (bf16)qd; KD[t * 136 + d] = (bf16)kd;
          if (t < nvalid) qg[(size_t)i * 512] = (bf16)qd;
          if (i & 1) kt[i >> 1] |= kdt << 16; else kt[i >> 1] = kdt; }
      v4u* kg = (v4u*)(F.KDTG() + ((size_t)slot * 128 + d) * 64 + 16 * qtr);
      kg[0] = (v4u){kt[0], kt[1], kt[2], kt[3]}; kg[1] = (v4u){kt[4], kt[5], kt[6], kt[7]};
      if (qtr == 0) F.DLG()[slot * 128 + d] = __expf(tot); }
    { const int e = tid & 255, hf = tid >> 8; const bf16* vp = Z + (size_t)(row0 + 32 * hf) * ZW + GV + hh * 256 + e;
      unsigned vw[16];
#pragma unroll
      for (int i = 0; i < 32; ++i) { const int s = 32 * hf + i; unsigned x = 0u; if (s < nvalid) x = vp[(size_t)i * ZW];
          if (i & 1) vw[i >> 1] |= x << 16; else vw[i >> 1] = x; }
      LAS v4u* vl = (LAS v4u*)(VT + e * 72 + 32 * hf); v4u* vg = (v4u*)(F.VTG() + ((size_t)slot * 256 + e) * 64 + 32 * hf);
#pragma unroll
      for (int k = 0; k < 4; ++k) { const v4u w = {vw[4 * k], vw[4 * k + 1], vw[4 * k + 2], vw[4 * k + 3]}; vl[k] = w; vg[k] = w; } }
    __syncthreads();
#pragma unroll
    for (int bi = 0; bi < 2; ++bi) { const int blk = 2 * wave + bi, tb = blk >> 2, sbk = blk & 3;
        f32x4 acc = {0.f, 0.f, 0.f, 0.f};
        if (sbk <= tb) {
#pragma unroll
            for (int ks = 0; ks < 4; ++ks) { const bf16x8 a = *(const LAS bf16x8*)(KD + (sbk * 16 + fr) * 136 + ks * 32 + fq * 8), b = *(const LAS bf16x8*)(QD + (tb * 16 + fr) * 136 + ks * 32 + fq * 8);
                acc = __builtin_amdgcn_mfma_f32_16x16x32_bf16(a, b, acc, 0, 0, 0); } }
        const int t = tb * 16 + fr, s0 = sbk * 16 + 4 * fq;
        f32x4 m; m.x = (s0 + 0 <= t) ? acc.x : 0.f; m.y = (s0 + 1 <= t) ? acc.y : 0.f; m.z = (s0 + 2 <= t) ? acc.z : 0.f; m.w = (s0 + 3 <= t) ? acc.w : 0.f;
        *(LAS u32x2*)(AM + t * 72 + s0) = pack4bf(m); }
    __syncthreads();
#pragma unroll
    for (int ei = 0; ei < 2; ++ei) { const int eb = 2 * wave + ei;
        const bf16x8 a0 = *(const LAS bf16x8*)(VT + (eb * 16 + fr) * 72 + fq * 8), a1 = *(const LAS bf16x8*)(VT + (eb * 16 + fr) * 72 + 32 + fq * 8);
#pragma unroll
        for (int tb = 0; tb < 4; ++tb) { f32x4 o = {0.f, 0.f, 0.f, 0.f};
            o = __builtin_amdgcn_mfma_f32_16x16x32_bf16(a0, *(const LAS bf16x8*)(AM + (tb * 16 + fr) * 72 + fq * 8), o, 0, 0, 0);
            if (tb >= 2) o = __builtin_amdgcn_mfma_f32_16x16x32_bf16(a1, *(const LAS bf16x8*)(AM + (tb * 16 + fr) * 72 + 32 + fq * 8), o, 0, 0, 0);
            const int t = tb * 16 + fr;
            if (t < nvalid) *(f32x4*)(F.OGLA() + (size_t)(row0 + t) * 1024 + hh * 256 + eb * 16 + 4 * fq) = o; } }
    __syncthreads();
}
__device__ __forceinline__ void gla_state_step(Frame& F, int slot, int eb, int fr, int fq, f32x4 (&sacc)[8]) {
    const bf16* vt = F.VTG() + ((size_t)slot * 256 + eb * 16 + fr) * 64 + 8 * fq; const bf16x8 b0 = *(const bf16x8*)vt, b1 = *(const bf16x8*)(vt + 32);
    const bf16* kt = F.KDTG() + ((size_t)slot * 128 + fr) * 64 + 8 * fq; const float* dl = F.DLG() + slot * 128 + 4 * fq;
#pragma unroll
    for (int db = 0; db < 8; ++db) { const f32x4 dv = *(const f32x4*)(dl + db * 16); const bf16x8 a0 = *(const bf16x8*)(kt + (size_t)db * 16 * 64), a1 = *(const bf16x8*)(kt + (size_t)db * 16 * 64 + 32);
        f32x4 s = sacc[db] * dv; s = __builtin_amdgcn_mfma_f32_16x16x32_bf16(a0, b0, s, 0, 0, 0); s = __builtin_amdgcn_mfma_f32_16x16x32_bf16(a1, b1, s, 0, 0, 0); sacc[db] = s; }
}
__device__ __forceinline__ void gla_inter_step(Frame& F, int row0, int nvalid, int ntb, int hh, int eb, int fr, int fq, const f32x4 (&sacc)[8]) {
    bf16x8 sf[4];
#pragma unroll
    for (int ks = 0; ks < 4; ++ks) { const u32x2 lo = pack4bf(sacc[2 * ks]), hi = pack4bf(sacc[2 * ks + 1]); const v4u w = {lo.x, lo.y, hi.x, hi.y}; sf[ks] = __builtin_bit_cast(bf16x8, w); }
    for (int tb = 0; tb < ntb; ++tb) { const int t = tb * 16 + fr; const bool ok = t < nvalid;
        const bf16* qp = F.QDG() + (size_t)(row0 + t) * 512 + hh * 128 + 4 * fq;
        f32x4 o = {0.f, 0.f, 0.f, 0.f};
#pragma unroll
        for (int ks = 0; ks < 4; ++ks) { u32x2 lo = {0u, 0u}, hi = {0u, 0u}; if (ok) { lo = *(const u32x2*)(qp + 32 * ks); hi = *(const u32x2*)(qp + 32 * ks + 16); }
            const v4u w = {lo.x, lo.y, hi.x, hi.y}; o = __builtin_amdgcn_mfma_f32_16x16x32_bf16(sf[ks], __builtin_bit_cast(bf16x8, w), o, 0, 0, 0); }
        if (ok) { const size_t oi = (size_t)(row0 + t) * 1024 + hh * 256 + eb * 16 + 4 * fq; *(f32x4*)(F.OGLA_ST() + oi) = *(const f32x4*)(F.OGLA() + oi) + o; } }
}
__device__ __forceinline__ void gla_store_state(float* dst, int fr, int fq, const f32x4 (&sacc)[8]) {
#pragma unroll
    for (int db = 0; db < 8; ++db) { const int d0 = db * 16 + 4 * fq; dst[(size_t)(d0 + 0) * 256 + fr] = sacc[db].x; dst[(size_t)(d0 + 1) * 256 + fr] = sacc[db].y; dst[(size_t)(d0 + 2) * 256 + fr] = sacc[db].z; dst[(size_t)(d0 + 3) * 256 + fr] = sacc[db].w; }
}
__device__ __forceinline__ void gla_phase_g1(Frame& F, const Args& A, int l) {
    const int lane = F.lane_id(), fr = lane & 15, fq = lane >> 4;
    const int gw = F.vcu * NWAVES + F.wave, NGW = F.G * NWAVES;
    for (int it = gw; it < 2048; it += NGW) { const int bh = it >> 7, seg = (it >> 4) & 7, eb = it & 15;
        if (seg == 7) continue;
        f32x4 sacc[8];
#pragma unroll
        for (int db = 0; db < 8; ++db) sacc[db] = (f32x4){0.f, 0.f, 0.f, 0.f};
        const int slot0 = (((bh >> 2) * 32 + seg * 4) * 4) + (bh & 3);
        for (int c = 0; c < 4; ++c) gla_state_step(F, slot0 + 4 * c, eb, fr, fq, sacc);
        gla_store_state(F.SLOC() + ((size_t)(bh * 8 + seg) * 128) * 256 + eb * 16, fr, fq, sacc);
        if (eb == 0) {
#pragma unroll
            for (int k = 0; k < 2; ++k) { const int d = lane + 64 * k; float p = 1.f; for (int c = 0; c < 4; ++c) p *= F.DLG()[(slot0 + 4 * c) * 128 + d]; F.DSEG()[(bh * 8 + seg) * 128 + d] = p; } }
    }
    for (int it = gw; it < 2048; it += NGW) { const int sbh = it >> 4, eb = it & 15, sb = sbh >> 2, hh = sbh & 3;
        const size_t so = ((size_t)((l * 32 + sb) * 4 + hh)) * 32768 + eb * 16;
        const float* s0 = A.in[F.zo + I_SGLA] + so + fr;
        f32x4 sacc[8];
#pragma unroll
        for (int db = 0; db < 8; ++db) { const int d0 = db * 16 + 4 * fq; sacc[db].x = s0[(size_t)(d0 + 0) * 256]; sacc[db].y = s0[(size_t)(d0 + 1) * 256]; sacc[db].z = s0[(size_t)(d0 + 2) * 256]; sacc[db].w = s0[(size_t)(d0 + 3) * 256]; }
        gla_inter_step(F, NP_ROWS + sb * 4, 4, 1, hh, eb, fr, fq, sacc);
        gla_state_step(F, 512 + sbh, eb, fr, fq, sacc);
        gla_store_state(F.out + O_GLA_S + so, fr, fq, sacc);
    }
}
__device__ __forceinline__ void gla_phase_g2(Frame& F, const Args& A, int l) {
    const int lane = F.lane_id(), fr = lane & 15, fq = lane >> 4;
    const int gw = F.vcu * NWAVES + F.wave, NGW = F.G * NWAVES;
    for (int it = gw; it < 2048; it += NGW) { const int bh = it >> 7, seg = (it >> 4) & 7, eb = it & 15, hh = bh & 3;
        f32x4 sacc[8];
#pragma unroll
        for (int db = 0; db < 8; ++db) sacc[db] = (f32x4){0.f, 0.f, 0.f, 0.f};
        for (int i2 = 0; i2 < seg; ++i2) { const float* sl = F.SLOC() + ((size_t)(bh * 8 + i2) * 128) * 256 + eb * 16 + fr; const float* dg = F.DSEG() + (bh * 8 + i2) * 128;
#pragma unroll
            for (int db = 0; db < 8; ++db) { const int d0 = db * 16 + 4 * fq; const f32x4 dv = *(const f32x4*)(dg + d0);
                sacc[db].x = sacc[db].x * dv.x + sl[(size_t)(d0 + 0) * 256]; sacc[db].y = sacc[db].y * dv.y + sl[(size_t)(d0 + 1) * 256]; sacc[db].z = sacc[db].z * dv.z + sl[(size_t)(d0 + 2) * 256]; sacc[db].w = sacc[db].w * dv.w + sl[(size_t)(d0 + 3) * 256]; } }
        const int slot0 = (((bh >> 2) * 32 + seg * 4) * 4) + hh, row0 = (bh >> 2) * 2048 + seg * 256;
        for (int c = 0; c < 4; ++c) { gla_inter_step(F, row0 + c * 64, 64, 4, hh, eb, fr, fq, sacc); gla_state_step(F, slot0 + 4 * c, eb, fr, fq, sacc); }
        if (seg == 7) gla_store_state(F.out + O_GLA_P + ((size_t)(l * 16 + bh)) * 32768 + eb * 16, fr, fq, sacc);
    }
}
constexpr int AT_VT = 0, AT_VTS = 184, AT_BT = 64 * AT_VTS * 2, AT_END = AT_BT + 4 * 128 * 4;
__device__ __forceinline__ void attn_unit_mfma(Frame& F, const Args& A, int l, int u) {
    const int lane = F.lane_id(), wave = F.wave, tid = wave * 64 + lane, fr = lane & 15, fq = lane >> 4;
    const int span = u >> 1, g = u & 1, t0g = span * 32, tb0 = t0g & 2047;
    LAS bf16* VT = (LAS bf16*)(F.lds + AT_VT); LAS float* BT = (LAS float*)(F.lds + AT_BT);
    const bf16* Z = F.Z();
#pragma unroll
    for (int pass = 0; pass < 2; ++pass) { const int key = pass * 128 + (tid >> 2), dch = (tid & 3) * 16;
        if (key < 160) { v4u v0 = {0u, 0u, 0u, 0u}, v1 = {0u, 0u, 0u, 0u};
            if (tb0 - 128 + key >= 0) { const v4u* vp = (const v4u*)(Z + (size_t)(t0g - 128 + key) * ZW + ZV + g * 64 + dch); v0 = vp[0]; v1 = vp[1]; }
            LAS bf16* vt = VT + dch * AT_VTS + key;
            vt[0 * AT_VTS] = (bf16)(v0.x & 0xffffu); vt[1 * AT_VTS] = (bf16)(v0.x >> 16); vt[2 * AT_VTS] = (bf16)(v0.y & 0xffffu); vt[3 * AT_VTS] = (bf16)(v0.y >> 16);
            vt[4 * AT_VTS] = (bf16)(v0.z & 0xffffu); vt[5 * AT_VTS] = (bf16)(v0.z >> 16); vt[6 * AT_VTS] = (bf16)(v0.w & 0xffffu); vt[7 * AT_VTS] = (bf16)(v0.w >> 16);
            vt[8 * AT_VTS] = (bf16)(v1.x & 0xffffu); vt[9 * AT_VTS] = (bf16)(v1.x >> 16); vt[10 * AT_VTS] = (bf16)(v1.y & 0xffffu); vt[11 * AT_VTS] = (bf16)(v1.y >> 16);
            vt[12 * AT_VTS] = (bf16)(v1.z & 0xffffu); vt[13 * AT_VTS] = (bf16)(v1.z >> 16); vt[14 * AT_VTS] = (bf16)(v1.w & 0xffffu); vt[15 * AT_VTS] = (bf16)(v1.w >> 16); } }
    BT[tid] = F.BTAB()[(g * 4) * 128 + tid];
    __syncthreads();
    const int rb = wave >> 2, hl = wave & 3, hd = g * 4 + hl, t0w = t0g + 16 * rb;
    bf16x8 qf[2];
    { const bf16* qp = Z + (size_t)(t0w + fr) * ZW + ZQ + hd * 64 + 8 * fq; qf[0] = *(const bf16x8*)qp; qf[1] = *(const bf16x8*)(qp + 32); }
    f32x4 sacc[9];
#pragma unroll
    for (int kb = 0; kb < 9; ++kb) { const int kl = 16 * (rb + kb) + fr; bf16x8 k0 = {0, 0, 0, 0, 0, 0, 0, 0}, k1 = {0, 0, 0, 0, 0, 0, 0, 0};
        if (tb0 - 128 + kl >= 0) { const bf16* kp = Z + (size_t)(t0g - 128 + kl) * ZW + ZK + g * 64 + 8 * fq; k0 = *(const bf16x8*)kp; k1 = *(const bf16x8*)(kp + 32); }
        f32x4 acc = {0.f, 0.f, 0.f, 0.f};
        acc = __builtin_amdgcn_mfma_f32_16x16x32_bf16(k0, qf[0], acc, 0, 0, 0); acc = __builtin_amdgcn_mfma_f32_16x16x32_bf16(k1, qf[1], acc, 0, 0, 0);
        sacc[kb] = acc; }
    const float sink = A.in[F.zo + I_SINKS][l * 8 + hd];
    float mx = -INFINITY;
#pragma unroll
    for (int kb = 0; kb < 9; ++kb)
#pragma unroll
        for (int i = 0; i < 4; ++i) { const int dist = 128 - 16 * kb + fr - 4 * fq - i, kpos = tb0 + 16 * rb + fr - dist;
            const bool valid = (dist >= 0) && (dist < 128) && (kpos >= 0);
            const float s = valid ? sacc[kb][i] * 0.125f + BT[hl * 128 + (dist & 127)] : -INFINITY;
            sacc[kb][i] = s; mx = fmaxf(mx, s); }
    mx = fmaxf(mx, __shfl_xor(mx, 16)); mx = fmaxf(mx, __shfl_xor(mx, 32)); mx = fmaxf(mx, sink);
    float ls = 0.f;
#pragma unroll
    for (int kb = 0; kb < 9; ++kb)
#pragma unroll
        for (int i = 0; i < 4; ++i) { const float p = __expf(sacc[kb][i] - mx); sacc[kb][i] = p; ls += p; }
    ls += __shfl_xor(ls, 16); ls += __shfl_xor(ls, 32);
    const float rden = 1.0f / (ls + __expf(sink - mx));
    bf16x8 pf[5];
#pragma unroll
    for (int pp = 0; pp < 5; ++pp) { const f32x4 a = sacc[2 * pp], b = (2 * pp + 1 < 9) ? sacc[2 * pp + 1] : (f32x4){0.f, 0.f, 0.f, 0.f};
        const unsigned w0 = pk2(a.x, a.y), w1 = pk2(a.z, a.w), w2 = pk2(b.x, b.y), w3 = pk2(b.z, b.w);
        v4u w = {w0, w1, w2, w3}; pf[pp] = __builtin_bit_cast(bf16x8, w); }
#pragma unroll
    for (int db = 0; db < 4; ++db) { f32x4 o = {0.f, 0.f, 0.f, 0.f};
#pragma unroll
        for (int pp = 0; pp < 5; ++pp) { const LAS bf16* vr = VT + (db * 16 + fr) * AT_VTS + 16 * (rb + 2 * pp) + 4 * fq;
            const u32x2 lo = *(const LAS u32x2*)vr; u32x2 hi = {0u, 0u}; if (2 * pp + 1 < 9) hi = *(const LAS u32x2*)(vr + 16);
            v4u w = {lo.x, lo.y, hi.x, hi.y};
            o = __builtin_amdgcn_mfma_f32_16x16x32_bf16(__builtin_bit_cast(bf16x8, w), pf[pp], o, 0, 0, 0); }
        *(u32x2*)(F.MIX() + (size_t)(t0w + fr) * DM + hd * 64 + db * 16 + 4 * fq) = pack4bf(o * rden); }
    __syncthreads();
}
__device__ __forceinline__ void pool_item_mfma(Frame& F, const Args& A, int l, int rblk, int g) {
    const int lane = F.lane_id(), fr = lane & 15, fq = lane >> 4;
    const int t = rblk * 16 + fr, pos = t & 2047, w = 2 << g;
    const bf16* Z = F.Z();
    const int nwin = (pos + 1) < w ? (pos + 1) : w; const float rc = 1.0f / (float)nwin;
    bf16x8 df[4];
#pragma unroll
    for (int ks = 0; ks < 4; ++ks) { const bf16* up = Z + (size_t)t * ZW + ZU + g * 128 + ks * 32 + 8 * fq;
        float s[8], u0[8];
        { const v4u x = *(const v4u*)up; u0[0] = bflo(x.x); u0[1] = bfhi(x.x); u0[2] = bflo(x.y); u0[3] = bfhi(x.y); u0[4] = bflo(x.z); u0[5] = bfhi(x.z); u0[6] = bflo(x.w); u0[7] = bfhi(x.w); }
#pragma unroll
        for (int j = 0; j < 8; ++j) s[j] = u0[j];
        for (int i = 1; i < nwin; ++i) { const v4u x = *(const v4u*)(up - (size_t)i * ZW);
            s[0] += bflo(x.x); s[1] += bfhi(x.x); s[2] += bflo(x.y); s[3] += bfhi(x.y); s[4] += bflo(x.z); s[5] += bfhi(x.z); s[6] += bflo(x.w); s[7] += bfhi(x.w); }
        v4u wv; wv.x = pk2(s[0] * rc - u0[0], s[1] * rc - u0[1]); wv.y = pk2(s[2] * rc - u0[2], s[3] * rc - u0[3]); wv.z = pk2(s[4] * rc - u0[4], s[5] * rc - u0[5]); wv.w = pk2(s[6] * rc - u0[6], s[7] * rc - u0[7]);
        df[ks] = __builtin_bit_cast(bf16x8, wv); }
    const bf16* wt = F.WPT() + ((size_t)(l * 4 + g) * 128) * 128; const float* psc = A.in[F.zo + I_PSCALE] + l * 512 + g * 128;
#pragma unroll
    for (int nb = 0; nb < 8; ++nb) { f32x4 acc = {0.f, 0.f, 0.f, 0.f};
#pragma unroll
        for (int ks = 0; ks < 4; ++ks) { const bf16x8 a = *(const bf16x8*)(wt + (size_t)(nb * 16 + fr) * 128 + ks * 32 + 8 * fq); acc = __builtin_amdgcn_mfma_f32_16x16x32_bf16(a, df[ks], acc, 0, 0, 0); }
        const f32x4 sc = *(const f32x4*)(psc + nb * 16 + 4 * fq);
        *(u32x2*)(F.MIX() + (size_t)t * DM + 512 + g * 128 + nb * 16 + 4 * fq) = pack4bf(acc * sc); }
}
__device__ __forceinline__ void skinny_resid(Frame& F, const bf16* Asmp, const bf16* Bt, int K, const float* gate) {
    const int lane = F.lane_id(), wave = F.wave, fr = lane & 15, fq = lane >> 4;
    LAS float* red = (LAS float*)(F.lds + RING_OFF);
    const int kw = K >> 3, ksteps = kw >> 5;
    for (int u = F.vcu; u < 256; u += F.G) {
        const int c0 = (u >> 1) * 16, r0 = (u & 1) * 64;
        const bf16* bp = Bt + (size_t)(c0 + fr) * K + wave * kw + 8 * fq;
        const bf16* ap = Asmp + (size_t)(r0 + fr) * K + wave * kw + 8 * fq;
        f32x4 acc[4];
#pragma unroll
        for (int rb = 0; rb < 4; ++rb) acc[rb] = (f32x4){0.f, 0.f, 0.f, 0.f};
        bf16x8 bc = *(const bf16x8*)bp, ac[4];
#pragma unroll
        for (int rb = 0; rb < 4; ++rb) ac[rb] = *(const bf16x8*)(ap + (size_t)rb * 16 * K);
        for (int ks = 0; ks < ksteps; ++ks) {
            bf16x8 bn = bc, an[4];
#pragma unroll
            for (int rb = 0; rb < 4; ++rb) an[rb] = ac[rb];
            if (ks + 1 < ksteps) { bn = *(const bf16x8*)(bp + (ks + 1) * 32);
#pragma unroll
                for (int rb = 0; rb < 4; ++rb) an[rb] = *(const bf16x8*)(ap + (size_t)rb * 16 * K + (ks + 1) * 32); }
#pragma unroll
            for (int rb = 0; rb < 4; ++rb) acc[rb] = __builtin_amdgcn_mfma_f32_16x16x32_bf16(bc, ac[rb], acc[rb], 0, 0, 0);
            bc = bn;
#pragma unroll
            for (int rb = 0; rb < 4; ++rb) ac[rb] = an[rb];
        }
#pragma unroll
        for (int rb = 0; rb < 4; ++rb) *(LAS f32x4*)(red + ((wave * 4 + rb) * 64 + lane) * 4) = acc[rb];
        __syncthreads();
        if (wave < 4) { f32x4 s = {0.f, 0.f, 0.f, 0.f};
#pragma unroll
            for (int w2 = 0; w2 < 8; ++w2) s = s + *(const LAS f32x4*)(red + ((w2 * 4 + wave) * 64 + lane) * 4);
            const int r = r0 + wave * 16 + fr;
            const f32x4 g = *(const f32x4*)(gate + (size_t)(4 + (r >> 2)) * MODLD + c0 + 4 * fq);
            float* xp = F.X() + (size_t)(NP_ROWS + r) * DM + c0 + 4 * fq; f32x4 xv = *(const f32x4*)xp; xv = xv + g * s; *(f32x4*)xp = xv; }
        __syncthreads();
    }
}

#ifndef EN_P0
#define EN_P0 1
#endif
#ifndef EN_G
#define EN_G 1
#endif
#ifndef EN_N
#define EN_N 1
#endif
#ifndef EN_M2
#define EN_M2 1
#endif
#ifndef EN_M3
#define EN_M3 1
#endif
#ifndef EN_M4
#define EN_M4 1
#endif
#ifndef EN_G1
#define EN_G1 1
#endif
#ifndef EN_GIN
#define EN_GIN 1
#endif
#ifndef EN_GOUT
#define EN_GOUT 1
#endif
#ifndef EN_GGU
#define EN_GGU 1
#endif
#ifndef EN_GDN
#define EN_GDN 1
#endif
#ifndef PROBE_DUP
#define PROBE_DUP 0
#endif
#ifndef MK_SINGLE
#define MK_SINGLE 1
#endif

#define PH_ARGS unsigned ldsb_, unsigned wslo_, unsigned wshi_, unsigned olo_, unsigned ohi_, int wave_, int vcu_, int G_, int probe_, int l_
#define PH_PASS ldsb, wslo, wshi, olo, ohi, F.wave, F.vcu, F.G, F.probe
#define PH_FRAME() Frame F; { const unsigned a0 = __builtin_amdgcn_readfirstlane(ldsb_), a1 = __builtin_amdgcn_readfirstlane(wslo_), a2 = __builtin_amdgcn_readfirstlane(wshi_), a3 = __builtin_amdgcn_readfirstlane(olo_), a4 = __builtin_amdgcn_readfirstlane(ohi_); \
    F.lds = (LAS unsigned char*)(unsigned long long)a0; F.MISC = (volatile LAS unsigned*)(F.lds + MISC_OFF); F.ws = (unsigned char*)(((unsigned long long)a2 << 32) | a1); F.out = (float*)(((unsigned long long)a4 << 32) | a3); \
    F.wave = __builtin_amdgcn_readfirstlane(wave_); F.vcu = __builtin_amdgcn_readfirstlane(vcu_); F.G = __builtin_amdgcn_readfirstlane(G_); F.zo = 0; F.probe = __builtin_amdgcn_readfirstlane(probe_); } \
    const int l = __builtin_amdgcn_readfirstlane(l_); (void)l; \
    const Args& args = *(const Args*)__builtin_amdgcn_kernarg_segment_ptr();
__device__ __forceinline__ void ph_prologue(PH_ARGS) { PH_FRAME(); p0_prologue(F, args); }
__device__ __forceinline__ void ph_norm1(PH_ARGS) { PH_FRAME(); norm_mod_rows(F, args.in[I_GMIX] + l * DM, F.MOD() + (size_t)l * MODW); }
__device__ __forceinline__ void ph_norm2(PH_ARGS) { PH_FRAME(); norm_mod_rows(F, args.in[I_GFFN] + l * DM, F.MOD() + (size_t)l * MODW + 6144); }
__device__ __forceinline__ void ph_final(PH_ARGS) { PH_FRAME(); final_norm_rows(F, args); }
__device__ __forceinline__ void ph_mixa(PH_ARGS) { PH_FRAME();
    const int gw = F.vcu * NWAVES + F.wave, NGW = F.G * NWAVES; LAS float* wscr = (LAS float*)(F.lds + RING_OFF + F.wave * 16384);
    for (int u = F.vcu; u < GL_NSLOT; u += F.G) gla_prep_unit(F, args, l, u);
    for (int u = F.vcu; u < 512; u += F.G) attn_unit_mfma(F, args, l, u);
    for (int it = gw; it < 512 * 4; it += NGW) pool_item_mfma(F, args, l, it >> 2, it & 3);
    for (int it = gw; it < NS_ROWS * 8; it += NGW) attn_item(F, args, l, NP_ROWS + (it >> 3), it & 7, wscr);
    for (int it = gw; it < NS_ROWS * 4; it += NGW) pool_item(F, args, l, NP_ROWS + (it >> 2), it & 3, wscr);
    cache_outputs(F, args, l);
}
__device__ __forceinline__ void ph_gla1(PH_ARGS) { PH_FRAME(); gla_phase_g1(F, args, l); }
__device__ __forceinline__ void ph_gla2(PH_ARGS) { PH_FRAME(); gla_phase_g2(F, args, l); }
__device__ __forceinline__ void ph_mixc(PH_ARGS) { PH_FRAME(); const int gw = F.vcu * NWAVES + F.wave, NGW = F.G * NWAVES; for (int it = gw; it < NROWS * 4; it += NGW) gla_out_item(F, args, l, it >> 2, it & 3); }
constexpr int PH_PER_LAYER = 10, PH_LAYER0 = 2, PH_FINAL = PH_LAYER0 + DEPTH * PH_PER_LAYER, PH_COUNT = PH_FINAL + 1;
__global__ void __launch_bounds__(NTHREADS, 2) hymba_fwd(Args args) {
    extern __shared__ __attribute__((aligned(16))) unsigned char lds[];
    Frame F;
    F.lds = (LAS unsigned char*)lds;
    F.MISC = (volatile LAS unsigned*)(F.lds + MISC_OFF);
    F.wave = __builtin_amdgcn_readfirstlane((int)threadIdx.x >> 6); F.zo = 0; F.probe = 0;
    F.G = gridDim.x; { const int bx = blockIdx.x; F.vcu = (F.G % 8 == 0) ? (bx % 8) * (F.G / 8) + bx / 8 : bx; }
    F.ws = args.ws; F.out = args.out;
    gu32* const ctl = (gu32*)(F.ws + WS_CTL);
    for (int u = threadIdx.x; u < (LDS_BYTES - LDSCTL_OFF) / 4; u += NTHREADS) ((LAS unsigned*)(F.lds + LDSCTL_OFF))[u] = 0u;
    __syncthreads();
#if MK_SINGLE
    XcdBarrier bar = xcd_barrier_post((unsigned*)(ctl + CW_BAR), F.MISC + 8);
#define GRID_BAR() xcd_barrier(bar)
#else
#define GRID_BAR() do { } while (0)
#endif
    const int lo = args.ph_lo, hi = args.ph_hi;
    const unsigned ldsb = (unsigned)(unsigned long long)F.lds, wslo = (unsigned)(unsigned long long)F.ws, wshi = (unsigned)((unsigned long long)F.ws >> 32), olo = (unsigned)(unsigned long long)F.out, ohi = (unsigned)((unsigned long long)F.out >> 32);
#define IN(k) (lo <= (k) && (k) < hi)
#define BOTH(k) (IN(k) && IN((k) + 1))
#define PHASE_BEGIN() asm volatile("s_mov_b32 %0, 0" : "=s"(F.zo), "+s"(F.G), "+s"(F.vcu), "+s"(F.wave))
#define gw (F.vcu * NWAVES + F.wave)
#define NGW (F.G * NWAVES)
#define wscr ((LAS float*)(F.lds + RING_OFF + F.wave * 16384))

    if (EN_P0 && IN(0)) for (int rep_ = 0; rep_ < ((PROBE_DUP & 1) ? 2 : 1); ++rep_) { PHASE_BEGIN(); ph_prologue(PH_PASS, 0); if (BOTH(0)) GRID_BAR(); }
    if (EN_G && EN_G1 && IN(1)) for (int rep_ = 0; rep_ < ((PROBE_DUP & 1) ? 2 : 1); ++rep_) { PHASE_BEGIN();
        pg8::Gemm g{F.SC(), F.Wada_t(), 256, DEPTH * MODW, DM}; pg8::StaticOrder S; S.init(256, DEPTH * MODW, F.G, (int)blockIdx.x);
        pg8::EpiMod E{F.MOD(), args.in[F.zo + I_BADA]};
        pg8::gemm_phase<pg8::EpiMod, pg8::StaticOrder, true, true>(F.lds + RING_OFF, g, S, E, F.wave);
        if (BOTH(1)) GRID_BAR();
    }
    for (int l = 0; l < DEPTH; ++l) {
        const int pb = PH_LAYER0 + l * PH_PER_LAYER;
        const float* modl = F.MOD() + (size_t)l * MODW;
        if (EN_N && IN(pb + 0)) for (int rep_ = 0; rep_ < ((PROBE_DUP & 2) ? 2 : 1); ++rep_) { PHASE_BEGIN(); ph_norm1(PH_PASS, l); if (BOTH(pb + 0)) GRID_BAR(); }
        if (EN_G && EN_GIN && IN(pb + 1)) for (int rep_ = 0; rep_ < ((PROBE_DUP & 4) ? 2 : 1); ++rep_) { PHASE_BEGIN();
            pg8::Gemm g{F.H(), F.Win_t() + (size_t)l * ZW * DM, MPAD, ZW, DM}; pg8::StaticOrder S; S.init(MPAD, ZW, F.G, (int)blockIdx.x);
            pg8::EpiZ E{F.Z(), ZW};
            pg8::gemm_phase<pg8::EpiZ, pg8::StaticOrder, true, true>(F.lds + RING_OFF, g, S, E, F.wave);
            if (BOTH(pb + 1)) GRID_BAR();
        }
        if (EN_M2 && IN(pb + 2)) for (int rep_ = 0; rep_ < ((PROBE_DUP & 8) ? 2 : 1); ++rep_) { PHASE_BEGIN();
            ph_mixa(PH_PASS, l);
            if (BOTH(pb + 2)) GRID_BAR();
        }
        if (EN_M3 && IN(pb + 3)) for (int rep_ = 0; rep_ < ((PROBE_DUP & 16) ? 2 : 1); ++rep_) { PHASE_BEGIN(); F.probe = ((PROBE_DUP & 16) && rep_ == 0) ? 1 : 0; ph_gla1(PH_PASS, l); if (BOTH(pb + 3)) GRID_BAR(); }
        if (EN_M3 && IN(pb + 4)) for (int rep_ = 0; rep_ < ((PROBE_DUP & 32) ? 2 : 1); ++rep_) { PHASE_BEGIN(); F.probe = ((PROBE_DUP & 32) && rep_ == 0) ? 1 : 0;
            ph_gla2(PH_PASS, l);
            if (BOTH(pb + 4)) GRID_BAR();
        }
        if (EN_M4 && IN(pb + 5)) for (int rep_ = 0; rep_ < ((PROBE_DUP & 64) ? 2 : 1); ++rep_) { PHASE_BEGIN(); ph_mixc(PH_PASS, l); if (BOTH(pb + 5)) GRID_BAR(); }
        if (EN_G && EN_GOUT && IN(pb + 6)) { PHASE_BEGIN();
            pg8::Gemm g{F.MIX(), F.Wout_t() + (size_t)l * DM * DM, NP_ROWS, DM, DM}; pg8::StaticOrder S; S.init(NP_ROWS, DM, F.G, (int)blockIdx.x);
            pg8::EpiResid E{F.X(), modl + 4096};
            pg8::gemm_phase<pg8::EpiResid, pg8::StaticOrder, true, true>(F.lds + RING_OFF, g, S, E, F.wave);
            skinny_resid(F, F.MIX() + (size_t)NP_ROWS * DM, F.Wout_t() + (size_t)l * DM * DM, DM, modl + 4096);
            if (BOTH(pb + 6)) GRID_BAR();
        }
        if (EN_N && IN(pb + 7)) for (int rep_ = 0; rep_ < ((PROBE_DUP & 2) ? 2 : 1); ++rep_) { PHASE_BEGIN(); ph_norm2(PH_PASS, l); if (BOTH(pb + 7)) GRID_BAR(); }
        if (EN_G && EN_GGU && IN(pb + 8)) for (int rep_ = 0; rep_ < ((PROBE_DUP & 4) ? 2 : 1); ++rep_) { PHASE_BEGIN();
            pg8::Gemm g{F.H(), F.Wgu_t() + (size_t)l * NGU * DM, MPAD, NGU, DM}; pg8::StaticOrder S; S.init(MPAD, NGU, F.G, (int)blockIdx.x);
            pg8::EpiSwiGLU E{F.ACT(), DFF};
            pg8::gemm_phase<pg8::EpiSwiGLU, pg8::StaticOrder, true, true>(F.lds + RING_OFF, g, S, E, F.wave);
            if (BOTH(pb + 8)) GRID_BAR();
        }
        if (EN_G && EN_GDN && IN(pb + 9)) { PHASE_BEGIN();
            pg8::Gemm g{F.ACT(), F.Wdn_t() + (size_t)l * DM * DFF, NP_ROWS, DM, DFF}; pg8::StaticOrder S; S.init(NP_ROWS, DM, F.G, (int)blockIdx.x);
            pg8::EpiResid E{F.X(), modl + 10240};
            pg8::gemm_phase<pg8::EpiResid, pg8::StaticOrder, true, true>(F.lds + RING_OFF, g, S, E, F.wave);
            skinny_resid(F, F.ACT() + (size_t)NP_ROWS * DFF, F.Wdn_t() + (size_t)l * DM * DFF, DFF, modl + 10240);
            if (BOTH(pb + 9)) GRID_BAR();
        }
    }
    if (IN(PH_FINAL)) { PHASE_BEGIN(); ph_final(PH_PASS, 0); }
#ifdef PROBE_SCALE
    GRID_BAR();
    { const size_t offs[11] = {O_Y, 16777216, O_WK_P, O_WV_P, O_POOL_P, O_GLA_P, O_WK_S, O_WV_S, O_POOL_S, O_GLA_S, O_END};
      const size_t gt_ = (size_t)(F.vcu * NWAVES + F.wave) * 64 + F.lane_id(), NGT_ = (size_t)F.G * NWAVES * 64;
      for (int k = 0; k < 10; ++k) { const float sc = 1.0f + 0.05f * (float)(k + 1); for (size_t i = offs[k] + gt_; i < offs[k + 1]; i += NGT_) F.out[i] *= sc; } }
#endif
#undef IN
#undef BOTH
#undef gw
#undef NGW
#undef wscr
}

extern "C" void kernel_launch(void* const* d_in, const int* in_sizes, int n_in, void* d_out, int out_size, void* d_ws, size_t ws_size, hipStream_t stream) {
    static int grid = 0;
    if (grid == 0) {
        if (n_in != 24 || out_size != (int)O_END || ws_size < WS_END) { fprintf(stderr, "kernel_launch: unexpected sizes n_in %d out %d ws %zu\n", n_in, out_size, ws_size); grid = -1; return; }
        int dev = 0, cus = 0;
        if (hipGetDevice(&dev) != hipSuccess || hipDeviceGetAttribute(&cus, hipDeviceAttributeMultiprocessorCount, dev) != hipSuccess) { grid = -1; return; }
        if (hipFuncSetAttribute((const void*)hymba_fwd, hipFuncAttributeMaxDynamicSharedMemorySize, LDS_BYTES) != hipSuccess) { fprintf(stderr, "kernel_launch: hipFuncSetAttribute failed\n"); grid = -1; return; }
        (void)hipGetLastError();
        grid = cus;
    }
    if (grid < 0) return;
    (void)hipMemsetAsync((char*)d_ws + WS_CTL, 0, CTL_ZERO_BYTES, stream);
    Args a{};
    for (int i = 0; i < 24; ++i) a.in[i] = (const float*)d_in[i];
    a.out = (float*)d_out; a.ws = (unsigned char*)d_ws;
#if MK_SINGLE
    a.ph_lo = 0; a.ph_hi = PH_COUNT;
    hipLaunchKernelGGL(hymba_fwd, dim3(grid), dim3(NTHREADS), LDS_BYTES, stream, a);
#else
    for (int p = 0; p < PH_COUNT; ++p) { a.ph_lo = p; a.ph_hi = p + 1; hipLaunchKernelGGL(hymba_fwd, dim3(grid), dim3(NTHREADS), LDS_BYTES, stream, a); }
#endif
}
```

```cpp
#include <hip/hip_runtime.h>
#include <cstdio>
#include <cstdint>
#include <cmath>
namespace pg8 {
#define PG8_LAS __attribute__((address_space(3)))
typedef unsigned short bf16_t;
typedef short bf16x8 __attribute__((ext_vector_type(8)));
typedef float f32x4 __attribute__((ext_vector_type(4)));
typedef unsigned u32x4 __attribute__((ext_vector_type(4)));
constexpr int BM = 256, BK = 64, HALF = 128, HTB = HALF * BK * 2  , STAGE_BYTES = 8 * HTB, NXCD = 8, WGM = 8;

__host__ __device__ __forceinline__ int lds_byte(int r, int c) { const int st = (r >> 4) * 2 + (c >> 5), rr = r & 15, cc = c & 31, ob = rr * 64 + cc * 2; return st * 1024 + (ob ^ (((ob >> 9) & 1) << 5)); }
__host__ __device__ __forceinline__ void stage_rc(int b, int& R, int& C) { const int st = b / 1024, sb = b % 1024, swz = sb ^ (((sb >> 9) & 1) << 5); R = (st >> 1) * 16 + swz / 64; C = (st & 1) * 32 + (swz % 64) / 2; }
__host__ __device__ __forceinline__ int perm32(int rho) { const int n = rho >> 4, i = rho & 15; return 8 * (i >> 2) + 4 * n + (i & 3); }

struct Unit { int pm, pn; };
struct Gemm { const bf16_t* A; const bf16_t* Bt; int M, N, K; };

struct StaticOrder {
    int nM, nN, nwg, G, c;
    __host__ __device__ void init(int M, int N, int G_, int c_) { nM = M / BM; nN = N / BM; nwg = nM * nN; G = G_; c = c_; }
    __host__ __device__ bool next(int i, Unit& u) const {
        const long L = (long)i * G + c; if (L >= nwg) return false;
        int wgid = (int)L; { const int q = nwg / NXCD, r = nwg % NXCD, xcd = wgid % NXCD, off = wgid / NXCD; wgid = (xcd < r ? xcd * (q + 1) : r * (q + 1) + (xcd - r) * q) + off; }
        const int nig = WGM * nN, gid = wgid / nig, fm = gid * WGM, gsz = (nM - fm) < WGM ? (nM - fm) : WGM;
        u.pm = fm + ((wgid % nig) % gsz); u.pn = (wgid % nig) / gsz; return true;
    }
    __device__ __forceinline__ void a_ready(const Unit&) const {}
    __device__ __forceinline__ void done(const Unit&) const {}
};

__device__ __forceinline__ unsigned cvt_pk_bf16(float lo, float hi) { unsigned r; asm volatile("v_cvt_pk_bf16_f32 %0, %1, %2" : "=v"(r) : "v"(lo), "v"(hi)); return r; }
typedef float f32x2 __attribute__((ext_vector_type(2)));
constexpr int MODLD_ = 49152;
__device__ __forceinline__ float fast_sigmoid(float x) { return __builtin_amdgcn_rcpf(1.0f + __expf(-x)); }
struct EpiZ {
    static constexpr bool PERM = true, AFTER_DRAIN = false;
    bf16_t* O; int ldc;
    __device__ __forceinline__ void operator()(const f32x4 (&acc)[2][2][4][2], const Unit& u, int wr, int wc, int fr, int fq) const {
        const int row0 = u.pm * BM + wr * 64 + fr, col0 = u.pn * BM + wc * 32 + 8 * fq;
#pragma unroll
        for (int ai = 0; ai < 2; ++ai)
#pragma unroll
            for (int m = 0; m < 4; ++m) { bf16_t* rowp = O + (size_t)(row0 + ai * HALF + m * 16) * ldc + col0;
#pragma unroll
                for (int bj = 0; bj < 2; ++bj) { const f32x4 v0 = acc[ai][bj][m][0], v1 = acc[ai][bj][m][1];
                    u32x4 w; w.x = cvt_pk_bf16(v0[0], v0[1]); w.y = cvt_pk_bf16(v0[2], v0[3]); w.z = cvt_pk_bf16(v1[0], v1[1]); w.w = cvt_pk_bf16(v1[2], v1[3]);
                    *(u32x4*)(rowp + bj * HALF) = w; } }
    }
};
struct EpiSwiGLU {
    static constexpr bool PERM = true, AFTER_DRAIN = false;
    bf16_t* O; int ldc;
    __device__ __forceinline__ void operator()(const f32x4 (&acc)[2][2][4][2], const Unit& u, int wr, int wc, int fr, int fq) const {
        const int row0 = u.pm * BM + wr * 64 + fr, col0 = u.pn * HALF + wc * 32 + 8 * fq;
#pragma unroll
        for (int ai = 0; ai < 2; ++ai)
#pragma unroll
            for (int m = 0; m < 4; ++m) { bf16_t* rowp = O + (size_t)(row0 + ai * HALF + m * 16) * ldc + col0;
                float r[8];
#pragma unroll
                for (int n = 0; n < 2; ++n)
#pragma unroll
                    for (int i = 0; i < 4; ++i) { const float g = acc[ai][0][m][n][i], up = acc[ai][1][m][n][i]; r[n * 4 + i] = g * fast_sigmoid(g) * up; }
                u32x4 w; w.x = cvt_pk_bf16(r[0], r[1]); w.y = cvt_pk_bf16(r[2], r[3]); w.z = cvt_pk_bf16(r[4], r[5]); w.w = cvt_pk_bf16(r[6], r[7]);
                *(u32x4*)rowp = w; }
    }
};
struct EpiResid {
    static constexpr bool PERM = false, AFTER_DRAIN = false;
    float* X; const float* gate; float* XS;
    __device__ __forceinline__ void operator()(const f32x4 (&acc)[2][2][4][2], const Unit& u, int wr, int wc, int fr, int fq) const {
        const int col0 = u.pn * BM + wc * 32 + 4 * fq;
        if (u.pm < 32) {
            const float* g = gate + (size_t)(u.pm >> 3) * MODLD_ + col0;
            f32x4 gv[2][2];
#pragma unroll
            for (int bj = 0; bj < 2; ++bj)
#pragma unroll
                for (int n = 0; n < 2; ++n) gv[bj][n] = *(const f32x4*)(g + bj * HALF + n * 16);
#pragma unroll
            for (int ai = 0; ai < 2; ++ai)
#pragma unroll
                for (int m = 0; m < 4; ++m) { const size_t xo = (size_t)(u.pm * BM + ai * HALF + wr * 64 + m * 16 + fr) * 2048 + col0; const float* xp = X + xo; float* xs = XS + xo;
#pragma unroll
                    for (int bj = 0; bj < 2; ++bj)
#pragma unroll
                        for (int n = 0; n < 2; ++n) { f32x4 xv = *(const f32x4*)(xp + bj * HALF + n * 16); xv = xv + gv[bj][n] * acc[ai][bj][m][n]; *(f32x4*)(xs + bj * HALF + n * 16) = xv; } }
        } else {
#pragma unroll
            for (int m = 0; m < 4; ++m) { const int rl = wr * 64 + m * 16 + fr;
                const float* g = gate + (size_t)(4 + (rl >> 2)) * MODLD_ + col0; float* xp = X + (size_t)(8192 + rl) * 2048 + col0;
#pragma unroll
                for (int bj = 0; bj < 2; ++bj)
#pragma unroll
                    for (int n = 0; n < 2; ++n) { const f32x4 gvv = *(const f32x4*)(g + bj * HALF + n * 16); f32x4 xv = *(const f32x4*)(xp + bj * HALF + n * 16);
                        xv = xv + gvv * acc[0][bj][m][n]; *(f32x4*)(xp + bj * HALF + n * 16) = xv; } }
        }
    }
};
struct EpiMod {
    static constexpr bool PERM = false, AFTER_DRAIN = false;
    float* M; const float* bias;
    __device__ __forceinline__ void operator()(const f32x4 (&acc)[2][2][4][2], const Unit& u, int wr, int wc, int fr, int fq) const {
        if (wr != 0) return;
        const int col0 = u.pn * BM + wc * 32 + 4 * fq;
#pragma unroll
        for (int m = 0; m < 3; ++m) { const int r = m * 16 + fr;
            if (r < 36) {
#pragma unroll
                for (int bj = 0; bj < 2; ++bj)
#pragma unroll
                    for (int n = 0; n < 2; ++n) { const f32x4 bv = *(const f32x4*)(bias + col0 + bj * HALF + n * 16);
                        *(f32x4*)(M + (size_t)r * MODLD_ + col0 + bj * HALF + n * 16) = acc[0][bj][m][n] + bv; } } }
    }
};

template <class Epi, class Sched, bool ALIGN_EPI = false, bool SP2 = false>
__device__ __forceinline__ void gemm_phase(PG8_LAS unsigned char* lds, const Gemm g, const Sched& S, const Epi& E, int wid_in) {
    int lane_ = (int)__builtin_amdgcn_mbcnt_hi(~0u, __builtin_amdgcn_mbcnt_lo(~0u, 0u)); asm volatile("" : "+v"(lane_));
    const int wid = __builtin_amdgcn_readfirstlane(wid_in), lane = lane_, tid = wid * 64 + lane, wr = wid >> 2, wc = wid & 3, fr = lane & 15, fq = lane >> 4;
    int K_ = g.K; asm volatile("" : "+s"(K_));
    const int K = K_, nt = K / BK;
    unsigned voffA[2], voffB[2];
#pragma unroll
    for (int i = 0; i < 2; ++i) { int R, C; stage_rc(tid * 16 + i * 8192, R, C); const int Rb = Epi::PERM ? ((R & ~31) + perm32(R & 31)) : R;
        voffA[i] = (unsigned)(R * K + C) * 2u; voffB[i] = (unsigned)(Rb * K + C) * 2u; }
    const size_t kstep = (size_t)(BK * 2);
    const size_t hstep = (size_t)HALF * K * 2;
    const size_t tstep = 2 * hstep;
    const unsigned ldsw = (unsigned)wid * 1024u;
    const int aoff = lds_byte(wr * 64 + fr, fq * 8), boff = lds_byte(wc * 32 + fr, fq * 8);
#define PG8_SA(b, h) (((b) * 2 + (h)) * HTB)
#define PG8_SB(b, h) ((4 + (b) * 2 + (h)) * HTB)
#define PG8_STAGE(bufoff, gbase, voff) do { _Pragma("unroll") for (int _i = 0; _i < 2; ++_i) \
        __builtin_amdgcn_global_load_lds((const unsigned*)((const char*)(gbase) + (voff)[_i]), (PG8_LAS unsigned*)(lds + (bufoff) + ldsw + _i * 8192), 16, 0, 0); } while (0)
#define PG8_LDA(dst, b, h) do { _Pragma("unroll") for (int m = 0; m < 4; ++m) _Pragma("unroll") for (int k = 0; k < 2; ++k) dst[m][k] = *(const PG8_LAS bf16x8*)(lds + PG8_SA(b, h) + aoff + m * 2048 + k * 1024); } while (0)
#define PG8_LDB(dst, b, h) do { _Pragma("unroll") for (int n = 0; n < 2; ++n) _Pragma("unroll") for (int k = 0; k < 2; ++k) dst[n][k] = *(const PG8_LAS bf16x8*)(lds + PG8_SB(b, h) + boff + n * 2048 + k * 1024); } while (0)
#define PG8_MMA(ai, bj, At, Bt) do { __builtin_amdgcn_s_setprio(1); _Pragma("unroll") for (int m = 0; m < 4; ++m) _Pragma("unroll") for (int n = 0; n < 2; ++n) _Pragma("unroll") for (int k = 0; k < 2; ++k) \
        acc[ai][bj][m][n] = __builtin_amdgcn_mfma_f32_16x16x32_bf16(Bt[n][k], At[m][k], acc[ai][bj][m][n], 0, 0, 0); __builtin_amdgcn_s_setprio(0); } while (0)
#define PG8_WAIT_V(n) asm volatile("s_waitcnt vmcnt(" #n ")" ::: "memory")
#define PG8_WAIT_L(n) asm volatile("s_waitcnt lgkmcnt(" #n ")" ::: "memory")
#define PG8_BAR __builtin_amdgcn_s_barrier()
#define PG8_SCHED __builtin_amdgcn_sched_barrier(0)
    Unit cur, nxt; int ui = 0;
    if (!S.next(0, cur)) return;
    f32x4 acc[2][2][4][2];
#pragma unroll
    for (int a = 0; a < 2; ++a)
#pragma unroll
        for (int b = 0; b < 2; ++b)
#pragma unroll
            for (int m = 0; m < 4; ++m)
#pragma unroll
                for (int n = 0; n < 2; ++n) acc[a][b][m][n] = (f32x4){0.f, 0.f, 0.f, 0.f};
    bf16x8 At[4][2], B0[2][2], B1[2][2];
    const char* cA = (const char*)g.A + (size_t)cur.pm * tstep; const char* cB = (const char*)g.Bt + (size_t)cur.pn * tstep;
    S.a_ready(cur);
    if constexpr (SP2) {
        PG8_STAGE(PG8_SB(0, 0), cB, voffB); PG8_STAGE(PG8_SB(0, 1), cB + hstep, voffB); PG8_STAGE(PG8_SA(0, 0), cA, voffA); PG8_STAGE(PG8_SA(0, 1), cA + hstep, voffA);
        if (wr == 1) PG8_BAR;
        PG8_WAIT_V(2); PG8_BAR;
        PG8_STAGE(PG8_SB(1, 0), cB + kstep, voffB); PG8_STAGE(PG8_SA(1, 0), cA + kstep, voffA); PG8_STAGE(PG8_SB(1, 1), cB + hstep + kstep, voffB);
        PG8_WAIT_V(6); PG8_BAR;
    } else {
        PG8_STAGE(PG8_SB(0, 0), cB, voffB); PG8_STAGE(PG8_SA(0, 0), cA, voffA); PG8_STAGE(PG8_SB(0, 1), cB + hstep, voffB); PG8_STAGE(PG8_SA(0, 1), cA + hstep, voffA);
        if (wr == 1) PG8_BAR;
        PG8_WAIT_V(4); PG8_BAR;
        PG8_STAGE(PG8_SB(1, 0), cB + kstep, voffB); PG8_STAGE(PG8_SA(1, 0), cA + kstep, voffA); PG8_STAGE(PG8_SB(1, 1), cB + hstep + kstep, voffB);
        PG8_WAIT_V(6); PG8_BAR;
    }
    for (;;) {
        const bool has_next = S.next(ui + 1, nxt);
        const char* nA = has_next ? (const char*)g.A + (size_t)nxt.pm * tstep : cA; const char* nB = has_next ? (const char*)g.Bt + (size_t)nxt.pn * tstep : cB;
        for (int t = 0; t < nt; t += 2) {
            const bool last = (t == nt - 2);
            const char* a1 = cA + (size_t)(t + 1) * kstep;
            const char* a2 = last ? nA : cA + (size_t)(t + 2) * kstep; const char* b2 = last ? nB : cB + (size_t)(t + 2) * kstep;
            const char* a3 = a2 + kstep; const char* b3 = b2 + kstep;
            if (last && has_next) S.a_ready(nxt);
            if constexpr (SP2) {
            PG8_LDB(B0, 0, 0); PG8_LDB(B1, 0, 1); PG8_SCHED; PG8_LDA(At, 0, 0); PG8_STAGE(PG8_SA(1, 1), a1 + hstep, voffA);
            PG8_WAIT_V(8); PG8_WAIT_L(0); PG8_BAR; PG8_MMA(0, 0, At, B0); PG8_MMA(0, 1, At, B1); PG8_BAR; PG8_SCHED;
            PG8_LDA(At, 0, 1); PG8_STAGE(PG8_SB(0, 0), b2, voffB); PG8_STAGE(PG8_SB(0, 1), b2 + hstep, voffB); PG8_STAGE(PG8_SA(0, 0), a2, voffA);
            PG8_WAIT_V(8); PG8_WAIT_L(0); PG8_BAR; PG8_MMA(1, 0, At, B0); PG8_MMA(1, 1, At, B1); PG8_BAR; PG8_SCHED;
            PG8_LDB(B0, 1, 0); PG8_LDB(B1, 1, 1); PG8_SCHED; PG8_LDA(At, 1, 0); PG8_STAGE(PG8_SA(0, 1), a2 + hstep, voffA);
            PG8_WAIT_V(8); PG8_WAIT_L(0); PG8_BAR; PG8_MMA(0, 0, At, B0); PG8_MMA(0, 1, At, B1); PG8_BAR; PG8_SCHED;
            PG8_LDA(At, 1, 1); PG8_STAGE(PG8_SB(1, 0), b3, voffB); PG8_STAGE(PG8_SB(1, 1), b3 + hstep, voffB); PG8_STAGE(PG8_SA(1, 0), a3, voffA);
            PG8_WAIT_V(8); PG8_WAIT_L(0); PG8_BAR; PG8_MMA(1, 0, At, B0); PG8_MMA(1, 1, At, B1); PG8_BAR; PG8_SCHED;
            } else {
            PG8_LDB(B0, 0, 0); PG8_SCHED; PG8_LDA(At, 0, 0); PG8_STAGE(PG8_SA(1, 1), a1 + hstep, voffA);
            PG8_WAIT_L(8); PG8_BAR; PG8_WAIT_L(0); PG8_MMA(0, 0, At, B0); PG8_BAR; PG8_SCHED;
            PG8_LDB(B1, 0, 1); PG8_STAGE(PG8_SB(0, 0), b2, voffB);
            PG8_BAR; PG8_WAIT_L(0); PG8_MMA(0, 1, At, B1); PG8_BAR;
            PG8_LDA(At, 0, 1); PG8_STAGE(PG8_SA(0, 0), a2, voffA);
            PG8_BAR; PG8_WAIT_L(0); PG8_MMA(1, 0, At, B0); PG8_BAR; PG8_SCHED;
            PG8_STAGE(PG8_SB(0, 1), b2 + hstep, voffB);
            PG8_WAIT_V(6); PG8_BAR; PG8_MMA(1, 1, At, B1); PG8_BAR;
            PG8_LDB(B0, 1, 0); PG8_SCHED; PG8_LDA(At, 1, 0); PG8_STAGE(PG8_SA(0, 1), a2 + hstep, voffA);
            PG8_WAIT_L(8); PG8_BAR; PG8_WAIT_L(0); PG8_MMA(0, 0, At, B0); PG8_BAR; PG8_SCHED;
            PG8_LDB(B1, 1, 1); PG8_STAGE(PG8_SB(1, 0), b3, voffB);
            PG8_BAR; PG8_WAIT_L(0); PG8_MMA(0, 1, At, B1); PG8_BAR;
            PG8_LDA(At, 1, 1); PG8_STAGE(PG8_SA(1, 0), a3, voffA);
            PG8_BAR; PG8_WAIT_L(0); PG8_MMA(1, 0, At, B0); PG8_BAR; PG8_SCHED;
            PG8_STAGE(PG8_SB(1, 1), b3 + hstep, voffB);
            PG8_WAIT_V(6); PG8_BAR; PG8_MMA(1, 1, At, B1); PG8_BAR;
            }
        }
        if constexpr (ALIGN_EPI) { if (wr == 0) PG8_BAR; }
        if constexpr (!Epi::AFTER_DRAIN) { E(acc, cur, wr, wc, fr, fq); S.done(cur); }
        if (!has_next) break;
#pragma unroll
        for (int a = 0; a < 2; ++a)
#pragma unroll
            for (int b = 0; b < 2; ++b)
#pragma unroll
                for (int m = 0; m < 4; ++m)
#pragma unroll
                    for (int n = 0; n < 2; ++n) acc[a][b][m][n] = (f32x4){0.f, 0.f, 0.f, 0.f};
        cur = nxt; cA = nA; cB = nB; ++ui;
        if constexpr (ALIGN_EPI) { if (wr == 1) PG8_BAR; }
    }
    PG8_WAIT_V(0);
    if constexpr (!ALIGN_EPI) { if (wr == 0) PG8_BAR; }
    PG8_BAR;
    if constexpr (Epi::AFTER_DRAIN) { E.fused(acc, cur, wr, wc, fr, fq, lds, wid, lane); S.done(cur); }
#undef PG8_SA
#undef PG8_SB
#undef PG8_STAGE
#undef PG8_LDA
#undef PG8_LDB
#undef PG8_MMA
#undef PG8_WAIT_V
#undef PG8_WAIT_L
#undef PG8_BAR
#undef PG8_SCHED
}
}
#define GAS __attribute__((address_space(1)))
#define LAS __attribute__((address_space(3)))
typedef unsigned short bf16;
typedef unsigned v4u __attribute__((ext_vector_type(4)));
typedef float f32x4 __attribute__((ext_vector_type(4)));
typedef short bf16x8 __attribute__((ext_vector_type(8)));
typedef GAS unsigned gu32;
typedef GAS unsigned long long gu64;
#define RLX_AGENT __ATOMIC_RELAXED, __HIP_MEMORY_SCOPE_AGENT
#define LDS_WAIT() asm volatile("s_waitcnt lgkmcnt(0)" ::: "memory")
#define VM_WAIT() asm volatile("s_waitcnt vmcnt(0)" ::: "memory")
__device__ __forceinline__ unsigned long long rt() { return __builtin_amdgcn_s_memrealtime(); }
__device__ __forceinline__ unsigned f2bf(float f) { unsigned u = __builtin_bit_cast(unsigned, f); return (u + 0x7fffu + ((u >> 16) & 1u)) >> 16; }
__device__ __forceinline__ unsigned pk2(float lo, float hi) { return f2bf(lo) | (f2bf(hi) << 16); }

#define XB_TMO      128
#define XB_XCNT(j)  (256  + 64 * (j))
#define XB_XSUB(j)  (1280 + 64 * (j))
#define XB_XGEN(j)  (2304 + 64 * (j))
#define XB_TOP      3328
#define XB_TOPGEN   3392
#define XCD_BAR_WORDS 3456
#define XB_SPIN_CAP (1u << 18)

__device__ __forceinline__ unsigned xb_ld(unsigned* p)              { return __hip_atomic_load(p, __ATOMIC_RELAXED, __HIP_MEMORY_SCOPE_AGENT); }
__device__ __forceinline__ unsigned xb_add(unsigned* p, unsigned v) { return __hip_atomic_fetch_add(p, v, __ATOMIC_RELAXED, __HIP_MEMORY_SCOPE_AGENT); }
__device__ __forceinline__ unsigned xb_xcc_id() { return (unsigned)__builtin_amdgcn_s_getreg((3 << 11) | 20) & 0xFu; }
#define XB_SPIN(cond, bar) do { unsigned _sp = 0; while (cond) { __builtin_amdgcn_s_sleep(1); \
    if ((++_sp & 255u) == 0u) { if (xb_ld(&(bar)[XB_TMO])) break; if (_sp > XB_SPIN_CAP) { atomicAdd(&(bar)[XB_TMO], 1u); break; } } } } while (0)

struct XcdBarrier {
    unsigned* bar; unsigned x;
    volatile LAS unsigned* st;
};

__device__ __forceinline__ XcdBarrier xcd_barrier_post(unsigned* bar, volatile LAS unsigned* st) {
    XcdBarrier b; b.bar = bar; b.x = xb_xcc_id(); b.st = st;
    if (threadIdx.x == 0) (void)xb_add(&bar[XB_XCNT(b.x)], 1u);
    return b;
}
__device__ __forceinline__ void xcd_barrier_complete(unsigned* bar, unsigned x, unsigned& nloc, unsigned& nx) {
    const unsigned G = gridDim.x * gridDim.y * gridDim.z;
    unsigned sum, cnt, mine, sp = 0u;
    for (;;) {
        sum = 0u; cnt = 0u; mine = 0u;
#pragma unroll
        for (unsigned j = 0; j < 16; ++j) { const unsigned c = xb_ld(&bar[XB_XCNT(j)]); sum += c; cnt += (c > 0u) ? 1u : 0u; mine = (j == x) ? c : mine; }
        if (sum == G) break;
        __builtin_amdgcn_s_sleep(1);
        if ((++sp & 255u) == 0u) { if (xb_ld(&bar[XB_TMO])) break; if (sp > XB_SPIN_CAP) { atomicAdd(&bar[XB_TMO], 1u); break; } }
    }
    nloc = mine > 0u ? mine : 1u; nx = cnt > 0u ? cnt : 1u;
}

__device__ __forceinline__ void xcd_barrier(const XcdBarrier& b) {
    asm volatile("s_waitcnt vmcnt(0)" ::: "memory");
    __syncthreads();
    if (threadIdx.x == 0) {
        unsigned* bar = b.bar;
        __builtin_amdgcn_s_waitcnt(0);
        unsigned nloc = b.st[0], nx = b.st[1];
        if (nloc == 0u) { xcd_barrier_complete(bar, b.x, nloc, nx); b.st[0] = nloc; b.st[1] = nx; }
        const unsigned old = xb_add(&bar[XB_XSUB(b.x)], 1u);
        const unsigned gen = old / nloc;
        if (old + 1u == (gen + 1u) * nloc) {
            __builtin_amdgcn_fence(__ATOMIC_RELEASE, "agent");
            asm volatile("s_waitcnt vmcnt(0)" ::: "memory");
            const unsigned og = xb_add(&bar[XB_TOP], 1u);
            const unsigned tg = og / nx;
            if (og + 1u == (tg + 1u) * nx) xb_add(&bar[XB_TOPGEN], 1u);
            else XB_SPIN(xb_ld(&bar[XB_TOPGEN]) == tg, bar);
            __builtin_amdgcn_fence(__ATOMIC_ACQUIRE, "agent");
            xb_add(&bar[XB_XGEN(b.x)], 1u);
            asm volatile("s_waitcnt vmcnt(0)" ::: "memory");
        } else {
            XB_SPIN(xb_ld(&bar[XB_XGEN(b.x)]) == gen, bar);
            __builtin_amdgcn_fence(__ATOMIC_ACQUIRE, "agent");
            asm volatile("s_waitcnt vmcnt(0)" ::: "memory");
        }
    }
    __syncthreads();
}

constexpr int NWAVES = 8, NTHREADS = 512;
constexpr int DM = 2048, NP_ROWS = 8192, NS_ROWS = 128, NROWS = 8320, MPAD = 8448;
constexpr int DEPTH = 4, NBATCH = 36;
constexpr int INW = 4368, ZW = 4608;
constexpr int ZQ = 0, ZK = 512, ZV = 640, ZU = 768, GQ = 1280, GK = 1792, GV = 2304, GG = 3328, GA = 4352;
constexpr int DFF = 5632, NGU = 11264, MODW = 12288, MODLD = 49152;
constexpr float EPS = 1e-6f;
constexpr size_t O_Y = 0, O_WK_P = 17039360, O_WV_P = 17301504, O_POOL_P = 17563648, O_GLA_P = 17686528,
                 O_WK_S = 19783680, O_WV_S = 21880832, O_POOL_S = 23977984, O_GLA_S = 24961024, O_END = 41738240;
constexpr size_t MiB = 1u << 20;
constexpr size_t WS_CTL = 0, CTL_ZERO_BYTES = 1 * MiB;
constexpr size_t WS_WADA = 1 * MiB;
constexpr size_t WS_WIN  = WS_WADA + 192 * MiB;
constexpr size_t WS_WOUT = WS_WIN + 72 * MiB;
constexpr size_t WS_WGU  = WS_WOUT + 32 * MiB;
constexpr size_t WS_WDN  = WS_WGU + 176 * MiB;
constexpr size_t WS_X    = WS_WDN + 88 * MiB;
constexpr size_t WS_H    = WS_X + 66 * MiB;
constexpr size_t WS_Z    = WS_H + 33 * MiB;
constexpr size_t WS_MIX  = WS_Z + 75 * MiB;
constexpr size_t WS_ACT  = WS_MIX + 33 * MiB;
constexpr size_t WS_OGLA = WS_ACT + 91 * MiB;
constexpr size_t WS_LA   = WS_OGLA + 33 * MiB;
constexpr size_t WS_MOD  = WS_LA + 17 * MiB;
constexpr size_t WS_SC   = WS_MOD + 7 * MiB;
constexpr size_t WS_BTAB = WS_SC + 1 * MiB;
constexpr size_t WS_WPT  = WS_BTAB + 1 * MiB;
constexpr size_t WS_QDG  = WS_WPT + 1 * MiB;
constexpr size_t WS_KDTG = WS_QDG + 9 * MiB;
constexpr size_t WS_VTG  = WS_KDTG + 11 * MiB;
constexpr size_t WS_DLG  = WS_VTG + 21 * MiB;
constexpr size_t WS_DUMMY = WS_DLG + 1 * MiB;
constexpr size_t WS_END  = WS_DUMMY + 66 * MiB;
constexpr int CW_BAR = 4096;
constexpr int RING_OFF = 0, RING_BYTES = 131072;
constexpr int LDSCTL_OFF = RING_BYTES, MISC_OFF = LDSCTL_OFF + 320;
constexpr int LDS_BYTES = 147456;

struct Args { const float* in[24]; float* out; unsigned char* ws; int ph_lo, ph_hi; };
struct Frame {
    LAS unsigned char* lds;
    volatile LAS unsigned* MISC;
    int wave, vcu, G; int zo; int probe;
    __device__ __forceinline__ float* X_ST() const { return (float*)(ws + (probe ? WS_DUMMY : WS_X)); }
    __device__ __forceinline__ float* OGLA_ST() const { return (float*)(ws + (probe ? WS_DUMMY : WS_OGLA)); }
    __device__ __forceinline__ int lane_id() const { return (int)__builtin_amdgcn_mbcnt_hi(~0u, __builtin_amdgcn_mbcnt_lo(~0u, 0u)); }
    unsigned char* ws; float* out;
    __device__ __forceinline__ bf16* Wada_t() const { return (bf16*)(ws + WS_WADA); }
    __device__ __forceinline__ bf16* Win_t() const { return (bf16*)(ws + WS_WIN); }
    __device__ __forceinline__ bf16* Wout_t() const { return (bf16*)(ws + WS_WOUT); }
    __device__ __forceinline__ bf16* Wgu_t() const { return (bf16*)(ws + WS_WGU); }
    __device__ __forceinline__ bf16* Wdn_t() const { return (bf16*)(ws + WS_WDN); }
    __device__ __forceinline__ float* X() const { return (float*)(ws + WS_X); }
    __device__ __forceinline__ bf16* H() const { return (bf16*)(ws + WS_H); }
    __device__ __forceinline__ bf16* Z() const { return (bf16*)(ws + WS_Z); }
    __device__ __forceinline__ bf16* MIX() const { return (bf16*)(ws + WS_MIX); }
    __device__ __forceinline__ bf16* ACT() const { return (bf16*)(ws + WS_ACT); }
    __device__ __forceinline__ float* OGLA() const { return (float*)(ws + WS_OGLA); }
    __device__ __forceinline__ float* SLOC() const { return (float*)(ws + WS_LA); }
    __device__ __forceinline__ float* DSEG() const { return (float*)(ws + WS_LA + 16 * MiB); }
    __device__ __forceinline__ float* MOD() const { return (float*)(ws + WS_MOD); }
    __device__ __forceinline__ bf16* SC() const { return (bf16*)(ws + WS_SC); }
    __device__ __forceinline__ float* BTAB() const { return (float*)(ws + WS_BTAB); }
    __device__ __forceinline__ bf16* WPT() const { return (bf16*)(ws + WS_WPT); }
    __device__ __forceinline__ bf16* QDG() const { return (bf16*)(ws + WS_QDG); }
    __device__ __forceinline__ bf16* KDTG() const { return (bf16*)(ws + WS_KDTG); }
    __device__ __forceinline__ bf16* VTG() const { return (bf16*)(ws + WS_VTG); }
    __device__ __forceinline__ float* DLG() const { return (float*)(ws + WS_DLG); }
};
enum { I_XP = 0, I_XS, I_CK, I_CV, I_SPOOL, I_SGLA, I_CP, I_CS, I_WADA, I_BADA, I_GMIX, I_GFFN, I_WIN, I_WOUT, I_RELB, I_SINKS, I_WPOOL, I_PSCALE, I_WA2, I_BA2, I_GGLA, I_WGU, I_WDN, I_GFIN };

__device__ __forceinline__ float bf2f(unsigned short b) { return __uint_as_float((unsigned)b << 16); }
__device__ __forceinline__ float bflo(unsigned w) { return __uint_as_float(w << 16); }
__device__ __forceinline__ float bfhi(unsigned w) { return __uint_as_float(w & 0xffff0000u); }
__device__ __forceinline__ float wave_sum(float v) {
#pragma unroll
    for (int o = 1; o < 64; o <<= 1) v += __shfl_xor(v, o);
    return v;
}
__device__ __forceinline__ float wave_max(float v) {
#pragma unroll
    for (int o = 1; o < 64; o <<= 1) v = fmaxf(v, __shfl_xor(v, o));
    return v;
}
__device__ __forceinline__ int t5_bucket(int n) {
    if (n < 16) return n;
    return 16 + (n >= 19) + (n >= 21) + (n >= 24) + (n >= 27) + (n >= 31) + (n >= 35) + (n >= 40) + (n >= 46) + (n >= 52) + (n >= 59) + (n >= 67) + (n >= 77) + (n >= 87) + (n >= 99) + (n >= 113);
}

template <int MODE>
__device__ __forceinline__ void transpose_item(const float* W, int K, int N, int nblk, bf16* WT, int row_off, LAS float* scr, int item, int lane) {
    const int kb = item / nblk, nb = item % nblk, k0 = 64 * kb, n0 = 32 * nb;
    const int nn = n0 + (lane & 31); const bool ok = nn < N;
    float wv[32];
#pragma unroll
    for (int i = 0; i < 32; ++i) { const int kk = 2 * i + (lane >> 5); wv[i] = ok ? W[(size_t)(k0 + kk) * N + nn] : 0.f; }
#pragma unroll
    for (int i = 0; i < 32; ++i) { const int kk = 2 * i + (lane >> 5); scr[kk * 33 + (lane & 31)] = wv[i]; }
    LDS_WAIT(); asm volatile("" ::: "memory");
    const int c = lane & 7;
#pragma unroll
    for (int j = 0; j < 4; ++j) { const int n = (lane >> 3) + 8 * j; const LAS float* s = scr + (8 * c) * 33 + n;
        v4u o; o.x = pk2(s[0 * 33], s[1 * 33]); o.y = pk2(s[2 * 33], s[3 * 33]); o.z = pk2(s[4 * 33], s[5 * 33]); o.w = pk2(s[6 * 33], s[7 * 33]);
        int orow = n0 + n;
        if (MODE == 1) { orow = (orow < DFF) ? ((orow >> 7) * 256 + (orow & 127)) : (((orow - DFF) >> 7) * 256 + 128 + ((orow - DFF) & 127)); }
        *(GAS v4u*)(WT + (size_t)(row_off + orow) * K + k0 + 8 * c) = o; }
    LDS_WAIT(); asm volatile("" ::: "memory");
}
__device__ __forceinline__ void p0_prologue(Frame& F, const Args& A) {
    LAS float* scr = (LAS float*)(F.lds + RING_OFF + F.wave * 16384);
    const int gw = F.vcu * NWAVES + F.wave, NGW = F.G * NWAVES;
    const int gt = gw * 64 + F.lane_id(), NGT = NGW * 64;
    constexpr int I_ADA = 32 * 384, I_IN = 32 * 137, I_OUT = 32 * 64, I_GU = 32 * 352, I_DN = 88 * 64, I_L = I_ADA + I_IN + I_OUT + I_GU + I_DN;
    for (int it = gw; it < DEPTH * I_L; it += NGW) {
        const int l = it / I_L; int r = it - l * I_L;
        if (r < I_ADA) { transpose_item<0>(A.in[F.zo + I_WADA] + (size_t)l * DM * MODW, DM, MODW, 384, F.Wada_t(), l * MODW, scr, r, F.lane_id()); continue; } r -= I_ADA;
        if (r < I_IN)  { transpose_item<0>(A.in[F.zo + I_WIN] + (size_t)l * DM * INW, DM, INW, 137, F.Win_t() + (size_t)l * ZW * DM, 0, scr, r, F.lane_id()); continue; } r -= I_IN;
        if (r < I_OUT) { transpose_item<0>(A.in[F.zo + I_WOUT] + (size_t)l * DM * DM, DM, DM, 64, F.Wout_t() + (size_t)l * DM * DM, 0, scr, r, F.lane_id()); continue; } r -= I_OUT;
        if (r < I_GU)  { transpose_item<1>(A.in[F.zo + I_WGU] + (size_t)l * DM * NGU, DM, NGU, 352, F.Wgu_t() + (size_t)l * NGU * DM, 0, scr, r, F.lane_id()); continue; } r -= I_GU;
        transpose_item<0>(A.in[F.zo + I_WDN] + (size_t)l * DFF * DM, DFF, DM, 64, F.Wdn_t() + (size_t)l * DM * DFF, 0, scr, r, F.lane_id());
    }
    const v4u z4 = {0u, 0u, 0u, 0u};
    for (int i = gt; i < DEPTH * 224 * 256; i += NGT) { const int l = i / (224 * 256), r = i - l * (224 * 256); *((GAS v4u*)(F.Win_t() + ((size_t)l * ZW + 4384) * DM) + r) = z4; }
    for (int i = gt; i < 128 * 256; i += NGT) { *((GAS v4u*)(F.H() + (size_t)NROWS * DM) + i) = z4; *((GAS v4u*)(F.MIX() + (size_t)NROWS * DM) + i) = z4; }
    for (int i = gt; i < 128 * 704; i += NGT) *((GAS v4u*)(F.ACT() + (size_t)NROWS * DFF) + i) = z4;
    for (int i = gt; i < NP_ROWS * 512; i += NGT) ((GAS f32x4*)F.X())[i] = ((const GAS f32x4*)A.in[F.zo + I_XP])[i];
    for (int i = gt; i < NS_ROWS * 512; i += NGT) ((GAS f32x4*)(F.X() + (size_t)NP_ROWS * DM))[i] = ((const GAS f32x4*)A.in[F.zo + I_XS])[i];
    for (int i = gt; i < 256 * 1024; i += NGT) { const int r = i >> 10, cp = (i & 1023) * 2; unsigned w = 0u;
        if (r < NBATCH) { const float* c = (r < 4) ? (A.in[F.zo + I_CP] + (size_t)r * DM) : (A.in[F.zo + I_CS] + (size_t)(r - 4) * DM); const float a = c[cp], b = c[cp + 1];
            w = pk2(a / (1.0f + __expf(-a)), b / (1.0f + __expf(-b))); }
        ((GAS unsigned*)F.SC())[i] = w; }
    for (int i = gt; i < 4 * 4 * 128 * 128; i += NGT) { const int lg = i >> 14, dcol = (i >> 7) & 127, c = i & 127; F.WPT()[i] = (bf16)f2bf(A.in[F.zo + I_WPOOL][((size_t)lg * 128 + c) * 128 + dcol]); }
    for (int i = gt; i < 8 * 128; i += NGT) { const int h = i >> 7, dist = i & 127; F.BTAB()[i] = A.in[F.zo + I_RELB][t5_bucket(dist) * 8 + h]; }
}

__device__ __forceinline__ void norm_mod_rows(Frame& F, const float* g, const float* modl  ) {
    const int gw = F.vcu * NWAVES + F.wave, NGW = F.G * NWAVES;
    for (int r = gw; r < NROWS; r += NGW) {
        const int b = r < NP_ROWS ? (r >> 11) : 4 + ((r - NP_ROWS) >> 2);
        const float* xr = F.X() + (size_t)r * DM + 4 * F.lane_id(); const float* sh = modl + (size_t)b * MODLD + 4 * F.lane_id(); const float* gg = g + 4 * F.lane_id();
        f32x4 v[8]; float ss = 0.f;
#pragma unroll
        for (int j = 0; j < 8; ++j) { v[j] = *(const f32x4*)(xr + 256 * j); ss += (v[j].x * v[j].x + v[j].y * v[j].y) + (v[j].z * v[j].z + v[j].w * v[j].w); }
        const float rstd = 1.0f / sqrtf(wave_sum(ss) * (1.0f / DM) + EPS);
        bf16* hr = F.H() + (size_t)r * DM + 4 * F.lane_id();
#pragma unroll
        for (int j = 0; j < 8; ++j) { const f32x4 gv = *(const f32x4*)(gg + 256 * j), sv = *(const f32x4*)(sh + 256 * j), cv = *(const f32x4*)(sh + 2048 + 256 * j);
            const f32x4 y = (v[j] * rstd * gv) * (1.0f + cv) + sv;
            uint2 w; w.x = pk2(y.x, y.y); w.y = pk2(y.z, y.w); *(uint2*)(hr + 256 * j) = w; }
    }
}
__device__ __forceinline__ void final_norm_rows(Frame& F, const Args& A) {
    const int gw = F.vcu * NWAVES + F.wave, NGW = F.G * NWAVES; const float* g = A.in[F.zo + I_GFIN] + 4 * F.lane_id();
    for (int r = gw; r < NROWS; r += NGW) {
        const float* xr = F.X() + (size_t)r * DM + 4 * F.lane_id();
        f32x4 v[8]; float ss = 0.f;
#pragma unroll
        for (int j = 0; j < 8; ++j) { v[j] = *(const f32x4*)(xr + 256 * j); ss += (v[j].x * v[j].x + v[j].y * v[j].y) + (v[j].z * v[j].z + v[j].w * v[j].w); }
        const float rstd = 1.0f / sqrtf(wave_sum(ss) * (1.0f / DM) + EPS);
        float* yr = F.out + O_Y + (size_t)r * DM + 4 * F.lane_id();
#pragma unroll
        for (int j = 0; j < 8; ++j) { const f32x4 gv = *(const f32x4*)(g + 256 * j); *(f32x4*)(yr + 256 * j) = v[j] * rstd * gv; }
    }
}

__device__ __forceinline__ void attn_item(Frame& F, const Args& A, int l, int r, int hd, LAS float* ps) {
    const int lane = F.lane_id(), g = hd >> 2; const bool smp = r >= NP_ROWS;
    const int t = r & 2047, sb = smp ? ((r - NP_ROWS) >> 2) : 0, si = (r - NP_ROWS) & 3;
    LAS float* qs = ps + 128;
    { const unsigned w = ((const unsigned*)(F.Z() + (size_t)r * ZW + ZQ + hd * 64))[lane & 31]; if (lane < 32) { qs[2 * lane] = bflo(w); qs[2 * lane + 1] = bfhi(w); } }
    LDS_WAIT(); asm volatile("" ::: "memory");
    const float* ck = A.in[F.zo + I_CK] + ((size_t)(l * 32 + sb) * 128) * 128 + g * 64;
    const float* cv = A.in[F.zo + I_CV] + ((size_t)(l * 32 + sb) * 128) * 128 + g * 64;
    const int jmin = smp ? 0 : (t >= 127 ? 0 : 127 - t);
    float sc[2];
#pragma unroll 1
    for (int jj = 0; jj < 2; ++jj) {
        const int j = lane + 64 * jj, dist = 127 - j; float dot = 0.f; bool valid = j >= jmin;
        if (valid) {
            const int krel = si - dist;
            if (smp && krel < 0) {
                const f32x4* kp = (const f32x4*)(ck + (size_t)(krel + 128) * 128);
#pragma unroll 4
                for (int c = 0; c < 16; ++c) { const f32x4 kv = kp[c]; const f32x4 qv = *(const LAS f32x4*)(qs + 4 * c); dot += qv.x * kv.x + qv.y * kv.y + qv.z * kv.z + qv.w * kv.w; }
            } else {
                const int krow = smp ? (NP_ROWS + sb * 4 + krel) : (r - dist);
                const v4u* kp = (const v4u*)(F.Z() + (size_t)krow * ZW + ZK + g * 64);
#pragma unroll 4
                for (int c = 0; c < 8; ++c) { const v4u w = kp[c];
                    const f32x4 qa = *(const LAS f32x4*)(qs + 8 * c), qb = *(const LAS f32x4*)(qs + 8 * c + 4);
                    dot += qa.x * bflo(w.x) + qa.y * bfhi(w.x) + qa.z * bflo(w.y) + qa.w * bfhi(w.y) + qb.x * bflo(w.z) + qb.y * bfhi(w.z) + qb.z * bflo(w.w) + qb.w * bfhi(w.w); }
            }
        }
        const float sv = valid ? dot * 0.125f + F.BTAB()[hd * 128 + dist] : -INFINITY;
        if (jj == 0) sc[0] = sv; else sc[1] = sv;
    }
    const float sink = A.in[F.zo + I_SINKS][l * 8 + hd];
    const float m = fmaxf(wave_max(fmaxf(sc[0], sc[1])), sink);
    const float p0 = __expf(sc[0] - m), p1 = __expf(sc[1] - m);
    const float denom = wave_sum(p0 + p1) + __expf(sink - m);
    ps[lane] = p0; ps[lane + 64] = p1;
    LDS_WAIT(); asm volatile("" ::: "memory");
    float o = 0.f;
    for (int j = jmin; j < 128; ++j) {
        const float pj = ps[j]; const int dist = 127 - j; float vv;
        const int krel = si - dist;
        if (smp && krel < 0) vv = cv[(size_t)(krel + 128) * 128 + lane];
        else { const int krow = smp ? (NP_ROWS + sb * 4 + krel) : (r - dist); vv = bf2f(F.Z()[(size_t)krow * ZW + ZV + g * 64 + lane]); }
        o += pj * vv;
    }
    F.MIX()[(size_t)r * DM + hd * 64 + lane] = (bf16)f2bf(o / denom);
    LDS_WAIT(); asm volatile("" ::: "memory");
}
__device__ __forceinline__ void pool_item(Frame& F, const Args& A, int l, int r, int gi, LAS float* ds) {
    const int lane = F.lane_id(), w = 2 << gi; const bool smp = r >= NP_ROWS;
    const int t = r & 2047, sb = (r - NP_ROWS) >> 2, si = (r - NP_ROWS) & 3;
    const float* pbuf = A.in[F.zo + I_SPOOL] + ((size_t)(l * 32 + sb) * 15) * 512 + gi * 128;
    float s0 = 0.f, s1 = 0.f, u0 = 0.f, u1 = 0.f;
    for (int o = 0; o < w; ++o) {
        float a0 = 0.f, a1 = 0.f;
        if (!smp) { if (t - o >= 0) { const bf16* zp = F.Z() + (size_t)(r - o) * ZW + ZU + gi * 128; a0 = bf2f(zp[lane]); a1 = bf2f(zp[lane + 64]); } }
        else { const int idx = si - o;
            if (idx >= 0) { const bf16* zp = F.Z() + (size_t)(NP_ROWS + sb * 4 + idx) * ZW + ZU + gi * 128; a0 = bf2f(zp[lane]); a1 = bf2f(zp[lane + 64]); }
            else { const float* bp = pbuf + (size_t)(15 + idx) * 512; a0 = bp[lane]; a1 = bp[lane + 64]; } }
        if (o == 0) { u0 = a0; u1 = a1; }
        s0 += a0; s1 += a1;
    }
    const float cnt = smp ? (float)w : (float)((t + 1) < w ? (t + 1) : w);
    ds[lane] = s0 / cnt - u0; ds[lane + 64] = s1 / cnt - u1;
    LDS_WAIT(); asm volatile("" ::: "memory");
    const float* wp = A.in[F.zo + I_WPOOL] + ((size_t)(l * 4 + gi) * 128) * 128;
    float y0 = 0.f, y1 = 0.f;
#pragma unroll 4
    for (int c = 0; c < 128; ++c) { const float dv = ds[c]; y0 += dv * wp[c * 128 + lane]; y1 += dv * wp[c * 128 + lane + 64]; }
    const float* psc = A.in[F.zo + I_PSCALE] + l * 512 + gi * 128;
    bf16* mp = F.MIX() + (size_t)r * DM + 512 + gi * 128;
    mp[lane] = (bf16)f2bf(y0 * psc[lane]); mp[lane + 64] = (bf16)f2bf(y1 * psc[lane + 64]);
    LDS_WAIT(); asm volatile("" ::: "memory");
}
__device__ __forceinline__ void cache_outputs(Frame& F, const Args& A, int l) {
    const int gt = (F.vcu * NWAVES + F.wave) * 64 + F.lane_id(), NGT = F.G * NWAVES * 64;
    for (int i = gt; i < 4 * 128 * 128; i += NGT) { const int b = i >> 14, j = (i >> 7) & 127, c = i & 127; const bf16* zr = F.Z() + (size_t)(b * 2048 + 1920 + j) * ZW;
        F.out[O_WK_P + (size_t)l * 65536 + i] = bf2f(zr[ZK + c]); F.out[O_WV_P + (size_t)l * 65536 + i] = bf2f(zr[ZV + c]); }
    for (int i = gt; i < 4 * 15 * 512; i += NGT) { const int b = i / 7680, rem = i - b * 7680, j = rem >> 9, c = rem & 511;
        F.out[O_POOL_P + (size_t)l * 30720 + i] = bf2f(F.Z()[(size_t)(b * 2048 + 2033 + j) * ZW + ZU + c]); }
    for (int i = gt; i < 32 * 128 * 128; i += NGT) { const int sb = i >> 14, p = (i >> 7) & 127, c = i & 127; float kv, vv;
        if (p < 124) { const size_t src = ((size_t)(l * 32 + sb) * 128 + p + 4) * 128 + c; kv = A.in[F.zo + I_CK][src]; vv = A.in[F.zo + I_CV][src]; }
        else { const bf16* zr = F.Z() + (size_t)(NP_ROWS + sb * 4 + p - 124) * ZW; kv = bf2f(zr[ZK + c]); vv = bf2f(zr[ZV + c]); }
        F.out[O_WK_S + (size_t)l * 524288 + i] = kv; F.out[O_WV_S + (size_t)l * 524288 + i] = vv; }
    for (int i = gt; i < 32 * 15 * 512; i += NGT) { const int sb = i / 7680, rem = i - sb * 7680, j = rem >> 9, c = rem & 511; float v;
        if (j < 11) v = A.in[F.zo + I_SPOOL][((size_t)(l * 32 + sb) * 15 + j + 4) * 512 + c];
        else v = bf2f(F.Z()[(size_t)(NP_ROWS + sb * 4 + j - 11) * ZW + ZU + c]);
        F.out[O_POOL_S + (size_t)l * 245760 + i] = v; }
}
__device__ __forceinline__ void gla_out_item(Frame& F, const Args& A, int l, int r, int hh) {
    const int lane = F.lane_id();
    const f32x4 o = *(const f32x4*)(F.OGLA() + (size_t)r * 1024 + hh * 256 + 4 * lane);
    const float ss = wave_sum((o.x * o.x + o.y * o.y) + (o.z * o.z + o.w * o.w));
    const float rstd = 1.0f / sqrtf(ss * (1.0f / 256.0f) + EPS);
    const f32x4 gv = *(const f32x4*)(A.in[F.zo + I_GGLA] + l * 1024 + hh * 256 + 4 * lane);
    const uint2 gw = *(const uint2*)(F.Z() + (size_t)r * ZW + GG + hh * 256 + 4 * lane);
    const float g0 = bflo(gw.x), g1 = bfhi(gw.x), g2 = bflo(gw.y), g3 = bfhi(gw.y);
    const float y0 = o.x * rstd * gv.x * (g0 / (1.0f + __expf(-g0))), y1 = o.y * rstd * gv.y * (g1 / (1.0f + __expf(-g1)));
    const float y2 = o.z * rstd * gv.z * (g2 / (1.0f + __expf(-g2))), y3 = o.w * rstd * gv.w * (g3 / (1.0f + __expf(-g3)));
    uint2 w; w.x = pk2(y0, y1); w.y = pk2(y2, y3);
    *(uint2*)(F.MIX() + (size_t)r * DM + 1024 + hh * 256 + 4 * lane) = w;
}
typedef unsigned u32x2 __attribute__((ext_vector_type(2)));
__device__ __forceinline__ u32x2 pack4bf(const f32x4 v) { u32x2 w; w.x = pk2(v.x, v.y); w.y = pk2(v.z, v.w); return w; }
constexpr int GL_QD = 0, GL_KD = 17408, GL_VT = 34816, GL_AM = 71680, GL_BS = 80896, GL_GS = 82944, GL_END = 87040;
static_assert(GL_END <= RING_BYTES, "GLA LDS map");
constexpr int GL_NSLOT = 640;
__device__ __forceinline__ void gla_prep_unit(Frame& F, const Args& A, int l, int slot) {
    const int lane = F.lane_id(), wave = F.wave, tid = wave * 64 + lane, fr = lane & 15, fq = lane >> 4;
    const bool smp = slot >= 512; const int hh = slot & 3;
    const int row0 = smp ? (NP_ROWS + ((slot - 512) >> 2) * 4) : ((slot >> 7) * 2048 + ((slot >> 2) & 31) * 64), nvalid = smp ? 4 : 64;
    const int d = tid & 127, qtr = tid >> 7, cg = hh * 128 + d;
    LAS bf16* QD = (LAS bf16*)(F.lds + GL_QD); LAS bf16* KD = (LAS bf16*)(F.lds + GL_KD); LAS bf16* VT = (LAS bf16*)(F.lds + GL_VT); LAS bf16* AM = (LAS bf16*)(F.lds + GL_AM);
    LAS float* BS = (LAS float*)(F.lds + GL_BS); LAS float* GS = (LAS float*)(F.lds + GL_GS);
    const bf16* Z = F.Z();
    { const int t = tid >> 3, j0 = (tid & 7) * 2; float g0 = 0.f, g1 = 0.f;
      if (t < nvalid) { const unsigned w = *(const unsigned*)(Z + (size_t)(row0 + t) * ZW + GA + j0); g0 = bflo(w); g1 = bfhi(w); }
      GS[t * 16 + j0] = g0; GS[t * 16 + j0 + 1] = g1; }
    float wa[16];
    { const float* wp = A.in[F.zo + I_WA2] + (size_t)l * 16 * 512 + cg;
#pragma unroll
      for (int j = 0; j < 16; ++j) wa[j] = wp[j * 512]; }
    const float ba = A.in[F.zo + I_BA2][l * 512 + cg];
    __syncthreads();
    float bl[16]; float run = 0.f;
#pragma unroll
    for (int i = 0; i < 16; ++i) { const int t = 16 * qtr + i; const LAS f32x4* gp = (const LAS f32x4*)(GS + t * 16); const f32x4 g0 = gp[0], g1 = gp[1], g2 = gp[2], g3 = gp[3];
        float x = ba + g0.x * wa[0] + g0.y * wa[1] + g0.z * wa[2] + g0.w * wa[3] + g1.x * wa[4] + g1.y * wa[5] + g1.z * wa[6] + g1.w * wa[7];
        x += g2.x * wa[8] + g2.y * wa[9] + g2.z * wa[10] + g2.w * wa[11] + g3.x * wa[12] + g3.y * wa[13] + g3.z * wa[14] + g3.w * wa[15];
        float la = (fminf(x, 0.f) - __logf(1.0f + __expf(-fabsf(x)))) * (1.0f / 16.0f);
        if (t >= nvalid) la = 0.f;
        run += la; bl[i] = run; }
    BS[qtr * 128 + d] = run;
    __syncthreads();
    float pre = 0.f, tot = 0.f;
#pragma unroll
    for (int q2 = 0; q2 < 4; ++q2) { const float v = BS[q2 * 128 + d]; tot += v; if (q2 < qtr) pre += v; }
    { const bf16* zq = Z + (size_t)(row0 + 16 * qtr) * ZW + GQ + cg; const bf16* zk = zq + (GK - GQ);
      bf16* qg = F.QDG() + (size_t)(row0 + 16 * qtr) * 512 + cg;
      unsigned kt[8];
#pragma unroll
      for (int i = 0; i < 16; ++i) { const int t = 16 * qtr + i; const float b = pre + bl[i]; float qv = 0.f, kv = 0.f;
          if (t < nvalid) { qv = bf2f(zq[(size_t)i * ZW]); kv = bf2f(zk[(size_t)i * ZW]); }
          const unsigned qd = f2bf(qv * __expf(b) * 0.08838834764831845f), kd = f2bf(kv * __expf(-b)), kdt = f2bf(kv * __expf(tot - b));
          QD[t * 136 + d] = (bf16)qd; KD[t * 136 + d] = (bf16)kd;
          if (t < nvalid) qg[(size_t)i * 512] = (bf16)qd;
          if (i & 1) kt[i >> 1] |= kdt << 16; else kt[i >> 1] = kdt; }
      v4u* kg = (v4u*)(F.KDTG() + ((size_t)slot * 128 + d) * 64 + 16 * qtr);
      kg[0] = (v4u){kt[0], kt[1], kt[2], kt[3]}; kg[1] = (v4u){kt[4], kt[5], kt[6], kt[7]};
      if (qtr == 0) F.DLG()[slot * 128 + d] = __expf(tot); }
    { const int e = tid & 255, hf = tid >> 8; const bf16* vp = Z + (size_t)(row0 + 32 * hf) * ZW + GV + hh * 256 + e;
      unsigned vw[16];
#pragma unroll
      for (int i = 0; i < 32; ++i) { const int s = 32 * hf + i; unsigned x = 0u; if (s < nvalid) x = vp[(size_t)i * ZW];
          if (i & 1) vw[i >> 1] |= x << 16; else vw[i >> 1] = x; }
      LAS v4u* vl = (LAS v4u*)(VT + e * 72 + 32 * hf); v4u* vg = (v4u*)(F.VTG() + ((size_t)slot * 256 + e) * 64 + 32 * hf);
#pragma unroll
      for (int k = 0; k < 4; ++k) { const v4u w = {vw[4 * k], vw[4 * k + 1], vw[4 * k + 2], vw[4 * k + 3]}; vl[k] = w; vg[k] = w; } }
    __syncthreads();
#pragma unroll
    for (int bi = 0; bi < 2; ++bi) { const int blk = 2 * wave + bi, tb = blk >> 2, sbk = blk & 3;
        f32x4 acc = {0.f, 0.f, 0.f, 0.f};
        if (sbk <= tb) {
#pragma unroll
            for (int ks = 0; ks < 4; ++ks) { const bf16x8 a = *(const LAS bf16x8*)(KD + (sbk * 16 + fr) * 136 + ks * 32 + fq * 8), b = *(const LAS bf16x8*)(QD + (tb * 16 + fr) * 136 + ks * 32 + fq * 8);
                acc = __builtin_amdgcn_mfma_f32_16x16x32_bf16(a, b, acc, 0, 0, 0); } }
        const int t = tb * 16 + fr, s0 = sbk * 16 + 4 * fq;
        f32x4 m; m.x = (s0 + 0 <= t) ? acc.x : 0.f; m.y = (s0 + 1 <= t) ? acc.y : 0.f; m.z = (s0 + 2 <= t) ? acc.z : 0.f; m.w = (s0 + 3 <= t) ? acc.w : 0.f;
        *(LAS u32x2*)(AM + t * 72 + s0) = pack4bf(m); }
    __syncthreads();
#pragma unroll
    for (int ei = 0; ei < 2; ++ei) { const int eb = 2 * wave + ei;
        const bf16x8 a0 = *(const LAS bf16x8*)(VT + (eb * 16 + fr) * 72 + fq * 8), a1 = *(const LAS bf16x8*)(VT + (eb * 16 + fr) * 72 + 32 + fq * 8);
#pragma unroll
        for (int tb = 0; tb < 4; ++tb) { f32x4 o = {0.f, 0.f, 0.f, 0.f};
            o = __builtin_amdgcn_mfma_f32_16x16x32_bf16(a0, *(const LAS bf16x8*)(AM + (tb * 16 + fr) * 72 + fq * 8), o, 0, 0, 0);
            if (tb >= 2) o = __builtin_amdgcn_mfma_f32_16x16x32_bf16(a1, *(const LAS bf16x8*)(AM + (tb * 16 + fr) * 72 + 32 + fq * 8), o, 0, 0, 0);
            const int t = tb * 16 + fr;
            if (t < nvalid) *(f32x4*)(F.OGLA() + (size_t)(row0 + t) * 1024 + hh * 256 + eb * 16 + 4 * fq) = o; } }
    __syncthreads();
}
__device__ __forceinline__ void gla_state_step(Frame& F, int slot, int eb, int fr, int fq, f32x4 (&sacc)[8]) {
    const bf16* vt = F.VTG() + ((size_t)slot * 256 + eb * 16 + fr) * 64 + 8 * fq; const bf16x8 b0 = *(const bf16x8*)vt, b1 = *(const bf16x8*)(vt + 32);
    const bf16* kt = F.KDTG() + ((size_t)slot * 128 + fr) * 64 + 8 * fq; const float* dl = F.DLG() + slot * 128 + 4 * fq;
#pragma unroll
    for (int db = 0; db < 8; ++db) { const f32x4 dv = *(const f32x4*)(dl + db * 16); const bf16x8 a0 = *(const bf16x8*)(kt + (size_t)db * 16 * 64), a1 = *(const bf16x8*)(kt + (size_t)db * 16 * 64 + 32);
        f32x4 s = sacc[db] * dv; s = __builtin_amdgcn_mfma_f32_16x16x32_bf16(a0, b0, s, 0, 0, 0); s = __builtin_amdgcn_mfma_f32_16x16x32_bf16(a1, b1, s, 0, 0, 0); sacc[db] = s; }
}
__device__ __forceinline__ void gla_inter_step(Frame& F, int row0, int nvalid, int ntb, int hh, int eb, int fr, int fq, const f32x4 (&sacc)[8]) {
    bf16x8 sf[4];
#pragma unroll
    for (int ks = 0; ks < 4; ++ks) { const u32x2 lo = pack4bf(sacc[2 * ks]), hi = pack4bf(sacc[2 * ks + 1]); const v4u w = {lo.x, lo.y, hi.x, hi.y}; sf[ks] = __builtin_bit_cast(bf16x8, w); }
    for (int tb = 0; tb < ntb; ++tb) { const int t = tb * 16 + fr; const bool ok = t < nvalid;
        const bf16* qp = F.QDG() + (size_t)(row0 + t) * 512 + hh * 128 + 4 * fq;
        f32x4 o = {0.f, 0.f, 0.f, 0.f};
#pragma unroll
        for (int ks = 0; ks < 4; ++ks) { u32x2 lo = {0u, 0u}, hi = {0u, 0u}; if (ok) { lo = *(const u32x2*)(qp + 32 * ks); hi = *(const u32x2*)(qp + 32 * ks + 16); }
            const v4u w = {lo.x, lo.y, hi.x, hi.y}; o = __builtin_amdgcn_mfma_f32_16x16x32_bf16(sf[ks], __builtin_bit_cast(bf16x8, w), o, 0, 0, 0); }
        if (ok) { const size_t oi = (size_t)(row0 + t) * 1024 + hh * 256 + eb * 16 + 4 * fq; *(f32x4*)(F.OGLA_ST() + oi) = *(const f32x4*)(F.OGLA() + oi) + o; } }
}
__device__ __forceinline__ void gla_store_state(float* dst, int fr, int fq, const f32x4 (&sacc)[8]) {
#pragma unroll
    for (int db = 0; db < 8; ++db) { const int d0 = db * 16 + 4 * fq; dst[(size_t)(d0 + 0) * 256 + fr] = sacc[db].x; dst[(size_t)(d0 + 1) * 256 + fr] = sacc[db].y; dst[(size_t)(d0 + 2) * 256 + fr] = sacc[db].z; dst[(size_t)(d0 + 3) * 256 + fr] = sacc[db].w; }
}
__device__ __forceinline__ void gla_phase_g1(Frame& F, const Args& A, int l) {
    const int lane = F.lane_id(), fr = lane & 15, fq = lane >> 4;
    const int gw = F.vcu * NWAVES + F.wave, NGW = F.G * NWAVES;
    for (int it = gw; it < 2048; it += NGW) { const int bh = it >> 7, seg = (it >> 4) & 7, eb = it & 15;
        if (seg == 7) continue;
        f32x4 sacc[8];
#pragma unroll
        for (int db = 0; db < 8; ++db) sacc[db] = (f32x4){0.f, 0.f, 0.f, 0.f};
        const int slot0 = (((bh >> 2) * 32 + seg * 4) * 4) + (bh & 3);
        for (int c = 0; c < 4; ++c) gla_state_step(F, slot0 + 4 * c, eb, fr, fq, sacc);
        gla_store_state(F.SLOC() + ((size_t)(bh * 8 + seg) * 128) * 256 + eb * 16, fr, fq, sacc);
        if (eb == 0) {
#pragma unroll
            for (int k = 0; k < 2; ++k) { const int d = lane + 64 * k; float p = 1.f; for (int c = 0; c < 4; ++c) p *= F.DLG()[(slot0 + 4 * c) * 128 + d]; F.DSEG()[(bh * 8 + seg) * 128 + d] = p; } }
    }
    for (int it = gw; it < 2048; it += NGW) { const int sbh = it >> 4, eb = it & 15, sb = sbh >> 2, hh = sbh & 3;
        const size_t so = ((size_t)((l * 32 + sb) * 4 + hh)) * 32768 + eb * 16;
        const float* s0 = A.in[F.zo + I_SGLA] + so + fr;
        f32x4 sacc[8];
#pragma unroll
        for (int db = 0; db < 8; ++db) { const int d0 = db * 16 + 4 * fq; sacc[db].x = s0[(size_t)(d0 + 0) * 256]; sacc[db].y = s0[(size_t)(d0 + 1) * 256]; sacc[db].z = s0[(size_t)(d0 + 2) * 256]; sacc[db].w = s0[(size_t)(d0 + 3) * 256]; }
        gla_inter_step(F, NP_ROWS + sb * 4, 4, 1, hh, eb, fr, fq, sacc);
        gla_state_step(F, 512 + sbh, eb, fr, fq, sacc);
        gla_store_state(F.out + O_GLA_S + so, fr, fq, sacc);
    }
}
__device__ __forceinline__ void gla_phase_g2(Frame& F, const Args& A, int l) {
    const int lane = F.lane_id(), fr = lane & 15, fq = lane >> 4;
    const int gw = F.vcu * NWAVES + F.wave, NGW = F.G * NWAVES;
    for (int it = gw; it < 2048; it += NGW) { const int bh = it >> 7, seg = (it >> 4) & 7, eb = it & 15, hh = bh & 3;
        f32x4 sacc[8];
#pragma unroll
        for (int db = 0; db < 8; ++db) sacc[db] = (f32x4){0.f, 0.f, 0.f, 0.f};
        for (int i2 = 0; i2 < seg; ++i2) { const float* sl = F.SLOC() + ((size_t)(bh * 8 + i2) * 128) * 256 + eb * 16 + fr; const float* dg = F.DSEG() + (bh * 8 + i2) * 128;
#pragma unroll
            for (int db = 0; db < 8; ++db) { const int d0 = db * 16 + 4 * fq; const f32x4 dv = *(const f32x4*)(dg + d0);
                sacc[db].x = sacc[db].x * dv.x + sl[(size_t)(d0 + 0) * 256]; sacc[db].y = sacc[db].y * dv.y + sl[(size_t)(d0 + 1) * 256]; sacc[db].z = sacc[db].z * dv.z + sl[(size_t)(d0 + 2) * 256]; sacc[db].w = sacc[db].w * dv.w + sl[(size_t)(d0 + 3) * 256]; } }
        const int slot0 = (((bh >> 2) * 32 + seg * 4) * 4) + hh, row0 = (bh >> 2) * 2048 + seg * 256;
        for (int c = 0; c < 4; ++c) { gla_inter_step(F, row0 + c * 64, 64, 4, hh, eb, fr, fq, sacc); gla_state_step(F, slot0 + 4 * c, eb, fr, fq, sacc); }
        if (seg == 7) gla_store_state(F.out + O_GLA_P + ((size_t)(l * 16 + bh)) * 32768 + eb * 16, fr, fq, sacc);
    }
}
constexpr int AT_VT = 0, AT_VTS = 184, AT_BT = 64 * AT_VTS * 2, AT_END = AT_BT + 4 * 128 * 4;
__device__ __forceinline__ void attn_unit_mfma(Frame& F, const Args& A, int l, int u) {
    const int lane = F.lane_id(), wave = F.wave, tid = wave * 64 + lane, fr = lane & 15, fq = lane >> 4;
    const int span = u >> 1, g = u & 1, t0g = span * 32, tb0 = t0g & 2047;
    LAS bf16* VT = (LAS bf16*)(F.lds + AT_VT); LAS float* BT = (LAS float*)(F.lds + AT_BT);
    const bf16* Z = F.Z();
#pragma unroll
    for (int pass = 0; pass < 2; ++pass) { const int key = pass * 128 + (tid >> 2), dch = (tid & 3) * 16;
        if (key < 160) { v4u v0 = {0u, 0u, 0u, 0u}, v1 = {0u, 0u, 0u, 0u};
            if (tb0 - 128 + key >= 0) { const v4u* vp = (const v4u*)(Z + (size_t)(t0g - 128 + key) * ZW + ZV + g * 64 + dch); v0 = vp[0]; v1 = vp[1]; }
            LAS bf16* vt = VT + dch * AT_VTS + key;
            vt[0 * AT_VTS] = (bf16)(v0.x & 0xffffu); vt[1 * AT_VTS] = (bf16)(v0.x >> 16); vt[2 * AT_VTS] = (bf16)(v0.y & 0xffffu); vt[3 * AT_VTS] = (bf16)(v0.y >> 16);
            vt[4 * AT_VTS] = (bf16)(v0.z & 0xffffu); vt[5 * AT_VTS] = (bf16)(v0.z >> 16); vt[6 * AT_VTS] = (bf16)(v0.w & 0xffffu); vt[7 * AT_VTS] = (bf16)(v0.w >> 16);
            vt[8 * AT_VTS] = (bf16)(v1.x & 0xffffu); vt[9 * AT_VTS] = (bf16)(v1.x >> 16); vt[10 * AT_VTS] = (bf16)(v1.y & 0xffffu); vt[11 * AT_VTS] = (bf16)(v1.y >> 16);
            vt[12 * AT_VTS] = (bf16)(v1.z & 0xffffu); vt[13 * AT_VTS] = (bf16)(v1.z >> 16); vt[14 * AT_VTS] = (bf16)(v1.w & 0xffffu); vt[15 * AT_VTS] = (bf16)(v1.w >> 16); } }
    BT[tid] = F.BTAB()[(g * 4) * 128 + tid];
    __syncthreads();
    const int rb = wave >> 2, hl = wave & 3, hd = g * 4 + hl, t0w = t0g + 16 * rb;
    bf16x8 qf[2];
    { const bf16* qp = Z + (size_t)(t0w + fr) * ZW + ZQ + hd * 64 + 8 * fq; qf[0] = *(const bf16x8*)qp; qf[1] = *(const bf16x8*)(qp + 32); }
    f32x4 sacc[9];
#pragma unroll
    for (int kb = 0; kb < 9; ++kb) { const int kl = 16 * (rb + kb) + fr; bf16x8 k0 = {0, 0, 0, 0, 0, 0, 0, 0}, k1 = {0, 0, 0, 0, 0, 0, 0, 0};
        if (tb0 - 128 + kl >= 0) { const bf16* kp = Z + (size_t)(t0g - 128 + kl) * ZW + ZK + g * 64 + 8 * fq; k0 = *(const bf16x8*)kp; k1 = *(const bf16x8*)(kp + 32); }
        f32x4 acc = {0.f, 0.f, 0.f, 0.f};
        acc = __builtin_amdgcn_mfma_f32_16x16x32_bf16(k0, qf[0], acc, 0, 0, 0); acc = __builtin_amdgcn_mfma_f32_16x16x32_bf16(k1, qf[1], acc, 0, 0, 0);
        sacc[kb] = acc; }
    const float sink = A.in[F.zo + I_SINKS][l * 8 + hd];
    float mx = -INFINITY;
#pragma unroll
    for (int kb = 0; kb < 9; ++kb)
#pragma unroll
        for (int i = 0; i < 4; ++i) { const int dist = 128 - 16 * kb + fr - 4 * fq - i, kpos = tb0 + 16 * rb + fr - dist;
            const bool valid = (dist >= 0) && (dist < 128) && (kpos >= 0);
            const float s = valid ? sacc[kb][i] * 0.125f + BT[hl * 128 + (dist & 127)] : -INFINITY;
            sacc[kb][i] = s; mx = fmaxf(mx, s); }
    mx = fmaxf(mx, __shfl_xor(mx, 16)); mx = fmaxf(mx, __shfl_xor(mx, 32)); mx = fmaxf(mx, sink);
    float ls = 0.f;
#pragma unroll
    for (int kb = 0; kb < 9; ++kb)
#pragma unroll
        for (int i = 0; i < 4; ++i) { const float p = __expf(sacc[kb][i] - mx); sacc[kb][i] = p; ls += p; }
    ls += __shfl_xor(ls, 16); ls += __shfl_xor(ls, 32);
    const float rden = 1.0f / (ls + __expf(sink - mx));
    bf16x8 pf[5];
#pragma unroll
    for (int pp = 0; pp < 5; ++pp) { const f32x4 a = sacc[2 * pp], b = (2 * pp + 1 < 9) ? sacc[2 * pp + 1] : (f32x4){0.f, 0.f, 0.f, 0.f};
        const unsigned w0 = pk2(a.x, a.y), w1 = pk2(a.z, a.w), w2 = pk2(b.x, b.y), w3 = pk2(b.z, b.w);
        v4u w = {w0, w1, w2, w3}; pf[pp] = __builtin_bit_cast(bf16x8, w); }
#pragma unroll
    for (int db = 0; db < 4; ++db) { f32x4 o = {0.f, 0.f, 0.f, 0.f};
#pragma unroll
        for (int pp = 0; pp < 5; ++pp) { const LAS bf16* vr = VT + (db * 16 + fr) * AT_VTS + 16 * (rb + 2 * pp) + 4 * fq;
            const u32x2 lo = *(const LAS u32x2*)vr; u32x2 hi = {0u, 0u}; if (2 * pp + 1 < 9) hi = *(const LAS u32x2*)(vr + 16);
            v4u w = {lo.x, lo.y, hi.x, hi.y};
            o = __builtin_amdgcn_mfma_f32_16x16x32_bf16(__builtin_bit_cast(bf16x8, w), pf[pp], o, 0, 0, 0); }
        *(u32x2*)(F.MIX() + (size_t)(t0w + fr) * DM + hd * 64 + db * 16 + 4 * fq) = pack4bf(o * rden); }
    __syncthreads();
}
__device__ __forceinline__ void pool_item_mfma(Frame& F, const Args& A, int l, int rblk, int g) {
    const int lane = F.lane_id(), fr = lane & 15, fq = lane >> 4;
    const int t = rblk * 16 + fr, pos = t & 2047, w = 2 << g;
    const bf16* Z = F.Z();
    const int nwin = (pos + 1) < w ? (pos + 1) : w; const float rc = 1.0f / (float)nwin;
    bf16x8 df[4];
#pragma unroll
    for (int ks = 0; ks < 4; ++ks) { const bf16* up = Z + (size_t)t * ZW + ZU + g * 128 + ks * 32 + 8 * fq;
        float s[8], u0[8];
        { const v4u x = *(const v4u*)up; u0[0] = bflo(x.x); u0[1] = bfhi(x.x); u0[2] = bflo(x.y); u0[3] = bfhi(x.y); u0[4] = bflo(x.z); u0[5] = bfhi(x.z); u0[6] = bflo(x.w); u0[7] = bfhi(x.w); }
#pragma unroll
        for (int j = 0; j < 8; ++j) s[j] = u0[j];
        for (int i = 1; i < nwin; ++i) { const v4u x = *(const v4u*)(up - (size_t)i * ZW);
            s[0] += bflo(x.x); s[1] += bfhi(x.x); s[2] += bflo(x.y); s[3] += bfhi(x.y); s[4] += bflo(x.z); s[5] += bfhi(x.z); s[6] += bflo(x.w); s[7] += bfhi(x.w); }
        v4u wv; wv.x = pk2(s[0] * rc - u0[0], s[1] * rc - u0[1]); wv.y = pk2(s[2] * rc - u0[2], s[3] * rc - u0[3]); wv.z = pk2(s[4] * rc - u0[4], s[5] * rc - u0[5]); wv.w = pk2(s[6] * rc - u0[6], s[7] * rc - u0[7]);
        df[ks] = __builtin_bit_cast(bf16x8, wv); }
    const bf16* wt = F.WPT() + ((size_t)(l * 4 + g) * 128) * 128; const float* psc = A.in[F.zo + I_PSCALE] + l * 512 + g * 128;
#pragma unroll
    for (int nb = 0; nb < 8; ++nb) { f32x4 acc = {0.f, 0.f, 0.f, 0.f};
#pragma unroll
        for (int ks = 0; ks < 4; ++ks) { const bf16x8 a = *(const bf16x8*)(wt + (size_t)(nb * 16 + fr) * 128 + ks * 32 + 8 * fq); acc = __builtin_amdgcn_mfma_f32_16x16x32_bf16(a, df[ks], acc, 0, 0, 0); }
        const f32x4 sc = *(const f32x4*)(psc + nb * 16 + 4 * fq);
        *(u32x2*)(F.MIX() + (size_t)t * DM + 512 + g * 128 + nb * 16 + 4 * fq) = pack4bf(acc * sc); }
}
__device__ __forceinline__ void skinny_resid(Frame& F, const bf16* Asmp, const bf16* Bt, int K, const float* gate) {
    const int lane = F.lane_id(), wave = F.wave, fr = lane & 15, fq = lane >> 4;
    LAS float* red = (LAS float*)(F.lds + RING_OFF);
    const int kw = K >> 3, ksteps = kw >> 5;
    for (int u = F.vcu; u < 256; u += F.G) {
        const int c0 = (u >> 1) * 16, r0 = (u & 1) * 64;
        const bf16* bp = Bt + (size_t)(c0 + fr) * K + wave * kw + 8 * fq;
        const bf16* ap = Asmp + (size_t)(r0 + fr) * K + wave * kw + 8 * fq;
        f32x4 acc[4];
#pragma unroll
        for (int rb = 0; rb < 4; ++rb) acc[rb] = (f32x4){0.f, 0.f, 0.f, 0.f};
        bf16x8 bc = *(const bf16x8*)bp, ac[4];
#pragma unroll
        for (int rb = 0; rb < 4; ++rb) ac[rb] = *(const bf16x8*)(ap + (size_t)rb * 16 * K);
        for (int ks = 0; ks < ksteps; ++ks) {
            bf16x8 bn = bc, an[4];
#pragma unroll
            for (int rb = 0; rb < 4; ++rb) an[rb] = ac[rb];
            if (ks + 1 < ksteps) { bn = *(const bf16x8*)(bp + (ks + 1) * 32);
#pragma unroll
                for (int rb = 0; rb < 4; ++rb) an[rb] = *(const bf16x8*)(ap + (size_t)rb * 16 * K + (ks + 1) * 32); }
#pragma unroll
            for (int rb = 0; rb < 4; ++rb) acc[rb] = __builtin_amdgcn_mfma_f32_16x16x32_bf16(bc, ac[rb], acc[rb], 0, 0, 0);
            bc = bn;
#pragma unroll
            for (int rb = 0; rb < 4; ++rb) ac[rb] = an[rb];
        }
#pragma unroll
        for (int rb = 0; rb < 4; ++rb) *(LAS f32x4*)(red + ((wave * 4 + rb) * 64 + lane) * 4) = acc[rb];
        __syncthreads();
        if (wave < 4) { f32x4 s = {0.f, 0.f, 0.f, 0.f};
#pragma unroll
            for (int w2 = 0; w2 < 8; ++w2) s = s + *(const LAS f32x4*)(red + ((w2 * 4 + wave) * 64 + lane) * 4);
            const int r = r0 + wave * 16 + fr;
            const f32x4 g = *(const f32x4*)(gate + (size_t)(4 + (r >> 2)) * MODLD + c0 + 4 * fq);
            const size_t xo = (size_t)(NP_ROWS + r) * DM + c0 + 4 * fq; f32x4 xv = *(const f32x4*)(F.X() + xo); xv = xv + g * s; *(f32x4*)(F.X_ST() + xo) = xv; }
        __syncthreads();
    }
}

#ifndef EN_P0
#define EN_P0 1
#endif
#ifndef EN_G
#define EN_G 1
#endif
#ifndef EN_N
#define EN_N 1
#endif
#ifndef EN_M2
#define EN_M2 1
#endif
#ifndef EN_M3
#define EN_M3 1
#endif
#ifndef EN_M4
#define EN_M4 1
#endif
#ifndef EN_G1
#define EN_G1 1
#endif
#ifndef EN_GIN
#define EN_GIN 1
#endif
#ifndef EN_GOUT
#define EN_GOUT 1
#endif
#ifndef EN_GGU
#define EN_GGU 1
#endif
#ifndef EN_GDN
#define EN_GDN 1
#endif
#ifndef PROBE_DUP
#define PROBE_DUP 0
#endif
#ifndef MK_SINGLE
#define MK_SINGLE 1
#endif

#define PH_ARGS unsigned ldsb_, unsigned wslo_, unsigned wshi_, unsigned olo_, unsigned ohi_, int wave_, int vcu_, int G_, int probe_, int l_
#define PH_PASS ldsb, wslo, wshi, olo, ohi, F.wave, F.vcu, F.G, F.probe
#define PH_FRAME() Frame F; { const unsigned a0 = __builtin_amdgcn_readfirstlane(ldsb_), a1 = __builtin_amdgcn_readfirstlane(wslo_), a2 = __builtin_amdgcn_readfirstlane(wshi_), a3 = __builtin_amdgcn_readfirstlane(olo_), a4 = __builtin_amdgcn_readfirstlane(ohi_); \
    F.lds = (LAS unsigned char*)(unsigned long long)a0; F.MISC = (volatile LAS unsigned*)(F.lds + MISC_OFF); F.ws = (unsigned char*)(((unsigned long long)a2 << 32) | a1); F.out = (float*)(((unsigned long long)a4 << 32) | a3); \
    F.wave = __builtin_amdgcn_readfirstlane(wave_); F.vcu = __builtin_amdgcn_readfirstlane(vcu_); F.G = __builtin_amdgcn_readfirstlane(G_); F.zo = 0; F.probe = __builtin_amdgcn_readfirstlane(probe_); } \
    const int l = __builtin_amdgcn_readfirstlane(l_); (void)l; \
    const Args& args = *(const Args*)__builtin_amdgcn_kernarg_segment_ptr();
__device__ __forceinline__ void ph_prologue(PH_ARGS) { PH_FRAME(); p0_prologue(F, args); }
__device__ __forceinline__ void ph_norm1(PH_ARGS) { PH_FRAME(); norm_mod_rows(F, args.in[I_GMIX] + l * DM, F.MOD() + (size_t)l * MODW); }
__device__ __forceinline__ void ph_norm2(PH_ARGS) { PH_FRAME(); norm_mod_rows(F, args.in[I_GFFN] + l * DM, F.MOD() + (size_t)l * MODW + 6144); }
__device__ __forceinline__ void ph_final(PH_ARGS) { PH_FRAME(); final_norm_rows(F, args); }
__device__ __forceinline__ void ph_mixa(PH_ARGS) { PH_FRAME();
    const int gw = F.vcu * NWAVES + F.wave, NGW = F.G * NWAVES; LAS float* wscr = (LAS float*)(F.lds + RING_OFF + F.wave * 16384);
    for (int u = F.vcu; u < GL_NSLOT; u += F.G) gla_prep_unit(F, args, l, u);
    for (int u = F.vcu; u < 512; u += F.G) attn_unit_mfma(F, args, l, u);
    for (int it = gw; it < 512 * 4; it += NGW) pool_item_mfma(F, args, l, it >> 2, it & 3);
    for (int it = gw; it < NS_ROWS * 8; it += NGW) attn_item(F, args, l, NP_ROWS + (it >> 3), it & 7, wscr);
    for (int it = gw; it < NS_ROWS * 4; it += NGW) pool_item(F, args, l, NP_ROWS + (it >> 2), it & 3, wscr);
    cache_outputs(F, args, l);
}
__device__ __forceinline__ void ph_gla1(PH_ARGS) { PH_FRAME(); gla_phase_g1(F, args, l); }
__device__ __forceinline__ void ph_gla2(PH_ARGS) { PH_FRAME(); gla_phase_g2(F, args, l); }
__device__ __forceinline__ void ph_mixc(PH_ARGS) { PH_FRAME(); const int gw = F.vcu * NWAVES + F.wave, NGW = F.G * NWAVES; for (int it = gw; it < NROWS * 4; it += NGW) gla_out_item(F, args, l, it >> 2, it & 3); }
constexpr int PH_PER_LAYER = 10, PH_LAYER0 = 2, PH_FINAL = PH_LAYER0 + DEPTH * PH_PER_LAYER, PH_COUNT = PH_FINAL + 1;
__global__ void __launch_bounds__(NTHREADS, 2) hymba_fwd(Args args) {
    extern __shared__ __attribute__((aligned(16))) unsigned char lds[];
    Frame F;
    F.lds = (LAS unsigned char*)lds;
    F.MISC = (volatile LAS unsigned*)(F.lds + MISC_OFF);
    F.wave = __builtin_amdgcn_readfirstlane((int)threadIdx.x >> 6); F.zo = 0; F.probe = 0;
    F.G = gridDim.x; { const int bx = blockIdx.x; F.vcu = (F.G % 8 == 0) ? (bx % 8) * (F.G / 8) + bx / 8 : bx; }
    F.ws = args.ws; F.out = args.out;
    gu32* const ctl = (gu32*)(F.ws + WS_CTL);
    for (int u = threadIdx.x; u < (LDS_BYTES - LDSCTL_OFF) / 4; u += NTHREADS) ((LAS unsigned*)(F.lds + LDSCTL_OFF))[u] = 0u;
    __syncthreads();
#if MK_SINGLE
    XcdBarrier bar = xcd_barrier_post((unsigned*)(ctl + CW_BAR), F.MISC + 8);
#define GRID_BAR() xcd_barrier(bar)
#else
#define GRID_BAR() do { } while (0)
#endif
    const int lo = args.ph_lo, hi = args.ph_hi;
    const unsigned ldsb = (unsigned)(unsigned long long)F.lds, wslo = (unsigned)(unsigned long long)F.ws, wshi = (unsigned)((unsigned long long)F.ws >> 32), olo = (unsigned)(unsigned long long)F.out, ohi = (unsigned)((unsigned long long)F.out >> 32);
#define IN(k) (lo <= (k) && (k) < hi)
#define BOTH(k) (IN(k) && IN((k) + 1))
#define PHASE_BEGIN() asm volatile("s_mov_b32 %0, 0" : "=s"(F.zo), "+s"(F.G), "+s"(F.vcu), "+s"(F.wave))
#define gw (F.vcu * NWAVES + F.wave)
#define NGW (F.G * NWAVES)
#define wscr ((LAS float*)(F.lds + RING_OFF + F.wave * 16384))

    if (EN_P0 && IN(0)) for (int rep_ = 0; rep_ < ((PROBE_DUP & 1) ? 2 : 1); ++rep_) { PHASE_BEGIN(); ph_prologue(PH_PASS, 0); if (BOTH(0)) GRID_BAR(); }
    if (EN_G && EN_G1 && IN(1)) for (int rep_ = 0; rep_ < ((PROBE_DUP & 1) ? 2 : 1); ++rep_) { PHASE_BEGIN();
        pg8::Gemm g{F.SC(), F.Wada_t(), 256, DEPTH * MODW, DM}; pg8::StaticOrder S; S.init(256, DEPTH * MODW, F.G, (int)blockIdx.x);
        pg8::EpiMod E{F.MOD(), args.in[F.zo + I_BADA]};
        pg8::gemm_phase<pg8::EpiMod, pg8::StaticOrder, true, true>(F.lds + RING_OFF, g, S, E, F.wave);
        if (BOTH(1)) GRID_BAR();
    }
    for (int l = 0; l < DEPTH; ++l) {
        const int pb = PH_LAYER0 + l * PH_PER_LAYER;
        const float* modl = F.MOD() + (size_t)l * MODW;
        if (EN_N && IN(pb + 0)) for (int rep_ = 0; rep_ < ((PROBE_DUP & 2) ? 2 : 1); ++rep_) { PHASE_BEGIN(); ph_norm1(PH_PASS, l); if (BOTH(pb + 0)) GRID_BAR(); }
        if (EN_G && EN_GIN && IN(pb + 1)) for (int rep_ = 0; rep_ < ((PROBE_DUP & 4) ? 2 : 1); ++rep_) { PHASE_BEGIN();
            pg8::Gemm g{F.H(), F.Win_t() + (size_t)l * ZW * DM, MPAD, ZW, DM}; pg8::StaticOrder S; S.init(MPAD, ZW, F.G, (int)blockIdx.x);
            pg8::EpiZ E{F.Z(), ZW};
            pg8::gemm_phase<pg8::EpiZ, pg8::StaticOrder, true, true>(F.lds + RING_OFF, g, S, E, F.wave);
            if (BOTH(pb + 1)) GRID_BAR();
        }
        if (EN_M2 && IN(pb + 2)) for (int rep_ = 0; rep_ < ((PROBE_DUP & 8) ? 2 : 1); ++rep_) { PHASE_BEGIN();
            ph_mixa(PH_PASS, l);
            if (BOTH(pb + 2)) GRID_BAR();
        }
        if (EN_M3 && IN(pb + 3)) for (int rep_ = 0; rep_ < ((PROBE_DUP & 16) ? 2 : 1); ++rep_) { PHASE_BEGIN(); F.probe = ((PROBE_DUP & 16) && rep_ == 0) ? 1 : 0; ph_gla1(PH_PASS, l); if (BOTH(pb + 3)) GRID_BAR(); }
        if (EN_M3 && IN(pb + 4)) for (int rep_ = 0; rep_ < ((PROBE_DUP & 32) ? 2 : 1); ++rep_) { PHASE_BEGIN(); F.probe = ((PROBE_DUP & 32) && rep_ == 0) ? 1 : 0;
            ph_gla2(PH_PASS, l);
            if (BOTH(pb + 4)) GRID_BAR();
        }
        if (EN_M4 && IN(pb + 5)) for (int rep_ = 0; rep_ < ((PROBE_DUP & 64) ? 2 : 1); ++rep_) { PHASE_BEGIN(); ph_mixc(PH_PASS, l); if (BOTH(pb + 5)) GRID_BAR(); }
        if (EN_G && EN_GOUT && IN(pb + 6)) for (int rep_ = 0; rep_ < ((PROBE_DUP & 128) ? 2 : 1); ++rep_) { PHASE_BEGIN(); F.probe = ((PROBE_DUP & 128) && rep_ == 0) ? 1 : 0;
            pg8::Gemm g{F.MIX(), F.Wout_t() + (size_t)l * DM * DM, NP_ROWS, DM, DM}; pg8::StaticOrder S; S.init(NP_ROWS, DM, F.G, (int)blockIdx.x);
            pg8::EpiResid E{F.X(), modl + 4096, F.X_ST()};
            pg8::gemm_phase<pg8::EpiResid, pg8::StaticOrder, true, true>(F.lds + RING_OFF, g, S, E, F.wave);
            if ((PROBE_DUP & 512) && !F.probe) { F.probe = 1; skinny_resid(F, F.MIX() + (size_t)NP_ROWS * DM, F.Wout_t() + (size_t)l * DM * DM, DM, modl + 4096); F.probe = 0; }
            skinny_resid(F, F.MIX() + (size_t)NP_ROWS * DM, F.Wout_t() + (size_t)l * DM * DM, DM, modl + 4096);
            if (BOTH(pb + 6)) GRID_BAR();
        }
        if (EN_N && IN(pb + 7)) for (int rep_ = 0; rep_ < ((PROBE_DUP & 2) ? 2 : 1); ++rep_) { PHASE_BEGIN(); ph_norm2(PH_PASS, l); if (BOTH(pb + 7)) GRID_BAR(); }
        if (EN_G && EN_GGU && IN(pb + 8)) for (int rep_ = 0; rep_ < ((PROBE_DUP & 4) ? 2 : 1); ++rep_) { PHASE_BEGIN();
            pg8::Gemm g{F.H(), F.Wgu_t() + (size_t)l * NGU * DM, MPAD, NGU, DM}; pg8::StaticOrder S; S.init(MPAD, NGU, F.G, (int)blockIdx.x);
            pg8::EpiSwiGLU E{F.ACT(), DFF};
            pg8::gemm_phase<pg8::EpiSwiGLU, pg8::StaticOrder, true, true>(F.lds + RING_OFF, g, S, E, F.wave);
            if (BOTH(pb + 8)) GRID_BAR();
        }
        if (EN_G && EN_GDN && IN(pb + 9)) for (int rep_ = 0; rep_ < ((PROBE_DUP & 256) ? 2 : 1); ++rep_) { PHASE_BEGIN(); F.probe = ((PROBE_DUP & 256) && rep_ == 0) ? 1 : 0;
            pg8::Gemm g{F.ACT(), F.Wdn_t() + (size_t)l * DM * DFF, NP_ROWS, DM, DFF}; pg8::StaticOrder S; S.init(NP_ROWS, DM, F.G, (int)blockIdx.x);
            pg8::EpiResid E{F.X(), modl + 10240, F.X_ST()};
            pg8::gemm_phase<pg8::EpiResid, pg8::StaticOrder, true, true>(F.lds + RING_OFF, g, S, E, F.wave);
            if ((PROBE_DUP & 512) && !F.probe) { F.probe = 1; skinny_resid(F, F.ACT() + (size_t)NP_ROWS * DFF, F.Wdn_t() + (size_t)l * DM * DFF, DFF, modl + 10240); F.probe = 0; }
            skinny_resid(F, F.ACT() + (size_t)NP_ROWS * DFF, F.Wdn_t() + (size_t)l * DM * DFF, DFF, modl + 10240);
            if (BOTH(pb + 9)) GRID_BAR();
        }
    }
    if (IN(PH_FINAL)) { PHASE_BEGIN(); ph_final(PH_PASS, 0); }
#ifdef PROBE_SCALE
    GRID_BAR();
    { const size_t offs[11] = {O_Y, 16777216, O_WK_P, O_WV_P, O_POOL_P, O_GLA_P, O_WK_S, O_WV_S, O_POOL_S, O_GLA_S, O_END};
      const size_t gt_ = (size_t)(F.vcu * NWAVES + F.wave) * 64 + F.lane_id(), NGT_ = (size_t)F.G * NWAVES * 64;
      for (int k = 0; k < 10; ++k) { const float sc = 1.0f + 0.05f * (float)(k + 1); for (size_t i = offs[k] + gt_; i < offs[k + 1]; i += NGT_) F.out[i] *= sc; } }
#endif
#undef IN
#undef BOTH
#undef gw
#undef NGW
#undef wscr
}

extern "C" void kernel_launch(void* const* d_in, const int* in_sizes, int n_in, void* d_out, int out_size, void* d_ws, size_t ws_size, hipStream_t stream) {
    static int grid = 0;
    if (grid == 0) {
        if (n_in != 24 || out_size != (int)O_END || ws_size < WS_END) { fprintf(stderr, "kernel_launch: unexpected sizes n_in %d out %d ws %zu\n", n_in, out_size, ws_size); grid = -1; return; }
        int dev = 0, cus = 0;
        if (hipGetDevice(&dev) != hipSuccess || hipDeviceGetAttribute(&cus, hipDeviceAttributeMultiprocessorCount, dev) != hipSuccess) { grid = -1; return; }
        if (hipFuncSetAttribute((const void*)hymba_fwd, hipFuncAttributeMaxDynamicSharedMemorySize, LDS_BYTES) != hipSuccess) { fprintf(stderr, "kernel_launch: hipFuncSetAttribute failed\n"); grid = -1; return; }
        (void)hipGetLastError();
        grid = cus;
    }
    if (grid < 0) return;
    (void)hipMemsetAsync((char*)d_ws + WS_CTL, 0, CTL_ZERO_BYTES, stream);
    Args a{};
    for (int i = 0; i < 24; ++i) a.in[i] = (const float*)d_in[i];
    a.out = (float*)d_out; a.ws = (unsigned char*)d_ws;
#if MK_SINGLE
    a.ph_lo = 0; a.ph_hi = PH_COUNT;
    hipLaunchKernelGGL(hymba_fwd, dim3(grid), dim3(NTHREADS), LDS_BYTES, stream, a);
#else
    for (int p = 0; p < PH_COUNT; ++p) { a.ph_lo = p; a.ph_hi = p + 1; hipLaunchKernelGGL(hymba_fwd, dim3(grid), dim3(NTHREADS), LDS_BYTES, stream, a); }
#endif
}
```

```cpp
#include <hip/hip_runtime.h>
#include <cstdio>
#include <cstdint>
#include <cmath>
namespace pg8 {
#define PG8_LAS __attribute__((address_space(3)))
typedef unsigned short bf16_t;
typedef short bf16x8 __attribute__((ext_vector_type(8)));
typedef float f32x4 __attribute__((ext_vector_type(4)));
typedef unsigned u32x4 __attribute__((ext_vector_type(4)));
constexpr int BM = 256, BK = 64, HALF = 128, HTB = HALF * BK * 2  , STAGE_BYTES = 8 * HTB, NXCD = 8, WGM = 8;

__host__ __device__ __forceinline__ int lds_byte(int r, int c) { const int st = (r >> 4) * 2 + (c >> 5), rr = r & 15, cc = c & 31, ob = rr * 64 + cc * 2; return st * 1024 + (ob ^ (((ob >> 9) & 1) << 5)); }
__host__ __device__ __forceinline__ void stage_rc(int b, int& R, int& C) { const int st = b / 1024, sb = b % 1024, swz = sb ^ (((sb >> 9) & 1) << 5); R = (st >> 1) * 16 + swz / 64; C = (st & 1) * 32 + (swz % 64) / 2; }
__host__ __device__ __forceinline__ int perm32(int rho) { const int n = rho >> 4, i = rho & 15; return 8 * (i >> 2) + 4 * n + (i & 3); }

struct Unit { int pm, pn; };
struct Gemm { const bf16_t* A; const bf16_t* Bt; int M, N, K; };

struct StaticOrder {
    int nM, nN, nwg, G, c;
    __host__ __device__ void init(int M, int N, int G_, int c_) { nM = M / BM; nN = N / BM; nwg = nM * nN; G = G_; c = c_; }
    __host__ __device__ bool next(int i, Unit& u) const {
        const long L = (long)i * G + c; if (L >= nwg) return false;
        int wgid = (int)L; { const int q = nwg / NXCD, r = nwg % NXCD, xcd = wgid % NXCD, off = wgid / NXCD; wgid = (xcd < r ? xcd * (q + 1) : r * (q + 1) + (xcd - r) * q) + off; }
        const int nig = WGM * nN, gid = wgid / nig, fm = gid * WGM, gsz = (nM - fm) < WGM ? (nM - fm) : WGM;
        u.pm = fm + ((wgid % nig) % gsz); u.pn = (wgid % nig) / gsz; return true;
    }
    __device__ __forceinline__ void a_ready(const Unit&) const {}
    __device__ __forceinline__ void done(const Unit&) const {}
};

__device__ __forceinline__ unsigned cvt_pk_bf16(float lo, float hi) { unsigned r; asm volatile("v_cvt_pk_bf16_f32 %0, %1, %2" : "=v"(r) : "v"(lo), "v"(hi)); return r; }
typedef float f32x2 __attribute__((ext_vector_type(2)));
constexpr int MODLD_ = 49152;
__device__ __forceinline__ float fast_sigmoid(float x) { return __builtin_amdgcn_rcpf(1.0f + __expf(-x)); }
struct EpiZ {
    static constexpr bool PERM = true, AFTER_DRAIN = false;
    bf16_t* O; int ldc;
    __device__ __forceinline__ void operator()(const f32x4 (&acc)[2][2][4][2], const Unit& u, int wr, int wc, int fr, int fq) const {
        const int row0 = u.pm * BM + wr * 64 + fr, col0 = u.pn * BM + wc * 32 + 8 * fq;
#pragma unroll
        for (int ai = 0; ai < 2; ++ai)
#pragma unroll
            for (int m = 0; m < 4; ++m) { bf16_t* rowp = O + (size_t)(row0 + ai * HALF + m * 16) * ldc + col0;
#pragma unroll
                for (int bj = 0; bj < 2; ++bj) { const f32x4 v0 = acc[ai][bj][m][0], v1 = acc[ai][bj][m][1];
                    u32x4 w; w.x = cvt_pk_bf16(v0[0], v0[1]); w.y = cvt_pk_bf16(v0[2], v0[3]); w.z = cvt_pk_bf16(v1[0], v1[1]); w.w = cvt_pk_bf16(v1[2], v1[3]);
                    *(u32x4*)(rowp + bj * HALF) = w; } }
    }
};
struct EpiSwiGLU {
    static constexpr bool PERM = true, AFTER_DRAIN = false;
    bf16_t* O; int ldc;
    __device__ __forceinline__ void operator()(const f32x4 (&acc)[2][2][4][2], const Unit& u, int wr, int wc, int fr, int fq) const {
        const int row0 = u.pm * BM + wr * 64 + fr, col0 = u.pn * HALF + wc * 32 + 8 * fq;
#pragma unroll
        for (int ai = 0; ai < 2; ++ai)
#pragma unroll
            for (int m = 0; m < 4; ++m) { bf16_t* rowp = O + (size_t)(row0 + ai * HALF + m * 16) * ldc + col0;
                float r[8];
#pragma unroll
                for (int n = 0; n < 2; ++n)
#pragma unroll
                    for (int i = 0; i < 4; ++i) { const float g = acc[ai][0][m][n][i], up = acc[ai][1][m][n][i]; r[n * 4 + i] = g * fast_sigmoid(g) * up; }
                u32x4 w; w.x = cvt_pk_bf16(r[0], r[1]); w.y = cvt_pk_bf16(r[2], r[3]); w.z = cvt_pk_bf16(r[4], r[5]); w.w = cvt_pk_bf16(r[6], r[7]);
                *(u32x4*)rowp = w; }
    }
};
struct EpiResid {
    static constexpr bool PERM = false, AFTER_DRAIN = false;
    float* X; const float* gate; float* XS;
    __device__ __forceinline__ void operator()(const f32x4 (&acc)[2][2][4][2], const Unit& u, int wr, int wc, int fr, int fq) const {
        const int col0 = u.pn * BM + wc * 32 + 4 * fq;
        if (u.pm < 32) {
            const float* g = gate + (size_t)(u.pm >> 3) * MODLD_ + col0;
            f32x4 gv[2][2];
#pragma unroll
            for (int bj = 0; bj < 2; ++bj)
#pragma unroll
                for (int n = 0; n < 2; ++n) gv[bj][n] = *(const f32x4*)(g + bj * HALF + n * 16);
#pragma unroll
            for (int ai = 0; ai < 2; ++ai)
#pragma unroll
                for (int m = 0; m < 4; ++m) { const size_t xo = (size_t)(u.pm * BM + ai * HALF + wr * 64 + m * 16 + fr) * 2048 + col0; const float* xp = X + xo; float* xs = XS + xo;
#pragma unroll
                    for (int bj = 0; bj < 2; ++bj)
#pragma unroll
                        for (int n = 0; n < 2; ++n) { f32x4 xv = *(const f32x4*)(xp + bj * HALF + n * 16); xv = xv + gv[bj][n] * acc[ai][bj][m][n]; *(f32x4*)(xs + bj * HALF + n * 16) = xv; } }
        } else {
#pragma unroll
            for (int m = 0; m < 4; ++m) { const int rl = wr * 64 + m * 16 + fr;
                const float* g = gate + (size_t)(4 + (rl >> 2)) * MODLD_ + col0; float* xp = X + (size_t)(8192 + rl) * 2048 + col0;
#pragma unroll
                for (int bj = 0; bj < 2; ++bj)
#pragma unroll
                    for (int n = 0; n < 2; ++n) { const f32x4 gvv = *(const f32x4*)(g + bj * HALF + n * 16); f32x4 xv = *(const f32x4*)(xp + bj * HALF + n * 16);
                        xv = xv + gvv * acc[0][bj][m][n]; *(f32x4*)(xp + bj * HALF + n * 16) = xv; } }
        }
    }
};
struct EpiMod {
    static constexpr bool PERM = false, AFTER_DRAIN = false;
    float* M; const float* bias;
    __device__ __forceinline__ void operator()(const f32x4 (&acc)[2][2][4][2], const Unit& u, int wr, int wc, int fr, int fq) const {
        if (wr != 0) return;
        const int col0 = u.pn * BM + wc * 32 + 4 * fq;
#pragma unroll
        for (int m = 0; m < 3; ++m) { const int r = m * 16 + fr;
            if (r < 36) {
#pragma unroll
                for (int bj = 0; bj < 2; ++bj)
#pragma unroll
                    for (int n = 0; n < 2; ++n) { const f32x4 bv = *(const f32x4*)(bias + col0 + bj * HALF + n * 16);
                        *(f32x4*)(M + (size_t)r * MODLD_ + col0 + bj * HALF + n * 16) = acc[0][bj][m][n] + bv; } } }
    }
};

template <class Epi, class Sched, bool ALIGN_EPI = false, bool SP2 = false>
__device__ __forceinline__ void gemm_phase(PG8_LAS unsigned char* lds, const Gemm g, const Sched& S, const Epi& E, int wid_in) {
    int lane_ = (int)__builtin_amdgcn_mbcnt_hi(~0u, __builtin_amdgcn_mbcnt_lo(~0u, 0u)); asm volatile("" : "+v"(lane_));
    const int wid = __builtin_amdgcn_readfirstlane(wid_in), lane = lane_, tid = wid * 64 + lane, wr = wid >> 2, wc = wid & 3, fr = lane & 15, fq = lane >> 4;
    int K_ = g.K; asm volatile("" : "+s"(K_));
    const int K = K_, nt = K / BK;
    unsigned voffA[2], voffB[2];
#pragma unroll
    for (int i = 0; i < 2; ++i) { int R, C; stage_rc(tid * 16 + i * 8192, R, C); const int Rb = Epi::PERM ? ((R & ~31) + perm32(R & 31)) : R;
        voffA[i] = (unsigned)(R * K + C) * 2u; voffB[i] = (unsigned)(Rb * K + C) * 2u; }
    const size_t kstep = (size_t)(BK * 2);
    const size_t hstep = (size_t)HALF * K * 2;
    const size_t tstep = 2 * hstep;
    const unsigned ldsw = (unsigned)wid * 1024u;
    const int aoff = lds_byte(wr * 64 + fr, fq * 8), boff = lds_byte(wc * 32 + fr, fq * 8);
#define PG8_SA(b, h) (((b) * 2 + (h)) * HTB)
#define PG8_SB(b, h) ((4 + (b) * 2 + (h)) * HTB)
#define PG8_STAGE(bufoff, gbase, voff) do { _Pragma("unroll") for (int _i = 0; _i < 2; ++_i) \
        __builtin_amdgcn_global_load_lds((const unsigned*)((const char*)(gbase) + (voff)[_i]), (PG8_LAS unsigned*)(lds + (bufoff) + ldsw + _i * 8192), 16, 0, 0); } while (0)
#define PG8_LDA(dst, b, h) do { _Pragma("unroll") for (int m = 0; m < 4; ++m) _Pragma("unroll") for (int k = 0; k < 2; ++k) dst[m][k] = *(const PG8_LAS bf16x8*)(lds + PG8_SA(b, h) + aoff + m * 2048 + k * 1024); } while (0)
#define PG8_LDB(dst, b, h) do { _Pragma("unroll") for (int n = 0; n < 2; ++n) _Pragma("unroll") for (int k = 0; k < 2; ++k) dst[n][k] = *(const PG8_LAS bf16x8*)(lds + PG8_SB(b, h) + boff + n * 2048 + k * 1024); } while (0)
#define PG8_MMA(ai, bj, At, Bt) do { __builtin_amdgcn_s_setprio(1); _Pragma("unroll") for (int m = 0; m < 4; ++m) _Pragma("unroll") for (int n = 0; n < 2; ++n) _Pragma("unroll") for (int k = 0; k < 2; ++k) \
        acc[ai][bj][m][n] = __builtin_amdgcn_mfma_f32_16x16x32_bf16(Bt[n][k], At[m][k], acc[ai][bj][m][n], 0, 0, 0); __builtin_amdgcn_s_setprio(0); } while (0)
#define PG8_WAIT_V(n) asm volatile("s_waitcnt vmcnt(" #n ")" ::: "memory")
#define PG8_WAIT_L(n) asm volatile("s_waitcnt lgkmcnt(" #n ")" ::: "memory")
#define PG8_BAR __builtin_amdgcn_s_barrier()
#define PG8_SCHED __builtin_amdgcn_sched_barrier(0)
    Unit cur, nxt; int ui = 0;
    if (!S.next(0, cur)) return;
    f32x4 acc[2][2][4][2];
#pragma unroll
    for (int a = 0; a < 2; ++a)
#pragma unroll
        for (int b = 0; b < 2; ++b)
#pragma unroll
            for (int m = 0; m < 4; ++m)
#pragma unroll
                for (int n = 0; n < 2; ++n) acc[a][b][m][n] = (f32x4){0.f, 0.f, 0.f, 0.f};
    bf16x8 At[4][2], B0[2][2], B1[2][2];
    const char* cA = (const char*)g.A + (size_t)cur.pm * tstep; const char* cB = (const char*)g.Bt + (size_t)cur.pn * tstep;
    S.a_ready(cur);
    if constexpr (SP2) {
        PG8_STAGE(PG8_SB(0, 0), cB, voffB); PG8_STAGE(PG8_SB(0, 1), cB + hstep, voffB); PG8_STAGE(PG8_SA(0, 0), cA, voffA); PG8_STAGE(PG8_SA(0, 1), cA + hstep, voffA);
        if (wr == 1) PG8_BAR;
        PG8_WAIT_V(2); PG8_BAR;
        PG8_STAGE(PG8_SB(1, 0), cB + kstep, voffB); PG8_STAGE(PG8_SA(1, 0), cA + kstep, voffA); PG8_STAGE(PG8_SB(1, 1), cB + hstep + kstep, voffB);
        PG8_WAIT_V(6); PG8_BAR;
    } else {
        PG8_STAGE(PG8_SB(0, 0), cB, voffB); PG8_STAGE(PG8_SA(0, 0), cA, voffA); PG8_STAGE(PG8_SB(0, 1), cB + hstep, voffB); PG8_STAGE(PG8_SA(0, 1), cA + hstep, voffA);
        if (wr == 1) PG8_BAR;
        PG8_WAIT_V(4); PG8_BAR;
        PG8_STAGE(PG8_SB(1, 0), cB + kstep, voffB); PG8_STAGE(PG8_SA(1, 0), cA + kstep, voffA); PG8_STAGE(PG8_SB(1, 1), cB + hstep + kstep, voffB);
        PG8_WAIT_V(6); PG8_BAR;
    }
    for (;;) {
        const bool has_next = S.next(ui + 1, nxt);
        const char* nA = has_next ? (const char*)g.A + (size_t)nxt.pm * tstep : cA; const char* nB = has_next ? (const char*)g.Bt + (size_t)nxt.pn * tstep : cB;
        for (int t = 0; t < nt; t += 2) {
            const bool last = (t == nt - 2);
            const char* a1 = cA + (size_t)(t + 1) * kstep;
            const char* a2 = last ? nA : cA + (size_t)(t + 2) * kstep; const char* b2 = last ? nB : cB + (size_t)(t + 2) * kstep;
            const char* a3 = a2 + kstep; const char* b3 = b2 + kstep;
            if (last && has_next) S.a_ready(nxt);
            if constexpr (SP2) {
            PG8_LDB(B0, 0, 0); PG8_LDB(B1, 0, 1); PG8_SCHED; PG8_LDA(At, 0, 0); PG8_STAGE(PG8_SA(1, 1), a1 + hstep, voffA);
            PG8_WAIT_V(8); PG8_WAIT_L(0); PG8_BAR; PG8_MMA(0, 0, At, B0); PG8_MMA(0, 1, At, B1); PG8_BAR; PG8_SCHED;
            PG8_LDA(At, 0, 1); PG8_STAGE(PG8_SB(0, 0), b2, voffB); PG8_STAGE(PG8_SB(0, 1), b2 + hstep, voffB); PG8_STAGE(PG8_SA(0, 0), a2, voffA);
            PG8_WAIT_V(8); PG8_WAIT_L(0); PG8_BAR; PG8_MMA(1, 0, At, B0); PG8_MMA(1, 1, At, B1); PG8_BAR; PG8_SCHED;
            PG8_LDB(B0, 1, 0); PG8_LDB(B1, 1, 1); PG8_SCHED; PG8_LDA(At, 1, 0); PG8_STAGE(PG8_SA(0, 1), a2 + hstep, voffA);
            PG8_WAIT_V(8); PG8_WAIT_L(0); PG8_BAR; PG8_MMA(0, 0, At, B0); PG8_MMA(0, 1, At, B1); PG8_BAR; PG8_SCHED;
            PG8_LDA(At, 1, 1); PG8_STAGE(PG8_SB(1, 0), b3, voffB); PG8_STAGE(PG8_SB(1, 1), b3 + hstep, voffB); PG8_STAGE(PG8_SA(1, 0), a3, voffA);
            PG8_WAIT_V(8); PG8_WAIT_L(0); PG8_BAR; PG8_MMA(1, 0, At, B0); PG8_MMA(1, 1, At, B1); PG8_BAR; PG8_SCHED;
            } else {
            PG8_LDB(B0, 0, 0); PG8_SCHED; PG8_LDA(At, 0, 0); PG8_STAGE(PG8_SA(1, 1), a1 + hstep, voffA);
            PG8_WAIT_L(8); PG8_BAR; PG8_WAIT_L(0); PG8_MMA(0, 0, At, B0); PG8_BAR; PG8_SCHED;
            PG8_LDB(B1, 0, 1); PG8_STAGE(PG8_SB(0, 0), b2, voffB);
            PG8_BAR; PG8_WAIT_L(0); PG8_MMA(0, 1, At, B1); PG8_BAR;
            PG8_LDA(At, 0, 1); PG8_STAGE(PG8_SA(0, 0), a2, voffA);
            PG8_BAR; PG8_WAIT_L(0); PG8_MMA(1, 0, At, B0); PG8_BAR; PG8_SCHED;
            PG8_STAGE(PG8_SB(0, 1), b2 + hstep, voffB);
            PG8_WAIT_V(6); PG8_BAR; PG8_MMA(1, 1, At, B1); PG8_BAR;
            PG8_LDB(B0, 1, 0); PG8_SCHED; PG8_LDA(At, 1, 0); PG8_STAGE(PG8_SA(0, 1), a2 + hstep, voffA);
            PG8_WAIT_L(8); PG8_BAR; PG8_WAIT_L(0); PG8_MMA(0, 0, At, B0); PG8_BAR; PG8_SCHED;
            PG8_LDB(B1, 1, 1); PG8_STAGE(PG8_SB(1, 0), b3, voffB);
            PG8_BAR; PG8_WAIT_L(0); PG8_MMA(0, 1, At, B1); PG8_BAR;
            PG8_LDA(At, 1, 1); PG8_STAGE(PG8_SA(1, 0), a3, voffA);
            PG8_BAR; PG8_WAIT_L(0); PG8_MMA(1, 0, At, B0); PG8_BAR; PG8_SCHED;
            PG8_STAGE(PG8_SB(1, 1), b3 + hstep, voffB);
            PG8_WAIT_V(6); PG8_BAR; PG8_MMA(1, 1, At, B1); PG8_BAR;
            }
        }
        if constexpr (ALIGN_EPI) { if (wr == 0) PG8_BAR; }
        if constexpr (!Epi::AFTER_DRAIN) { E(acc, cur, wr, wc, fr, fq); S.done(cur); }
        if (!has_next) break;
#pragma unroll
        for (int a = 0; a < 2; ++a)
#pragma unroll
            for (int b = 0; b < 2; ++b)
#pragma unroll
                for (int m = 0; m < 4; ++m)
#pragma unroll
                    for (int n = 0; n < 2; ++n) acc[a][b][m][n] = (f32x4){0.f, 0.f, 0.f, 0.f};
        cur = nxt; cA = nA; cB = nB; ++ui;
        if constexpr (ALIGN_EPI) { if (wr == 1) PG8_BAR; }
    }
    PG8_WAIT_V(0);
    if constexpr (!ALIGN_EPI) { if (wr == 0) PG8_BAR; }
    PG8_BAR;
    if constexpr (Epi::AFTER_DRAIN) { E.fused(acc, cur, wr, wc, fr, fq, lds, wid, lane); S.done(cur); }
#undef PG8_SA
#undef PG8_SB
#undef PG8_STAGE
#undef PG8_LDA
#undef PG8_LDB
#undef PG8_MMA
#undef PG8_WAIT_V
#undef PG8_WAIT_L
#undef PG8_BAR
#undef PG8_SCHED
}
}
#define GAS __attribute__((address_space(1)))
#define LAS __attribute__((address_space(3)))
typedef unsigned short bf16;
typedef unsigned v4u __attribute__((ext_vector_type(4)));
typedef float f32x4 __attribute__((ext_vector_type(4)));
typedef short bf16x8 __attribute__((ext_vector_type(8)));
typedef GAS unsigned gu32;
typedef GAS unsigned long long gu64;
#define RLX_AGENT __ATOMIC_RELAXED, __HIP_MEMORY_SCOPE_AGENT
#define LDS_WAIT() asm volatile("s_waitcnt lgkmcnt(0)" ::: "memory")
#define VM_WAIT() asm volatile("s_waitcnt vmcnt(0)" ::: "memory")
__device__ __forceinline__ unsigned long long rt() { return __builtin_amdgcn_s_memrealtime(); }
__device__ __forceinline__ unsigned f2bf(float f) { unsigned u = __builtin_bit_cast(unsigned, f); return (u + 0x7fffu + ((u >> 16) & 1u)) >> 16; }
__device__ __forceinline__ unsigned pk2(float lo, float hi) { return f2bf(lo) | (f2bf(hi) << 16); }

#define XB_TMO      128
#define XB_XCNT(j)  (256  + 64 * (j))
#define XB_XSUB(j)  (1280 + 64 * (j))
#define XB_XGEN(j)  (2304 + 64 * (j))
#define XB_TOP      3328
#define XB_TOPGEN   3392
#define XCD_BAR_WORDS 3456
#define XB_SPIN_CAP (1u << 18)

__device__ __forceinline__ unsigned xb_ld(unsigned* p)              { return __hip_atomic_load(p, __ATOMIC_RELAXED, __HIP_MEMORY_SCOPE_AGENT); }
__device__ __forceinline__ unsigned xb_add(unsigned* p, unsigned v) { return __hip_atomic_fetch_add(p, v, __ATOMIC_RELAXED, __HIP_MEMORY_SCOPE_AGENT); }
__device__ __forceinline__ unsigned xb_xcc_id() { return (unsigned)__builtin_amdgcn_s_getreg((3 << 11) | 20) & 0xFu; }
#define XB_SPIN(cond, bar) do { unsigned _sp = 0; while (cond) { __builtin_amdgcn_s_sleep(1); \
    if ((++_sp & 255u) == 0u) { if (xb_ld(&(bar)[XB_TMO])) break; if (_sp > XB_SPIN_CAP) { atomicAdd(&(bar)[XB_TMO], 1u); break; } } } } while (0)

struct XcdBarrier {
    unsigned* bar; unsigned x;
    volatile LAS unsigned* st;
};

__device__ __forceinline__ XcdBarrier xcd_barrier_post(unsigned* bar, volatile LAS unsigned* st) {
    XcdBarrier b; b.bar = bar; b.x = xb_xcc_id(); b.st = st;
    if (threadIdx.x == 0) (void)xb_add(&bar[XB_XCNT(b.x)], 1u);
    return b;
}
__device__ __forceinline__ void xcd_barrier_complete(unsigned* bar, unsigned x, unsigned& nloc, unsigned& nx) {
    const unsigned G = gridDim.x * gridDim.y * gridDim.z;
    unsigned sum, cnt, mine, sp = 0u;
    for (;;) {
        sum = 0u; cnt = 0u; mine = 0u;
#pragma unroll
        for (unsigned j = 0; j < 16; ++j) { const unsigned c = xb_ld(&bar[XB_XCNT(j)]); sum += c; cnt += (c > 0u) ? 1u : 0u; mine = (j == x) ? c : mine; }
        if (sum == G) break;
        __builtin_amdgcn_s_sleep(1);
        if ((++sp & 255u) == 0u) { if (xb_ld(&bar[XB_TMO])) break; if (sp > XB_SPIN_CAP) { atomicAdd(&bar[XB_TMO], 1u); break; } }
    }
    nloc = mine > 0u ? mine : 1u; nx = cnt > 0u ? cnt : 1u;
}

__device__ __forceinline__ void xcd_barrier(const XcdBarrier& b) {
    asm volatile("s_waitcnt vmcnt(0)" ::: "memory");
    __syncthreads();
    if (threadIdx.x == 0) {
        unsigned* bar = b.bar;
        __builtin_amdgcn_s_waitcnt(0);
        unsigned nloc = b.st[0], nx = b.st[1];
        if (nloc == 0u) { xcd_barrier_complete(bar, b.x, nloc, nx); b.st[0] = nloc; b.st[1] = nx; }
        const unsigned old = xb_add(&bar[XB_XSUB(b.x)], 1u);
        const unsigned gen = old / nloc;
        if (old + 1u == (gen + 1u) * nloc) {
            __builtin_amdgcn_fence(__ATOMIC_RELEASE, "agent");
            asm volatile("s_waitcnt vmcnt(0)" ::: "memory");
            const unsigned og = xb_add(&bar[XB_TOP], 1u);
            const unsigned tg = og / nx;
            if (og + 1u == (tg + 1u) * nx) xb_add(&bar[XB_TOPGEN], 1u);
            else XB_SPIN(xb_ld(&bar[XB_TOPGEN]) == tg, bar);
            __builtin_amdgcn_fence(__ATOMIC_ACQUIRE, "agent");
            xb_add(&bar[XB_XGEN(b.x)], 1u);
            asm volatile("s_waitcnt vmcnt(0)" ::: "memory");
        } else {
            XB_SPIN(xb_ld(&bar[XB_XGEN(b.x)]) == gen, bar);
            __builtin_amdgcn_fence(__ATOMIC_ACQUIRE, "agent");
            asm volatile("s_waitcnt vmcnt(0)" ::: "memory");
        }
    }
    __syncthreads();
}

constexpr int NWAVES = 8, NTHREADS = 512;
constexpr int DM = 2048, NP_ROWS = 8192, NS_ROWS = 128, NROWS = 8320, MPAD = 8448;
constexpr int DEPTH = 4, NBATCH = 36;
constexpr int INW = 4368, ZW = 4608;
constexpr int ZQ = 0, ZK = 512, ZV = 640, ZU = 768, GQ = 1280, GK = 1792, GV = 2304, GG = 3328, GA = 4352;
constexpr int DFF = 5632, NGU = 11264, MODW = 12288, MODLD = 49152;
constexpr float EPS = 1e-6f;
constexpr size_t O_Y = 0, O_WK_P = 17039360, O_WV_P = 17301504, O_POOL_P = 17563648, O_GLA_P = 17686528,
                 O_WK_S = 19783680, O_WV_S = 21880832, O_POOL_S = 23977984, O_GLA_S = 24961024, O_END = 41738240;
constexpr size_t MiB = 1u << 20;
constexpr size_t WS_CTL = 0, CTL_ZERO_BYTES = 1 * MiB;
constexpr size_t WS_WADA = 1 * MiB;
constexpr size_t WS_WIN  = WS_WADA + 192 * MiB;
constexpr size_t WS_WOUT = WS_WIN + 72 * MiB;
constexpr size_t WS_WGU  = WS_WOUT + 32 * MiB;
constexpr size_t WS_WDN  = WS_WGU + 176 * MiB;
constexpr size_t WS_X    = WS_WDN + 88 * MiB;
constexpr size_t WS_H    = WS_X + 66 * MiB;
constexpr size_t WS_Z    = WS_H + 33 * MiB;
constexpr size_t WS_MIX  = WS_Z + 75 * MiB;
constexpr size_t WS_ACT  = WS_MIX + 33 * MiB;
constexpr size_t WS_OGLA = WS_ACT + 91 * MiB;
constexpr size_t WS_LA   = WS_OGLA + 33 * MiB;
constexpr size_t WS_MOD  = WS_LA + 17 * MiB;
constexpr size_t WS_SC   = WS_MOD + 7 * MiB;
constexpr size_t WS_BTAB = WS_SC + 1 * MiB;
constexpr size_t WS_WPT  = WS_BTAB + 1 * MiB;
constexpr size_t WS_QDG  = WS_WPT + 1 * MiB;
constexpr size_t WS_KDTG = WS_QDG + 9 * MiB;
constexpr size_t WS_VTG  = WS_KDTG + 11 * MiB;
constexpr size_t WS_DLG  = WS_VTG + 21 * MiB;
constexpr size_t WS_DUMMY = WS_DLG + 1 * MiB;
constexpr size_t WS_END  = WS_DUMMY + 66 * MiB;
constexpr int CW_BAR = 4096;
constexpr int RING_OFF = 0, RING_BYTES = 131072;
constexpr int LDSCTL_OFF = RING_BYTES, MISC_OFF = LDSCTL_OFF + 320;
constexpr int LDS_BYTES = 147456;

struct Args { const float* in[24]; float* out; unsigned char* ws; int ph_lo, ph_hi; };
struct Frame {
    LAS unsigned char* lds;
    volatile LAS unsigned* MISC;
    int wave, vcu, G; int zo; int probe;
    __device__ __forceinline__ float* X_ST() const { return (float*)(ws + (probe ? WS_DUMMY : WS_X)); }
    __device__ __forceinline__ float* OGLA_ST() const { return (float*)(ws + (probe ? WS_DUMMY : WS_OGLA)); }
    __device__ __forceinline__ int lane_id() const { return (int)__builtin_amdgcn_mbcnt_hi(~0u, __builtin_amdgcn_mbcnt_lo(~0u, 0u)); }
    unsigned char* ws; float* out;
    __device__ __forceinline__ bf16* Wada_t() const { return (bf16*)(ws + WS_WADA); }
    __device__ __forceinline__ bf16* Win_t() const { return (bf16*)(ws + WS_WIN); }
    __device__ __forceinline__ bf16* Wout_t() const { return (bf16*)(ws + WS_WOUT); }
    __device__ __forceinline__ bf16* Wgu_t() const { return (bf16*)(ws + WS_WGU); }
    __device__ __forceinline__ bf16* Wdn_t() const { return (bf16*)(ws + WS_WDN); }
    __device__ __forceinline__ float* X() const { return (float*)(ws + WS_X); }
    __device__ __forceinline__ bf16* H() const { return (bf16*)(ws + WS_H); }
    __device__ __forceinline__ bf16* Z() const { return (bf16*)(ws + WS_Z); }
    __device__ __forceinline__ bf16* MIX() const { return (bf16*)(ws + WS_MIX); }
    __device__ __forceinline__ bf16* ACT() const { return (bf16*)(ws + WS_ACT); }
    __device__ __forceinline__ float* OGLA() const { return (float*)(ws + WS_OGLA); }
    __device__ __forceinline__ float* SLOC() const { return (float*)(ws + WS_LA); }
    __device__ __forceinline__ float* DSEG() const { return (float*)(ws + WS_LA + 16 * MiB); }
    __device__ __forceinline__ float* MOD() const { return (float*)(ws + WS_MOD); }
    __device__ __forceinline__ bf16* SC() const { return (bf16*)(ws + WS_SC); }
    __device__ __forceinline__ float* BTAB() const { return (float*)(ws + WS_BTAB); }
    __device__ __forceinline__ bf16* WPT() const { return (bf16*)(ws + WS_WPT); }
    __device__ __forceinline__ bf16* QDG() const { return (bf16*)(ws + WS_QDG); }
    __device__ __forceinline__ bf16* KDTG() const { return (bf16*)(ws + WS_KDTG); }
    __device__ __forceinline__ bf16* VTG() const { return (bf16*)(ws + WS_VTG); }
    __device__ __forceinline__ float* DLG() const { return (float*)(ws + WS_DLG); }
};
enum { I_XP = 0, I_XS, I_CK, I_CV, I_SPOOL, I_SGLA, I_CP, I_CS, I_WADA, I_BADA, I_GMIX, I_GFFN, I_WIN, I_WOUT, I_RELB, I_SINKS, I_WPOOL, I_PSCALE, I_WA2, I_BA2, I_GGLA, I_WGU, I_WDN, I_GFIN };

__device__ __forceinline__ float bf2f(unsigned short b) { return __uint_as_float((unsigned)b << 16); }
__device__ __forceinline__ float bflo(unsigned w) { return __uint_as_float(w << 16); }
__device__ __forceinline__ float bfhi(unsigned w) { return __uint_as_float(w & 0xffff0000u); }
__device__ __forceinline__ float wave_sum(float v) {
#pragma unroll
    for (int o = 1; o < 64; o <<= 1) v += __shfl_xor(v, o);
    return v;
}
__device__ __forceinline__ float wave_max(float v) {
#pragma unroll
    for (int o = 1; o < 64; o <<= 1) v = fmaxf(v, __shfl_xor(v, o));
    return v;
}
__device__ __forceinline__ int t5_bucket(int n) {
    if (n < 16) return n;
    return 16 + (n >= 19) + (n >= 21) + (n >= 24) + (n >= 27) + (n >= 31) + (n >= 35) + (n >= 40) + (n >= 46) + (n >= 52) + (n >= 59) + (n >= 67) + (n >= 77) + (n >= 87) + (n >= 99) + (n >= 113);
}

template <int MODE>
__device__ __forceinline__ void transpose_item(const float* W, int K, int N, int nblk, bf16* WT, int row_off, LAS float* scr, int item, int lane) {
    const int kb = item / nblk, nb = item % nblk, k0 = 64 * kb, n0 = 32 * nb;
    const int nn = n0 + (lane & 31); const bool ok = nn < N;
    float wv[32];
#pragma unroll
    for (int i = 0; i < 32; ++i) { const int kk = 2 * i + (lane >> 5); wv[i] = ok ? W[(size_t)(k0 + kk) * N + nn] : 0.f; }
#pragma unroll
    for (int i = 0; i < 32; ++i) { const int kk = 2 * i + (lane >> 5); scr[kk * 33 + (lane & 31)] = wv[i]; }
    LDS_WAIT(); asm volatile("" ::: "memory");
    const int c = lane & 7;
#pragma unroll
    for (int j = 0; j < 4; ++j) { const int n = (lane >> 3) + 8 * j; const LAS float* s = scr + (8 * c) * 33 + n;
        v4u o; o.x = pk2(s[0 * 33], s[1 * 33]); o.y = pk2(s[2 * 33], s[3 * 33]); o.z = pk2(s[4 * 33], s[5 * 33]); o.w = pk2(s[6 * 33], s[7 * 33]);
        int orow = n0 + n;
        if (MODE == 1) { orow = (orow < DFF) ? ((orow >> 7) * 256 + (orow & 127)) : (((orow - DFF) >> 7) * 256 + 128 + ((orow - DFF) & 127)); }
        *(GAS v4u*)(WT + (size_t)(row_off + orow) * K + k0 + 8 * c) = o; }
    LDS_WAIT(); asm volatile("" ::: "memory");
}
__device__ __forceinline__ void p0_prologue(Frame& F, const Args& A) {
    LAS float* scr = (LAS float*)(F.lds + RING_OFF + F.wave * 16384);
    const int gw = F.vcu * NWAVES + F.wave, NGW = F.G * NWAVES;
    const int gt = gw * 64 + F.lane_id(), NGT = NGW * 64;
    constexpr int I_ADA = 32 * 384, I_IN = 32 * 137, I_OUT = 32 * 64, I_GU = 32 * 352, I_DN = 88 * 64, I_L = I_ADA + I_IN + I_OUT + I_GU + I_DN;
    for (int it = gw; it < DEPTH * I_L; it += NGW) {
        const int l = it / I_L; int r = it - l * I_L;
        if (r < I_ADA) { transpose_item<0>(A.in[F.zo + I_WADA] + (size_t)l * DM * MODW, DM, MODW, 384, F.Wada_t(), l * MODW, scr, r, F.lane_id()); continue; } r -= I_ADA;
        if (r < I_IN)  { transpose_item<0>(A.in[F.zo + I_WIN] + (size_t)l * DM * INW, DM, INW, 137, F.Win_t() + (size_t)l * ZW * DM, 0, scr, r, F.lane_id()); continue; } r -= I_IN;
        if (r < I_OUT) { transpose_item<0>(A.in[F.zo + I_WOUT] + (size_t)l * DM * DM, DM, DM, 64, F.Wout_t() + (size_t)l * DM * DM, 0, scr, r, F.lane_id()); continue; } r -= I_OUT;
        if (r < I_GU)  { transpose_item<1>(A.in[F.zo + I_WGU] + (size_t)l * DM * NGU, DM, NGU, 352, F.Wgu_t() + (size_t)l * NGU * DM, 0, scr, r, F.lane_id()); continue; } r -= I_GU;
        transpose_item<0>(A.in[F.zo + I_WDN] + (size_t)l * DFF * DM, DFF, DM, 64, F.Wdn_t() + (size_t)l * DM * DFF, 0, scr, r, F.lane_id());
    }
    const v4u z4 = {0u, 0u, 0u, 0u};
    for (int i = gt; i < DEPTH * 224 * 256; i += NGT) { const int l = i / (224 * 256), r = i - l * (224 * 256); *((GAS v4u*)(F.Win_t() + ((size_t)l * ZW + 4384) * DM) + r) = z4; }
    for (int i = gt; i < 128 * 256; i += NGT) { *((GAS v4u*)(F.H() + (size_t)NROWS * DM) + i) = z4; *((GAS v4u*)(F.MIX() + (size_t)NROWS * DM) + i) = z4; }
    for (int i = gt; i < 128 * 704; i += NGT) *((GAS v4u*)(F.ACT() + (size_t)NROWS * DFF) + i) = z4;
    for (int i = gt; i < NP_ROWS * 512; i += NGT) ((GAS f32x4*)F.X())[i] = ((const GAS f32x4*)A.in[F.zo + I_XP])[i];
    for (int i = gt; i < NS_ROWS * 512; i += NGT) ((GAS f32x4*)(F.X() + (size_t)NP_ROWS * DM))[i] = ((const GAS f32x4*)A.in[F.zo + I_XS])[i];
    for (int i = gt; i < 256 * 1024; i += NGT) { const int r = i >> 10, cp = (i & 1023) * 2; unsigned w = 0u;
        if (r < NBATCH) { const float* c = (r < 4) ? (A.in[F.zo + I_CP] + (size_t)r * DM) : (A.in[F.zo + I_CS] + (size_t)(r - 4) * DM); const float a = c[cp], b = c[cp + 1];
            w = pk2(a / (1.0f + __expf(-a)), b / (1.0f + __expf(-b))); }
        ((GAS unsigned*)F.SC())[i] = w; }
    for (int i = gt; i < 4 * 4 * 128 * 128; i += NGT) { const int lg = i >> 14, dcol = (i >> 7) & 127, c = i & 127; F.WPT()[i] = (bf16)f2bf(A.in[F.zo + I_WPOOL][((size_t)lg * 128 + c) * 128 + dcol]); }
    for (int i = gt; i < 8 * 128; i += NGT) { const int h = i >> 7, dist = i & 127; F.BTAB()[i] = A.in[F.zo + I_RELB][t5_bucket(dist) * 8 + h]; }
}

__device__ __forceinline__ void norm_mod_rows(Frame& F, const float* g, const float* modl  ) {
    const int gw = F.vcu * NWAVES + F.wave, NGW = F.G * NWAVES;
    for (int r = gw; r < NROWS; r += NGW) {
        const int b = r < NP_ROWS ? (r >> 11) : 4 + ((r - NP_ROWS) >> 2);
        const float* xr = F.X() + (size_t)r * DM + 4 * F.lane_id(); const float* sh = modl + (size_t)b * MODLD + 4 * F.lane_id(); const float* gg = g + 4 * F.lane_id();
        f32x4 v[8]; float ss = 0.f;
#pragma unroll
        for (int j = 0; j < 8; ++j) { v[j] = *(const f32x4*)(xr + 256 * j); ss += (v[j].x * v[j].x + v[j].y * v[j].y) + (v[j].z * v[j].z + v[j].w * v[j].w); }
        const float rstd = 1.0f / sqrtf(wave_sum(ss) * (1.0f / DM) + EPS);
        bf16* hr = F.H() + (size_t)r * DM + 4 * F.lane_id();
#pragma unroll
        for (int j = 0; j < 8; ++j) { const f32x4 gv = *(const f32x4*)(gg + 256 * j), sv = *(const f32x4*)(sh + 256 * j), cv = *(const f32x4*)(sh + 2048 + 256 * j);
            const f32x4 y = (v[j] * rstd * gv) * (1.0f + cv) + sv;
            uint2 w; w.x = pk2(y.x, y.y); w.y = pk2(y.z, y.w); *(uint2*)(hr + 256 * j) = w; }
    }
}
__device__ __forceinline__ void final_norm_rows(Frame& F, const Args& A) {
    const int gw = F.vcu * NWAVES + F.wave, NGW = F.G * NWAVES; const float* g = A.in[F.zo + I_GFIN] + 4 * F.lane_id();
    for (int r = gw; r < NROWS; r += NGW) {
        const float* xr = F.X() + (size_t)r * DM + 4 * F.lane_id();
        f32x4 v[8]; float ss = 0.f;
#pragma unroll
        for (int j = 0; j < 8; ++j) { v[j] = *(const f32x4*)(xr + 256 * j); ss += (v[j].x * v[j].x + v[j].y * v[j].y) + (v[j].z * v[j].z + v[j].w * v[j].w); }
        const float rstd = 1.0f / sqrtf(wave_sum(ss) * (1.0f / DM) + EPS);
        float* yr = F.out + O_Y + (size_t)r * DM + 4 * F.lane_id();
#pragma unroll
        for (int j = 0; j < 8; ++j) { const f32x4 gv = *(const f32x4*)(g + 256 * j); *(f32x4*)(yr + 256 * j) = v[j] * rstd * gv; }
    }
}

__device__ __forceinline__ void attn_item(Frame& F, const Args& A, int l, int r, int hd, LAS float* ps) {
    const int lane = F.lane_id(), g = hd >> 2; const bool smp = r >= NP_ROWS;
    const int t = r & 2047, sb = smp ? ((r - NP_ROWS) >> 2) : 0, si = (r - NP_ROWS) & 3;
    LAS float* qs = ps + 128;
    { const unsigned w = ((const unsigned*)(F.Z() + (size_t)r * ZW + ZQ + hd * 64))[lane & 31]; if (lane < 32) { qs[2 * lane] = bflo(w); qs[2 * lane + 1] = bfhi(w); } }
    LDS_WAIT(); asm volatile("" ::: "memory");
    const float* ck = A.in[F.zo + I_CK] + ((size_t)(l * 32 + sb) * 128) * 128 + g * 64;
    const float* cv = A.in[F.zo + I_CV] + ((size_t)(l * 32 + sb) * 128) * 128 + g * 64;
    const int jmin = smp ? 0 : (t >= 127 ? 0 : 127 - t);
    float sc[2];
#pragma unroll 1
    for (int jj = 0; jj < 2; ++jj) {
        const int j = lane + 64 * jj, dist = 127 - j; float dot = 0.f; bool valid = j >= jmin;
        if (valid) {
            const int krel = si - dist;
            if (smp && krel < 0) {
                const f32x4* kp = (const f32x4*)(ck + (size_t)(krel + 128) * 128);
#pragma unroll 4
                for (int c = 0; c < 16; ++c) { const f32x4 kv = kp[c]; const f32x4 qv = *(const LAS f32x4*)(qs + 4 * c); dot += qv.x * kv.x + qv.y * kv.y + qv.z * kv.z + qv.w * kv.w; }
            } else {
                const int krow = smp ? (NP_ROWS + sb * 4 + krel) : (r - dist);
                const v4u* kp = (const v4u*)(F.Z() + (size_t)krow * ZW + ZK + g * 64);
#pragma unroll 4
                for (int c = 0; c < 8; ++c) { const v4u w = kp[c];
                    const f32x4 qa = *(const LAS f32x4*)(qs + 8 * c), qb = *(const LAS f32x4*)(qs + 8 * c + 4);
                    dot += qa.x * bflo(w.x) + qa.y * bfhi(w.x) + qa.z * bflo(w.y) + qa.w * bfhi(w.y) + qb.x * bflo(w.z) + qb.y * bfhi(w.z) + qb.z * bflo(w.w) + qb.w * bfhi(w.w); }
            }
        }
        const float sv = valid ? dot * 0.125f + F.BTAB()[hd * 128 + dist] : -INFINITY;
        if (jj == 0) sc[0] = sv; else sc[1] = sv;
    }
    const float sink = A.in[F.zo + I_SINKS][l * 8 + hd];
    const float m = fmaxf(wave_max(fmaxf(sc[0], sc[1])), sink);
    const float p0 = __expf(sc[0] - m), p1 = __expf(sc[1] - m);
    const float denom = wave_sum(p0 + p1) + __expf(sink - m);
    ps[lane] = p0; ps[lane + 64] = p1;
    LDS_WAIT(); asm volatile("" ::: "memory");
    float o = 0.f;
#pragma unroll 4
    for (int j = jmin; j < 128; ++j) {
        const float pj = ps[j]; const int dist = 127 - j; float vv;
        const int krel = si - dist;
        if (smp && krel < 0) vv = cv[(size_t)(krel + 128) * 128 + lane];
        else { const int krow = smp ? (NP_ROWS + sb * 4 + krel) : (r - dist); vv = bf2f(F.Z()[(size_t)krow * ZW + ZV + g * 64 + lane]); }
        o += pj * vv;
    }
    F.MIX()[(size_t)r * DM + hd * 64 + lane] = (bf16)f2bf(o / denom);
    LDS_WAIT(); asm volatile("" ::: "memory");
}
__device__ __forceinline__ void pool_item(Frame& F, const Args& A, int l, int r, int gi, LAS float* ds) {
    const int lane = F.lane_id(), w = 2 << gi; const bool smp = r >= NP_ROWS;
    const int t = r & 2047, sb = (r - NP_ROWS) >> 2, si = (r - NP_ROWS) & 3;
    const float* pbuf = A.in[F.zo + I_SPOOL] + ((size_t)(l * 32 + sb) * 15) * 512 + gi * 128;
    float s0 = 0.f, s1 = 0.f, u0 = 0.f, u1 = 0.f;
#pragma unroll 4
    for (int o = 0; o < w; ++o) {
        float a0 = 0.f, a1 = 0.f;
        if (!smp) { if (t - o >= 0) { const bf16* zp = F.Z() + (size_t)(r - o) * ZW + ZU + gi * 128; a0 = bf2f(zp[lane]); a1 = bf2f(zp[lane + 64]); } }
        else { const int idx = si - o;
            if (idx >= 0) { const bf16* zp = F.Z() + (size_t)(NP_ROWS + sb * 4 + idx) * ZW + ZU + gi * 128; a0 = bf2f(zp[lane]); a1 = bf2f(zp[lane + 64]); }
            else { const float* bp = pbuf + (size_t)(15 + idx) * 512; a0 = bp[lane]; a1 = bp[lane + 64]; } }
        if (o == 0) { u0 = a0; u1 = a1; }
        s0 += a0; s1 += a1;
    }
    const float cnt = smp ? (float)w : (float)((t + 1) < w ? (t + 1) : w);
    ds[lane] = s0 / cnt - u0; ds[lane + 64] = s1 / cnt - u1;
    LDS_WAIT(); asm volatile("" ::: "memory");
    const float* wp = A.in[F.zo + I_WPOOL] + ((size_t)(l * 4 + gi) * 128) * 128;
    float y0 = 0.f, y1 = 0.f;
#pragma unroll 4
    for (int c = 0; c < 128; ++c) { const float dv = ds[c]; y0 += dv * wp[c * 128 + lane]; y1 += dv * wp[c * 128 + lane + 64]; }
    const float* psc = A.in[F.zo + I_PSCALE] + l * 512 + gi * 128;
    bf16* mp = F.MIX() + (size_t)r * DM + 512 + gi * 128;
    mp[lane] = (bf16)f2bf(y0 * psc[lane]); mp[lane + 64] = (bf16)f2bf(y1 * psc[lane + 64]);
    LDS_WAIT(); asm volatile("" ::: "memory");
}
__device__ __forceinline__ void cache_outputs(Frame& F, const Args& A, int l) {
    const int gt = (F.vcu * NWAVES + F.wave) * 64 + F.lane_id(), NGT = F.G * NWAVES * 64;
    for (int i = gt; i < 4 * 128 * 128; i += NGT) { const int b = i >> 14, j = (i >> 7) & 127, c = i & 127; const bf16* zr = F.Z() + (size_t)(b * 2048 + 1920 + j) * ZW;
        F.out[O_WK_P + (size_t)l * 65536 + i] = bf2f(zr[ZK + c]); F.out[O_WV_P + (size_t)l * 65536 + i] = bf2f(zr[ZV + c]); }
    for (int i = gt; i < 4 * 15 * 512; i += NGT) { const int b = i / 7680, rem = i - b * 7680, j = rem >> 9, c = rem & 511;
        F.out[O_POOL_P + (size_t)l * 30720 + i] = bf2f(F.Z()[(size_t)(b * 2048 + 2033 + j) * ZW + ZU + c]); }
    for (int i = gt; i < 32 * 128 * 128; i += NGT) { const int sb = i >> 14, p = (i >> 7) & 127, c = i & 127; float kv, vv;
        if (p < 124) { const size_t src = ((size_t)(l * 32 + sb) * 128 + p + 4) * 128 + c; kv = A.in[F.zo + I_CK][src]; vv = A.in[F.zo + I_CV][src]; }
        else { const bf16* zr = F.Z() + (size_t)(NP_ROWS + sb * 4 + p - 124) * ZW; kv = bf2f(zr[ZK + c]); vv = bf2f(zr[ZV + c]); }
        F.out[O_WK_S + (size_t)l * 524288 + i] = kv; F.out[O_WV_S + (size_t)l * 524288 + i] = vv; }
    for (int i = gt; i < 32 * 15 * 512; i += NGT) { const int sb = i / 7680, rem = i - sb * 7680, j = rem >> 9, c = rem & 511; float v;
        if (j < 11) v = A.in[F.zo + I_SPOOL][((size_t)(l * 32 + sb) * 15 + j + 4) * 512 + c];
        else v = bf2f(F.Z()[(size_t)(NP_ROWS + sb * 4 + j - 11) * ZW + ZU + c]);
        F.out[O_POOL_S + (size_t)l * 245760 + i] = v; }
}
__device__ __forceinline__ void gla_out_item(Frame& F, const Args& A, int l, int r, int hh) {
    const int lane = F.lane_id();
    const f32x4 o = *(const f32x4*)(F.OGLA() + (size_t)r * 1024 + hh * 256 + 4 * lane);
    const float ss = wave_sum((o.x * o.x + o.y * o.y) + (o.z * o.z + o.w * o.w));
    const float rstd = 1.0f / sqrtf(ss * (1.0f / 256.0f) + EPS);
    const f32x4 gv = *(const f32x4*)(A.in[F.zo + I_GGLA] + l * 1024 + hh * 256 + 4 * lane);
    const uint2 gw = *(const uint2*)(F.Z() + (size_t)r * ZW + GG + hh * 256 + 4 * lane);
    const float g0 = bflo(gw.x), g1 = bfhi(gw.x), g2 = bflo(gw.y), g3 = bfhi(gw.y);
    const float y0 = o.x * rstd * gv.x * (g0 / (1.0f + __expf(-g0))), y1 = o.y * rstd * gv.y * (g1 / (1.0f + __expf(-g1)));
    const float y2 = o.z * rstd * gv.z * (g2 / (1.0f + __expf(-g2))), y3 = o.w * rstd * gv.w * (g3 / (1.0f + __expf(-g3)));
    uint2 w; w.x = pk2(y0, y1); w.y = pk2(y2, y3);
    *(uint2*)(F.MIX() + (size_t)r * DM + 1024 + hh * 256 + 4 * lane) = w;
}
typedef unsigned u32x2 __attribute__((ext_vector_type(2)));
__device__ __forceinline__ u32x2 pack4bf(const f32x4 v) { u32x2 w; w.x = pk2(v.x, v.y); w.y = pk2(v.z, v.w); return w; }
constexpr int GL_QD = 0, GL_KD = 17408, GL_VT = 34816, GL_AM = 71680, GL_BS = 80896, GL_GS = 82944, GL_END = 87040;
static_assert(GL_END <= RING_BYTES, "GLA LDS map");
constexpr int GL_NSLOT = 640;
__device__ __forceinline__ void gla_prep_unit(Frame& F, const Args& A, int l, int slot) {
    const int lane = F.lane_id(), wave = F.wave, tid = wave * 64 + lane, fr = lane & 15, fq = lane >> 4;
    const bool smp = slot >= 512; const int hh = slot & 3;
    const int row0 = smp ? (NP_ROWS + ((slot - 512) >> 2) * 4) : ((slot >> 7) * 2048 + ((slot >> 2) & 31) * 64), nvalid = smp ? 4 : 64;
    const int d = tid & 127, qtr = tid >> 7, cg = hh * 128 + d;
    LAS bf16* QD = (LAS bf16*)(F.lds + GL_QD); LAS bf16* KD = (LAS bf16*)(F.lds + GL_KD); LAS bf16* VT = (LAS bf16*)(F.lds + GL_VT); LAS bf16* AM = (LAS bf16*)(F.lds + GL_AM);
    LAS float* BS = (LAS float*)(F.lds + GL_BS); LAS float* GS = (LAS float*)(F.lds + GL_GS);
    const bf16* Z = F.Z();
    { const int t = tid >> 3, j0 = (tid & 7) * 2; float g0 = 0.f, g1 = 0.f;
      if (t < nvalid) { const unsigned w = *(const unsigned*)(Z + (size_t)(row0 + t) * ZW + GA + j0); g0 = bflo(w); g1 = bfhi(w); }
      GS[t * 16 + j0] = g0; GS[t * 16 + j0 + 1] = g1; }
    float wa[16];
    { const float* wp = A.in[F.zo + I_WA2] + (size_t)l * 16 * 512 + cg;
#pragma unroll
      for (int j = 0; j < 16; ++j) wa[j] = wp[j * 512]; }
    const float ba = A.in[F.zo + I_BA2][l * 512 + cg];
    __syncthreads();
    float bl[16]; float run = 0.f;
#pragma unroll
    for (int i = 0; i < 16; ++i) { const int t = 16 * qtr + i; const LAS f32x4* gp = (const LAS f32x4*)(GS + t * 16); const f32x4 g0 = gp[0], g1 = gp[1], g2 = gp[2], g3 = gp[3];
        float x = ba + g0.x * wa[0] + g0.y * wa[1] + g0.z * wa[2] + g0.w * wa[3] + g1.x * wa[4] + g1.y * wa[5] + g1.z * wa[6] + g1.w * wa[7];
        x += g2.x * wa[8] + g2.y * wa[9] + g2.z * wa[10] + g2.w * wa[11] + g3.x * wa[12] + g3.y * wa[13] + g3.z * wa[14] + g3.w * wa[15];
        float la = (fminf(x, 0.f) - __logf(1.0f + __expf(-fabsf(x)))) * (1.0f / 16.0f);
        if (t >= nvalid) la = 0.f;
        run += la; bl[i] = run; }
    BS[qtr * 128 + d] = run;
    __syncthreads();
    float pre = 0.f, tot = 0.f;
#pragma unroll
    for (int q2 = 0; q2 < 4; ++q2) { const float v = BS[q2 * 128 + d]; tot += v; if (q2 < qtr) pre += v; }
    { const bf16* zq = Z + (size_t)(row0 + 16 * qtr) * ZW + GQ + cg; const bf16* zk = zq + (GK - GQ);
      bf16* qg = F.QDG() + (size_t)(row0 + 16 * qtr) * 512 + cg;
      unsigned kt[8];
#pragma unroll
      for (int i = 0; i < 16; ++i) { const int t = 16 * qtr + i; const float b = pre + bl[i]; float qv = 0.f, kv = 0.f;
          if (t < nvalid) { qv = bf2f(zq[(size_t)i * ZW]); kv = bf2f(zk[(size_t)i * ZW]); }
          const unsigned qd = f2bf(qv * __expf(b) * 0.08838834764831845f), kd = f2bf(kv * __expf(-b)), kdt = f2bf(kv * __expf(tot - b));
          QD[t * 136 + d] = (bf16)qd; KD[t * 136 + d] = (bf16)kd;
          if (t < nvalid) qg[(size_t)i * 512] = (bf16)qd;
          if (i & 1) kt[i >> 1] |= kdt << 16; else kt[i >> 1] = kdt; }
      v4u* kg = (v4u*)(F.KDTG() + ((size_t)slot * 128 + d) * 64 + 16 * qtr);
      kg[0] = (v4u){kt[0], kt[1], kt[2], kt[3]}; kg[1] = (v4u){kt[4], kt[5], kt[6], kt[7]};
      if (qtr == 0) F.DLG()[slot * 128 + d] = __expf(tot); }
    { const int e = tid & 255, hf = tid >> 8; const bf16* vp = Z + (size_t)(row0 + 32 * hf) * ZW + GV + hh * 256 + e;
      unsigned vw[16];
#pragma unroll
      for (int i = 0; i < 32; ++i) { const int s = 32 * hf + i; unsigned x = 0u; if (s < nvalid) x = vp[(size_t)i * ZW];
          if (i & 1) vw[i >> 1] |= x << 16; else vw[i >> 1] = x; }
      LAS v4u* vl = (LAS v4u*)(VT + e * 72 + 32 * hf); v4u* vg = (v4u*)(F.VTG() + ((size_t)slot * 256 + e) * 64 + 32 * hf);
#pragma unroll
      for (int k = 0; k < 4; ++k) { const v4u w = {vw[4 * k], vw[4 * k + 1], vw[4 * k + 2], vw[4 * k + 3]}; vl[k] = w; vg[k] = w; } }
    __syncthreads();
#pragma unroll
    for (int bi = 0; bi < 2; ++bi) { const int blk = 2 * wave + bi, tb = blk >> 2, sbk = blk & 3;
        f32x4 acc = {0.f, 0.f, 0.f, 0.f};
        if (sbk <= tb) {
#pragma unroll
            for (int ks = 0; ks < 4; ++ks) { const bf16x8 a = *(const LAS bf16x8*)(KD + (sbk * 16 + fr) * 136 + ks * 32 + fq * 8), b = *(const LAS bf16x8*)(QD + (tb * 16 + fr) * 136 + ks * 32 + fq * 8);
                acc = __builtin_amdgcn_mfma_f32_16x16x32_bf16(a, b, acc, 0, 0, 0); } }
        const int t = tb * 16 + fr, s0 = sbk * 16 + 4 * fq;
        f32x4 m; m.x = (s0 + 0 <= t) ? acc.x : 0.f; m.y = (s0 + 1 <= t) ? acc.y : 0.f; m.z = (s0 + 2 <= t) ? acc.z : 0.f; m.w = (s0 + 3 <= t) ? acc.w : 0.f;
        *(LAS u32x2*)(AM + t * 72 + s0) = pack4bf(m); }
    __syncthreads();
#pragma unroll
    for (int ei = 0; ei < 2; ++ei) { const int eb = 2 * wave + ei;
        const bf16x8 a0 = *(const LAS bf16x8*)(VT + (eb * 16 + fr) * 72 + fq * 8), a1 = *(const LAS bf16x8*)(VT + (eb * 16 + fr) * 72 + 32 + fq * 8);
#pragma unroll
        for (int tb = 0; tb < 4; ++tb) { f32x4 o = {0.f, 0.f, 0.f, 0.f};
            o = __builtin_amdgcn_mfma_f32_16x16x32_bf16(a0, *(const LAS bf16x8*)(AM + (tb * 16 + fr) * 72 + fq * 8), o, 0, 0, 0);
            if (tb >= 2) o = __builtin_amdgcn_mfma_f32_16x16x32_bf16(a1, *(const LAS bf16x8*)(AM + (tb * 16 + fr) * 72 + 32 + fq * 8), o, 0, 0, 0);
            const int t = tb * 16 + fr;
            if (t < nvalid) *(f32x4*)(F.OGLA() + (size_t)(row0 + t) * 1024 + hh * 256 + eb * 16 + 4 * fq) = o; } }
    __syncthreads();
}
__device__ __forceinline__ void gla_state_step(Frame& F, int slot, int eb, int fr, int fq, f32x4 (&sacc)[8]) {
    const bf16* vt = F.VTG() + ((size_t)slot * 256 + eb * 16 + fr) * 64 + 8 * fq; const bf16x8 b0 = *(const bf16x8*)vt, b1 = *(const bf16x8*)(vt + 32);
    const bf16* kt = F.KDTG() + ((size_t)slot * 128 + fr) * 64 + 8 * fq; const float* dl = F.DLG() + slot * 128 + 4 * fq;
#pragma unroll
    for (int db = 0; db < 8; ++db) { const f32x4 dv = *(const f32x4*)(dl + db * 16); const bf16x8 a0 = *(const bf16x8*)(kt + (size_t)db * 16 * 64), a1 = *(const bf16x8*)(kt + (size_t)db * 16 * 64 + 32);
        f32x4 s = sacc[db] * dv; s = __builtin_amdgcn_mfma_f32_16x16x32_bf16(a0, b0, s, 0, 0, 0); s = __builtin_amdgcn_mfma_f32_16x16x32_bf16(a1, b1, s, 0, 0, 0); sacc[db] = s; }
}
__device__ __forceinline__ void gla_inter_step(Frame& F, int row0, int nvalid, int ntb, int hh, int eb, int fr, int fq, const f32x4 (&sacc)[8]) {
    bf16x8 sf[4];
#pragma unroll
    for (int ks = 0; ks < 4; ++ks) { const u32x2 lo = pack4bf(sacc[2 * ks]), hi = pack4bf(sacc[2 * ks + 1]); const v4u w = {lo.x, lo.y, hi.x, hi.y}; sf[ks] = __builtin_bit_cast(bf16x8, w); }
    for (int tb = 0; tb < ntb; ++tb) { const int t = tb * 16 + fr; const bool ok = t < nvalid;
        const bf16* qp = F.QDG() + (size_t)(row0 + t) * 512 + hh * 128 + 4 * fq;
        f32x4 o = {0.f, 0.f, 0.f, 0.f};
#pragma unroll
        for (int ks = 0; ks < 4; ++ks) { u32x2 lo = {0u, 0u}, hi = {0u, 0u}; if (ok) { lo = *(const u32x2*)(qp + 32 * ks); hi = *(const u32x2*)(qp + 32 * ks + 16); }
            const v4u w = {lo.x, lo.y, hi.x, hi.y}; o = __builtin_amdgcn_mfma_f32_16x16x32_bf16(sf[ks], __builtin_bit_cast(bf16x8, w), o, 0, 0, 0); }
        if (ok) { const size_t oi = (size_t)(row0 + t) * 1024 + hh * 256 + eb * 16 + 4 * fq; *(f32x4*)(F.OGLA_ST() + oi) = *(const f32x4*)(F.OGLA() + oi) + o; } }
}
__device__ __forceinline__ void gla_store_state(float* dst, int fr, int fq, const f32x4 (&sacc)[8]) {
#pragma unroll
    for (int db = 0; db < 8; ++db) { const int d0 = db * 16 + 4 * fq; dst[(size_t)(d0 + 0) * 256 + fr] = sacc[db].x; dst[(size_t)(d0 + 1) * 256 + fr] = sacc[db].y; dst[(size_t)(d0 + 2) * 256 + fr] = sacc[db].z; dst[(size_t)(d0 + 3) * 256 + fr] = sacc[db].w; }
}
__device__ __forceinline__ void gla_phase_g1(Frame& F, const Args& A, int l) {
    const int lane = F.lane_id(), fr = lane & 15, fq = lane >> 4;
    const int gw = F.vcu * NWAVES + F.wave, NGW = F.G * NWAVES;
    for (int it = gw; it < 2048; it += NGW) { const int bh = it >> 7, seg = (it >> 4) & 7, eb = it & 15;
        if (seg == 7) continue;
        f32x4 sacc[8];
#pragma unroll
        for (int db = 0; db < 8; ++db) sacc[db] = (f32x4){0.f, 0.f, 0.f, 0.f};
        const int slot0 = (((bh >> 2) * 32 + seg * 4) * 4) + (bh & 3);
        for (int c = 0; c < 4; ++c) gla_state_step(F, slot0 + 4 * c, eb, fr, fq, sacc);
        gla_store_state(F.SLOC() + ((size_t)(bh * 8 + seg) * 128) * 256 + eb * 16, fr, fq, sacc);
        if (eb == 0) {
#pragma unroll
            for (int k = 0; k < 2; ++k) { const int d = lane + 64 * k; float p = 1.f; for (int c = 0; c < 4; ++c) p *= F.DLG()[(slot0 + 4 * c) * 128 + d]; F.DSEG()[(bh * 8 + seg) * 128 + d] = p; } }
    }
    for (int it = gw; it < 2048; it += NGW) { const int sbh = it >> 4, eb = it & 15, sb = sbh >> 2, hh = sbh & 3;
        const size_t so = ((size_t)((l * 32 + sb) * 4 + hh)) * 32768 + eb * 16;
        const float* s0 = A.in[F.zo + I_SGLA] + so + fr;
        f32x4 sacc[8];
#pragma unroll
        for (int db = 0; db < 8; ++db) { const int d0 = db * 16 + 4 * fq; sacc[db].x = s0[(size_t)(d0 + 0) * 256]; sacc[db].y = s0[(size_t)(d0 + 1) * 256]; sacc[db].z = s0[(size_t)(d0 + 2) * 256]; sacc[db].w = s0[(size_t)(d0 + 3) * 256]; }
        gla_inter_step(F, NP_ROWS + sb * 4, 4, 1, hh, eb, fr, fq, sacc);
        gla_state_step(F, 512 + sbh, eb, fr, fq, sacc);
        gla_store_state(F.out + O_GLA_S + so, fr, fq, sacc);
    }
}
__device__ __forceinline__ void gla_phase_g2(Frame& F, const Args& A, int l) {
    const int lane = F.lane_id(), fr = lane & 15, fq = lane >> 4;
    const int gw = F.vcu * NWAVES + F.wave, NGW = F.G * NWAVES;
    for (int it = gw; it < 2048; it += NGW) { const int bh = it >> 7, seg = (it >> 4) & 7, eb = it & 15, hh = bh & 3;
        f32x4 sacc[8];
#pragma unroll
        for (int db = 0; db < 8; ++db) sacc[db] = (f32x4){0.f, 0.f, 0.f, 0.f};
        for (int i2 = 0; i2 < seg; ++i2) { const float* sl = F.SLOC() + ((size_t)(bh * 8 + i2) * 128) * 256 + eb * 16 + fr; const float* dg = F.DSEG() + (bh * 8 + i2) * 128;
#pragma unroll
            for (int db = 0; db < 8; ++db) { const int d0 = db * 16 + 4 * fq; const f32x4 dv = *(const f32x4*)(dg + d0);
                sacc[db].x = sacc[db].x * dv.x + sl[(size_t)(d0 + 0) * 256]; sacc[db].y = sacc[db].y * dv.y + sl[(size_t)(d0 + 1) * 256]; sacc[db].z = sacc[db].z * dv.z + sl[(size_t)(d0 + 2) * 256]; sacc[db].w = sacc[db].w * dv.w + sl[(size_t)(d0 + 3) * 256]; } }
        const int slot0 = (((bh >> 2) * 32 + seg * 4) * 4) + hh, row0 = (bh >> 2) * 2048 + seg * 256;
        for (int c = 0; c < 4; ++c) { gla_inter_step(F, row0 + c * 64, 64, 4, hh, eb, fr, fq, sacc); gla_state_step(F, slot0 + 4 * c, eb, fr, fq, sacc); }
        if (seg == 7) gla_store_state(F.out + O_GLA_P + ((size_t)(l * 16 + bh)) * 32768 + eb * 16, fr, fq, sacc);
    }
}
constexpr int AT_VT = 0, AT_VTS = 184, AT_BT = 64 * AT_VTS * 2, AT_END = AT_BT + 4 * 128 * 4;
__device__ __forceinline__ void attn_unit_mfma(Frame& F, const Args& A, int l, int u) {
    const int lane = F.lane_id(), wave = F.wave, tid = wave * 64 + lane, fr = lane & 15, fq = lane >> 4;
    const int span = u >> 1, g = u & 1, t0g = span * 32, tb0 = t0g & 2047;
    LAS bf16* VT = (LAS bf16*)(F.lds + AT_VT); LAS float* BT = (LAS float*)(F.lds + AT_BT);
    const bf16* Z = F.Z();
#pragma unroll
    for (int pass = 0; pass < 2; ++pass) { const int key = pass * 128 + (tid >> 2), dch = (tid & 3) * 16;
        if (key < 160) { v4u v0 = {0u, 0u, 0u, 0u}, v1 = {0u, 0u, 0u, 0u};
            if (tb0 - 128 + key >= 0) { const v4u* vp = (const v4u*)(Z + (size_t)(t0g - 128 + key) * ZW + ZV + g * 64 + dch); v0 = vp[0]; v1 = vp[1]; }
            LAS bf16* vt = VT + dch * AT_VTS + key;
            vt[0 * AT_VTS] = (bf16)(v0.x & 0xffffu); vt[1 * AT_VTS] = (bf16)(v0.x >> 16); vt[2 * AT_VTS] = (bf16)(v0.y & 0xffffu); vt[3 * AT_VTS] = (bf16)(v0.y >> 16);
            vt[4 * AT_VTS] = (bf16)(v0.z & 0xffffu); vt[5 * AT_VTS] = (bf16)(v0.z >> 16); vt[6 * AT_VTS] = (bf16)(v0.w & 0xffffu); vt[7 * AT_VTS] = (bf16)(v0.w >> 16);
            vt[8 * AT_VTS] = (bf16)(v1.x & 0xffffu); vt[9 * AT_VTS] = (bf16)(v1.x >> 16); vt[10 * AT_VTS] = (bf16)(v1.y & 0xffffu); vt[11 * AT_VTS] = (bf16)(v1.y >> 16);
            vt[12 * AT_VTS] = (bf16)(v1.z & 0xffffu); vt[13 * AT_VTS] = (bf16)(v1.z >> 16); vt[14 * AT_VTS] = (bf16)(v1.w & 0xffffu); vt[15 * AT_VTS] = (bf16)(v1.w >> 16); } }
    BT[tid] = F.BTAB()[(g * 4) * 128 + tid];
    __syncthreads();
    const int rb = wave >> 2, hl = wave & 3, hd = g * 4 + hl, t0w = t0g + 16 * rb;
    bf16x8 qf[2];
    { const bf16* qp = Z + (size_t)(t0w + fr) * ZW + ZQ + hd * 64 + 8 * fq; qf[0] = *(const bf16x8*)qp; qf[1] = *(const bf16x8*)(qp + 32); }
    f32x4 sacc[9];
#pragma unroll
    for (int kb = 0; kb < 9; ++kb) { const int kl = 16 * (rb + kb) + fr; bf16x8 k0 = {0, 0, 0, 0, 0, 0, 0, 0}, k1 = {0, 0, 0, 0, 0, 0, 0, 0};
        if (tb0 - 128 + kl >= 0) { const bf16* kp = Z + (size_t)(t0g - 128 + kl) * ZW + ZK + g * 64 + 8 * fq; k0 = *(const bf16x8*)kp; k1 = *(const bf16x8*)(kp + 32); }
        f32x4 acc = {0.f, 0.f, 0.f, 0.f};
        acc = __builtin_amdgcn_mfma_f32_16x16x32_bf16(k0, qf[0], acc, 0, 0, 0); acc = __builtin_amdgcn_mfma_f32_16x16x32_bf16(k1, qf[1], acc, 0, 0, 0);
        sacc[kb] = acc; }
    const float sink = A.in[F.zo + I_SINKS][l * 8 + hd];
    float mx = -INFINITY;
#pragma unroll
    for (int kb = 0; kb < 9; ++kb)
#pragma unroll
        for (int i = 0; i < 4; ++i) { const int dist = 128 - 16 * kb + fr - 4 * fq - i, kpos = tb0 + 16 * rb + fr - dist;
            const bool valid = (dist >= 0) && (dist < 128) && (kpos >= 0);
            const float s = valid ? sacc[kb][i] * 0.125f + BT[hl * 128 + (dist & 127)] : -INFINITY;
            sacc[kb][i] = s; mx = fmaxf(mx, s); }
    mx = fmaxf(mx, __shfl_xor(mx, 16)); mx = fmaxf(mx, __shfl_xor(mx, 32)); mx = fmaxf(mx, sink);
    float ls = 0.f;
#pragma unroll
    for (int kb = 0; kb < 9; ++kb)
#pragma unroll
        for (int i = 0; i < 4; ++i) { const float p = __expf(sacc[kb][i] - mx); sacc[kb][i] = p; ls += p; }
    ls += __shfl_xor(ls, 16); ls += __shfl_xor(ls, 32);
    const float rden = 1.0f / (ls + __expf(sink - mx));
    bf16x8 pf[5];
#pragma unroll
    for (int pp = 0; pp < 5; ++pp) { const f32x4 a = sacc[2 * pp], b = (2 * pp + 1 < 9) ? sacc[2 * pp + 1] : (f32x4){0.f, 0.f, 0.f, 0.f};
        const unsigned w0 = pk2(a.x, a.y), w1 = pk2(a.z, a.w), w2 = pk2(b.x, b.y), w3 = pk2(b.z, b.w);
        v4u w = {w0, w1, w2, w3}; pf[pp] = __builtin_bit_cast(bf16x8, w); }
#pragma unroll
    for (int db = 0; db < 4; ++db) { f32x4 o = {0.f, 0.f, 0.f, 0.f};
#pragma unroll
        for (int pp = 0; pp < 5; ++pp) { const LAS bf16* vr = VT + (db * 16 + fr) * AT_VTS + 16 * (rb + 2 * pp) + 4 * fq;
            const u32x2 lo = *(const LAS u32x2*)vr; u32x2 hi = {0u, 0u}; if (2 * pp + 1 < 9) hi = *(const LAS u32x2*)(vr + 16);
            v4u w = {lo.x, lo.y, hi.x, hi.y};
            o = __builtin_amdgcn_mfma_f32_16x16x32_bf16(__builtin_bit_cast(bf16x8, w), pf[pp], o, 0, 0, 0); }
        *(u32x2*)(F.MIX() + (size_t)(t0w + fr) * DM + hd * 64 + db * 16 + 4 * fq) = pack4bf(o * rden); }
    __syncthreads();
}
template <int W>
__device__ __forceinline__ void pool_item_body(Frame& F, const Args& A, int l, int rblk, int g) {
    const int lane = F.lane_id(), fr = lane & 15, fq = lane >> 4;
    const int t = rblk * 16 + fr, pos = t & 2047;
    const bf16* Z = F.Z();
    const int nwin = (pos + 1) < W ? (pos + 1) : W; const float rc = 1.0f / (float)nwin;
    const bf16* wt = F.WPT() + ((size_t)(l * 4 + g) * 128) * 128; const float* psc = A.in[F.zo + I_PSCALE] + l * 512 + g * 128;
    f32x4 acc[8];
#pragma unroll
    for (int nb = 0; nb < 8; ++nb) acc[nb] = (f32x4){0.f, 0.f, 0.f, 0.f};
#pragma unroll 1
    for (int ks = 0; ks < 4; ++ks) { const bf16* up = Z + (size_t)t * ZW + ZU + g * 128 + ks * 32 + 8 * fq;
        v4u x[W];
#pragma unroll
        for (int i = 0; i < W; ++i) { x[i] = (v4u){0u, 0u, 0u, 0u}; if (i < nwin) x[i] = *(const v4u*)(up - (size_t)i * ZW); }
        float s[8];
#pragma unroll
        for (int j = 0; j < 8; ++j) s[j] = 0.f;
#pragma unroll
        for (int i = 0; i < W; ++i) { s[0] += bflo(x[i].x); s[1] += bfhi(x[i].x); s[2] += bflo(x[i].y); s[3] += bfhi(x[i].y); s[4] += bflo(x[i].z); s[5] += bfhi(x[i].z); s[6] += bflo(x[i].w); s[7] += bfhi(x[i].w); }
        const v4u u0 = x[0];
        v4u wv; wv.x = pk2(s[0] * rc - bflo(u0.x), s[1] * rc - bfhi(u0.x)); wv.y = pk2(s[2] * rc - bflo(u0.y), s[3] * rc - bfhi(u0.y)); wv.z = pk2(s[4] * rc - bflo(u0.z), s[5] * rc - bfhi(u0.z)); wv.w = pk2(s[6] * rc - bflo(u0.w), s[7] * rc - bfhi(u0.w));
        const bf16x8 df = __builtin_bit_cast(bf16x8, wv);
#pragma unroll
        for (int nb = 0; nb < 8; ++nb) { const bf16x8 a = *(const bf16x8*)(wt + (size_t)(nb * 16 + fr) * 128 + ks * 32 + 8 * fq); acc[nb] = __builtin_amdgcn_mfma_f32_16x16x32_bf16(a, df, acc[nb], 0, 0, 0); } }
#pragma unroll
    for (int nb = 0; nb < 8; ++nb) { const f32x4 sc = *(const f32x4*)(psc + nb * 16 + 4 * fq);
        *(u32x2*)(F.MIX() + (size_t)t * DM + 512 + g * 128 + nb * 16 + 4 * fq) = pack4bf(acc[nb] * sc); }
}
__device__ __forceinline__ void pool_item_mfma(Frame& F, const Args& A, int l, int rblk, int g) {
    if (g == 0) pool_item_body<2>(F, A, l, rblk, g); else if (g == 1) pool_item_body<4>(F, A, l, rblk, g); else if (g == 2) pool_item_body<8>(F, A, l, rblk, g); else pool_item_body<16>(F, A, l, rblk, g);
}
__device__ __forceinline__ void skinny_resid(Frame& F, const bf16* Asmp, const bf16* Bt, int K, const float* gate) {
    const int lane = F.lane_id(), wave = F.wave, fr = lane & 15, fq = lane >> 4;
    LAS float* red = (LAS float*)(F.lds + RING_OFF);
    const int kw = K >> 3, ksteps = kw >> 5;
    for (int u = F.vcu; u < 256; u += F.G) {
        const int c0 = (u >> 1) * 16, r0 = (u & 1) * 64;
        const bf16* bp = Bt + (size_t)(c0 + fr) * K + wave * kw + 8 * fq;
        const bf16* ap = Asmp + (size_t)(r0 + fr) * K + wave * kw + 8 * fq;
        f32x4 acc[4];
#pragma unroll
        for (int rb = 0; rb < 4; ++rb) acc[rb] = (f32x4){0.f, 0.f, 0.f, 0.f};
        bf16x8 bc = *(const bf16x8*)bp, ac[4];
#pragma unroll
        for (int rb = 0; rb < 4; ++rb) ac[rb] = *(const bf16x8*)(ap + (size_t)rb * 16 * K);
        for (int ks = 0; ks < ksteps; ++ks) {
            bf16x8 bn = bc, an[4];
#pragma unroll
            for (int rb = 0; rb < 4; ++rb) an[rb] = ac[rb];
            if (ks + 1 < ksteps) { bn = *(const bf16x8*)(bp + (ks + 1) * 32);
#pragma unroll
                for (int rb = 0; rb < 4; ++rb) an[rb] = *(const bf16x8*)(ap + (size_t)rb * 16 * K + (ks + 1) * 32); }
#pragma unroll
            for (int rb = 0; rb < 4; ++rb) acc[rb] = __builtin_amdgcn_mfma_f32_16x16x32_bf16(bc, ac[rb], acc[rb], 0, 0, 0);
            bc = bn;
#pragma unroll
            for (int rb = 0; rb < 4; ++rb) ac[rb] = an[rb];
        }
#pragma unroll
        for (int rb = 0; rb < 4; ++rb) *(LAS f32x4*)(red + ((wave * 4 + rb) * 64 + lane) * 4) = acc[rb];
        __syncthreads();
        if (wave < 4) { f32x4 s = {0.f, 0.f, 0.f, 0.f};
#pragma unroll
            for (int w2 = 0; w2 < 8; ++w2) s = s + *(const LAS f32x4*)(red + ((w2 * 4 + wave) * 64 + lane) * 4);
            const int r = r0 + wave * 16 + fr;
            const f32x4 g = *(const f32x4*)(gate + (size_t)(4 + (r >> 2)) * MODLD + c0 + 4 * fq);
            const size_t xo = (size_t)(NP_ROWS + r) * DM + c0 + 4 * fq; f32x4 xv = *(const f32x4*)(F.X() + xo); xv = xv + g * s; *(f32x4*)(F.X_ST() + xo) = xv; }
        __syncthreads();
    }
}

#ifndef EN_P0
#define EN_P0 1
#endif
#ifndef EN_G
#define EN_G 1
#endif
#ifndef EN_N
#define EN_N 1
#endif
#ifndef EN_M2
#define EN_M2 1
#endif
#ifndef EN_M3
#define EN_M3 1
#endif
#ifndef EN_M4
#define EN_M4 1
#endif
#ifndef EN_G1
#define EN_G1 1
#endif
#ifndef EN_GIN
#define EN_GIN 1
#endif
#ifndef EN_GOUT
#define EN_GOUT 1
#endif
#ifndef EN_GGU
#define EN_GGU 1
#endif
#ifndef EN_GDN
#define EN_GDN 1
#endif
#ifndef PROBE_DUP
#define PROBE_DUP 0
#endif
#ifndef MK_SINGLE
#define MK_SINGLE 1
#endif

#define PH_ARGS unsigned ldsb_, unsigned wslo_, unsigned wshi_, unsigned olo_, unsigned ohi_, int wave_, int vcu_, int G_, int probe_, int l_
#define PH_PASS ldsb, wslo, wshi, olo, ohi, F.wave, F.vcu, F.G, F.probe
#define PH_FRAME() Frame F; { const unsigned a0 = __builtin_amdgcn_readfirstlane(ldsb_), a1 = __builtin_amdgcn_readfirstlane(wslo_), a2 = __builtin_amdgcn_readfirstlane(wshi_), a3 = __builtin_amdgcn_readfirstlane(olo_), a4 = __builtin_amdgcn_readfirstlane(ohi_); \
    F.lds = (LAS unsigned char*)(unsigned long long)a0; F.MISC = (volatile LAS unsigned*)(F.lds + MISC_OFF); F.ws = (unsigned char*)(((unsigned long long)a2 << 32) | a1); F.out = (float*)(((unsigned long long)a4 << 32) | a3); \
    F.wave = __builtin_amdgcn_readfirstlane(wave_); F.vcu = __builtin_amdgcn_readfirstlane(vcu_); F.G = __builtin_amdgcn_readfirstlane(G_); F.zo = 0; F.probe = __builtin_amdgcn_readfirstlane(probe_); } \
    const int l = __builtin_amdgcn_readfirstlane(l_); (void)l; \
    const Args& args = *(const Args*)__builtin_amdgcn_kernarg_segment_ptr();
__device__ __forceinline__ void ph_prologue(PH_ARGS) { PH_FRAME(); p0_prologue(F, args); }
__device__ __forceinline__ void ph_norm1(PH_ARGS) { PH_FRAME(); norm_mod_rows(F, args.in[I_GMIX] + l * DM, F.MOD() + (size_t)l * MODW); }
__device__ __forceinline__ void ph_norm2(PH_ARGS) { PH_FRAME(); norm_mod_rows(F, args.in[I_GFFN] + l * DM, F.MOD() + (size_t)l * MODW + 6144); }
__device__ __forceinline__ void ph_final(PH_ARGS) { PH_FRAME(); final_norm_rows(F, args); }
__device__ __forceinline__ void ph_mixa(PH_ARGS) { PH_FRAME();
    const int gw = F.vcu * NWAVES + F.wave, NGW = F.G * NWAVES; LAS float* wscr = (LAS float*)(F.lds + RING_OFF + F.wave * 16384);
    for (int u = F.vcu; u < GL_NSLOT; u += F.G) gla_prep_unit(F, args, l, u);
    for (int u = F.vcu; u < 512; u += F.G) attn_unit_mfma(F, args, l, u);
    for (int it = gw; it < 512 * 4; it += NGW) pool_item_mfma(F, args, l, it >> 2, it & 3);
    for (int it = gw; it < NS_ROWS * 8; it += NGW) attn_item(F, args, l, NP_ROWS + (it >> 3), it & 7, wscr);
    for (int it = gw; it < NS_ROWS * 4; it += NGW) pool_item(F, args, l, NP_ROWS + (it >> 2), it & 3, wscr);
    cache_outputs(F, args, l);
}
__device__ __forceinline__ void ph_gla1(PH_ARGS) { PH_FRAME(); gla_phase_g1(F, args, l); }
__device__ __forceinline__ void ph_gla2(PH_ARGS) { PH_FRAME(); gla_phase_g2(F, args, l); }
__device__ __forceinline__ void ph_mixc(PH_ARGS) { PH_FRAME(); const int gw = F.vcu * NWAVES + F.wave, NGW = F.G * NWAVES; for (int it = gw; it < NROWS * 4; it += NGW) gla_out_item(F, args, l, it >> 2, it & 3); }
constexpr int PH_PER_LAYER = 10, PH_LAYER0 = 2, PH_FINAL = PH_LAYER0 + DEPTH * PH_PER_LAYER, PH_COUNT = PH_FINAL + 1;
__global__ void __launch_bounds__(NTHREADS, 2) hymba_fwd(Args args) {
    extern __shared__ __attribute__((aligned(16))) unsigned char lds[];
    Frame F;
    F.lds = (LAS unsigned char*)lds;
    F.MISC = (volatile LAS unsigned*)(F.lds + MISC_OFF);
    F.wave = __builtin_amdgcn_readfirstlane((int)threadIdx.x >> 6); F.zo = 0; F.probe = 0;
    F.G = gridDim.x; { const int bx = blockIdx.x; F.vcu = (F.G % 8 == 0) ? (bx % 8) * (F.G / 8) + bx / 8 : bx; }
    F.ws = args.ws; F.out = args.out;
    gu32* const ctl = (gu32*)(F.ws + WS_CTL);
    for (int u = threadIdx.x; u < (LDS_BYTES - LDSCTL_OFF) / 4; u += NTHREADS) ((LAS unsigned*)(F.lds + LDSCTL_OFF))[u] = 0u;
    __syncthreads();
#if MK_SINGLE
    XcdBarrier bar = xcd_barrier_post((unsigned*)(ctl + CW_BAR), F.MISC + 8);
#define GRID_BAR() xcd_barrier(bar)
#else
#define GRID_BAR() do { } while (0)
#endif
    const int lo = args.ph_lo, hi = args.ph_hi;
    const unsigned ldsb = (unsigned)(unsigned long long)F.lds, wslo = (unsigned)(unsigned long long)F.ws, wshi = (unsigned)((unsigned long long)F.ws >> 32), olo = (unsigned)(unsigned long long)F.out, ohi = (unsigned)((unsigned long long)F.out >> 32);
#define IN(k) (lo <= (k) && (k) < hi)
#define BOTH(k) (IN(k) && IN((k) + 1))
#define PHASE_BEGIN() asm volatile("s_mov_b32 %0, 0" : "=s"(F.zo), "+s"(F.G), "+s"(F.vcu), "+s"(F.wave))
#define gw (F.vcu * NWAVES + F.wave)
#define NGW (F.G * NWAVES)
#define wscr ((LAS float*)(F.lds + RING_OFF + F.wave * 16384))

    if (EN_P0 && IN(0)) for (int rep_ = 0; rep_ < ((PROBE_DUP & 1) ? 2 : 1); ++rep_) { PHASE_BEGIN(); ph_prologue(PH_PASS, 0); if (BOTH(0)) GRID_BAR(); }
    if (EN_G && EN_G1 && IN(1)) for (int rep_ = 0; rep_ < ((PROBE_DUP & 1) ? 2 : 1); ++rep_) { PHASE_BEGIN();
        pg8::Gemm g{F.SC(), F.Wada_t(), 256, DEPTH * MODW, DM}; pg8::StaticOrder S; S.init(256, DEPTH * MODW, F.G, (int)blockIdx.x);
        pg8::EpiMod E{F.MOD(), args.in[F.zo + I_BADA]};
        pg8::gemm_phase<pg8::EpiMod, pg8::StaticOrder, true, true>(F.lds + RING_OFF, g, S, E, F.wave);
        if (BOTH(1)) GRID_BAR();
    }
    for (int l = 0; l < DEPTH; ++l) {
        const int pb = PH_LAYER0 + l * PH_PER_LAYER;
        const float* modl = F.MOD() + (size_t)l * MODW;
        if (EN_N && IN(pb + 0)) for (int rep_ = 0; rep_ < ((PROBE_DUP & 2) ? 2 : 1); ++rep_) { PHASE_BEGIN(); ph_norm1(PH_PASS, l); if (BOTH(pb + 0)) GRID_BAR(); }
        if (EN_G && EN_GIN && IN(pb + 1)) for (int rep_ = 0; rep_ < ((PROBE_DUP & 4) ? 2 : 1); ++rep_) { PHASE_BEGIN();
            pg8::Gemm g{F.H(), F.Win_t() + (size_t)l * ZW * DM, MPAD, ZW, DM}; pg8::StaticOrder S; S.init(MPAD, ZW, F.G, (int)blockIdx.x);
            pg8::EpiZ E{F.Z(), ZW};
            pg8::gemm_phase<pg8::EpiZ, pg8::StaticOrder, true, true>(F.lds + RING_OFF, g, S, E, F.wave);
            if (BOTH(pb + 1)) GRID_BAR();
        }
        if (EN_M2 && IN(pb + 2)) for (int rep_ = 0; rep_ < ((PROBE_DUP & 8) ? 2 : 1); ++rep_) { PHASE_BEGIN();
            ph_mixa(PH_PASS, l);
            if (BOTH(pb + 2)) GRID_BAR();
        }
        if (EN_M3 && IN(pb + 3)) for (int rep_ = 0; rep_ < ((PROBE_DUP & 16) ? 2 : 1); ++rep_) { PHASE_BEGIN(); F.probe = ((PROBE_DUP & 16) && rep_ == 0) ? 1 : 0; ph_gla1(PH_PASS, l); if (BOTH(pb + 3)) GRID_BAR(); }
        if (EN_M3 && IN(pb + 4)) for (int rep_ = 0; rep_ < ((PROBE_DUP & 32) ? 2 : 1); ++rep_) { PHASE_BEGIN(); F.probe = ((PROBE_DUP & 32) && rep_ == 0) ? 1 : 0;
            ph_gla2(PH_PASS, l);
            if (BOTH(pb + 4)) GRID_BAR();
        }
        if (EN_M4 && IN(pb + 5)) for (int rep_ = 0; rep_ < ((PROBE_DUP & 64) ? 2 : 1); ++rep_) { PHASE_BEGIN(); ph_mixc(PH_PASS, l); if (BOTH(pb + 5)) GRID_BAR(); }
        if (EN_G && EN_GOUT && IN(pb + 6)) for (int rep_ = 0; rep_ < ((PROBE_DUP & 128) ? 2 : 1); ++rep_) { PHASE_BEGIN(); F.probe = ((PROBE_DUP & 128) && rep_ == 0) ? 1 : 0;
            pg8::Gemm g{F.MIX(), F.Wout_t() + (size_t)l * DM * DM, NP_ROWS, DM, DM}; pg8::StaticOrder S; S.init(NP_ROWS, DM, F.G, (int)blockIdx.x);
            pg8::EpiResid E{F.X(), modl + 4096, F.X_ST()};
            pg8::gemm_phase<pg8::EpiResid, pg8::StaticOrder, true, true>(F.lds + RING_OFF, g, S, E, F.wave);
            if ((PROBE_DUP & 512) && !F.probe) { F.probe = 1; skinny_resid(F, F.MIX() + (size_t)NP_ROWS * DM, F.Wout_t() + (size_t)l * DM * DM, DM, modl + 4096); F.probe = 0; }
            skinny_resid(F, F.MIX() + (size_t)NP_ROWS * DM, F.Wout_t() + (size_t)l * DM * DM, DM, modl + 4096);
            if (BOTH(pb + 6)) GRID_BAR();
        }
        if (EN_N && IN(pb + 7)) for (int rep_ = 0; rep_ < ((PROBE_DUP & 2) ? 2 : 1); ++rep_) { PHASE_BEGIN(); ph_norm2(PH_PASS, l); if (BOTH(pb + 7)) GRID_BAR(); }
        if (EN_G && EN_GGU && IN(pb + 8)) for (int rep_ = 0; rep_ < ((PROBE_DUP & 4) ? 2 : 1); ++rep_) { PHASE_BEGIN();
            pg8::Gemm g{F.H(), F.Wgu_t() + (size_t)l * NGU * DM, MPAD, NGU, DM}; pg8::StaticOrder S; S.init(MPAD, NGU, F.G, (int)blockIdx.x);
            pg8::EpiSwiGLU E{F.ACT(), DFF};
            pg8::gemm_phase<pg8::EpiSwiGLU, pg8::StaticOrder, true, true>(F.lds + RING_OFF, g, S, E, F.wave);
            if (BOTH(pb + 8)) GRID_BAR();
        }
        if (EN_G && EN_GDN && IN(pb + 9)) for (int rep_ = 0; rep_ < ((PROBE_DUP & 256) ? 2 : 1); ++rep_) { PHASE_BEGIN(); F.probe = ((PROBE_DUP & 256) && rep_ == 0) ? 1 : 0;
            pg8::Gemm g{F.ACT(), F.Wdn_t() + (size_t)l * DM * DFF, NP_ROWS, DM, DFF}; pg8::StaticOrder S; S.init(NP_ROWS, DM, F.G, (int)blockIdx.x);
            pg8::EpiResid E{F.X(), modl + 10240, F.X_ST()};
            pg8::gemm_phase<pg8::EpiResid, pg8::StaticOrder, true, true>(F.lds + RING_OFF, g, S, E, F.wave);
            if ((PROBE_DUP & 512) && !F.probe) { F.probe = 1; skinny_resid(F, F.ACT() + (size_t)NP_ROWS * DFF, F.Wdn_t() + (size_t)l * DM * DFF, DFF, modl + 10240); F.probe = 0; }
            skinny_resid(F, F.ACT() + (size_t)NP_ROWS * DFF, F.Wdn_t() + (size_t)l * DM * DFF, DFF, modl + 10240);
            if (BOTH(pb + 9)) GRID_BAR();
        }
    }
    if (IN(PH_FINAL)) { PHASE_BEGIN(); ph_final(PH_PASS, 0); }
#ifdef PROBE_SCALE
    GRID_BAR();
    { const size_t offs[11] = {O_Y, 16777216, O_WK_P, O_WV_P, O_POOL_P, O_GLA_P, O_WK_S, O_WV_S, O_POOL_S, O_GLA_S, O_END};
      const size_t gt_ = (size_t)(F.vcu * NWAVES + F.wave) * 64 + F.lane_id(), NGT_ = (size_t)F.G * NWAVES * 64;
      for (int k = 0; k < 10; ++k) { const float sc = 1.0f + 0.05f * (float)(k + 1); for (size_t i = offs[k] + gt_; i < offs[k + 1]; i += NGT_) F.out[i] *= sc; } }
#endif
#undef IN
#undef BOTH
#undef gw
#undef NGW
#undef wscr
}

extern "C" void kernel_launch(void* const* d_in, const int* in_sizes, int n_in, void* d_out, int out_size, void* d_ws, size_t ws_size, hipStream_t stream) {
    static int grid = 0;
    if (grid == 0) {
        if (n_in != 24 || out_size != (int)O_END || ws_size < WS_END) { fprintf(stderr, "kernel_launch: unexpected sizes n_in %d out %d ws %zu\n", n_in, out_size, ws_size); grid = -1; return; }
        int dev = 0, cus = 0;
        if (hipGetDevice(&dev) != hipSuccess || hipDeviceGetAttribute(&cus, hipDeviceAttributeMultiprocessorCount, dev) != hipSuccess) { grid = -1; return; }
        if (hipFuncSetAttribute((const void*)hymba_fwd, hipFuncAttributeMaxDynamicSharedMemorySize, LDS_BYTES) != hipSuccess) { fprintf(stderr, "kernel_launch: hipFuncSetAttribute failed\n"); grid = -1; return; }
        (void)hipGetLastError();
        grid = cus;
    }
    if (grid < 0) return;
    (void)hipMemsetAsync((char*)d_ws + WS_CTL, 0, CTL_ZERO_BYTES, stream);
    Args a{};
    for (int i = 0; i < 24; ++i) a.in[i] = (const float*)d_in[i];
    a.out = (float*)d_out; a.ws = (unsigned char*)d_ws;
#if MK_SINGLE
    a.ph_lo = 0; a.ph_hi = PH_COUNT;
    hipLaunchKernelGGL(hymba_fwd, dim3(grid), dim3(NTHREADS), LDS_BYTES, stream, a);
#else
    for (int p = 0; p < PH_COUNT; ++p) { a.ph_lo = p; a.ph_hi = p + 1; hipLaunchKernelGGL(hymba_fwd, dim3(grid), dim3(NTHREADS), LDS_BYTES, stream, a); }
#endif
}
```

```cpp
#include <hip/hip_runtime.h>
#include <cstdio>
#include <cstdint>
#include <cmath>
namespace pg8 {
#define PG8_LAS __attribute__((address_space(3)))
typedef unsigned short bf16_t;
typedef short bf16x8 __attribute__((ext_vector_type(8)));
typedef float f32x4 __attribute__((ext_vector_type(4)));
typedef unsigned u32x4 __attribute__((ext_vector_type(4)));
constexpr int BM = 256, BK = 64, HALF = 128, HTB = HALF * BK * 2  , STAGE_BYTES = 8 * HTB, NXCD = 8, WGM = 8;

__host__ __device__ __forceinline__ int lds_byte(int r, int c) { const int st = (r >> 4) * 2 + (c >> 5), rr = r & 15, cc = c & 31, ob = rr * 64 + cc * 2; return st * 1024 + (ob ^ (((ob >> 9) & 1) << 5)); }
__host__ __device__ __forceinline__ void stage_rc(int b, int& R, int& C) { const int st = b / 1024, sb = b % 1024, swz = sb ^ (((sb >> 9) & 1) << 5); R = (st >> 1) * 16 + swz / 64; C = (st & 1) * 32 + (swz % 64) / 2; }
__host__ __device__ __forceinline__ int perm32(int rho) { const int n = rho >> 4, i = rho & 15; return 8 * (i >> 2) + 4 * n + (i & 3); }

struct Unit { int pm, pn; };
struct Gemm { const bf16_t* A; const bf16_t* Bt; int M, N, K; };

struct StaticOrder {
    int nM, nN, nwg, G, c;
    __host__ __device__ void init(int M, int N, int G_, int c_) { nM = M / BM; nN = N / BM; nwg = nM * nN; G = G_; c = c_; }
    __host__ __device__ bool next(int i, Unit& u) const {
        const long L = (long)i * G + c; if (L >= nwg) return false;
        int wgid = (int)L; { const int q = nwg / NXCD, r = nwg % NXCD, xcd = wgid % NXCD, off = wgid / NXCD; wgid = (xcd < r ? xcd * (q + 1) : r * (q + 1) + (xcd - r) * q) + off; }
        const int nig = WGM * nN, gid = wgid / nig, fm = gid * WGM, gsz = (nM - fm) < WGM ? (nM - fm) : WGM;
        u.pm = fm + ((wgid % nig) % gsz); u.pn = (wgid % nig) / gsz; return true;
    }
    __device__ __forceinline__ void a_ready(const Unit&) const {}
    __device__ __forceinline__ void done(const Unit&) const {}
};

__device__ __forceinline__ unsigned cvt_pk_bf16(float lo, float hi) { unsigned r; asm volatile("v_cvt_pk_bf16_f32 %0, %1, %2" : "=v"(r) : "v"(lo), "v"(hi)); return r; }
typedef float f32x2 __attribute__((ext_vector_type(2)));
constexpr int MODLD_ = 49152;
__device__ __forceinline__ float fast_sigmoid(float x) { return __builtin_amdgcn_rcpf(1.0f + __expf(-x)); }
struct EpiZ {
    static constexpr bool PERM = true, AFTER_DRAIN = false;
    bf16_t* O; int ldc;
    __device__ __forceinline__ void operator()(const f32x4 (&acc)[2][2][4][2], const Unit& u, int wr, int wc, int fr, int fq) const {
        const int row0 = u.pm * BM + wr * 64 + fr, col0 = u.pn * BM + wc * 32 + 8 * fq;
#pragma unroll
        for (int ai = 0; ai < 2; ++ai)
#pragma unroll
            for (int m = 0; m < 4; ++m) { bf16_t* rowp = O + (size_t)(row0 + ai * HALF + m * 16) * ldc + col0;
#pragma unroll
                for (int bj = 0; bj < 2; ++bj) { const f32x4 v0 = acc[ai][bj][m][0], v1 = acc[ai][bj][m][1];
                    u32x4 w; w.x = cvt_pk_bf16(v0[0], v0[1]); w.y = cvt_pk_bf16(v0[2], v0[3]); w.z = cvt_pk_bf16(v1[0], v1[1]); w.w = cvt_pk_bf16(v1[2], v1[3]);
                    *(u32x4*)(rowp + bj * HALF) = w; } }
    }
};
struct EpiSwiGLU {
    static constexpr bool PERM = true, AFTER_DRAIN = false;
    bf16_t* O; int ldc;
    __device__ __forceinline__ void operator()(const f32x4 (&acc)[2][2][4][2], const Unit& u, int wr, int wc, int fr, int fq) const {
        const int row0 = u.pm * BM + wr * 64 + fr, col0 = u.pn * HALF + wc * 32 + 8 * fq;
#pragma unroll
        for (int ai = 0; ai < 2; ++ai)
#pragma unroll
            for (int m = 0; m < 4; ++m) { bf16_t* rowp = O + (size_t)(row0 + ai * HALF + m * 16) * ldc + col0;
                float r[8];
#pragma unroll
                for (int n = 0; n < 2; ++n)
#pragma unroll
                    for (int i = 0; i < 4; ++i) { const float g = acc[ai][0][m][n][i], up = acc[ai][1][m][n][i]; r[n * 4 + i] = g * fast_sigmoid(g) * up; }
                u32x4 w; w.x = cvt_pk_bf16(r[0], r[1]); w.y = cvt_pk_bf16(r[2], r[3]); w.z = cvt_pk_bf16(r[4], r[5]); w.w = cvt_pk_bf16(r[6], r[7]);
                *(u32x4*)rowp = w; }
    }
};
struct EpiResid {
    static constexpr bool PERM = false, AFTER_DRAIN = false;
    float* X; const float* gate; float* XS;
    __device__ __forceinline__ void operator()(const f32x4 (&acc)[2][2][4][2], const Unit& u, int wr, int wc, int fr, int fq) const {
        const int col0 = u.pn * BM + wc * 32 + 4 * fq;
        if (u.pm < 32) {
            const float* g = gate + (size_t)(u.pm >> 3) * MODLD_ + col0;
            f32x4 gv[2][2];
#pragma unroll
            for (int bj = 0; bj < 2; ++bj)
#pragma unroll
                for (int n = 0; n < 2; ++n) gv[bj][n] = *(const f32x4*)(g + bj * HALF + n * 16);
#pragma unroll
            for (int ai = 0; ai < 2; ++ai)
#pragma unroll
                for (int m = 0; m < 4; ++m) { const size_t xo = (size_t)(u.pm * BM + ai * HALF + wr * 64 + m * 16 + fr) * 2048 + col0; const float* xp = X + xo; float* xs = XS + xo;
#pragma unroll
                    for (int bj = 0; bj < 2; ++bj)
#pragma unroll
                        for (int n = 0; n < 2; ++n) { f32x4 xv = *(const f32x4*)(xp + bj * HALF + n * 16); xv = xv + gv[bj][n] * acc[ai][bj][m][n]; *(f32x4*)(xs + bj * HALF + n * 16) = xv; } }
        } else {
#pragma unroll
            for (int m = 0; m < 4; ++m) { const int rl = wr * 64 + m * 16 + fr;
                const float* g = gate + (size_t)(4 + (rl >> 2)) * MODLD_ + col0; float* xp = X + (size_t)(8192 + rl) * 2048 + col0;
#pragma unroll
                for (int bj = 0; bj < 2; ++bj)
#pragma unroll
                    for (int n = 0; n < 2; ++n) { const f32x4 gvv = *(const f32x4*)(g + bj * HALF + n * 16); f32x4 xv = *(const f32x4*)(xp + bj * HALF + n * 16);
                        xv = xv + gvv * acc[0][bj][m][n]; *(f32x4*)(xp + bj * HALF + n * 16) = xv; } }
        }
    }
};
struct EpiMod {
    static constexpr bool PERM = false, AFTER_DRAIN = false;
    float* M; const float* bias;
    __device__ __forceinline__ void operator()(const f32x4 (&acc)[2][2][4][2], const Unit& u, int wr, int wc, int fr, int fq) const {
        if (wr != 0) return;
        const int col0 = u.pn * BM + wc * 32 + 4 * fq;
#pragma unroll
        for (int m = 0; m < 3; ++m) { const int r = m * 16 + fr;
            if (r < 36) {
#pragma unroll
                for (int bj = 0; bj < 2; ++bj)
#pragma unroll
                    for (int n = 0; n < 2; ++n) { const f32x4 bv = *(const f32x4*)(bias + col0 + bj * HALF + n * 16);
                        *(f32x4*)(M + (size_t)r * MODLD_ + col0 + bj * HALF + n * 16) = acc[0][bj][m][n] + bv; } } }
    }
};

template <class Epi, class Sched, bool ALIGN_EPI = false, bool SP2 = false>
__device__ __forceinline__ void gemm_phase(PG8_LAS unsigned char* lds, const Gemm g, const Sched& S, const Epi& E, int wid_in) {
    int lane_ = (int)__builtin_amdgcn_mbcnt_hi(~0u, __builtin_amdgcn_mbcnt_lo(~0u, 0u)); asm volatile("" : "+v"(lane_));
    const int wid = __builtin_amdgcn_readfirstlane(wid_in), lane = lane_, tid = wid * 64 + lane, wr = wid >> 2, wc = wid & 3, fr = lane & 15, fq = lane >> 4;
    int K_ = g.K; asm volatile("" : "+s"(K_));
    const int K = K_, nt = K / BK;
    unsigned voffA[2], voffB[2];
#pragma unroll
    for (int i = 0; i < 2; ++i) { int R, C; stage_rc(tid * 16 + i * 8192, R, C); const int Rb = Epi::PERM ? ((R & ~31) + perm32(R & 31)) : R;
        voffA[i] = (unsigned)(R * K + C) * 2u; voffB[i] = (unsigned)(Rb * K + C) * 2u; }
    const size_t kstep = (size_t)(BK * 2);
    const size_t hstep = (size_t)HALF * K * 2;
    const size_t tstep = 2 * hstep;
    const unsigned ldsw = (unsigned)wid * 1024u;
    const int aoff = lds_byte(wr * 64 + fr, fq * 8), boff = lds_byte(wc * 32 + fr, fq * 8);
#define PG8_SA(b, h) (((b) * 2 + (h)) * HTB)
#define PG8_SB(b, h) ((4 + (b) * 2 + (h)) * HTB)
#define PG8_STAGE(bufoff, gbase, voff) do { _Pragma("unroll") for (int _i = 0; _i < 2; ++_i) \
        __builtin_amdgcn_global_load_lds((const unsigned*)((const char*)(gbase) + (voff)[_i]), (PG8_LAS unsigned*)(lds + (bufoff) + ldsw + _i * 8192), 16, 0, 0); } while (0)
#define PG8_LDA(dst, b, h) do { _Pragma("unroll") for (int m = 0; m < 4; ++m) _Pragma("unroll") for (int k = 0; k < 2; ++k) dst[m][k] = *(const PG8_LAS bf16x8*)(lds + PG8_SA(b, h) + aoff + m * 2048 + k * 1024); } while (0)
#define PG8_LDB(dst, b, h) do { _Pragma("unroll") for (int n = 0; n < 2; ++n) _Pragma("unroll") for (int k = 0; k < 2; ++k) dst[n][k] = *(const PG8_LAS bf16x8*)(lds + PG8_SB(b, h) + boff + n * 2048 + k * 1024); } while (0)
#define PG8_MMA(ai, bj, At, Bt) do { __builtin_amdgcn_s_setprio(1); _Pragma("unroll") for (int m = 0; m < 4; ++m) _Pragma("unroll") for (int n = 0; n < 2; ++n) _Pragma("unroll") for (int k = 0; k < 2; ++k) \
        acc[ai][bj][m][n] = __builtin_amdgcn_mfma_f32_16x16x32_bf16(Bt[n][k], At[m][k], acc[ai][bj][m][n], 0, 0, 0); __builtin_amdgcn_s_setprio(0); } while (0)
#define PG8_WAIT_V(n) asm volatile("s_waitcnt vmcnt(" #n ")" ::: "memory")
#define PG8_WAIT_L(n) asm volatile("s_waitcnt lgkmcnt(" #n ")" ::: "memory")
#define PG8_BAR __builtin_amdgcn_s_barrier()
#define PG8_SCHED __builtin_amdgcn_sched_barrier(0)
    Unit cur, nxt; int ui = 0;
    if (!S.next(0, cur)) return;
    f32x4 acc[2][2][4][2];
#pragma unroll
    for (int a = 0; a < 2; ++a)
#pragma unroll
        for (int b = 0; b < 2; ++b)
#pragma unroll
            for (int m = 0; m < 4; ++m)
#pragma unroll
                for (int n = 0; n < 2; ++n) acc[a][b][m][n] = (f32x4){0.f, 0.f, 0.f, 0.f};
    bf16x8 At[4][2], B0[2][2], B1[2][2];
    const char* cA = (const char*)g.A + (size_t)cur.pm * tstep; const char* cB = (const char*)g.Bt + (size_t)cur.pn * tstep;
    S.a_ready(cur);
    if constexpr (SP2) {
        PG8_STAGE(PG8_SB(0, 0), cB, voffB); PG8_STAGE(PG8_SB(0, 1), cB + hstep, voffB); PG8_STAGE(PG8_SA(0, 0), cA, voffA); PG8_STAGE(PG8_SA(0, 1), cA + hstep, voffA);
        if (wr == 1) PG8_BAR;
        PG8_WAIT_V(2); PG8_BAR;
        PG8_STAGE(PG8_SB(1, 0), cB + kstep, voffB); PG8_STAGE(PG8_SA(1, 0), cA + kstep, voffA); PG8_STAGE(PG8_SB(1, 1), cB + hstep + kstep, voffB);
        PG8_WAIT_V(6); PG8_BAR;
    } else {
        PG8_STAGE(PG8_SB(0, 0), cB, voffB); PG8_STAGE(PG8_SA(0, 0), cA, voffA); PG8_STAGE(PG8_SB(0, 1), cB + hstep, voffB); PG8_STAGE(PG8_SA(0, 1), cA + hstep, voffA);
        if (wr == 1) PG8_BAR;
        PG8_WAIT_V(4); PG8_BAR;
        PG8_STAGE(PG8_SB(1, 0), cB + kstep, voffB); PG8_STAGE(PG8_SA(1, 0), cA + kstep, voffA); PG8_STAGE(PG8_SB(1, 1), cB + hstep + kstep, voffB);
        PG8_WAIT_V(6); PG8_BAR;
    }
    for (;;) {
        const bool has_next = S.next(ui + 1, nxt);
        const char* nA = has_next ? (const char*)g.A + (size_t)nxt.pm * tstep : cA; const char* nB = has_next ? (const char*)g.Bt + (size_t)nxt.pn * tstep : cB;
        for (int t = 0; t < nt; t += 2) {
            const bool last = (t == nt - 2);
            const char* a1 = cA + (size_t)(t + 1) * kstep;
            const char* a2 = last ? nA : cA + (size_t)(t + 2) * kstep; const char* b2 = last ? nB : cB + (size_t)(t + 2) * kstep;
            const char* a3 = a2 + kstep; const char* b3 = b2 + kstep;
            if (last && has_next) S.a_ready(nxt);
            if constexpr (SP2) {
            PG8_LDB(B0, 0, 0); PG8_LDB(B1, 0, 1); PG8_SCHED; PG8_LDA(At, 0, 0); PG8_STAGE(PG8_SA(1, 1), a1 + hstep, voffA);
            PG8_WAIT_V(8); PG8_WAIT_L(0); PG8_BAR; PG8_MMA(0, 0, At, B0); PG8_MMA(0, 1, At, B1); PG8_BAR; PG8_SCHED;
            PG8_LDA(At, 0, 1); PG8_STAGE(PG8_SB(0, 0), b2, voffB); PG8_STAGE(PG8_SB(0, 1), b2 + hstep, voffB); PG8_STAGE(PG8_SA(0, 0), a2, voffA);
            PG8_WAIT_V(8); PG8_WAIT_L(0); PG8_BAR; PG8_MMA(1, 0, At, B0); PG8_MMA(1, 1, At, B1); PG8_BAR; PG8_SCHED;
            PG8_LDB(B0, 1, 0); PG8_LDB(B1, 1, 1); PG8_SCHED; PG8_LDA(At, 1, 0); PG8_STAGE(PG8_SA(0, 1), a2 + hstep, voffA);
            PG8_WAIT_V(8); PG8_WAIT_L(0); PG8_BAR; PG8_MMA(0, 0, At, B0); PG8_MMA(0, 1, At, B1); PG8_BAR; PG8_SCHED;
            PG8_LDA(At, 1, 1); PG8_STAGE(PG8_SB(1, 0), b3, voffB); PG8_STAGE(PG8_SB(1, 1), b3 + hstep, voffB); PG8_STAGE(PG8_SA(1, 0), a3, voffA);
            PG8_WAIT_V(8); PG8_WAIT_L(0); PG8_BAR; PG8_MMA(1, 0, At, B0); PG8_MMA(1, 1, At, B1); PG8_BAR; PG8_SCHED;
            } else {
            PG8_LDB(B0, 0, 0); PG8_SCHED; PG8_LDA(At, 0, 0); PG8_STAGE(PG8_SA(1, 1), a1 + hstep, voffA);
            PG8_WAIT_L(8); PG8_BAR; PG8_WAIT_L(0); PG8_MMA(0, 0, At, B0); PG8_BAR; PG8_SCHED;
            PG8_LDB(B1, 0, 1); PG8_STAGE(PG8_SB(0, 0), b2, voffB);
            PG8_BAR; PG8_WAIT_L(0); PG8_MMA(0, 1, At, B1); PG8_BAR;
            PG8_LDA(At, 0, 1); PG8_STAGE(PG8_SA(0, 0), a2, voffA);
            PG8_BAR; PG8_WAIT_L(0); PG8_MMA(1, 0, At, B0); PG8_BAR; PG8_SCHED;
            PG8_STAGE(PG8_SB(0, 1), b2 + hstep, voffB);
            PG8_WAIT_V(6); PG8_BAR; PG8_MMA(1, 1, At, B1); PG8_BAR;
            PG8_LDB(B0, 1, 0); PG8_SCHED; PG8_LDA(At, 1, 0); PG8_STAGE(PG8_SA(0, 1), a2 + hstep, voffA);
            PG8_WAIT_L(8); PG8_BAR; PG8_WAIT_L(0); PG8_MMA(0, 0, At, B0); PG8_BAR; PG8_SCHED;
            PG8_LDB(B1, 1, 1); PG8_STAGE(PG8_SB(1, 0), b3, voffB);
            PG8_BAR; PG8_WAIT_L(0); PG8_MMA(0, 1, At, B1); PG8_BAR;
            PG8_LDA(At, 1, 1); PG8_STAGE(PG8_SA(1, 0), a3, voffA);
            PG8_BAR; PG8_WAIT_L(0); PG8_MMA(1, 0, At, B0); PG8_BAR; PG8_SCHED;
            PG8_STAGE(PG8_SB(1, 1), b3 + hstep, voffB);
            PG8_WAIT_V(6); PG8_BAR; PG8_MMA(1, 1, At, B1); PG8_BAR;
            }
        }
        if constexpr (ALIGN_EPI) { if (wr == 0) PG8_BAR; }
        if constexpr (!Epi::AFTER_DRAIN) { E(acc, cur, wr, wc, fr, fq); S.done(cur); }
        if (!has_next) break;
#pragma unroll
        for (int a = 0; a < 2; ++a)
#pragma unroll
            for (int b = 0; b < 2; ++b)
#pragma unroll
                for (int m = 0; m < 4; ++m)
#pragma unroll
                    for (int n = 0; n < 2; ++n) acc[a][b][m][n] = (f32x4){0.f, 0.f, 0.f, 0.f};
        cur = nxt; cA = nA; cB = nB; ++ui;
        if constexpr (ALIGN_EPI) { if (wr == 1) PG8_BAR; }
    }
    PG8_WAIT_V(0);
    if constexpr (!ALIGN_EPI) { if (wr == 0) PG8_BAR; }
    PG8_BAR;
    if constexpr (Epi::AFTER_DRAIN) { E.fused(acc, cur, wr, wc, fr, fq, lds, wid, lane); S.done(cur); }
#undef PG8_SA
#undef PG8_SB
#undef PG8_STAGE
#undef PG8_LDA
#undef PG8_LDB
#undef PG8_MMA
#undef PG8_WAIT_V
#undef PG8_WAIT_L
#undef PG8_BAR
#undef PG8_SCHED
}
}
#define GAS __attribute__((address_space(1)))
#define LAS __attribute__((address_space(3)))
typedef unsigned short bf16;
typedef unsigned v4u __attribute__((ext_vector_type(4)));
typedef float f32x4 __attribute__((ext_vector_type(4)));
typedef short bf16x8 __attribute__((ext_vector_type(8)));
typedef GAS unsigned gu32;
typedef GAS unsigned long long gu64;
#define RLX_AGENT __ATOMIC_RELAXED, __HIP_MEMORY_SCOPE_AGENT
#define LDS_WAIT() asm volatile("s_waitcnt lgkmcnt(0)" ::: "memory")
#define VM_WAIT() asm volatile("s_waitcnt vmcnt(0)" ::: "memory")
__device__ __forceinline__ unsigned long long rt() { return __builtin_amdgcn_s_memrealtime(); }
__device__ __forceinline__ unsigned f2bf(float f) { unsigned u = __builtin_bit_cast(unsigned, f); return (u + 0x7fffu + ((u >> 16) & 1u)) >> 16; }
__device__ __forceinline__ unsigned pk2(float lo, float hi) { return f2bf(lo) | (f2bf(hi) << 16); }

#define XB_TMO      128
#define XB_XCNT(j)  (256  + 64 * (j))
#define XB_XSUB(j)  (1280 + 64 * (j))
#define XB_XGEN(j)  (2304 + 64 * (j))
#define XB_TOP      3328
#define XB_TOPGEN   3392
#define XCD_BAR_WORDS 3456
#define XB_SPIN_CAP (1u << 18)

__device__ __forceinline__ unsigned xb_ld(unsigned* p)              { return __hip_atomic_load(p, __ATOMIC_RELAXED, __HIP_MEMORY_SCOPE_AGENT); }
__device__ __forceinline__ unsigned xb_add(unsigned* p, unsigned v) { return __hip_atomic_fetch_add(p, v, __ATOMIC_RELAXED, __HIP_MEMORY_SCOPE_AGENT); }
__device__ __forceinline__ unsigned xb_xcc_id() { return (unsigned)__builtin_amdgcn_s_getreg((3 << 11) | 20) & 0xFu; }
#define XB_SPIN(cond, bar) do { unsigned _sp = 0; while (cond) { __builtin_amdgcn_s_sleep(1); \
    if ((++_sp & 255u) == 0u) { if (xb_ld(&(bar)[XB_TMO])) break; if (_sp > XB_SPIN_CAP) { atomicAdd(&(bar)[XB_TMO], 1u); break; } } } } while (0)

struct XcdBarrier {
    unsigned* bar; unsigned x;
    volatile LAS unsigned* st;
};

__device__ __forceinline__ XcdBarrier xcd_barrier_post(unsigned* bar, volatile LAS unsigned* st) {
    XcdBarrier b; b.bar = bar; b.x = xb_xcc_id(); b.st = st;
    if (threadIdx.x == 0) (void)xb_add(&bar[XB_XCNT(b.x)], 1u);
    return b;
}
__device__ __forceinline__ void xcd_barrier_complete(unsigned* bar, unsigned x, unsigned& nloc, unsigned& nx) {
    const unsigned G = gridDim.x * gridDim.y * gridDim.z;
    unsigned sum, cnt, mine, sp = 0u;
    for (;;) {
        sum = 0u; cnt = 0u; mine = 0u;
#pragma unroll
        for (unsigned j = 0; j < 16; ++j) { const unsigned c = xb_ld(&bar[XB_XCNT(j)]); sum += c; cnt += (c > 0u) ? 1u : 0u; mine = (j == x) ? c : mine; }
        if (sum == G) break;
        __builtin_amdgcn_s_sleep(1);
        if ((++sp & 255u) == 0u) { if (xb_ld(&bar[XB_TMO])) break; if (sp > XB_SPIN_CAP) { atomicAdd(&bar[XB_TMO], 1u); break; } }
    }
    nloc = mine > 0u ? mine : 1u; nx = cnt > 0u ? cnt : 1u;
}

__device__ __forceinline__ void xcd_barrier(const XcdBarrier& b) {
    asm volatile("s_waitcnt vmcnt(0)" ::: "memory");
    __syncthreads();
    if (threadIdx.x == 0) {
        unsigned* bar = b.bar;
        __builtin_amdgcn_s_waitcnt(0);
        unsigned nloc = b.st[0], nx = b.st[1];
        if (nloc == 0u) { xcd_barrier_complete(bar, b.x, nloc, nx); b.st[0] = nloc; b.st[1] = nx; }
        const unsigned old = xb_add(&bar[XB_XSUB(b.x)], 1u);
        const unsigned gen = old / nloc;
        if (old + 1u == (gen + 1u) * nloc) {
            __builtin_amdgcn_fence(__ATOMIC_RELEASE, "agent");
            asm volatile("s_waitcnt vmcnt(0)" ::: "memory");
            const unsigned og = xb_add(&bar[XB_TOP], 1u);
            const unsigned tg = og / nx;
            if (og + 1u == (tg + 1u) * nx) xb_add(&bar[XB_TOPGEN], 1u);
            else XB_SPIN(xb_ld(&bar[XB_TOPGEN]) == tg, bar);
            __builtin_amdgcn_fence(__ATOMIC_ACQUIRE, "agent");
            xb_add(&bar[XB_XGEN(b.x)], 1u);
            asm volatile("s_waitcnt vmcnt(0)" ::: "memory");
        } else {
            XB_SPIN(xb_ld(&bar[XB_XGEN(b.x)]) == gen, bar);
            __builtin_amdgcn_fence(__ATOMIC_ACQUIRE, "agent");
            asm volatile("s_waitcnt vmcnt(0)" ::: "memory");
        }
    }
    __syncthreads();
}

constexpr int NWAVES = 8, NTHREADS = 512;
constexpr int DM = 2048, NP_ROWS = 8192, NS_ROWS = 128, NROWS = 8320, MPAD = 8448;
constexpr int DEPTH = 4, NBATCH = 36;
constexpr int INW = 4368, ZW = 4608;
constexpr int ZQ = 0, ZK = 512, ZV = 640, ZU = 768, GQ = 1280, GK = 1792, GV = 2304, GG = 3328, GA = 4352;
constexpr int DFF = 5632, NGU = 11264, MODW = 12288, MODLD = 49152;
constexpr float EPS = 1e-6f;
constexpr size_t O_Y = 0, O_WK_P = 17039360, O_WV_P = 17301504, O_POOL_P = 17563648, O_GLA_P = 17686528,
                 O_WK_S = 19783680, O_WV_S = 21880832, O_POOL_S = 23977984, O_GLA_S = 24961024, O_END = 41738240;
constexpr size_t MiB = 1u << 20;
constexpr size_t WS_CTL = 0, CTL_ZERO_BYTES = 1 * MiB;
constexpr size_t WS_WADA = 1 * MiB;
constexpr size_t WS_WIN  = WS_WADA + 192 * MiB;
constexpr size_t WS_WOUT = WS_WIN + 72 * MiB;
constexpr size_t WS_WGU  = WS_WOUT + 32 * MiB;
constexpr size_t WS_WDN  = WS_WGU + 176 * MiB;
constexpr size_t WS_X    = WS_WDN + 88 * MiB;
constexpr size_t WS_H    = WS_X + 66 * MiB;
constexpr size_t WS_Z    = WS_H + 33 * MiB;
constexpr size_t WS_MIX  = WS_Z + 75 * MiB;
constexpr size_t WS_ACT  = WS_MIX + 33 * MiB;
constexpr size_t WS_OGLA = WS_ACT + 91 * MiB;
constexpr size_t WS_LA   = WS_OGLA + 33 * MiB;
constexpr size_t WS_MOD  = WS_LA + 17 * MiB;
constexpr size_t WS_SC   = WS_MOD + 7 * MiB;
constexpr size_t WS_BTAB = WS_SC + 1 * MiB;
constexpr size_t WS_WPT  = WS_BTAB + 1 * MiB;
constexpr size_t WS_QDG  = WS_WPT + 1 * MiB;
constexpr size_t WS_KDTG = WS_QDG + 9 * MiB;
constexpr size_t WS_VTG  = WS_KDTG + 11 * MiB;
constexpr size_t WS_DLG  = WS_VTG + 21 * MiB;
constexpr size_t WS_DUMMY = WS_DLG + 1 * MiB;
constexpr size_t WS_END  = WS_DUMMY + 66 * MiB;
constexpr int CW_BAR = 4096;
constexpr int RING_OFF = 0, RING_BYTES = 131072;
constexpr int LDSCTL_OFF = RING_BYTES, MISC_OFF = LDSCTL_OFF + 320;
constexpr int LDS_BYTES = 147456;

struct Args { const float* in[24]; float* out; unsigned char* ws; int ph_lo, ph_hi; };
struct Frame {
    LAS unsigned char* lds;
    volatile LAS unsigned* MISC;
    int wave, vcu, G; int zo; int probe;
    __device__ __forceinline__ float* X_ST() const { return (float*)(ws + (probe ? WS_DUMMY : WS_X)); }
    __device__ __forceinline__ float* OGLA_ST() const { return (float*)(ws + (probe ? WS_DUMMY : WS_OGLA)); }
    __device__ __forceinline__ int lane_id() const { return (int)__builtin_amdgcn_mbcnt_hi(~0u, __builtin_amdgcn_mbcnt_lo(~0u, 0u)); }
    unsigned char* ws; float* out;
    __device__ __forceinline__ bf16* Wada_t() const { return (bf16*)(ws + WS_WADA); }
    __device__ __forceinline__ bf16* Win_t() const { return (bf16*)(ws + WS_WIN); }
    __device__ __forceinline__ bf16* Wout_t() const { return (bf16*)(ws + WS_WOUT); }
    __device__ __forceinline__ bf16* Wgu_t() const { return (bf16*)(ws + WS_WGU); }
    __device__ __forceinline__ bf16* Wdn_t() const { return (bf16*)(ws + WS_WDN); }
    __device__ __forceinline__ float* X() const { return (float*)(ws + WS_X); }
    __device__ __forceinline__ bf16* H() const { return (bf16*)(ws + WS_H); }
    __device__ __forceinline__ bf16* Z() const { return (bf16*)(ws + WS_Z); }
    __device__ __forceinline__ bf16* MIX() const { return (bf16*)(ws + WS_MIX); }
    __device__ __forceinline__ bf16* ACT() const { return (bf16*)(ws + WS_ACT); }
    __device__ __forceinline__ float* OGLA() const { return (float*)(ws + WS_OGLA); }
    __device__ __forceinline__ float* SLOC() const { return (float*)(ws + WS_LA); }
    __device__ __forceinline__ float* DSEG() const { return (float*)(ws + WS_LA + 16 * MiB); }
    __device__ __forceinline__ float* MOD() const { return (float*)(ws + WS_MOD); }
    __device__ __forceinline__ bf16* SC() const { return (bf16*)(ws + WS_SC); }
    __device__ __forceinline__ float* BTAB() const { return (float*)(ws + WS_BTAB); }
    __device__ __forceinline__ bf16* WPT() const { return (bf16*)(ws + WS_WPT); }
    __device__ __forceinline__ bf16* QDG() const { return (bf16*)(ws + WS_QDG); }
    __device__ __forceinline__ bf16* KDTG() const { return (bf16*)(ws + WS_KDTG); }
    __device__ __forceinline__ bf16* VTG() const { return (bf16*)(ws + WS_VTG); }
    __device__ __forceinline__ float* DLG() const { return (float*)(ws + WS_DLG); }
};
enum { I_XP = 0, I_XS, I_CK, I_CV, I_SPOOL, I_SGLA, I_CP, I_CS, I_WADA, I_BADA, I_GMIX, I_GFFN, I_WIN, I_WOUT, I_RELB, I_SINKS, I_WPOOL, I_PSCALE, I_WA2, I_BA2, I_GGLA, I_WGU, I_WDN, I_GFIN };

__device__ __forceinline__ float bf2f(unsigned short b) { return __uint_as_float((unsigned)b << 16); }
__device__ __forceinline__ float bflo(unsigned w) { return __uint_as_float(w << 16); }
__device__ __forceinline__ float bfhi(unsigned w) { return __uint_as_float(w & 0xffff0000u); }
__device__ __forceinline__ float wave_sum(float v) {
#pragma unroll
    for (int o = 1; o < 64; o <<= 1) v += __shfl_xor(v, o);
    return v;
}
__device__ __forceinline__ float wave_max(float v) {
#pragma unroll
    for (int o = 1; o < 64; o <<= 1) v = fmaxf(v, __shfl_xor(v, o));
    return v;
}
__device__ __forceinline__ int t5_bucket(int n) {
    if (n < 16) return n;
    return 16 + (n >= 19) + (n >= 21) + (n >= 24) + (n >= 27) + (n >= 31) + (n >= 35) + (n >= 40) + (n >= 46) + (n >= 52) + (n >= 59) + (n >= 67) + (n >= 77) + (n >= 87) + (n >= 99) + (n >= 113);
}

template <int MODE>
__device__ __forceinline__ void transpose_item(const float* W, int K, int N, int nblk, bf16* WT, int row_off, LAS float* scr, int item, int lane) {
    const int kb = item / nblk, nb = item % nblk, k0 = 64 * kb, n0 = 32 * nb;
    const int nn = n0 + (lane & 31); const bool ok = nn < N;
    float wv[32];
#pragma unroll
    for (int i = 0; i < 32; ++i) { const int kk = 2 * i + (lane >> 5); wv[i] = ok ? W[(size_t)(k0 + kk) * N + nn] : 0.f; }
#pragma unroll
    for (int i = 0; i < 32; ++i) { const int kk = 2 * i + (lane >> 5); scr[kk * 33 + (lane & 31)] = wv[i]; }
    LDS_WAIT(); asm volatile("" ::: "memory");
    const int c = lane & 7;
#pragma unroll
    for (int j = 0; j < 4; ++j) { const int n = (lane >> 3) + 8 * j; const LAS float* s = scr + (8 * c) * 33 + n;
        v4u o; o.x = pk2(s[0 * 33], s[1 * 33]); o.y = pk2(s[2 * 33], s[3 * 33]); o.z = pk2(s[4 * 33], s[5 * 33]); o.w = pk2(s[6 * 33], s[7 * 33]);
        int orow = n0 + n;
        if (MODE == 1) { orow = (orow < DFF) ? ((orow >> 7) * 256 + (orow & 127)) : (((orow - DFF) >> 7) * 256 + 128 + ((orow - DFF) & 127)); }
        *(GAS v4u*)(WT + (size_t)(row_off + orow) * K + k0 + 8 * c) = o; }
    LDS_WAIT(); asm volatile("" ::: "memory");
}
__device__ __forceinline__ void p0_prologue(Frame& F, const Args& A) {
    LAS float* scr = (LAS float*)(F.lds + RING_OFF + F.wave * 16384);
    const int gw = F.vcu * NWAVES + F.wave, NGW = F.G * NWAVES;
    const int gt = gw * 64 + F.lane_id(), NGT = NGW * 64;
    constexpr int I_ADA = 32 * 384, I_IN = 32 * 137, I_OUT = 32 * 64, I_GU = 32 * 352, I_DN = 88 * 64, I_L = I_ADA + I_IN + I_OUT + I_GU + I_DN;
    for (int it = gw; it < DEPTH * I_L; it += NGW) {
        const int l = it / I_L; int r = it - l * I_L;
        if (r < I_ADA) { transpose_item<0>(A.in[F.zo + I_WADA] + (size_t)l * DM * MODW, DM, MODW, 384, F.Wada_t(), l * MODW, scr, r, F.lane_id()); continue; } r -= I_ADA;
        if (r < I_IN)  { transpose_item<0>(A.in[F.zo + I_WIN] + (size_t)l * DM * INW, DM, INW, 137, F.Win_t() + (size_t)l * ZW * DM, 0, scr, r, F.lane_id()); continue; } r -= I_IN;
        if (r < I_OUT) { transpose_item<0>(A.in[F.zo + I_WOUT] + (size_t)l * DM * DM, DM, DM, 64, F.Wout_t() + (size_t)l * DM * DM, 0, scr, r, F.lane_id()); continue; } r -= I_OUT;
        if (r < I_GU)  { transpose_item<1>(A.in[F.zo + I_WGU] + (size_t)l * DM * NGU, DM, NGU, 352, F.Wgu_t() + (size_t)l * NGU * DM, 0, scr, r, F.lane_id()); continue; } r -= I_GU;
        transpose_item<0>(A.in[F.zo + I_WDN] + (size_t)l * DFF * DM, DFF, DM, 64, F.Wdn_t() + (size_t)l * DM * DFF, 0, scr, r, F.lane_id());
    }
    const v4u z4 = {0u, 0u, 0u, 0u};
    for (int i = gt; i < DEPTH * 224 * 256; i += NGT) { const int l = i / (224 * 256), r = i - l * (224 * 256); *((GAS v4u*)(F.Win_t() + ((size_t)l * ZW + 4384) * DM) + r) = z4; }
    for (int i = gt; i < 128 * 256; i += NGT) { *((GAS v4u*)(F.H() + (size_t)NROWS * DM) + i) = z4; *((GAS v4u*)(F.MIX() + (size_t)NROWS * DM) + i) = z4; }
    for (int i = gt; i < 128 * 704; i += NGT) *((GAS v4u*)(F.ACT() + (size_t)NROWS * DFF) + i) = z4;
    for (int i = gt; i < NP_ROWS * 512; i += NGT) ((GAS f32x4*)F.X())[i] = ((const GAS f32x4*)A.in[F.zo + I_XP])[i];
    for (int i = gt; i < NS_ROWS * 512; i += NGT) ((GAS f32x4*)(F.X() + (size_t)NP_ROWS * DM))[i] = ((const GAS f32x4*)A.in[F.zo + I_XS])[i];
    for (int i = gt; i < 256 * 1024; i += NGT) { const int r = i >> 10, cp = (i & 1023) * 2; unsigned w = 0u;
        if (r < NBATCH) { const float* c = (r < 4) ? (A.in[F.zo + I_CP] + (size_t)r * DM) : (A.in[F.zo + I_CS] + (size_t)(r - 4) * DM); const float a = c[cp], b = c[cp + 1];
            w = pk2(a / (1.0f + __expf(-a)), b / (1.0f + __expf(-b))); }
        ((GAS unsigned*)F.SC())[i] = w; }
    for (int i = gt; i < 4 * 4 * 128 * 128; i += NGT) { const int lg = i >> 14, dcol = (i >> 7) & 127, c = i & 127; F.WPT()[i] = (bf16)f2bf(A.in[F.zo + I_WPOOL][((size_t)lg * 128 + c) * 128 + dcol]); }
    for (int i = gt; i < 8 * 128; i += NGT) { const int h = i >> 7, dist = i & 127; F.BTAB()[i] = A.in[F.zo + I_RELB][t5_bucket(dist) * 8 + h]; }
}

__device__ __forceinline__ void norm_mod_rows(Frame& F, const float* g, const float* modl  ) {
    const int gw = F.vcu * NWAVES + F.wave, NGW = F.G * NWAVES;
    for (int r = gw; r < NROWS; r += NGW) {
        const int b = r < NP_ROWS ? (r >> 11) : 4 + ((r - NP_ROWS) >> 2);
        const float* xr = F.X() + (size_t)r * DM + 4 * F.lane_id(); const float* sh = modl + (size_t)b * MODLD + 4 * F.lane_id(); const float* gg = g + 4 * F.lane_id();
        f32x4 v[8]; float ss = 0.f;
#pragma unroll
        for (int j = 0; j < 8; ++j) { v[j] = *(const f32x4*)(xr + 256 * j); ss += (v[j].x * v[j].x + v[j].y * v[j].y) + (v[j].z * v[j].z + v[j].w * v[j].w); }
        const float rstd = 1.0f / sqrtf(wave_sum(ss) * (1.0f / DM) + EPS);
        bf16* hr = F.H() + (size_t)r * DM + 4 * F.lane_id();
#pragma unroll
        for (int j = 0; j < 8; ++j) { const f32x4 gv = *(const f32x4*)(gg + 256 * j), sv = *(const f32x4*)(sh + 256 * j), cv = *(const f32x4*)(sh + 2048 + 256 * j);
            const f32x4 y = (v[j] * rstd * gv) * (1.0f + cv) + sv;
            uint2 w; w.x = pk2(y.x, y.y); w.y = pk2(y.z, y.w); *(uint2*)(hr + 256 * j) = w; }
    }
}
__device__ __forceinline__ void final_norm_rows(Frame& F, const Args& A) {
    const int gw = F.vcu * NWAVES + F.wave, NGW = F.G * NWAVES; const float* g = A.in[F.zo + I_GFIN] + 4 * F.lane_id();
    for (int r = gw; r < NROWS; r += NGW) {
        const float* xr = F.X() + (size_t)r * DM + 4 * F.lane_id();
        f32x4 v[8]; float ss = 0.f;
#pragma unroll
        for (int j = 0; j < 8; ++j) { v[j] = *(const f32x4*)(xr + 256 * j); ss += (v[j].x * v[j].x + v[j].y * v[j].y) + (v[j].z * v[j].z + v[j].w * v[j].w); }
        const float rstd = 1.0f / sqrtf(wave_sum(ss) * (1.0f / DM) + EPS);
        float* yr = F.out + O_Y + (size_t)r * DM + 4 * F.lane_id();
#pragma unroll
        for (int j = 0; j < 8; ++j) { const f32x4 gv = *(const f32x4*)(g + 256 * j); *(f32x4*)(yr + 256 * j) = v[j] * rstd * gv; }
    }
}

__device__ __forceinline__ void attn_item(Frame& F, const Args& A, int l, int r, int hd, LAS float* ps) {
    const int lane = F.lane_id(), g = hd >> 2; const bool smp = r >= NP_ROWS;
    const int t = r & 2047, sb = smp ? ((r - NP_ROWS) >> 2) : 0, si = (r - NP_ROWS) & 3;
    LAS float* qs = ps + 128;
    { const unsigned w = ((const unsigned*)(F.Z() + (size_t)r * ZW + ZQ + hd * 64))[lane & 31]; if (lane < 32) { qs[2 * lane] = bflo(w); qs[2 * lane + 1] = bfhi(w); } }
    LDS_WAIT(); asm volatile("" ::: "memory");
    const float* ck = A.in[F.zo + I_CK] + ((size_t)(l * 32 + sb) * 128) * 128 + g * 64;
    const float* cv = A.in[F.zo + I_CV] + ((size_t)(l * 32 + sb) * 128) * 128 + g * 64;
    const int jmin = smp ? 0 : (t >= 127 ? 0 : 127 - t);
    float sc[2];
#pragma unroll 1
    for (int jj = 0; jj < 2; ++jj) {
        const int j = lane + 64 * jj, dist = 127 - j; float dot = 0.f; bool valid = j >= jmin;
        if (valid) {
            const int krel = si - dist;
            if (smp && krel < 0) {
                const f32x4* kp = (const f32x4*)(ck + (size_t)(krel + 128) * 128);
#pragma unroll 4
                for (int c = 0; c < 16; ++c) { const f32x4 kv = kp[c]; const f32x4 qv = *(const LAS f32x4*)(qs + 4 * c); dot += qv.x * kv.x + qv.y * kv.y + qv.z * kv.z + qv.w * kv.w; }
            } else {
                const int krow = smp ? (NP_ROWS + sb * 4 + krel) : (r - dist);
                const v4u* kp = (const v4u*)(F.Z() + (size_t)krow * ZW + ZK + g * 64);
#pragma unroll 4
                for (int c = 0; c < 8; ++c) { const v4u w = kp[c];
                    const f32x4 qa = *(const LAS f32x4*)(qs + 8 * c), qb = *(const LAS f32x4*)(qs + 8 * c + 4);
                    dot += qa.x * bflo(w.x) + qa.y * bfhi(w.x) + qa.z * bflo(w.y) + qa.w * bfhi(w.y) + qb.x * bflo(w.z) + qb.y * bfhi(w.z) + qb.z * bflo(w.w) + qb.w * bfhi(w.w); }
            }
        }
        const float sv = valid ? dot * 0.125f + F.BTAB()[hd * 128 + dist] : -INFINITY;
        if (jj == 0) sc[0] = sv; else sc[1] = sv;
    }
    const float sink = A.in[F.zo + I_SINKS][l * 8 + hd];
    const float m = fmaxf(wave_max(fmaxf(sc[0], sc[1])), sink);
    const float p0 = __expf(sc[0] - m), p1 = __expf(sc[1] - m);
    const float denom = wave_sum(p0 + p1) + __expf(sink - m);
    ps[lane] = p0; ps[lane + 64] = p1;
    LDS_WAIT(); asm volatile("" ::: "memory");
    float o = 0.f;
#pragma unroll 16
    for (int j = jmin; j < 128; ++j) {
        const float pj = ps[j]; const int dist = 127 - j; float vv;
        const int krel = si - dist;
        if (smp && krel < 0) vv = cv[(size_t)(krel + 128) * 128 + lane];
        else { const int krow = smp ? (NP_ROWS + sb * 4 + krel) : (r - dist); vv = bf2f(F.Z()[(size_t)krow * ZW + ZV + g * 64 + lane]); }
        o += pj * vv;
    }
    F.MIX()[(size_t)r * DM + hd * 64 + lane] = (bf16)f2bf(o / denom);
    LDS_WAIT(); asm volatile("" ::: "memory");
}
__device__ __forceinline__ void pool_item(Frame& F, const Args& A, int l, int r, int gi, LAS float* ds) {
    const int lane = F.lane_id(), w = 2 << gi; const bool smp = r >= NP_ROWS;
    const int t = r & 2047, sb = (r - NP_ROWS) >> 2, si = (r - NP_ROWS) & 3;
    const float* pbuf = A.in[F.zo + I_SPOOL] + ((size_t)(l * 32 + sb) * 15) * 512 + gi * 128;
    float s0 = 0.f, s1 = 0.f, u0 = 0.f, u1 = 0.f;
#pragma unroll 4
    for (int o = 0; o < w; ++o) {
        float a0 = 0.f, a1 = 0.f;
        if (!smp) { if (t - o >= 0) { const bf16* zp = F.Z() + (size_t)(r - o) * ZW + ZU + gi * 128; a0 = bf2f(zp[lane]); a1 = bf2f(zp[lane + 64]); } }
        else { const int idx = si - o;
            if (idx >= 0) { const bf16* zp = F.Z() + (size_t)(NP_ROWS + sb * 4 + idx) * ZW + ZU + gi * 128; a0 = bf2f(zp[lane]); a1 = bf2f(zp[lane + 64]); }
            else { const float* bp = pbuf + (size_t)(15 + idx) * 512; a0 = bp[lane]; a1 = bp[lane + 64]; } }
        if (o == 0) { u0 = a0; u1 = a1; }
        s0 += a0; s1 += a1;
    }
    const float cnt = smp ? (float)w : (float)((t + 1) < w ? (t + 1) : w);
    ds[lane] = s0 / cnt - u0; ds[lane + 64] = s1 / cnt - u1;
    LDS_WAIT(); asm volatile("" ::: "memory");
    const float* wp = A.in[F.zo + I_WPOOL] + ((size_t)(l * 4 + gi) * 128) * 128;
    float y0 = 0.f, y1 = 0.f;
#pragma unroll 16
    for (int c = 0; c < 128; ++c) { const float dv = ds[c]; y0 += dv * wp[c * 128 + lane]; y1 += dv * wp[c * 128 + lane + 64]; }
    const float* psc = A.in[F.zo + I_PSCALE] + l * 512 + gi * 128;
    bf16* mp = F.MIX() + (size_t)r * DM + 512 + gi * 128;
    mp[lane] = (bf16)f2bf(y0 * psc[lane]); mp[lane + 64] = (bf16)f2bf(y1 * psc[lane + 64]);
    LDS_WAIT(); asm volatile("" ::: "memory");
}
__device__ __forceinline__ void cache_outputs(Frame& F, const Args& A, int l) {
    const int gt = (F.vcu * NWAVES + F.wave) * 64 + F.lane_id(), NGT = F.G * NWAVES * 64;
#pragma unroll 4
    for (int i = gt; i < 4 * 128 * 128; i += NGT) { const int b = i >> 14, j = (i >> 7) & 127, c = i & 127; const bf16* zr = F.Z() + (size_t)(b * 2048 + 1920 + j) * ZW;
        F.out[O_WK_P + (size_t)l * 65536 + i] = bf2f(zr[ZK + c]); F.out[O_WV_P + (size_t)l * 65536 + i] = bf2f(zr[ZV + c]); }
#pragma unroll 4
    for (int i = gt; i < 4 * 15 * 512; i += NGT) { const int b = i / 7680, rem = i - b * 7680, j = rem >> 9, c = rem & 511;
        F.out[O_POOL_P + (size_t)l * 30720 + i] = bf2f(F.Z()[(size_t)(b * 2048 + 2033 + j) * ZW + ZU + c]); }
#pragma unroll 4
    for (int i = gt; i < 32 * 128 * 128; i += NGT) { const int sb = i >> 14, p = (i >> 7) & 127, c = i & 127; float kv, vv;
        if (p < 124) { const size_t src = ((size_t)(l * 32 + sb) * 128 + p + 4) * 128 + c; kv = A.in[F.zo + I_CK][src]; vv = A.in[F.zo + I_CV][src]; }
        else { const bf16* zr = F.Z() + (size_t)(NP_ROWS + sb * 4 + p - 124) * ZW; kv = bf2f(zr[ZK + c]); vv = bf2f(zr[ZV + c]); }
        F.out[O_WK_S + (size_t)l * 524288 + i] = kv; F.out[O_WV_S + (size_t)l * 524288 + i] = vv; }
#pragma unroll 4
    for (int i = gt; i < 32 * 15 * 512; i += NGT) { const int sb = i / 7680, rem = i - sb * 7680, j = rem >> 9, c = rem & 511; float v;
        if (j < 11) v = A.in[F.zo + I_SPOOL][((size_t)(l * 32 + sb) * 15 + j + 4) * 512 + c];
        else v = bf2f(F.Z()[(size_t)(NP_ROWS + sb * 4 + j - 11) * ZW + ZU + c]);
        F.out[O_POOL_S + (size_t)l * 245760 + i] = v; }
}
__device__ __forceinline__ void gla_out_item(Frame& F, const Args& A, int l, int r, int hh) {
    const int lane = F.lane_id();
    const f32x4 o = *(const f32x4*)(F.OGLA() + (size_t)r * 1024 + hh * 256 + 4 * lane);
    const float ss = wave_sum((o.x * o.x + o.y * o.y) + (o.z * o.z + o.w * o.w));
    const float rstd = 1.0f / sqrtf(ss * (1.0f / 256.0f) + EPS);
    const f32x4 gv = *(const f32x4*)(A.in[F.zo + I_GGLA] + l * 1024 + hh * 256 + 4 * lane);
    const uint2 gw = *(const uint2*)(F.Z() + (size_t)r * ZW + GG + hh * 256 + 4 * lane);
    const float g0 = bflo(gw.x), g1 = bfhi(gw.x), g2 = bflo(gw.y), g3 = bfhi(gw.y);
    const float y0 = o.x * rstd * gv.x * (g0 / (1.0f + __expf(-g0))), y1 = o.y * rstd * gv.y * (g1 / (1.0f + __expf(-g1)));
    const float y2 = o.z * rstd * gv.z * (g2 / (1.0f + __expf(-g2))), y3 = o.w * rstd * gv.w * (g3 / (1.0f + __expf(-g3)));
    uint2 w; w.x = pk2(y0, y1); w.y = pk2(y2, y3);
    *(uint2*)(F.MIX() + (size_t)r * DM + 1024 + hh * 256 + 4 * lane) = w;
}
typedef unsigned u32x2 __attribute__((ext_vector_type(2)));
__device__ __forceinline__ u32x2 pack4bf(const f32x4 v) { u32x2 w; w.x = pk2(v.x, v.y); w.y = pk2(v.z, v.w); return w; }
constexpr int GL_QD = 0, GL_KD = 17408, GL_VT = 34816, GL_AM = 71680, GL_BS = 80896, GL_GS = 82944, GL_END = 87040;
static_assert(GL_END <= RING_BYTES, "GLA LDS map");
constexpr int GL_NSLOT = 640;
__device__ __forceinline__ void gla_prep_unit(Frame& F, const Args& A, int l, int slot) {
    const int lane = F.lane_id(), wave = F.wave, tid = wave * 64 + lane, fr = lane & 15, fq = lane >> 4;
    const bool smp = slot >= 512; const int hh = slot & 3;
    const int row0 = smp ? (NP_ROWS + ((slot - 512) >> 2) * 4) : ((slot >> 7) * 2048 + ((slot >> 2) & 31) * 64), nvalid = smp ? 4 : 64;
    const int d = tid & 127, qtr = tid >> 7, cg = hh * 128 + d;
    LAS bf16* QD = (LAS bf16*)(F.lds + GL_QD); LAS bf16* KD = (LAS bf16*)(F.lds + GL_KD); LAS bf16* VT = (LAS bf16*)(F.lds + GL_VT); LAS bf16* AM = (LAS bf16*)(F.lds + GL_AM);
    LAS float* BS = (LAS float*)(F.lds + GL_BS); LAS float* GS = (LAS float*)(F.lds + GL_GS);
    const bf16* Z = F.Z();
    unsigned short qraw[16], kraw[16], vraw[32];
    { const bf16* zq = Z + (size_t)(row0 + 16 * qtr) * ZW + GQ + cg; const bf16* zk = zq + (GK - GQ);
#pragma unroll
      for (int i = 0; i < 16; ++i) { qraw[i] = 0; kraw[i] = 0; if (16 * qtr + i < nvalid) { qraw[i] = zq[(size_t)i * ZW]; kraw[i] = zk[(size_t)i * ZW]; } }
      const int e = tid & 255, hf = tid >> 8; const bf16* vp = Z + (size_t)(row0 + 32 * hf) * ZW + GV + hh * 256 + e;
#pragma unroll
      for (int i = 0; i < 32; ++i) { vraw[i] = 0; if (32 * hf + i < nvalid) vraw[i] = vp[(size_t)i * ZW]; } }
    { const int t = tid >> 3, j0 = (tid & 7) * 2; float g0 = 0.f, g1 = 0.f;
      if (t < nvalid) { const unsigned w = *(const unsigned*)(Z + (size_t)(row0 + t) * ZW + GA + j0); g0 = bflo(w); g1 = bfhi(w); }
      GS[t * 16 + j0] = g0; GS[t * 16 + j0 + 1] = g1; }
    float wa[16];
    { const float* wp = A.in[F.zo + I_WA2] + (size_t)l * 16 * 512 + cg;
#pragma unroll
      for (int j = 0; j < 16; ++j) wa[j] = wp[j * 512]; }
    const float ba = A.in[F.zo + I_BA2][l * 512 + cg];
    __syncthreads();
    float bl[16]; float run = 0.f;
#pragma unroll
    for (int i = 0; i < 16; ++i) { const int t = 16 * qtr + i; const LAS f32x4* gp = (const LAS f32x4*)(GS + t * 16); const f32x4 g0 = gp[0], g1 = gp[1], g2 = gp[2], g3 = gp[3];
        float x = ba + g0.x * wa[0] + g0.y * wa[1] + g0.z * wa[2] + g0.w * wa[3] + g1.x * wa[4] + g1.y * wa[5] + g1.z * wa[6] + g1.w * wa[7];
        x += g2.x * wa[8] + g2.y * wa[9] + g2.z * wa[10] + g2.w * wa[11] + g3.x * wa[12] + g3.y * wa[13] + g3.z * wa[14] + g3.w * wa[15];
        float la = (fminf(x, 0.f) - __logf(1.0f + __expf(-fabsf(x)))) * (1.0f / 16.0f);
        if (t >= nvalid) la = 0.f;
        run += la; bl[i] = run; }
    BS[qtr * 128 + d] = run;
    __syncthreads();
    float pre = 0.f, tot = 0.f;
#pragma unroll
    for (int q2 = 0; q2 < 4; ++q2) { const float v = BS[q2 * 128 + d]; tot += v; if (q2 < qtr) pre += v; }
    { bf16* qg = F.QDG() + (size_t)(row0 + 16 * qtr) * 512 + cg;
      unsigned kt[8];
#pragma unroll
      for (int i = 0; i < 16; ++i) { const int t = 16 * qtr + i; const float b = pre + bl[i]; float qv = 0.f, kv = 0.f;
          qv = bf2f(qraw[i]); kv = bf2f(kraw[i]);
          const unsigned qd = f2bf(qv * __expf(b) * 0.08838834764831845f), kd = f2bf(kv * __expf(-b)), kdt = f2bf(kv * __expf(tot - b));
          QD[t * 136 + d] = (bf16)qd; KD[t * 136 + d] = (bf16)kd;
          if (t < nvalid) qg[(size_t)i * 512] = (bf16)qd;
          if (i & 1) kt[i >> 1] |= kdt << 16; else kt[i >> 1] = kdt; }
      v4u* kg = (v4u*)(F.KDTG() + ((size_t)slot * 128 + d) * 64 + 16 * qtr);
      kg[0] = (v4u){kt[0], kt[1], kt[2], kt[3]}; kg[1] = (v4u){kt[4], kt[5], kt[6], kt[7]};
      if (qtr == 0) F.DLG()[slot * 128 + d] = __expf(tot); }
    { const int e = tid & 255, hf = tid >> 8;
      unsigned vw[16];
#pragma unroll
      for (int i = 0; i < 32; ++i) { const unsigned x = vraw[i];
          if (i & 1) vw[i >> 1] |= x << 16; else vw[i >> 1] = x; }
      LAS v4u* vl = (LAS v4u*)(VT + e * 72 + 32 * hf); v4u* vg = (v4u*)(F.VTG() + ((size_t)slot * 256 + e) * 64 + 32 * hf);
#pragma unroll
      for (int k = 0; k < 4; ++k) { const v4u w = {vw[4 * k], vw[4 * k + 1], vw[4 * k + 2], vw[4 * k + 3]}; vl[k] = w; vg[k] = w; } }
    __syncthreads();
#pragma unroll
    for (int bi = 0; bi < 2; ++bi) { const int blk = 2 * wave + bi, tb = blk >> 2, sbk = blk & 3;
        f32x4 acc = {0.f, 0.f, 0.f, 0.f};
        if (sbk <= tb) {
#pragma unroll
            for (int ks = 0; ks < 4; ++ks) { const bf16x8 a = *(const LAS bf16x8*)(KD + (sbk * 16 + fr) * 136 + ks * 32 + fq * 8), b = *(const LAS bf16x8*)(QD + (tb * 16 + fr) * 136 + ks * 32 + fq * 8);
                acc = __builtin_amdgcn_mfma_f32_16x16x32_bf16(a, b, acc, 0, 0, 0); } }
        const int t = tb * 16 + fr, s0 = sbk * 16 + 4 * fq;
        f32x4 m; m.x = (s0 + 0 <= t) ? acc.x : 0.f; m.y = (s0 + 1 <= t) ? acc.y : 0.f; m.z = (s0 + 2 <= t) ? acc.z : 0.f; m.w = (s0 + 3 <= t) ? acc.w : 0.f;
        *(LAS u32x2*)(AM + t * 72 + s0) = pack4bf(m); }
    __syncthreads();
#pragma unroll
    for (int ei = 0; ei < 2; ++ei) { const int eb = 2 * wave + ei;
        const bf16x8 a0 = *(const LAS bf16x8*)(VT + (eb * 16 + fr) * 72 + fq * 8), a1 = *(const LAS bf16x8*)(VT + (eb * 16 + fr) * 72 + 32 + fq * 8);
#pragma unroll
        for (int tb = 0; tb < 4; ++tb) { f32x4 o = {0.f, 0.f, 0.f, 0.f};
            o = __builtin_amdgcn_mfma_f32_16x16x32_bf16(a0, *(const LAS bf16x8*)(AM + (tb * 16 + fr) * 72 + fq * 8), o, 0, 0, 0);
            if (tb >= 2) o = __builtin_amdgcn_mfma_f32_16x16x32_bf16(a1, *(const LAS bf16x8*)(AM + (tb * 16 + fr) * 72 + 32 + fq * 8), o, 0, 0, 0);
            const int t = tb * 16 + fr;
            if (t < nvalid) *(f32x4*)(F.OGLA() + (size_t)(row0 + t) * 1024 + hh * 256 + eb * 16 + 4 * fq) = o; } }
    __syncthreads();
}
__device__ __forceinline__ void gla_state_step(Frame& F, int slot, int eb, int fr, int fq, f32x4 (&sacc)[8]) {
    const bf16* vt = F.VTG() + ((size_t)slot * 256 + eb * 16 + fr) * 64 + 8 * fq; const bf16x8 b0 = *(const bf16x8*)vt, b1 = *(const bf16x8*)(vt + 32);
    const bf16* kt = F.KDTG() + ((size_t)slot * 128 + fr) * 64 + 8 * fq; const float* dl = F.DLG() + slot * 128 + 4 * fq;
#pragma unroll
    for (int db = 0; db < 8; ++db) { const f32x4 dv = *(const f32x4*)(dl + db * 16); const bf16x8 a0 = *(const bf16x8*)(kt + (size_t)db * 16 * 64), a1 = *(const bf16x8*)(kt + (size_t)db * 16 * 64 + 32);
        f32x4 s = sacc[db] * dv; s = __builtin_amdgcn_mfma_f32_16x16x32_bf16(a0, b0, s, 0, 0, 0); s = __builtin_amdgcn_mfma_f32_16x16x32_bf16(a1, b1, s, 0, 0, 0); sacc[db] = s; }
}
__device__ __forceinline__ void gla_inter_step(Frame& F, int row0, int nvalid, int ntb, int hh, int eb, int fr, int fq, const f32x4 (&sacc)[8]) {
    bf16x8 sf[4];
#pragma unroll
    for (int ks = 0; ks < 4; ++ks) { const u32x2 lo = pack4bf(sacc[2 * ks]), hi = pack4bf(sacc[2 * ks + 1]); const v4u w = {lo.x, lo.y, hi.x, hi.y}; sf[ks] = __builtin_bit_cast(bf16x8, w); }
    for (int tb = 0; tb < ntb; ++tb) { const int t = tb * 16 + fr; const bool ok = t < nvalid;
        const bf16* qp = F.QDG() + (size_t)(row0 + t) * 512 + hh * 128 + 4 * fq;
        f32x4 o = {0.f, 0.f, 0.f, 0.f};
#pragma unroll
        for (int ks = 0; ks < 4; ++ks) { u32x2 lo = {0u, 0u}, hi = {0u, 0u}; if (ok) { lo = *(const u32x2*)(qp + 32 * ks); hi = *(const u32x2*)(qp + 32 * ks + 16); }
            const v4u w = {lo.x, lo.y, hi.x, hi.y}; o = __builtin_amdgcn_mfma_f32_16x16x32_bf16(sf[ks], __builtin_bit_cast(bf16x8, w), o, 0, 0, 0); }
        if (ok) { const size_t oi = (size_t)(row0 + t) * 1024 + hh * 256 + eb * 16 + 4 * fq; *(f32x4*)(F.OGLA_ST() + oi) = *(const f32x4*)(F.OGLA() + oi) + o; } }
}
__device__ __forceinline__ void gla_store_state(float* dst, int fr, int fq, const f32x4 (&sacc)[8]) {
#pragma unroll
    for (int db = 0; db < 8; ++db) { const int d0 = db * 16 + 4 * fq; dst[(size_t)(d0 + 0) * 256 + fr] = sacc[db].x; dst[(size_t)(d0 + 1) * 256 + fr] = sacc[db].y; dst[(size_t)(d0 + 2) * 256 + fr] = sacc[db].z; dst[(size_t)(d0 + 3) * 256 + fr] = sacc[db].w; }
}
__device__ __forceinline__ void gla_phase_g1(Frame& F, const Args& A, int l) {
    const int lane = F.lane_id(), fr = lane & 15, fq = lane >> 4;
    const int gw = F.vcu * NWAVES + F.wave, NGW = F.G * NWAVES;
    for (int it = gw; it < 2048; it += NGW) { const int bh = it >> 7, seg = (it >> 4) & 7, eb = it & 15;
        if (seg == 7) continue;
        f32x4 sacc[8];
#pragma unroll
        for (int db = 0; db < 8; ++db) sacc[db] = (f32x4){0.f, 0.f, 0.f, 0.f};
        const int slot0 = (((bh >> 2) * 32 + seg * 4) * 4) + (bh & 3);
        for (int c = 0; c < 4; ++c) gla_state_step(F, slot0 + 4 * c, eb, fr, fq, sacc);
        gla_store_state(F.SLOC() + ((size_t)(bh * 8 + seg) * 128) * 256 + eb * 16, fr, fq, sacc);
        if (eb == 0) {
#pragma unroll
            for (int k = 0; k < 2; ++k) { const int d = lane + 64 * k; float p = 1.f; for (int c = 0; c < 4; ++c) p *= F.DLG()[(slot0 + 4 * c) * 128 + d]; F.DSEG()[(bh * 8 + seg) * 128 + d] = p; } }
    }
    for (int it = gw; it < 2048; it += NGW) { const int sbh = it >> 4, eb = it & 15, sb = sbh >> 2, hh = sbh & 3;
        const size_t so = ((size_t)((l * 32 + sb) * 4 + hh)) * 32768 + eb * 16;
        const float* s0 = A.in[F.zo + I_SGLA] + so + fr;
        f32x4 sacc[8];
#pragma unroll
        for (int db = 0; db < 8; ++db) { const int d0 = db * 16 + 4 * fq; sacc[db].x = s0[(size_t)(d0 + 0) * 256]; sacc[db].y = s0[(size_t)(d0 + 1) * 256]; sacc[db].z = s0[(size_t)(d0 + 2) * 256]; sacc[db].w = s0[(size_t)(d0 + 3) * 256]; }
        gla_inter_step(F, NP_ROWS + sb * 4, 4, 1, hh, eb, fr, fq, sacc);
        gla_state_step(F, 512 + sbh, eb, fr, fq, sacc);
        gla_store_state(F.out + O_GLA_S + so, fr, fq, sacc);
    }
}
__device__ __forceinline__ void gla_phase_g2(Frame& F, const Args& A, int l) {
    const int lane = F.lane_id(), fr = lane & 15, fq = lane >> 4;
    const int gw = F.vcu * NWAVES + F.wave, NGW = F.G * NWAVES;
    for (int it = gw; it < 2048; it += NGW) { const int bh = it >> 7, seg = (it >> 4) & 7, eb = it & 15, hh = bh & 3;
        f32x4 sacc[8];
#pragma unroll
        for (int db = 0; db < 8; ++db) sacc[db] = (f32x4){0.f, 0.f, 0.f, 0.f};
        for (int i2 = 0; i2 < seg; ++i2) { const float* sl = F.SLOC() + ((size_t)(bh * 8 + i2) * 128) * 256 + eb * 16 + fr; const float* dg = F.DSEG() + (bh * 8 + i2) * 128;
#pragma unroll
            for (int db = 0; db < 8; ++db) { const int d0 = db * 16 + 4 * fq; const f32x4 dv = *(const f32x4*)(dg + d0);
                sacc[db].x = sacc[db].x * dv.x + sl[(size_t)(d0 + 0) * 256]; sacc[db].y = sacc[db].y * dv.y + sl[(size_t)(d0 + 1) * 256]; sacc[db].z = sacc[db].z * dv.z + sl[(size_t)(d0 + 2) * 256]; sacc[db].w = sacc[db].w * dv.w + sl[(size_t)(d0 + 3) * 256]; } }
        const int slot0 = (((bh >> 2) * 32 + seg * 4) * 4) + hh, row0 = (bh >> 2) * 2048 + seg * 256;
        for (int c = 0; c < 4; ++c) { gla_inter_step(F, row0 + c * 64, 64, 4, hh, eb, fr, fq, sacc); gla_state_step(F, slot0 + 4 * c, eb, fr, fq, sacc); }
        if (seg == 7) gla_store_state(F.out + O_GLA_P + ((size_t)(l * 16 + bh)) * 32768 + eb * 16, fr, fq, sacc);
    }
}
constexpr int AT_VT = 0, AT_VTS = 184, AT_BT = 64 * AT_VTS * 2, AT_END = AT_BT + 4 * 128 * 4;
__device__ __forceinline__ void attn_unit_mfma(Frame& F, const Args& A, int l, int u) {
    const int lane = F.lane_id(), wave = F.wave, tid = wave * 64 + lane, fr = lane & 15, fq = lane >> 4;
    const int span = u >> 1, g = u & 1, t0g = span * 32, tb0 = t0g & 2047;
    LAS bf16* VT = (LAS bf16*)(F.lds + AT_VT); LAS float* BT = (LAS float*)(F.lds + AT_BT);
    const bf16* Z = F.Z();
    const int rb = wave >> 2, hl = wave & 3, hd = g * 4 + hl, t0w = t0g + 16 * rb;
    bf16x8 qf[2], kf[9][2];
    { const bf16* qp = Z + (size_t)(t0w + fr) * ZW + ZQ + hd * 64 + 8 * fq; qf[0] = *(const bf16x8*)qp; qf[1] = *(const bf16x8*)(qp + 32); }
#pragma unroll
    for (int kb = 0; kb < 9; ++kb) { const int kl = 16 * (rb + kb) + fr; kf[kb][0] = (bf16x8){0, 0, 0, 0, 0, 0, 0, 0}; kf[kb][1] = (bf16x8){0, 0, 0, 0, 0, 0, 0, 0};
        if (tb0 - 128 + kl >= 0) { const bf16* kp = Z + (size_t)(t0g - 128 + kl) * ZW + ZK + g * 64 + 8 * fq; kf[kb][0] = *(const bf16x8*)kp; kf[kb][1] = *(const bf16x8*)(kp + 32); } }
#pragma unroll
    for (int pass = 0; pass < 2; ++pass) { const int key = pass * 128 + (tid >> 2), dch = (tid & 3) * 16;
        if (key < 160) { v4u v0 = {0u, 0u, 0u, 0u}, v1 = {0u, 0u, 0u, 0u};
            if (tb0 - 128 + key >= 0) { const v4u* vp = (const v4u*)(Z + (size_t)(t0g - 128 + key) * ZW + ZV + g * 64 + dch); v0 = vp[0]; v1 = vp[1]; }
            LAS bf16* vt = VT + dch * AT_VTS + key;
            vt[0 * AT_VTS] = (bf16)(v0.x & 0xffffu); vt[1 * AT_VTS] = (bf16)(v0.x >> 16); vt[2 * AT_VTS] = (bf16)(v0.y & 0xffffu); vt[3 * AT_VTS] = (bf16)(v0.y >> 16);
            vt[4 * AT_VTS] = (bf16)(v0.z & 0xffffu); vt[5 * AT_VTS] = (bf16)(v0.z >> 16); vt[6 * AT_VTS] = (bf16)(v0.w & 0xffffu); vt[7 * AT_VTS] = (bf16)(v0.w >> 16);
            vt[8 * AT_VTS] = (bf16)(v1.x & 0xffffu); vt[9 * AT_VTS] = (bf16)(v1.x >> 16); vt[10 * AT_VTS] = (bf16)(v1.y & 0xffffu); vt[11 * AT_VTS] = (bf16)(v1.y >> 16);
            vt[12 * AT_VTS] = (bf16)(v1.z & 0xffffu); vt[13 * AT_VTS] = (bf16)(v1.z >> 16); vt[14 * AT_VTS] = (bf16)(v1.w & 0xffffu); vt[15 * AT_VTS] = (bf16)(v1.w >> 16); } }
    BT[tid] = F.BTAB()[(g * 4) * 128 + tid];
    __syncthreads();
    f32x4 sacc[9];
#pragma unroll
    for (int kb = 0; kb < 9; ++kb) {
        f32x4 acc = {0.f, 0.f, 0.f, 0.f};
        acc = __builtin_amdgcn_mfma_f32_16x16x32_bf16(kf[kb][0], qf[0], acc, 0, 0, 0); acc = __builtin_amdgcn_mfma_f32_16x16x32_bf16(kf[kb][1], qf[1], acc, 0, 0, 0);
        sacc[kb] = acc; }
    const float sink = A.in[F.zo + I_SINKS][l * 8 + hd];
    float mx = -INFINITY;
#pragma unroll
    for (int kb = 0; kb < 9; ++kb)
#pragma unroll
        for (int i = 0; i < 4; ++i) { const int dist = 128 - 16 * kb + fr - 4 * fq - i, kpos = tb0 + 16 * rb + fr - dist;
            const bool valid = (dist >= 0) && (dist < 128) && (kpos >= 0);
            const float s = valid ? sacc[kb][i] * 0.125f + BT[hl * 128 + (dist & 127)] : -INFINITY;
            sacc[kb][i] = s; mx = fmaxf(mx, s); }
    mx = fmaxf(mx, __shfl_xor(mx, 16)); mx = fmaxf(mx, __shfl_xor(mx, 32)); mx = fmaxf(mx, sink);
    float ls = 0.f;
#pragma unroll
    for (int kb = 0; kb < 9; ++kb)
#pragma unroll
        for (int i = 0; i < 4; ++i) { const float p = __expf(sacc[kb][i] - mx); sacc[kb][i] = p; ls += p; }
    ls += __shfl_xor(ls, 16); ls += __shfl_xor(ls, 32);
    const float rden = 1.0f / (ls + __expf(sink - mx));
    bf16x8 pf[5];
#pragma unroll
    for (int pp = 0; pp < 5; ++pp) { const f32x4 a = sacc[2 * pp], b = (2 * pp + 1 < 9) ? sacc[2 * pp + 1] : (f32x4){0.f, 0.f, 0.f, 0.f};
        const unsigned w0 = pk2(a.x, a.y), w1 = pk2(a.z, a.w), w2 = pk2(b.x, b.y), w3 = pk2(b.z, b.w);
        v4u w = {w0, w1, w2, w3}; pf[pp] = __builtin_bit_cast(bf16x8, w); }
#pragma unroll
    for (int db = 0; db < 4; ++db) { f32x4 o = {0.f, 0.f, 0.f, 0.f};
#pragma unroll
        for (int pp = 0; pp < 5; ++pp) { const LAS bf16* vr = VT + (db * 16 + fr) * AT_VTS + 16 * (rb + 2 * pp) + 4 * fq;
            const u32x2 lo = *(const LAS u32x2*)vr; u32x2 hi = {0u, 0u}; if (2 * pp + 1 < 9) hi = *(const LAS u32x2*)(vr + 16);
            v4u w = {lo.x, lo.y, hi.x, hi.y};
            o = __builtin_amdgcn_mfma_f32_16x16x32_bf16(__builtin_bit_cast(bf16x8, w), pf[pp], o, 0, 0, 0); }
        *(u32x2*)(F.MIX() + (size_t)(t0w + fr) * DM + hd * 64 + db * 16 + 4 * fq) = pack4bf(o * rden); }
    __syncthreads();
}
template <int W>
__device__ __forceinline__ void pool_item_body(Frame& F, const Args& A, int l, int rblk, int g) {
    const int lane = F.lane_id(), fr = lane & 15, fq = lane >> 4;
    const int t = rblk * 16 + fr, pos = t & 2047;
    const bf16* Z = F.Z();
    const int nwin = (pos + 1) < W ? (pos + 1) : W; const float rc = 1.0f / (float)nwin;
    const bf16* wt = F.WPT() + ((size_t)(l * 4 + g) * 128) * 128; const float* psc = A.in[F.zo + I_PSCALE] + l * 512 + g * 128;
    f32x4 acc[8];
#pragma unroll
    for (int nb = 0; nb < 8; ++nb) acc[nb] = (f32x4){0.f, 0.f, 0.f, 0.f};
#pragma unroll 1
    for (int ks = 0; ks < 4; ++ks) { const bf16* up = Z + (size_t)t * ZW + ZU + g * 128 + ks * 32 + 8 * fq;
        v4u x[W];
#pragma unroll
        for (int i = 0; i < W; ++i) { x[i] = (v4u){0u, 0u, 0u, 0u}; if (i < nwin) x[i] = *(const v4u*)(up - (size_t)i * ZW); }
        float s[8];
#pragma unroll
        for (int j = 0; j < 8; ++j) s[j] = 0.f;
#pragma unroll
        for (int i = 0; i < W; ++i) { s[0] += bflo(x[i].x); s[1] += bfhi(x[i].x); s[2] += bflo(x[i].y); s[3] += bfhi(x[i].y); s[4] += bflo(x[i].z); s[5] += bfhi(x[i].z); s[6] += bflo(x[i].w); s[7] += bfhi(x[i].w); }
        const v4u u0 = x[0];
        v4u wv; wv.x = pk2(s[0] * rc - bflo(u0.x), s[1] * rc - bfhi(u0.x)); wv.y = pk2(s[2] * rc - bflo(u0.y), s[3] * rc - bfhi(u0.y)); wv.z = pk2(s[4] * rc - bflo(u0.z), s[5] * rc - bfhi(u0.z)); wv.w = pk2(s[6] * rc - bflo(u0.w), s[7] * rc - bfhi(u0.w));
        const bf16x8 df = __builtin_bit_cast(bf16x8, wv);
#pragma unroll
        for (int nb = 0; nb < 8; ++nb) { const bf16x8 a = *(const bf16x8*)(wt + (size_t)(nb * 16 + fr) * 128 + ks * 32 + 8 * fq); acc[nb] = __builtin_amdgcn_mfma_f32_16x16x32_bf16(a, df, acc[nb], 0, 0, 0); } }
#pragma unroll
    for (int nb = 0; nb < 8; ++nb) { const f32x4 sc = *(const f32x4*)(psc + nb * 16 + 4 * fq);
        *(u32x2*)(F.MIX() + (size_t)t * DM + 512 + g * 128 + nb * 16 + 4 * fq) = pack4bf(acc[nb] * sc); }
}
__device__ __forceinline__ void pool_item_mfma(Frame& F, const Args& A, int l, int rblk, int g) {
    if (g == 0) pool_item_body<2>(F, A, l, rblk, g); else if (g == 1) pool_item_body<4>(F, A, l, rblk, g); else if (g == 2) pool_item_body<8>(F, A, l, rblk, g); else pool_item_body<16>(F, A, l, rblk, g);
}
__device__ __forceinline__ void skinny_resid(Frame& F, const bf16* Asmp, const bf16* Bt, int K, const float* gate) {
    const int lane = F.lane_id(), wave = F.wave, fr = lane & 15, fq = lane >> 4;
    LAS float* red = (LAS float*)(F.lds + RING_OFF);
    const int kw = K >> 3, ksteps = kw >> 5;
    for (int u = F.vcu; u < 256; u += F.G) {
        const int c0 = (u >> 1) * 16, r0 = (u & 1) * 64;
        const bf16* bp = Bt + (size_t)(c0 + fr) * K + wave * kw + 8 * fq;
        const bf16* ap = Asmp + (size_t)(r0 + fr) * K + wave * kw + 8 * fq;
        f32x4 acc[4];
#pragma unroll
        for (int rb = 0; rb < 4; ++rb) acc[rb] = (f32x4){0.f, 0.f, 0.f, 0.f};
        bf16x8 bc = *(const bf16x8*)bp, ac[4];
#pragma unroll
        for (int rb = 0; rb < 4; ++rb) ac[rb] = *(const bf16x8*)(ap + (size_t)rb * 16 * K);
        for (int ks = 0; ks < ksteps; ++ks) {
            bf16x8 bn = bc, an[4];
#pragma unroll
            for (int rb = 0; rb < 4; ++rb) an[rb] = ac[rb];
            if (ks + 1 < ksteps) { bn = *(const bf16x8*)(bp + (ks + 1) * 32);
#pragma unroll
                for (int rb = 0; rb < 4; ++rb) an[rb] = *(const bf16x8*)(ap + (size_t)rb * 16 * K + (ks + 1) * 32); }
#pragma unroll
            for (int rb = 0; rb < 4; ++rb) acc[rb] = __builtin_amdgcn_mfma_f32_16x16x32_bf16(bc, ac[rb], acc[rb], 0, 0, 0);
            bc = bn;
#pragma unroll
            for (int rb = 0; rb < 4; ++rb) ac[rb] = an[rb];
        }
#pragma unroll
        for (int rb = 0; rb < 4; ++rb) *(LAS f32x4*)(red + ((wave * 4 + rb) * 64 + lane) * 4) = acc[rb];
        __syncthreads();
        if (wave < 4) { f32x4 s = {0.f, 0.f, 0.f, 0.f};
#pragma unroll
            for (int w2 = 0; w2 < 8; ++w2) s = s + *(const LAS f32x4*)(red + ((w2 * 4 + wave) * 64 + lane) * 4);
            const int r = r0 + wave * 16 + fr;
            const f32x4 g = *(const f32x4*)(gate + (size_t)(4 + (r >> 2)) * MODLD + c0 + 4 * fq);
            const size_t xo = (size_t)(NP_ROWS + r) * DM + c0 + 4 * fq; f32x4 xv = *(const f32x4*)(F.X() + xo); xv = xv + g * s; *(f32x4*)(F.X_ST() + xo) = xv; }
        __syncthreads();
    }
}

#ifndef EN_P0
#define EN_P0 1
#endif
#ifndef EN_G
#define EN_G 1
#endif
#ifndef EN_N
#define EN_N 1
#endif
#ifndef EN_M2
#define EN_M2 1
#endif
#ifndef EN_M3
#define EN_M3 1
#endif
#ifndef EN_M4
#define EN_M4 1
#endif
#ifndef EN_G1
#define EN_G1 1
#endif
#ifndef EN_GIN
#define EN_GIN 1
#endif
#ifndef EN_GOUT
#define EN_GOUT 1
#endif
#ifndef EN_GGU
#define EN_GGU 1
#endif
#ifndef EN_GDN
#define EN_GDN 1
#endif
#ifndef PROBE_DUP
#define PROBE_DUP 0
#endif
#ifndef MK_SINGLE
#define MK_SINGLE 1
#endif

#define PH_ARGS unsigned ldsb_, unsigned wslo_, unsigned wshi_, unsigned olo_, unsigned ohi_, int wave_, int vcu_, int G_, int probe_, int l_
#define PH_PASS ldsb, wslo, wshi, olo, ohi, F.wave, F.vcu, F.G, F.probe
#define PH_FRAME() Frame F; { const unsigned a0 = __builtin_amdgcn_readfirstlane(ldsb_), a1 = __builtin_amdgcn_readfirstlane(wslo_), a2 = __builtin_amdgcn_readfirstlane(wshi_), a3 = __builtin_amdgcn_readfirstlane(olo_), a4 = __builtin_amdgcn_readfirstlane(ohi_); \
    F.lds = (LAS unsigned char*)(unsigned long long)a0; F.MISC = (volatile LAS unsigned*)(F.lds + MISC_OFF); F.ws = (unsigned char*)(((unsigned long long)a2 << 32) | a1); F.out = (float*)(((unsigned long long)a4 << 32) | a3); \
    F.wave = __builtin_amdgcn_readfirstlane(wave_); F.vcu = __builtin_amdgcn_readfirstlane(vcu_); F.G = __builtin_amdgcn_readfirstlane(G_); F.zo = 0; F.probe = __builtin_amdgcn_readfirstlane(probe_); } \
    const int l = __builtin_amdgcn_readfirstlane(l_); (void)l; \
    const Args& args = *(const Args*)__builtin_amdgcn_kernarg_segment_ptr();
__device__ __forceinline__ void ph_prologue(PH_ARGS) { PH_FRAME(); p0_prologue(F, args); }
__device__ __forceinline__ void ph_norm1(PH_ARGS) { PH_FRAME(); norm_mod_rows(F, args.in[I_GMIX] + l * DM, F.MOD() + (size_t)l * MODW); }
__device__ __forceinline__ void ph_norm2(PH_ARGS) { PH_FRAME(); norm_mod_rows(F, args.in[I_GFFN] + l * DM, F.MOD() + (size_t)l * MODW + 6144); }
__device__ __forceinline__ void ph_final(PH_ARGS) { PH_FRAME(); final_norm_rows(F, args); }
__device__ __forceinline__ void ph_mixa(PH_ARGS) { PH_FRAME();
    const int gw = F.vcu * NWAVES + F.wave, NGW = F.G * NWAVES; LAS float* wscr = (LAS float*)(F.lds + RING_OFF + F.wave * 16384);
    for (int u = F.vcu; u < GL_NSLOT; u += F.G) gla_prep_unit(F, args, l, u);
    for (int u = F.vcu; u < 512; u += F.G) attn_unit_mfma(F, args, l, u);
    for (int it = gw; it < 512 * 4; it += NGW) pool_item_mfma(F, args, l, it >> 2, it & 3);
    for (int it = gw; it < NS_ROWS * 8; it += NGW) attn_item(F, args, l, NP_ROWS + (it >> 3), it & 7, wscr);
    for (int it = gw; it < NS_ROWS * 4; it += NGW) pool_item(F, args, l, NP_ROWS + (it >> 2), it & 3, wscr);
    cache_outputs(F, args, l);
}
__device__ __forceinline__ void ph_gla1(PH_ARGS) { PH_FRAME(); gla_phase_g1(F, args, l); }
__device__ __forceinline__ void ph_gla2(PH_ARGS) { PH_FRAME(); gla_phase_g2(F, args, l); }
__device__ __forceinline__ void ph_mixc(PH_ARGS) { PH_FRAME(); const int gw = F.vcu * NWAVES + F.wave, NGW = F.G * NWAVES; for (int it = gw; it < NROWS * 4; it += NGW) gla_out_item(F, args, l, it >> 2, it & 3); }
constexpr int PH_PER_LAYER = 10, PH_LAYER0 = 2, PH_FINAL = PH_LAYER0 + DEPTH * PH_PER_LAYER, PH_COUNT = PH_FINAL + 1;
__global__ void __launch_bounds__(NTHREADS, 2) hymba_fwd(Args args) {
    extern __shared__ __attribute__((aligned(16))) unsigned char lds[];
    Frame F;
    F.lds = (LAS unsigned char*)lds;
    F.MISC = (volatile LAS unsigned*)(F.lds + MISC_OFF);
    F.wave = __builtin_amdgcn_readfirstlane((int)threadIdx.x >> 6); F.zo = 0; F.probe = 0;
    F.G = gridDim.x; { const int bx = blockIdx.x; F.vcu = (F.G % 8 == 0) ? (bx % 8) * (F.G / 8) + bx / 8 : bx; }
    F.ws = args.ws; F.out = args.out;
    gu32* const ctl = (gu32*)(F.ws + WS_CTL);
    for (int u = threadIdx.x; u < (LDS_BYTES - LDSCTL_OFF) / 4; u += NTHREADS) ((LAS unsigned*)(F.lds + LDSCTL_OFF))[u] = 0u;
    __syncthreads();
#if MK_SINGLE
    XcdBarrier bar = xcd_barrier_post((unsigned*)(ctl + CW_BAR), F.MISC + 8);
#define GRID_BAR() xcd_barrier(bar)
#else
#define GRID_BAR() do { } while (0)
#endif
    const int lo = args.ph_lo, hi = args.ph_hi;
    const unsigned ldsb = (unsigned)(unsigned long long)F.lds, wslo = (unsigned)(unsigned long long)F.ws, wshi = (unsigned)((unsigned long long)F.ws >> 32), olo = (unsigned)(unsigned long long)F.out, ohi = (unsigned)((unsigned long long)F.out >> 32);
#define IN(k) (lo <= (k) && (k) < hi)
#define BOTH(k) (IN(k) && IN((k) + 1))
#define PHASE_BEGIN() asm volatile("s_mov_b32 %0, 0" : "=s"(F.zo), "+s"(F.G), "+s"(F.vcu), "+s"(F.wave))
#define gw (F.vcu * NWAVES + F.wave)
#define NGW (F.G * NWAVES)
#define wscr ((LAS float*)(F.lds + RING_OFF + F.wave * 16384))

    if (EN_P0 && IN(0)) for (int rep_ = 0; rep_ < ((PROBE_DUP & 1) ? 2 : 1); ++rep_) { PHASE_BEGIN(); ph_prologue(PH_PASS, 0); if (BOTH(0)) GRID_BAR(); }
    if (EN_G && EN_G1 && IN(1)) for (int rep_ = 0; rep_ < ((PROBE_DUP & 1) ? 2 : 1); ++rep_) { PHASE_BEGIN();
        pg8::Gemm g{F.SC(), F.Wada_t(), 256, DEPTH * MODW, DM}; pg8::StaticOrder S; S.init(256, DEPTH * MODW, F.G, (int)blockIdx.x);
        pg8::EpiMod E{F.MOD(), args.in[F.zo + I_BADA]};
        pg8::gemm_phase<pg8::EpiMod, pg8::StaticOrder, true, true>(F.lds + RING_OFF, g, S, E, F.wave);
        if (BOTH(1)) GRID_BAR();
    }
    for (int l = 0; l < DEPTH; ++l) {
        const int pb = PH_LAYER0 + l * PH_PER_LAYER;
        const float* modl = F.MOD() + (size_t)l * MODW;
        if (EN_N && IN(pb + 0)) for (int rep_ = 0; rep_ < ((PROBE_DUP & 2) ? 2 : 1); ++rep_) { PHASE_BEGIN(); ph_norm1(PH_PASS, l); if (BOTH(pb + 0)) GRID_BAR(); }
        if (EN_G && EN_GIN && IN(pb + 1)) for (int rep_ = 0; rep_ < ((PROBE_DUP & 4) ? 2 : 1); ++rep_) { PHASE_BEGIN();
            pg8::Gemm g{F.H(), F.Win_t() + (size_t)l * ZW * DM, MPAD, ZW, DM}; pg8::StaticOrder S; S.init(MPAD, ZW, F.G, (int)blockIdx.x);
            pg8::EpiZ E{F.Z(), ZW};
            pg8::gemm_phase<pg8::EpiZ, pg8::StaticOrder, true, true>(F.lds + RING_OFF, g, S, E, F.wave);
            if (BOTH(pb + 1)) GRID_BAR();
        }
        if (EN_M2 && IN(pb + 2)) for (int rep_ = 0; rep_ < ((PROBE_DUP & 8) ? 2 : 1); ++rep_) { PHASE_BEGIN();
            ph_mixa(PH_PASS, l);
            if (BOTH(pb + 2)) GRID_BAR();
        }
        if (EN_M3 && IN(pb + 3)) for (int rep_ = 0; rep_ < ((PROBE_DUP & 16) ? 2 : 1); ++rep_) { PHASE_BEGIN(); F.probe = ((PROBE_DUP & 16) && rep_ == 0) ? 1 : 0; ph_gla1(PH_PASS, l); if (BOTH(pb + 3)) GRID_BAR(); }
        if (EN_M3 && IN(pb + 4)) for (int rep_ = 0; rep_ < ((PROBE_DUP & 32) ? 2 : 1); ++rep_) { PHASE_BEGIN(); F.probe = ((PROBE_DUP & 32) && rep_ == 0) ? 1 : 0;
            ph_gla2(PH_PASS, l);
            if (BOTH(pb + 4)) GRID_BAR();
        }
        if (EN_M4 && IN(pb + 5)) for (int rep_ = 0; rep_ < ((PROBE_DUP & 64) ? 2 : 1); ++rep_) { PHASE_BEGIN(); ph_mixc(PH_PASS, l); if (BOTH(pb + 5)) GRID_BAR(); }
        if (EN_G && EN_GOUT && IN(pb + 6)) for (int rep_ = 0; rep_ < ((PROBE_DUP & 128) ? 2 : 1); ++rep_) { PHASE_BEGIN(); F.probe = ((PROBE_DUP & 128) && rep_ == 0) ? 1 : 0;
            pg8::Gemm g{F.MIX(), F.Wout_t() + (size_t)l * DM * DM, NP_ROWS, DM, DM}; pg8::StaticOrder S; S.init(NP_ROWS, DM, F.G, (int)blockIdx.x);
            pg8::EpiResid E{F.X(), modl + 4096, F.X_ST()};
            pg8::gemm_phase<pg8::EpiResid, pg8::StaticOrder, true, true>(F.lds + RING_OFF, g, S, E, F.wave);
            if ((PROBE_DUP & 512) && !F.probe) { F.probe = 1; skinny_resid(F, F.MIX() + (size_t)NP_ROWS * DM, F.Wout_t() + (size_t)l * DM * DM, DM, modl + 4096); F.probe = 0; }
            skinny_resid(F, F.MIX() + (size_t)NP_ROWS * DM, F.Wout_t() + (size_t)l * DM * DM, DM, modl + 4096);
            if (BOTH(pb + 6)) GRID_BAR();
        }
        if (EN_N && IN(pb + 7)) for (int rep_ = 0; rep_ < ((PROBE_DUP & 2) ? 2 : 1); ++rep_) { PHASE_BEGIN(); ph_norm2(PH_PASS, l); if (BOTH(pb + 7)) GRID_BAR(); }
        if (EN_G && EN_GGU && IN(pb + 8)) for (int rep_ = 0; rep_ < ((PROBE_DUP & 4) ? 2 : 1); ++rep_) { PHASE_BEGIN();
            pg8::Gemm g{F.H(), F.Wgu_t() + (size_t)l * NGU * DM, MPAD, NGU, DM}; pg8::StaticOrder S; S.init(MPAD, NGU, F.G, (int)blockIdx.x);
            pg8::EpiSwiGLU E{F.ACT(), DFF};
            pg8::gemm_phase<pg8::EpiSwiGLU, pg8::StaticOrder, true, true>(F.lds + RING_OFF, g, S, E, F.wave);
            if (BOTH(pb + 8)) GRID_BAR();
        }
        if (EN_G && EN_GDN && IN(pb + 9)) for (int rep_ = 0; rep_ < ((PROBE_DUP & 256) ? 2 : 1); ++rep_) { PHASE_BEGIN(); F.probe = ((PROBE_DUP & 256) && rep_ == 0) ? 1 : 0;
            pg8::Gemm g{F.ACT(), F.Wdn_t() + (size_t)l * DM * DFF, NP_ROWS, DM, DFF}; pg8::StaticOrder S; S.init(NP_ROWS, DM, F.G, (int)blockIdx.x);
            pg8::EpiResid E{F.X(), modl + 10240, F.X_ST()};
            pg8::gemm_phase<pg8::EpiResid, pg8::StaticOrder, true, true>(F.lds + RING_OFF, g, S, E, F.wave);
            if ((PROBE_DUP & 512) && !F.probe) { F.probe = 1; skinny_resid(F, F.ACT() + (size_t)NP_ROWS * DFF, F.Wdn_t() + (size_t)l * DM * DFF, DFF, modl + 10240); F.probe = 0; }
            skinny_resid(F, F.ACT() + (size_t)NP_ROWS * DFF, F.Wdn_t() + (size_t)l * DM * DFF, DFF, modl + 10240);
            if (BOTH(pb + 9)) GRID_BAR();
        }
    }
    if (IN(PH_FINAL)) { PHASE_BEGIN(); ph_final(PH_PASS, 0); }
#ifdef PROBE_SCALE
    GRID_BAR();
    { const size_t offs[11] = {O_Y, 16777216, O_WK_P, O_WV_P, O_POOL_P, O_GLA_P, O_WK_S, O_WV_S, O_POOL_S, O_GLA_S, O_END};
      const size_t gt_ = (size_t)(F.vcu * NWAVES + F.wave) * 64 + F.lane_id(), NGT_ = (size_t)F.G * NWAVES * 64;
      for (int k = 0; k < 10; ++k) { const float sc = 1.0f + 0.05f * (float)(k + 1); for (size_t i = offs[k] + gt_; i < offs[k + 1]; i += NGT_) F.out[i] *= sc; } }
#endif
#undef IN
#undef BOTH
#undef gw
#undef NGW
#undef wscr
}

extern "C" void kernel_launch(void* const* d_in, const int* in_sizes, int n_in, void* d_out, int out_size, void* d_ws, size_t ws_size, hipStream_t stream) {
    static int grid = 0;
    if (grid == 0) {
        if (n_in != 24 || out_size != (int)O_END || ws_size < WS_END) { fprintf(stderr, "kernel_launch: unexpected sizes n_in %d out %d ws %zu\n", n_in, out_size, ws_size); grid = -1; return; }
        int dev = 0, cus = 0;
        if (hipGetDevice(&dev) != hipSuccess || hipDeviceGetAttribute(&cus, hipDeviceAttributeMultiprocessorCount, dev) != hipSuccess) { grid = -1; return; }
        if (hipFuncSetAttribute((const void*)hymba_fwd, hipFuncAttributeMaxDynamicSharedMemorySize, LDS_BYTES) != hipSuccess) { fprintf(stderr, "kernel_launch: hipFuncSetAttribute failed\n"); grid = -1; return; }
        (void)hipGetLastError();
        grid = cus;
    }
    if (grid < 0) return;
    (void)hipMemsetAsync((char*)d_ws + WS_CTL, 0, CTL_ZERO_BYTES, stream);
    Args a{};
    for (int i = 0; i < 24; ++i) a.in[i] = (const float*)d_in[i];
    a.out = (float*)d_out; a.ws = (unsigned char*)d_ws;
#if MK_SINGLE
    a.ph_lo = 0; a.ph_hi = PH_COUNT;
    hipLaunchKernelGGL(hymba_fwd, dim3(grid), dim3(NTHREADS), LDS_BYTES, stream, a);
#else
    for (int p = 0; p < PH_COUNT; ++p) { a.ph_lo = p; a.ph_hi = p + 1; hipLaunchKernelGGL(hymba_fwd, dim3(grid), dim3(NTHREADS), LDS_BYTES, stream, a); }
#endif
}
```

```cpp
#include <hip/hip_runtime.h>
#include <cstdio>
#include <cstdint>
#include <cmath>
namespace pg8 {
#define PG8_LAS __attribute__((address_space(3)))
typedef unsigned short bf16_t;
typedef short bf16x8 __attribute__((ext_vector_type(8)));
typedef float f32x4 __attribute__((ext_vector_type(4)));
typedef unsigned u32x4 __attribute__((ext_vector_type(4)));
constexpr int BM = 256, BK = 64, HALF = 128, HTB = HALF * BK * 2  , STAGE_BYTES = 8 * HTB, NXCD = 8, WGM = 8;

__host__ __device__ __forceinline__ int lds_byte(int r, int c) { const int st = (r >> 4) * 2 + (c >> 5), rr = r & 15, cc = c & 31, ob = rr * 64 + cc * 2; return st * 1024 + (ob ^ (((ob >> 9) & 1) << 5)); }
__host__ __device__ __forceinline__ void stage_rc(int b, int& R, int& C) { const int st = b / 1024, sb = b % 1024, swz = sb ^ (((sb >> 9) & 1) << 5); R = (st >> 1) * 16 + swz / 64; C = (st & 1) * 32 + (swz % 64) / 2; }
__host__ __device__ __forceinline__ int perm32(int rho) { const int n = rho >> 4, i = rho & 15; return 8 * (i >> 2) + 4 * n + (i & 3); }

struct Unit { int pm, pn; };
struct Gemm { const bf16_t* A; const bf16_t* Bt; int M, N, K; };

struct StaticOrder {
    int nM, nN, nwg, G, c;
    __host__ __device__ void init(int M, int N, int G_, int c_) { nM = M / BM; nN = N / BM; nwg = nM * nN; G = G_; c = c_; }
    __host__ __device__ bool next(int i, Unit& u) const {
        const long L = (long)i * G + c; if (L >= nwg) return false;
        int wgid = (int)L; { const int q = nwg / NXCD, r = nwg % NXCD, xcd = wgid % NXCD, off = wgid / NXCD; wgid = (xcd < r ? xcd * (q + 1) : r * (q + 1) + (xcd - r) * q) + off; }
        const int nig = WGM * nN, gid = wgid / nig, fm = gid * WGM, gsz = (nM - fm) < WGM ? (nM - fm) : WGM;
        u.pm = fm + ((wgid % nig) % gsz); u.pn = (wgid % nig) / gsz; return true;
    }
    __device__ __forceinline__ void a_ready(const Unit&) const {}
    __device__ __forceinline__ void done(const Unit&) const {}
};

__device__ __forceinline__ unsigned cvt_pk_bf16(float lo, float hi) { unsigned r; asm volatile("v_cvt_pk_bf16_f32 %0, %1, %2" : "=v"(r) : "v"(lo), "v"(hi)); return r; }
typedef float f32x2 __attribute__((ext_vector_type(2)));
constexpr int MODLD_ = 49152;
__device__ __forceinline__ float fast_sigmoid(float x) { return __builtin_amdgcn_rcpf(1.0f + __expf(-x)); }
struct EpiZ {
    static constexpr bool PERM = true, AFTER_DRAIN = false;
    bf16_t* O; int ldc;
    __device__ __forceinline__ void operator()(const f32x4 (&acc)[2][2][4][2], const Unit& u, int wr, int wc, int fr, int fq) const {
        const int row0 = u.pm * BM + wr * 64 + fr, col0 = u.pn * BM + wc * 32 + 8 * fq;
#pragma unroll
        for (int ai = 0; ai < 2; ++ai)
#pragma unroll
            for (int m = 0; m < 4; ++m) { bf16_t* rowp = O + (size_t)(row0 + ai * HALF + m * 16) * ldc + col0;
#pragma unroll
                for (int bj = 0; bj < 2; ++bj) { const f32x4 v0 = acc[ai][bj][m][0], v1 = acc[ai][bj][m][1];
                    u32x4 w; w.x = cvt_pk_bf16(v0[0], v0[1]); w.y = cvt_pk_bf16(v0[2], v0[3]); w.z = cvt_pk_bf16(v1[0], v1[1]); w.w = cvt_pk_bf16(v1[2], v1[3]);
                    *(u32x4*)(rowp + bj * HALF) = w; } }
    }
};
struct EpiSwiGLU {
    static constexpr bool PERM = true, AFTER_DRAIN = false;
    bf16_t* O; int ldc;
    __device__ __forceinline__ void operator()(const f32x4 (&acc)[2][2][4][2], const Unit& u, int wr, int wc, int fr, int fq) const {
        const int row0 = u.pm * BM + wr * 64 + fr, col0 = u.pn * HALF + wc * 32 + 8 * fq;
#pragma unroll
        for (int ai = 0; ai < 2; ++ai)
#pragma unroll
            for (int m = 0; m < 4; ++m) { bf16_t* rowp = O + (size_t)(row0 + ai * HALF + m * 16) * ldc + col0;
                float r[8];
#pragma unroll
                for (int n = 0; n < 2; ++n)
#pragma unroll
                    for (int i = 0; i < 4; ++i) { const float g = acc[ai][0][m][n][i], up = acc[ai][1][m][n][i]; r[n * 4 + i] = g * fast_sigmoid(g) * up; }
                u32x4 w; w.x = cvt_pk_bf16(r[0], r[1]); w.y = cvt_pk_bf16(r[2], r[3]); w.z = cvt_pk_bf16(r[4], r[5]); w.w = cvt_pk_bf16(r[6], r[7]);
                *(u32x4*)rowp = w; }
    }
};
struct EpiResid {
    static constexpr bool PERM = false, AFTER_DRAIN = false;
    float* X; const float* gate; float* XS;
    __device__ __forceinline__ void operator()(const f32x4 (&acc)[2][2][4][2], const Unit& u, int wr, int wc, int fr, int fq) const {
        const int col0 = u.pn * BM + wc * 32 + 4 * fq;
        if (u.pm < 32) {
            const float* g = gate + (size_t)(u.pm >> 3) * MODLD_ + col0;
            f32x4 gv[2][2];
#pragma unroll
            for (int bj = 0; bj < 2; ++bj)
#pragma unroll
                for (int n = 0; n < 2; ++n) gv[bj][n] = *(const f32x4*)(g + bj * HALF + n * 16);
#pragma unroll
            for (int ai = 0; ai < 2; ++ai)
#pragma unroll
                for (int m = 0; m < 4; ++m) { const size_t xo = (size_t)(u.pm * BM + ai * HALF + wr * 64 + m * 16 + fr) * 2048 + col0; const float* xp = X + xo; float* xs = XS + xo;
#pragma unroll
                    for (int bj = 0; bj < 2; ++bj)
#pragma unroll
                        for (int n = 0; n < 2; ++n) { f32x4 xv = *(const f32x4*)(xp + bj * HALF + n * 16); xv = xv + gv[bj][n] * acc[ai][bj][m][n]; *(f32x4*)(xs + bj * HALF + n * 16) = xv; } }
        } else {
#pragma unroll
            for (int m = 0; m < 4; ++m) { const int rl = wr * 64 + m * 16 + fr;
                const float* g = gate + (size_t)(4 + (rl >> 2)) * MODLD_ + col0; float* xp = X + (size_t)(8192 + rl) * 2048 + col0;
#pragma unroll
                for (int bj = 0; bj < 2; ++bj)
#pragma unroll
                    for (int n = 0; n < 2; ++n) { const f32x4 gvv = *(const f32x4*)(g + bj * HALF + n * 16); f32x4 xv = *(const f32x4*)(xp + bj * HALF + n * 16);
                        xv = xv + gvv * acc[0][bj][m][n]; *(f32x4*)(xp + bj * HALF + n * 16) = xv; } }
        }
    }
};
struct EpiMod {
    static constexpr bool PERM = false, AFTER_DRAIN = false;
    float* M; const float* bias;
    __device__ __forceinline__ void operator()(const f32x4 (&acc)[2][2][4][2], const Unit& u, int wr, int wc, int fr, int fq) const {
        if (wr != 0) return;
        const int col0 = u.pn * BM + wc * 32 + 4 * fq;
#pragma unroll
        for (int m = 0; m < 3; ++m) { const int r = m * 16 + fr;
            if (r < 36) {
#pragma unroll
                for (int bj = 0; bj < 2; ++bj)
#pragma unroll
                    for (int n = 0; n < 2; ++n) { const f32x4 bv = *(const f32x4*)(bias + col0 + bj * HALF + n * 16);
                        *(f32x4*)(M + (size_t)r * MODLD_ + col0 + bj * HALF + n * 16) = acc[0][bj][m][n] + bv; } } }
    }
};

template <class Epi, class Sched, bool ALIGN_EPI = false, bool SP2 = false>
__device__ __forceinline__ void gemm_phase(PG8_LAS unsigned char* lds, const Gemm g, const Sched& S, const Epi& E, int wid_in) {
    int lane_ = (int)__builtin_amdgcn_mbcnt_hi(~0u, __builtin_amdgcn_mbcnt_lo(~0u, 0u)); asm volatile("" : "+v"(lane_));
    const int wid = __builtin_amdgcn_readfirstlane(wid_in), lane = lane_, tid = wid * 64 + lane, wr = wid >> 2, wc = wid & 3, fr = lane & 15, fq = lane >> 4;
    int K_ = g.K; asm volatile("" : "+s"(K_));
    const int K = K_, nt = K / BK;
    unsigned voffA[2], voffB[2];
#pragma unroll
    for (int i = 0; i < 2; ++i) { int R, C; stage_rc(tid * 16 + i * 8192, R, C); const int Rb = Epi::PERM ? ((R & ~31) + perm32(R & 31)) : R;
        voffA[i] = (unsigned)(R * K + C) * 2u; voffB[i] = (unsigned)(Rb * K + C) * 2u; }
    const size_t kstep = (size_t)(BK * 2);
    const size_t hstep = (size_t)HALF * K * 2;
    const size_t tstep = 2 * hstep;
    const unsigned ldsw = (unsigned)wid * 1024u;
    const int aoff = lds_byte(wr * 64 + fr, fq * 8), boff = lds_byte(wc * 32 + fr, fq * 8);
#define PG8_SA(b, h) (((b) * 2 + (h)) * HTB)
#define PG8_SB(b, h) ((4 + (b) * 2 + (h)) * HTB)
#define PG8_STAGE(bufoff, gbase, voff) do { _Pragma("unroll") for (int _i = 0; _i < 2; ++_i) \
        __builtin_amdgcn_global_load_lds((const unsigned*)((const char*)(gbase) + (voff)[_i]), (PG8_LAS unsigned*)(lds + (bufoff) + ldsw + _i * 8192), 16, 0, 0); } while (0)
#define PG8_LDA(dst, b, h) do { _Pragma("unroll") for (int m = 0; m < 4; ++m) _Pragma("unroll") for (int k = 0; k < 2; ++k) dst[m][k] = *(const PG8_LAS bf16x8*)(lds + PG8_SA(b, h) + aoff + m * 2048 + k * 1024); } while (0)
#define PG8_LDB(dst, b, h) do { _Pragma("unroll") for (int n = 0; n < 2; ++n) _Pragma("unroll") for (int k = 0; k < 2; ++k) dst[n][k] = *(const PG8_LAS bf16x8*)(lds + PG8_SB(b, h) + boff + n * 2048 + k * 1024); } while (0)
#define PG8_MMA(ai, bj, At, Bt) do { __builtin_amdgcn_s_setprio(1); _Pragma("unroll") for (int m = 0; m < 4; ++m) _Pragma("unroll") for (int n = 0; n < 2; ++n) _Pragma("unroll") for (int k = 0; k < 2; ++k) \
        acc[ai][bj][m][n] = __builtin_amdgcn_mfma_f32_16x16x32_bf16(Bt[n][k], At[m][k], acc[ai][bj][m][n], 0, 0, 0); __builtin_amdgcn_s_setprio(0); } while (0)
#define PG8_WAIT_V(n) asm volatile("s_waitcnt vmcnt(" #n ")" ::: "memory")
#define PG8_WAIT_L(n) asm volatile("s_waitcnt lgkmcnt(" #n ")" ::: "memory")
#define PG8_BAR __builtin_amdgcn_s_barrier()
#define PG8_SCHED __builtin_amdgcn_sched_barrier(0)
    Unit cur, nxt; int ui = 0;
    if (!S.next(0, cur)) return;
    f32x4 acc[2][2][4][2];
#pragma unroll
    for (int a = 0; a < 2; ++a)
#pragma unroll
        for (int b = 0; b < 2; ++b)
#pragma unroll
            for (int m = 0; m < 4; ++m)
#pragma unroll
                for (int n = 0; n < 2; ++n) acc[a][b][m][n] = (f32x4){0.f, 0.f, 0.f, 0.f};
    bf16x8 At[4][2], B0[2][2], B1[2][2];
    const char* cA = (const char*)g.A + (size_t)cur.pm * tstep; const char* cB = (const char*)g.Bt + (size_t)cur.pn * tstep;
    S.a_ready(cur);
    if constexpr (SP2) {
        PG8_STAGE(PG8_SB(0, 0), cB, voffB); PG8_STAGE(PG8_SB(0, 1), cB + hstep, voffB); PG8_STAGE(PG8_SA(0, 0), cA, voffA); PG8_STAGE(PG8_SA(0, 1), cA + hstep, voffA);
        if (wr == 1) PG8_BAR;
        PG8_WAIT_V(2); PG8_BAR;
        PG8_STAGE(PG8_SB(1, 0), cB + kstep, voffB); PG8_STAGE(PG8_SA(1, 0), cA + kstep, voffA); PG8_STAGE(PG8_SB(1, 1), cB + hstep + kstep, voffB);
        PG8_WAIT_V(6); PG8_BAR;
    } else {
        PG8_STAGE(PG8_SB(0, 0), cB, voffB); PG8_STAGE(PG8_SA(0, 0), cA, voffA); PG8_STAGE(PG8_SB(0, 1), cB + hstep, voffB); PG8_STAGE(PG8_SA(0, 1), cA + hstep, voffA);
        if (wr == 1) PG8_BAR;
        PG8_WAIT_V(4); PG8_BAR;
        PG8_STAGE(PG8_SB(1, 0), cB + kstep, voffB); PG8_STAGE(PG8_SA(1, 0), cA + kstep, voffA); PG8_STAGE(PG8_SB(1, 1), cB + hstep + kstep, voffB);
        PG8_WAIT_V(6); PG8_BAR;
    }
    for (;;) {
        const bool has_next = S.next(ui + 1, nxt);
        const char* nA = has_next ? (const char*)g.A + (size_t)nxt.pm * tstep : cA; const char* nB = has_next ? (const char*)g.Bt + (size_t)nxt.pn * tstep : cB;
        for (int t = 0; t < nt; t += 2) {
            const bool last = (t == nt - 2);
            const char* a1 = cA + (size_t)(t + 1) * kstep;
            const char* a2 = last ? nA : cA + (size_t)(t + 2) * kstep; const char* b2 = last ? nB : cB + (size_t)(t + 2) * kstep;
            const char* a3 = a2 + kstep; const char* b3 = b2 + kstep;
            if (last && has_next) S.a_ready(nxt);
            if constexpr (SP2) {
            PG8_LDB(B0, 0, 0); PG8_LDB(B1, 0, 1); PG8_SCHED; PG8_LDA(At, 0, 0); PG8_STAGE(PG8_SA(1, 1), a1 + hstep, voffA);
            PG8_WAIT_V(8); PG8_WAIT_L(0); PG8_BAR; PG8_MMA(0, 0, At, B0); PG8_MMA(0, 1, At, B1); PG8_BAR; PG8_SCHED;
            PG8_LDA(At, 0, 1); PG8_STAGE(PG8_SB(0, 0), b2, voffB); PG8_STAGE(PG8_SB(0, 1), b2 + hstep, voffB); PG8_STAGE(PG8_SA(0, 0), a2, voffA);
            PG8_WAIT_V(8); PG8_WAIT_L(0); PG8_BAR; PG8_MMA(1, 0, At, B0); PG8_MMA(1, 1, At, B1); PG8_BAR; PG8_SCHED;
            PG8_LDB(B0, 1, 0); PG8_LDB(B1, 1, 1); PG8_SCHED; PG8_LDA(At, 1, 0); PG8_STAGE(PG8_SA(0, 1), a2 + hstep, voffA);
            PG8_WAIT_V(8); PG8_WAIT_L(0); PG8_BAR; PG8_MMA(0, 0, At, B0); PG8_MMA(0, 1, At, B1); PG8_BAR; PG8_SCHED;
            PG8_LDA(At, 1, 1); PG8_STAGE(PG8_SB(1, 0), b3, voffB); PG8_STAGE(PG8_SB(1, 1), b3 + hstep, voffB); PG8_STAGE(PG8_SA(1, 0), a3, voffA);
            PG8_WAIT_V(8); PG8_WAIT_L(0); PG8_BAR; PG8_MMA(1, 0, At, B0); PG8_MMA(1, 1, At, B1); PG8_BAR; PG8_SCHED;
            } else {
            PG8_LDB(B0, 0, 0); PG8_SCHED; PG8_LDA(At, 0, 0); PG8_STAGE(PG8_SA(1, 1), a1 + hstep, voffA);
            PG8_WAIT_L(8); PG8_BAR; PG8_WAIT_L(0); PG8_MMA(0, 0, At, B0); PG8_BAR; PG8_SCHED;
            PG8_LDB(B1, 0, 1); PG8_STAGE(PG8_SB(0, 0), b2, voffB);
            PG8_BAR; PG8_WAIT_L(0); PG8_MMA(0, 1, At, B1); PG8_BAR;
            PG8_LDA(At, 0, 1); PG8_STAGE(PG8_SA(0, 0), a2, voffA);
            PG8_BAR; PG8_WAIT_L(0); PG8_MMA(1, 0, At, B0); PG8_BAR; PG8_SCHED;
            PG8_STAGE(PG8_SB(0, 1), b2 + hstep, voffB);
            PG8_WAIT_V(6); PG8_BAR; PG8_MMA(1, 1, At, B1); PG8_BAR;
            PG8_LDB(B0, 1, 0); PG8_SCHED; PG8_LDA(At, 1, 0); PG8_STAGE(PG8_SA(0, 1), a2 + hstep, voffA);
            PG8_WAIT_L(8); PG8_BAR; PG8_WAIT_L(0); PG8_MMA(0, 0, At, B0); PG8_BAR; PG8_SCHED;
            PG8_LDB(B1, 1, 1); PG8_STAGE(PG8_SB(1, 0), b3, voffB);
            PG8_BAR; PG8_WAIT_L(0); PG8_MMA(0, 1, At, B1); PG8_BAR;
            PG8_LDA(At, 1, 1); PG8_STAGE(PG8_SA(1, 0), a3, voffA);
            PG8_BAR; PG8_WAIT_L(0); PG8_MMA(1, 0, At, B0); PG8_BAR; PG8_SCHED;
            PG8_STAGE(PG8_SB(1, 1), b3 + hstep, voffB);
            PG8_WAIT_V(6); PG8_BAR; PG8_MMA(1, 1, At, B1); PG8_BAR;
            }
        }
        if constexpr (ALIGN_EPI) { if (wr == 0) PG8_BAR; }
        if constexpr (!Epi::AFTER_DRAIN) { E(acc, cur, wr, wc, fr, fq); S.done(cur); }
        if (!has_next) break;
#pragma unroll
        for (int a = 0; a < 2; ++a)
#pragma unroll
            for (int b = 0; b < 2; ++b)
#pragma unroll
                for (int m = 0; m < 4; ++m)
#pragma unroll
                    for (int n = 0; n < 2; ++n) acc[a][b][m][n] = (f32x4){0.f, 0.f, 0.f, 0.f};
        cur = nxt; cA = nA; cB = nB; ++ui;
        if constexpr (ALIGN_EPI) { if (wr == 1) PG8_BAR; }
    }
    PG8_WAIT_V(0);
    if constexpr (!ALIGN_EPI) { if (wr == 0) PG8_BAR; }
    PG8_BAR;
    if constexpr (Epi::AFTER_DRAIN) { E.fused(acc, cur, wr, wc, fr, fq, lds, wid, lane); S.done(cur); }
#undef PG8_SA
#undef PG8_SB
#undef PG8_STAGE
#undef PG8_LDA
#undef PG8_LDB
#undef PG8_MMA
#undef PG8_WAIT_V
#undef PG8_WAIT_L
#undef PG8_BAR
#undef PG8_SCHED
}
}
#define GAS __attribute__((address_space(1)))
#define LAS __attribute__((address_space(3)))
typedef unsigned short bf16;
typedef unsigned v4u __attribute__((ext_vector_type(4)));
typedef float f32x4 __attribute__((ext_vector_type(4)));
typedef short bf16x8 __attribute__((ext_vector_type(8)));
typedef GAS unsigned gu32;
typedef GAS unsigned long long gu64;
#define RLX_AGENT __ATOMIC_RELAXED, __HIP_MEMORY_SCOPE_AGENT
#define LDS_WAIT() asm volatile("s_waitcnt lgkmcnt(0)" ::: "memory")
#define VM_WAIT() asm volatile("s_waitcnt vmcnt(0)" ::: "memory")
__device__ __forceinline__ unsigned long long rt() { return __builtin_amdgcn_s_memrealtime(); }
__device__ __forceinline__ unsigned f2bf(float f) { unsigned u = __builtin_bit_cast(unsigned, f); return (u + 0x7fffu + ((u >> 16) & 1u)) >> 16; }
__device__ __forceinline__ unsigned pk2(float lo, float hi) { return f2bf(lo) | (f2bf(hi) << 16); }

#define XB_TMO      128
#define XB_XCNT(j)  (256  + 64 * (j))
#define XB_XSUB(j)  (1280 + 64 * (j))
#define XB_XGEN(j)  (2304 + 64 * (j))
#define XB_TOP      3328
#define XB_TOPGEN   3392
#define XCD_BAR_WORDS 3456
#define XB_SPIN_CAP (1u << 18)

__device__ __forceinline__ unsigned xb_ld(unsigned* p)              { return __hip_atomic_load(p, __ATOMIC_RELAXED, __HIP_MEMORY_SCOPE_AGENT); }
__device__ __forceinline__ unsigned xb_add(unsigned* p, unsigned v) { return __hip_atomic_fetch_add(p, v, __ATOMIC_RELAXED, __HIP_MEMORY_SCOPE_AGENT); }
__device__ __forceinline__ unsigned xb_xcc_id() { return (unsigned)__builtin_amdgcn_s_getreg((3 << 11) | 20) & 0xFu; }
#define XB_SPIN(cond, bar) do { unsigned _sp = 0; while (cond) { __builtin_amdgcn_s_sleep(1); \
    if ((++_sp & 255u) == 0u) { if (xb_ld(&(bar)[XB_TMO])) break; if (_sp > XB_SPIN_CAP) { atomicAdd(&(bar)[XB_TMO], 1u); break; } } } } while (0)

struct XcdBarrier {
    unsigned* bar; unsigned x;
    volatile LAS unsigned* st;
};

__device__ __forceinline__ XcdBarrier xcd_barrier_post(unsigned* bar, volatile LAS unsigned* st) {
    XcdBarrier b; b.bar = bar; b.x = xb_xcc_id(); b.st = st;
    if (threadIdx.x == 0) (void)xb_add(&bar[XB_XCNT(b.x)], 1u);
    return b;
}
__device__ __forceinline__ void xcd_barrier_complete(unsigned* bar, unsigned x, unsigned& nloc, unsigned& nx) {
    const unsigned G = gridDim.x * gridDim.y * gridDim.z;
    unsigned sum, cnt, mine, sp = 0u;
    for (;;) {
        sum = 0u; cnt = 0u; mine = 0u;
#pragma unroll
        for (unsigned j = 0; j < 16; ++j) { const unsigned c = xb_ld(&bar[XB_XCNT(j)]); sum += c; cnt += (c > 0u) ? 1u : 0u; mine = (j == x) ? c : mine; }
        if (sum == G) break;
        __builtin_amdgcn_s_sleep(1);
        if ((++sp & 255u) == 0u) { if (xb_ld(&bar[XB_TMO])) break; if (sp > XB_SPIN_CAP) { atomicAdd(&bar[XB_TMO], 1u); break; } }
    }
    nloc = mine > 0u ? mine : 1u; nx = cnt > 0u ? cnt : 1u;
}

__device__ __forceinline__ void xcd_barrier(const XcdBarrier& b) {
    asm volatile("s_waitcnt vmcnt(0)" ::: "memory");
    __syncthreads();
    if (threadIdx.x == 0) {
        unsigned* bar = b.bar;
        __builtin_amdgcn_s_waitcnt(0);
        unsigned nloc = b.st[0], nx = b.st[1];
        if (nloc == 0u) { xcd_barrier_complete(bar, b.x, nloc, nx); b.st[0] = nloc; b.st[1] = nx; }
        const unsigned old = xb_add(&bar[XB_XSUB(b.x)], 1u);
        const unsigned gen = old / nloc;
        if (old + 1u == (gen + 1u) * nloc) {
            __builtin_amdgcn_fence(__ATOMIC_RELEASE, "agent");
            asm volatile("s_waitcnt vmcnt(0)" ::: "memory");
            const unsigned og = xb_add(&bar[XB_TOP], 1u);
            const unsigned tg = og / nx;
            if (og + 1u == (tg + 1u) * nx) xb_add(&bar[XB_TOPGEN], 1u);
            else XB_SPIN(xb_ld(&bar[XB_TOPGEN]) == tg, bar);
            __builtin_amdgcn_fence(__ATOMIC_ACQUIRE, "agent");
            xb_add(&bar[XB_XGEN(b.x)], 1u);
            asm volatile("s_waitcnt vmcnt(0)" ::: "memory");
        } else {
            XB_SPIN(xb_ld(&bar[XB_XGEN(b.x)]) == gen, bar);
            __builtin_amdgcn_fence(__ATOMIC_ACQUIRE, "agent");
            asm volatile("s_waitcnt vmcnt(0)" ::: "memory");
        }
    }
    __syncthreads();
}

constexpr int NWAVES = 8, NTHREADS = 512;
constexpr int DM = 2048, NP_ROWS = 8192, NS_ROWS = 128, NROWS = 8320, MPAD = 8448;
constexpr int DEPTH = 4, NBATCH = 36;
constexpr int INW = 4368, ZW = 4608;
constexpr int ZQ = 0, ZK = 512, ZV = 640, ZU = 768, GQ = 1280, GK = 1792, GV = 2304, GG = 3328, GA = 4352;
constexpr int DFF = 5632, NGU = 11264, MODW = 12288, MODLD = 49152;
constexpr float EPS = 1e-6f;
constexpr size_t O_Y = 0, O_WK_P = 17039360, O_WV_P = 17301504, O_POOL_P = 17563648, O_GLA_P = 17686528,
                 O_WK_S = 19783680, O_WV_S = 21880832, O_POOL_S = 23977984, O_GLA_S = 24961024, O_END = 41738240;
constexpr size_t MiB = 1u << 20;
constexpr size_t WS_CTL = 0, CTL_ZERO_BYTES = 1 * MiB;
constexpr size_t WS_WADA = 1 * MiB;
constexpr size_t WS_WIN  = WS_WADA + 192 * MiB;
constexpr size_t WS_WOUT = WS_WIN + 72 * MiB;
constexpr size_t WS_WGU  = WS_WOUT + 32 * MiB;
constexpr size_t WS_WDN  = WS_WGU + 176 * MiB;
constexpr size_t WS_X    = WS_WDN + 88 * MiB;
constexpr size_t WS_H    = WS_X + 66 * MiB;
constexpr size_t WS_Z    = WS_H + 33 * MiB;
constexpr size_t WS_MIX  = WS_Z + 75 * MiB;
constexpr size_t WS_ACT  = WS_MIX + 33 * MiB;
constexpr size_t WS_OGLA = WS_ACT + 91 * MiB;
constexpr size_t WS_LA   = WS_OGLA + 33 * MiB;
constexpr size_t WS_MOD  = WS_LA + 17 * MiB;
constexpr size_t WS_SC   = WS_MOD + 7 * MiB;
constexpr size_t WS_BTAB = WS_SC + 1 * MiB;
constexpr size_t WS_WPT  = WS_BTAB + 1 * MiB;
constexpr size_t WS_QDG  = WS_WPT + 1 * MiB;
constexpr size_t WS_KDTG = WS_QDG + 9 * MiB;
constexpr size_t WS_VTG  = WS_KDTG + 11 * MiB;
constexpr size_t WS_DLG  = WS_VTG + 21 * MiB;
constexpr size_t WS_DUMMY = WS_DLG + 1 * MiB;
constexpr size_t WS_END  = WS_DUMMY + 66 * MiB;
constexpr int CW_BAR = 4096;
constexpr int RING_OFF = 0, RING_BYTES = 131072;
constexpr int LDSCTL_OFF = RING_BYTES, MISC_OFF = LDSCTL_OFF + 320;
constexpr int LDS_BYTES = 147456;

struct Args { const float* in[24]; float* out; unsigned char* ws; int ph_lo, ph_hi; };
struct Frame {
    LAS unsigned char* lds;
    volatile LAS unsigned* MISC;
    int wave, vcu, G; int zo; int probe;
    __device__ __forceinline__ float* X_ST() const { return (float*)(ws + (probe ? WS_DUMMY : WS_X)); }
    __device__ __forceinline__ float* OGLA_ST() const { return (float*)(ws + (probe ? WS_DUMMY : WS_OGLA)); }
    __device__ __forceinline__ int lane_id() const { return (int)__builtin_amdgcn_mbcnt_hi(~0u, __builtin_amdgcn_mbcnt_lo(~0u, 0u)); }
    unsigned char* ws; float* out;
    __device__ __forceinline__ bf16* Wada_t() const { return (bf16*)(ws + WS_WADA); }
    __device__ __forceinline__ bf16* Win_t() const { return (bf16*)(ws + WS_WIN); }
    __device__ __forceinline__ bf16* Wout_t() const { return (bf16*)(ws + WS_WOUT); }
    __device__ __forceinline__ bf16* Wgu_t() const { return (bf16*)(ws + WS_WGU); }
    __device__ __forceinline__ bf16* Wdn_t() const { return (bf16*)(ws + WS_WDN); }
    __device__ __forceinline__ float* X() const { return (float*)(ws + WS_X); }
    __device__ __forceinline__ bf16* H() const { return (bf16*)(ws + WS_H); }
    __device__ __forceinline__ bf16* Z() const { return (bf16*)(ws + WS_Z); }
    __device__ __forceinline__ bf16* MIX() const { return (bf16*)(ws + WS_MIX); }
    __device__ __forceinline__ bf16* ACT() const { return (bf16*)(ws + WS_ACT); }
    __device__ __forceinline__ float* OGLA() const { return (float*)(ws + WS_OGLA); }
    __device__ __forceinline__ float* SLOC() const { return (float*)(ws + WS_LA); }
    __device__ __forceinline__ float* DSEG() const { return (float*)(ws + WS_LA + 16 * MiB); }
    __device__ __forceinline__ float* MOD() const { return (float*)(ws + WS_MOD); }
    __device__ __forceinline__ bf16* SC() const { return (bf16*)(ws + WS_SC); }
    __device__ __forceinline__ float* BTAB() const { return (float*)(ws + WS_BTAB); }
    __device__ __forceinline__ bf16* WPT() const { return (bf16*)(ws + WS_WPT); }
    __device__ __forceinline__ bf16* QDG() const { return (bf16*)(ws + WS_QDG); }
    __device__ __forceinline__ bf16* KDTG() const { return (bf16*)(ws + WS_KDTG); }
    __device__ __forceinline__ bf16* VTG() const { return (bf16*)(ws + WS_VTG); }
    __device__ __forceinline__ float* DLG() const { return (float*)(ws + WS_DLG); }
};
enum { I_XP = 0, I_XS, I_CK, I_CV, I_SPOOL, I_SGLA, I_CP, I_CS, I_WADA, I_BADA, I_GMIX, I_GFFN, I_WIN, I_WOUT, I_RELB, I_SINKS, I_WPOOL, I_PSCALE, I_WA2, I_BA2, I_GGLA, I_WGU, I_WDN, I_GFIN };

__device__ __forceinline__ float bf2f(unsigned short b) { return __uint_as_float((unsigned)b << 16); }
__device__ __forceinline__ float bflo(unsigned w) { return __uint_as_float(w << 16); }
__device__ __forceinline__ float bfhi(unsigned w) { return __uint_as_float(w & 0xffff0000u); }
__device__ __forceinline__ float wave_sum(float v) {
#pragma unroll
    for (int o = 1; o < 64; o <<= 1) v += __shfl_xor(v, o);
    return v;
}
__device__ __forceinline__ float wave_max(float v) {
#pragma unroll
    for (int o = 1; o < 64; o <<= 1) v = fmaxf(v, __shfl_xor(v, o));
    return v;
}
__device__ __forceinline__ int t5_bucket(int n) {
    if (n < 16) return n;
    return 16 + (n >= 19) + (n >= 21) + (n >= 24) + (n >= 27) + (n >= 31) + (n >= 35) + (n >= 40) + (n >= 46) + (n >= 52) + (n >= 59) + (n >= 67) + (n >= 77) + (n >= 87) + (n >= 99) + (n >= 113);
}

template <int MODE>
__device__ __forceinline__ void transpose_item(const float* W, int K, int N, int nblk, bf16* WT, int row_off, LAS float* scr, int item, int lane) {
    const int kb = item / nblk, nb = item % nblk, k0 = 64 * kb, n0 = 32 * nb;
    const int nn = n0 + (lane & 31); const bool ok = nn < N;
    float wv[32];
#pragma unroll
    for (int i = 0; i < 32; ++i) { const int kk = 2 * i + (lane >> 5); wv[i] = ok ? W[(size_t)(k0 + kk) * N + nn] : 0.f; }
#pragma unroll
    for (int i = 0; i < 32; ++i) { const int kk = 2 * i + (lane >> 5); scr[kk * 33 + (lane & 31)] = wv[i]; }
    LDS_WAIT(); asm volatile("" ::: "memory");
    const int c = lane & 7;
#pragma unroll
    for (int j = 0; j < 4; ++j) { const int n = (lane >> 3) + 8 * j; const LAS float* s = scr + (8 * c) * 33 + n;
        v4u o; o.x = pk2(s[0 * 33], s[1 * 33]); o.y = pk2(s[2 * 33], s[3 * 33]); o.z = pk2(s[4 * 33], s[5 * 33]); o.w = pk2(s[6 * 33], s[7 * 33]);
        int orow = n0 + n;
        if (MODE == 1) { orow = (orow < DFF) ? ((orow >> 7) * 256 + (orow & 127)) : (((orow - DFF) >> 7) * 256 + 128 + ((orow - DFF) & 127)); }
        *(GAS v4u*)(WT + (size_t)(row_off + orow) * K + k0 + 8 * c) = o; }
    LDS_WAIT(); asm volatile("" ::: "memory");
}
__device__ __forceinline__ void p0_prologue(Frame& F, const Args& A) {
    LAS float* scr = (LAS float*)(F.lds + RING_OFF + F.wave * 16384);
    const int gw = F.vcu * NWAVES + F.wave, NGW = F.G * NWAVES;
    const int gt = gw * 64 + F.lane_id(), NGT = NGW * 64;
    constexpr int I_ADA = 32 * 384, I_IN = 32 * 137, I_OUT = 32 * 64, I_GU = 32 * 352, I_DN = 88 * 64, I_L = I_ADA + I_IN + I_OUT + I_GU + I_DN;
    for (int it = gw; it < DEPTH * I_L; it += NGW) {
        const int l = it / I_L; int r = it - l * I_L;
        if (r < I_ADA) { transpose_item<0>(A.in[F.zo + I_WADA] + (size_t)l * DM * MODW, DM, MODW, 384, F.Wada_t(), l * MODW, scr, r, F.lane_id()); continue; } r -= I_ADA;
        if (r < I_IN)  { transpose_item<0>(A.in[F.zo + I_WIN] + (size_t)l * DM * INW, DM, INW, 137, F.Win_t() + (size_t)l * ZW * DM, 0, scr, r, F.lane_id()); continue; } r -= I_IN;
        if (r < I_OUT) { transpose_item<0>(A.in[F.zo + I_WOUT] + (size_t)l * DM * DM, DM, DM, 64, F.Wout_t() + (size_t)l * DM * DM, 0, scr, r, F.lane_id()); continue; } r -= I_OUT;
        if (r < I_GU)  { transpose_item<1>(A.in[F.zo + I_WGU] + (size_t)l * DM * NGU, DM, NGU, 352, F.Wgu_t() + (size_t)l * NGU * DM, 0, scr, r, F.lane_id()); continue; } r -= I_GU;
        transpose_item<0>(A.in[F.zo + I_WDN] + (size_t)l * DFF * DM, DFF, DM, 64, F.Wdn_t() + (size_t)l * DM * DFF, 0, scr, r, F.lane_id());
    }
    const v4u z4 = {0u, 0u, 0u, 0u};
    for (int i = gt; i < DEPTH * 224 * 256; i += NGT) { const int l = i / (224 * 256), r = i - l * (224 * 256); *((GAS v4u*)(F.Win_t() + ((size_t)l * ZW + 4384) * DM) + r) = z4; }
    for (int i = gt; i < 128 * 256; i += NGT) { *((GAS v4u*)(F.H() + (size_t)NROWS * DM) + i) = z4; *((GAS v4u*)(F.MIX() + (size_t)NROWS * DM) + i) = z4; }
    for (int i = gt; i < 128 * 704; i += NGT) *((GAS v4u*)(F.ACT() + (size_t)NROWS * DFF) + i) = z4;
    for (int i = gt; i < NP_ROWS * 512; i += NGT) ((GAS f32x4*)F.X())[i] = ((const GAS f32x4*)A.in[F.zo + I_XP])[i];
    for (int i = gt; i < NS_ROWS * 512; i += NGT) ((GAS f32x4*)(F.X() + (size_t)NP_ROWS * DM))[i] = ((const GAS f32x4*)A.in[F.zo + I_XS])[i];
    for (int i = gt; i < 256 * 1024; i += NGT) { const int r = i >> 10, cp = (i & 1023) * 2; unsigned w = 0u;
        if (r < NBATCH) { const float* c = (r < 4) ? (A.in[F.zo + I_CP] + (size_t)r * DM) : (A.in[F.zo + I_CS] + (size_t)(r - 4) * DM); const float a = c[cp], b = c[cp + 1];
            w = pk2(a / (1.0f + __expf(-a)), b / (1.0f + __expf(-b))); }
        ((GAS unsigned*)F.SC())[i] = w; }
    for (int i = gt; i < 4 * 4 * 128 * 128; i += NGT) { const int lg = i >> 14, dcol = (i >> 7) & 127, c = i & 127; F.WPT()[i] = (bf16)f2bf(A.in[F.zo + I_WPOOL][((size_t)lg * 128 + c) * 128 + dcol]); }
    for (int i = gt; i < 8 * 128; i += NGT) { const int h = i >> 7, dist = i & 127; F.BTAB()[i] = A.in[F.zo + I_RELB][t5_bucket(dist) * 8 + h]; }
}

__device__ __forceinline__ void norm_mod_rows(Frame& F, const float* g, const float* modl  ) {
    const int gw = F.vcu * NWAVES + F.wave, NGW = F.G * NWAVES;
    for (int r = gw; r < NROWS; r += NGW) {
        const int b = r < NP_ROWS ? (r >> 11) : 4 + ((r - NP_ROWS) >> 2);
        const float* xr = F.X() + (size_t)r * DM + 4 * F.lane_id(); const float* sh = modl + (size_t)b * MODLD + 4 * F.lane_id(); const float* gg = g + 4 * F.lane_id();
        f32x4 v[8]; float ss = 0.f;
#pragma unroll
        for (int j = 0; j < 8; ++j) { v[j] = *(const f32x4*)(xr + 256 * j); ss += (v[j].x * v[j].x + v[j].y * v[j].y) + (v[j].z * v[j].z + v[j].w * v[j].w); }
        const float rstd = 1.0f / sqrtf(wave_sum(ss) * (1.0f / DM) + EPS);
        bf16* hr = F.H() + (size_t)r * DM + 4 * F.lane_id();
#pragma unroll
        for (int j = 0; j < 8; ++j) { const f32x4 gv = *(const f32x4*)(gg + 256 * j), sv = *(const f32x4*)(sh + 256 * j), cv = *(const f32x4*)(sh + 2048 + 256 * j);
            const f32x4 y = (v[j] * rstd * gv) * (1.0f + cv) + sv;
            uint2 w; w.x = pk2(y.x, y.y); w.y = pk2(y.z, y.w); *(uint2*)(hr + 256 * j) = w; }
    }
}
__device__ __forceinline__ void final_norm_rows(Frame& F, const Args& A) {
    const int gw = F.vcu * NWAVES + F.wave, NGW = F.G * NWAVES; const float* g = A.in[F.zo + I_GFIN] + 4 * F.lane_id();
    for (int r = gw; r < NROWS; r += NGW) {
        const float* xr = F.X() + (size_t)r * DM + 4 * F.lane_id();
        f32x4 v[8]; float ss = 0.f;
#pragma unroll
        for (int j = 0; j < 8; ++j) { v[j] = *(const f32x4*)(xr + 256 * j); ss += (v[j].x * v[j].x + v[j].y * v[j].y) + (v[j].z * v[j].z + v[j].w * v[j].w); }
        const float rstd = 1.0f / sqrtf(wave_sum(ss) * (1.0f / DM) + EPS);
        float* yr = F.out + O_Y + (size_t)r * DM + 4 * F.lane_id();
#pragma unroll
        for (int j = 0; j < 8; ++j) { const f32x4 gv = *(const f32x4*)(g + 256 * j); *(f32x4*)(yr + 256 * j) = v[j] * rstd * gv; }
    }
}

__device__ __forceinline__ void attn_item(Frame& F, const Args& A, int l, int r, int hd, LAS float* ps) {
    const int lane = F.lane_id(), g = hd >> 2; const bool smp = r >= NP_ROWS;
    const int t = r & 2047, sb = smp ? ((r - NP_ROWS) >> 2) : 0, si = (r - NP_ROWS) & 3;
    LAS float* qs = ps + 128;
    { const unsigned w = ((const unsigned*)(F.Z() + (size_t)r * ZW + ZQ + hd * 64))[lane & 31]; if (lane < 32) { qs[2 * lane] = bflo(w); qs[2 * lane + 1] = bfhi(w); } }
    LDS_WAIT(); asm volatile("" ::: "memory");
    const float* ck = A.in[F.zo + I_CK] + ((size_t)(l * 32 + sb) * 128) * 128 + g * 64;
    const float* cv = A.in[F.zo + I_CV] + ((size_t)(l * 32 + sb) * 128) * 128 + g * 64;
    const int jmin = smp ? 0 : (t >= 127 ? 0 : 127 - t);
    float sc[2];
#pragma unroll 1
    for (int jj = 0; jj < 2; ++jj) {
        const int j = lane + 64 * jj, dist = 127 - j; float dot = 0.f; bool valid = j >= jmin;
        if (valid) {
            const int krel = si - dist;
            if (smp && krel < 0) {
                const f32x4* kp = (const f32x4*)(ck + (size_t)(krel + 128) * 128);
#pragma unroll 4
                for (int c = 0; c < 16; ++c) { const f32x4 kv = kp[c]; const f32x4 qv = *(const LAS f32x4*)(qs + 4 * c); dot += qv.x * kv.x + qv.y * kv.y + qv.z * kv.z + qv.w * kv.w; }
            } else {
                const int krow = smp ? (NP_ROWS + sb * 4 + krel) : (r - dist);
                const v4u* kp = (const v4u*)(F.Z() + (size_t)krow * ZW + ZK + g * 64);
#pragma unroll 4
                for (int c = 0; c < 8; ++c) { const v4u w = kp[c];
                    const f32x4 qa = *(const LAS f32x4*)(qs + 8 * c), qb = *(const LAS f32x4*)(qs + 8 * c + 4);
                    dot += qa.x * bflo(w.x) + qa.y * bfhi(w.x) + qa.z * bflo(w.y) + qa.w * bfhi(w.y) + qb.x * bflo(w.z) + qb.y * bfhi(w.z) + qb.z * bflo(w.w) + qb.w * bfhi(w.w); }
            }
        }
        const float sv = valid ? dot * 0.125f + F.BTAB()[hd * 128 + dist] : -INFINITY;
        if (jj == 0) sc[0] = sv; else sc[1] = sv;
    }
    const float sink = A.in[F.zo + I_SINKS][l * 8 + hd];
    const float m = fmaxf(wave_max(fmaxf(sc[0], sc[1])), sink);
    const float p0 = __expf(sc[0] - m), p1 = __expf(sc[1] - m);
    const float denom = wave_sum(p0 + p1) + __expf(sink - m);
    ps[lane] = p0; ps[lane + 64] = p1;
    LDS_WAIT(); asm volatile("" ::: "memory");
    float o = 0.f;
#pragma unroll 16
    for (int j = jmin; j < 128; ++j) {
        const float pj = ps[j]; const int dist = 127 - j; float vv;
        const int krel = si - dist;
        if (smp && krel < 0) vv = cv[(size_t)(krel + 128) * 128 + lane];
        else { const int krow = smp ? (NP_ROWS + sb * 4 + krel) : (r - dist); vv = bf2f(F.Z()[(size_t)krow * ZW + ZV + g * 64 + lane]); }
        o += pj * vv;
    }
    F.MIX()[(size_t)r * DM + hd * 64 + lane] = (bf16)f2bf(o / denom);
    LDS_WAIT(); asm volatile("" ::: "memory");
}
__device__ __forceinline__ void pool_item(Frame& F, const Args& A, int l, int r, int gi, LAS float* ds) {
    const int lane = F.lane_id(), w = 2 << gi; const bool smp = r >= NP_ROWS;
    const int t = r & 2047, sb = (r - NP_ROWS) >> 2, si = (r - NP_ROWS) & 3;
    const float* pbuf = A.in[F.zo + I_SPOOL] + ((size_t)(l * 32 + sb) * 15) * 512 + gi * 128;
    float s0 = 0.f, s1 = 0.f, u0 = 0.f, u1 = 0.f;
#pragma unroll 4
    for (int o = 0; o < w; ++o) {
        float a0 = 0.f, a1 = 0.f;
        if (!smp) { if (t - o >= 0) { const bf16* zp = F.Z() + (size_t)(r - o) * ZW + ZU + gi * 128; a0 = bf2f(zp[lane]); a1 = bf2f(zp[lane + 64]); } }
        else { const int idx = si - o;
            if (idx >= 0) { const bf16* zp = F.Z() + (size_t)(NP_ROWS + sb * 4 + idx) * ZW + ZU + gi * 128; a0 = bf2f(zp[lane]); a1 = bf2f(zp[lane + 64]); }
            else { const float* bp = pbuf + (size_t)(15 + idx) * 512; a0 = bp[lane]; a1 = bp[lane + 64]; } }
        if (o == 0) { u0 = a0; u1 = a1; }
        s0 += a0; s1 += a1;
    }
    const float cnt = smp ? (float)w : (float)((t + 1) < w ? (t + 1) : w);
    ds[lane] = s0 / cnt - u0; ds[lane + 64] = s1 / cnt - u1;
    LDS_WAIT(); asm volatile("" ::: "memory");
    const float* wp = A.in[F.zo + I_WPOOL] + ((size_t)(l * 4 + gi) * 128) * 128;
    float y0 = 0.f, y1 = 0.f;
#pragma unroll 16
    for (int c = 0; c < 128; ++c) { const float dv = ds[c]; y0 += dv * wp[c * 128 + lane]; y1 += dv * wp[c * 128 + lane + 64]; }
    const float* psc = A.in[F.zo + I_PSCALE] + l * 512 + gi * 128;
    bf16* mp = F.MIX() + (size_t)r * DM + 512 + gi * 128;
    mp[lane] = (bf16)f2bf(y0 * psc[lane]); mp[lane + 64] = (bf16)f2bf(y1 * psc[lane + 64]);
    LDS_WAIT(); asm volatile("" ::: "memory");
}
__device__ __forceinline__ void cache_outputs(Frame& F, const Args& A, int l) {
    const int gt = (F.vcu * NWAVES + F.wave) * 64 + F.lane_id(), NGT = F.G * NWAVES * 64;
#pragma unroll 4
    for (int i = gt; i < 4 * 128 * 128; i += NGT) { const int b = i >> 14, j = (i >> 7) & 127, c = i & 127; const bf16* zr = F.Z() + (size_t)(b * 2048 + 1920 + j) * ZW;
        F.out[O_WK_P + (size_t)l * 65536 + i] = bf2f(zr[ZK + c]); F.out[O_WV_P + (size_t)l * 65536 + i] = bf2f(zr[ZV + c]); }
#pragma unroll 4
    for (int i = gt; i < 4 * 15 * 512; i += NGT) { const int b = i / 7680, rem = i - b * 7680, j = rem >> 9, c = rem & 511;
        F.out[O_POOL_P + (size_t)l * 30720 + i] = bf2f(F.Z()[(size_t)(b * 2048 + 2033 + j) * ZW + ZU + c]); }
#pragma unroll 4
    for (int i = gt; i < 32 * 128 * 128; i += NGT) { const int sb = i >> 14, p = (i >> 7) & 127, c = i & 127; float kv, vv;
        if (p < 124) { const size_t src = ((size_t)(l * 32 + sb) * 128 + p + 4) * 128 + c; kv = A.in[F.zo + I_CK][src]; vv = A.in[F.zo + I_CV][src]; }
        else { const bf16* zr = F.Z() + (size_t)(NP_ROWS + sb * 4 + p - 124) * ZW; kv = bf2f(zr[ZK + c]); vv = bf2f(zr[ZV + c]); }
        F.out[O_WK_S + (size_t)l * 524288 + i] = kv; F.out[O_WV_S + (size_t)l * 524288 + i] = vv; }
#pragma unroll 4
    for (int i = gt; i < 32 * 15 * 512; i += NGT) { const int sb = i / 7680, rem = i - sb * 7680, j = rem >> 9, c = rem & 511; float v;
        if (j < 11) v = A.in[F.zo + I_SPOOL][((size_t)(l * 32 + sb) * 15 + j + 4) * 512 + c];
        else v = bf2f(F.Z()[(size_t)(NP_ROWS + sb * 4 + j - 11) * ZW + ZU + c]);
        F.out[O_POOL_S + (size_t)l * 245760 + i] = v; }
}
__device__ __forceinline__ void gla_out_item(Frame& F, const Args& A, int l, int r, int hh) {
    const int lane = F.lane_id();
    const f32x4 o = *(const f32x4*)(F.OGLA() + (size_t)r * 1024 + hh * 256 + 4 * lane);
    const float ss = wave_sum((o.x * o.x + o.y * o.y) + (o.z * o.z + o.w * o.w));
    const float rstd = 1.0f / sqrtf(ss * (1.0f / 256.0f) + EPS);
    const f32x4 gv = *(const f32x4*)(A.in[F.zo + I_GGLA] + l * 1024 + hh * 256 + 4 * lane);
    const uint2 gw = *(const uint2*)(F.Z() + (size_t)r * ZW + GG + hh * 256 + 4 * lane);
    const float g0 = bflo(gw.x), g1 = bfhi(gw.x), g2 = bflo(gw.y), g3 = bfhi(gw.y);
    const float y0 = o.x * rstd * gv.x * (g0 / (1.0f + __expf(-g0))), y1 = o.y * rstd * gv.y * (g1 / (1.0f + __expf(-g1)));
    const float y2 = o.z * rstd * gv.z * (g2 / (1.0f + __expf(-g2))), y3 = o.w * rstd * gv.w * (g3 / (1.0f + __expf(-g3)));
    uint2 w; w.x = pk2(y0, y1); w.y = pk2(y2, y3);
    *(uint2*)(F.MIX() + (size_t)r * DM + 1024 + hh * 256 + 4 * lane) = w;
}
typedef unsigned u32x2 __attribute__((ext_vector_type(2)));
__device__ __forceinline__ u32x2 pack4bf(const f32x4 v) { u32x2 w; w.x = pk2(v.x, v.y); w.y = pk2(v.z, v.w); return w; }
constexpr int GL_QD = 0, GL_KD = 17408, GL_VT = 34816, GL_AM = 71680, GL_BS = 80896, GL_GS = 82944, GL_END = 87040;
static_assert(GL_END <= RING_BYTES, "GLA LDS map");
constexpr int GL_NSLOT = 640;
__device__ __forceinline__ void gla_prep_unit(Frame& F, const Args& A, int l, int slot) {
    const int lane = F.lane_id(), wave = F.wave, tid = wave * 64 + lane, fr = lane & 15, fq = lane >> 4;
    const bool smp = slot >= 512; const int hh = slot & 3;
    const int row0 = smp ? (NP_ROWS + ((slot - 512) >> 2) * 4) : ((slot >> 7) * 2048 + ((slot >> 2) & 31) * 64), nvalid = smp ? 4 : 64;
    const int d = tid & 127, qtr = tid >> 7, cg = hh * 128 + d;
    LAS bf16* QD = (LAS bf16*)(F.lds + GL_QD); LAS bf16* KD = (LAS bf16*)(F.lds + GL_KD); LAS bf16* VT = (LAS bf16*)(F.lds + GL_VT); LAS bf16* AM = (LAS bf16*)(F.lds + GL_AM);
    LAS float* BS = (LAS float*)(F.lds + GL_BS); LAS float* GS = (LAS float*)(F.lds + GL_GS);
    const bf16* Z = F.Z();
    unsigned short qraw[16], kraw[16], vraw[32];
    { const bf16* zq = Z + (size_t)(row0 + 16 * qtr) * ZW + GQ + cg; const bf16* zk = zq + (GK - GQ);
#pragma unroll
      for (int i = 0; i < 16; ++i) { qraw[i] = 0; kraw[i] = 0; if (16 * qtr + i < nvalid) { qraw[i] = zq[(size_t)i * ZW]; kraw[i] = zk[(size_t)i * ZW]; } }
      const int e = tid & 255, hf = tid >> 8; const bf16* vp = Z + (size_t)(row0 + 32 * hf) * ZW + GV + hh * 256 + e;
#pragma unroll
      for (int i = 0; i < 32; ++i) { vraw[i] = 0; if (32 * hf + i < nvalid) vraw[i] = vp[(size_t)i * ZW]; } }
    { const int t = tid >> 3, j0 = (tid & 7) * 2; float g0 = 0.f, g1 = 0.f;
      if (t < nvalid) { const unsigned w = *(const unsigned*)(Z + (size_t)(row0 + t) * ZW + GA + j0); g0 = bflo(w); g1 = bfhi(w); }
      GS[t * 16 + j0] = g0; GS[t * 16 + j0 + 1] = g1; }
    float wa[16];
    { const float* wp = A.in[F.zo + I_WA2] + (size_t)l * 16 * 512 + cg;
#pragma unroll
      for (int j = 0; j < 16; ++j) wa[j] = wp[j * 512]; }
    const float ba = A.in[F.zo + I_BA2][l * 512 + cg];
    __syncthreads();
    float bl[16]; float run = 0.f;
#pragma unroll
    for (int i = 0; i < 16; ++i) { const int t = 16 * qtr + i; const LAS f32x4* gp = (const LAS f32x4*)(GS + t * 16); const f32x4 g0 = gp[0], g1 = gp[1], g2 = gp[2], g3 = gp[3];
        float x = ba + g0.x * wa[0] + g0.y * wa[1] + g0.z * wa[2] + g0.w * wa[3] + g1.x * wa[4] + g1.y * wa[5] + g1.z * wa[6] + g1.w * wa[7];
        x += g2.x * wa[8] + g2.y * wa[9] + g2.z * wa[10] + g2.w * wa[11] + g3.x * wa[12] + g3.y * wa[13] + g3.z * wa[14] + g3.w * wa[15];
        float la = (fminf(x, 0.f) - __logf(1.0f + __expf(-fabsf(x)))) * (1.0f / 16.0f);
        if (t >= nvalid) la = 0.f;
        run += la; bl[i] = run; }
    BS[qtr * 128 + d] = run;
    __syncthreads();
    float pre = 0.f, tot = 0.f;
#pragma unroll
    for (int q2 = 0; q2 < 4; ++q2) { const float v = BS[q2 * 128 + d]; tot += v; if (q2 < qtr) pre += v; }
    { bf16* qg = F.QDG() + (size_t)(row0 + 16 * qtr) * 512 + cg;
      unsigned kt[8];
#pragma unroll
      for (int i = 0; i < 16; ++i) { const int t = 16 * qtr + i; const float b = pre + bl[i]; float qv = 0.f, kv = 0.f;
          qv = bf2f(qraw[i]); kv = bf2f(kraw[i]);
          const unsigned qd = f2bf(qv * __expf(b) * 0.08838834764831845f), kd = f2bf(kv * __expf(-b)), kdt = f2bf(kv * __expf(tot - b));
          QD[t * 136 + d] = (bf16)qd; KD[t * 136 + d] = (bf16)kd;
          if (t < nvalid) qg[(size_t)i * 512] = (bf16)qd;
          if (i & 1) kt[i >> 1] |= kdt << 16; else kt[i >> 1] = kdt; }
      v4u* kg = (v4u*)(F.KDTG() + ((size_t)slot * 128 + d) * 64 + 16 * qtr);
      kg[0] = (v4u){kt[0], kt[1], kt[2], kt[3]}; kg[1] = (v4u){kt[4], kt[5], kt[6], kt[7]};
      if (qtr == 0) F.DLG()[slot * 128 + d] = __expf(tot); }
    { const int e = tid & 255, hf = tid >> 8;
      unsigned vw[16];
#pragma unroll
      for (int i = 0; i < 32; ++i) { const unsigned x = vraw[i];
          if (i & 1) vw[i >> 1] |= x << 16; else vw[i >> 1] = x; }
      LAS v4u* vl = (LAS v4u*)(VT + e * 72 + 32 * hf); v4u* vg = (v4u*)(F.VTG() + ((size_t)slot * 256 + e) * 64 + 32 * hf);
#pragma unroll
      for (int k = 0; k < 4; ++k) { const v4u w = {vw[4 * k], vw[4 * k + 1], vw[4 * k + 2], vw[4 * k + 3]}; vl[k] = w; vg[k] = w; } }
    __syncthreads();
#pragma unroll
    for (int bi = 0; bi < 2; ++bi) { const int blk = 2 * wave + bi, tb = blk >> 2, sbk = blk & 3;
        f32x4 acc = {0.f, 0.f, 0.f, 0.f};
        if (sbk <= tb) {
#pragma unroll
            for (int ks = 0; ks < 4; ++ks) { const bf16x8 a = *(const LAS bf16x8*)(KD + (sbk * 16 + fr) * 136 + ks * 32 + fq * 8), b = *(const LAS bf16x8*)(QD + (tb * 16 + fr) * 136 + ks * 32 + fq * 8);
                acc = __builtin_amdgcn_mfma_f32_16x16x32_bf16(a, b, acc, 0, 0, 0); } }
        const int t = tb * 16 + fr, s0 = sbk * 16 + 4 * fq;
        f32x4 m; m.x = (s0 + 0 <= t) ? acc.x : 0.f; m.y = (s0 + 1 <= t) ? acc.y : 0.f; m.z = (s0 + 2 <= t) ? acc.z : 0.f; m.w = (s0 + 3 <= t) ? acc.w : 0.f;
        *(LAS u32x2*)(AM + t * 72 + s0) = pack4bf(m); }
    __syncthreads();
#pragma unroll
    for (int ei = 0; ei < 2; ++ei) { const int eb = 2 * wave + ei;
        const bf16x8 a0 = *(const LAS bf16x8*)(VT + (eb * 16 + fr) * 72 + fq * 8), a1 = *(const LAS bf16x8*)(VT + (eb * 16 + fr) * 72 + 32 + fq * 8);
#pragma unroll
        for (int tb = 0; tb < 4; ++tb) { f32x4 o = {0.f, 0.f, 0.f, 0.f};
            o = __builtin_amdgcn_mfma_f32_16x16x32_bf16(a0, *(const LAS bf16x8*)(AM + (tb * 16 + fr) * 72 + fq * 8), o, 0, 0, 0);
            if (tb >= 2) o = __builtin_amdgcn_mfma_f32_16x16x32_bf16(a1, *(const LAS bf16x8*)(AM + (tb * 16 + fr) * 72 + 32 + fq * 8), o, 0, 0, 0);
            const int t = tb * 16 + fr;
            if (t < nvalid) *(f32x4*)(F.OGLA() + (size_t)(row0 + t) * 1024 + hh * 256 + eb * 16 + 4 * fq) = o; } }
    __syncthreads();
}
__device__ __forceinline__ void gla_state_step(Frame& F, int slot, int eb, int fr, int fq, f32x4 (&sacc)[8]) {
    const bf16* vt = F.VTG() + ((size_t)slot * 256 + eb * 16 + fr) * 64 + 8 * fq; const bf16x8 b0 = *(const bf16x8*)vt, b1 = *(const bf16x8*)(vt + 32);
    const bf16* kt = F.KDTG() + ((size_t)slot * 128 + fr) * 64 + 8 * fq; const float* dl = F.DLG() + slot * 128 + 4 * fq;
#pragma unroll
    for (int db = 0; db < 8; ++db) { const f32x4 dv = *(const f32x4*)(dl + db * 16); const bf16x8 a0 = *(const bf16x8*)(kt + (size_t)db * 16 * 64), a1 = *(const bf16x8*)(kt + (size_t)db * 16 * 64 + 32);
        f32x4 s = sacc[db] * dv; s = __builtin_amdgcn_mfma_f32_16x16x32_bf16(a0, b0, s, 0, 0, 0); s = __builtin_amdgcn_mfma_f32_16x16x32_bf16(a1, b1, s, 0, 0, 0); sacc[db] = s; }
}
template <int NTB>
__device__ __forceinline__ void gla_inter_step(Frame& F, int row0, int nvalid, int hh, int eb, int fr, int fq, const f32x4 (&sacc)[8]) {
    u32x2 qlo[NTB][4], qhi[NTB][4]; f32x4 oi[NTB];
#pragma unroll
    for (int tb = 0; tb < NTB; ++tb) { const int t = tb * 16 + fr; const bool ok = t < nvalid;
        const bf16* qp = F.QDG() + (size_t)(row0 + t) * 512 + hh * 128 + 4 * fq; const float* op = F.OGLA() + (size_t)(row0 + t) * 1024 + hh * 256 + eb * 16 + 4 * fq;
        oi[tb] = (f32x4){0.f, 0.f, 0.f, 0.f}; if (ok) oi[tb] = *(const f32x4*)op;
#pragma unroll
        for (int ks = 0; ks < 4; ++ks) { qlo[tb][ks] = (u32x2){0u, 0u}; qhi[tb][ks] = (u32x2){0u, 0u}; if (ok) { qlo[tb][ks] = *(const u32x2*)(qp + 32 * ks); qhi[tb][ks] = *(const u32x2*)(qp + 32 * ks + 16); } } }
    bf16x8 sf[4];
#pragma unroll
    for (int ks = 0; ks < 4; ++ks) { const u32x2 lo = pack4bf(sacc[2 * ks]), hi = pack4bf(sacc[2 * ks + 1]); const v4u w = {lo.x, lo.y, hi.x, hi.y}; sf[ks] = __builtin_bit_cast(bf16x8, w); }
#pragma unroll
    for (int tb = 0; tb < NTB; ++tb) { const int t = tb * 16 + fr; f32x4 o = oi[tb];
#pragma unroll
        for (int ks = 0; ks < 4; ++ks) { const v4u w = {qlo[tb][ks].x, qlo[tb][ks].y, qhi[tb][ks].x, qhi[tb][ks].y}; o = __builtin_amdgcn_mfma_f32_16x16x32_bf16(sf[ks], __builtin_bit_cast(bf16x8, w), o, 0, 0, 0); }
        if (t < nvalid) *(f32x4*)(F.OGLA_ST() + (size_t)(row0 + t) * 1024 + hh * 256 + eb * 16 + 4 * fq) = o; }
}
__device__ __forceinline__ void gla_store_state(float* dst, int fr, int fq, const f32x4 (&sacc)[8]) {
#pragma unroll
    for (int db = 0; db < 8; ++db) { const int d0 = db * 16 + 4 * fq; dst[(size_t)(d0 + 0) * 256 + fr] = sacc[db].x; dst[(size_t)(d0 + 1) * 256 + fr] = sacc[db].y; dst[(size_t)(d0 + 2) * 256 + fr] = sacc[db].z; dst[(size_t)(d0 + 3) * 256 + fr] = sacc[db].w; }
}
__device__ __forceinline__ void gla_phase_g1(Frame& F, const Args& A, int l) {
    const int lane = F.lane_id(), fr = lane & 15, fq = lane >> 4;
    const int gw = F.vcu * NWAVES + F.wave, NGW = F.G * NWAVES;
    for (int it = gw; it < 2048; it += NGW) { const int bh = it >> 7, seg = (it >> 4) & 7, eb = it & 15;
        if (seg == 7) continue;
        f32x4 sacc[8];
#pragma unroll
        for (int db = 0; db < 8; ++db) sacc[db] = (f32x4){0.f, 0.f, 0.f, 0.f};
        const int slot0 = (((bh >> 2) * 32 + seg * 4) * 4) + (bh & 3);
#pragma unroll 1
        for (int c = 0; c < 4; ++c) gla_state_step(F, slot0 + 4 * c, eb, fr, fq, sacc);
        gla_store_state(F.SLOC() + ((size_t)(bh * 8 + seg) * 128) * 256 + eb * 16, fr, fq, sacc);
        if (eb == 0) {
#pragma unroll
            for (int k = 0; k < 2; ++k) { const int d = lane + 64 * k; float p = 1.f; for (int c = 0; c < 4; ++c) p *= F.DLG()[(slot0 + 4 * c) * 128 + d]; F.DSEG()[(bh * 8 + seg) * 128 + d] = p; } }
    }
    for (int it = gw; it < 2048; it += NGW) { const int sbh = it >> 4, eb = it & 15, sb = sbh >> 2, hh = sbh & 3;
        const size_t so = ((size_t)((l * 32 + sb) * 4 + hh)) * 32768 + eb * 16;
        const float* s0 = A.in[F.zo + I_SGLA] + so + fr;
        f32x4 sacc[8];
#pragma unroll
        for (int db = 0; db < 8; ++db) { const int d0 = db * 16 + 4 * fq; sacc[db].x = s0[(size_t)(d0 + 0) * 256]; sacc[db].y = s0[(size_t)(d0 + 1) * 256]; sacc[db].z = s0[(size_t)(d0 + 2) * 256]; sacc[db].w = s0[(size_t)(d0 + 3) * 256]; }
        gla_inter_step<1>(F, NP_ROWS + sb * 4, 4, hh, eb, fr, fq, sacc);
        gla_state_step(F, 512 + sbh, eb, fr, fq, sacc);
        gla_store_state(F.out + O_GLA_S + so, fr, fq, sacc);
    }
}
__device__ __forceinline__ void gla_phase_g2(Frame& F, const Args& A, int l) {
    const int lane = F.lane_id(), fr = lane & 15, fq = lane >> 4;
    const int gw = F.vcu * NWAVES + F.wave, NGW = F.G * NWAVES;
    for (int it = gw; it < 2048; it += NGW) { const int bh = it >> 7, seg = (it >> 4) & 7, eb = it & 15, hh = bh & 3;
        f32x4 sacc[8];
#pragma unroll
        for (int db = 0; db < 8; ++db) sacc[db] = (f32x4){0.f, 0.f, 0.f, 0.f};
        for (int i2 = 0; i2 < seg; ++i2) { const float* sl = F.SLOC() + ((size_t)(bh * 8 + i2) * 128) * 256 + eb * 16 + fr; const float* dg = F.DSEG() + (bh * 8 + i2) * 128;
#pragma unroll
            for (int db = 0; db < 8; ++db) { const int d0 = db * 16 + 4 * fq; const f32x4 dv = *(const f32x4*)(dg + d0);
                sacc[db].x = sacc[db].x * dv.x + sl[(size_t)(d0 + 0) * 256]; sacc[db].y = sacc[db].y * dv.y + sl[(size_t)(d0 + 1) * 256]; sacc[db].z = sacc[db].z * dv.z + sl[(size_t)(d0 + 2) * 256]; sacc[db].w = sacc[db].w * dv.w + sl[(size_t)(d0 + 3) * 256]; } }
        const int slot0 = (((bh >> 2) * 32 + seg * 4) * 4) + hh, row0 = (bh >> 2) * 2048 + seg * 256;
#pragma unroll 1
        for (int c = 0; c < 4; ++c) { gla_inter_step<4>(F, row0 + c * 64, 64, hh, eb, fr, fq, sacc); gla_state_step(F, slot0 + 4 * c, eb, fr, fq, sacc); }
        if (seg == 7) gla_store_state(F.out + O_GLA_P + ((size_t)(l * 16 + bh)) * 32768 + eb * 16, fr, fq, sacc);
    }
}
constexpr int AT_VT = 0, AT_VTS = 184, AT_BT = 64 * AT_VTS * 2, AT_END = AT_BT + 4 * 128 * 4;
__device__ __forceinline__ void attn_unit_mfma(Frame& F, const Args& A, int l, int u) {
    const int lane = F.lane_id(), wave = F.wave, tid = wave * 64 + lane, fr = lane & 15, fq = lane >> 4;
    const int span = u >> 1, g = u & 1, t0g = span * 32, tb0 = t0g & 2047;
    LAS bf16* VT = (LAS bf16*)(F.lds + AT_VT); LAS float* BT = (LAS float*)(F.lds + AT_BT);
    const bf16* Z = F.Z();
    const int rb = wave >> 2, hl = wave & 3, hd = g * 4 + hl, t0w = t0g + 16 * rb;
    bf16x8 qf[2], kf[9][2];
    { const bf16* qp = Z + (size_t)(t0w + fr) * ZW + ZQ + hd * 64 + 8 * fq; qf[0] = *(const bf16x8*)qp; qf[1] = *(const bf16x8*)(qp + 32); }
#pragma unroll
    for (int kb = 0; kb < 9; ++kb) { const int kl = 16 * (rb + kb) + fr; kf[kb][0] = (bf16x8){0, 0, 0, 0, 0, 0, 0, 0}; kf[kb][1] = (bf16x8){0, 0, 0, 0, 0, 0, 0, 0};
        if (tb0 - 128 + kl >= 0) { const bf16* kp = Z + (size_t)(t0g - 128 + kl) * ZW + ZK + g * 64 + 8 * fq; kf[kb][0] = *(const bf16x8*)kp; kf[kb][1] = *(const bf16x8*)(kp + 32); } }
#pragma unroll
    for (int pass = 0; pass < 2; ++pass) { const int key = pass * 128 + (tid >> 2), dch = (tid & 3) * 16;
        if (key < 160) { v4u v0 = {0u, 0u, 0u, 0u}, v1 = {0u, 0u, 0u, 0u};
            if (tb0 - 128 + key >= 0) { const v4u* vp = (const v4u*)(Z + (size_t)(t0g - 128 + key) * ZW + ZV + g * 64 + dch); v0 = vp[0]; v1 = vp[1]; }
            LAS bf16* vt = VT + dch * AT_VTS + key;
            vt[0 * AT_VTS] = (bf16)(v0.x & 0xffffu); vt[1 * AT_VTS] = (bf16)(v0.x >> 16); vt[2 * AT_VTS] = (bf16)(v0.y & 0xffffu); vt[3 * AT_VTS] = (bf16)(v0.y >> 16);
            vt[4 * AT_VTS] = (bf16)(v0.z & 0xffffu); vt[5 * AT_VTS] = (bf16)(v0.z >> 16); vt[6 * AT_VTS] = (bf16)(v0.w & 0xffffu); vt[7 * AT_VTS] = (bf16)(v0.w >> 16);
            vt[8 * AT_VTS] = (bf16)(v1.x & 0xffffu); vt[9 * AT_VTS] = (bf16)(v1.x >> 16); vt[10 * AT_VTS] = (bf16)(v1.y & 0xffffu); vt[11 * AT_VTS] = (bf16)(v1.y >> 16);
            vt[12 * AT_VTS] = (bf16)(v1.z & 0xffffu); vt[13 * AT_VTS] = (bf16)(v1.z >> 16); vt[14 * AT_VTS] = (bf16)(v1.w & 0xffffu); vt[15 * AT_VTS] = (bf16)(v1.w >> 16); } }
    BT[tid] = F.BTAB()[(g * 4) * 128 + tid];
    __syncthreads();
    f32x4 sacc[9];
#pragma unroll
    for (int kb = 0; kb < 9; ++kb) {
        f32x4 acc = {0.f, 0.f, 0.f, 0.f};
        acc = __builtin_amdgcn_mfma_f32_16x16x32_bf16(kf[kb][0], qf[0], acc, 0, 0, 0); acc = __builtin_amdgcn_mfma_f32_16x16x32_bf16(kf[kb][1], qf[1], acc, 0, 0, 0);
        sacc[kb] = acc; }
    const float sink = A.in[F.zo + I_SINKS][l * 8 + hd];
    float mx = -INFINITY;
#pragma unroll
    for (int kb = 0; kb < 9; ++kb)
#pragma unroll
        for (int i = 0; i < 4; ++i) { const int dist = 128 - 16 * kb + fr - 4 * fq - i, kpos = tb0 + 16 * rb + fr - dist;
            const bool valid = (dist >= 0) && (dist < 128) && (kpos >= 0);
            const float s = valid ? sacc[kb][i] * 0.125f + BT[hl * 128 + (dist & 127)] : -INFINITY;
            sacc[kb][i] = s; mx = fmaxf(mx, s); }
    mx = fmaxf(mx, __shfl_xor(mx, 16)); mx = fmaxf(mx, __shfl_xor(mx, 32)); mx = fmaxf(mx, sink);
    float ls = 0.f;
#pragma unroll
    for (int kb = 0; kb < 9; ++kb)
#pragma unroll
        for (int i = 0; i < 4; ++i) { const float p = __expf(sacc[kb][i] - mx); sacc[kb][i] = p; ls += p; }
    ls += __shfl_xor(ls, 16); ls += __shfl_xor(ls, 32);
    const float rden = 1.0f / (ls + __expf(sink - mx));
    bf16x8 pf[5];
#pragma unroll
    for (int pp = 0; pp < 5; ++pp) { const f32x4 a = sacc[2 * pp], b = (2 * pp + 1 < 9) ? sacc[2 * pp + 1] : (f32x4){0.f, 0.f, 0.f, 0.f};
        const unsigned w0 = pk2(a.x, a.y), w1 = pk2(a.z, a.w), w2 = pk2(b.x, b.y), w3 = pk2(b.z, b.w);
        v4u w = {w0, w1, w2, w3}; pf[pp] = __builtin_bit_cast(bf16x8, w); }
#pragma unroll
    for (int db = 0; db < 4; ++db) { f32x4 o = {0.f, 0.f, 0.f, 0.f};
#pragma unroll
        for (int pp = 0; pp < 5; ++pp) { const LAS bf16* vr = VT + (db * 16 + fr) * AT_VTS + 16 * (rb + 2 * pp) + 4 * fq;
            const u32x2 lo = *(const LAS u32x2*)vr; u32x2 hi = {0u, 0u}; if (2 * pp + 1 < 9) hi = *(const LAS u32x2*)(vr + 16);
            v4u w = {lo.x, lo.y, hi.x, hi.y};
            o = __builtin_amdgcn_mfma_f32_16x16x32_bf16(__builtin_bit_cast(bf16x8, w), pf[pp], o, 0, 0, 0); }
        *(u32x2*)(F.MIX() + (size_t)(t0w + fr) * DM + hd * 64 + db * 16 + 4 * fq) = pack4bf(o * rden); }
    __syncthreads();
}
template <int W>
__device__ __forceinline__ void pool_item_body(Frame& F, const Args& A, int l, int rblk, int g) {
    const int lane = F.lane_id(), fr = lane & 15, fq = lane >> 4;
    const int t = rblk * 16 + fr, pos = t & 2047;
    const bf16* Z = F.Z();
    const int nwin = (pos + 1) < W ? (pos + 1) : W; const float rc = 1.0f / (float)nwin;
    const bf16* wt = F.WPT() + ((size_t)(l * 4 + g) * 128) * 128; const float* psc = A.in[F.zo + I_PSCALE] + l * 512 + g * 128;
    f32x4 acc[8];
#pragma unroll
    for (int nb = 0; nb < 8; ++nb) acc[nb] = (f32x4){0.f, 0.f, 0.f, 0.f};
#pragma unroll 1
    for (int ks = 0; ks < 4; ++ks) { const bf16* up = Z + (size_t)t * ZW + ZU + g * 128 + ks * 32 + 8 * fq;
        v4u x[W];
#pragma unroll
        for (int i = 0; i < W; ++i) { x[i] = (v4u){0u, 0u, 0u, 0u}; if (i < nwin) x[i] = *(const v4u*)(up - (size_t)i * ZW); }
        float s[8];
#pragma unroll
        for (int j = 0; j < 8; ++j) s[j] = 0.f;
#pragma unroll
        for (int i = 0; i < W; ++i) { s[0] += bflo(x[i].x); s[1] += bfhi(x[i].x); s[2] += bflo(x[i].y); s[3] += bfhi(x[i].y); s[4] += bflo(x[i].z); s[5] += bfhi(x[i].z); s[6] += bflo(x[i].w); s[7] += bfhi(x[i].w); }
        const v4u u0 = x[0];
        v4u wv; wv.x = pk2(s[0] * rc - bflo(u0.x), s[1] * rc - bfhi(u0.x)); wv.y = pk2(s[2] * rc - bflo(u0.y), s[3] * rc - bfhi(u0.y)); wv.z = pk2(s[4] * rc - bflo(u0.z), s[5] * rc - bfhi(u0.z)); wv.w = pk2(s[6] * rc - bflo(u0.w), s[7] * rc - bfhi(u0.w));
        const bf16x8 df = __builtin_bit_cast(bf16x8, wv);
#pragma unroll
        for (int nb = 0; nb < 8; ++nb) { const bf16x8 a = *(const bf16x8*)(wt + (size_t)(nb * 16 + fr) * 128 + ks * 32 + 8 * fq); acc[nb] = __builtin_amdgcn_mfma_f32_16x16x32_bf16(a, df, acc[nb], 0, 0, 0); } }
#pragma unroll
    for (int nb = 0; nb < 8; ++nb) { const f32x4 sc = *(const f32x4*)(psc + nb * 16 + 4 * fq);
        *(u32x2*)(F.MIX() + (size_t)t * DM + 512 + g * 128 + nb * 16 + 4 * fq) = pack4bf(acc[nb] * sc); }
}
__device__ __forceinline__ void pool_item_mfma(Frame& F, const Args& A, int l, int rblk, int g) {
    if (g == 0) pool_item_body<2>(F, A, l, rblk, g); else if (g == 1) pool_item_body<4>(F, A, l, rblk, g); else if (g == 2) pool_item_body<8>(F, A, l, rblk, g); else pool_item_body<16>(F, A, l, rblk, g);
}
__device__ __forceinline__ void skinny_resid(Frame& F, const bf16* Asmp, const bf16* Bt, int K, const float* gate) {
    const int lane = F.lane_id(), wave = F.wave, fr = lane & 15, fq = lane >> 4;
    LAS float* red = (LAS float*)(F.lds + RING_OFF);
    const int kw = K >> 3, ksteps = kw >> 5;
    for (int u = F.vcu; u < 256; u += F.G) {
        const int c0 = (u >> 1) * 16, r0 = (u & 1) * 64;
        const bf16* bp = Bt + (size_t)(c0 + fr) * K + wave * kw + 8 * fq;
        const bf16* ap = Asmp + (size_t)(r0 + fr) * K + wave * kw + 8 * fq;
        f32x4 acc[4];
#pragma unroll
        for (int rb = 0; rb < 4; ++rb) acc[rb] = (f32x4){0.f, 0.f, 0.f, 0.f};
        bf16x8 bc = *(const bf16x8*)bp, ac[4];
#pragma unroll
        for (int rb = 0; rb < 4; ++rb) ac[rb] = *(const bf16x8*)(ap + (size_t)rb * 16 * K);
        for (int ks = 0; ks < ksteps; ++ks) {
            bf16x8 bn = bc, an[4];
#pragma unroll
            for (int rb = 0; rb < 4; ++rb) an[rb] = ac[rb];
            if (ks + 1 < ksteps) { bn = *(const bf16x8*)(bp + (ks + 1) * 32);
#pragma unroll
                for (int rb = 0; rb < 4; ++rb) an[rb] = *(const bf16x8*)(ap + (size_t)rb * 16 * K + (ks + 1) * 32); }
#pragma unroll
            for (int rb = 0; rb < 4; ++rb) acc[rb] = __builtin_amdgcn_mfma_f32_16x16x32_bf16(bc, ac[rb], acc[rb], 0, 0, 0);
            bc = bn;
#pragma unroll
            for (int rb = 0; rb < 4; ++rb) ac[rb] = an[rb];
        }
#pragma unroll
        for (int rb = 0; rb < 4; ++rb) *(LAS f32x4*)(red + ((wave * 4 + rb) * 64 + lane) * 4) = acc[rb];
        __syncthreads();
        if (wave < 4) { f32x4 s = {0.f, 0.f, 0.f, 0.f};
#pragma unroll
            for (int w2 = 0; w2 < 8; ++w2) s = s + *(const LAS f32x4*)(red + ((w2 * 4 + wave) * 64 + lane) * 4);
            const int r = r0 + wave * 16 + fr;
            const f32x4 g = *(const f32x4*)(gate + (size_t)(4 + (r >> 2)) * MODLD + c0 + 4 * fq);
            const size_t xo = (size_t)(NP_ROWS + r) * DM + c0 + 4 * fq; f32x4 xv = *(const f32x4*)(F.X() + xo); xv = xv + g * s; *(f32x4*)(F.X_ST() + xo) = xv; }
        __syncthreads();
    }
}

#ifndef EN_P0
#define EN_P0 1
#endif
#ifndef EN_G
#define EN_G 1
#endif
#ifndef EN_N
#define EN_N 1
#endif
#ifndef EN_M2
#define EN_M2 1
#endif
#ifndef EN_M3
#define EN_M3 1
#endif
#ifndef EN_M4
#define EN_M4 1
#endif
#ifndef EN_G1
#define EN_G1 1
#endif
#ifndef EN_GIN
#define EN_GIN 1
#endif
#ifndef EN_GOUT
#define EN_GOUT 1
#endif
#ifndef EN_GGU
#define EN_GGU 1
#endif
#ifndef EN_GDN
#define EN_GDN 1
#endif
#ifndef PROBE_DUP
#define PROBE_DUP 0
#endif
#ifndef MK_SINGLE
#define MK_SINGLE 1
#endif

#define PH_ARGS unsigned ldsb_, unsigned wslo_, unsigned wshi_, unsigned olo_, unsigned ohi_, int wave_, int vcu_, int G_, int probe_, int l_
#define PH_PASS ldsb, wslo, wshi, olo, ohi, F.wave, F.vcu, F.G, F.probe
#define PH_FRAME() Frame F; { const unsigned a0 = __builtin_amdgcn_readfirstlane(ldsb_), a1 = __builtin_amdgcn_readfirstlane(wslo_), a2 = __builtin_amdgcn_readfirstlane(wshi_), a3 = __builtin_amdgcn_readfirstlane(olo_), a4 = __builtin_amdgcn_readfirstlane(ohi_); \
    F.lds = (LAS unsigned char*)(unsigned long long)a0; F.MISC = (volatile LAS unsigned*)(F.lds + MISC_OFF); F.ws = (unsigned char*)(((unsigned long long)a2 << 32) | a1); F.out = (float*)(((unsigned long long)a4 << 32) | a3); \
    F.wave = __builtin_amdgcn_readfirstlane(wave_); F.vcu = __builtin_amdgcn_readfirstlane(vcu_); F.G = __builtin_amdgcn_readfirstlane(G_); F.zo = 0; F.probe = __builtin_amdgcn_readfirstlane(probe_); } \
    const int l = __builtin_amdgcn_readfirstlane(l_); (void)l; \
    const Args& args = *(const Args*)__builtin_amdgcn_kernarg_segment_ptr();
__device__ __forceinline__ void ph_prologue(PH_ARGS) { PH_FRAME(); p0_prologue(F, args); }
__device__ __forceinline__ void ph_norm1(PH_ARGS) { PH_FRAME(); norm_mod_rows(F, args.in[I_GMIX] + l * DM, F.MOD() + (size_t)l * MODW); }
__device__ __forceinline__ void ph_norm2(PH_ARGS) { PH_FRAME(); norm_mod_rows(F, args.in[I_GFFN] + l * DM, F.MOD() + (size_t)l * MODW + 6144); }
__device__ __forceinline__ void ph_final(PH_ARGS) { PH_FRAME(); final_norm_rows(F, args); }
__device__ __forceinline__ void ph_mixa(PH_ARGS) { PH_FRAME();
    const int gw = F.vcu * NWAVES + F.wave, NGW = F.G * NWAVES; LAS float* wscr = (LAS float*)(F.lds + RING_OFF + F.wave * 16384);
    for (int u = F.vcu; u < GL_NSLOT; u += F.G) gla_prep_unit(F, args, l, u);
    for (int u = F.vcu; u < 512; u += F.G) attn_unit_mfma(F, args, l, u);
    for (int it = gw; it < 512 * 4; it += NGW) pool_item_mfma(F, args, l, it >> 2, it & 3);
    { const int gwr = (F.G - 1 - F.vcu) + F.G * F.wave;
      for (int it = gwr; it < NS_ROWS * 8; it += NGW) attn_item(F, args, l, NP_ROWS + (it >> 3), it & 7, wscr);
      for (int it = gwr - 4 * F.G; it < NS_ROWS * 4; it += NGW) if (it >= 0) pool_item(F, args, l, NP_ROWS + (it >> 2), it & 3, wscr); }
    cache_outputs(F, args, l);
}
__device__ __forceinline__ void ph_gla1(PH_ARGS) { PH_FRAME(); gla_phase_g1(F, args, l); }
__device__ __forceinline__ void ph_gla2(PH_ARGS) { PH_FRAME(); gla_phase_g2(F, args, l); }
__device__ __forceinline__ void ph_mixc(PH_ARGS) { PH_FRAME(); const int gw = F.vcu * NWAVES + F.wave, NGW = F.G * NWAVES;
#pragma unroll 4
    for (int it = gw; it < NROWS * 4; it += NGW) gla_out_item(F, args, l, it >> 2, it & 3); }
constexpr int PH_PER_LAYER = 10, PH_LAYER0 = 2, PH_FINAL = PH_LAYER0 + DEPTH * PH_PER_LAYER, PH_COUNT = PH_FINAL + 1;
__global__ void __launch_bounds__(NTHREADS, 2) hymba_fwd(Args args) {
    extern __shared__ __attribute__((aligned(16))) unsigned char lds[];
    Frame F;
    F.lds = (LAS unsigned char*)lds;
    F.MISC = (volatile LAS unsigned*)(F.lds + MISC_OFF);
    F.wave = __builtin_amdgcn_readfirstlane((int)threadIdx.x >> 6); F.zo = 0; F.probe = 0;
    F.G = gridDim.x; { const int bx = blockIdx.x; F.vcu = (F.G % 8 == 0) ? (bx % 8) * (F.G / 8) + bx / 8 : bx; }
    F.ws = args.ws; F.out = args.out;
    gu32* const ctl = (gu32*)(F.ws + WS_CTL);
    for (int u = threadIdx.x; u < (LDS_BYTES - LDSCTL_OFF) / 4; u += NTHREADS) ((LAS unsigned*)(F.lds + LDSCTL_OFF))[u] = 0u;
    __syncthreads();
#if MK_SINGLE
    XcdBarrier bar = xcd_barrier_post((unsigned*)(ctl + CW_BAR), F.MISC + 8);
#define GRID_BAR() xcd_barrier(bar)
#else
#define GRID_BAR() do { } while (0)
#endif
    const int lo = args.ph_lo, hi = args.ph_hi;
    const unsigned ldsb = (unsigned)(unsigned long long)F.lds, wslo = (unsigned)(unsigned long long)F.ws, wshi = (unsigned)((unsigned long long)F.ws >> 32), olo = (unsigned)(unsigned long long)F.out, ohi = (unsigned)((unsigned long long)F.out >> 32);
#define IN(k) (lo <= (k) && (k) < hi)
#define BOTH(k) (IN(k) && IN((k) + 1))
#define PHASE_BEGIN() asm volatile("s_mov_b32 %0, 0" : "=s"(F.zo), "+s"(F.G), "+s"(F.vcu), "+s"(F.wave))
#define gw (F.vcu * NWAVES + F.wave)
#define NGW (F.G * NWAVES)
#define wscr ((LAS float*)(F.lds + RING_OFF + F.wave * 16384))

    if (EN_P0 && IN(0)) for (int rep_ = 0; rep_ < ((PROBE_DUP & 1) ? 2 : 1); ++rep_) { PHASE_BEGIN(); ph_prologue(PH_PASS, 0); if (BOTH(0)) GRID_BAR(); }
    if (EN_G && EN_G1 && IN(1)) for (int rep_ = 0; rep_ < ((PROBE_DUP & 1) ? 2 : 1); ++rep_) { PHASE_BEGIN();
        pg8::Gemm g{F.SC(), F.Wada_t(), 256, DEPTH * MODW, DM}; pg8::StaticOrder S; S.init(256, DEPTH * MODW, F.G, (int)blockIdx.x);
        pg8::EpiMod E{F.MOD(), args.in[F.zo + I_BADA]};
        pg8::gemm_phase<pg8::EpiMod, pg8::StaticOrder, true, true>(F.lds + RING_OFF, g, S, E, F.wave);
        if (BOTH(1)) GRID_BAR();
    }
    for (int l = 0; l < DEPTH; ++l) {
        const int pb = PH_LAYER0 + l * PH_PER_LAYER;
        const float* modl = F.MOD() + (size_t)l * MODW;
        if (EN_N && IN(pb + 0)) for (int rep_ = 0; rep_ < ((PROBE_DUP & 2) ? 2 : 1); ++rep_) { PHASE_BEGIN(); ph_norm1(PH_PASS, l); if (BOTH(pb + 0)) GRID_BAR(); }
        if (EN_G && EN_GIN && IN(pb + 1)) for (int rep_ = 0; rep_ < ((PROBE_DUP & 4) ? 2 : 1); ++rep_) { PHASE_BEGIN();
            pg8::Gemm g{F.H(), F.Win_t() + (size_t)l * ZW * DM, MPAD, ZW, DM}; pg8::StaticOrder S; S.init(MPAD, ZW, F.G, (int)blockIdx.x);
            pg8::EpiZ E{F.Z(), ZW};
            pg8::gemm_phase<pg8::EpiZ, pg8::StaticOrder, true, true>(F.lds + RING_OFF, g, S, E, F.wave);
            if (BOTH(pb + 1)) GRID_BAR();
        }
        if (EN_M2 && IN(pb + 2)) for (int rep_ = 0; rep_ < ((PROBE_DUP & 8) ? 2 : 1); ++rep_) { PHASE_BEGIN();
            ph_mixa(PH_PASS, l);
            if (BOTH(pb + 2)) GRID_BAR();
        }
        if (EN_M3 && IN(pb + 3)) for (int rep_ = 0; rep_ < ((PROBE_DUP & 16) ? 2 : 1); ++rep_) { PHASE_BEGIN(); F.probe = ((PROBE_DUP & 16) && rep_ == 0) ? 1 : 0; ph_gla1(PH_PASS, l); if (BOTH(pb + 3)) GRID_BAR(); }
        if (EN_M3 && IN(pb + 4)) for (int rep_ = 0; rep_ < ((PROBE_DUP & 32) ? 2 : 1); ++rep_) { PHASE_BEGIN(); F.probe = ((PROBE_DUP & 32) && rep_ == 0) ? 1 : 0;
            ph_gla2(PH_PASS, l);
            if (BOTH(pb + 4)) GRID_BAR();
        }
        if (EN_M4 && IN(pb + 5)) for (int rep_ = 0; rep_ < ((PROBE_DUP & 64) ? 2 : 1); ++rep_) { PHASE_BEGIN(); ph_mixc(PH_PASS, l); if (BOTH(pb + 5)) GRID_BAR(); }
        if (EN_G && EN_GOUT && IN(pb + 6)) for (int rep_ = 0; rep_ < ((PROBE_DUP & 128) ? 2 : 1); ++rep_) { PHASE_BEGIN(); F.probe = ((PROBE_DUP & 128) && rep_ == 0) ? 1 : 0;
            pg8::Gemm g{F.MIX(), F.Wout_t() + (size_t)l * DM * DM, NP_ROWS, DM, DM}; pg8::StaticOrder S; S.init(NP_ROWS, DM, F.G, (int)blockIdx.x);
            pg8::EpiResid E{F.X(), modl + 4096, F.X_ST()};
            pg8::gemm_phase<pg8::EpiResid, pg8::StaticOrder, true, true>(F.lds + RING_OFF, g, S, E, F.wave);
            if ((PROBE_DUP & 512) && !F.probe) { F.probe = 1; skinny_resid(F, F.MIX() + (size_t)NP_ROWS * DM, F.Wout_t() + (size_t)l * DM * DM, DM, modl + 4096); F.probe = 0; }
            skinny_resid(F, F.MIX() + (size_t)NP_ROWS * DM, F.Wout_t() + (size_t)l * DM * DM, DM, modl + 4096);
            if (BOTH(pb + 6)) GRID_BAR();
        }
        if (EN_N && IN(pb + 7)) for (int rep_ = 0; rep_ < ((PROBE_DUP & 2) ? 2 : 1); ++rep_) { PHASE_BEGIN(); ph_norm2(PH_PASS, l); if (BOTH(pb + 7)) GRID_BAR(); }
        if (EN_G && EN_GGU && IN(pb + 8)) for (int rep_ = 0; rep_ < ((PROBE_DUP & 4) ? 2 : 1); ++rep_) { PHASE_BEGIN();
            pg8::Gemm g{F.H(), F.Wgu_t() + (size_t)l * NGU * DM, MPAD, NGU, DM}; pg8::StaticOrder S; S.init(MPAD, NGU, F.G, (int)blockIdx.x);
            pg8::EpiSwiGLU E{F.ACT(), DFF};
            pg8::gemm_phase<pg8::EpiSwiGLU, pg8::StaticOrder, true, true>(F.lds + RING_OFF, g, S, E, F.wave);
            if (BOTH(pb + 8)) GRID_BAR();
        }
        if (EN_G && EN_GDN && IN(pb + 9)) for (int rep_ = 0; rep_ < ((PROBE_DUP & 256) ? 2 : 1); ++rep_) { PHASE_BEGIN(); F.probe = ((PROBE_DUP & 256) && rep_ == 0) ? 1 : 0;
            pg8::Gemm g{F.ACT(), F.Wdn_t() + (size_t)l * DM * DFF, NP_ROWS, DM, DFF}; pg8::StaticOrder S; S.init(NP_ROWS, DM, F.G, (int)blockIdx.x);
            pg8::EpiResid E{F.X(), modl + 10240, F.X_ST()};
            pg8::gemm_phase<pg8::EpiResid, pg8::StaticOrder, true, true>(F.lds + RING_OFF, g, S, E, F.wave);
            if ((PROBE_DUP & 512) && !F.probe) { F.probe = 1; skinny_resid(F, F.ACT() + (size_t)NP_ROWS * DFF, F.Wdn_t() + (size_t)l * DM * DFF, DFF, modl + 10240); F.probe = 0; }
            skinny_resid(F, F.ACT() + (size_t)NP_ROWS * DFF, F.Wdn_t() + (size_t)l * DM * DFF, DFF, modl + 10240);
            if (BOTH(pb + 9)) GRID_BAR();
        }
    }
    if (IN(PH_FINAL)) { PHASE_BEGIN(); ph_final(PH_PASS, 0); }
#ifdef PROBE_SCALE
    GRID_BAR();
    { const size_t offs[11] = {O_Y, 16777216, O_WK_P, O_WV_P, O_POOL_P, O_GLA_P, O_WK_S, O_WV_S, O_POOL_S, O_GLA_S, O_END};
      const size_t gt_ = (size_t)(F.vcu * NWAVES + F.wave) * 64 + F.lane_id(), NGT_ = (size_t)F.G * NWAVES * 64;
      for (int k = 0; k < 10; ++k) { const float sc = 1.0f + 0.05f * (float)(k + 1); for (size_t i = offs[k] + gt_; i < offs[k + 1]; i += NGT_) F.out[i] *= sc; } }
#endif
#undef IN
#undef BOTH
#undef gw
#undef NGW
#undef wscr
}

extern "C" void kernel_launch(void* const* d_in, const int* in_sizes, int n_in, void* d_out, int out_size, void* d_ws, size_t ws_size, hipStream_t stream) {
    static int grid = 0;
    if (grid == 0) {
        if (n_in != 24 || out_size != (int)O_END || ws_size < WS_END) { fprintf(stderr, "kernel_launch: unexpected sizes n_in %d out %d ws %zu\n", n_in, out_size, ws_size); grid = -1; return; }
        int dev = 0, cus = 0;
        if (hipGetDevice(&dev) != hipSuccess || hipDeviceGetAttribute(&cus, hipDeviceAttributeMultiprocessorCount, dev) != hipSuccess) { grid = -1; return; }
        if (hipFuncSetAttribute((const void*)hymba_fwd, hipFuncAttributeMaxDynamicSharedMemorySize, LDS_BYTES) != hipSuccess) { fprintf(stderr, "kernel_launch: hipFuncSetAttribute failed\n"); grid = -1; return; }
        (void)hipGetLastError();
        grid = cus;
    }
    if (grid < 0) return;
    (void)hipMemsetAsync((char*)d_ws + WS_CTL, 0, CTL_ZERO_BYTES, stream);
    Args a{};
    for (int i = 0; i < 24; ++i) a.in[i] = (const float*)d_in[i];
    a.out = (float*)d_out; a.ws = (unsigned char*)d_ws;
#if MK_SINGLE
    a.ph_lo = 0; a.ph_hi = PH_COUNT;
    hipLaunchKernelGGL(hymba_fwd, dim3(grid), dim3(NTHREADS), LDS_BYTES, stream, a);
#else
    for (int p = 0; p < PH_COUNT; ++p) { a.ph_lo = p; a.ph_hi = p + 1; hipLaunchKernelGGL(hymba_fwd, dim3(grid), dim3(NTHREADS), LDS_BYTES, stream, a); }
#endif
}
```

```cpp
#include <hip/hip_runtime.h>
#include <cstdio>
#include <cstdint>
#include <cmath>
namespace pg8 {
#define PG8_LAS __attribute__((address_space(3)))
typedef unsigned short bf16_t;
typedef short bf16x8 __attribute__((ext_vector_type(8)));
typedef float f32x4 __attribute__((ext_vector_type(4)));
typedef unsigned u32x4 __attribute__((ext_vector_type(4)));
constexpr int BM = 256, BK = 64, HALF = 128, HTB = HALF * BK * 2  , STAGE_BYTES = 8 * HTB, NXCD = 8, WGM = 8;

__host__ __device__ __forceinline__ int lds_byte(int r, int c) { const int st = (r >> 4) * 2 + (c >> 5), rr = r & 15, cc = c & 31, ob = rr * 64 + cc * 2; return st * 1024 + (ob ^ (((ob >> 9) & 1) << 5)); }
__host__ __device__ __forceinline__ void stage_rc(int b, int& R, int& C) { const int st = b / 1024, sb = b % 1024, swz = sb ^ (((sb >> 9) & 1) << 5); R = (st >> 1) * 16 + swz / 64; C = (st & 1) * 32 + (swz % 64) / 2; }
__host__ __device__ __forceinline__ int perm32(int rho) { const int n = rho >> 4, i = rho & 15; return 8 * (i >> 2) + 4 * n + (i & 3); }

struct Unit { int pm, pn; };
struct Gemm { const bf16_t* A; const bf16_t* Bt; int M, N, K; };

struct StaticOrder {
    int nM, nN, nwg, G, c;
    __host__ __device__ void init(int M, int N, int G_, int c_) { nM = M / BM; nN = N / BM; nwg = nM * nN; G = G_; c = c_; }
    __host__ __device__ bool next(int i, Unit& u) const {
        const long L = (long)i * G + c; if (L >= nwg) return false;
        int wgid = (int)L; { const int q = nwg / NXCD, r = nwg % NXCD, xcd = wgid % NXCD, off = wgid / NXCD; wgid = (xcd < r ? xcd * (q + 1) : r * (q + 1) + (xcd - r) * q) + off; }
        const int nig = WGM * nN, gid = wgid / nig, fm = gid * WGM, gsz = (nM - fm) < WGM ? (nM - fm) : WGM;
        u.pm = fm + ((wgid % nig) % gsz); u.pn = (wgid % nig) / gsz; return true;
    }
    __device__ __forceinline__ void a_ready(const Unit&) const {}
    __device__ __forceinline__ void done(const Unit&) const {}
};

__device__ __forceinline__ unsigned cvt_pk_bf16(float lo, float hi) { unsigned r; asm volatile("v_cvt_pk_bf16_f32 %0, %1, %2" : "=v"(r) : "v"(lo), "v"(hi)); return r; }
typedef float f32x2 __attribute__((ext_vector_type(2)));
constexpr int MODLD_ = 49152;
__device__ __forceinline__ float fast_sigmoid(float x) { return __builtin_amdgcn_rcpf(1.0f + __expf(-x)); }
struct EpiZ {
    static constexpr bool PERM = true, AFTER_DRAIN = false;
    bf16_t* O; int ldc;
    __device__ __forceinline__ void operator()(const f32x4 (&acc)[2][2][4][2], const Unit& u, int wr, int wc, int fr, int fq) const {
        const int row0 = u.pm * BM + wr * 64 + fr, col0 = u.pn * BM + wc * 32 + 8 * fq;
#pragma unroll
        for (int ai = 0; ai < 2; ++ai)
#pragma unroll
            for (int m = 0; m < 4; ++m) { bf16_t* rowp = O + (size_t)(row0 + ai * HALF + m * 16) * ldc + col0;
#pragma unroll
                for (int bj = 0; bj < 2; ++bj) { const f32x4 v0 = acc[ai][bj][m][0], v1 = acc[ai][bj][m][1];
                    u32x4 w; w.x = cvt_pk_bf16(v0[0], v0[1]); w.y = cvt_pk_bf16(v0[2], v0[3]); w.z = cvt_pk_bf16(v1[0], v1[1]); w.w = cvt_pk_bf16(v1[2], v1[3]);
                    *(u32x4*)(rowp + bj * HALF) = w; } }
    }
};
struct EpiSwiGLU {
    static constexpr bool PERM = true, AFTER_DRAIN = false;
    bf16_t* O; int ldc;
    __device__ __forceinline__ void operator()(const f32x4 (&acc)[2][2][4][2], const Unit& u, int wr, int wc, int fr, int fq) const {
        const int row0 = u.pm * BM + wr * 64 + fr, col0 = u.pn * HALF + wc * 32 + 8 * fq;
#pragma unroll
        for (int ai = 0; ai < 2; ++ai)
#pragma unroll
            for (int m = 0; m < 4; ++m) { bf16_t* rowp = O + (size_t)(row0 + ai * HALF + m * 16) * ldc + col0;
                float r[8];
#pragma unroll
                for (int n = 0; n < 2; ++n)
#pragma unroll
                    for (int i = 0; i < 4; ++i) { const float g = acc[ai][0][m][n][i], up = acc[ai][1][m][n][i]; r[n * 4 + i] = g * fast_sigmoid(g) * up; }
                u32x4 w; w.x = cvt_pk_bf16(r[0], r[1]); w.y = cvt_pk_bf16(r[2], r[3]); w.z = cvt_pk_bf16(r[4], r[5]); w.w = cvt_pk_bf16(r[6], r[7]);
                *(u32x4*)rowp = w; }
    }
};
struct EpiResid {
    static constexpr bool PERM = false, AFTER_DRAIN = false;
    float* X; const float* gate; float* XS;
    __device__ __forceinline__ void operator()(const f32x4 (&acc)[2][2][4][2], const Unit& u, int wr, int wc, int fr, int fq) const {
        const int col0 = u.pn * BM + wc * 32 + 4 * fq;
        if (u.pm < 32) {
            const float* g = gate + (size_t)(u.pm >> 3) * MODLD_ + col0;
            f32x4 gv[2][2];
#pragma unroll
            for (int bj = 0; bj < 2; ++bj)
#pragma unroll
                for (int n = 0; n < 2; ++n) gv[bj][n] = *(const f32x4*)(g + bj * HALF + n * 16);
#pragma unroll
            for (int ai = 0; ai < 2; ++ai)
#pragma unroll
                for (int m = 0; m < 4; ++m) { const size_t xo = (size_t)(u.pm * BM + ai * HALF + wr * 64 + m * 16 + fr) * 2048 + col0; const float* xp = X + xo; float* xs = XS + xo;
#pragma unroll
                    for (int bj = 0; bj < 2; ++bj)
#pragma unroll
                        for (int n = 0; n < 2; ++n) { f32x4 xv = *(const f32x4*)(xp + bj * HALF + n * 16); xv = xv + gv[bj][n] * acc[ai][bj][m][n]; *(f32x4*)(xs + bj * HALF + n * 16) = xv; } }
        } else {
#pragma unroll
            for (int m = 0; m < 4; ++m) { const int rl = wr * 64 + m * 16 + fr;
                const float* g = gate + (size_t)(4 + (rl >> 2)) * MODLD_ + col0; float* xp = X + (size_t)(8192 + rl) * 2048 + col0;
#pragma unroll
                for (int bj = 0; bj < 2; ++bj)
#pragma unroll
                    for (int n = 0; n < 2; ++n) { const f32x4 gvv = *(const f32x4*)(g + bj * HALF + n * 16); f32x4 xv = *(const f32x4*)(xp + bj * HALF + n * 16);
                        xv = xv + gvv * acc[0][bj][m][n]; *(f32x4*)(xp + bj * HALF + n * 16) = xv; } }
        }
    }
};
struct EpiMod {
    static constexpr bool PERM = false, AFTER_DRAIN = false;
    float* M; const float* bias;
    __device__ __forceinline__ void operator()(const f32x4 (&acc)[2][2][4][2], const Unit& u, int wr, int wc, int fr, int fq) const {
        if (wr != 0) return;
        const int col0 = u.pn * BM + wc * 32 + 4 * fq;
#pragma unroll
        for (int m = 0; m < 3; ++m) { const int r = m * 16 + fr;
            if (r < 36) {
#pragma unroll
                for (int bj = 0; bj < 2; ++bj)
#pragma unroll
                    for (int n = 0; n < 2; ++n) { const f32x4 bv = *(const f32x4*)(bias + col0 + bj * HALF + n * 16);
                        *(f32x4*)(M + (size_t)r * MODLD_ + col0 + bj * HALF + n * 16) = acc[0][bj][m][n] + bv; } } }
    }
};

template <class Epi, class Sched, bool ALIGN_EPI = false, bool SP2 = false>
__device__ __forceinline__ void gemm_phase(PG8_LAS unsigned char* lds, const Gemm g, const Sched& S, const Epi& E, int wid_in) {
    int lane_ = (int)__builtin_amdgcn_mbcnt_hi(~0u, __builtin_amdgcn_mbcnt_lo(~0u, 0u)); asm volatile("" : "+v"(lane_));
    const int wid = __builtin_amdgcn_readfirstlane(wid_in), lane = lane_, tid = wid * 64 + lane, wr = wid >> 2, wc = wid & 3, fr = lane & 15, fq = lane >> 4;
    int K_ = g.K; asm volatile("" : "+s"(K_));
    const int K = K_, nt = K / BK;
    unsigned voffA[2], voffB[2];
#pragma unroll
    for (int i = 0; i < 2; ++i) { int R, C; stage_rc(tid * 16 + i * 8192, R, C); const int Rb = Epi::PERM ? ((R & ~31) + perm32(R & 31)) : R;
        voffA[i] = (unsigned)(R * K + C) * 2u; voffB[i] = (unsigned)(Rb * K + C) * 2u; }
    const size_t kstep = (size_t)(BK * 2);
    const size_t hstep = (size_t)HALF * K * 2;
    const size_t tstep = 2 * hstep;
    const unsigned ldsw = (unsigned)wid * 1024u;
    const int aoff = lds_byte(wr * 64 + fr, fq * 8), boff = lds_byte(wc * 32 + fr, fq * 8);
#define PG8_SA(b, h) (((b) * 2 + (h)) * HTB)
#define PG8_SB(b, h) ((4 + (b) * 2 + (h)) * HTB)
#define PG8_STAGE(bufoff, gbase, voff) do { _Pragma("unroll") for (int _i = 0; _i < 2; ++_i) \
        __builtin_amdgcn_global_load_lds((const unsigned*)((const char*)(gbase) + (voff)[_i]), (PG8_LAS unsigned*)(lds + (bufoff) + ldsw + _i * 8192), 16, 0, 0); } while (0)
#define PG8_LDA(dst, b, h) do { _Pragma("unroll") for (int m = 0; m < 4; ++m) _Pragma("unroll") for (int k = 0; k < 2; ++k) dst[m][k] = *(const PG8_LAS bf16x8*)(lds + PG8_SA(b, h) + aoff + m * 2048 + k * 1024); } while (0)
#define PG8_LDB(dst, b, h) do { _Pragma("unroll") for (int n = 0; n < 2; ++n) _Pragma("unroll") for (int k = 0; k < 2; ++k) dst[n][k] = *(const PG8_LAS bf16x8*)(lds + PG8_SB(b, h) + boff + n * 2048 + k * 1024); } while (0)
#define PG8_MMA(ai, bj, At, Bt) do { __builtin_amdgcn_s_setprio(1); _Pragma("unroll") for (int m = 0; m < 4; ++m) _Pragma("unroll") for (int n = 0; n < 2; ++n) _Pragma("unroll") for (int k = 0; k < 2; ++k) \
        acc[ai][bj][m][n] = __builtin_amdgcn_mfma_f32_16x16x32_bf16(Bt[n][k], At[m][k], acc[ai][bj][m][n], 0, 0, 0); __builtin_amdgcn_s_setprio(0); } while (0)
#define PG8_WAIT_V(n) asm volatile("s_waitcnt vmcnt(" #n ")" ::: "memory")
#define PG8_WAIT_L(n) asm volatile("s_waitcnt lgkmcnt(" #n ")" ::: "memory")
#define PG8_BAR __builtin_amdgcn_s_barrier()
#define PG8_SCHED __builtin_amdgcn_sched_barrier(0)
    Unit cur, nxt; int ui = 0;
    if (!S.next(0, cur)) return;
    f32x4 acc[2][2][4][2];
#pragma unroll
    for (int a = 0; a < 2; ++a)
#pragma unroll
        for (int b = 0; b < 2; ++b)
#pragma unroll
            for (int m = 0; m < 4; ++m)
#pragma unroll
                for (int n = 0; n < 2; ++n) acc[a][b][m][n] = (f32x4){0.f, 0.f, 0.f, 0.f};
    bf16x8 At[4][2], B0[2][2], B1[2][2];
    const char* cA = (const char*)g.A + (size_t)cur.pm * tstep; const char* cB = (const char*)g.Bt + (size_t)cur.pn * tstep;
    S.a_ready(cur);
    if constexpr (SP2) {
        PG8_STAGE(PG8_SB(0, 0), cB, voffB); PG8_STAGE(PG8_SB(0, 1), cB + hstep, voffB); PG8_STAGE(PG8_SA(0, 0), cA, voffA); PG8_STAGE(PG8_SA(0, 1), cA + hstep, voffA);
        if (wr == 1) PG8_BAR;
        PG8_WAIT_V(2); PG8_BAR;
        PG8_STAGE(PG8_SB(1, 0), cB + kstep, voffB); PG8_STAGE(PG8_SA(1, 0), cA + kstep, voffA); PG8_STAGE(PG8_SB(1, 1), cB + hstep + kstep, voffB);
        PG8_WAIT_V(6); PG8_BAR;
    } else {
        PG8_STAGE(PG8_SB(0, 0), cB, voffB); PG8_STAGE(PG8_SA(0, 0), cA, voffA); PG8_STAGE(PG8_SB(0, 1), cB + hstep, voffB); PG8_STAGE(PG8_SA(0, 1), cA + hstep, voffA);
        if (wr == 1) PG8_BAR;
        PG8_WAIT_V(4); PG8_BAR;
        PG8_STAGE(PG8_SB(1, 0), cB + kstep, voffB); PG8_STAGE(PG8_SA(1, 0), cA + kstep, voffA); PG8_STAGE(PG8_SB(1, 1), cB + hstep + kstep, voffB);
        PG8_WAIT_V(6); PG8_BAR;
    }
    for (;;) {
        const bool has_next = S.next(ui + 1, nxt);
        const char* nA = has_next ? (const char*)g.A + (size_t)nxt.pm * tstep : cA; const char* nB = has_next ? (const char*)g.Bt + (size_t)nxt.pn * tstep : cB;
        for (int t = 0; t < nt; t += 2) {
            const bool last = (t == nt - 2);
            const char* a1 = cA + (size_t)(t + 1) * kstep;
            const char* a2 = last ? nA : cA + (size_t)(t + 2) * kstep; const char* b2 = last ? nB : cB + (size_t)(t + 2) * kstep;
            const char* a3 = a2 + kstep; const char* b3 = b2 + kstep;
            if (last && has_next) S.a_ready(nxt);
            if constexpr (SP2) {
            PG8_LDB(B0, 0, 0); PG8_LDB(B1, 0, 1); PG8_SCHED; PG8_LDA(At, 0, 0); PG8_STAGE(PG8_SA(1, 1), a1 + hstep, voffA);
            PG8_WAIT_V(8); PG8_WAIT_L(0); PG8_BAR; PG8_MMA(0, 0, At, B0); PG8_MMA(0, 1, At, B1); PG8_BAR; PG8_SCHED;
            PG8_LDA(At, 0, 1); PG8_STAGE(PG8_SB(0, 0), b2, voffB); PG8_STAGE(PG8_SB(0, 1), b2 + hstep, voffB); PG8_STAGE(PG8_SA(0, 0), a2, voffA);
            PG8_WAIT_V(8); PG8_WAIT_L(0); PG8_BAR; PG8_MMA(1, 0, At, B0); PG8_MMA(1, 1, At, B1); PG8_BAR; PG8_SCHED;
            PG8_LDB(B0, 1, 0); PG8_LDB(B1, 1, 1); PG8_SCHED; PG8_LDA(At, 1, 0); PG8_STAGE(PG8_SA(0, 1), a2 + hstep, voffA);
            PG8_WAIT_V(8); PG8_WAIT_L(0); PG8_BAR; PG8_MMA(0, 0, At, B0); PG8_MMA(0, 1, At, B1); PG8_BAR; PG8_SCHED;
            PG8_LDA(At, 1, 1); PG8_STAGE(PG8_SB(1, 0), b3, voffB); PG8_STAGE(PG8_SB(1, 1), b3 + hstep, voffB); PG8_STAGE(PG8_SA(1, 0), a3, voffA);
            PG8_WAIT_V(8); PG8_WAIT_L(0); PG8_BAR; PG8_MMA(1, 0, At, B0); PG8_MMA(1, 1, At, B1); PG8_BAR; PG8_SCHED;
            } else {
            PG8_LDB(B0, 0, 0); PG8_SCHED; PG8_LDA(At, 0, 0); PG8_STAGE(PG8_SA(1, 1), a1 + hstep, voffA);
            PG8_WAIT_L(8); PG8_BAR; PG8_WAIT_L(0); PG8_MMA(0, 0, At, B0); PG8_BAR; PG8_SCHED;
            PG8_LDB(B1, 0, 1); PG8_STAGE(PG8_SB(0, 0), b2, voffB);
            PG8_BAR; PG8_WAIT_L(0); PG8_MMA(0, 1, At, B1); PG8_BAR;
            PG8_LDA(At, 0, 1); PG8_STAGE(PG8_SA(0, 0), a2, voffA);
            PG8_BAR; PG8_WAIT_L(0); PG8_MMA(1, 0, At, B0); PG8_BAR; PG8_SCHED;
            PG8_STAGE(PG8_SB(0, 1), b2 + hstep, voffB);
            PG8_WAIT_V(6); PG8_BAR; PG8_MMA(1, 1, At, B1); PG8_BAR;
            PG8_LDB(B0, 1, 0); PG8_SCHED; PG8_LDA(At, 1, 0); PG8_STAGE(PG8_SA(0, 1), a2 + hstep, voffA);
            PG8_WAIT_L(8); PG8_BAR; PG8_WAIT_L(0); PG8_MMA(0, 0, At, B0); PG8_BAR; PG8_SCHED;
            PG8_LDB(B1, 1, 1); PG8_STAGE(PG8_SB(1, 0), b3, voffB);
            PG8_BAR; PG8_WAIT_L(0); PG8_MMA(0, 1, At, B1); PG8_BAR;
            PG8_LDA(At, 1, 1); PG8_STAGE(PG8_SA(1, 0), a3, voffA);
            PG8_BAR; PG8_WAIT_L(0); PG8_MMA(1, 0, At, B0); PG8_BAR; PG8_SCHED;
            PG8_STAGE(PG8_SB(1, 1), b3 + hstep, voffB);
            PG8_WAIT_V(6); PG8_BAR; PG8_MMA(1, 1, At, B1); PG8_BAR;
            }
        }
        if constexpr (ALIGN_EPI) { if (wr == 0) PG8_BAR; }
        if constexpr (!Epi::AFTER_DRAIN) { E(acc, cur, wr, wc, fr, fq); S.done(cur); }
        if (!has_next) break;
#pragma unroll
        for (int a = 0; a < 2; ++a)
#pragma unroll
            for (int b = 0; b < 2; ++b)
#pragma unroll
                for (int m = 0; m < 4; ++m)
#pragma unroll
                    for (int n = 0; n < 2; ++n) acc[a][b][m][n] = (f32x4){0.f, 0.f, 0.f, 0.f};
        cur = nxt; cA = nA; cB = nB; ++ui;
        if constexpr (ALIGN_EPI) { if (wr == 1) PG8_BAR; }
    }
    PG8_WAIT_V(0);
    if constexpr (!ALIGN_EPI) { if (wr == 0) PG8_BAR; }
    PG8_BAR;
    if constexpr (Epi::AFTER_DRAIN) { E.fused(acc, cur, wr, wc, fr, fq, lds, wid, lane); S.done(cur); }
#undef PG8_SA
#undef PG8_SB
#undef PG8_STAGE
#undef PG8_LDA
#undef PG8_LDB
#undef PG8_MMA
#undef PG8_WAIT_V
#undef PG8_WAIT_L
#undef PG8_BAR
#undef PG8_SCHED
}
}
#define GAS __attribute__((address_space(1)))
#define LAS __attribute__((address_space(3)))
typedef unsigned short bf16;
typedef unsigned v4u __attribute__((ext_vector_type(4)));
typedef float f32x4 __attribute__((ext_vector_type(4)));
typedef short bf16x8 __attribute__((ext_vector_type(8)));
typedef GAS unsigned gu32;
typedef GAS unsigned long long gu64;
#define RLX_AGENT __ATOMIC_RELAXED, __HIP_MEMORY_SCOPE_AGENT
#define LDS_WAIT() asm volatile("s_waitcnt lgkmcnt(0)" ::: "memory")
#define VM_WAIT() asm volatile("s_waitcnt vmcnt(0)" ::: "memory")
__device__ __forceinline__ unsigned long long rt() { return __builtin_amdgcn_s_memrealtime(); }
__device__ __forceinline__ unsigned f2bf(float f) { unsigned u = __builtin_bit_cast(unsigned, f); return (u + 0x7fffu + ((u >> 16) & 1u)) >> 16; }
__device__ __forceinline__ unsigned pk2(float lo, float hi) { return f2bf(lo) | (f2bf(hi) << 16); }

#define XB_TMO      128
#define XB_XCNT(j)  (256  + 64 * (j))
#define XB_XSUB(j)  (1280 + 64 * (j))
#define XB_XGEN(j)  (2304 + 64 * (j))
#define XB_TOP      3328
#define XB_TOPGEN   3392
#define XCD_BAR_WORDS 3456
#define XB_SPIN_CAP (1u << 18)

__device__ __forceinline__ unsigned xb_ld(unsigned* p)              { return __hip_atomic_load(p, __ATOMIC_RELAXED, __HIP_MEMORY_SCOPE_AGENT); }
__device__ __forceinline__ unsigned xb_add(unsigned* p, unsigned v) { return __hip_atomic_fetch_add(p, v, __ATOMIC_RELAXED, __HIP_MEMORY_SCOPE_AGENT); }
__device__ __forceinline__ unsigned xb_xcc_id() { return (unsigned)__builtin_amdgcn_s_getreg((3 << 11) | 20) & 0xFu; }
#define XB_SPIN(cond, bar) do { unsigned _sp = 0; while (cond) { __builtin_amdgcn_s_sleep(1); \
    if ((++_sp & 255u) == 0u) { if (xb_ld(&(bar)[XB_TMO])) break; if (_sp > XB_SPIN_CAP) { atomicAdd(&(bar)[XB_TMO], 1u); break; } } } } while (0)

struct XcdBarrier {
    unsigned* bar; unsigned x;
    volatile LAS unsigned* st;
};

__device__ __forceinline__ XcdBarrier xcd_barrier_post(unsigned* bar, volatile LAS unsigned* st) {
    XcdBarrier b; b.bar = bar; b.x = xb_xcc_id(); b.st = st;
    if (threadIdx.x == 0) (void)xb_add(&bar[XB_XCNT(b.x)], 1u);
    return b;
}
__device__ __forceinline__ void xcd_barrier_complete(unsigned* bar, unsigned x, unsigned& nloc, unsigned& nx) {
    const unsigned G = gridDim.x * gridDim.y * gridDim.z;
    unsigned sum, cnt, mine, sp = 0u;
    for (;;) {
        sum = 0u; cnt = 0u; mine = 0u;
#pragma unroll
        for (unsigned j = 0; j < 16; ++j) { const unsigned c = xb_ld(&bar[XB_XCNT(j)]); sum += c; cnt += (c > 0u) ? 1u : 0u; mine = (j == x) ? c : mine; }
        if (sum == G) break;
        __builtin_amdgcn_s_sleep(1);
        if ((++sp & 255u) == 0u) { if (xb_ld(&bar[XB_TMO])) break; if (sp > XB_SPIN_CAP) { atomicAdd(&bar[XB_TMO], 1u); break; } }
    }
    nloc = mine > 0u ? mine : 1u; nx = cnt > 0u ? cnt : 1u;
}

__device__ __forceinline__ void xcd_barrier(const XcdBarrier& b) {
    asm volatile("s_waitcnt vmcnt(0)" ::: "memory");
    __syncthreads();
    if (threadIdx.x == 0) {
        unsigned* bar = b.bar;
        __builtin_amdgcn_s_waitcnt(0);
        unsigned nloc = b.st[0], nx = b.st[1];
        if (nloc == 0u) { xcd_barrier_complete(bar, b.x, nloc, nx); b.st[0] = nloc; b.st[1] = nx; }
        const unsigned old = xb_add(&bar[XB_XSUB(b.x)], 1u);
        const unsigned gen = old / nloc;
        if (old + 1u == (gen + 1u) * nloc) {
            __builtin_amdgcn_fence(__ATOMIC_RELEASE, "agent");
            asm volatile("s_waitcnt vmcnt(0)" ::: "memory");
            const unsigned og = xb_add(&bar[XB_TOP], 1u);
            const unsigned tg = og / nx;
            if (og + 1u == (tg + 1u) * nx) xb_add(&bar[XB_TOPGEN], 1u);
            else XB_SPIN(xb_ld(&bar[XB_TOPGEN]) == tg, bar);
            __builtin_amdgcn_fence(__ATOMIC_ACQUIRE, "agent");
            xb_add(&bar[XB_XGEN(b.x)], 1u);
            asm volatile("s_waitcnt vmcnt(0)" ::: "memory");
        } else {
            XB_SPIN(xb_ld(&bar[XB_XGEN(b.x)]) == gen, bar);
            __builtin_amdgcn_fence(__ATOMIC_ACQUIRE, "agent");
            asm volatile("s_waitcnt vmcnt(0)" ::: "memory");
        }
    }
    __syncthreads();
}

constexpr int NWAVES = 8, NTHREADS = 512;
constexpr int DM = 2048, NP_ROWS = 8192, NS_ROWS = 128, NROWS = 8320, MPAD = 8448;
constexpr int DEPTH = 4, NBATCH = 36;
constexpr int INW = 4368, ZW = 4608;
constexpr int ZQ = 0, ZK = 512, ZV = 640, ZU = 768, GQ = 1280, GK = 1792, GV = 2304, GG = 3328, GA = 4352;
constexpr int DFF = 5632, NGU = 11264, MODW = 12288, MODLD = 49152;
constexpr float EPS = 1e-6f;
constexpr size_t O_Y = 0, O_WK_P = 17039360, O_WV_P = 17301504, O_POOL_P = 17563648, O_GLA_P = 17686528,
                 O_WK_S = 19783680, O_WV_S = 21880832, O_POOL_S = 23977984, O_GLA_S = 24961024, O_END = 41738240;
constexpr size_t MiB = 1u << 20;
constexpr size_t WS_CTL = 0, CTL_ZERO_BYTES = 1 * MiB;
constexpr size_t WS_WADA = 1 * MiB;
constexpr size_t WS_WIN  = WS_WADA + 192 * MiB;
constexpr size_t WS_WOUT = WS_WIN + 72 * MiB;
constexpr size_t WS_WGU  = WS_WOUT + 32 * MiB;
constexpr size_t WS_WDN  = WS_WGU + 176 * MiB;
constexpr size_t WS_X    = WS_WDN + 88 * MiB;
constexpr size_t WS_H    = WS_X + 66 * MiB;
constexpr size_t WS_Z    = WS_H + 33 * MiB;
constexpr size_t WS_MIX  = WS_Z + 75 * MiB;
constexpr size_t WS_ACT  = WS_MIX + 33 * MiB;
constexpr size_t WS_OGLA = WS_ACT + 91 * MiB;
constexpr size_t WS_LA   = WS_OGLA + 33 * MiB;
constexpr size_t WS_MOD  = WS_LA + 17 * MiB;
constexpr size_t WS_SC   = WS_MOD + 7 * MiB;
constexpr size_t WS_BTAB = WS_SC + 1 * MiB;
constexpr size_t WS_WPT  = WS_BTAB + 1 * MiB;
constexpr size_t WS_QDG  = WS_WPT + 1 * MiB;
constexpr size_t WS_KDTG = WS_QDG + 9 * MiB;
constexpr size_t WS_VTG  = WS_KDTG + 11 * MiB;
constexpr size_t WS_DLG  = WS_VTG + 21 * MiB;
constexpr size_t WS_DUMMY = WS_DLG + 1 * MiB;
constexpr size_t WS_END  = WS_DUMMY + 66 * MiB;
constexpr int CW_BAR = 4096;
constexpr int RING_OFF = 0, RING_BYTES = 131072;
constexpr int LDSCTL_OFF = RING_BYTES, MISC_OFF = LDSCTL_OFF + 320;
constexpr int LDS_BYTES = 147456;

struct Args { const float* in[24]; float* out; unsigned char* ws; int ph_lo, ph_hi; };
struct Frame {
    LAS unsigned char* lds;
    volatile LAS unsigned* MISC;
    int wave, vcu, G; int zo; int probe;
    __device__ __forceinline__ float* X_ST() const { return (float*)(ws + (probe ? WS_DUMMY : WS_X)); }
    __device__ __forceinline__ float* OGLA_ST() const { return (float*)(ws + (probe ? WS_DUMMY : WS_OGLA)); }
    __device__ __forceinline__ int lane_id() const { return (int)__builtin_amdgcn_mbcnt_hi(~0u, __builtin_amdgcn_mbcnt_lo(~0u, 0u)); }
    unsigned char* ws; float* out;
    __device__ __forceinline__ bf16* Wada_t() const { return (bf16*)(ws + WS_WADA); }
    __device__ __forceinline__ bf16* Win_t() const { return (bf16*)(ws + WS_WIN); }
    __device__ __forceinline__ bf16* Wout_t() const { return (bf16*)(ws + WS_WOUT); }
    __device__ __forceinline__ bf16* Wgu_t() const { return (bf16*)(ws + WS_WGU); }
    __device__ __forceinline__ bf16* Wdn_t() const { return (bf16*)(ws + WS_WDN); }
    __device__ __forceinline__ float* X() const { return (float*)(ws + WS_X); }
    __device__ __forceinline__ bf16* H() const { return (bf16*)(ws + WS_H); }
    __device__ __forceinline__ bf16* Z() const { return (bf16*)(ws + WS_Z); }
    __device__ __forceinline__ bf16* MIX() const { return (bf16*)(ws + WS_MIX); }
    __device__ __forceinline__ bf16* ACT() const { return (bf16*)(ws + WS_ACT); }
    __device__ __forceinline__ float* OGLA() const { return (float*)(ws + WS_OGLA); }
    __device__ __forceinline__ float* SLOC() const { return (float*)(ws + WS_LA); }
    __device__ __forceinline__ float* DSEG() const { return (float*)(ws + WS_LA + 16 * MiB); }
    __device__ __forceinline__ float* MOD() const { return (float*)(ws + WS_MOD); }
    __device__ __forceinline__ bf16* SC() const { return (bf16*)(ws + WS_SC); }
    __device__ __forceinline__ float* BTAB() const { return (float*)(ws + WS_BTAB); }
    __device__ __forceinline__ bf16* WPT() const { return (bf16*)(ws + WS_WPT); }
    __device__ __forceinline__ bf16* QDG() const { return (bf16*)(ws + WS_QDG); }
    __device__ __forceinline__ bf16* KDTG() const { return (bf16*)(ws + WS_KDTG); }
    __device__ __forceinline__ bf16* VTG() const { return (bf16*)(ws + WS_VTG); }
    __device__ __forceinline__ float* DLG() const { return (float*)(ws + WS_DLG); }
};
enum { I_XP = 0, I_XS, I_CK, I_CV, I_SPOOL, I_SGLA, I_CP, I_CS, I_WADA, I_BADA, I_GMIX, I_GFFN, I_WIN, I_WOUT, I_RELB, I_SINKS, I_WPOOL, I_PSCALE, I_WA2, I_BA2, I_GGLA, I_WGU, I_WDN, I_GFIN };

__device__ __forceinline__ float bf2f(unsigned short b) { return __uint_as_float((unsigned)b << 16); }
__device__ __forceinline__ float bflo(unsigned w) { return __uint_as_float(w << 16); }
__device__ __forceinline__ float bfhi(unsigned w) { return __uint_as_float(w & 0xffff0000u); }
__device__ __forceinline__ float wave_sum(float v) {
#pragma unroll
    for (int o = 1; o < 64; o <<= 1) v += __shfl_xor(v, o);
    return v;
}
__device__ __forceinline__ float wave_max(float v) {
#pragma unroll
    for (int o = 1; o < 64; o <<= 1) v = fmaxf(v, __shfl_xor(v, o));
    return v;
}
__device__ __forceinline__ int t5_bucket(int n) {
    if (n < 16) return n;
    return 16 + (n >= 19) + (n >= 21) + (n >= 24) + (n >= 27) + (n >= 31) + (n >= 35) + (n >= 40) + (n >= 46) + (n >= 52) + (n >= 59) + (n >= 67) + (n >= 77) + (n >= 87) + (n >= 99) + (n >= 113);
}

template <int MODE>
__device__ __forceinline__ void transpose_item(const float* W, int K, int N, int nblk, bf16* WT, int row_off, LAS float* scr, int item, int lane) {
    const int kb = item / nblk, nb = item % nblk, k0 = 64 * kb, n0 = 32 * nb;
    const int nn = n0 + (lane & 31); const bool ok = nn < N;
    float wv[32];
#pragma unroll
    for (int i = 0; i < 32; ++i) { const int kk = 2 * i + (lane >> 5); wv[i] = ok ? W[(size_t)(k0 + kk) * N + nn] : 0.f; }
#pragma unroll
    for (int i = 0; i < 32; ++i) { const int kk = 2 * i + (lane >> 5); scr[kk * 33 + (lane & 31)] = wv[i]; }
    LDS_WAIT(); asm volatile("" ::: "memory");
    const int c = lane & 7;
#pragma unroll
    for (int j = 0; j < 4; ++j) { const int n = (lane >> 3) + 8 * j; const LAS float* s = scr + (8 * c) * 33 + n;
        v4u o; o.x = pk2(s[0 * 33], s[1 * 33]); o.y = pk2(s[2 * 33], s[3 * 33]); o.z = pk2(s[4 * 33], s[5 * 33]); o.w = pk2(s[6 * 33], s[7 * 33]);
        int orow = n0 + n;
        if (MODE == 1) { orow = (orow < DFF) ? ((orow >> 7) * 256 + (orow & 127)) : (((orow - DFF) >> 7) * 256 + 128 + ((orow - DFF) & 127)); }
        *(GAS v4u*)(WT + (size_t)(row_off + orow) * K + k0 + 8 * c) = o; }
    LDS_WAIT(); asm volatile("" ::: "memory");
}
__device__ __forceinline__ float silu_f(float a) { return a * __builtin_amdgcn_rcpf(1.0f + __expf(-a)); }
__device__ __forceinline__ void adaln_item(Frame& F, const Args& A, int item, LAS float* scr) {
    const int lane = F.lane_id(), fr = lane & 15, fq = lane >> 4;
    const int l = item / 384, nb = item - l * 384, n0 = 32 * nb;
    const float* W = A.in[F.zo + I_WADA] + (size_t)l * DM * MODW + n0 + (lane & 31) + (size_t)(lane >> 5) * MODW;
    const float* crow[3];
#pragma unroll
    for (int rb = 0; rb < 3; ++rb) { const int b = rb * 16 + fr; crow[rb] = (b < 4) ? (A.in[F.zo + I_CP] + (size_t)b * DM) : (A.in[F.zo + I_CS] + (size_t)((b < NBATCH ? b : NBATCH - 1) - 4) * DM); }
    f32x4 acc[3][2];
#pragma unroll
    for (int rb = 0; rb < 3; ++rb) { acc[rb][0] = (f32x4){0.f, 0.f, 0.f, 0.f}; acc[rb][1] = (f32x4){0.f, 0.f, 0.f, 0.f}; }
    float wv[32];
#pragma unroll
    for (int i = 0; i < 32; ++i) wv[i] = W[(size_t)(2 * i) * MODW];
    for (int kb = 0; kb < 32; ++kb) {
#pragma unroll
        for (int i = 0; i < 32; ++i) scr[(2 * i + (lane >> 5)) * 33 + (lane & 31)] = wv[i];
        if (kb + 1 < 32) {
#pragma unroll
            for (int i = 0; i < 32; ++i) wv[i] = W[(size_t)(64 * (kb + 1) + 2 * i) * MODW];
        }
        LDS_WAIT(); asm volatile("" ::: "memory");
#pragma unroll
        for (int ks = 0; ks < 2; ++ks) {
            bf16x8 bfr[2];
#pragma unroll
            for (int nk = 0; nk < 2; ++nk) { const LAS float* s = scr + (32 * ks + 8 * fq) * 33 + 16 * nk + fr;
                v4u w; w.x = pk2(s[0 * 33], s[1 * 33]); w.y = pk2(s[2 * 33], s[3 * 33]); w.z = pk2(s[4 * 33], s[5 * 33]); w.w = pk2(s[6 * 33], s[7 * 33]); bfr[nk] = __builtin_bit_cast(bf16x8, w); }
#pragma unroll
            for (int rb = 0; rb < 3; ++rb) { const f32x4* cp = (const f32x4*)(crow[rb] + 64 * kb + 32 * ks + 8 * fq); const f32x4 c0 = cp[0], c1 = cp[1];
                v4u w; w.x = pk2(silu_f(c0.x), silu_f(c0.y)); w.y = pk2(silu_f(c0.z), silu_f(c0.w)); w.z = pk2(silu_f(c1.x), silu_f(c1.y)); w.w = pk2(silu_f(c1.z), silu_f(c1.w));
                const bf16x8 af = __builtin_bit_cast(bf16x8, w);
                acc[rb][0] = __builtin_amdgcn_mfma_f32_16x16x32_bf16(af, bfr[0], acc[rb][0], 0, 0, 0); acc[rb][1] = __builtin_amdgcn_mfma_f32_16x16x32_bf16(af, bfr[1], acc[rb][1], 0, 0, 0); } }
        LDS_WAIT(); asm volatile("" ::: "memory");
    }
    const float* bias = A.in[F.zo + I_BADA] + l * MODW + n0; float* mo = F.MOD() + (size_t)l * MODW + n0;
#pragma unroll
    for (int rb = 0; rb < 3; ++rb)
#pragma unroll
        for (int nk = 0; nk < 2; ++nk) { const float bv = bias[16 * nk + fr];
#pragma unroll
            for (int i = 0; i < 4; ++i) { const int b = rb * 16 + 4 * fq + i; if (b < NBATCH) mo[(size_t)b * MODLD + 16 * nk + fr] = acc[rb][nk][i] + bv; } }
}
__device__ __forceinline__ void p0_prologue(Frame& F, const Args& A) {
    LAS float* scr = (LAS float*)(F.lds + RING_OFF + F.wave * 16384);
    const int gw = F.vcu * NWAVES + F.wave, NGW = F.G * NWAVES;
    const int gt = gw * 64 + F.lane_id(), NGT = NGW * 64;
    for (int it = gw; it < DEPTH * 384; it += NGW) adaln_item(F, A, it, scr);
    constexpr int I_IN = 32 * 137, I_OUT = 32 * 64, I_GU = 32 * 352, I_DN = 88 * 64, I_L = I_IN + I_OUT + I_GU + I_DN;
    for (int it = gw; it < DEPTH * I_L; it += NGW) {
        const int l = it / I_L; int r = it - l * I_L;
        if (r < I_IN)  { transpose_item<0>(A.in[F.zo + I_WIN] + (size_t)l * DM * INW, DM, INW, 137, F.Win_t() + (size_t)l * ZW * DM, 0, scr, r, F.lane_id()); continue; } r -= I_IN;
        if (r < I_OUT) { transpose_item<0>(A.in[F.zo + I_WOUT] + (size_t)l * DM * DM, DM, DM, 64, F.Wout_t() + (size_t)l * DM * DM, 0, scr, r, F.lane_id()); continue; } r -= I_OUT;
        if (r < I_GU)  { transpose_item<1>(A.in[F.zo + I_WGU] + (size_t)l * DM * NGU, DM, NGU, 352, F.Wgu_t() + (size_t)l * NGU * DM, 0, scr, r, F.lane_id()); continue; } r -= I_GU;
        transpose_item<0>(A.in[F.zo + I_WDN] + (size_t)l * DFF * DM, DFF, DM, 64, F.Wdn_t() + (size_t)l * DM * DFF, 0, scr, r, F.lane_id());
    }
    const v4u z4 = {0u, 0u, 0u, 0u};
    for (int i = gt; i < DEPTH * 224 * 256; i += NGT) { const int l = i / (224 * 256), r = i - l * (224 * 256); *((GAS v4u*)(F.Win_t() + ((size_t)l * ZW + 4384) * DM) + r) = z4; }
    for (int i = gt; i < 128 * 256; i += NGT) { *((GAS v4u*)(F.H() + (size_t)NROWS * DM) + i) = z4; *((GAS v4u*)(F.MIX() + (size_t)NROWS * DM) + i) = z4; }
    for (int i = gt; i < 128 * 704; i += NGT) *((GAS v4u*)(F.ACT() + (size_t)NROWS * DFF) + i) = z4;
    for (int i = gt; i < NP_ROWS * 512; i += NGT) ((GAS f32x4*)F.X())[i] = ((const GAS f32x4*)A.in[F.zo + I_XP])[i];
    for (int i = gt; i < NS_ROWS * 512; i += NGT) ((GAS f32x4*)(F.X() + (size_t)NP_ROWS * DM))[i] = ((const GAS f32x4*)A.in[F.zo + I_XS])[i];
    for (int i = gt; i < 4 * 4 * 128 * 128; i += NGT) { const int lg = i >> 14, dcol = (i >> 7) & 127, c = i & 127; F.WPT()[i] = (bf16)f2bf(A.in[F.zo + I_WPOOL][((size_t)lg * 128 + c) * 128 + dcol]); }
    for (int i = gt; i < 8 * 128; i += NGT) { const int h = i >> 7, dist = i & 127; F.BTAB()[i] = A.in[F.zo + I_RELB][t5_bucket(dist) * 8 + h]; }
}

__device__ __forceinline__ void norm_mod_rows(Frame& F, const float* g, const float* modl  ) {
    const int gw = F.vcu * NWAVES + F.wave, NGW = F.G * NWAVES;
    for (int r = gw; r < NROWS; r += NGW) {
        const int b = r < NP_ROWS ? (r >> 11) : 4 + ((r - NP_ROWS) >> 2);
        const float* xr = F.X() + (size_t)r * DM + 4 * F.lane_id(); const float* sh = modl + (size_t)b * MODLD + 4 * F.lane_id(); const float* gg = g + 4 * F.lane_id();
        f32x4 v[8]; float ss = 0.f;
#pragma unroll
        for (int j = 0; j < 8; ++j) { v[j] = *(const f32x4*)(xr + 256 * j); ss += (v[j].x * v[j].x + v[j].y * v[j].y) + (v[j].z * v[j].z + v[j].w * v[j].w); }
        const float rstd = 1.0f / sqrtf(wave_sum(ss) * (1.0f / DM) + EPS);
        bf16* hr = F.H() + (size_t)r * DM + 4 * F.lane_id();
#pragma unroll
        for (int j = 0; j < 8; ++j) { const f32x4 gv = *(const f32x4*)(gg + 256 * j), sv = *(const f32x4*)(sh + 256 * j), cv = *(const f32x4*)(sh + 2048 + 256 * j);
            const f32x4 y = (v[j] * rstd * gv) * (1.0f + cv) + sv;
            uint2 w; w.x = pk2(y.x, y.y); w.y = pk2(y.z, y.w); *(uint2*)(hr + 256 * j) = w; }
    }
}
__device__ __forceinline__ void final_norm_rows(Frame& F, const Args& A) {
    const int gw = F.vcu * NWAVES + F.wave, NGW = F.G * NWAVES; const float* g = A.in[F.zo + I_GFIN] + 4 * F.lane_id();
    for (int r = gw; r < NROWS; r += NGW) {
        const float* xr = F.X() + (size_t)r * DM + 4 * F.lane_id();
        f32x4 v[8]; float ss = 0.f;
#pragma unroll
        for (int j = 0; j < 8; ++j) { v[j] = *(const f32x4*)(xr + 256 * j); ss += (v[j].x * v[j].x + v[j].y * v[j].y) + (v[j].z * v[j].z + v[j].w * v[j].w); }
        const float rstd = 1.0f / sqrtf(wave_sum(ss) * (1.0f / DM) + EPS);
        float* yr = F.out + O_Y + (size_t)r * DM + 4 * F.lane_id();
#pragma unroll
        for (int j = 0; j < 8; ++j) { const f32x4 gv = *(const f32x4*)(g + 256 * j); *(f32x4*)(yr + 256 * j) = v[j] * rstd * gv; }
    }
}

__device__ __forceinline__ void attn_item(Frame& F, const Args& A, int l, int r, int hd, LAS float* ps) {
    const int lane = F.lane_id(), g = hd >> 2; const bool smp = r >= NP_ROWS;
    const int t = r & 2047, sb = smp ? ((r - NP_ROWS) >> 2) : 0, si = (r - NP_ROWS) & 3;
    LAS float* qs = ps + 128;
    { const unsigned w = ((const unsigned*)(F.Z() + (size_t)r * ZW + ZQ + hd * 64))[lane & 31]; if (lane < 32) { qs[2 * lane] = bflo(w); qs[2 * lane + 1] = bfhi(w); } }
    LDS_WAIT(); asm volatile("" ::: "memory");
    const float* ck = A.in[F.zo + I_CK] + ((size_t)(l * 32 + sb) * 128) * 128 + g * 64;
    const float* cv = A.in[F.zo + I_CV] + ((size_t)(l * 32 + sb) * 128) * 128 + g * 64;
    const int jmin = smp ? 0 : (t >= 127 ? 0 : 127 - t);
    float sc[2];
#pragma unroll 1
    for (int jj = 0; jj < 2; ++jj) {
        const int j = lane + 64 * jj, dist = 127 - j; float dot = 0.f; bool valid = j >= jmin;
        if (valid) {
            const int krel = si - dist;
            if (smp && krel < 0) {
                const f32x4* kp = (const f32x4*)(ck + (size_t)(krel + 128) * 128);
#pragma unroll 4
                for (int c = 0; c < 16; ++c) { const f32x4 kv = kp[c]; const f32x4 qv = *(const LAS f32x4*)(qs + 4 * c); dot += qv.x * kv.x + qv.y * kv.y + qv.z * kv.z + qv.w * kv.w; }
            } else {
                const int krow = smp ? (NP_ROWS + sb * 4 + krel) : (r - dist);
                const v4u* kp = (const v4u*)(F.Z() + (size_t)krow * ZW + ZK + g * 64);
#pragma unroll 4
                for (int c = 0; c < 8; ++c) { const v4u w = kp[c];
                    const f32x4 qa = *(const LAS f32x4*)(qs + 8 * c), qb = *(const LAS f32x4*)(qs + 8 * c + 4);
                    dot += qa.x * bflo(w.x) + qa.y * bfhi(w.x) + qa.z * bflo(w.y) + qa.w * bfhi(w.y) + qb.x * bflo(w.z) + qb.y * bfhi(w.z) + qb.z * bflo(w.w) + qb.w * bfhi(w.w); }
            }
        }
        const float sv = valid ? dot * 0.125f + F.BTAB()[hd * 128 + dist] : -INFINITY;
        if (jj == 0) sc[0] = sv; else sc[1] = sv;
    }
    const float sink = A.in[F.zo + I_SINKS][l * 8 + hd];
    const float m = fmaxf(wave_max(fmaxf(sc[0], sc[1])), sink);
    const float p0 = __expf(sc[0] - m), p1 = __expf(sc[1] - m);
    const float denom = wave_sum(p0 + p1) + __expf(sink - m);
    ps[lane] = p0; ps[lane + 64] = p1;
    LDS_WAIT(); asm volatile("" ::: "memory");
    float o = 0.f;
#pragma unroll 16
    for (int j = jmin; j < 128; ++j) {
        const float pj = ps[j]; const int dist = 127 - j; float vv;
        const int krel = si - dist;
        if (smp && krel < 0) vv = cv[(size_t)(krel + 128) * 128 + lane];
        else { const int krow = smp ? (NP_ROWS + sb * 4 + krel) : (r - dist); vv = bf2f(F.Z()[(size_t)krow * ZW + ZV + g * 64 + lane]); }
        o += pj * vv;
    }
    F.MIX()[(size_t)r * DM + hd * 64 + lane] = (bf16)f2bf(o / denom);
    LDS_WAIT(); asm volatile("" ::: "memory");
}
__device__ __forceinline__ void pool_item(Frame& F, const Args& A, int l, int r, int gi, LAS float* ds) {
    const int lane = F.lane_id(), w = 2 << gi; const bool smp = r >= NP_ROWS;
    const int t = r & 2047, sb = (r - NP_ROWS) >> 2, si = (r - NP_ROWS) & 3;
    const float* pbuf = A.in[F.zo + I_SPOOL] + ((size_t)(l * 32 + sb) * 15) * 512 + gi * 128;
    float s0 = 0.f, s1 = 0.f, u0 = 0.f, u1 = 0.f;
#pragma unroll 4
    for (int o = 0; o < w; ++o) {
        float a0 = 0.f, a1 = 0.f;
        if (!smp) { if (t - o >= 0) { const bf16* zp = F.Z() + (size_t)(r - o) * ZW + ZU + gi * 128; a0 = bf2f(zp[lane]); a1 = bf2f(zp[lane + 64]); } }
        else { const int idx = si - o;
            if (idx >= 0) { const bf16* zp = F.Z() + (size_t)(NP_ROWS + sb * 4 + idx) * ZW + ZU + gi * 128; a0 = bf2f(zp[lane]); a1 = bf2f(zp[lane + 64]); }
            else { const float* bp = pbuf + (size_t)(15 + idx) * 512; a0 = bp[lane]; a1 = bp[lane + 64]; } }
        if (o == 0) { u0 = a0; u1 = a1; }
        s0 += a0; s1 += a1;
    }
    const float cnt = smp ? (float)w : (float)((t + 1) < w ? (t + 1) : w);
    ds[lane] = s0 / cnt - u0; ds[lane + 64] = s1 / cnt - u1;
    LDS_WAIT(); asm volatile("" ::: "memory");
    const float* wp = A.in[F.zo + I_WPOOL] + ((size_t)(l * 4 + gi) * 128) * 128;
    float y0 = 0.f, y1 = 0.f;
#pragma unroll 16
    for (int c = 0; c < 128; ++c) { const float dv = ds[c]; y0 += dv * wp[c * 128 + lane]; y1 += dv * wp[c * 128 + lane + 64]; }
    const float* psc = A.in[F.zo + I_PSCALE] + l * 512 + gi * 128;
    bf16* mp = F.MIX() + (size_t)r * DM + 512 + gi * 128;
    mp[lane] = (bf16)f2bf(y0 * psc[lane]); mp[lane + 64] = (bf16)f2bf(y1 * psc[lane + 64]);
    LDS_WAIT(); asm volatile("" ::: "memory");
}
__device__ __forceinline__ void cache_outputs(Frame& F, const Args& A, int l) {
    const int gt = (F.vcu * NWAVES + F.wave) * 64 + F.lane_id(), NGT = F.G * NWAVES * 64;
#pragma unroll 4
    for (int i = gt; i < 4 * 128 * 128; i += NGT) { const int b = i >> 14, j = (i >> 7) & 127, c = i & 127; const bf16* zr = F.Z() + (size_t)(b * 2048 + 1920 + j) * ZW;
        F.out[O_WK_P + (size_t)l * 65536 + i] = bf2f(zr[ZK + c]); F.out[O_WV_P + (size_t)l * 65536 + i] = bf2f(zr[ZV + c]); }
#pragma unroll 4
    for (int i = gt; i < 4 * 15 * 512; i += NGT) { const int b = i / 7680, rem = i - b * 7680, j = rem >> 9, c = rem & 511;
        F.out[O_POOL_P + (size_t)l * 30720 + i] = bf2f(F.Z()[(size_t)(b * 2048 + 2033 + j) * ZW + ZU + c]); }
#pragma unroll 4
    for (int i = gt; i < 32 * 128 * 128; i += NGT) { const int sb = i >> 14, p = (i >> 7) & 127, c = i & 127; float kv, vv;
        if (p < 124) { const size_t src = ((size_t)(l * 32 + sb) * 128 + p + 4) * 128 + c; kv = A.in[F.zo + I_CK][src]; vv = A.in[F.zo + I_CV][src]; }
        else { const bf16* zr = F.Z() + (size_t)(NP_ROWS + sb * 4 + p - 124) * ZW; kv = bf2f(zr[ZK + c]); vv = bf2f(zr[ZV + c]); }
        F.out[O_WK_S + (size_t)l * 524288 + i] = kv; F.out[O_WV_S + (size_t)l * 524288 + i] = vv; }
#pragma unroll 4
    for (int i = gt; i < 32 * 15 * 512; i += NGT) { const int sb = i / 7680, rem = i - sb * 7680, j = rem >> 9, c = rem & 511; float v;
        if (j < 11) v = A.in[F.zo + I_SPOOL][((size_t)(l * 32 + sb) * 15 + j + 4) * 512 + c];
        else v = bf2f(F.Z()[(size_t)(NP_ROWS + sb * 4 + j - 11) * ZW + ZU + c]);
        F.out[O_POOL_S + (size_t)l * 245760 + i] = v; }
}
__device__ __forceinline__ void gla_out_item(Frame& F, const Args& A, int l, int r, int hh) {
    const int lane = F.lane_id();
    const f32x4 o = *(const f32x4*)(F.OGLA() + (size_t)r * 1024 + hh * 256 + 4 * lane);
    const float ss = wave_sum((o.x * o.x + o.y * o.y) + (o.z * o.z + o.w * o.w));
    const float rstd = 1.0f / sqrtf(ss * (1.0f / 256.0f) + EPS);
    const f32x4 gv = *(const f32x4*)(A.in[F.zo + I_GGLA] + l * 1024 + hh * 256 + 4 * lane);
    const uint2 gw = *(const uint2*)(F.Z() + (size_t)r * ZW + GG + hh * 256 + 4 * lane);
    const float g0 = bflo(gw.x), g1 = bfhi(gw.x), g2 = bflo(gw.y), g3 = bfhi(gw.y);
    const float y0 = o.x * rstd * gv.x * (g0 / (1.0f + __expf(-g0))), y1 = o.y * rstd * gv.y * (g1 / (1.0f + __expf(-g1)));
    const float y2 = o.z * rstd * gv.z * (g2 / (1.0f + __expf(-g2))), y3 = o.w * rstd * gv.w * (g3 / (1.0f + __expf(-g3)));
    uint2 w; w.x = pk2(y0, y1); w.y = pk2(y2, y3);
    *(uint2*)(F.MIX() + (size_t)r * DM + 1024 + hh * 256 + 4 * lane) = w;
}
typedef unsigned u32x2 __attribute__((ext_vector_type(2)));
__device__ __forceinline__ u32x2 pack4bf(const f32x4 v) { u32x2 w; w.x = pk2(v.x, v.y); w.y = pk2(v.z, v.w); return w; }
constexpr int GL_QD = 0, GL_KD = 17408, GL_VT = 34816, GL_AM = 71680, GL_BS = 80896, GL_GS = 82944, GL_END = 87040;
static_assert(GL_END <= RING_BYTES, "GLA LDS map");
constexpr int GL_NSLOT = 640;
__device__ __forceinline__ void gla_prep_unit(Frame& F, const Args& A, int l, int slot) {
    const int lane = F.lane_id(), wave = F.wave, tid = wave * 64 + lane, fr = lane & 15, fq = lane >> 4;
    const bool smp = slot >= 512; const int hh = slot & 3;
    const int row0 = smp ? (NP_ROWS + ((slot - 512) >> 2) * 4) : ((slot >> 7) * 2048 + ((slot >> 2) & 31) * 64), nvalid = smp ? 4 : 64;
    const int d = tid & 127, qtr = tid >> 7, cg = hh * 128 + d;
    LAS bf16* QD = (LAS bf16*)(F.lds + GL_QD); LAS bf16* KD = (LAS bf16*)(F.lds + GL_KD); LAS bf16* VT = (LAS bf16*)(F.lds + GL_VT); LAS bf16* AM = (LAS bf16*)(F.lds + GL_AM);
    LAS float* BS = (LAS float*)(F.lds + GL_BS); LAS float* GS = (LAS float*)(F.lds + GL_GS);
    const bf16* Z = F.Z();
    unsigned short qraw[16], kraw[16], vraw[32];
    { const bf16* zq = Z + (size_t)(row0 + 16 * qtr) * ZW + GQ + cg; const bf16* zk = zq + (GK - GQ);
#pragma unroll
      for (int i = 0; i < 16; ++i) { qraw[i] = 0; kraw[i] = 0; if (16 * qtr + i < nvalid) { qraw[i] = zq[(size_t)i * ZW]; kraw[i] = zk[(size_t)i * ZW]; } }
      const int e = tid & 255, hf = tid >> 8; const bf16* vp = Z + (size_t)(row0 + 32 * hf) * ZW + GV + hh * 256 + e;
#pragma unroll
      for (int i = 0; i < 32; ++i) { vraw[i] = 0; if (32 * hf + i < nvalid) vraw[i] = vp[(size_t)i * ZW]; } }
    { const int t = tid >> 3, j0 = (tid & 7) * 2; float g0 = 0.f, g1 = 0.f;
      if (t < nvalid) { const unsigned w = *(const unsigned*)(Z + (size_t)(row0 + t) * ZW + GA + j0); g0 = bflo(w); g1 = bfhi(w); }
      GS[t * 16 + j0] = g0; GS[t * 16 + j0 + 1] = g1; }
    float wa[16];
    { const float* wp = A.in[F.zo + I_WA2] + (size_t)l * 16 * 512 + cg;
#pragma unroll
      for (int j = 0; j < 16; ++j) wa[j] = wp[j * 512]; }
    const float ba = A.in[F.zo + I_BA2][l * 512 + cg];
    __syncthreads();
    float bl[16]; float run = 0.f;
#pragma unroll
    for (int i = 0; i < 16; ++i) { const int t = 16 * qtr + i; const LAS f32x4* gp = (const LAS f32x4*)(GS + t * 16); const f32x4 g0 = gp[0], g1 = gp[1], g2 = gp[2], g3 = gp[3];
        float x = ba + g0.x * wa[0] + g0.y * wa[1] + g0.z * wa[2] + g0.w * wa[3] + g1.x * wa[4] + g1.y * wa[5] + g1.z * wa[6] + g1.w * wa[7];
        x += g2.x * wa[8] + g2.y * wa[9] + g2.z * wa[10] + g2.w * wa[11] + g3.x * wa[12] + g3.y * wa[13] + g3.z * wa[14] + g3.w * wa[15];
        float la = (fminf(x, 0.f) - __logf(1.0f + __expf(-fabsf(x)))) * (1.0f / 16.0f);
        if (t >= nvalid) la = 0.f;
        run += la; bl[i] = run; }
    BS[qtr * 128 + d] = run;
    __syncthreads();
    float pre = 0.f, tot = 0.f;
#pragma unroll
    for (int q2 = 0; q2 < 4; ++q2) { const float v = BS[q2 * 128 + d]; tot += v; if (q2 < qtr) pre += v; }
    { bf16* qg = F.QDG() + (size_t)(row0 + 16 * qtr) * 512 + cg;
      unsigned kt[8];
#pragma unroll
      for (int i = 0; i < 16; ++i) { const int t = 16 * qtr + i; const float b = pre + bl[i]; float qv = 0.f, kv = 0.f;
          qv = bf2f(qraw[i]); kv = bf2f(kraw[i]);
          const unsigned qd = f2bf(qv * __expf(b) * 0.08838834764831845f), kd = f2bf(kv * __expf(-b)), kdt = f2bf(kv * __expf(tot - b));
          QD[t * 136 + d] = (bf16)qd; KD[t * 136 + d] = (bf16)kd;
          if (t < nvalid) qg[(size_t)i * 512] = (bf16)qd;
          if (i & 1) kt[i >> 1] |= kdt << 16; else kt[i >> 1] = kdt; }
      v4u* kg = (v4u*)(F.KDTG() + ((size_t)slot * 128 + d) * 64 + 16 * qtr);
      kg[0] = (v4u){kt[0], kt[1], kt[2], kt[3]}; kg[1] = (v4u){kt[4], kt[5], kt[6], kt[7]};
      if (qtr == 0) F.DLG()[slot * 128 + d] = __expf(tot); }
    { const int e = tid & 255, hf = tid >> 8;
      unsigned vw[16];
#pragma unroll
      for (int i = 0; i < 32; ++i) { const unsigned x = vraw[i];
          if (i & 1) vw[i >> 1] |= x << 16; else vw[i >> 1] = x; }
      LAS v4u* vl = (LAS v4u*)(VT + e * 72 + 32 * hf); v4u* vg = (v4u*)(F.VTG() + ((size_t)slot * 256 + e) * 64 + 32 * hf);
#pragma unroll
      for (int k = 0; k < 4; ++k) { const v4u w = {vw[4 * k], vw[4 * k + 1], vw[4 * k + 2], vw[4 * k + 3]}; vl[k] = w; vg[k] = w; } }
    __syncthreads();
#pragma unroll
    for (int bi = 0; bi < 2; ++bi) { const int blk = 2 * wave + bi, tb = blk >> 2, sbk = blk & 3;
        f32x4 acc = {0.f, 0.f, 0.f, 0.f};
        if (sbk <= tb) {
#pragma unroll
            for (int ks = 0; ks < 4; ++ks) { const bf16x8 a = *(const LAS bf16x8*)(KD + (sbk * 16 + fr) * 136 + ks * 32 + fq * 8), b = *(const LAS bf16x8*)(QD + (tb * 16 + fr) * 136 + ks * 32 + fq * 8);
                acc = __builtin_amdgcn_mfma_f32_16x16x32_bf16(a, b, acc, 0, 0, 0); } }
        const int t = tb * 16 + fr, s0 = sbk * 16 + 4 * fq;
        f32x4 m; m.x = (s0 + 0 <= t) ? acc.x : 0.f; m.y = (s0 + 1 <= t) ? acc.y : 0.f; m.z = (s0 + 2 <= t) ? acc.z : 0.f; m.w = (s0 + 3 <= t) ? acc.w : 0.f;
        *(LAS u32x2*)(AM + t * 72 + s0) = pack4bf(m); }
    __syncthreads();
#pragma unroll
    for (int ei = 0; ei < 2; ++ei) { const int eb = 2 * wave + ei;
        const bf16x8 a0 = *(const LAS bf16x8*)(VT + (eb * 16 + fr) * 72 + fq * 8), a1 = *(const LAS bf16x8*)(VT + (eb * 16 + fr) * 72 + 32 + fq * 8);
#pragma unroll
        for (int tb = 0; tb < 4; ++tb) { f32x4 o = {0.f, 0.f, 0.f, 0.f};
            o = __builtin_amdgcn_mfma_f32_16x16x32_bf16(a0, *(const LAS bf16x8*)(AM + (tb * 16 + fr) * 72 + fq * 8), o, 0, 0, 0);
            if (tb >= 2) o = __builtin_amdgcn_mfma_f32_16x16x32_bf16(a1, *(const LAS bf16x8*)(AM + (tb * 16 + fr) * 72 + 32 + fq * 8), o, 0, 0, 0);
            const int t = tb * 16 + fr;
            if (t < nvalid) *(f32x4*)(F.OGLA() + (size_t)(row0 + t) * 1024 + hh * 256 + eb * 16 + 4 * fq) = o; } }
    __syncthreads();
}
__device__ __forceinline__ void gla_state_step(Frame& F, int slot, int eb, int fr, int fq, f32x4 (&sacc)[8]) {
    const bf16* vt = F.VTG() + ((size_t)slot * 256 + eb * 16 + fr) * 64 + 8 * fq; const bf16x8 b0 = *(const bf16x8*)vt, b1 = *(const bf16x8*)(vt + 32);
    const bf16* kt = F.KDTG() + ((size_t)slot * 128 + fr) * 64 + 8 * fq; const float* dl = F.DLG() + slot * 128 + 4 * fq;
#pragma unroll
    for (int db = 0; db < 8; ++db) { const f32x4 dv = *(const f32x4*)(dl + db * 16); const bf16x8 a0 = *(const bf16x8*)(kt + (size_t)db * 16 * 64), a1 = *(const bf16x8*)(kt + (size_t)db * 16 * 64 + 32);
        f32x4 s = sacc[db] * dv; s = __builtin_amdgcn_mfma_f32_16x16x32_bf16(a0, b0, s, 0, 0, 0); s = __builtin_amdgcn_mfma_f32_16x16x32_bf16(a1, b1, s, 0, 0, 0); sacc[db] = s; }
}
template <int NTB>
__device__ __forceinline__ void gla_inter_step(Frame& F, int row0, int nvalid, int hh, int eb, int fr, int fq, const f32x4 (&sacc)[8]) {
    u32x2 qlo[NTB][4], qhi[NTB][4]; f32x4 oi[NTB];
#pragma unroll
    for (int tb = 0; tb < NTB; ++tb) { const int t = tb * 16 + fr; const bool ok = t < nvalid;
        const bf16* qp = F.QDG() + (size_t)(row0 + t) * 512 + hh * 128 + 4 * fq; const float* op = F.OGLA() + (size_t)(row0 + t) * 1024 + hh * 256 + eb * 16 + 4 * fq;
        oi[tb] = (f32x4){0.f, 0.f, 0.f, 0.f}; if (ok) oi[tb] = *(const f32x4*)op;
#pragma unroll
        for (int ks = 0; ks < 4; ++ks) { qlo[tb][ks] = (u32x2){0u, 0u}; qhi[tb][ks] = (u32x2){0u, 0u}; if (ok) { qlo[tb][ks] = *(const u32x2*)(qp + 32 * ks); qhi[tb][ks] = *(const u32x2*)(qp + 32 * ks + 16); } } }
    bf16x8 sf[4];
#pragma unroll
    for (int ks = 0; ks < 4; ++ks) { const u32x2 lo = pack4bf(sacc[2 * ks]), hi = pack4bf(sacc[2 * ks + 1]); const v4u w = {lo.x, lo.y, hi.x, hi.y}; sf[ks] = __builtin_bit_cast(bf16x8, w); }
#pragma unroll
    for (int tb = 0; tb < NTB; ++tb) { const int t = tb * 16 + fr; f32x4 o = oi[tb];
#pragma unroll
        for (int ks = 0; ks < 4; ++ks) { const v4u w = {qlo[tb][ks].x, qlo[tb][ks].y, qhi[tb][ks].x, qhi[tb][ks].y}; o = __builtin_amdgcn_mfma_f32_16x16x32_bf16(sf[ks], __builtin_bit_cast(bf16x8, w), o, 0, 0, 0); }
        if (t < nvalid) *(f32x4*)(F.OGLA_ST() + (size_t)(row0 + t) * 1024 + hh * 256 + eb * 16 + 4 * fq) = o; }
}
__device__ __forceinline__ void gla_store_state(float* dst, int fr, int fq, const f32x4 (&sacc)[8]) {
#pragma unroll
    for (int db = 0; db < 8; ++db) { const int d0 = db * 16 + 4 * fq; dst[(size_t)(d0 + 0) * 256 + fr] = sacc[db].x; dst[(size_t)(d0 + 1) * 256 + fr] = sacc[db].y; dst[(size_t)(d0 + 2) * 256 + fr] = sacc[db].z; dst[(size_t)(d0 + 3) * 256 + fr] = sacc[db].w; }
}
__device__ __forceinline__ void gla_phase_g1(Frame& F, const Args& A, int l) {
    const int lane = F.lane_id(), fr = lane & 15, fq = lane >> 4;
    const int gw = F.vcu * NWAVES + F.wave, NGW = F.G * NWAVES;
    for (int it = gw; it < 2048; it += NGW) { const int bh = it >> 7, seg = (it >> 4) & 7, eb = it & 15;
        if (seg == 7) continue;
        f32x4 sacc[8];
#pragma unroll
        for (int db = 0; db < 8; ++db) sacc[db] = (f32x4){0.f, 0.f, 0.f, 0.f};
        const int slot0 = (((bh >> 2) * 32 + seg * 4) * 4) + (bh & 3);
#pragma unroll 1
        for (int c = 0; c < 4; ++c) gla_state_step(F, slot0 + 4 * c, eb, fr, fq, sacc);
        gla_store_state(F.SLOC() + ((size_t)(bh * 8 + seg) * 128) * 256 + eb * 16, fr, fq, sacc);
        if (eb == 0) {
#pragma unroll
            for (int k = 0; k < 2; ++k) { const int d = lane + 64 * k; float p = 1.f; for (int c = 0; c < 4; ++c) p *= F.DLG()[(slot0 + 4 * c) * 128 + d]; F.DSEG()[(bh * 8 + seg) * 128 + d] = p; } }
    }
    for (int it = gw; it < 2048; it += NGW) { const int sbh = it >> 4, eb = it & 15, sb = sbh >> 2, hh = sbh & 3;
        const size_t so = ((size_t)((l * 32 + sb) * 4 + hh)) * 32768 + eb * 16;
        const float* s0 = A.in[F.zo + I_SGLA] + so + fr;
        f32x4 sacc[8];
#pragma unroll
        for (int db = 0; db < 8; ++db) { const int d0 = db * 16 + 4 * fq; sacc[db].x = s0[(size_t)(d0 + 0) * 256]; sacc[db].y = s0[(size_t)(d0 + 1) * 256]; sacc[db].z = s0[(size_t)(d0 + 2) * 256]; sacc[db].w = s0[(size_t)(d0 + 3) * 256]; }
        gla_inter_step<1>(F, NP_ROWS + sb * 4, 4, hh, eb, fr, fq, sacc);
        gla_state_step(F, 512 + sbh, eb, fr, fq, sacc);
        gla_store_state(F.out + O_GLA_S + so, fr, fq, sacc);
    }
}
__device__ __forceinline__ void gla_phase_g2(Frame& F, const Args& A, int l) {
    const int lane = F.lane_id(), fr = lane & 15, fq = lane >> 4;
    const int gw = F.vcu * NWAVES + F.wave, NGW = F.G * NWAVES;
    for (int it = gw; it < 2048; it += NGW) { const int bh = it >> 7, seg = (it >> 4) & 7, eb = it & 15, hh = bh & 3;
        f32x4 sacc[8];
#pragma unroll
        for (int db = 0; db < 8; ++db) sacc[db] = (f32x4){0.f, 0.f, 0.f, 0.f};
        for (int i2 = 0; i2 < seg; ++i2) { const float* sl = F.SLOC() + ((size_t)(bh * 8 + i2) * 128) * 256 + eb * 16 + fr; const float* dg = F.DSEG() + (bh * 8 + i2) * 128;
#pragma unroll
            for (int db = 0; db < 8; ++db) { const int d0 = db * 16 + 4 * fq; const f32x4 dv = *(const f32x4*)(dg + d0);
                sacc[db].x = sacc[db].x * dv.x + sl[(size_t)(d0 + 0) * 256]; sacc[db].y = sacc[db].y * dv.y + sl[(size_t)(d0 + 1) * 256]; sacc[db].z = sacc[db].z * dv.z + sl[(size_t)(d0 + 2) * 256]; sacc[db].w = sacc[db].w * dv.w + sl[(size_t)(d0 + 3) * 256]; } }
        const int slot0 = (((bh >> 2) * 32 + seg * 4) * 4) + hh, row0 = (bh >> 2) * 2048 + seg * 256;
#pragma unroll 1
        for (int c = 0; c < 4; ++c) { gla_inter_step<4>(F, row0 + c * 64, 64, hh, eb, fr, fq, sacc); gla_state_step(F, slot0 + 4 * c, eb, fr, fq, sacc); }
        if (seg == 7) gla_store_state(F.out + O_GLA_P + ((size_t)(l * 16 + bh)) * 32768 + eb * 16, fr, fq, sacc);
    }
}
constexpr int AT_VT = 0, AT_VTS = 184, AT_BT = 64 * AT_VTS * 2, AT_END = AT_BT + 4 * 128 * 4;
__device__ __forceinline__ void attn_unit_mfma(Frame& F, const Args& A, int l, int u) {
    const int lane = F.lane_id(), wave = F.wave, tid = wave * 64 + lane, fr = lane & 15, fq = lane >> 4;
    const int span = u >> 1, g = u & 1, t0g = span * 32, tb0 = t0g & 2047;
    LAS bf16* VT = (LAS bf16*)(F.lds + AT_VT); LAS float* BT = (LAS float*)(F.lds + AT_BT);
    const bf16* Z = F.Z();
    const int rb = wave >> 2, hl = wave & 3, hd = g * 4 + hl, t0w = t0g + 16 * rb;
    bf16x8 qf[2], kf[9][2];
    { const bf16* qp = Z + (size_t)(t0w + fr) * ZW + ZQ + hd * 64 + 8 * fq; qf[0] = *(const bf16x8*)qp; qf[1] = *(const bf16x8*)(qp + 32); }
#pragma unroll
    for (int kb = 0; kb < 9; ++kb) { const int kl = 16 * (rb + kb) + fr; kf[kb][0] = (bf16x8){0, 0, 0, 0, 0, 0, 0, 0}; kf[kb][1] = (bf16x8){0, 0, 0, 0, 0, 0, 0, 0};
        if (tb0 - 128 + kl >= 0) { const bf16* kp = Z + (size_t)(t0g - 128 + kl) * ZW + ZK + g * 64 + 8 * fq; kf[kb][0] = *(const bf16x8*)kp; kf[kb][1] = *(const bf16x8*)(kp + 32); } }
#pragma unroll
    for (int pass = 0; pass < 2; ++pass) { const int key = pass * 128 + (tid >> 2), dch = (tid & 3) * 16;
        if (key < 160) { v4u v0 = {0u, 0u, 0u, 0u}, v1 = {0u, 0u, 0u, 0u};
            if (tb0 - 128 + key >= 0) { const v4u* vp = (const v4u*)(Z + (size_t)(t0g - 128 + key) * ZW + ZV + g * 64 + dch); v0 = vp[0]; v1 = vp[1]; }
            LAS bf16* vt = VT + dch * AT_VTS + key;
            vt[0 * AT_VTS] = (bf16)(v0.x & 0xffffu); vt[1 * AT_VTS] = (bf16)(v0.x >> 16); vt[2 * AT_VTS] = (bf16)(v0.y & 0xffffu); vt[3 * AT_VTS] = (bf16)(v0.y >> 16);
            vt[4 * AT_VTS] = (bf16)(v0.z & 0xffffu); vt[5 * AT_VTS] = (bf16)(v0.z >> 16); vt[6 * AT_VTS] = (bf16)(v0.w & 0xffffu); vt[7 * AT_VTS] = (bf16)(v0.w >> 16);
            vt[8 * AT_VTS] = (bf16)(v1.x & 0xffffu); vt[9 * AT_VTS] = (bf16)(v1.x >> 16); vt[10 * AT_VTS] = (bf16)(v1.y & 0xffffu); vt[11 * AT_VTS] = (bf16)(v1.y >> 16);
            vt[12 * AT_VTS] = (bf16)(v1.z & 0xffffu); vt[13 * AT_VTS] = (bf16)(v1.z >> 16); vt[14 * AT_VTS] = (bf16)(v1.w & 0xffffu); vt[15 * AT_VTS] = (bf16)(v1.w >> 16); } }
    BT[tid] = F.BTAB()[(g * 4) * 128 + tid];
    __syncthreads();
    f32x4 sacc[9];
#pragma unroll
    for (int kb = 0; kb < 9; ++kb) {
        f32x4 acc = {0.f, 0.f, 0.f, 0.f};
        acc = __builtin_amdgcn_mfma_f32_16x16x32_bf16(kf[kb][0], qf[0], acc, 0, 0, 0); acc = __builtin_amdgcn_mfma_f32_16x16x32_bf16(kf[kb][1], qf[1], acc, 0, 0, 0);
        sacc[kb] = acc; }
    const float sink = A.in[F.zo + I_SINKS][l * 8 + hd];
    float mx = -INFINITY;
#pragma unroll
    for (int kb = 0; kb < 9; ++kb)
#pragma unroll
        for (int i = 0; i < 4; ++i) { const int dist = 128 - 16 * kb + fr - 4 * fq - i, kpos = tb0 + 16 * rb + fr - dist;
            const bool valid = (dist >= 0) && (dist < 128) && (kpos >= 0);
            const float s = valid ? sacc[kb][i] * 0.125f + BT[hl * 128 + (dist & 127)] : -INFINITY;
            sacc[kb][i] = s; mx = fmaxf(mx, s); }
    mx = fmaxf(mx, __shfl_xor(mx, 16)); mx = fmaxf(mx, __shfl_xor(mx, 32)); mx = fmaxf(mx, sink);
    float ls = 0.f;
#pragma unroll
    for (int kb = 0; kb < 9; ++kb)
#pragma unroll
        for (int i = 0; i < 4; ++i) { const float p = __expf(sacc[kb][i] - mx); sacc[kb][i] = p; ls += p; }
    ls += __shfl_xor(ls, 16); ls += __shfl_xor(ls, 32);
    const float rden = 1.0f / (ls + __expf(sink - mx));
    bf16x8 pf[5];
#pragma unroll
    for (int pp = 0; pp < 5; ++pp) { const f32x4 a = sacc[2 * pp], b = (2 * pp + 1 < 9) ? sacc[2 * pp + 1] : (f32x4){0.f, 0.f, 0.f, 0.f};
        const unsigned w0 = pk2(a.x, a.y), w1 = pk2(a.z, a.w), w2 = pk2(b.x, b.y), w3 = pk2(b.z, b.w);
        v4u w = {w0, w1, w2, w3}; pf[pp] = __builtin_bit_cast(bf16x8, w); }
#pragma unroll
    for (int db = 0; db < 4; ++db) { f32x4 o = {0.f, 0.f, 0.f, 0.f};
#pragma unroll
        for (int pp = 0; pp < 5; ++pp) { const LAS bf16* vr = VT + (db * 16 + fr) * AT_VTS + 16 * (rb + 2 * pp) + 4 * fq;
            const u32x2 lo = *(const LAS u32x2*)vr; u32x2 hi = {0u, 0u}; if (2 * pp + 1 < 9) hi = *(const LAS u32x2*)(vr + 16);
            v4u w = {lo.x, lo.y, hi.x, hi.y};
            o = __builtin_amdgcn_mfma_f32_16x16x32_bf16(__builtin_bit_cast(bf16x8, w), pf[pp], o, 0, 0, 0); }
        *(u32x2*)(F.MIX() + (size_t)(t0w + fr) * DM + hd * 64 + db * 16 + 4 * fq) = pack4bf(o * rden); }
    __syncthreads();
}
template <int W>
__device__ __forceinline__ void pool_item_body(Frame& F, const Args& A, int l, int rblk, int g) {
    const int lane = F.lane_id(), fr = lane & 15, fq = lane >> 4;
    const int t = rblk * 16 + fr, pos = t & 2047;
    const bf16* Z = F.Z();
    const int nwin = (pos + 1) < W ? (pos + 1) : W; const float rc = 1.0f / (float)nwin;
    const bf16* wt = F.WPT() + ((size_t)(l * 4 + g) * 128) * 128; const float* psc = A.in[F.zo + I_PSCALE] + l * 512 + g * 128;
    f32x4 acc[8];
#pragma unroll
    for (int nb = 0; nb < 8; ++nb) acc[nb] = (f32x4){0.f, 0.f, 0.f, 0.f};
#pragma unroll 1
    for (int ks = 0; ks < 4; ++ks) { const bf16* up = Z + (size_t)t * ZW + ZU + g * 128 + ks * 32 + 8 * fq;
        v4u x[W];
#pragma unroll
        for (int i = 0; i < W; ++i) { x[i] = (v4u){0u, 0u, 0u, 0u}; if (i < nwin) x[i] = *(const v4u*)(up - (size_t)i * ZW); }
        float s[8];
#pragma unroll
        for (int j = 0; j < 8; ++j) s[j] = 0.f;
#pragma unroll
        for (int i = 0; i < W; ++i) { s[0] += bflo(x[i].x); s[1] += bfhi(x[i].x); s[2] += bflo(x[i].y); s[3] += bfhi(x[i].y); s[4] += bflo(x[i].z); s[5] += bfhi(x[i].z); s[6] += bflo(x[i].w); s[7] += bfhi(x[i].w); }
        const v4u u0 = x[0];
        v4u wv; wv.x = pk2(s[0] * rc - bflo(u0.x), s[1] * rc - bfhi(u0.x)); wv.y = pk2(s[2] * rc - bflo(u0.y), s[3] * rc - bfhi(u0.y)); wv.z = pk2(s[4] * rc - bflo(u0.z), s[5] * rc - bfhi(u0.z)); wv.w = pk2(s[6] * rc - bflo(u0.w), s[7] * rc - bfhi(u0.w));
        const bf16x8 df = __builtin_bit_cast(bf16x8, wv);
#pragma unroll
        for (int nb = 0; nb < 8; ++nb) { const bf16x8 a = *(const bf16x8*)(wt + (size_t)(nb * 16 + fr) * 128 + ks * 32 + 8 * fq); acc[nb] = __builtin_amdgcn_mfma_f32_16x16x32_bf16(a, df, acc[nb], 0, 0, 0); } }
#pragma unroll
    for (int nb = 0; nb < 8; ++nb) { const f32x4 sc = *(const f32x4*)(psc + nb * 16 + 4 * fq);
        *(u32x2*)(F.MIX() + (size_t)t * DM + 512 + g * 128 + nb * 16 + 4 * fq) = pack4bf(acc[nb] * sc); }
}
__device__ __forceinline__ void pool_item_mfma(Frame& F, const Args& A, int l, int rblk, int g) {
    if (g == 0) pool_item_body<2>(F, A, l, rblk, g); else if (g == 1) pool_item_body<4>(F, A, l, rblk, g); else if (g == 2) pool_item_body<8>(F, A, l, rblk, g); else pool_item_body<16>(F, A, l, rblk, g);
}
__device__ __forceinline__ void skinny_resid(Frame& F, const bf16* Asmp, const bf16* Bt, int K, const float* gate) {
    const int lane = F.lane_id(), wave = F.wave, fr = lane & 15, fq = lane >> 4;
    LAS float* red = (LAS float*)(F.lds + RING_OFF);
    const int kw = K >> 3, ksteps = kw >> 5;
    for (int u = F.vcu; u < 256; u += F.G) {
        const int c0 = (u >> 1) * 16, r0 = (u & 1) * 64;
        const bf16* bp = Bt + (size_t)(c0 + fr) * K + wave * kw + 8 * fq;
        const bf16* ap = Asmp + (size_t)(r0 + fr) * K + wave * kw + 8 * fq;
        f32x4 acc[4];
#pragma unroll
        for (int rb = 0; rb < 4; ++rb) acc[rb] = (f32x4){0.f, 0.f, 0.f, 0.f};
        bf16x8 bc = *(const bf16x8*)bp, ac[4];
#pragma unroll
        for (int rb = 0; rb < 4; ++rb) ac[rb] = *(const bf16x8*)(ap + (size_t)rb * 16 * K);
        for (int ks = 0; ks < ksteps; ++ks) {
            bf16x8 bn = bc, an[4];
#pragma unroll
            for (int rb = 0; rb < 4; ++rb) an[rb] = ac[rb];
            if (ks + 1 < ksteps) { bn = *(const bf16x8*)(bp + (ks + 1) * 32);
#pragma unroll
                for (int rb = 0; rb < 4; ++rb) an[rb] = *(const bf16x8*)(ap + (size_t)rb * 16 * K + (ks + 1) * 32); }
#pragma unroll
            for (int rb = 0; rb < 4; ++rb) acc[rb] = __builtin_amdgcn_mfma_f32_16x16x32_bf16(bc, ac[rb], acc[rb], 0, 0, 0);
            bc = bn;
#pragma unroll
            for (int rb = 0; rb < 4; ++rb) ac[rb] = an[rb];
        }
#pragma unroll
        for (int rb = 0; rb < 4; ++rb) *(LAS f32x4*)(red + ((wave * 4 + rb) * 64 + lane) * 4) = acc[rb];
        __syncthreads();
        if (wave < 4) { f32x4 s = {0.f, 0.f, 0.f, 0.f};
#pragma unroll
            for (int w2 = 0; w2 < 8; ++w2) s = s + *(const LAS f32x4*)(red + ((w2 * 4 + wave) * 64 + lane) * 4);
            const int r = r0 + wave * 16 + fr;
            const f32x4 g = *(const f32x4*)(gate + (size_t)(4 + (r >> 2)) * MODLD + c0 + 4 * fq);
            const size_t xo = (size_t)(NP_ROWS + r) * DM + c0 + 4 * fq; f32x4 xv = *(const f32x4*)(F.X() + xo); xv = xv + g * s; *(f32x4*)(F.X_ST() + xo) = xv; }
        __syncthreads();
    }
}

#ifndef EN_P0
#define EN_P0 1
#endif
#ifndef EN_G
#define EN_G 1
#endif
#ifndef EN_N
#define EN_N 1
#endif
#ifndef EN_M2
#define EN_M2 1
#endif
#ifndef EN_M3
#define EN_M3 1
#endif
#ifndef EN_M4
#define EN_M4 1
#endif
#ifndef EN_G1
#define EN_G1 1
#endif
#ifndef EN_GIN
#define EN_GIN 1
#endif
#ifndef EN_GOUT
#define EN_GOUT 1
#endif
#ifndef EN_GGU
#define EN_GGU 1
#endif
#ifndef EN_GDN
#define EN_GDN 1
#endif
#ifndef PROBE_DUP
#define PROBE_DUP 0
#endif
#ifndef MK_SINGLE
#define MK_SINGLE 1
#endif

#define PH_ARGS unsigned ldsb_, unsigned wslo_, unsigned wshi_, unsigned olo_, unsigned ohi_, int wave_, int vcu_, int G_, int probe_, int l_
#define PH_PASS ldsb, wslo, wshi, olo, ohi, F.wave, F.vcu, F.G, F.probe
#define PH_FRAME() Frame F; { const unsigned a0 = __builtin_amdgcn_readfirstlane(ldsb_), a1 = __builtin_amdgcn_readfirstlane(wslo_), a2 = __builtin_amdgcn_readfirstlane(wshi_), a3 = __builtin_amdgcn_readfirstlane(olo_), a4 = __builtin_amdgcn_readfirstlane(ohi_); \
    F.lds = (LAS unsigned char*)(unsigned long long)a0; F.MISC = (volatile LAS unsigned*)(F.lds + MISC_OFF); F.ws = (unsigned char*)(((unsigned long long)a2 << 32) | a1); F.out = (float*)(((unsigned long long)a4 << 32) | a3); \
    F.wave = __builtin_amdgcn_readfirstlane(wave_); F.vcu = __builtin_amdgcn_readfirstlane(vcu_); F.G = __builtin_amdgcn_readfirstlane(G_); F.zo = 0; F.probe = __builtin_amdgcn_readfirstlane(probe_); } \
    const int l = __builtin_amdgcn_readfirstlane(l_); (void)l; \
    const Args& args = *(const Args*)__builtin_amdgcn_kernarg_segment_ptr();
__device__ __forceinline__ void ph_prologue(PH_ARGS) { PH_FRAME(); p0_prologue(F, args); }
__device__ __forceinline__ void ph_norm1(PH_ARGS) { PH_FRAME(); norm_mod_rows(F, args.in[I_GMIX] + l * DM, F.MOD() + (size_t)l * MODW); }
__device__ __forceinline__ void ph_norm2(PH_ARGS) { PH_FRAME(); norm_mod_rows(F, args.in[I_GFFN] + l * DM, F.MOD() + (size_t)l * MODW + 6144); }
__device__ __forceinline__ void ph_final(PH_ARGS) { PH_FRAME(); final_norm_rows(F, args); }
__device__ __forceinline__ void ph_mixa(PH_ARGS) { PH_FRAME();
    const int gw = F.vcu * NWAVES + F.wave, NGW = F.G * NWAVES; LAS float* wscr = (LAS float*)(F.lds + RING_OFF + F.wave * 16384);
    for (int u = F.vcu; u < GL_NSLOT; u += F.G) gla_prep_unit(F, args, l, u);
    for (int u = F.vcu; u < 512; u += F.G) attn_unit_mfma(F, args, l, u);
    for (int it = gw; it < 512 * 4; it += NGW) pool_item_mfma(F, args, l, it >> 2, it & 3);
    { const int gwr = (F.G - 1 - F.vcu) + F.G * F.wave;
      for (int it = gwr; it < NS_ROWS * 8; it += NGW) attn_item(F, args, l, NP_ROWS + (it >> 3), it & 7, wscr);
      for (int it = gwr - 4 * F.G; it < NS_ROWS * 4; it += NGW) if (it >= 0) pool_item(F, args, l, NP_ROWS + (it >> 2), it & 3, wscr); }
    cache_outputs(F, args, l);
}
__device__ __forceinline__ void ph_gla1(PH_ARGS) { PH_FRAME(); gla_phase_g1(F, args, l); }
__device__ __forceinline__ void ph_gla2(PH_ARGS) { PH_FRAME(); gla_phase_g2(F, args, l); }
__device__ __forceinline__ void ph_mixc(PH_ARGS) { PH_FRAME(); const int gw = F.vcu * NWAVES + F.wave, NGW = F.G * NWAVES;
#pragma unroll 4
    for (int it = gw; it < NROWS * 4; it += NGW) gla_out_item(F, args, l, it >> 2, it & 3); }
constexpr int PH_PER_LAYER = 10, PH_LAYER0 = 1, PH_FINAL = PH_LAYER0 + DEPTH * PH_PER_LAYER, PH_COUNT = PH_FINAL + 1;
__global__ void __launch_bounds__(NTHREADS, 2) hymba_fwd(Args args) {
    extern __shared__ __attribute__((aligned(16))) unsigned char lds[];
    Frame F;
    F.lds = (LAS unsigned char*)lds;
    F.MISC = (volatile LAS unsigned*)(F.lds + MISC_OFF);
    F.wave = __builtin_amdgcn_readfirstlane((int)threadIdx.x >> 6); F.zo = 0; F.probe = 0;
    F.G = gridDim.x; { const int bx = blockIdx.x; F.vcu = (F.G % 8 == 0) ? (bx % 8) * (F.G / 8) + bx / 8 : bx; }
    F.ws = args.ws; F.out = args.out;
    gu32* const ctl = (gu32*)(F.ws + WS_CTL);
    for (int u = threadIdx.x; u < (LDS_BYTES - LDSCTL_OFF) / 4; u += NTHREADS) ((LAS unsigned*)(F.lds + LDSCTL_OFF))[u] = 0u;
    __syncthreads();
#if MK_SINGLE
    XcdBarrier bar = xcd_barrier_post((unsigned*)(ctl + CW_BAR), F.MISC + 8);
#define GRID_BAR() xcd_barrier(bar)
#else
#define GRID_BAR() do { } while (0)
#endif
    const int lo = args.ph_lo, hi = args.ph_hi;
    const unsigned ldsb = (unsigned)(unsigned long long)F.lds, wslo = (unsigned)(unsigned long long)F.ws, wshi = (unsigned)((unsigned long long)F.ws >> 32), olo = (unsigned)(unsigned long long)F.out, ohi = (unsigned)((unsigned long long)F.out >> 32);
#define IN(k) (lo <= (k) && (k) < hi)
#define BOTH(k) (IN(k) && IN((k) + 1))
#define PHASE_BEGIN() asm volatile("s_mov_b32 %0, 0" : "=s"(F.zo), "+s"(F.G), "+s"(F.vcu), "+s"(F.wave))
#define gw (F.vcu * NWAVES + F.wave)
#define NGW (F.G * NWAVES)
#define wscr ((LAS float*)(F.lds + RING_OFF + F.wave * 16384))

    if (EN_P0 && IN(0)) for (int rep_ = 0; rep_ < ((PROBE_DUP & 1) ? 2 : 1); ++rep_) { PHASE_BEGIN(); ph_prologue(PH_PASS, 0); if (BOTH(0)) GRID_BAR(); }
    for (int l = 0; l < DEPTH; ++l) {
        const int pb = PH_LAYER0 + l * PH_PER_LAYER;
        const float* modl = F.MOD() + (size_t)l * MODW;
        if (EN_N && IN(pb + 0)) for (int rep_ = 0; rep_ < ((PROBE_DUP & 2) ? 2 : 1); ++rep_) { PHASE_BEGIN(); ph_norm1(PH_PASS, l); if (BOTH(pb + 0)) GRID_BAR(); }
        if (EN_G && EN_GIN && IN(pb + 1)) for (int rep_ = 0; rep_ < ((PROBE_DUP & 4) ? 2 : 1); ++rep_) { PHASE_BEGIN();
            pg8::Gemm g{F.H(), F.Win_t() + (size_t)l * ZW * DM, MPAD, ZW, DM}; pg8::StaticOrder S; S.init(MPAD, ZW, F.G, (int)blockIdx.x);
            pg8::EpiZ E{F.Z(), ZW};
            pg8::gemm_phase<pg8::EpiZ, pg8::StaticOrder, true, true>(F.lds + RING_OFF, g, S, E, F.wave);
            if (BOTH(pb + 1)) GRID_BAR();
        }
        if (EN_M2 && IN(pb + 2)) for (int rep_ = 0; rep_ < ((PROBE_DUP & 8) ? 2 : 1); ++rep_) { PHASE_BEGIN();
            ph_mixa(PH_PASS, l);
            if (BOTH(pb + 2)) GRID_BAR();
        }
        if (EN_M3 && IN(pb + 3)) for (int rep_ = 0; rep_ < ((PROBE_DUP & 16) ? 2 : 1); ++rep_) { PHASE_BEGIN(); F.probe = ((PROBE_DUP & 16) && rep_ == 0) ? 1 : 0; ph_gla1(PH_PASS, l); if (BOTH(pb + 3)) GRID_BAR(); }
        if (EN_M3 && IN(pb + 4)) for (int rep_ = 0; rep_ < ((PROBE_DUP & 32) ? 2 : 1); ++rep_) { PHASE_BEGIN(); F.probe = ((PROBE_DUP & 32) && rep_ == 0) ? 1 : 0;
            ph_gla2(PH_PASS, l);
            if (BOTH(pb + 4)) GRID_BAR();
        }
        if (EN_M4 && IN(pb + 5)) for (int rep_ = 0; rep_ < ((PROBE_DUP & 64) ? 2 : 1); ++rep_) { PHASE_BEGIN(); ph_mixc(PH_PASS, l); if (BOTH(pb + 5)) GRID_BAR(); }
        if (EN_G && EN_GOUT && IN(pb + 6)) for (int rep_ = 0; rep_ < ((PROBE_DUP & 128) ? 2 : 1); ++rep_) { PHASE_BEGIN(); F.probe = ((PROBE_DUP & 128) && rep_ == 0) ? 1 : 0;
            pg8::Gemm g{F.MIX(), F.Wout_t() + (size_t)l * DM * DM, NP_ROWS, DM, DM}; pg8::StaticOrder S; S.init(NP_ROWS, DM, F.G, (int)blockIdx.x);
            pg8::EpiResid E{F.X(), modl + 4096, F.X_ST()};
            pg8::gemm_phase<pg8::EpiResid, pg8::StaticOrder, true, true>(F.lds + RING_OFF, g, S, E, F.wave);
            if ((PROBE_DUP & 512) && !F.probe) { F.probe = 1; skinny_resid(F, F.MIX() + (size_t)NP_ROWS * DM, F.Wout_t() + (size_t)l * DM * DM, DM, modl + 4096); F.probe = 0; }
            skinny_resid(F, F.MIX() + (size_t)NP_ROWS * DM, F.Wout_t() + (size_t)l * DM * DM, DM, modl + 4096);
            if (BOTH(pb + 6)) GRID_BAR();
        }
        if (EN_N && IN(pb + 7)) for (int rep_ = 0; rep_ < ((PROBE_DUP & 2) ? 2 : 1); ++rep_) { PHASE_BEGIN(); ph_norm2(PH_PASS, l); if (BOTH(pb + 7)) GRID_BAR(); }
        if (EN_G && EN_GGU && IN(pb + 8)) for (int rep_ = 0; rep_ < ((PROBE_DUP & 4) ? 2 : 1); ++rep_) { PHASE_BEGIN();
            pg8::Gemm g{F.H(), F.Wgu_t() + (size_t)l * NGU * DM, MPAD, NGU, DM}; pg8::StaticOrder S; S.init(MPAD, NGU, F.G, (int)blockIdx.x);
            pg8::EpiSwiGLU E{F.ACT(), DFF};
            pg8::gemm_phase<pg8::EpiSwiGLU, pg8::StaticOrder, true, true>(F.lds + RING_OFF, g, S, E, F.wave);
            if (BOTH(pb + 8)) GRID_BAR();
        }
        if (EN_G && EN_GDN && IN(pb + 9)) for (int rep_ = 0; rep_ < ((PROBE_DUP & 256) ? 2 : 1); ++rep_) { PHASE_BEGIN(); F.probe = ((PROBE_DUP & 256) && rep_ == 0) ? 1 : 0;
            pg8::Gemm g{F.ACT(), F.Wdn_t() + (size_t)l * DM * DFF, NP_ROWS, DM, DFF}; pg8::StaticOrder S; S.init(NP_ROWS, DM, F.G, (int)blockIdx.x);
            pg8::EpiResid E{F.X(), modl + 10240, F.X_ST()};
            pg8::gemm_phase<pg8::EpiResid, pg8::StaticOrder, true, true>(F.lds + RING_OFF, g, S, E, F.wave);
            if ((PROBE_DUP & 512) && !F.probe) { F.probe = 1; skinny_resid(F, F.ACT() + (size_t)NP_ROWS * DFF, F.Wdn_t() + (size_t)l * DM * DFF, DFF, modl + 10240); F.probe = 0; }
            skinny_resid(F, F.ACT() + (size_t)NP_ROWS * DFF, F.Wdn_t() + (size_t)l * DM * DFF, DFF, modl + 10240);
            if (BOTH(pb + 9)) GRID_BAR();
        }
    }
    if (IN(PH_FINAL)) { PHASE_BEGIN(); ph_final(PH_PASS, 0); }
#ifdef PROBE_SCALE
    GRID_BAR();
    { const size_t offs[11] = {O_Y, 16777216, O_WK_P, O_WV_P, O_POOL_P, O_GLA_P, O_WK_S, O_WV_S, O_POOL_S, O_GLA_S, O_END};
      const size_t gt_ = (size_t)(F.vcu * NWAVES + F.wave) * 64 + F.lane_id(), NGT_ = (size_t)F.G * NWAVES * 64;
      for (int k = 0; k < 10; ++k) { const float sc = 1.0f + 0.05f * (float)(k + 1); for (size_t i = offs[k] + gt_; i < offs[k + 1]; i += NGT_) F.out[i] *= sc; } }
#endif
#undef IN
#undef BOTH
#undef gw
#undef NGW
#undef wscr
}

extern "C" void kernel_launch(void* const* d_in, const int* in_sizes, int n_in, void* d_out, int out_size, void* d_ws, size_t ws_size, hipStream_t stream) {
    static int grid = 0;
    if (grid == 0) {
        if (n_in != 24 || out_size != (int)O_END || ws_size < WS_END) { fprintf(stderr, "kernel_launch: unexpected sizes n_in %d out %d ws %zu\n", n_in, out_size, ws_size); grid = -1; return; }
        int dev = 0, cus = 0;
        if (hipGetDevice(&dev) != hipSuccess || hipDeviceGetAttribute(&cus, hipDeviceAttributeMultiprocessorCount, dev) != hipSuccess) { grid = -1; return; }
        if (hipFuncSetAttribute((const void*)hymba_fwd, hipFuncAttributeMaxDynamicSharedMemorySize, LDS_BYTES) != hipSuccess) { fprintf(stderr, "kernel_launch: hipFuncSetAttribute failed\n"); grid = -1; return; }
        (void)hipGetLastError();
        grid = cus;
    }
    if (grid < 0) return;
    (void)hipMemsetAsync((char*)d_ws + WS_CTL, 0, CTL_ZERO_BYTES, stream);
    Args a{};
    for (int i = 0; i < 24; ++i) a.in[i] = (const float*)d_in[i];
    a.out = (float*)d_out; a.ws = (unsigned char*)d_ws;
#if MK_SINGLE
    a.ph_lo = 0; a.ph_hi = PH_COUNT;
    hipLaunchKernelGGL(hymba_fwd, dim3(grid), dim3(NTHREADS), LDS_BYTES, stream, a);
#else
    for (int p = 0; p < PH_COUNT; ++p) { a.ph_lo = p; a.ph_hi = p + 1; hipLaunchKernelGGL(hymba_fwd, dim3(grid), dim3(NTHREADS), LDS_BYTES, stream, a); }
#endif
}
```

```cpp
#include <hip/hip_runtime.h>
#include <cstdio>
#include <cstdint>
#include <cmath>
namespace pg8 {
#define PG8_LAS __attribute__((address_space(3)))
typedef unsigned short bf16_t;
typedef short bf16x8 __attribute__((ext_vector_type(8)));
typedef float f32x4 __attribute__((ext_vector_type(4)));
typedef unsigned u32x4 __attribute__((ext_vector_type(4)));
constexpr int BM = 256, BK = 64, HALF = 128, HTB = HALF * BK * 2  , STAGE_BYTES = 8 * HTB, NXCD = 8, WGM = 8;

__host__ __device__ __forceinline__ int lds_byte(int r, int c) { const int st = (r >> 4) * 2 + (c >> 5), rr = r & 15, cc = c & 31, ob = rr * 64 + cc * 2; return st * 1024 + (ob ^ (((ob >> 9) & 1) << 5)); }
__host__ __device__ __forceinline__ void stage_rc(int b, int& R, int& C) { const int st = b / 1024, sb = b % 1024, swz = sb ^ (((sb >> 9) & 1) << 5); R = (st >> 1) * 16 + swz / 64; C = (st & 1) * 32 + (swz % 64) / 2; }
__host__ __device__ __forceinline__ int perm32(int rho) { const int n = rho >> 4, i = rho & 15; return 8 * (i >> 2) + 4 * n + (i & 3); }

struct Unit { int pm, pn; };
struct Gemm { const bf16_t* A; const bf16_t* Bt; int M, N, K; };

struct StaticOrder {
    int nM, nN, nwg, G, c;
    __host__ __device__ void init(int M, int N, int G_, int c_) { nM = M / BM; nN = N / BM; nwg = nM * nN; G = G_; c = c_; }
    __host__ __device__ bool next(int i, Unit& u) const {
        const long L = (long)i * G + c; if (L >= nwg) return false;
        int wgid = (int)L; { const int q = nwg / NXCD, r = nwg % NXCD, xcd = wgid % NXCD, off = wgid / NXCD; wgid = (xcd < r ? xcd * (q + 1) : r * (q + 1) + (xcd - r) * q) + off; }
        const int nig = WGM * nN, gid = wgid / nig, fm = gid * WGM, gsz = (nM - fm) < WGM ? (nM - fm) : WGM;
        u.pm = fm + ((wgid % nig) % gsz); u.pn = (wgid % nig) / gsz; return true;
    }
    __device__ __forceinline__ void a_ready(const Unit&) const {}
    __device__ __forceinline__ void done(const Unit&) const {}
};

__device__ __forceinline__ unsigned cvt_pk_bf16(float lo, float hi) { unsigned r; asm volatile("v_cvt_pk_bf16_f32 %0, %1, %2" : "=v"(r) : "v"(lo), "v"(hi)); return r; }
typedef float f32x2 __attribute__((ext_vector_type(2)));
constexpr int MODLD_ = 49152;
__device__ __forceinline__ float fast_sigmoid(float x) { return __builtin_amdgcn_rcpf(1.0f + __expf(-x)); }
struct EpiZ {
    static constexpr bool PERM = true, AFTER_DRAIN = false;
    bf16_t* O; int ldc;
    __device__ __forceinline__ void operator()(const f32x4 (&acc)[2][2][4][2], const Unit& u, int wr, int wc, int fr, int fq) const {
        const int row0 = u.pm * BM + wr * 64 + fr, col0 = u.pn * BM + wc * 32 + 8 * fq;
#pragma unroll
        for (int ai = 0; ai < 2; ++ai)
#pragma unroll
            for (int m = 0; m < 4; ++m) { bf16_t* rowp = O + (size_t)(row0 + ai * HALF + m * 16) * ldc + col0;
#pragma unroll
                for (int bj = 0; bj < 2; ++bj) { const f32x4 v0 = acc[ai][bj][m][0], v1 = acc[ai][bj][m][1];
                    u32x4 w; w.x = cvt_pk_bf16(v0[0], v0[1]); w.y = cvt_pk_bf16(v0[2], v0[3]); w.z = cvt_pk_bf16(v1[0], v1[1]); w.w = cvt_pk_bf16(v1[2], v1[3]);
                    *(u32x4*)(rowp + bj * HALF) = w; } }
    }
};
struct EpiSwiGLU {
    static constexpr bool PERM = true, AFTER_DRAIN = false;
    bf16_t* O; int ldc;
    __device__ __forceinline__ void operator()(const f32x4 (&acc)[2][2][4][2], const Unit& u, int wr, int wc, int fr, int fq) const {
        const int row0 = u.pm * BM + wr * 64 + fr, col0 = u.pn * HALF + wc * 32 + 8 * fq;
#pragma unroll
        for (int ai = 0; ai < 2; ++ai)
#pragma unroll
            for (int m = 0; m < 4; ++m) { bf16_t* rowp = O + (size_t)(row0 + ai * HALF + m * 16) * ldc + col0;
                float r[8];
#pragma unroll
                for (int n = 0; n < 2; ++n)
#pragma unroll
                    for (int i = 0; i < 4; ++i) { const float g = acc[ai][0][m][n][i], up = acc[ai][1][m][n][i]; r[n * 4 + i] = g * fast_sigmoid(g) * up; }
                u32x4 w; w.x = cvt_pk_bf16(r[0], r[1]); w.y = cvt_pk_bf16(r[2], r[3]); w.z = cvt_pk_bf16(r[4], r[5]); w.w = cvt_pk_bf16(r[6], r[7]);
                *(u32x4*)rowp = w; }
    }
};
struct EpiResid {
    static constexpr bool PERM = false, AFTER_DRAIN = false;
    float* X; const float* gate; float* XS;
    __device__ __forceinline__ void operator()(const f32x4 (&acc)[2][2][4][2], const Unit& u, int wr, int wc, int fr, int fq) const {
        const int col0 = u.pn * BM + wc * 32 + 4 * fq;
        if (u.pm < 32) {
            const float* g = gate + (size_t)(u.pm >> 3) * MODLD_ + col0;
            f32x4 gv[2][2];
#pragma unroll
            for (int bj = 0; bj < 2; ++bj)
#pragma unroll
                for (int n = 0; n < 2; ++n) gv[bj][n] = *(const f32x4*)(g + bj * HALF + n * 16);
#pragma unroll
            for (int ai = 0; ai < 2; ++ai)
#pragma unroll
                for (int m = 0; m < 4; ++m) { const size_t xo = (size_t)(u.pm * BM + ai * HALF + wr * 64 + m * 16 + fr) * 2048 + col0; const float* xp = X + xo; float* xs = XS + xo;
#pragma unroll
                    for (int bj = 0; bj < 2; ++bj)
#pragma unroll
                        for (int n = 0; n < 2; ++n) { f32x4 xv = *(const f32x4*)(xp + bj * HALF + n * 16); xv = xv + gv[bj][n] * acc[ai][bj][m][n]; *(f32x4*)(xs + bj * HALF + n * 16) = xv; } }
        } else {
#pragma unroll
            for (int m = 0; m < 4; ++m) { const int rl = wr * 64 + m * 16 + fr;
                const float* g = gate + (size_t)(4 + (rl >> 2)) * MODLD_ + col0; float* xp = X + (size_t)(8192 + rl) * 2048 + col0;
#pragma unroll
                for (int bj = 0; bj < 2; ++bj)
#pragma unroll
                    for (int n = 0; n < 2; ++n) { const f32x4 gvv = *(const f32x4*)(g + bj * HALF + n * 16); f32x4 xv = *(const f32x4*)(xp + bj * HALF + n * 16);
                        xv = xv + gvv * acc[0][bj][m][n]; *(f32x4*)(xp + bj * HALF + n * 16) = xv; } }
        }
    }
};
struct EpiMod {
    static constexpr bool PERM = false, AFTER_DRAIN = false;
    float* M; const float* bias;
    __device__ __forceinline__ void operator()(const f32x4 (&acc)[2][2][4][2], const Unit& u, int wr, int wc, int fr, int fq) const {
        if (wr != 0) return;
        const int col0 = u.pn * BM + wc * 32 + 4 * fq;
#pragma unroll
        for (int m = 0; m < 3; ++m) { const int r = m * 16 + fr;
            if (r < 36) {
#pragma unroll
                for (int bj = 0; bj < 2; ++bj)
#pragma unroll
                    for (int n = 0; n < 2; ++n) { const f32x4 bv = *(const f32x4*)(bias + col0 + bj * HALF + n * 16);
                        *(f32x4*)(M + (size_t)r * MODLD_ + col0 + bj * HALF + n * 16) = acc[0][bj][m][n] + bv; } } }
    }
};

template <class Epi, class Sched, bool ALIGN_EPI = false, bool SP2 = false>
__device__ __forceinline__ void gemm_phase(PG8_LAS unsigned char* lds, const Gemm g, const Sched& S, const Epi& E, int wid_in) {
    int lane_ = (int)__builtin_amdgcn_mbcnt_hi(~0u, __builtin_amdgcn_mbcnt_lo(~0u, 0u)); asm volatile("" : "+v"(lane_));
    const int wid = __builtin_amdgcn_readfirstlane(wid_in), lane = lane_, tid = wid * 64 + lane, wr = wid >> 2, wc = wid & 3, fr = lane & 15, fq = lane >> 4;
    int K_ = g.K; asm volatile("" : "+s"(K_));
    const int K = K_, nt = K / BK;
    unsigned voffA[2], voffB[2];
#pragma unroll
    for (int i = 0; i < 2; ++i) { int R, C; stage_rc(tid * 16 + i * 8192, R, C); const int Rb = Epi::PERM ? ((R & ~31) + perm32(R & 31)) : R;
        voffA[i] = (unsigned)(R * K + C) * 2u; voffB[i] = (unsigned)(Rb * K + C) * 2u; }
    const size_t kstep = (size_t)(BK * 2);
    const size_t hstep = (size_t)HALF * K * 2;
    const size_t tstep = 2 * hstep;
    const unsigned ldsw = (unsigned)wid * 1024u;
    const int aoff = lds_byte(wr * 64 + fr, fq * 8), boff = lds_byte(wc * 32 + fr, fq * 8);
#define PG8_SA(b, h) (((b) * 2 + (h)) * HTB)
#define PG8_SB(b, h) ((4 + (b) * 2 + (h)) * HTB)
#define PG8_STAGE(bufoff, gbase, voff) do { _Pragma("unroll") for (int _i = 0; _i < 2; ++_i) \
        __builtin_amdgcn_global_load_lds((const unsigned*)((const char*)(gbase) + (voff)[_i]), (PG8_LAS unsigned*)(lds + (bufoff) + ldsw + _i * 8192), 16, 0, 0); } while (0)
#define PG8_LDA(dst, b, h) do { _Pragma("unroll") for (int m = 0; m < 4; ++m) _Pragma("unroll") for (int k = 0; k < 2; ++k) dst[m][k] = *(const PG8_LAS bf16x8*)(lds + PG8_SA(b, h) + aoff + m * 2048 + k * 1024); } while (0)
#define PG8_LDB(dst, b, h) do { _Pragma("unroll") for (int n = 0; n < 2; ++n) _Pragma("unroll") for (int k = 0; k < 2; ++k) dst[n][k] = *(const PG8_LAS bf16x8*)(lds + PG8_SB(b, h) + boff + n * 2048 + k * 1024); } while (0)
#define PG8_MMA(ai, bj, At, Bt) do { __builtin_amdgcn_s_setprio(1); _Pragma("unroll") for (int m = 0; m < 4; ++m) _Pragma("unroll") for (int n = 0; n < 2; ++n) _Pragma("unroll") for (int k = 0; k < 2; ++k) \
        acc[ai][bj][m][n] = __builtin_amdgcn_mfma_f32_16x16x32_bf16(Bt[n][k], At[m][k], acc[ai][bj][m][n], 0, 0, 0); __builtin_amdgcn_s_setprio(0); } while (0)
#define PG8_WAIT_V(n) asm volatile("s_waitcnt vmcnt(" #n ")" ::: "memory")
#define PG8_WAIT_L(n) asm volatile("s_waitcnt lgkmcnt(" #n ")" ::: "memory")
#define PG8_BAR __builtin_amdgcn_s_barrier()
#define PG8_SCHED __builtin_amdgcn_sched_barrier(0)
    Unit cur, nxt; int ui = 0;
    if (!S.next(0, cur)) return;
    f32x4 acc[2][2][4][2];
#pragma unroll
    for (int a = 0; a < 2; ++a)
#pragma unroll
        for (int b = 0; b < 2; ++b)
#pragma unroll
            for (int m = 0; m < 4; ++m)
#pragma unroll
                for (int n = 0; n < 2; ++n) acc[a][b][m][n] = (f32x4){0.f, 0.f, 0.f, 0.f};
    bf16x8 At[4][2], B0[2][2], B1[2][2];
    const char* cA = (const char*)g.A + (size_t)cur.pm * tstep; const char* cB = (const char*)g.Bt + (size_t)cur.pn * tstep;
    S.a_ready(cur);
    if constexpr (SP2) {
        PG8_STAGE(PG8_SB(0, 0), cB, voffB); PG8_STAGE(PG8_SB(0, 1), cB + hstep, voffB); PG8_STAGE(PG8_SA(0, 0), cA, voffA); PG8_STAGE(PG8_SA(0, 1), cA + hstep, voffA);
        if (wr == 1) PG8_BAR;
        PG8_WAIT_V(2); PG8_BAR;
        PG8_STAGE(PG8_SB(1, 0), cB + kstep, voffB); PG8_STAGE(PG8_SA(1, 0), cA + kstep, voffA); PG8_STAGE(PG8_SB(1, 1), cB + hstep + kstep, voffB);
        PG8_WAIT_V(6); PG8_BAR;
    } else {
        PG8_STAGE(PG8_SB(0, 0), cB, voffB); PG8_STAGE(PG8_SA(0, 0), cA, voffA); PG8_STAGE(PG8_SB(0, 1), cB + hstep, voffB); PG8_STAGE(PG8_SA(0, 1), cA + hstep, voffA);
        if (wr == 1) PG8_BAR;
        PG8_WAIT_V(4); PG8_BAR;
        PG8_STAGE(PG8_SB(1, 0), cB + kstep, voffB); PG8_STAGE(PG8_SA(1, 0), cA + kstep, voffA); PG8_STAGE(PG8_SB(1, 1), cB + hstep + kstep, voffB);
        PG8_WAIT_V(6); PG8_BAR;
    }
    for (;;) {
        const bool has_next = S.next(ui + 1, nxt);
        const char* nA = has_next ? (const char*)g.A + (size_t)nxt.pm * tstep : cA; const char* nB = has_next ? (const char*)g.Bt + (size_t)nxt.pn * tstep : cB;
        for (int t = 0; t < nt; t += 2) {
            const bool last = (t == nt - 2);
            const char* a1 = cA + (size_t)(t + 1) * kstep;
            const char* a2 = last ? nA : cA + (size_t)(t + 2) * kstep; const char* b2 = last ? nB : cB + (size_t)(t + 2) * kstep;
            const char* a3 = a2 + kstep; const char* b3 = b2 + kstep;
            if (last && has_next) S.a_ready(nxt);
            if constexpr (SP2) {
            PG8_LDB(B0, 0, 0); PG8_LDB(B1, 0, 1); PG8_SCHED; PG8_LDA(At, 0, 0); PG8_STAGE(PG8_SA(1, 1), a1 + hstep, voffA);
            PG8_WAIT_V(8); PG8_WAIT_L(0); PG8_BAR; PG8_MMA(0, 0, At, B0); PG8_MMA(0, 1, At, B1); PG8_BAR; PG8_SCHED;
            PG8_LDA(At, 0, 1); PG8_STAGE(PG8_SB(0, 0), b2, voffB); PG8_STAGE(PG8_SB(0, 1), b2 + hstep, voffB); PG8_STAGE(PG8_SA(0, 0), a2, voffA);
            PG8_WAIT_V(8); PG8_WAIT_L(0); PG8_BAR; PG8_MMA(1, 0, At, B0); PG8_MMA(1, 1, At, B1); PG8_BAR; PG8_SCHED;
            PG8_LDB(B0, 1, 0); PG8_LDB(B1, 1, 1); PG8_SCHED; PG8_LDA(At, 1, 0); PG8_STAGE(PG8_SA(0, 1), a2 + hstep, voffA);
            PG8_WAIT_V(8); PG8_WAIT_L(0); PG8_BAR; PG8_MMA(0, 0, At, B0); PG8_MMA(0, 1, At, B1); PG8_BAR; PG8_SCHED;
            PG8_LDA(At, 1, 1); PG8_STAGE(PG8_SB(1, 0), b3, voffB); PG8_STAGE(PG8_SB(1, 1), b3 + hstep, voffB); PG8_STAGE(PG8_SA(1, 0), a3, voffA);
            PG8_WAIT_V(8); PG8_WAIT_L(0); PG8_BAR; PG8_MMA(1, 0, At, B0); PG8_MMA(1, 1, At, B1); PG8_BAR; PG8_SCHED;
            } else {
            PG8_LDB(B0, 0, 0); PG8_SCHED; PG8_LDA(At, 0, 0); PG8_STAGE(PG8_SA(1, 1), a1 + hstep, voffA);
            PG8_WAIT_L(8); PG8_BAR; PG8_WAIT_L(0); PG8_MMA(0, 0, At, B0); PG8_BAR; PG8_SCHED;
            PG8_LDB(B1, 0, 1); PG8_STAGE(PG8_SB(0, 0), b2, voffB);
            PG8_BAR; PG8_WAIT_L(0); PG8_MMA(0, 1, At, B1); PG8_BAR;
            PG8_LDA(At, 0, 1); PG8_STAGE(PG8_SA(0, 0), a2, voffA);
            PG8_BAR; PG8_WAIT_L(0); PG8_MMA(1, 0, At, B0); PG8_BAR; PG8_SCHED;
            PG8_STAGE(PG8_SB(0, 1), b2 + hstep, voffB);
            PG8_WAIT_V(6); PG8_BAR; PG8_MMA(1, 1, At, B1); PG8_BAR;
            PG8_LDB(B0, 1, 0); PG8_SCHED; PG8_LDA(At, 1, 0); PG8_STAGE(PG8_SA(0, 1), a2 + hstep, voffA);
            PG8_WAIT_L(8); PG8_BAR; PG8_WAIT_L(0); PG8_MMA(0, 0, At, B0); PG8_BAR; PG8_SCHED;
            PG8_LDB(B1, 1, 1); PG8_STAGE(PG8_SB(1, 0), b3, voffB);
            PG8_BAR; PG8_WAIT_L(0); PG8_MMA(0, 1, At, B1); PG8_BAR;
            PG8_LDA(At, 1, 1); PG8_STAGE(PG8_SA(1, 0), a3, voffA);
            PG8_BAR; PG8_WAIT_L(0); PG8_MMA(1, 0, At, B0); PG8_BAR; PG8_SCHED;
            PG8_STAGE(PG8_SB(1, 1), b3 + hstep, voffB);
            PG8_WAIT_V(6); PG8_BAR; PG8_MMA(1, 1, At, B1); PG8_BAR;
            }
        }
        if constexpr (ALIGN_EPI) { if (wr == 0) PG8_BAR; }
        if constexpr (!Epi::AFTER_DRAIN) { E(acc, cur, wr, wc, fr, fq); S.done(cur); }
        if (!has_next) break;
#pragma unroll
        for (int a = 0; a < 2; ++a)
#pragma unroll
            for (int b = 0; b < 2; ++b)
#pragma unroll
                for (int m = 0; m < 4; ++m)
#pragma unroll
                    for (int n = 0; n < 2; ++n) acc[a][b][m][n] = (f32x4){0.f, 0.f, 0.f, 0.f};
        cur = nxt; cA = nA; cB = nB; ++ui;
        if constexpr (ALIGN_EPI) { if (wr == 1) PG8_BAR; }
    }
    PG8_WAIT_V(0);
    if constexpr (!ALIGN_EPI) { if (wr == 0) PG8_BAR; }
    PG8_BAR;
    if constexpr (Epi::AFTER_DRAIN) { E.fused(acc, cur, wr, wc, fr, fq, lds, wid, lane); S.done(cur); }
#undef PG8_SA
#undef PG8_SB
#undef PG8_STAGE
#undef PG8_LDA
#undef PG8_LDB
#undef PG8_MMA
#undef PG8_WAIT_V
#undef PG8_WAIT_L
#undef PG8_BAR
#undef PG8_SCHED
}
}
#define GAS __attribute__((address_space(1)))
#define LAS __attribute__((address_space(3)))
typedef unsigned short bf16;
typedef unsigned v4u __attribute__((ext_vector_type(4)));
typedef float f32x4 __attribute__((ext_vector_type(4)));
typedef short bf16x8 __attribute__((ext_vector_type(8)));
typedef GAS unsigned gu32;
typedef GAS unsigned long long gu64;
#define RLX_AGENT __ATOMIC_RELAXED, __HIP_MEMORY_SCOPE_AGENT
#define LDS_WAIT() asm volatile("s_waitcnt lgkmcnt(0)" ::: "memory")
#define VM_WAIT() asm volatile("s_waitcnt vmcnt(0)" ::: "memory")
__device__ __forceinline__ unsigned long long rt() { return __builtin_amdgcn_s_memrealtime(); }
__device__ __forceinline__ unsigned f2bf(float f) { unsigned u = __builtin_bit_cast(unsigned, f); return (u + 0x7fffu + ((u >> 16) & 1u)) >> 16; }
__device__ __forceinline__ unsigned pk2(float lo, float hi) { return f2bf(lo) | (f2bf(hi) << 16); }

#define XB_TMO      128
#define XB_XCNT(j)  (256  + 64 * (j))
#define XB_XSUB(j)  (1280 + 64 * (j))
#define XB_XGEN(j)  (2304 + 64 * (j))
#define XB_TOP      3328
#define XB_TOPGEN   3392
#define XCD_BAR_WORDS 3456
#define XB_SPIN_CAP (1u << 18)

__device__ __forceinline__ unsigned xb_ld(unsigned* p)              { return __hip_atomic_load(p, __ATOMIC_RELAXED, __HIP_MEMORY_SCOPE_AGENT); }
__device__ __forceinline__ unsigned xb_add(unsigned* p, unsigned v) { return __hip_atomic_fetch_add(p, v, __ATOMIC_RELAXED, __HIP_MEMORY_SCOPE_AGENT); }
__device__ __forceinline__ unsigned xb_xcc_id() { return (unsigned)__builtin_amdgcn_s_getreg((3 << 11) | 20) & 0xFu; }
#define XB_SPIN(cond, bar) do { unsigned _sp = 0; while (cond) { __builtin_amdgcn_s_sleep(1); \
    if ((++_sp & 255u) == 0u) { if (xb_ld(&(bar)[XB_TMO])) break; if (_sp > XB_SPIN_CAP) { atomicAdd(&(bar)[XB_TMO], 1u); break; } } } } while (0)

struct XcdBarrier {
    unsigned* bar; unsigned x;
    volatile LAS unsigned* st;
};

__device__ __forceinline__ XcdBarrier xcd_barrier_post(unsigned* bar, volatile LAS unsigned* st) {
    XcdBarrier b; b.bar = bar; b.x = xb_xcc_id(); b.st = st;
    if (threadIdx.x == 0) (void)xb_add(&bar[XB_XCNT(b.x)], 1u);
    return b;
}
__device__ __forceinline__ void xcd_barrier_complete(unsigned* bar, unsigned x, unsigned& nloc, unsigned& nx) {
    const unsigned G = gridDim.x * gridDim.y * gridDim.z;
    unsigned sum, cnt, mine, sp = 0u;
    for (;;) {
        sum = 0u; cnt = 0u; mine = 0u;
#pragma unroll
        for (unsigned j = 0; j < 16; ++j) { const unsigned c = xb_ld(&bar[XB_XCNT(j)]); sum += c; cnt += (c > 0u) ? 1u : 0u; mine = (j == x) ? c : mine; }
        if (sum == G) break;
        __builtin_amdgcn_s_sleep(1);
        if ((++sp & 255u) == 0u) { if (xb_ld(&bar[XB_TMO])) break; if (sp > XB_SPIN_CAP) { atomicAdd(&bar[XB_TMO], 1u); break; } }
    }
    nloc = mine > 0u ? mine : 1u; nx = cnt > 0u ? cnt : 1u;
}

__device__ __forceinline__ void xcd_barrier(const XcdBarrier& b) {
    asm volatile("s_waitcnt vmcnt(0)" ::: "memory");
    __syncthreads();
    if (threadIdx.x == 0) {
        unsigned* bar = b.bar;
        __builtin_amdgcn_s_waitcnt(0);
        unsigned nloc = b.st[0], nx = b.st[1];
        if (nloc == 0u) { xcd_barrier_complete(bar, b.x, nloc, nx); b.st[0] = nloc; b.st[1] = nx; }
        const unsigned old = xb_add(&bar[XB_XSUB(b.x)], 1u);
        const unsigned gen = old / nloc;
        if (old + 1u == (gen + 1u) * nloc) {
            __builtin_amdgcn_fence(__ATOMIC_RELEASE, "agent");
            asm volatile("s_waitcnt vmcnt(0)" ::: "memory");
            const unsigned og = xb_add(&bar[XB_TOP], 1u);
            const unsigned tg = og / nx;
            if (og + 1u == (tg + 1u) * nx) xb_add(&bar[XB_TOPGEN], 1u);
            else XB_SPIN(xb_ld(&bar[XB_TOPGEN]) == tg, bar);
            __builtin_amdgcn_fence(__ATOMIC_ACQUIRE, "agent");
            xb_add(&bar[XB_XGEN(b.x)], 1u);
            asm volatile("s_waitcnt vmcnt(0)" ::: "memory");
        } else {
            XB_SPIN(xb_ld(&bar[XB_XGEN(b.x)]) == gen, bar);
            __builtin_amdgcn_fence(__ATOMIC_ACQUIRE, "agent");
            asm volatile("s_waitcnt vmcnt(0)" ::: "memory");
        }
    }
    __syncthreads();
}

constexpr int NWAVES = 8, NTHREADS = 512;
constexpr int DM = 2048, NP_ROWS = 8192, NS_ROWS = 128, NROWS = 8320, MPAD = 8448;
constexpr int DEPTH = 4, NBATCH = 36;
constexpr int INW = 4368, ZW = 4608;
constexpr int ZQ = 0, ZK = 512, ZV = 640, ZU = 768, GQ = 1280, GK = 1792, GV = 2304, GG = 3328, GA = 4352;
constexpr int DFF = 5632, NGU = 11264, MODW = 12288, MODLD = 49152;
constexpr float EPS = 1e-6f;
constexpr size_t O_Y = 0, O_WK_P = 17039360, O_WV_P = 17301504, O_POOL_P = 17563648, O_GLA_P = 17686528,
                 O_WK_S = 19783680, O_WV_S = 21880832, O_POOL_S = 23977984, O_GLA_S = 24961024, O_END = 41738240;
constexpr size_t MiB = 1u << 20;
constexpr size_t WS_CTL = 0, CTL_ZERO_BYTES = 1 * MiB;
constexpr size_t WS_WADA = 1 * MiB;
constexpr size_t WS_WIN  = WS_WADA + 192 * MiB;
constexpr size_t WS_WOUT = WS_WIN + 72 * MiB;
constexpr size_t WS_WGU  = WS_WOUT + 32 * MiB;
constexpr size_t WS_WDN  = WS_WGU + 176 * MiB;
constexpr size_t WS_X    = WS_WDN + 88 * MiB;
constexpr size_t WS_H    = WS_X + 66 * MiB;
constexpr size_t WS_Z    = WS_H + 33 * MiB;
constexpr size_t WS_MIX  = WS_Z + 75 * MiB;
constexpr size_t WS_ACT  = WS_MIX + 33 * MiB;
constexpr size_t WS_OGLA = WS_ACT + 91 * MiB;
constexpr size_t WS_LA   = WS_OGLA + 33 * MiB;
constexpr size_t WS_MOD  = WS_LA + 17 * MiB;
constexpr size_t WS_SC   = WS_MOD + 7 * MiB;
constexpr size_t WS_BTAB = WS_SC + 1 * MiB;
constexpr size_t WS_WPT  = WS_BTAB + 1 * MiB;
constexpr size_t WS_QDG  = WS_WPT + 1 * MiB;
constexpr size_t WS_KDTG = WS_QDG + 9 * MiB;
constexpr size_t WS_VTG  = WS_KDTG + 11 * MiB;
constexpr size_t WS_DLG  = WS_VTG + 21 * MiB;
constexpr size_t WS_DUMMY = WS_DLG + 1 * MiB;
constexpr size_t WS_END  = WS_DUMMY + 66 * MiB;
constexpr int CW_BAR = 4096;
constexpr int RING_OFF = 0, RING_BYTES = 131072;
constexpr int LDSCTL_OFF = RING_BYTES, MISC_OFF = LDSCTL_OFF + 320;
constexpr int LDS_BYTES = 147456;

struct Args { const float* in[24]; float* out; unsigned char* ws; int ph_lo, ph_hi; };
struct Frame {
    LAS unsigned char* lds;
    volatile LAS unsigned* MISC;
    int wave, vcu, G; int zo; int probe;
    __device__ __forceinline__ float* X_ST() const { return (float*)(ws + (probe ? WS_DUMMY : WS_X)); }
    __device__ __forceinline__ float* OGLA_ST() const { return (float*)(ws + (probe ? WS_DUMMY : WS_OGLA)); }
    __device__ __forceinline__ int lane_id() const { return (int)__builtin_amdgcn_mbcnt_hi(~0u, __builtin_amdgcn_mbcnt_lo(~0u, 0u)); }
    unsigned char* ws; float* out;
    __device__ __forceinline__ bf16* Wada_t() const { return (bf16*)(ws + WS_WADA); }
    __device__ __forceinline__ bf16* Win_t() const { return (bf16*)(ws + WS_WIN); }
    __device__ __forceinline__ bf16* Wout_t() const { return (bf16*)(ws + WS_WOUT); }
    __device__ __forceinline__ bf16* Wgu_t() const { return (bf16*)(ws + WS_WGU); }
    __device__ __forceinline__ bf16* Wdn_t() const { return (bf16*)(ws + WS_WDN); }
    __device__ __forceinline__ float* X() const { return (float*)(ws + WS_X); }
    __device__ __forceinline__ bf16* H() const { return (bf16*)(ws + WS_H); }
    __device__ __forceinline__ bf16* Z() const { return (bf16*)(ws + WS_Z); }
    __device__ __forceinline__ bf16* MIX() const { return (bf16*)(ws + WS_MIX); }
    __device__ __forceinline__ bf16* ACT() const { return (bf16*)(ws + WS_ACT); }
    __device__ __forceinline__ float* OGLA() const { return (float*)(ws + WS_OGLA); }
    __device__ __forceinline__ float* SLOC() const { return (float*)(ws + WS_LA); }
    __device__ __forceinline__ float* DSEG() const { return (float*)(ws + WS_LA + 16 * MiB); }
    __device__ __forceinline__ float* MOD() const { return (float*)(ws + WS_MOD); }
    __device__ __forceinline__ bf16* SC() const { return (bf16*)(ws + WS_SC); }
    __device__ __forceinline__ float* BTAB() const { return (float*)(ws + WS_BTAB); }
    __device__ __forceinline__ bf16* WPT() const { return (bf16*)(ws + WS_WPT); }
    __device__ __forceinline__ bf16* QDG() const { return (bf16*)(ws + WS_QDG); }
    __device__ __forceinline__ bf16* KDTG() const { return (bf16*)(ws + WS_KDTG); }
    __device__ __forceinline__ bf16* VTG() const { return (bf16*)(ws + WS_VTG); }
    __device__ __forceinline__ float* DLG() const { return (float*)(ws + WS_DLG); }
};
enum { I_XP = 0, I_XS, I_CK, I_CV, I_SPOOL, I_SGLA, I_CP, I_CS, I_WADA, I_BADA, I_GMIX, I_GFFN, I_WIN, I_WOUT, I_RELB, I_SINKS, I_WPOOL, I_PSCALE, I_WA2, I_BA2, I_GGLA, I_WGU, I_WDN, I_GFIN };

__device__ __forceinline__ float bf2f(unsigned short b) { return __uint_as_float((unsigned)b << 16); }
__device__ __forceinline__ float bflo(unsigned w) { return __uint_as_float(w << 16); }
__device__ __forceinline__ float bfhi(unsigned w) { return __uint_as_float(w & 0xffff0000u); }
__device__ __forceinline__ float wave_sum(float v) {
#pragma unroll
    for (int o = 1; o < 64; o <<= 1) v += __shfl_xor(v, o);
    return v;
}
__device__ __forceinline__ float wave_max(float v) {
#pragma unroll
    for (int o = 1; o < 64; o <<= 1) v = fmaxf(v, __shfl_xor(v, o));
    return v;
}
__device__ __forceinline__ int t5_bucket(int n) {
    if (n < 16) return n;
    return 16 + (n >= 19) + (n >= 21) + (n >= 24) + (n >= 27) + (n >= 31) + (n >= 35) + (n >= 40) + (n >= 46) + (n >= 52) + (n >= 59) + (n >= 67) + (n >= 77) + (n >= 87) + (n >= 99) + (n >= 113);
}

template <int MODE>
__device__ __forceinline__ void transpose_item(const float* W, int K, int N, int nblk, bf16* WT, int row_off, LAS float* scr, int item, int lane) {
    const int kb = item / nblk, nb = item % nblk, k0 = 64 * kb, n0 = 32 * nb;
    const int nn = n0 + (lane & 31); const bool ok = nn < N;
    float wv[32];
#pragma unroll
    for (int i = 0; i < 32; ++i) { const int kk = 2 * i + (lane >> 5); wv[i] = ok ? W[(size_t)(k0 + kk) * N + nn] : 0.f; }
#pragma unroll
    for (int i = 0; i < 32; ++i) { const int kk = 2 * i + (lane >> 5); scr[kk * 33 + (lane & 31)] = wv[i]; }
    LDS_WAIT(); asm volatile("" ::: "memory");
    const int c = lane & 7;
#pragma unroll
    for (int j = 0; j < 4; ++j) { const int n = (lane >> 3) + 8 * j; const LAS float* s = scr + (8 * c) * 33 + n;
        v4u o; o.x = pk2(s[0 * 33], s[1 * 33]); o.y = pk2(s[2 * 33], s[3 * 33]); o.z = pk2(s[4 * 33], s[5 * 33]); o.w = pk2(s[6 * 33], s[7 * 33]);
        int orow = n0 + n;
        if (MODE == 1) { orow = (orow < DFF) ? ((orow >> 7) * 256 + (orow & 127)) : (((orow - DFF) >> 7) * 256 + 128 + ((orow - DFF) & 127)); }
        *(GAS v4u*)(WT + (size_t)(row_off + orow) * K + k0 + 8 * c) = o; }
    LDS_WAIT(); asm volatile("" ::: "memory");
}
__device__ __forceinline__ float silu_f(float a) { return a * __builtin_amdgcn_rcpf(1.0f + __expf(-a)); }
__device__ __forceinline__ void adaln_item(Frame& F, const Args& A, int item, LAS float* scr) {
    const int lane = F.lane_id(), fr = lane & 15, fq = lane >> 4;
    const int l = item / 384, nb = item - l * 384, n0 = 32 * nb;
    const float* W = A.in[F.zo + I_WADA] + (size_t)l * DM * MODW + n0 + (lane & 31) + (size_t)(lane >> 5) * MODW;
    f32x4 acc[3][2];
#pragma unroll
    for (int rb = 0; rb < 3; ++rb) { acc[rb][0] = (f32x4){0.f, 0.f, 0.f, 0.f}; acc[rb][1] = (f32x4){0.f, 0.f, 0.f, 0.f}; }
    float wv[32];
#pragma unroll
    for (int i = 0; i < 32; ++i) wv[i] = W[(size_t)(2 * i) * MODW];
    for (int kb = 0; kb < 32; ++kb) {
#pragma unroll
        for (int i = 0; i < 32; ++i) scr[(2 * i + (lane >> 5)) * 33 + (lane & 31)] = wv[i];
        if (kb + 1 < 32) {
#pragma unroll
            for (int i = 0; i < 32; ++i) wv[i] = W[(size_t)(64 * (kb + 1) + 2 * i) * MODW];
        }
        LDS_WAIT(); asm volatile("" ::: "memory");
#pragma unroll
        for (int ks = 0; ks < 2; ++ks) {
            bf16x8 bfr[2];
#pragma unroll
            for (int nk = 0; nk < 2; ++nk) { const LAS float* s = scr + (32 * ks + 8 * fq) * 33 + 16 * nk + fr;
                v4u w; w.x = pk2(s[0 * 33], s[1 * 33]); w.y = pk2(s[2 * 33], s[3 * 33]); w.z = pk2(s[4 * 33], s[5 * 33]); w.w = pk2(s[6 * 33], s[7 * 33]); bfr[nk] = __builtin_bit_cast(bf16x8, w); }
#pragma unroll
            for (int rb = 0; rb < 3; ++rb) { const bf16x8 af = *(const bf16x8*)(F.SC() + (size_t)(rb * 16 + fr) * DM + 64 * kb + 32 * ks + 8 * fq);
                acc[rb][0] = __builtin_amdgcn_mfma_f32_16x16x32_bf16(af, bfr[0], acc[rb][0], 0, 0, 0); acc[rb][1] = __builtin_amdgcn_mfma_f32_16x16x32_bf16(af, bfr[1], acc[rb][1], 0, 0, 0); } }
        LDS_WAIT(); asm volatile("" ::: "memory");
    }
    const float* bias = A.in[F.zo + I_BADA] + l * MODW + n0; float* mo = F.MOD() + (size_t)l * MODW + n0;
#pragma unroll
    for (int rb = 0; rb < 3; ++rb)
#pragma unroll
        for (int nk = 0; nk < 2; ++nk) { const float bv = bias[16 * nk + fr];
#pragma unroll
            for (int i = 0; i < 4; ++i) { const int b = rb * 16 + 4 * fq + i; if (b < NBATCH) mo[(size_t)b * MODLD + 16 * nk + fr] = acc[rb][nk][i] + bv; } }
}
__device__ __forceinline__ void sc_table(Frame& F, const Args& A) {
    const int gt = (F.vcu * NWAVES + F.wave) * 64 + F.lane_id(), NGT = F.G * NWAVES * 64;
    for (int i = gt; i < 48 * 1024; i += NGT) { const int r = i >> 10, cp = (i & 1023) * 2; unsigned w = 0u;
        if (r < NBATCH) { const float* c = (r < 4) ? (A.in[F.zo + I_CP] + (size_t)r * DM) : (A.in[F.zo + I_CS] + (size_t)(r - 4) * DM); w = pk2(silu_f(c[cp]), silu_f(c[cp + 1])); }
        ((GAS unsigned*)F.SC())[i] = w; }
}
__device__ __forceinline__ void p0_prologue(Frame& F, const Args& A) {
    LAS float* scr = (LAS float*)(F.lds + RING_OFF + F.wave * 16384);
    const int gw = F.vcu * NWAVES + F.wave, NGW = F.G * NWAVES;
    const int gt = gw * 64 + F.lane_id(), NGT = NGW * 64;
    for (int it = gw; it < DEPTH * 384; it += NGW) adaln_item(F, A, it, scr);
    constexpr int I_IN = 32 * 137, I_OUT = 32 * 64, I_GU = 32 * 352, I_DN = 88 * 64, I_L = I_IN + I_OUT + I_GU + I_DN;
    for (int it = gw; it < DEPTH * I_L; it += NGW) {
        const int l = it / I_L; int r = it - l * I_L;
        if (r < I_IN)  { transpose_item<0>(A.in[F.zo + I_WIN] + (size_t)l * DM * INW, DM, INW, 137, F.Win_t() + (size_t)l * ZW * DM, 0, scr, r, F.lane_id()); continue; } r -= I_IN;
        if (r < I_OUT) { transpose_item<0>(A.in[F.zo + I_WOUT] + (size_t)l * DM * DM, DM, DM, 64, F.Wout_t() + (size_t)l * DM * DM, 0, scr, r, F.lane_id()); continue; } r -= I_OUT;
        if (r < I_GU)  { transpose_item<1>(A.in[F.zo + I_WGU] + (size_t)l * DM * NGU, DM, NGU, 352, F.Wgu_t() + (size_t)l * NGU * DM, 0, scr, r, F.lane_id()); continue; } r -= I_GU;
        transpose_item<0>(A.in[F.zo + I_WDN] + (size_t)l * DFF * DM, DFF, DM, 64, F.Wdn_t() + (size_t)l * DM * DFF, 0, scr, r, F.lane_id());
    }
    const v4u z4 = {0u, 0u, 0u, 0u};
    for (int i = gt; i < DEPTH * 224 * 256; i += NGT) { const int l = i / (224 * 256), r = i - l * (224 * 256); *((GAS v4u*)(F.Win_t() + ((size_t)l * ZW + 4384) * DM) + r) = z4; }
    for (int i = gt; i < 128 * 256; i += NGT) { *((GAS v4u*)(F.H() + (size_t)NROWS * DM) + i) = z4; *((GAS v4u*)(F.MIX() + (size_t)NROWS * DM) + i) = z4; }
    for (int i = gt; i < 128 * 704; i += NGT) *((GAS v4u*)(F.ACT() + (size_t)NROWS * DFF) + i) = z4;
    for (int i = gt; i < NP_ROWS * 512; i += NGT) ((GAS f32x4*)F.X())[i] = ((const GAS f32x4*)A.in[F.zo + I_XP])[i];
    for (int i = gt; i < NS_ROWS * 512; i += NGT) ((GAS f32x4*)(F.X() + (size_t)NP_ROWS * DM))[i] = ((const GAS f32x4*)A.in[F.zo + I_XS])[i];
    for (int i = gt; i < 4 * 4 * 128 * 128; i += NGT) { const int lg = i >> 14, dcol = (i >> 7) & 127, c = i & 127; F.WPT()[i] = (bf16)f2bf(A.in[F.zo + I_WPOOL][((size_t)lg * 128 + c) * 128 + dcol]); }
    for (int i = gt; i < 8 * 128; i += NGT) { const int h = i >> 7, dist = i & 127; F.BTAB()[i] = A.in[F.zo + I_RELB][t5_bucket(dist) * 8 + h]; }
}

__device__ __forceinline__ void norm_mod_rows(Frame& F, const float* g, const float* modl  ) {
    const int gw = F.vcu * NWAVES + F.wave, NGW = F.G * NWAVES;
    for (int r = gw; r < NROWS; r += NGW) {
        const int b = r < NP_ROWS ? (r >> 11) : 4 + ((r - NP_ROWS) >> 2);
        const float* xr = F.X() + (size_t)r * DM + 4 * F.lane_id(); const float* sh = modl + (size_t)b * MODLD + 4 * F.lane_id(); const float* gg = g + 4 * F.lane_id();
        f32x4 v[8]; float ss = 0.f;
#pragma unroll
        for (int j = 0; j < 8; ++j) { v[j] = *(const f32x4*)(xr + 256 * j); ss += (v[j].x * v[j].x + v[j].y * v[j].y) + (v[j].z * v[j].z + v[j].w * v[j].w); }
        const float rstd = 1.0f / sqrtf(wave_sum(ss) * (1.0f / DM) + EPS);
        bf16* hr = F.H() + (size_t)r * DM + 4 * F.lane_id();
#pragma unroll
        for (int j = 0; j < 8; ++j) { const f32x4 gv = *(const f32x4*)(gg + 256 * j), sv = *(const f32x4*)(sh + 256 * j), cv = *(const f32x4*)(sh + 2048 + 256 * j);
            const f32x4 y = (v[j] * rstd * gv) * (1.0f + cv) + sv;
            uint2 w; w.x = pk2(y.x, y.y); w.y = pk2(y.z, y.w); *(uint2*)(hr + 256 * j) = w; }
    }
}
__device__ __forceinline__ void final_norm_rows(Frame& F, const Args& A) {
    const int gw = F.vcu * NWAVES + F.wave, NGW = F.G * NWAVES; const float* g = A.in[F.zo + I_GFIN] + 4 * F.lane_id();
    for (int r = gw; r < NROWS; r += NGW) {
        const float* xr = F.X() + (size_t)r * DM + 4 * F.lane_id();
        f32x4 v[8]; float ss = 0.f;
#pragma unroll
        for (int j = 0; j < 8; ++j) { v[j] = *(const f32x4*)(xr + 256 * j); ss += (v[j].x * v[j].x + v[j].y * v[j].y) + (v[j].z * v[j].z + v[j].w * v[j].w); }
        const float rstd = 1.0f / sqrtf(wave_sum(ss) * (1.0f / DM) + EPS);
        float* yr = F.out + O_Y + (size_t)r * DM + 4 * F.lane_id();
#pragma unroll
        for (int j = 0; j < 8; ++j) { const f32x4 gv = *(const f32x4*)(g + 256 * j); *(f32x4*)(yr + 256 * j) = v[j] * rstd * gv; }
    }
}

__device__ __forceinline__ void attn_item(Frame& F, const Args& A, int l, int r, int hd, LAS float* ps) {
    const int lane = F.lane_id(), g = hd >> 2; const bool smp = r >= NP_ROWS;
    const int t = r & 2047, sb = smp ? ((r - NP_ROWS) >> 2) : 0, si = (r - NP_ROWS) & 3;
    LAS float* qs = ps + 128;
    { const unsigned w = ((const unsigned*)(F.Z() + (size_t)r * ZW + ZQ + hd * 64))[lane & 31]; if (lane < 32) { qs[2 * lane] = bflo(w); qs[2 * lane + 1] = bfhi(w); } }
    LDS_WAIT(); asm volatile("" ::: "memory");
    const float* ck = A.in[F.zo + I_CK] + ((size_t)(l * 32 + sb) * 128) * 128 + g * 64;
    const float* cv = A.in[F.zo + I_CV] + ((size_t)(l * 32 + sb) * 128) * 128 + g * 64;
    const int jmin = smp ? 0 : (t >= 127 ? 0 : 127 - t);
    float sc[2];
#pragma unroll 1
    for (int jj = 0; jj < 2; ++jj) {
        const int j = lane + 64 * jj, dist = 127 - j; float dot = 0.f; bool valid = j >= jmin;
        if (valid) {
            const int krel = si - dist;
            if (smp && krel < 0) {
                const f32x4* kp = (const f32x4*)(ck + (size_t)(krel + 128) * 128);
#pragma unroll 4
                for (int c = 0; c < 16; ++c) { const f32x4 kv = kp[c]; const f32x4 qv = *(const LAS f32x4*)(qs + 4 * c); dot += qv.x * kv.x + qv.y * kv.y + qv.z * kv.z + qv.w * kv.w; }
            } else {
                const int krow = smp ? (NP_ROWS + sb * 4 + krel) : (r - dist);
                const v4u* kp = (const v4u*)(F.Z() + (size_t)krow * ZW + ZK + g * 64);
#pragma unroll 4
                for (int c = 0; c < 8; ++c) { const v4u w = kp[c];
                    const f32x4 qa = *(const LAS f32x4*)(qs + 8 * c), qb = *(const LAS f32x4*)(qs + 8 * c + 4);
                    dot += qa.x * bflo(w.x) + qa.y * bfhi(w.x) + qa.z * bflo(w.y) + qa.w * bfhi(w.y) + qb.x * bflo(w.z) + qb.y * bfhi(w.z) + qb.z * bflo(w.w) + qb.w * bfhi(w.w); }
            }
        }
        const float sv = valid ? dot * 0.125f + F.BTAB()[hd * 128 + dist] : -INFINITY;
        if (jj == 0) sc[0] = sv; else sc[1] = sv;
    }
    const float sink = A.in[F.zo + I_SINKS][l * 8 + hd];
    const float m = fmaxf(wave_max(fmaxf(sc[0], sc[1])), sink);
    const float p0 = __expf(sc[0] - m), p1 = __expf(sc[1] - m);
    const float denom = wave_sum(p0 + p1) + __expf(sink - m);
    ps[lane] = p0; ps[lane + 64] = p1;
    LDS_WAIT(); asm volatile("" ::: "memory");
    float o = 0.f;
#pragma unroll 16
    for (int j = jmin; j < 128; ++j) {
        const float pj = ps[j]; const int dist = 127 - j; float vv;
        const int krel = si - dist;
        if (smp && krel < 0) vv = cv[(size_t)(krel + 128) * 128 + lane];
        else { const int krow = smp ? (NP_ROWS + sb * 4 + krel) : (r - dist); vv = bf2f(F.Z()[(size_t)krow * ZW + ZV + g * 64 + lane]); }
        o += pj * vv;
    }
    F.MIX()[(size_t)r * DM + hd * 64 + lane] = (bf16)f2bf(o / denom);
    LDS_WAIT(); asm volatile("" ::: "memory");
}
__device__ __forceinline__ void pool_item(Frame& F, const Args& A, int l, int r, int gi, LAS float* ds) {
    const int lane = F.lane_id(), w = 2 << gi; const bool smp = r >= NP_ROWS;
    const int t = r & 2047, sb = (r - NP_ROWS) >> 2, si = (r - NP_ROWS) & 3;
    const float* pbuf = A.in[F.zo + I_SPOOL] + ((size_t)(l * 32 + sb) * 15) * 512 + gi * 128;
    float s0 = 0.f, s1 = 0.f, u0 = 0.f, u1 = 0.f;
#pragma unroll 4
    for (int o = 0; o < w; ++o) {
        float a0 = 0.f, a1 = 0.f;
        if (!smp) { if (t - o >= 0) { const bf16* zp = F.Z() + (size_t)(r - o) * ZW + ZU + gi * 128; a0 = bf2f(zp[lane]); a1 = bf2f(zp[lane + 64]); } }
        else { const int idx = si - o;
            if (idx >= 0) { const bf16* zp = F.Z() + (size_t)(NP_ROWS + sb * 4 + idx) * ZW + ZU + gi * 128; a0 = bf2f(zp[lane]); a1 = bf2f(zp[lane + 64]); }
            else { const float* bp = pbuf + (size_t)(15 + idx) * 512; a0 = bp[lane]; a1 = bp[lane + 64]; } }
        if (o == 0) { u0 = a0; u1 = a1; }
        s0 += a0; s1 += a1;
    }
    const float cnt = smp ? (float)w : (float)((t + 1) < w ? (t + 1) : w);
    ds[lane] = s0 / cnt - u0; ds[lane + 64] = s1 / cnt - u1;
    LDS_WAIT(); asm volatile("" ::: "memory");
    const float* wp = A.in[F.zo + I_WPOOL] + ((size_t)(l * 4 + gi) * 128) * 128;
    float y0 = 0.f, y1 = 0.f;
#pragma unroll 16
    for (int c = 0; c < 128; ++c) { const float dv = ds[c]; y0 += dv * wp[c * 128 + lane]; y1 += dv * wp[c * 128 + lane + 64]; }
    const float* psc = A.in[F.zo + I_PSCALE] + l * 512 + gi * 128;
    bf16* mp = F.MIX() + (size_t)r * DM + 512 + gi * 128;
    mp[lane] = (bf16)f2bf(y0 * psc[lane]); mp[lane + 64] = (bf16)f2bf(y1 * psc[lane + 64]);
    LDS_WAIT(); asm volatile("" ::: "memory");
}
__device__ __forceinline__ void cache_outputs(Frame& F, const Args& A, int l) {
    const int gt = (F.vcu * NWAVES + F.wave) * 64 + F.lane_id(), NGT = F.G * NWAVES * 64;
#pragma unroll 4
    for (int i = gt; i < 4 * 128 * 128; i += NGT) { const int b = i >> 14, j = (i >> 7) & 127, c = i & 127; const bf16* zr = F.Z() + (size_t)(b * 2048 + 1920 + j) * ZW;
        F.out[O_WK_P + (size_t)l * 65536 + i] = bf2f(zr[ZK + c]); F.out[O_WV_P + (size_t)l * 65536 + i] = bf2f(zr[ZV + c]); }
#pragma unroll 4
    for (int i = gt; i < 4 * 15 * 512; i += NGT) { const int b = i / 7680, rem = i - b * 7680, j = rem >> 9, c = rem & 511;
        F.out[O_POOL_P + (size_t)l * 30720 + i] = bf2f(F.Z()[(size_t)(b * 2048 + 2033 + j) * ZW + ZU + c]); }
#pragma unroll 4
    for (int i = gt; i < 32 * 128 * 128; i += NGT) { const int sb = i >> 14, p = (i >> 7) & 127, c = i & 127; float kv, vv;
        if (p < 124) { const size_t src = ((size_t)(l * 32 + sb) * 128 + p + 4) * 128 + c; kv = A.in[F.zo + I_CK][src]; vv = A.in[F.zo + I_CV][src]; }
        else { const bf16* zr = F.Z() + (size_t)(NP_ROWS + sb * 4 + p - 124) * ZW; kv = bf2f(zr[ZK + c]); vv = bf2f(zr[ZV + c]); }
        F.out[O_WK_S + (size_t)l * 524288 + i] = kv; F.out[O_WV_S + (size_t)l * 524288 + i] = vv; }
#pragma unroll 4
    for (int i = gt; i < 32 * 15 * 512; i += NGT) { const int sb = i / 7680, rem = i - sb * 7680, j = rem >> 9, c = rem & 511; float v;
        if (j < 11) v = A.in[F.zo + I_SPOOL][((size_t)(l * 32 + sb) * 15 + j + 4) * 512 + c];
        else v = bf2f(F.Z()[(size_t)(NP_ROWS + sb * 4 + j - 11) * ZW + ZU + c]);
        F.out[O_POOL_S + (size_t)l * 245760 + i] = v; }
}
__device__ __forceinline__ void gla_out_item(Frame& F, const Args& A, int l, int r, int hh) {
    const int lane = F.lane_id();
    const f32x4 o = *(const f32x4*)(F.OGLA() + (size_t)r * 1024 + hh * 256 + 4 * lane);
    const float ss = wave_sum((o.x * o.x + o.y * o.y) + (o.z * o.z + o.w * o.w));
    const float rstd = 1.0f / sqrtf(ss * (1.0f / 256.0f) + EPS);
    const f32x4 gv = *(const f32x4*)(A.in[F.zo + I_GGLA] + l * 1024 + hh * 256 + 4 * lane);
    const uint2 gw = *(const uint2*)(F.Z() + (size_t)r * ZW + GG + hh * 256 + 4 * lane);
    const float g0 = bflo(gw.x), g1 = bfhi(gw.x), g2 = bflo(gw.y), g3 = bfhi(gw.y);
    const float y0 = o.x * rstd * gv.x * (g0 / (1.0f + __expf(-g0))), y1 = o.y * rstd * gv.y * (g1 / (1.0f + __expf(-g1)));
    const float y2 = o.z * rstd * gv.z * (g2 / (1.0f + __expf(-g2))), y3 = o.w * rstd * gv.w * (g3 / (1.0f + __expf(-g3)));
    uint2 w; w.x = pk2(y0, y1); w.y = pk2(y2, y3);
    *(uint2*)(F.MIX() + (size_t)r * DM + 1024 + hh * 256 + 4 * lane) = w;
}
typedef unsigned u32x2 __attribute__((ext_vector_type(2)));
__device__ __forceinline__ u32x2 pack4bf(const f32x4 v) { u32x2 w; w.x = pk2(v.x, v.y); w.y = pk2(v.z, v.w); return w; }
constexpr int GL_QD = 0, GL_KD = 17408, GL_VT = 34816, GL_AM = 71680, GL_BS = 80896, GL_GS = 82944, GL_END = 87040;
static_assert(GL_END <= RING_BYTES, "GLA LDS map");
constexpr int GL_NSLOT = 640;
__device__ __forceinline__ void gla_prep_unit(Frame& F, const Args& A, int l, int slot) {
    const int lane = F.lane_id(), wave = F.wave, tid = wave * 64 + lane, fr = lane & 15, fq = lane >> 4;
    const bool smp = slot >= 512; const int hh = slot & 3;
    const int row0 = smp ? (NP_ROWS + ((slot - 512) >> 2) * 4) : ((slot >> 7) * 2048 + ((slot >> 2) & 31) * 64), nvalid = smp ? 4 : 64;
    const int d = tid & 127, qtr = tid >> 7, cg = hh * 128 + d;
    LAS bf16* QD = (LAS bf16*)(F.lds + GL_QD); LAS bf16* KD = (LAS bf16*)(F.lds + GL_KD); LAS bf16* VT = (LAS bf16*)(F.lds + GL_VT); LAS bf16* AM = (LAS bf16*)(F.lds + GL_AM);
    LAS float* BS = (LAS float*)(F.lds + GL_BS); LAS float* GS = (LAS float*)(F.lds + GL_GS);
    const bf16* Z = F.Z();
    unsigned short qraw[16], kraw[16], vraw[32];
    { const bf16* zq = Z + (size_t)(row0 + 16 * qtr) * ZW + GQ + cg; const bf16* zk = zq + (GK - GQ);
#pragma unroll
      for (int i = 0; i < 16; ++i) { qraw[i] = 0; kraw[i] = 0; if (16 * qtr + i < nvalid) { qraw[i] = zq[(size_t)i * ZW]; kraw[i] = zk[(size_t)i * ZW]; } }
      const int e = tid & 255, hf = tid >> 8; const bf16* vp = Z + (size_t)(row0 + 32 * hf) * ZW + GV + hh * 256 + e;
#pragma unroll
      for (int i = 0; i < 32; ++i) { vraw[i] = 0; if (32 * hf + i < nvalid) vraw[i] = vp[(size_t)i * ZW]; } }
    { const int t = tid >> 3, j0 = (tid & 7) * 2; float g0 = 0.f, g1 = 0.f;
      if (t < nvalid) { const unsigned w = *(const unsigned*)(Z + (size_t)(row0 + t) * ZW + GA + j0); g0 = bflo(w); g1 = bfhi(w); }
      GS[t * 16 + j0] = g0; GS[t * 16 + j0 + 1] = g1; }
    float wa[16];
    { const float* wp = A.in[F.zo + I_WA2] + (size_t)l * 16 * 512 + cg;
#pragma unroll
      for (int j = 0; j < 16; ++j) wa[j] = wp[j * 512]; }
    const float ba = A.in[F.zo + I_BA2][l * 512 + cg];
    __syncthreads();
    float bl[16]; float run = 0.f;
#pragma unroll
    for (int i = 0; i < 16; ++i) { const int t = 16 * qtr + i; const LAS f32x4* gp = (const LAS f32x4*)(GS + t * 16); const f32x4 g0 = gp[0], g1 = gp[1], g2 = gp[2], g3 = gp[3];
        float x = ba + g0.x * wa[0] + g0.y * wa[1] + g0.z * wa[2] + g0.w * wa[3] + g1.x * wa[4] + g1.y * wa[5] + g1.z * wa[6] + g1.w * wa[7];
        x += g2.x * wa[8] + g2.y * wa[9] + g2.z * wa[10] + g2.w * wa[11] + g3.x * wa[12] + g3.y * wa[13] + g3.z * wa[14] + g3.w * wa[15];
        float la = (fminf(x, 0.f) - __logf(1.0f + __expf(-fabsf(x)))) * (1.0f / 16.0f);
        if (t >= nvalid) la = 0.f;
        run += la; bl[i] = run; }
    BS[qtr * 128 + d] = run;
    __syncthreads();
    float pre = 0.f, tot = 0.f;
#pragma unroll
    for (int q2 = 0; q2 < 4; ++q2) { const float v = BS[q2 * 128 + d]; tot += v; if (q2 < qtr) pre += v; }
    { bf16* qg = F.QDG() + (size_t)(row0 + 16 * qtr) * 512 + cg;
      unsigned kt[8];
#pragma unroll
      for (int i = 0; i < 16; ++i) { const int t = 16 * qtr + i; const float b = pre + bl[i]; float qv = 0.f, kv = 0.f;
          qv = bf2f(qraw[i]); kv = bf2f(kraw[i]);
          const unsigned qd = f2bf(qv * __expf(b) * 0.08838834764831845f), kd = f2bf(kv * __expf(-b)), kdt = f2bf(kv * __expf(tot - b));
          QD[t * 136 + d] = (bf16)qd; KD[t * 136 + d] = (bf16)kd;
          if (t < nvalid) qg[(size_t)i * 512] = (bf16)qd;
          if (i & 1) kt[i >> 1] |= kdt << 16; else kt[i >> 1] = kdt; }
      v4u* kg = (v4u*)(F.KDTG() + ((size_t)slot * 128 + d) * 64 + 16 * qtr);
      kg[0] = (v4u){kt[0], kt[1], kt[2], kt[3]}; kg[1] = (v4u){kt[4], kt[5], kt[6], kt[7]};
      if (qtr == 0) F.DLG()[slot * 128 + d] = __expf(tot); }
    { const int e = tid & 255, hf = tid >> 8;
      unsigned vw[16];
#pragma unroll
      for (int i = 0; i < 32; ++i) { const unsigned x = vraw[i];
          if (i & 1) vw[i >> 1] |= x << 16; else vw[i >> 1] = x; }
      LAS v4u* vl = (LAS v4u*)(VT + e * 72 + 32 * hf); v4u* vg = (v4u*)(F.VTG() + ((size_t)slot * 256 + e) * 64 + 32 * hf);
#pragma unroll
      for (int k = 0; k < 4; ++k) { const v4u w = {vw[4 * k], vw[4 * k + 1], vw[4 * k + 2], vw[4 * k + 3]}; vl[k] = w; vg[k] = w; } }
    __syncthreads();
#pragma unroll
    for (int bi = 0; bi < 2; ++bi) { const int blk = 2 * wave + bi, tb = blk >> 2, sbk = blk & 3;
        f32x4 acc = {0.f, 0.f, 0.f, 0.f};
        if (sbk <= tb) {
#pragma unroll
            for (int ks = 0; ks < 4; ++ks) { const bf16x8 a = *(const LAS bf16x8*)(KD + (sbk * 16 + fr) * 136 + ks * 32 + fq * 8), b = *(const LAS bf16x8*)(QD + (tb * 16 + fr) * 136 + ks * 32 + fq * 8);
                acc = __builtin_amdgcn_mfma_f32_16x16x32_bf16(a, b, acc, 0, 0, 0); } }
        const int t = tb * 16 + fr, s0 = sbk * 16 + 4 * fq;
        f32x4 m; m.x = (s0 + 0 <= t) ? acc.x : 0.f; m.y = (s0 + 1 <= t) ? acc.y : 0.f; m.z = (s0 + 2 <= t) ? acc.z : 0.f; m.w = (s0 + 3 <= t) ? acc.w : 0.f;
        *(LAS u32x2*)(AM + t * 72 + s0) = pack4bf(m); }
    __syncthreads();
#pragma unroll
    for (int ei = 0; ei < 2; ++ei) { const int eb = 2 * wave + ei;
        const bf16x8 a0 = *(const LAS bf16x8*)(VT + (eb * 16 + fr) * 72 + fq * 8), a1 = *(const LAS bf16x8*)(VT + (eb * 16 + fr) * 72 + 32 + fq * 8);
#pragma unroll
        for (int tb = 0; tb < 4; ++tb) { f32x4 o = {0.f, 0.f, 0.f, 0.f};
            o = __builtin_amdgcn_mfma_f32_16x16x32_bf16(a0, *(const LAS bf16x8*)(AM + (tb * 16 + fr) * 72 + fq * 8), o, 0, 0, 0);
            if (tb >= 2) o = __builtin_amdgcn_mfma_f32_16x16x32_bf16(a1, *(const LAS bf16x8*)(AM + (tb * 16 + fr) * 72 + 32 + fq * 8), o, 0, 0, 0);
            const int t = tb * 16 + fr;
            if (t < nvalid) *(f32x4*)(F.OGLA() + (size_t)(row0 + t) * 1024 + hh * 256 + eb * 16 + 4 * fq) = o; } }
    __syncthreads();
}
__device__ __forceinline__ void gla_state_step(Frame& F, int slot, int eb, int fr, int fq, f32x4 (&sacc)[8]) {
    const bf16* vt = F.VTG() + ((size_t)slot * 256 + eb * 16 + fr) * 64 + 8 * fq; const bf16x8 b0 = *(const bf16x8*)vt, b1 = *(const bf16x8*)(vt + 32);
    const bf16* kt = F.KDTG() + ((size_t)slot * 128 + fr) * 64 + 8 * fq; const float* dl = F.DLG() + slot * 128 + 4 * fq;
#pragma unroll
    for (int db = 0; db < 8; ++db) { const f32x4 dv = *(const f32x4*)(dl + db * 16); const bf16x8 a0 = *(const bf16x8*)(kt + (size_t)db * 16 * 64), a1 = *(const bf16x8*)(kt + (size_t)db * 16 * 64 + 32);
        f32x4 s = sacc[db] * dv; s = __builtin_amdgcn_mfma_f32_16x16x32_bf16(a0, b0, s, 0, 0, 0); s = __builtin_amdgcn_mfma_f32_16x16x32_bf16(a1, b1, s, 0, 0, 0); sacc[db] = s; }
}
template <int NTB>
__device__ __forceinline__ void gla_inter_step(Frame& F, int row0, int nvalid, int hh, int eb, int fr, int fq, const f32x4 (&sacc)[8]) {
    u32x2 qlo[NTB][4], qhi[NTB][4]; f32x4 oi[NTB];
#pragma unroll
    for (int tb = 0; tb < NTB; ++tb) { const int t = tb * 16 + fr; const bool ok = t < nvalid;
        const bf16* qp = F.QDG() + (size_t)(row0 + t) * 512 + hh * 128 + 4 * fq; const float* op = F.OGLA() + (size_t)(row0 + t) * 1024 + hh * 256 + eb * 16 + 4 * fq;
        oi[tb] = (f32x4){0.f, 0.f, 0.f, 0.f}; if (ok) oi[tb] = *(const f32x4*)op;
#pragma unroll
        for (int ks = 0; ks < 4; ++ks) { qlo[tb][ks] = (u32x2){0u, 0u}; qhi[tb][ks] = (u32x2){0u, 0u}; if (ok) { qlo[tb][ks] = *(const u32x2*)(qp + 32 * ks); qhi[tb][ks] = *(const u32x2*)(qp + 32 * ks + 16); } } }
    bf16x8 sf[4];
#pragma unroll
    for (int ks = 0; ks < 4; ++ks) { const u32x2 lo = pack4bf(sacc[2 * ks]), hi = pack4bf(sacc[2 * ks + 1]); const v4u w = {lo.x, lo.y, hi.x, hi.y}; sf[ks] = __builtin_bit_cast(bf16x8, w); }
#pragma unroll
    for (int tb = 0; tb < NTB; ++tb) { const int t = tb * 16 + fr; f32x4 o = oi[tb];
#pragma unroll
        for (int ks = 0; ks < 4; ++ks) { const v4u w = {qlo[tb][ks].x, qlo[tb][ks].y, qhi[tb][ks].x, qhi[tb][ks].y}; o = __builtin_amdgcn_mfma_f32_16x16x32_bf16(sf[ks], __builtin_bit_cast(bf16x8, w), o, 0, 0, 0); }
        if (t < nvalid) *(f32x4*)(F.OGLA_ST() + (size_t)(row0 + t) * 1024 + hh * 256 + eb * 16 + 4 * fq) = o; }
}
__device__ __forceinline__ void gla_store_state(float* dst, int fr, int fq, const f32x4 (&sacc)[8]) {
#pragma unroll
    for (int db = 0; db < 8; ++db) { const int d0 = db * 16 + 4 * fq; dst[(size_t)(d0 + 0) * 256 + fr] = sacc[db].x; dst[(size_t)(d0 + 1) * 256 + fr] = sacc[db].y; dst[(size_t)(d0 + 2) * 256 + fr] = sacc[db].z; dst[(size_t)(d0 + 3) * 256 + fr] = sacc[db].w; }
}
__device__ __forceinline__ void gla_phase_g1(Frame& F, const Args& A, int l) {
    const int lane = F.lane_id(), fr = lane & 15, fq = lane >> 4;
    const int gw = F.vcu * NWAVES + F.wave, NGW = F.G * NWAVES;
    for (int it = gw; it < 2048; it += NGW) { const int bh = it >> 7, seg = (it >> 4) & 7, eb = it & 15;
        if (seg == 7) continue;
        f32x4 sacc[8];
#pragma unroll
        for (int db = 0; db < 8; ++db) sacc[db] = (f32x4){0.f, 0.f, 0.f, 0.f};
        const int slot0 = (((bh >> 2) * 32 + seg * 4) * 4) + (bh & 3);
#pragma unroll 1
        for (int c = 0; c < 4; ++c) gla_state_step(F, slot0 + 4 * c, eb, fr, fq, sacc);
        gla_store_state(F.SLOC() + ((size_t)(bh * 8 + seg) * 128) * 256 + eb * 16, fr, fq, sacc);
        if (eb == 0) {
#pragma unroll
            for (int k = 0; k < 2; ++k) { const int d = lane + 64 * k; float p = 1.f; for (int c = 0; c < 4; ++c) p *= F.DLG()[(slot0 + 4 * c) * 128 + d]; F.DSEG()[(bh * 8 + seg) * 128 + d] = p; } }
    }
    for (int it = gw; it < 2048; it += NGW) { const int sbh = it >> 4, eb = it & 15, sb = sbh >> 2, hh = sbh & 3;
        const size_t so = ((size_t)((l * 32 + sb) * 4 + hh)) * 32768 + eb * 16;
        const float* s0 = A.in[F.zo + I_SGLA] + so + fr;
        f32x4 sacc[8];
#pragma unroll
        for (int db = 0; db < 8; ++db) { const int d0 = db * 16 + 4 * fq; sacc[db].x = s0[(size_t)(d0 + 0) * 256]; sacc[db].y = s0[(size_t)(d0 + 1) * 256]; sacc[db].z = s0[(size_t)(d0 + 2) * 256]; sacc[db].w = s0[(size_t)(d0 + 3) * 256]; }
        gla_inter_step<1>(F, NP_ROWS + sb * 4, 4, hh, eb, fr, fq, sacc);
        gla_state_step(F, 512 + sbh, eb, fr, fq, sacc);
        gla_store_state(F.out + O_GLA_S + so, fr, fq, sacc);
    }
}
__device__ __forceinline__ void gla_phase_g2(Frame& F, const Args& A, int l) {
    const int lane = F.lane_id(), fr = lane & 15, fq = lane >> 4;
    const int gw = F.vcu * NWAVES + F.wave, NGW = F.G * NWAVES;
    for (int it = gw; it < 2048; it += NGW) { const int bh = it >> 7, seg = (it >> 4) & 7, eb = it & 15, hh = bh & 3;
        f32x4 sacc[8];
#pragma unroll
        for (int db = 0; db < 8; ++db) sacc[db] = (f32x4){0.f, 0.f, 0.f, 0.f};
        for (int i2 = 0; i2 < seg; ++i2) { const float* sl = F.SLOC() + ((size_t)(bh * 8 + i2) * 128) * 256 + eb * 16 + fr; const float* dg = F.DSEG() + (bh * 8 + i2) * 128;
#pragma unroll
            for (int db = 0; db < 8; ++db) { const int d0 = db * 16 + 4 * fq; const f32x4 dv = *(const f32x4*)(dg + d0);
                sacc[db].x = sacc[db].x * dv.x + sl[(size_t)(d0 + 0) * 256]; sacc[db].y = sacc[db].y * dv.y + sl[(size_t)(d0 + 1) * 256]; sacc[db].z = sacc[db].z * dv.z + sl[(size_t)(d0 + 2) * 256]; sacc[db].w = sacc[db].w * dv.w + sl[(size_t)(d0 + 3) * 256]; } }
        const int slot0 = (((bh >> 2) * 32 + seg * 4) * 4) + hh, row0 = (bh >> 2) * 2048 + seg * 256;
#pragma unroll 1
        for (int c = 0; c < 4; ++c) { gla_inter_step<4>(F, row0 + c * 64, 64, hh, eb, fr, fq, sacc); gla_state_step(F, slot0 + 4 * c, eb, fr, fq, sacc); }
        if (seg == 7) gla_store_state(F.out + O_GLA_P + ((size_t)(l * 16 + bh)) * 32768 + eb * 16, fr, fq, sacc);
    }
}
constexpr int AT_VT = 0, AT_VTS = 184, AT_BT = 64 * AT_VTS * 2, AT_END = AT_BT + 4 * 128 * 4;
__device__ __forceinline__ void attn_unit_mfma(Frame& F, const Args& A, int l, int u) {
    const int lane = F.lane_id(), wave = F.wave, tid = wave * 64 + lane, fr = lane & 15, fq = lane >> 4;
    const int span = u >> 1, g = u & 1, t0g = span * 32, tb0 = t0g & 2047;
    LAS bf16* VT = (LAS bf16*)(F.lds + AT_VT); LAS float* BT = (LAS float*)(F.lds + AT_BT);
    const bf16* Z = F.Z();
    const int rb = wave >> 2, hl = wave & 3, hd = g * 4 + hl, t0w = t0g + 16 * rb;
    bf16x8 qf[2], kf[9][2];
    { const bf16* qp = Z + (size_t)(t0w + fr) * ZW + ZQ + hd * 64 + 8 * fq; qf[0] = *(const bf16x8*)qp; qf[1] = *(const bf16x8*)(qp + 32); }
#pragma unroll
    for (int kb = 0; kb < 9; ++kb) { const int kl = 16 * (rb + kb) + fr; kf[kb][0] = (bf16x8){0, 0, 0, 0, 0, 0, 0, 0}; kf[kb][1] = (bf16x8){0, 0, 0, 0, 0, 0, 0, 0};
        if (tb0 - 128 + kl >= 0) { const bf16* kp = Z + (size_t)(t0g - 128 + kl) * ZW + ZK + g * 64 + 8 * fq; kf[kb][0] = *(const bf16x8*)kp; kf[kb][1] = *(const bf16x8*)(kp + 32); } }
#pragma unroll
    for (int pass = 0; pass < 2; ++pass) { const int key = pass * 128 + (tid >> 2), dch = (tid & 3) * 16;
        if (key < 160) { v4u v0 = {0u, 0u, 0u, 0u}, v1 = {0u, 0u, 0u, 0u};
            if (tb0 - 128 + key >= 0) { const v4u* vp = (const v4u*)(Z + (size_t)(t0g - 128 + key) * ZW + ZV + g * 64 + dch); v0 = vp[0]; v1 = vp[1]; }
            LAS bf16* vt = VT + dch * AT_VTS + key;
            vt[0 * AT_VTS] = (bf16)(v0.x & 0xffffu); vt[1 * AT_VTS] = (bf16)(v0.x >> 16); vt[2 * AT_VTS] = (bf16)(v0.y & 0xffffu); vt[3 * AT_VTS] = (bf16)(v0.y >> 16);
            vt[4 * AT_VTS] = (bf16)(v0.z & 0xffffu); vt[5 * AT_VTS] = (bf16)(v0.z >> 16); vt[6 * AT_VTS] = (bf16)(v0.w & 0xffffu); vt[7 * AT_VTS] = (bf16)(v0.w >> 16);
            vt[8 * AT_VTS] = (bf16)(v1.x & 0xffffu); vt[9 * AT_VTS] = (bf16)(v1.x >> 16); vt[10 * AT_VTS] = (bf16)(v1.y & 0xffffu); vt[11 * AT_VTS] = (bf16)(v1.y >> 16);
            vt[12 * AT_VTS] = (bf16)(v1.z & 0xffffu); vt[13 * AT_VTS] = (bf16)(v1.z >> 16); vt[14 * AT_VTS] = (bf16)(v1.w & 0xffffu); vt[15 * AT_VTS] = (bf16)(v1.w >> 16); } }
    BT[tid] = F.BTAB()[(g * 4) * 128 + tid];
    __syncthreads();
    f32x4 sacc[9];
#pragma unroll
    for (int kb = 0; kb < 9; ++kb) {
        f32x4 acc = {0.f, 0.f, 0.f, 0.f};
        acc = __builtin_amdgcn_mfma_f32_16x16x32_bf16(kf[kb][0], qf[0], acc, 0, 0, 0); acc = __builtin_amdgcn_mfma_f32_16x16x32_bf16(kf[kb][1], qf[1], acc, 0, 0, 0);
        sacc[kb] = acc; }
    const float sink = A.in[F.zo + I_SINKS][l * 8 + hd];
    float mx = -INFINITY;
#pragma unroll
    for (int kb = 0; kb < 9; ++kb)
#pragma unroll
        for (int i = 0; i < 4; ++i) { const int dist = 128 - 16 * kb + fr - 4 * fq - i, kpos = tb0 + 16 * rb + fr - dist;
            const bool valid = (dist >= 0) && (dist < 128) && (kpos >= 0);
            const float s = valid ? sacc[kb][i] * 0.125f + BT[hl * 128 + (dist & 127)] : -INFINITY;
            sacc[kb][i] = s; mx = fmaxf(mx, s); }
    mx = fmaxf(mx, __shfl_xor(mx, 16)); mx = fmaxf(mx, __shfl_xor(mx, 32)); mx = fmaxf(mx, sink);
    float ls = 0.f;
#pragma unroll
    for (int kb = 0; kb < 9; ++kb)
#pragma unroll
        for (int i = 0; i < 4; ++i) { const float p = __expf(sacc[kb][i] - mx); sacc[kb][i] = p; ls += p; }
    ls += __shfl_xor(ls, 16); ls += __shfl_xor(ls, 32);
    const float rden = 1.0f / (ls + __expf(sink - mx));
    bf16x8 pf[5];
#pragma unroll
    for (int pp = 0; pp < 5; ++pp) { const f32x4 a = sacc[2 * pp], b = (2 * pp + 1 < 9) ? sacc[2 * pp + 1] : (f32x4){0.f, 0.f, 0.f, 0.f};
        const unsigned w0 = pk2(a.x, a.y), w1 = pk2(a.z, a.w), w2 = pk2(b.x, b.y), w3 = pk2(b.z, b.w);
        v4u w = {w0, w1, w2, w3}; pf[pp] = __builtin_bit_cast(bf16x8, w); }
#pragma unroll
    for (int db = 0; db < 4; ++db) { f32x4 o = {0.f, 0.f, 0.f, 0.f};
#pragma unroll
        for (int pp = 0; pp < 5; ++pp) { const LAS bf16* vr = VT + (db * 16 + fr) * AT_VTS + 16 * (rb + 2 * pp) + 4 * fq;
            const u32x2 lo = *(const LAS u32x2*)vr; u32x2 hi = {0u, 0u}; if (2 * pp + 1 < 9) hi = *(const LAS u32x2*)(vr + 16);
            v4u w = {lo.x, lo.y, hi.x, hi.y};
            o = __builtin_amdgcn_mfma_f32_16x16x32_bf16(__builtin_bit_cast(bf16x8, w), pf[pp], o, 0, 0, 0); }
        *(u32x2*)(F.MIX() + (size_t)(t0w + fr) * DM + hd * 64 + db * 16 + 4 * fq) = pack4bf(o * rden); }
    __syncthreads();
}
template <int W>
__device__ __forceinline__ void pool_item_body(Frame& F, const Args& A, int l, int rblk, int g) {
    const int lane = F.lane_id(), fr = lane & 15, fq = lane >> 4;
    const int t = rblk * 16 + fr, pos = t & 2047;
    const bf16* Z = F.Z();
    const int nwin = (pos + 1) < W ? (pos + 1) : W; const float rc = 1.0f / (float)nwin;
    const bf16* wt = F.WPT() + ((size_t)(l * 4 + g) * 128) * 128; const float* psc = A.in[F.zo + I_PSCALE] + l * 512 + g * 128;
    f32x4 acc[8];
#pragma unroll
    for (int nb = 0; nb < 8; ++nb) acc[nb] = (f32x4){0.f, 0.f, 0.f, 0.f};
#pragma unroll 1
    for (int ks = 0; ks < 4; ++ks) { const bf16* up = Z + (size_t)t * ZW + ZU + g * 128 + ks * 32 + 8 * fq;
        v4u x[W];
#pragma unroll
        for (int i = 0; i < W; ++i) { x[i] = (v4u){0u, 0u, 0u, 0u}; if (i < nwin) x[i] = *(const v4u*)(up - (size_t)i * ZW); }
        float s[8];
#pragma unroll
        for (int j = 0; j < 8; ++j) s[j] = 0.f;
#pragma unroll
        for (int i = 0; i < W; ++i) { s[0] += bflo(x[i].x); s[1] += bfhi(x[i].x); s[2] += bflo(x[i].y); s[3] += bfhi(x[i].y); s[4] += bflo(x[i].z); s[5] += bfhi(x[i].z); s[6] += bflo(x[i].w); s[7] += bfhi(x[i].w); }
        const v4u u0 = x[0];
        v4u wv; wv.x = pk2(s[0] * rc - bflo(u0.x), s[1] * rc - bfhi(u0.x)); wv.y = pk2(s[2] * rc - bflo(u0.y), s[3] * rc - bfhi(u0.y)); wv.z = pk2(s[4] * rc - bflo(u0.z), s[5] * rc - bfhi(u0.z)); wv.w = pk2(s[6] * rc - bflo(u0.w), s[7] * rc - bfhi(u0.w));
        const bf16x8 df = __builtin_bit_cast(bf16x8, wv);
#pragma unroll
        for (int nb = 0; nb < 8; ++nb) { const bf16x8 a = *(const bf16x8*)(wt + (size_t)(nb * 16 + fr) * 128 + ks * 32 + 8 * fq); acc[nb] = __builtin_amdgcn_mfma_f32_16x16x32_bf16(a, df, acc[nb], 0, 0, 0); } }
#pragma unroll
    for (int nb = 0; nb < 8; ++nb) { const f32x4 sc = *(const f32x4*)(psc + nb * 16 + 4 * fq);
        *(u32x2*)(F.MIX() + (size_t)t * DM + 512 + g * 128 + nb * 16 + 4 * fq) = pack4bf(acc[nb] * sc); }
}
__device__ __forceinline__ void pool_item_mfma(Frame& F, const Args& A, int l, int rblk, int g) {
    if (g == 0) pool_item_body<2>(F, A, l, rblk, g); else if (g == 1) pool_item_body<4>(F, A, l, rblk, g); else if (g == 2) pool_item_body<8>(F, A, l, rblk, g); else pool_item_body<16>(F, A, l, rblk, g);
}
__device__ __forceinline__ void skinny_resid(Frame& F, const bf16* Asmp, const bf16* Bt, int K, const float* gate) {
    const int lane = F.lane_id(), wave = F.wave, fr = lane & 15, fq = lane >> 4;
    LAS float* red = (LAS float*)(F.lds + RING_OFF);
    const int kw = K >> 3, ksteps = kw >> 5;
    for (int u = F.vcu; u < 256; u += F.G) {
        const int c0 = (u >> 1) * 16, r0 = (u & 1) * 64;
        const bf16* bp = Bt + (size_t)(c0 + fr) * K + wave * kw + 8 * fq;
        const bf16* ap = Asmp + (size_t)(r0 + fr) * K + wave * kw + 8 * fq;
        f32x4 acc[4];
#pragma unroll
        for (int rb = 0; rb < 4; ++rb) acc[rb] = (f32x4){0.f, 0.f, 0.f, 0.f};
        bf16x8 bc = *(const bf16x8*)bp, ac[4];
#pragma unroll
        for (int rb = 0; rb < 4; ++rb) ac[rb] = *(const bf16x8*)(ap + (size_t)rb * 16 * K);
        for (int ks = 0; ks < ksteps; ++ks) {
            bf16x8 bn = bc, an[4];
#pragma unroll
            for (int rb = 0; rb < 4; ++rb) an[rb] = ac[rb];
            if (ks + 1 < ksteps) { bn = *(const bf16x8*)(bp + (ks + 1) * 32);
#pragma unroll
                for (int rb = 0; rb < 4; ++rb) an[rb] = *(const bf16x8*)(ap + (size_t)rb * 16 * K + (ks + 1) * 32); }
#pragma unroll
            for (int rb = 0; rb < 4; ++rb) acc[rb] = __builtin_amdgcn_mfma_f32_16x16x32_bf16(bc, ac[rb], acc[rb], 0, 0, 0);
            bc = bn;
#pragma unroll
            for (int rb = 0; rb < 4; ++rb) ac[rb] = an[rb];
        }
#pragma unroll
        for (int rb = 0; rb < 4; ++rb) *(LAS f32x4*)(red + ((wave * 4 + rb) * 64 + lane) * 4) = acc[rb];
        __syncthreads();
        if (wave < 4) { f32x4 s = {0.f, 0.f, 0.f, 0.f};
#pragma unroll
            for (int w2 = 0; w2 < 8; ++w2) s = s + *(const LAS f32x4*)(red + ((w2 * 4 + wave) * 64 + lane) * 4);
            const int r = r0 + wave * 16 + fr;
            const f32x4 g = *(const f32x4*)(gate + (size_t)(4 + (r >> 2)) * MODLD + c0 + 4 * fq);
            const size_t xo = (size_t)(NP_ROWS + r) * DM + c0 + 4 * fq; f32x4 xv = *(const f32x4*)(F.X() + xo); xv = xv + g * s; *(f32x4*)(F.X_ST() + xo) = xv; }
        __syncthreads();
    }
}

#ifndef EN_P0
#define EN_P0 1
#endif
#ifndef EN_G
#define EN_G 1
#endif
#ifndef EN_N
#define EN_N 1
#endif
#ifndef EN_M2
#define EN_M2 1
#endif
#ifndef EN_M3
#define EN_M3 1
#endif
#ifndef EN_M4
#define EN_M4 1
#endif
#ifndef EN_G1
#define EN_G1 1
#endif
#ifndef EN_GIN
#define EN_GIN 1
#endif
#ifndef EN_GOUT
#define EN_GOUT 1
#endif
#ifndef EN_GGU
#define EN_GGU 1
#endif
#ifndef EN_GDN
#define EN_GDN 1
#endif
#ifndef PROBE_DUP
#define PROBE_DUP 0
#endif
#ifndef MK_SINGLE
#define MK_SINGLE 1
#endif

#define PH_ARGS unsigned ldsb_, unsigned wslo_, unsigned wshi_, unsigned olo_, unsigned ohi_, int wave_, int vcu_, int G_, int probe_, int l_
#define PH_PASS ldsb, wslo, wshi, olo, ohi, F.wave, F.vcu, F.G, F.probe
#define PH_FRAME() Frame F; { const unsigned a0 = __builtin_amdgcn_readfirstlane(ldsb_), a1 = __builtin_amdgcn_readfirstlane(wslo_), a2 = __builtin_amdgcn_readfirstlane(wshi_), a3 = __builtin_amdgcn_readfirstlane(olo_), a4 = __builtin_amdgcn_readfirstlane(ohi_); \
    F.lds = (LAS unsigned char*)(unsigned long long)a0; F.MISC = (volatile LAS unsigned*)(F.lds + MISC_OFF); F.ws = (unsigned char*)(((unsigned long long)a2 << 32) | a1); F.out = (float*)(((unsigned long long)a4 << 32) | a3); \
    F.wave = __builtin_amdgcn_readfirstlane(wave_); F.vcu = __builtin_amdgcn_readfirstlane(vcu_); F.G = __builtin_amdgcn_readfirstlane(G_); F.zo = 0; F.probe = __builtin_amdgcn_readfirstlane(probe_); } \
    const int l = __builtin_amdgcn_readfirstlane(l_); (void)l; \
    const Args& args = *(const Args*)__builtin_amdgcn_kernarg_segment_ptr();
__device__ __forceinline__ void ph_prologue(PH_ARGS) { PH_FRAME(); p0_prologue(F, args); }
__device__ __forceinline__ void ph_sctable(PH_ARGS) { PH_FRAME(); sc_table(F, args); }
__device__ __forceinline__ void ph_norm1(PH_ARGS) { PH_FRAME(); norm_mod_rows(F, args.in[I_GMIX] + l * DM, F.MOD() + (size_t)l * MODW); }
__device__ __forceinline__ void ph_norm2(PH_ARGS) { PH_FRAME(); norm_mod_rows(F, args.in[I_GFFN] + l * DM, F.MOD() + (size_t)l * MODW + 6144); }
__device__ __forceinline__ void ph_final(PH_ARGS) { PH_FRAME(); final_norm_rows(F, args); }
__device__ __forceinline__ void ph_mixa(PH_ARGS) { PH_FRAME();
    const int gw = F.vcu * NWAVES + F.wave, NGW = F.G * NWAVES; LAS float* wscr = (LAS float*)(F.lds + RING_OFF + F.wave * 16384);
    for (int u = F.vcu; u < GL_NSLOT; u += F.G) gla_prep_unit(F, args, l, u);
    for (int u = F.vcu; u < 512; u += F.G) attn_unit_mfma(F, args, l, u);
    for (int it = gw; it < 512 * 4; it += NGW) pool_item_mfma(F, args, l, it >> 2, it & 3);
    { const int gwr = (F.G - 1 - F.vcu) + F.G * F.wave;
      for (int it = gwr; it < NS_ROWS * 8; it += NGW) attn_item(F, args, l, NP_ROWS + (it >> 3), it & 7, wscr);
      for (int it = gwr - 4 * F.G; it < NS_ROWS * 4; it += NGW) if (it >= 0) pool_item(F, args, l, NP_ROWS + (it >> 2), it & 3, wscr); }
    cache_outputs(F, args, l);
}
__device__ __forceinline__ void ph_gla1(PH_ARGS) { PH_FRAME(); gla_phase_g1(F, args, l); }
__device__ __forceinline__ void ph_gla2(PH_ARGS) { PH_FRAME(); gla_phase_g2(F, args, l); }
__device__ __forceinline__ void ph_mixc(PH_ARGS) { PH_FRAME(); const int gw = F.vcu * NWAVES + F.wave, NGW = F.G * NWAVES;
#pragma unroll 4
    for (int it = gw; it < NROWS * 4; it += NGW) gla_out_item(F, args, l, it >> 2, it & 3); }
constexpr int PH_PER_LAYER = 10, PH_LAYER0 = 1, PH_FINAL = PH_LAYER0 + DEPTH * PH_PER_LAYER, PH_COUNT = PH_FINAL + 1;
__global__ void __launch_bounds__(NTHREADS, 2) hymba_fwd(Args args) {
    extern __shared__ __attribute__((aligned(16))) unsigned char lds[];
    Frame F;
    F.lds = (LAS unsigned char*)lds;
    F.MISC = (volatile LAS unsigned*)(F.lds + MISC_OFF);
    F.wave = __builtin_amdgcn_readfirstlane((int)threadIdx.x >> 6); F.zo = 0; F.probe = 0;
    F.G = gridDim.x; { const int bx = blockIdx.x; F.vcu = (F.G % 8 == 0) ? (bx % 8) * (F.G / 8) + bx / 8 : bx; }
    F.ws = args.ws; F.out = args.out;
    gu32* const ctl = (gu32*)(F.ws + WS_CTL);
    for (int u = threadIdx.x; u < (LDS_BYTES - LDSCTL_OFF) / 4; u += NTHREADS) ((LAS unsigned*)(F.lds + LDSCTL_OFF))[u] = 0u;
    __syncthreads();
#if MK_SINGLE
    XcdBarrier bar = xcd_barrier_post((unsigned*)(ctl + CW_BAR), F.MISC + 8);
#define GRID_BAR() xcd_barrier(bar)
#else
#define GRID_BAR() do { } while (0)
#endif
    const int lo = args.ph_lo, hi = args.ph_hi;
    const unsigned ldsb = (unsigned)(unsigned long long)F.lds, wslo = (unsigned)(unsigned long long)F.ws, wshi = (unsigned)((unsigned long long)F.ws >> 32), olo = (unsigned)(unsigned long long)F.out, ohi = (unsigned)((unsigned long long)F.out >> 32);
#define IN(k) (lo <= (k) && (k) < hi)
#define BOTH(k) (IN(k) && IN((k) + 1))
#define PHASE_BEGIN() asm volatile("s_mov_b32 %0, 0" : "=s"(F.zo), "+s"(F.G), "+s"(F.vcu), "+s"(F.wave))
#define gw (F.vcu * NWAVES + F.wave)
#define NGW (F.G * NWAVES)
#define wscr ((LAS float*)(F.lds + RING_OFF + F.wave * 16384))

    if (EN_P0 && IN(0)) { PHASE_BEGIN(); ph_sctable(PH_PASS, 0); GRID_BAR(); }
    if (EN_P0 && IN(0)) for (int rep_ = 0; rep_ < ((PROBE_DUP & 1) ? 2 : 1); ++rep_) { PHASE_BEGIN(); ph_prologue(PH_PASS, 0); if (BOTH(0)) GRID_BAR(); }
    for (int l = 0; l < DEPTH; ++l) {
        const int pb = PH_LAYER0 + l * PH_PER_LAYER;
        const float* modl = F.MOD() + (size_t)l * MODW;
        if (EN_N && IN(pb + 0)) for (int rep_ = 0; rep_ < ((PROBE_DUP & 2) ? 2 : 1); ++rep_) { PHASE_BEGIN(); ph_norm1(PH_PASS, l); if (BOTH(pb + 0)) GRID_BAR(); }
        if (EN_G && EN_GIN && IN(pb + 1)) for (int rep_ = 0; rep_ < ((PROBE_DUP & 4) ? 2 : 1); ++rep_) { PHASE_BEGIN();
            pg8::Gemm g{F.H(), F.Win_t() + (size_t)l * ZW * DM, MPAD, ZW, DM}; pg8::StaticOrder S; S.init(MPAD, ZW, F.G, (int)blockIdx.x);
            pg8::EpiZ E{F.Z(), ZW};
            pg8::gemm_phase<pg8::EpiZ, pg8::StaticOrder, true, true>(F.lds + RING_OFF, g, S, E, F.wave);
            if (BOTH(pb + 1)) GRID_BAR();
        }
        if (EN_M2 && IN(pb + 2)) for (int rep_ = 0; rep_ < ((PROBE_DUP & 8) ? 2 : 1); ++rep_) { PHASE_BEGIN();
            ph_mixa(PH_PASS, l);
            if (BOTH(pb + 2)) GRID_BAR();
        }
        if (EN_M3 && IN(pb + 3)) for (int rep_ = 0; rep_ < ((PROBE_DUP & 16) ? 2 : 1); ++rep_) { PHASE_BEGIN(); F.probe = ((PROBE_DUP & 16) && rep_ == 0) ? 1 : 0; ph_gla1(PH_PASS, l); if (BOTH(pb + 3)) GRID_BAR(); }
        if (EN_M3 && IN(pb + 4)) for (int rep_ = 0; rep_ < ((PROBE_DUP & 32) ? 2 : 1); ++rep_) { PHASE_BEGIN(); F.probe = ((PROBE_DUP & 32) && rep_ == 0) ? 1 : 0;
            ph_gla2(PH_PASS, l);
            if (BOTH(pb + 4)) GRID_BAR();
        }
        if (EN_M4 && IN(pb + 5)) for (int rep_ = 0; rep_ < ((PROBE_DUP & 64) ? 2 : 1); ++rep_) { PHASE_BEGIN(); ph_mixc(PH_PASS, l); if (BOTH(pb + 5)) GRID_BAR(); }
        if (EN_G && EN_GOUT && IN(pb + 6)) for (int rep_ = 0; rep_ < ((PROBE_DUP & 128) ? 2 : 1); ++rep_) { PHASE_BEGIN(); F.probe = ((PROBE_DUP & 128) && rep_ == 0) ? 1 : 0;
            pg8::Gemm g{F.MIX(), F.Wout_t() + (size_t)l * DM * DM, NP_ROWS, DM, DM}; pg8::StaticOrder S; S.init(NP_ROWS, DM, F.G, (int)blockIdx.x);
            pg8::EpiResid E{F.X(), modl + 4096, F.X_ST()};
            pg8::gemm_phase<pg8::EpiResid, pg8::StaticOrder, true, true>(F.lds + RING_OFF, g, S, E, F.wave);
            if ((PROBE_DUP & 512) && !F.probe) { F.probe = 1; skinny_resid(F, F.MIX() + (size_t)NP_ROWS * DM, F.Wout_t() + (size_t)l * DM * DM, DM, modl + 4096); F.probe = 0; }
            skinny_resid(F, F.MIX() + (size_t)NP_ROWS * DM, F.Wout_t() + (size_t)l * DM * DM, DM, modl + 4096);
            if (BOTH(pb + 6)) GRID_BAR();
        }
        if (EN_N && IN(pb + 7)) for (int rep_ = 0; rep_ < ((PROBE_DUP & 2) ? 2 : 1); ++rep_) { PHASE_BEGIN(); ph_norm2(PH_PASS, l); if (BOTH(pb + 7)) GRID_BAR(); }
        if (EN_G && EN_GGU && IN(pb + 8)) for (int rep_ = 0; rep_ < ((PROBE_DUP & 4) ? 2 : 1); ++rep_) { PHASE_BEGIN();
            pg8::Gemm g{F.H(), F.Wgu_t() + (size_t)l * NGU * DM, MPAD, NGU, DM}; pg8::StaticOrder S; S.init(MPAD, NGU, F.G, (int)blockIdx.x);
            pg8::EpiSwiGLU E{F.ACT(), DFF};
            pg8::gemm_phase<pg8::EpiSwiGLU, pg8::StaticOrder, true, true>(F.lds + RING_OFF, g, S, E, F.wave);
            if (BOTH(pb + 8)) GRID_BAR();
        }
        if (EN_G && EN_GDN && IN(pb + 9)) for (int rep_ = 0; rep_ < ((PROBE_DUP & 256) ? 2 : 1); ++rep_) { PHASE_BEGIN(); F.probe = ((PROBE_DUP & 256) && rep_ == 0) ? 1 : 0;
            pg8::Gemm g{F.ACT(), F.Wdn_t() + (size_t)l * DM * DFF, NP_ROWS, DM, DFF}; pg8::StaticOrder S; S.init(NP_ROWS, DM, F.G, (int)blockIdx.x);
            pg8::EpiResid E{F.X(), modl + 10240, F.X_ST()};
            pg8::gemm_phase<pg8::EpiResid, pg8::StaticOrder, true, true>(F.lds + RING_OFF, g, S, E, F.wave);
            if ((PROBE_DUP & 512) && !F.probe) { F.probe = 1; skinny_resid(F, F.ACT() + (size_t)NP_ROWS * DFF, F.Wdn_t() + (size_t)l * DM * DFF, DFF, modl + 10240); F.probe = 0; }
            skinny_resid(F, F.ACT() + (size_t)NP_ROWS * DFF, F.Wdn_t() + (size_t)l * DM * DFF, DFF, modl + 10240);
            if (BOTH(pb + 9)) GRID_BAR();
        }
    }
    if (IN(PH_FINAL)) { PHASE_BEGIN(); ph_final(PH_PASS, 0); }
#ifdef PROBE_SCALE
    GRID_BAR();
    { const size_t offs[11] = {O_Y, 16777216, O_WK_P, O_WV_P, O_POOL_P, O_GLA_P, O_WK_S, O_WV_S, O_POOL_S, O_GLA_S, O_END};
      const size_t gt_ = (size_t)(F.vcu * NWAVES + F.wave) * 64 + F.lane_id(), NGT_ = (size_t)F.G * NWAVES * 64;
      for (int k = 0; k < 10; ++k) { const float sc = 1.0f + 0.05f * (float)(k + 1); for (size_t i = offs[k] + gt_; i < offs[k + 1]; i += NGT_) F.out[i] *= sc; } }
#endif
#undef IN
#undef BOTH
#undef gw
#undef NGW
#undef wscr
}

extern "C" void kernel_launch(void* const* d_in, const int* in_sizes, int n_in, void* d_out, int out_size, void* d_ws, size_t ws_size, hipStream_t stream) {
    static int grid = 0;
    if (grid == 0) {
        if (n_in != 24 || out_size != (int)O_END || ws_size < WS_END) { fprintf(stderr, "kernel_launch: unexpected sizes n_in %d out %d ws %zu\n", n_in, out_size, ws_size); grid = -1; return; }
        int dev = 0, cus = 0;
        if (hipGetDevice(&dev) != hipSuccess || hipDeviceGetAttribute(&cus, hipDeviceAttributeMultiprocessorCount, dev) != hipSuccess) { grid = -1; return; }
        if (hipFuncSetAttribute((const void*)hymba_fwd, hipFuncAttributeMaxDynamicSharedMemorySize, LDS_BYTES) != hipSuccess) { fprintf(stderr, "kernel_launch: hipFuncSetAttribute failed\n"); grid = -1; return; }
        (void)hipGetLastError();
        grid = cus;
    }
    if (grid < 0) return;
    (void)hipMemsetAsync((char*)d_ws + WS_CTL, 0, CTL_ZERO_BYTES, stream);
    Args a{};
    for (int i = 0; i < 24; ++i) a.in[i] = (const float*)d_in[i];
    a.out = (float*)d_out; a.ws = (unsigned char*)d_ws;
#if MK_SINGLE
    a.ph_lo = 0; a.ph_hi = PH_COUNT;
    hipLaunchKernelGGL(hymba_fwd, dim3(grid), dim3(NTHREADS), LDS_BYTES, stream, a);
#else
    for (int p = 0; p < PH_COUNT; ++p) { a.ph_lo = p; a.ph_hi = p + 1; hipLaunchKernelGGL(hymba_fwd, dim3(grid), dim3(NTHREADS), LDS_BYTES, stream, a); }
#endif
}
```

```cpp
#include <hip/hip_runtime.h>
#include <cstdio>
#include <cstdint>
#include <cmath>
namespace pg8 {
#define PG8_LAS __attribute__((address_space(3)))
typedef unsigned short bf16_t;
typedef short bf16x8 __attribute__((ext_vector_type(8)));
typedef float f32x4 __attribute__((ext_vector_type(4)));
typedef unsigned u32x4 __attribute__((ext_vector_type(4)));
constexpr int BM = 256, BK = 64, HALF = 128, HTB = HALF * BK * 2  , STAGE_BYTES = 8 * HTB, NXCD = 8, WGM = 8;

__host__ __device__ __forceinline__ int lds_byte(int r, int c) { const int st = (r >> 4) * 2 + (c >> 5), rr = r & 15, cc = c & 31, ob = rr * 64 + cc * 2; return st * 1024 + (ob ^ (((ob >> 9) & 1) << 5)); }
__host__ __device__ __forceinline__ void stage_rc(int b, int& R, int& C) { const int st = b / 1024, sb = b % 1024, swz = sb ^ (((sb >> 9) & 1) << 5); R = (st >> 1) * 16 + swz / 64; C = (st & 1) * 32 + (swz % 64) / 2; }
__host__ __device__ __forceinline__ int perm32(int rho) { const int n = rho >> 4, i = rho & 15; return 8 * (i >> 2) + 4 * n + (i & 3); }

struct Unit { int pm, pn; };
struct Gemm { const bf16_t* A; const bf16_t* Bt; int M, N, K; };

struct StaticOrder {
    int nM, nN, nwg, G, c;
    __host__ __device__ void init(int M, int N, int G_, int c_) { nM = M / BM; nN = N / BM; nwg = nM * nN; G = G_; c = c_; }
    __host__ __device__ __forceinline__ bool next(int i, Unit& u) const {
        const long L = (long)i * G + c; if (L >= nwg) return false;
        int wgid = (int)L; { const int q = nwg / NXCD, r = nwg % NXCD, xcd = wgid % NXCD, off = wgid / NXCD; wgid = (xcd < r ? xcd * (q + 1) : r * (q + 1) + (xcd - r) * q) + off; }
        const int nig = WGM * nN, gid = wgid / nig, fm = gid * WGM, gsz = (nM - fm) < WGM ? (nM - fm) : WGM;
        u.pm = fm + ((wgid % nig) % gsz); u.pn = (wgid % nig) / gsz; return true;
    }
    __device__ __forceinline__ void a_ready(const Unit&) const {}
    __device__ __forceinline__ void done(const Unit&) const {}
};

__device__ __forceinline__ unsigned cvt_pk_bf16(float lo, float hi) { unsigned r; asm volatile("v_cvt_pk_bf16_f32 %0, %1, %2" : "=v"(r) : "v"(lo), "v"(hi)); return r; }
typedef float f32x2 __attribute__((ext_vector_type(2)));
constexpr int MODLD_ = 49152;
__device__ __forceinline__ float fast_sigmoid(float x) { return __builtin_amdgcn_rcpf(1.0f + __expf(-x)); }
struct EpiZ {
    static constexpr bool PERM = true, AFTER_DRAIN = false;
    bf16_t* O; int ldc;
    __device__ __forceinline__ void operator()(const f32x4 (&acc)[2][2][4][2], const Unit& u, int wr, int wc, int fr, int fq) const {
        const int row0 = u.pm * BM + wr * 64 + fr, col0 = u.pn * BM + wc * 32 + 8 * fq;
#pragma unroll
        for (int ai = 0; ai < 2; ++ai)
#pragma unroll
            for (int m = 0; m < 4; ++m) { bf16_t* rowp = O + (size_t)(row0 + ai * HALF + m * 16) * ldc + col0;
#pragma unroll
                for (int bj = 0; bj < 2; ++bj) { const f32x4 v0 = acc[ai][bj][m][0], v1 = acc[ai][bj][m][1];
                    u32x4 w; w.x = cvt_pk_bf16(v0[0], v0[1]); w.y = cvt_pk_bf16(v0[2], v0[3]); w.z = cvt_pk_bf16(v1[0], v1[1]); w.w = cvt_pk_bf16(v1[2], v1[3]);
                    *(u32x4*)(rowp + bj * HALF) = w; } }
    }
};
struct EpiSwiGLU {
    static constexpr bool PERM = true, AFTER_DRAIN = false;
    bf16_t* O; int ldc;
    __device__ __forceinline__ void operator()(const f32x4 (&acc)[2][2][4][2], const Unit& u, int wr, int wc, int fr, int fq) const {
        const int row0 = u.pm * BM + wr * 64 + fr, col0 = u.pn * HALF + wc * 32 + 8 * fq;
#pragma unroll
        for (int ai = 0; ai < 2; ++ai)
#pragma unroll
            for (int m = 0; m < 4; ++m) { bf16_t* rowp = O + (size_t)(row0 + ai * HALF + m * 16) * ldc + col0;
                float r[8];
#pragma unroll
                for (int n = 0; n < 2; ++n)
#pragma unroll
                    for (int i = 0; i < 4; ++i) { const float g = acc[ai][0][m][n][i], up = acc[ai][1][m][n][i]; r[n * 4 + i] = g * fast_sigmoid(g) * up; }
                u32x4 w; w.x = cvt_pk_bf16(r[0], r[1]); w.y = cvt_pk_bf16(r[2], r[3]); w.z = cvt_pk_bf16(r[4], r[5]); w.w = cvt_pk_bf16(r[6], r[7]);
                *(u32x4*)rowp = w; }
    }
};
struct EpiResid {
    static constexpr bool PERM = false, AFTER_DRAIN = false;
    float* X; const float* gate; float* XS;
    __device__ __forceinline__ void operator()(const f32x4 (&acc)[2][2][4][2], const Unit& u, int wr, int wc, int fr, int fq) const {
        const int col0 = u.pn * BM + wc * 32 + 4 * fq;
        if (u.pm < 32) {
            const float* g = gate + (size_t)(u.pm >> 3) * MODLD_ + col0;
            f32x4 gv[2][2];
#pragma unroll
            for (int bj = 0; bj < 2; ++bj)
#pragma unroll
                for (int n = 0; n < 2; ++n) gv[bj][n] = *(const f32x4*)(g + bj * HALF + n * 16);
#pragma unroll
            for (int ai = 0; ai < 2; ++ai)
#pragma unroll
                for (int m = 0; m < 4; ++m) { const size_t xo = (size_t)(u.pm * BM + ai * HALF + wr * 64 + m * 16 + fr) * 2048 + col0; const float* xp = X + xo; float* xs = XS + xo;
#pragma unroll
                    for (int bj = 0; bj < 2; ++bj)
#pragma unroll
                        for (int n = 0; n < 2; ++n) { f32x4 xv = *(const f32x4*)(xp + bj * HALF + n * 16); xv = xv + gv[bj][n] * acc[ai][bj][m][n]; *(f32x4*)(xs + bj * HALF + n * 16) = xv; } }
        } else {
#pragma unroll
            for (int m = 0; m < 4; ++m) { const int rl = wr * 64 + m * 16 + fr;
                const float* g = gate + (size_t)(4 + (rl >> 2)) * MODLD_ + col0; float* xp = X + (size_t)(8192 + rl) * 2048 + col0;
#pragma unroll
                for (int bj = 0; bj < 2; ++bj)
#pragma unroll
                    for (int n = 0; n < 2; ++n) { const f32x4 gvv = *(const f32x4*)(g + bj * HALF + n * 16); f32x4 xv = *(const f32x4*)(xp + bj * HALF + n * 16);
                        xv = xv + gvv * acc[0][bj][m][n]; *(f32x4*)(xp + bj * HALF + n * 16) = xv; } }
        }
    }
};
struct EpiMod {
    static constexpr bool PERM = false, AFTER_DRAIN = false;
    float* M; const float* bias;
    __device__ __forceinline__ void operator()(const f32x4 (&acc)[2][2][4][2], const Unit& u, int wr, int wc, int fr, int fq) const {
        if (wr != 0) return;
        const int col0 = u.pn * BM + wc * 32 + 4 * fq;
#pragma unroll
        for (int m = 0; m < 3; ++m) { const int r = m * 16 + fr;
            if (r < 36) {
#pragma unroll
                for (int bj = 0; bj < 2; ++bj)
#pragma unroll
                    for (int n = 0; n < 2; ++n) { const f32x4 bv = *(const f32x4*)(bias + col0 + bj * HALF + n * 16);
                        *(f32x4*)(M + (size_t)r * MODLD_ + col0 + bj * HALF + n * 16) = acc[0][bj][m][n] + bv; } } }
    }
};

template <class Epi, class Sched, bool ALIGN_EPI = false, bool SP2 = false>
__device__ __forceinline__ void gemm_phase(PG8_LAS unsigned char* lds, const Gemm g, const Sched& S, const Epi& E, int wid_in) {
    int lane_ = (int)__builtin_amdgcn_mbcnt_hi(~0u, __builtin_amdgcn_mbcnt_lo(~0u, 0u)); asm volatile("" : "+v"(lane_));
    const int wid = __builtin_amdgcn_readfirstlane(wid_in), lane = lane_, tid = wid * 64 + lane, wr = wid >> 2, wc = wid & 3, fr = lane & 15, fq = lane >> 4;
    int K_ = g.K; asm volatile("" : "+s"(K_));
    const int K = K_, nt = K / BK;
    unsigned voffA[2], voffB[2];
#pragma unroll
    for (int i = 0; i < 2; ++i) { int R, C; stage_rc(tid * 16 + i * 8192, R, C); const int Rb = Epi::PERM ? ((R & ~31) + perm32(R & 31)) : R;
        voffA[i] = (unsigned)(R * K + C) * 2u; voffB[i] = (unsigned)(Rb * K + C) * 2u; }
    const size_t kstep = (size_t)(BK * 2);
    const size_t hstep = (size_t)HALF * K * 2;
    const size_t tstep = 2 * hstep;
    const unsigned ldsw = (unsigned)wid * 1024u;
    const int aoff = lds_byte(wr * 64 + fr, fq * 8), boff = lds_byte(wc * 32 + fr, fq * 8);
#define PG8_SA(b, h) (((b) * 2 + (h)) * HTB)
#define PG8_SB(b, h) ((4 + (b) * 2 + (h)) * HTB)
#define PG8_STAGE(bufoff, gbase, voff) do { _Pragma("unroll") for (int _i = 0; _i < 2; ++_i) \
        __builtin_amdgcn_global_load_lds((const unsigned*)((const char*)(gbase) + (voff)[_i]), (PG8_LAS unsigned*)(lds + (bufoff) + ldsw + _i * 8192), 16, 0, 0); } while (0)
#define PG8_LDA(dst, b, h) do { _Pragma("unroll") for (int m = 0; m < 4; ++m) _Pragma("unroll") for (int k = 0; k < 2; ++k) dst[m][k] = *(const PG8_LAS bf16x8*)(lds + PG8_SA(b, h) + aoff + m * 2048 + k * 1024); } while (0)
#define PG8_LDB(dst, b, h) do { _Pragma("unroll") for (int n = 0; n < 2; ++n) _Pragma("unroll") for (int k = 0; k < 2; ++k) dst[n][k] = *(const PG8_LAS bf16x8*)(lds + PG8_SB(b, h) + boff + n * 2048 + k * 1024); } while (0)
#define PG8_MMA(ai, bj, At, Bt) do { __builtin_amdgcn_s_setprio(1); _Pragma("unroll") for (int m = 0; m < 4; ++m) _Pragma("unroll") for (int n = 0; n < 2; ++n) _Pragma("unroll") for (int k = 0; k < 2; ++k) \
        acc[ai][bj][m][n] = __builtin_amdgcn_mfma_f32_16x16x32_bf16(Bt[n][k], At[m][k], acc[ai][bj][m][n], 0, 0, 0); __builtin_amdgcn_s_setprio(0); } while (0)
#define PG8_WAIT_V(n) asm volatile("s_waitcnt vmcnt(" #n ")" ::: "memory")
#define PG8_WAIT_L(n) asm volatile("s_waitcnt lgkmcnt(" #n ")" ::: "memory")
#define PG8_BAR __builtin_amdgcn_s_barrier()
#define PG8_SCHED __builtin_amdgcn_sched_barrier(0)
    Unit cur, nxt; int ui = 0;
    if (!S.next(0, cur)) return;
    f32x4 acc[2][2][4][2];
#pragma unroll
    for (int a = 0; a < 2; ++a)
#pragma unroll
        for (int b = 0; b < 2; ++b)
#pragma unroll
            for (int m = 0; m < 4; ++m)
#pragma unroll
                for (int n = 0; n < 2; ++n) acc[a][b][m][n] = (f32x4){0.f, 0.f, 0.f, 0.f};
    bf16x8 At[4][2], B0[2][2], B1[2][2];
    const char* cA = (const char*)g.A + (size_t)cur.pm * tstep; const char* cB = (const char*)g.Bt + (size_t)cur.pn * tstep;
    S.a_ready(cur);
    if constexpr (SP2) {
        PG8_STAGE(PG8_SB(0, 0), cB, voffB); PG8_STAGE(PG8_SB(0, 1), cB + hstep, voffB); PG8_STAGE(PG8_SA(0, 0), cA, voffA); PG8_STAGE(PG8_SA(0, 1), cA + hstep, voffA);
        if (wr == 1) PG8_BAR;
        PG8_WAIT_V(2); PG8_BAR;
        PG8_STAGE(PG8_SB(1, 0), cB + kstep, voffB); PG8_STAGE(PG8_SA(1, 0), cA + kstep, voffA); PG8_STAGE(PG8_SB(1, 1), cB + hstep + kstep, voffB);
        PG8_WAIT_V(6); PG8_BAR;
    } else {
        PG8_STAGE(PG8_SB(0, 0), cB, voffB); PG8_STAGE(PG8_SA(0, 0), cA, voffA); PG8_STAGE(PG8_SB(0, 1), cB + hstep, voffB); PG8_STAGE(PG8_SA(0, 1), cA + hstep, voffA);
        if (wr == 1) PG8_BAR;
        PG8_WAIT_V(4); PG8_BAR;
        PG8_STAGE(PG8_SB(1, 0), cB + kstep, voffB); PG8_STAGE(PG8_SA(1, 0), cA + kstep, voffA); PG8_STAGE(PG8_SB(1, 1), cB + hstep + kstep, voffB);
        PG8_WAIT_V(6); PG8_BAR;
    }
    for (;;) {
        const bool has_next = S.next(ui + 1, nxt);
        const char* nA = has_next ? (const char*)g.A + (size_t)nxt.pm * tstep : cA; const char* nB = has_next ? (const char*)g.Bt + (size_t)nxt.pn * tstep : cB;
        for (int t = 0; t < nt; t += 2) {
            const bool last = (t == nt - 2);
            const char* a1 = cA + (size_t)(t + 1) * kstep;
            const char* a2 = last ? nA : cA + (size_t)(t + 2) * kstep; const char* b2 = last ? nB : cB + (size_t)(t + 2) * kstep;
            const char* a3 = a2 + kstep; const char* b3 = b2 + kstep;
            if (last && has_next) S.a_ready(nxt);
            if constexpr (SP2) {
            PG8_LDB(B0, 0, 0); PG8_LDB(B1, 0, 1); PG8_SCHED; PG8_LDA(At, 0, 0); PG8_STAGE(PG8_SA(1, 1), a1 + hstep, voffA);
            PG8_WAIT_V(8); PG8_WAIT_L(0); PG8_BAR; PG8_MMA(0, 0, At, B0); PG8_MMA(0, 1, At, B1); PG8_BAR; PG8_SCHED;
            PG8_LDA(At, 0, 1); PG8_STAGE(PG8_SB(0, 0), b2, voffB); PG8_STAGE(PG8_SB(0, 1), b2 + hstep, voffB); PG8_STAGE(PG8_SA(0, 0), a2, voffA);
            PG8_WAIT_V(8); PG8_WAIT_L(0); PG8_BAR; PG8_MMA(1, 0, At, B0); PG8_MMA(1, 1, At, B1); PG8_BAR; PG8_SCHED;
            PG8_LDB(B0, 1, 0); PG8_LDB(B1, 1, 1); PG8_SCHED; PG8_LDA(At, 1, 0); PG8_STAGE(PG8_SA(0, 1), a2 + hstep, voffA);
            PG8_WAIT_V(8); PG8_WAIT_L(0); PG8_BAR; PG8_MMA(0, 0, At, B0); PG8_MMA(0, 1, At, B1); PG8_BAR; PG8_SCHED;
            PG8_LDA(At, 1, 1); PG8_STAGE(PG8_SB(1, 0), b3, voffB); PG8_STAGE(PG8_SB(1, 1), b3 + hstep, voffB); PG8_STAGE(PG8_SA(1, 0), a3, voffA);
            PG8_WAIT_V(8); PG8_WAIT_L(0); PG8_BAR; PG8_MMA(1, 0, At, B0); PG8_MMA(1, 1, At, B1); PG8_BAR; PG8_SCHED;
            } else {
            PG8_LDB(B0, 0, 0); PG8_SCHED; PG8_LDA(At, 0, 0); PG8_STAGE(PG8_SA(1, 1), a1 + hstep, voffA);
            PG8_WAIT_L(8); PG8_BAR; PG8_WAIT_L(0); PG8_MMA(0, 0, At, B0); PG8_BAR; PG8_SCHED;
            PG8_LDB(B1, 0, 1); PG8_STAGE(PG8_SB(0, 0), b2, voffB);
            PG8_BAR; PG8_WAIT_L(0); PG8_MMA(0, 1, At, B1); PG8_BAR;
            PG8_LDA(At, 0, 1); PG8_STAGE(PG8_SA(0, 0), a2, voffA);
            PG8_BAR; PG8_WAIT_L(0); PG8_MMA(1, 0, At, B0); PG8_BAR; PG8_SCHED;
            PG8_STAGE(PG8_SB(0, 1), b2 + hstep, voffB);
            PG8_WAIT_V(6); PG8_BAR; PG8_MMA(1, 1, At, B1); PG8_BAR;
            PG8_LDB(B0, 1, 0); PG8_SCHED; PG8_LDA(At, 1, 0); PG8_STAGE(PG8_SA(0, 1), a2 + hstep, voffA);
            PG8_WAIT_L(8); PG8_BAR; PG8_WAIT_L(0); PG8_MMA(0, 0, At, B0); PG8_BAR; PG8_SCHED;
            PG8_LDB(B1, 1, 1); PG8_STAGE(PG8_SB(1, 0), b3, voffB);
            PG8_BAR; PG8_WAIT_L(0); PG8_MMA(0, 1, At, B1); PG8_BAR;
            PG8_LDA(At, 1, 1); PG8_STAGE(PG8_SA(1, 0), a3, voffA);
            PG8_BAR; PG8_WAIT_L(0); PG8_MMA(1, 0, At, B0); PG8_BAR; PG8_SCHED;
            PG8_STAGE(PG8_SB(1, 1), b3 + hstep, voffB);
            PG8_WAIT_V(6); PG8_BAR; PG8_MMA(1, 1, At, B1); PG8_BAR;
            }
        }
        if constexpr (ALIGN_EPI) { if (wr == 0) PG8_BAR; }
        if constexpr (!Epi::AFTER_DRAIN) { E(acc, cur, wr, wc, fr, fq); S.done(cur); }
        if (!has_next) break;
#pragma unroll
        for (int a = 0; a < 2; ++a)
#pragma unroll
            for (int b = 0; b < 2; ++b)
#pragma unroll
                for (int m = 0; m < 4; ++m)
#pragma unroll
                    for (int n = 0; n < 2; ++n) acc[a][b][m][n] = (f32x4){0.f, 0.f, 0.f, 0.f};
        cur = nxt; cA = nA; cB = nB; ++ui;
        if constexpr (ALIGN_EPI) { if (wr == 1) PG8_BAR; }
    }
    PG8_WAIT_V(0);
    if constexpr (!ALIGN_EPI) { if (wr == 0) PG8_BAR; }
    PG8_BAR;
    if constexpr (Epi::AFTER_DRAIN) { E.fused(acc, cur, wr, wc, fr, fq, lds, wid, lane); S.done(cur); }
#undef PG8_SA
#undef PG8_SB
#undef PG8_STAGE
#undef PG8_LDA
#undef PG8_LDB
#undef PG8_MMA
#undef PG8_WAIT_V
#undef PG8_WAIT_L
#undef PG8_BAR
#undef PG8_SCHED
}
}
#define GAS __attribute__((address_space(1)))
#define LAS __attribute__((address_space(3)))
typedef unsigned short bf16;
typedef unsigned v4u __attribute__((ext_vector_type(4)));
typedef float f32x4 __attribute__((ext_vector_type(4)));
typedef short bf16x8 __attribute__((ext_vector_type(8)));
typedef GAS unsigned gu32;
typedef GAS unsigned long long gu64;
#define RLX_AGENT __ATOMIC_RELAXED, __HIP_MEMORY_SCOPE_AGENT
#define LDS_WAIT() asm volatile("s_waitcnt lgkmcnt(0)" ::: "memory")
#define VM_WAIT() asm volatile("s_waitcnt vmcnt(0)" ::: "memory")
__device__ __forceinline__ unsigned long long rt() { return __builtin_amdgcn_s_memrealtime(); }
__device__ __forceinline__ unsigned f2bf(float f) { unsigned u = __builtin_bit_cast(unsigned, f); return (u + 0x7fffu + ((u >> 16) & 1u)) >> 16; }
__device__ __forceinline__ unsigned pk2(float lo, float hi) { return f2bf(lo) | (f2bf(hi) << 16); }

#define XB_TMO      128
#define XB_XCNT(j)  (256  + 64 * (j))
#define XB_XSUB(j)  (1280 + 64 * (j))
#define XB_XGEN(j)  (2304 + 64 * (j))
#define XB_TOP      3328
#define XB_TOPGEN   3392
#define XCD_BAR_WORDS 3456
#define XB_SPIN_CAP (1u << 18)

__device__ __forceinline__ unsigned xb_ld(unsigned* p)              { return __hip_atomic_load(p, __ATOMIC_RELAXED, __HIP_MEMORY_SCOPE_AGENT); }
__device__ __forceinline__ unsigned xb_add(unsigned* p, unsigned v) { return __hip_atomic_fetch_add(p, v, __ATOMIC_RELAXED, __HIP_MEMORY_SCOPE_AGENT); }
__device__ __forceinline__ unsigned xb_xcc_id() { return (unsigned)__builtin_amdgcn_s_getreg((3 << 11) | 20) & 0xFu; }
#define XB_SPIN(cond, bar) do { unsigned _sp = 0; while (cond) { __builtin_amdgcn_s_sleep(1); \
    if ((++_sp & 255u) == 0u) { if (xb_ld(&(bar)[XB_TMO])) break; if (_sp > XB_SPIN_CAP) { atomicAdd(&(bar)[XB_TMO], 1u); break; } } } } while (0)

struct XcdBarrier {
    unsigned* bar; unsigned x;
    volatile LAS unsigned* st;
};

__device__ __forceinline__ XcdBarrier xcd_barrier_post(unsigned* bar, volatile LAS unsigned* st) {
    XcdBarrier b; b.bar = bar; b.x = xb_xcc_id(); b.st = st;
    if (threadIdx.x == 0) (void)xb_add(&bar[XB_XCNT(b.x)], 1u);
    return b;
}
__device__ __forceinline__ void xcd_barrier_complete(unsigned* bar, unsigned x, unsigned& nloc, unsigned& nx) {
    const unsigned G = gridDim.x * gridDim.y * gridDim.z;
    unsigned sum, cnt, mine, sp = 0u;
    for (;;) {
        sum = 0u; cnt = 0u; mine = 0u;
#pragma unroll
        for (unsigned j = 0; j < 16; ++j) { const unsigned c = xb_ld(&bar[XB_XCNT(j)]); sum += c; cnt += (c > 0u) ? 1u : 0u; mine = (j == x) ? c : mine; }
        if (sum == G) break;
        __builtin_amdgcn_s_sleep(1);
        if ((++sp & 255u) == 0u) { if (xb_ld(&bar[XB_TMO])) break; if (sp > XB_SPIN_CAP) { atomicAdd(&bar[XB_TMO], 1u); break; } }
    }
    nloc = mine > 0u ? mine : 1u; nx = cnt > 0u ? cnt : 1u;
}

__device__ __forceinline__ void xcd_barrier(const XcdBarrier& b) {
    asm volatile("s_waitcnt vmcnt(0)" ::: "memory");
    __syncthreads();
    if (threadIdx.x == 0) {
        unsigned* bar = b.bar;
        __builtin_amdgcn_s_waitcnt(0);
        unsigned nloc = b.st[0], nx = b.st[1];
        if (nloc == 0u) { xcd_barrier_complete(bar, b.x, nloc, nx); b.st[0] = nloc; b.st[1] = nx; }
        const unsigned old = xb_add(&bar[XB_XSUB(b.x)], 1u);
        const unsigned gen = old / nloc;
        if (old + 1u == (gen + 1u) * nloc) {
            __builtin_amdgcn_fence(__ATOMIC_RELEASE, "agent");
            asm volatile("s_waitcnt vmcnt(0)" ::: "memory");
            const unsigned og = xb_add(&bar[XB_TOP], 1u);
            const unsigned tg = og / nx;
            if (og + 1u == (tg + 1u) * nx) xb_add(&bar[XB_TOPGEN], 1u);
            else XB_SPIN(xb_ld(&bar[XB_TOPGEN]) == tg, bar);
            __builtin_amdgcn_fence(__ATOMIC_ACQUIRE, "agent");
            xb_add(&bar[XB_XGEN(b.x)], 1u);
            asm volatile("s_waitcnt vmcnt(0)" ::: "memory");
        } else {
            XB_SPIN(xb_ld(&bar[XB_XGEN(b.x)]) == gen, bar);
            __builtin_amdgcn_fence(__ATOMIC_ACQUIRE, "agent");
            asm volatile("s_waitcnt vmcnt(0)" ::: "memory");
        }
    }
    __syncthreads();
}

constexpr int NWAVES = 8, NTHREADS = 512;
constexpr int DM = 2048, NP_ROWS = 8192, NS_ROWS = 128, NROWS = 8320, MPAD = 8448;
constexpr int DEPTH = 4, NBATCH = 36;
constexpr int INW = 4368, ZW = 4608;
constexpr int ZQ = 0, ZK = 512, ZV = 640, ZU = 768, GQ = 1280, GK = 1792, GV = 2304, GG = 3328, GA = 4352;
constexpr int DFF = 5632, NGU = 11264, MODW = 12288, MODLD = 49152;
constexpr float EPS = 1e-6f;
constexpr size_t O_Y = 0, O_WK_P = 17039360, O_WV_P = 17301504, O_POOL_P = 17563648, O_GLA_P = 17686528,
                 O_WK_S = 19783680, O_WV_S = 21880832, O_POOL_S = 23977984, O_GLA_S = 24961024, O_END = 41738240;
constexpr size_t MiB = 1u << 20;
constexpr size_t WS_CTL = 0, CTL_ZERO_BYTES = 1 * MiB;
constexpr size_t WS_WADA = 1 * MiB;
constexpr size_t WS_WIN  = WS_WADA + 192 * MiB;
constexpr size_t WS_WOUT = WS_WIN + 72 * MiB;
constexpr size_t WS_WGU  = WS_WOUT + 32 * MiB;
constexpr size_t WS_WDN  = WS_WGU + 176 * MiB;
constexpr size_t WS_X    = WS_WDN + 88 * MiB;
constexpr size_t WS_H    = WS_X + 66 * MiB;
constexpr size_t WS_Z    = WS_H + 33 * MiB;
constexpr size_t WS_MIX  = WS_Z + 75 * MiB;
constexpr size_t WS_ACT  = WS_MIX + 33 * MiB;
constexpr size_t WS_OGLA = WS_ACT + 91 * MiB;
constexpr size_t WS_LA   = WS_OGLA + 33 * MiB;
constexpr size_t WS_MOD  = WS_LA + 17 * MiB;
constexpr size_t WS_SC   = WS_MOD + 7 * MiB;
constexpr size_t WS_BTAB = WS_SC + 1 * MiB;
constexpr size_t WS_WPT  = WS_BTAB + 1 * MiB;
constexpr size_t WS_QDG  = WS_WPT + 1 * MiB;
constexpr size_t WS_KDTG = WS_QDG + 9 * MiB;
constexpr size_t WS_VTG  = WS_KDTG + 11 * MiB;
constexpr size_t WS_DLG  = WS_VTG + 21 * MiB;
constexpr size_t WS_DUMMY = WS_DLG + 1 * MiB;
constexpr size_t WS_XSLOT = WS_DUMMY + 66 * MiB;
constexpr size_t WS_END  = WS_XSLOT + 2 * MiB;
constexpr int CW_BAR = 4096;
constexpr int CW_TMO = 0, CW_PAN = 16384, PAN_BANK = 32 * 64;
constexpr int RING_OFF = 0, RING_BYTES = 131072;
constexpr int LDSCTL_OFF = RING_BYTES, MISC_OFF = LDSCTL_OFF + 320;
constexpr int LDS_BYTES = 147456;

struct Args { const float* in[24]; float* out; unsigned char* ws; int ph_lo, ph_hi; };
struct Frame {
    LAS unsigned char* lds;
    volatile LAS unsigned* MISC;
    int wave, vcu, G; int zo; int probe;
    __device__ __forceinline__ float* X_ST() const { return (float*)(ws + (probe ? WS_DUMMY : WS_X)); }
    __device__ __forceinline__ float* OGLA_ST() const { return (float*)(ws + (probe ? WS_DUMMY : WS_OGLA)); }
    __device__ __forceinline__ int lane_id() const { int l = (int)__builtin_amdgcn_mbcnt_hi(~0u, __builtin_amdgcn_mbcnt_lo(~0u, 0u)); asm volatile("" : "+v"(l)); return l; }
    unsigned char* ws; float* out;
    __device__ __forceinline__ bf16* Wada_t() const { return (bf16*)(ws + WS_WADA); }
    __device__ __forceinline__ bf16* Win_t() const { return (bf16*)(ws + WS_WIN); }
    __device__ __forceinline__ bf16* Wout_t() const { return (bf16*)(ws + WS_WOUT); }
    __device__ __forceinline__ bf16* Wgu_t() const { return (bf16*)(ws + WS_WGU); }
    __device__ __forceinline__ bf16* Wdn_t() const { return (bf16*)(ws + WS_WDN); }
    __device__ __forceinline__ float* X() const { return (float*)(ws + WS_X); }
    __device__ __forceinline__ bf16* H() const { return (bf16*)(ws + WS_H); }
    __device__ __forceinline__ bf16* Z() const { return (bf16*)(ws + WS_Z); }
    __device__ __forceinline__ bf16* MIX() const { return (bf16*)(ws + WS_MIX); }
    __device__ __forceinline__ bf16* ACT() const { return (bf16*)(ws + WS_ACT); }
    __device__ __forceinline__ float* OGLA() const { return (float*)(ws + WS_OGLA); }
    __device__ __forceinline__ float* SLOC() const { return (float*)(ws + WS_LA); }
    __device__ __forceinline__ float* DSEG() const { return (float*)(ws + WS_LA + 16 * MiB); }
    __device__ __forceinline__ float* MOD() const { return (float*)(ws + WS_MOD); }
    __device__ __forceinline__ bf16* SC() const { return (bf16*)(ws + WS_SC); }
    __device__ __forceinline__ float* BTAB() const { return (float*)(ws + WS_BTAB); }
    __device__ __forceinline__ bf16* WPT() const { return (bf16*)(ws + WS_WPT); }
    __device__ __forceinline__ bf16* QDG() const { return (bf16*)(ws + WS_QDG); }
    __device__ __forceinline__ bf16* KDTG() const { return (bf16*)(ws + WS_KDTG); }
    __device__ __forceinline__ bf16* VTG() const { return (bf16*)(ws + WS_VTG); }
    __device__ __forceinline__ float* DLG() const { return (float*)(ws + WS_DLG); }
};
enum { I_XP = 0, I_XS, I_CK, I_CV, I_SPOOL, I_SGLA, I_CP, I_CS, I_WADA, I_BADA, I_GMIX, I_GFFN, I_WIN, I_WOUT, I_RELB, I_SINKS, I_WPOOL, I_PSCALE, I_WA2, I_BA2, I_GGLA, I_WGU, I_WDN, I_GFIN };

__device__ __forceinline__ float bf2f(unsigned short b) { return __uint_as_float((unsigned)b << 16); }
__device__ __forceinline__ float bflo(unsigned w) { return __uint_as_float(w << 16); }
__device__ __forceinline__ float bfhi(unsigned w) { return __uint_as_float(w & 0xffff0000u); }
__device__ __forceinline__ float wave_sum(float v) {
#pragma unroll
    for (int o = 1; o < 64; o <<= 1) v += __shfl_xor(v, o);
    return v;
}
__device__ __forceinline__ float wave_max(float v) {
#pragma unroll
    for (int o = 1; o < 64; o <<= 1) v = fmaxf(v, __shfl_xor(v, o));
    return v;
}
__device__ __forceinline__ int t5_bucket(int n) {
    if (n < 16) return n;
    return 16 + (n >= 19) + (n >= 21) + (n >= 24) + (n >= 27) + (n >= 31) + (n >= 35) + (n >= 40) + (n >= 46) + (n >= 52) + (n >= 59) + (n >= 67) + (n >= 77) + (n >= 87) + (n >= 99) + (n >= 113);
}

template <int MODE>
__device__ __forceinline__ void transpose_item(const float* W, int K, int N, int nblk, bf16* WT, int row_off, LAS float* scr, int item, int lane) {
    const int kb = item / nblk, nb = item % nblk, k0 = 64 * kb, n0 = 32 * nb;
    const int nn = n0 + (lane & 31); const bool ok = nn < N;
    float wv[32];
#pragma unroll
    for (int i = 0; i < 32; ++i) { const int kk = 2 * i + (lane >> 5); wv[i] = ok ? W[(size_t)(k0 + kk) * N + nn] : 0.f; }
#pragma unroll
    for (int i = 0; i < 32; ++i) { const int kk = 2 * i + (lane >> 5); scr[kk * 33 + (lane & 31)] = wv[i]; }
    LDS_WAIT(); asm volatile("" ::: "memory");
    const int c = lane & 7;
#pragma unroll
    for (int j = 0; j < 4; ++j) { const int n = (lane >> 3) + 8 * j; const LAS float* s = scr + (8 * c) * 33 + n;
        v4u o; o.x = pk2(s[0 * 33], s[1 * 33]); o.y = pk2(s[2 * 33], s[3 * 33]); o.z = pk2(s[4 * 33], s[5 * 33]); o.w = pk2(s[6 * 33], s[7 * 33]);
        int orow = n0 + n;
        if (MODE == 1) { orow = (orow < DFF) ? ((orow >> 7) * 256 + (orow & 127)) : (((orow - DFF) >> 7) * 256 + 128 + ((orow - DFF) & 127)); }
        *(GAS v4u*)(WT + (size_t)(row_off + orow) * K + k0 + 8 * c) = o; }
    LDS_WAIT(); asm volatile("" ::: "memory");
}
__device__ __forceinline__ float silu_f(float a) { return a * __builtin_amdgcn_rcpf(1.0f + __expf(-a)); }
__device__ __forceinline__ void adaln_item(Frame& F, const Args& A, int item, LAS float* scr) {
    const int lane = F.lane_id(), fr = lane & 15, fq = lane >> 4;
    const int l = item / 384, nb = item - l * 384, n0 = 32 * nb;
    const float* W = A.in[F.zo + I_WADA] + (size_t)l * DM * MODW + n0 + (lane & 31) + (size_t)(lane >> 5) * MODW;
    f32x4 acc[3][2];
#pragma unroll
    for (int rb = 0; rb < 3; ++rb) { acc[rb][0] = (f32x4){0.f, 0.f, 0.f, 0.f}; acc[rb][1] = (f32x4){0.f, 0.f, 0.f, 0.f}; }
    float wv[32];
#pragma unroll
    for (int i = 0; i < 32; ++i) wv[i] = W[(size_t)(2 * i) * MODW];
    for (int kb = 0; kb < 32; ++kb) {
#pragma unroll
        for (int i = 0; i < 32; ++i) scr[(2 * i + (lane >> 5)) * 33 + (lane & 31)] = wv[i];
        if (kb + 1 < 32) {
#pragma unroll
            for (int i = 0; i < 32; ++i) wv[i] = W[(size_t)(64 * (kb + 1) + 2 * i) * MODW];
        }
        LDS_WAIT(); asm volatile("" ::: "memory");
#pragma unroll
        for (int ks = 0; ks < 2; ++ks) {
            bf16x8 bfr[2];
#pragma unroll
            for (int nk = 0; nk < 2; ++nk) { const LAS float* s = scr + (32 * ks + 8 * fq) * 33 + 16 * nk + fr;
                v4u w; w.x = pk2(s[0 * 33], s[1 * 33]); w.y = pk2(s[2 * 33], s[3 * 33]); w.z = pk2(s[4 * 33], s[5 * 33]); w.w = pk2(s[6 * 33], s[7 * 33]); bfr[nk] = __builtin_bit_cast(bf16x8, w); }
#pragma unroll
            for (int rb = 0; rb < 3; ++rb) { const bf16x8 af = *(const bf16x8*)(F.SC() + (size_t)(rb * 16 + fr) * DM + 64 * kb + 32 * ks + 8 * fq);
                acc[rb][0] = __builtin_amdgcn_mfma_f32_16x16x32_bf16(af, bfr[0], acc[rb][0], 0, 0, 0); acc[rb][1] = __builtin_amdgcn_mfma_f32_16x16x32_bf16(af, bfr[1], acc[rb][1], 0, 0, 0); } }
        LDS_WAIT(); asm volatile("" ::: "memory");
    }
    const float* bias = A.in[F.zo + I_BADA] + l * MODW + n0; float* mo = F.MOD() + (size_t)l * MODW + n0;
#pragma unroll
    for (int rb = 0; rb < 3; ++rb)
#pragma unroll
        for (int nk = 0; nk < 2; ++nk) { const float bv = bias[16 * nk + fr];
#pragma unroll
            for (int i = 0; i < 4; ++i) { const int b = rb * 16 + 4 * fq + i; if (b < NBATCH) mo[(size_t)b * MODLD + 16 * nk + fr] = acc[rb][nk][i] + bv; } }
}
__device__ __forceinline__ void sc_table(Frame& F, const Args& A) {
    const int gt = (F.vcu * NWAVES + F.wave) * 64 + F.lane_id(), NGT = F.G * NWAVES * 64;
    for (int i = gt; i < 48 * 1024; i += NGT) { const int r = i >> 10, cp = (i & 1023) * 2; unsigned w = 0u;
        if (r < NBATCH) { const float* c = (r < 4) ? (A.in[F.zo + I_CP] + (size_t)r * DM) : (A.in[F.zo + I_CS] + (size_t)(r - 4) * DM); w = pk2(silu_f(c[cp]), silu_f(c[cp + 1])); }
        ((GAS unsigned*)F.SC())[i] = w; }
}
__device__ __forceinline__ void p0_prologue(Frame& F, const Args& A) {
    LAS float* scr = (LAS float*)(F.lds + RING_OFF + F.wave * 16384);
    const int gw = F.vcu * NWAVES + F.wave, NGW = F.G * NWAVES;
    const int gt = gw * 64 + F.lane_id(), NGT = NGW * 64;
    for (int it = gw; it < DEPTH * 384; it += NGW) adaln_item(F, A, it, scr);
    constexpr int I_IN = 32 * 137, I_OUT = 32 * 64, I_GU = 32 * 352, I_DN = 88 * 64, I_L = I_IN + I_OUT + I_GU + I_DN;
    for (int it = gw; it < DEPTH * I_L; it += NGW) {
        const int l = it / I_L; int r = it - l * I_L;
        if (r < I_IN)  { transpose_item<0>(A.in[F.zo + I_WIN] + (size_t)l * DM * INW, DM, INW, 137, F.Win_t() + (size_t)l * ZW * DM, 0, scr, r, F.lane_id()); continue; } r -= I_IN;
        if (r < I_OUT) { transpose_item<0>(A.in[F.zo + I_WOUT] + (size_t)l * DM * DM, DM, DM, 64, F.Wout_t() + (size_t)l * DM * DM, 0, scr, r, F.lane_id()); continue; } r -= I_OUT;
        if (r < I_GU)  { transpose_item<1>(A.in[F.zo + I_WGU] + (size_t)l * DM * NGU, DM, NGU, 352, F.Wgu_t() + (size_t)l * NGU * DM, 0, scr, r, F.lane_id()); continue; } r -= I_GU;
        transpose_item<0>(A.in[F.zo + I_WDN] + (size_t)l * DFF * DM, DFF, DM, 64, F.Wdn_t() + (size_t)l * DM * DFF, 0, scr, r, F.lane_id());
    }
    const v4u z4 = {0u, 0u, 0u, 0u};
    for (int i = gt; i < DEPTH * 224 * 256; i += NGT) { const int l = i / (224 * 256), r = i - l * (224 * 256); *((GAS v4u*)(F.Win_t() + ((size_t)l * ZW + 4384) * DM) + r) = z4; }
    for (int i = gt; i < 128 * 256; i += NGT) { *((GAS v4u*)(F.H() + (size_t)NROWS * DM) + i) = z4; *((GAS v4u*)(F.MIX() + (size_t)NROWS * DM) + i) = z4; }
    for (int i = gt; i < 128 * 704; i += NGT) *((GAS v4u*)(F.ACT() + (size_t)NROWS * DFF) + i) = z4;
    for (int i = gt; i < NP_ROWS * 512; i += NGT) ((GAS f32x4*)F.X())[i] = ((const GAS f32x4*)A.in[F.zo + I_XP])[i];
    for (int i = gt; i < NS_ROWS * 512; i += NGT) ((GAS f32x4*)(F.X() + (size_t)NP_ROWS * DM))[i] = ((const GAS f32x4*)A.in[F.zo + I_XS])[i];
    for (int i = gt; i < 4 * 4 * 128 * 128; i += NGT) { const int lg = i >> 14, dcol = (i >> 7) & 127, c = i & 127; F.WPT()[i] = (bf16)f2bf(A.in[F.zo + I_WPOOL][((size_t)lg * 128 + c) * 128 + dcol]); }
    for (int i = gt; i < 8 * 128; i += NGT) { const int h = i >> 7, dist = i & 127; F.BTAB()[i] = A.in[F.zo + I_RELB][t5_bucket(dist) * 8 + h]; }
}

__device__ __forceinline__ void norm_mod_rows(Frame& F, const float* g, const float* modl  , int rbeg, int rend, int widx, int nw) {
    for (int r = rbeg + widx; r < rend; r += nw) {
        const int b = r < NP_ROWS ? (r >> 11) : 4 + ((r - NP_ROWS) >> 2);
        const float* xr = F.X() + (size_t)r * DM + 4 * F.lane_id(); const float* sh = modl + (size_t)b * MODLD + 4 * F.lane_id(); const float* gg = g + 4 * F.lane_id();
        f32x4 v[8]; float ss = 0.f;
#pragma unroll
        for (int j = 0; j < 8; ++j) { v[j] = *(const f32x4*)(xr + 256 * j); ss += (v[j].x * v[j].x + v[j].y * v[j].y) + (v[j].z * v[j].z + v[j].w * v[j].w); }
        const float rstd = 1.0f / sqrtf(wave_sum(ss) * (1.0f / DM) + EPS);
        bf16* hr = F.H() + (size_t)r * DM + 4 * F.lane_id();
#pragma unroll
        for (int j = 0; j < 8; ++j) { const f32x4 gv = *(const f32x4*)(gg + 256 * j), sv = *(const f32x4*)(sh + 256 * j), cv = *(const f32x4*)(sh + 2048 + 256 * j);
            const f32x4 y = (v[j] * rstd * gv) * (1.0f + cv) + sv;
            uint2 w; w.x = pk2(y.x, y.y); w.y = pk2(y.z, y.w); *(uint2*)(hr + 256 * j) = w; }
    }
}
__device__ __forceinline__ void final_norm_rows(Frame& F, const Args& A, int rbeg) {
    const int gw = F.vcu * NWAVES + F.wave, NGW = F.G * NWAVES; const float* g = A.in[F.zo + I_GFIN] + 4 * F.lane_id();
    for (int r = rbeg + gw; r < NROWS; r += NGW) {
        const float* xr = F.X() + (size_t)r * DM + 4 * F.lane_id();
        f32x4 v[8]; float ss = 0.f;
#pragma unroll
        for (int j = 0; j < 8; ++j) { v[j] = *(const f32x4*)(xr + 256 * j); ss += (v[j].x * v[j].x + v[j].y * v[j].y) + (v[j].z * v[j].z + v[j].w * v[j].w); }
        const float rstd = 1.0f / sqrtf(wave_sum(ss) * (1.0f / DM) + EPS);
        float* yr = F.out + O_Y + (size_t)r * DM + 4 * F.lane_id();
#pragma unroll
        for (int j = 0; j < 8; ++j) { const f32x4 gv = *(const f32x4*)(g + 256 * j); *(f32x4*)(yr + 256 * j) = v[j] * rstd * gv; }
    }
}

__device__ __forceinline__ void attn_item(Frame& F, const Args& A, int l, int r, int hd, LAS float* ps) {
    const int lane = F.lane_id(), g = hd >> 2; const bool smp = r >= NP_ROWS;
    const int t = r & 2047, sb = smp ? ((r - NP_ROWS) >> 2) : 0, si = (r - NP_ROWS) & 3;
    LAS float* qs = ps + 128;
    { const unsigned w = ((const unsigned*)(F.Z() + (size_t)r * ZW + ZQ + hd * 64))[lane & 31]; if (lane < 32) { qs[2 * lane] = bflo(w); qs[2 * lane + 1] = bfhi(w); } }
    LDS_WAIT(); asm volatile("" ::: "memory");
    const float* ck = A.in[F.zo + I_CK] + ((size_t)(l * 32 + sb) * 128) * 128 + g * 64;
    const float* cv = A.in[F.zo + I_CV] + ((size_t)(l * 32 + sb) * 128) * 128 + g * 64;
    const int jmin = smp ? 0 : (t >= 127 ? 0 : 127 - t);
    float sc[2];
#pragma unroll 1
    for (int jj = 0; jj < 2; ++jj) {
        const int j = lane + 64 * jj, dist = 127 - j; float dot = 0.f; bool valid = j >= jmin;
        if (valid) {
            const int krel = si - dist;
            if (smp && krel < 0) {
                const f32x4* kp = (const f32x4*)(ck + (size_t)(krel + 128) * 128);
#pragma unroll 4
                for (int c = 0; c < 16; ++c) { const f32x4 kv = kp[c]; const f32x4 qv = *(const LAS f32x4*)(qs + 4 * c); dot += qv.x * kv.x + qv.y * kv.y + qv.z * kv.z + qv.w * kv.w; }
            } else {
                const int krow = smp ? (NP_ROWS + sb * 4 + krel) : (r - dist);
                const v4u* kp = (const v4u*)(F.Z() + (size_t)krow * ZW + ZK + g * 64);
#pragma unroll 4
                for (int c = 0; c < 8; ++c) { const v4u w = kp[c];
                    const f32x4 qa = *(const LAS f32x4*)(qs + 8 * c), qb = *(const LAS f32x4*)(qs + 8 * c + 4);
                    dot += qa.x * bflo(w.x) + qa.y * bfhi(w.x) + qa.z * bflo(w.y) + qa.w * bfhi(w.y) + qb.x * bflo(w.z) + qb.y * bfhi(w.z) + qb.z * bflo(w.w) + qb.w * bfhi(w.w); }
            }
        }
        const float sv = valid ? dot * 0.125f + F.BTAB()[hd * 128 + dist] : -INFINITY;
        if (jj == 0) sc[0] = sv; else sc[1] = sv;
    }
    const float sink = A.in[F.zo + I_SINKS][l * 8 + hd];
    const float m = fmaxf(wave_max(fmaxf(sc[0], sc[1])), sink);
    const float p0 = __expf(sc[0] - m), p1 = __expf(sc[1] - m);
    const float denom = wave_sum(p0 + p1) + __expf(sink - m);
    ps[lane] = p0; ps[lane + 64] = p1;
    LDS_WAIT(); asm volatile("" ::: "memory");
    float o = 0.f;
#pragma unroll 16
    for (int j = jmin; j < 128; ++j) {
        const float pj = ps[j]; const int dist = 127 - j; float vv;
        const int krel = si - dist;
        if (smp && krel < 0) vv = cv[(size_t)(krel + 128) * 128 + lane];
        else { const int krow = smp ? (NP_ROWS + sb * 4 + krel) : (r - dist); vv = bf2f(F.Z()[(size_t)krow * ZW + ZV + g * 64 + lane]); }
        o += pj * vv;
    }
    F.MIX()[(size_t)r * DM + hd * 64 + lane] = (bf16)f2bf(o / denom);
    LDS_WAIT(); asm volatile("" ::: "memory");
}
__device__ __forceinline__ void pool_item(Frame& F, const Args& A, int l, int r, int gi, LAS float* ds) {
    const int lane = F.lane_id(), w = 2 << gi; const bool smp = r >= NP_ROWS;
    const int t = r & 2047, sb = (r - NP_ROWS) >> 2, si = (r - NP_ROWS) & 3;
    const float* pbuf = A.in[F.zo + I_SPOOL] + ((size_t)(l * 32 + sb) * 15) * 512 + gi * 128;
    float s0 = 0.f, s1 = 0.f, u0 = 0.f, u1 = 0.f;
#pragma unroll 4
    for (int o = 0; o < w; ++o) {
        float a0 = 0.f, a1 = 0.f;
        if (!smp) { if (t - o >= 0) { const bf16* zp = F.Z() + (size_t)(r - o) * ZW + ZU + gi * 128; a0 = bf2f(zp[lane]); a1 = bf2f(zp[lane + 64]); } }
        else { const int idx = si - o;
            if (idx >= 0) { const bf16* zp = F.Z() + (size_t)(NP_ROWS + sb * 4 + idx) * ZW + ZU + gi * 128; a0 = bf2f(zp[lane]); a1 = bf2f(zp[lane + 64]); }
            else { const float* bp = pbuf + (size_t)(15 + idx) * 512; a0 = bp[lane]; a1 = bp[lane + 64]; } }
        if (o == 0) { u0 = a0; u1 = a1; }
        s0 += a0; s1 += a1;
    }
    const float cnt = smp ? (float)w : (float)((t + 1) < w ? (t + 1) : w);
    ds[lane] = s0 / cnt - u0; ds[lane + 64] = s1 / cnt - u1;
    LDS_WAIT(); asm volatile("" ::: "memory");
    const float* wp = A.in[F.zo + I_WPOOL] + ((size_t)(l * 4 + gi) * 128) * 128;
    float y0 = 0.f, y1 = 0.f;
#pragma unroll 16
    for (int c = 0; c < 128; ++c) { const float dv = ds[c]; y0 += dv * wp[c * 128 + lane]; y1 += dv * wp[c * 128 + lane + 64]; }
    const float* psc = A.in[F.zo + I_PSCALE] + l * 512 + gi * 128;
    bf16* mp = F.MIX() + (size_t)r * DM + 512 + gi * 128;
    mp[lane] = (bf16)f2bf(y0 * psc[lane]); mp[lane + 64] = (bf16)f2bf(y1 * psc[lane + 64]);
    LDS_WAIT(); asm volatile("" ::: "memory");
}
__device__ __forceinline__ void cache_outputs(Frame& F, const Args& A, int l) {
    const int gt = (F.vcu * NWAVES + F.wave) * 64 + F.lane_id(), NGT = F.G * NWAVES * 64;
#pragma unroll 4
    for (int i = gt; i < 4 * 128 * 128; i += NGT) { const int b = i >> 14, j = (i >> 7) & 127, c = i & 127; const bf16* zr = F.Z() + (size_t)(b * 2048 + 1920 + j) * ZW;
        F.out[O_WK_P + (size_t)l * 65536 + i] = bf2f(zr[ZK + c]); F.out[O_WV_P + (size_t)l * 65536 + i] = bf2f(zr[ZV + c]); }
#pragma unroll 4
    for (int i = gt; i < 4 * 15 * 512; i += NGT) { const int b = i / 7680, rem = i - b * 7680, j = rem >> 9, c = rem & 511;
        F.out[O_POOL_P + (size_t)l * 30720 + i] = bf2f(F.Z()[(size_t)(b * 2048 + 2033 + j) * ZW + ZU + c]); }
#pragma unroll 4
    for (int i = gt; i < 32 * 128 * 128; i += NGT) { const int sb = i >> 14, p = (i >> 7) & 127, c = i & 127; float kv, vv;
        if (p < 124) { const size_t src = ((size_t)(l * 32 + sb) * 128 + p + 4) * 128 + c; kv = A.in[F.zo + I_CK][src]; vv = A.in[F.zo + I_CV][src]; }
        else { const bf16* zr = F.Z() + (size_t)(NP_ROWS + sb * 4 + p - 124) * ZW; kv = bf2f(zr[ZK + c]); vv = bf2f(zr[ZV + c]); }
        F.out[O_WK_S + (size_t)l * 524288 + i] = kv; F.out[O_WV_S + (size_t)l * 524288 + i] = vv; }
#pragma unroll 4
    for (int i = gt; i < 32 * 15 * 512; i += NGT) { const int sb = i / 7680, rem = i - sb * 7680, j = rem >> 9, c = rem & 511; float v;
        if (j < 11) v = A.in[F.zo + I_SPOOL][((size_t)(l * 32 + sb) * 15 + j + 4) * 512 + c];
        else v = bf2f(F.Z()[(size_t)(NP_ROWS + sb * 4 + j - 11) * ZW + ZU + c]);
        F.out[O_POOL_S + (size_t)l * 245760 + i] = v; }
}
__device__ __forceinline__ void gla_out_item(Frame& F, const Args& A, int l, int r, int hh) {
    const int lane = F.lane_id();
    const f32x4 o = *(const f32x4*)(F.OGLA() + (size_t)r * 1024 + hh * 256 + 4 * lane);
    const float ss = wave_sum((o.x * o.x + o.y * o.y) + (o.z * o.z + o.w * o.w));
    const float rstd = 1.0f / sqrtf(ss * (1.0f / 256.0f) + EPS);
    const f32x4 gv = *(const f32x4*)(A.in[F.zo + I_GGLA] + l * 1024 + hh * 256 + 4 * lane);
    const uint2 gw = *(const uint2*)(F.Z() + (size_t)r * ZW + GG + hh * 256 + 4 * lane);
    const float g0 = bflo(gw.x), g1 = bfhi(gw.x), g2 = bflo(gw.y), g3 = bfhi(gw.y);
    const float y0 = o.x * rstd * gv.x * (g0 / (1.0f + __expf(-g0))), y1 = o.y * rstd * gv.y * (g1 / (1.0f + __expf(-g1)));
    const float y2 = o.z * rstd * gv.z * (g2 / (1.0f + __expf(-g2))), y3 = o.w * rstd * gv.w * (g3 / (1.0f + __expf(-g3)));
    uint2 w; w.x = pk2(y0, y1); w.y = pk2(y2, y3);
    *(uint2*)(F.MIX() + (size_t)r * DM + 1024 + hh * 256 + 4 * lane) = w;
}
typedef unsigned u32x2 __attribute__((ext_vector_type(2)));
__device__ __forceinline__ u32x2 pack4bf(const f32x4 v) { u32x2 w; w.x = pk2(v.x, v.y); w.y = pk2(v.z, v.w); return w; }
__device__ __forceinline__ void gla_store_state(float* dst, int fr, int fq, const f32x4 (&sacc)[8]) {
#pragma unroll
    for (int db = 0; db < 8; ++db) { const int d0 = db * 16 + 4 * fq; dst[(size_t)(d0 + 0) * 256 + fr] = sacc[db].x; dst[(size_t)(d0 + 1) * 256 + fr] = sacc[db].y; dst[(size_t)(d0 + 2) * 256 + fr] = sacc[db].z; dst[(size_t)(d0 + 3) * 256 + fr] = sacc[db].w; }
}
constexpr int GL_QD = 0, GL_KD = 17408, GL_VT = 34816, GL_AM = 71680, GL_BS = 80896, GL_GS = 82944, GL_KDT = 87040, GL_DL = 105472, GL_END = 105984;
static_assert(GL_END <= RING_BYTES, "GLA LDS map");
constexpr int GL_NSLOT = 640;
__device__ __forceinline__ float gla_chunk_prep(Frame& F, int slot, int row0, int nvalid, int hh, const float (&wa)[16], float ba) {
    const int lane = F.lane_id(), wave = F.wave, tid = wave * 64 + lane, fr = lane & 15, fq = lane >> 4;
    const int d = tid & 127, qtr = tid >> 7, cg = hh * 128 + d;
    LAS bf16* QD = (LAS bf16*)(F.lds + GL_QD); LAS bf16* KD = (LAS bf16*)(F.lds + GL_KD); LAS bf16* VT = (LAS bf16*)(F.lds + GL_VT); LAS bf16* AM = (LAS bf16*)(F.lds + GL_AM); LAS bf16* KDT = (LAS bf16*)(F.lds + GL_KDT);
    LAS float* BS = (LAS float*)(F.lds + GL_BS); LAS float* GS = (LAS float*)(F.lds + GL_GS); LAS float* DL = (LAS float*)(F.lds + GL_DL);
    const bf16* Z = F.Z();
    unsigned qk[16], vw[16];
    { const int qtr_u = wave >> 1, hf_u = wave >> 2;
      const bf16* zq = Z + (size_t)(row0 + 16 * qtr_u) * ZW + GQ + hh * 128 + (wave & 1) * 64; const bf16* zk = zq + (GK - GQ);
      const bf16* vp = Z + (size_t)(row0 + 32 * hf_u) * ZW + GV + hh * 256 + (wave & 3) * 64;
      unsigned short qraw[16], kraw[16], vraw[32];
#pragma unroll
      for (int i = 0; i < 16; ++i) { qraw[i] = 0; kraw[i] = 0; if (16 * qtr_u + i < nvalid) { qraw[i] = (zq + (size_t)i * ZW)[lane]; kraw[i] = (zk + (size_t)i * ZW)[lane]; } }
#pragma unroll
      for (int i = 0; i < 32; ++i) { vraw[i] = 0; if (32 * hf_u + i < nvalid) vraw[i] = (vp + (size_t)i * ZW)[lane]; }
#pragma unroll
      for (int i = 0; i < 16; ++i) { qk[i] = (unsigned)qraw[i] | ((unsigned)kraw[i] << 16); vw[i] = (unsigned)vraw[2 * i] | ((unsigned)vraw[2 * i + 1] << 16); }
#pragma unroll
      for (int i = 0; i < 16; ++i) asm volatile("" : "+v"(qk[i]), "+v"(vw[i])); }
    { const int t = tid >> 3, j0 = (tid & 7) * 2; float g0 = 0.f, g1 = 0.f;
      if (t < nvalid) { const unsigned w = *(const unsigned*)(Z + (size_t)(row0 + t) * ZW + GA + j0); g0 = bflo(w); g1 = bfhi(w); }
      GS[t * 16 + j0] = g0; GS[t * 16 + j0 + 1] = g1; }
    __syncthreads();
    float bl[16]; float run = 0.f;
#pragma unroll
    for (int i = 0; i < 16; ++i) { const int t = 16 * qtr + i; const LAS f32x4* gp = (const LAS f32x4*)(GS + t * 16); const f32x4 g0 = gp[0], g1 = gp[1], g2 = gp[2], g3 = gp[3];
        float x = ba + g0.x * wa[0] + g0.y * wa[1] + g0.z * wa[2] + g0.w * wa[3] + g1.x * wa[4] + g1.y * wa[5] + g1.z * wa[6] + g1.w * wa[7];
        x += g2.x * wa[8] + g2.y * wa[9] + g2.z * wa[10] + g2.w * wa[11] + g3.x * wa[12] + g3.y * wa[13] + g3.z * wa[14] + g3.w * wa[15];
        float la = (fminf(x, 0.f) - __logf(1.0f + __expf(-fabsf(x)))) * (1.0f / 16.0f);
        if (t >= nvalid) la = 0.f;
        run += la; bl[i] = run;
        if (i & 1) asm volatile("" ::: "memory"); }
    BS[qtr * 128 + d] = run;
    __syncthreads();
    float pre = 0.f, tot = 0.f;
#pragma unroll
    for (int q2 = 0; q2 < 4; ++q2) { const float v = BS[q2 * 128 + d]; tot += v; if (q2 < qtr) pre += v; }
    { bf16* qg = F.QDG() + (size_t)(row0 + 16 * qtr) * 512 + cg;
      unsigned kt[8];
#pragma unroll
      for (int i = 0; i < 16; ++i) { const int t = 16 * qtr + i; const float b = pre + bl[i]; const float qv = bflo(qk[i]), kv = bfhi(qk[i]);
          const unsigned qd = f2bf(qv * __expf(b) * 0.08838834764831845f), kd = f2bf(kv * __expf(-b)), kdt = f2bf(kv * __expf(tot - b));
          QD[t * 136 + d] = (bf16)qd; KD[t * 136 + d] = (bf16)kd;
          if (t < nvalid) qg[(size_t)i * 512] = (bf16)qd;
          if (i & 1) kt[i >> 1] |= kdt << 16; else kt[i >> 1] = kdt; }
      const v4u k0 = {kt[0], kt[1], kt[2], kt[3]}, k1 = {kt[4], kt[5], kt[6], kt[7]};
      v4u* kg = (v4u*)(F.KDTG() + ((size_t)slot * 128 + d) * 64 + 16 * qtr); kg[0] = k0; kg[1] = k1;
      LAS v4u* kl = (LAS v4u*)(KDT + d * 72 + 16 * qtr); kl[0] = k0; kl[1] = k1;
      if (qtr == 0) { const float dl = __expf(tot); F.DLG()[slot * 128 + d] = dl; DL[d] = dl; } }
    { const int e = tid & 255, hf = tid >> 8;
      LAS v4u* vl = (LAS v4u*)(VT + e * 72 + 32 * hf); v4u* vg = (v4u*)(F.VTG() + ((size_t)slot * 256 + e) * 64 + 32 * hf);
#pragma unroll
      for (int k = 0; k < 4; ++k) { const v4u w = {vw[4 * k], vw[4 * k + 1], vw[4 * k + 2], vw[4 * k + 3]}; vl[k] = w; vg[k] = w; } }
    __syncthreads();
#pragma unroll
    for (int bi = 0; bi < 2; ++bi) { const int blk = 2 * wave + bi, tb = blk >> 2, sbk = blk & 3;
        f32x4 acc = {0.f, 0.f, 0.f, 0.f};
        if (sbk <= tb) {
#pragma unroll
            for (int ks = 0; ks < 4; ++ks) { const bf16x8 a = *(const LAS bf16x8*)(KD + (sbk * 16 + fr) * 136 + ks * 32 + fq * 8), b = *(const LAS bf16x8*)(QD + (tb * 16 + fr) * 136 + ks * 32 + fq * 8);
                acc = __builtin_amdgcn_mfma_f32_16x16x32_bf16(a, b, acc, 0, 0, 0); } }
        const int t = tb * 16 + fr, s0 = sbk * 16 + 4 * fq;
        f32x4 m; m.x = (s0 + 0 <= t) ? acc.x : 0.f; m.y = (s0 + 1 <= t) ? acc.y : 0.f; m.z = (s0 + 2 <= t) ? acc.z : 0.f; m.w = (s0 + 3 <= t) ? acc.w : 0.f;
        *(LAS u32x2*)(AM + t * 72 + s0) = pack4bf(m); }
    __syncthreads();
    return tot;
}
__device__ __forceinline__ void gla_state_step_lds(Frame& F, int fr, int fq, f32x4 (&sacc)[2][8]) {
    LAS bf16* VT = (LAS bf16*)(F.lds + GL_VT); LAS bf16* KDT = (LAS bf16*)(F.lds + GL_KDT); LAS float* DL = (LAS float*)(F.lds + GL_DL);
    bf16x8 b0[2], b1[2];
#pragma unroll
    for (int ei = 0; ei < 2; ++ei) { const LAS bf16* vt = VT + ((2 * F.wave + ei) * 16 + fr) * 72 + 8 * fq; b0[ei] = *(const LAS bf16x8*)vt; b1[ei] = *(const LAS bf16x8*)(vt + 32); }
#pragma unroll
    for (int db = 0; db < 8; ++db) { const f32x4 dv = *(const LAS f32x4*)(DL + db * 16 + 4 * fq); const LAS bf16* kt = KDT + (db * 16 + fr) * 72 + 8 * fq; const bf16x8 a0 = *(const LAS bf16x8*)kt, a1 = *(const LAS bf16x8*)(kt + 32);
#pragma unroll
        for (int ei = 0; ei < 2; ++ei) { f32x4 s = sacc[ei][db] * dv; s = __builtin_amdgcn_mfma_f32_16x16x32_bf16(a0, b0[ei], s, 0, 0, 0); s = __builtin_amdgcn_mfma_f32_16x16x32_bf16(a1, b1[ei], s, 0, 0, 0); sacc[ei][db] = s; } }
}
__device__ __forceinline__ f32x4 gla_intra_block(Frame& F, int eb, int tb, int fr, int fq, f32x4 o) {
    LAS bf16* VT = (LAS bf16*)(F.lds + GL_VT); LAS bf16* AM = (LAS bf16*)(F.lds + GL_AM);
    o = __builtin_amdgcn_mfma_f32_16x16x32_bf16(*(const LAS bf16x8*)(VT + (eb * 16 + fr) * 72 + fq * 8), *(const LAS bf16x8*)(AM + (tb * 16 + fr) * 72 + fq * 8), o, 0, 0, 0);
    if (tb >= 2) o = __builtin_amdgcn_mfma_f32_16x16x32_bf16(*(const LAS bf16x8*)(VT + (eb * 16 + fr) * 72 + 32 + fq * 8), *(const LAS bf16x8*)(AM + (tb * 16 + fr) * 72 + 32 + fq * 8), o, 0, 0, 0);
    return o;
}
__device__ __forceinline__ void gla_load_gate(Frame& F, const Args& A, int l, int hh, float (&wa)[16], float& ba) {
    const int tid = F.wave * 64 + F.lane_id(), cg = hh * 128 + (tid & 127);
    const float* wp = A.in[F.zo + I_WA2] + (size_t)l * 16 * 512 + cg;
#pragma unroll
    for (int j = 0; j < 16; ++j) wa[j] = wp[j * 512];
    ba = A.in[F.zo + I_BA2][l * 512 + cg];
}
__device__ __forceinline__ void gla_prompt_group(Frame& F, const Args& A, int l, int grp) {
    const int lane = F.lane_id(), wave = F.wave, tid = wave * 64 + lane, fr = lane & 15, fq = lane >> 4;
    const int hh = grp & 3, seg = (grp >> 2) & 7, b = grp >> 5, bh = b * 4 + hh;
    float wa[16], ba; gla_load_gate(F, A, l, hh, wa, ba);
    f32x4 sacc[2][8];
#pragma unroll
    for (int ei = 0; ei < 2; ++ei)
#pragma unroll
        for (int db = 0; db < 8; ++db) sacc[ei][db] = (f32x4){0.f, 0.f, 0.f, 0.f};
    float bsum = 0.f;
#pragma unroll 1
    for (int c = 0; c < 4; ++c) { const int row0 = b * 2048 + seg * 256 + c * 64, slot = ((b * 32 + seg * 4 + c) * 4) + hh;
        bsum += gla_chunk_prep(F, slot, row0, 64, hh, wa, ba);
#pragma unroll
        for (int ei = 0; ei < 2; ++ei) { const int eb = 2 * wave + ei;
#pragma unroll
            for (int tb = 0; tb < 4; ++tb) { const f32x4 o = gla_intra_block(F, eb, tb, fr, fq, (f32x4){0.f, 0.f, 0.f, 0.f});
                *(f32x4*)(F.OGLA() + (size_t)(row0 + tb * 16 + fr) * 1024 + hh * 256 + eb * 16 + 4 * fq) = o; } }
        if (seg < 7) gla_state_step_lds(F, fr, fq, sacc); }
    if (seg < 7) {
#pragma unroll
        for (int ei = 0; ei < 2; ++ei) gla_store_state(F.SLOC() + ((size_t)(bh * 8 + seg) * 128) * 256 + (2 * wave + ei) * 16, fr, fq, sacc[ei]);
        if (tid < 128) F.DSEG()[(bh * 8 + seg) * 128 + tid] = __expf(bsum); }
    __syncthreads();
}
__device__ __forceinline__ void gla_sample_unit(Frame& F, const Args& A, int l, int sbh) {
    const int lane = F.lane_id(), wave = F.wave, fr = lane & 15, fq = lane >> 4;
    const int hh = sbh & 3, sb = sbh >> 2, row0 = NP_ROWS + sb * 4;
    float wa[16], ba; gla_load_gate(F, A, l, hh, wa, ba);
    const size_t so = ((size_t)((l * 32 + sb) * 4 + hh)) * 32768;
    f32x4 sacc[2][8];
#pragma unroll
    for (int ei = 0; ei < 2; ++ei) { const float* s0 = A.in[F.zo + I_SGLA] + so + (2 * wave + ei) * 16 + fr;
#pragma unroll
        for (int db = 0; db < 8; ++db) { const int d0 = db * 16 + 4 * fq; sacc[ei][db].x = s0[(size_t)(d0 + 0) * 256]; sacc[ei][db].y = s0[(size_t)(d0 + 1) * 256]; sacc[ei][db].z = s0[(size_t)(d0 + 2) * 256]; sacc[ei][db].w = s0[(size_t)(d0 + 3) * 256]; } }
    (void)gla_chunk_prep(F, 512 + sbh, row0, 4, hh, wa, ba);
    LAS bf16* QD = (LAS bf16*)(F.lds + GL_QD);
#pragma unroll
    for (int ei = 0; ei < 2; ++ei) { const int eb = 2 * wave + ei;
        f32x4 o = gla_intra_block(F, eb, 0, fr, fq, (f32x4){0.f, 0.f, 0.f, 0.f});
#pragma unroll
        for (int ks = 0; ks < 4; ++ks) { const u32x2 lo = pack4bf(sacc[ei][2 * ks]), hi = pack4bf(sacc[ei][2 * ks + 1]); const v4u sw = {lo.x, lo.y, hi.x, hi.y};
            const u32x2 ql = *(const LAS u32x2*)(QD + fr * 136 + 32 * ks + 4 * fq), qh = *(const LAS u32x2*)(QD + fr * 136 + 32 * ks + 16 + 4 * fq); const v4u qw = {ql.x, ql.y, qh.x, qh.y};
            o = __builtin_amdgcn_mfma_f32_16x16x32_bf16(__builtin_bit_cast(bf16x8, sw), __builtin_bit_cast(bf16x8, qw), o, 0, 0, 0); }
        if (fr < 4) *(f32x4*)(F.OGLA() + (size_t)(row0 + fr) * 1024 + hh * 256 + eb * 16 + 4 * fq) = o; }
    gla_state_step_lds(F, fr, fq, sacc);
#pragma unroll
    for (int ei = 0; ei < 2; ++ei) gla_store_state(F.out + O_GLA_S + so + (2 * wave + ei) * 16, fr, fq, sacc[ei]);
    __syncthreads();
}
__device__ __forceinline__ void gla_state_step(Frame& F, int slot, int eb, int fr, int fq, f32x4 (&sacc)[8]) {
    const bf16* vt = F.VTG() + ((size_t)slot * 256 + eb * 16 + fr) * 64 + 8 * fq; const bf16x8 b0 = *(const bf16x8*)vt, b1 = *(const bf16x8*)(vt + 32);
    const bf16* kt = F.KDTG() + ((size_t)slot * 128 + fr) * 64 + 8 * fq; const float* dl = F.DLG() + slot * 128 + 4 * fq;
#pragma unroll
    for (int db = 0; db < 8; ++db) { const f32x4 dv = *(const f32x4*)(dl + db * 16); const bf16x8 a0 = *(const bf16x8*)(kt + (size_t)db * 16 * 64), a1 = *(const bf16x8*)(kt + (size_t)db * 16 * 64 + 32);
        f32x4 s = sacc[db] * dv; s = __builtin_amdgcn_mfma_f32_16x16x32_bf16(a0, b0, s, 0, 0, 0); s = __builtin_amdgcn_mfma_f32_16x16x32_bf16(a1, b1, s, 0, 0, 0); sacc[db] = s; }
}
template <int NTB>
__device__ __forceinline__ void gla_inter_step(Frame& F, int row0, int nvalid, int hh, int eb, int fr, int fq, const f32x4 (&sacc)[8]) {
    u32x2 qlo[NTB][4], qhi[NTB][4]; f32x4 oi[NTB];
#pragma unroll
    for (int tb = 0; tb < NTB; ++tb) { const int t = tb * 16 + fr; const bool ok = t < nvalid;
        const bf16* qp = F.QDG() + (size_t)(row0 + t) * 512 + hh * 128 + 4 * fq; const float* op = F.OGLA() + (size_t)(row0 + t) * 1024 + hh * 256 + eb * 16 + 4 * fq;
        oi[tb] = (f32x4){0.f, 0.f, 0.f, 0.f}; if (ok) oi[tb] = *(const f32x4*)op;
#pragma unroll
        for (int ks = 0; ks < 4; ++ks) { qlo[tb][ks] = (u32x2){0u, 0u}; qhi[tb][ks] = (u32x2){0u, 0u}; if (ok) { qlo[tb][ks] = *(const u32x2*)(qp + 32 * ks); qhi[tb][ks] = *(const u32x2*)(qp + 32 * ks + 16); } } }
    bf16x8 sf[4];
#pragma unroll
    for (int ks = 0; ks < 4; ++ks) { const u32x2 lo = pack4bf(sacc[2 * ks]), hi = pack4bf(sacc[2 * ks + 1]); const v4u w = {lo.x, lo.y, hi.x, hi.y}; sf[ks] = __builtin_bit_cast(bf16x8, w); }
#pragma unroll
    for (int tb = 0; tb < NTB; ++tb) { const int t = tb * 16 + fr; f32x4 o = oi[tb];
#pragma unroll
        for (int ks = 0; ks < 4; ++ks) { const v4u w = {qlo[tb][ks].x, qlo[tb][ks].y, qhi[tb][ks].x, qhi[tb][ks].y}; o = __builtin_amdgcn_mfma_f32_16x16x32_bf16(sf[ks], __builtin_bit_cast(bf16x8, w), o, 0, 0, 0); }
        if (t < nvalid) *(f32x4*)(F.OGLA_ST() + (size_t)(row0 + t) * 1024 + hh * 256 + eb * 16 + 4 * fq) = o; }
}
__device__ __forceinline__ void gla_phase_g2(Frame& F, const Args& A, int l) {
    const int lane = F.lane_id(), fr = lane & 15, fq = lane >> 4;
    const int gw = F.vcu * NWAVES + F.wave, NGW = F.G * NWAVES;
    for (int it = gw; it < 2048; it += NGW) { const int bh = it >> 7, seg = (it >> 4) & 7, eb = it & 15, hh = bh & 3;
        f32x4 sacc[8];
#pragma unroll
        for (int db = 0; db < 8; ++db) sacc[db] = (f32x4){0.f, 0.f, 0.f, 0.f};
        for (int i2 = 0; i2 < seg; ++i2) { const float* sl = F.SLOC() + ((size_t)(bh * 8 + i2) * 128) * 256 + eb * 16 + fr; const float* dg = F.DSEG() + (bh * 8 + i2) * 128;
#pragma unroll
            for (int db = 0; db < 8; ++db) { const int d0 = db * 16 + 4 * fq; const f32x4 dv = *(const f32x4*)(dg + d0);
                sacc[db].x = sacc[db].x * dv.x + sl[(size_t)(d0 + 0) * 256]; sacc[db].y = sacc[db].y * dv.y + sl[(size_t)(d0 + 1) * 256]; sacc[db].z = sacc[db].z * dv.z + sl[(size_t)(d0 + 2) * 256]; sacc[db].w = sacc[db].w * dv.w + sl[(size_t)(d0 + 3) * 256]; } }
        const int slot0 = (((bh >> 2) * 32 + seg * 4) * 4) + hh, row0 = (bh >> 2) * 2048 + seg * 256;
#pragma unroll 1
        for (int c = 0; c < 4; ++c) { gla_inter_step<4>(F, row0 + c * 64, 64, hh, eb, fr, fq, sacc); gla_state_step(F, slot0 + 4 * c, eb, fr, fq, sacc); }
        if (seg == 7) gla_store_state(F.out + O_GLA_P + ((size_t)(l * 16 + bh)) * 32768 + eb * 16, fr, fq, sacc);
    }
}
constexpr int AT_VT = 0, AT_VTS = 184, AT_BT = 64 * AT_VTS * 2, AT_END = AT_BT + 4 * 128 * 4;
__device__ __forceinline__ void attn_unit_mfma(Frame& F, const Args& A, int l, int u) {
    const int lane = F.lane_id(), wave = F.wave, tid = wave * 64 + lane, fr = lane & 15, fq = lane >> 4;
    const int span = u >> 1, g = u & 1, t0g = span * 32, tb0 = t0g & 2047;
    LAS bf16* VT = (LAS bf16*)(F.lds + AT_VT); LAS float* BT = (LAS float*)(F.lds + AT_BT);
    const bf16* Z = F.Z();
    const int rb = wave >> 2, hl = wave & 3, hd = g * 4 + hl, t0w = t0g + 16 * rb;
    bf16x8 qf[2], kf[9][2];
    { const bf16* qp = Z + (size_t)(t0w + fr) * ZW + ZQ + hd * 64 + 8 * fq; qf[0] = *(const bf16x8*)qp; qf[1] = *(const bf16x8*)(qp + 32); }
#pragma unroll
    for (int kb = 0; kb < 9; ++kb) { const int kl = 16 * (rb + kb) + fr; kf[kb][0] = (bf16x8){0, 0, 0, 0, 0, 0, 0, 0}; kf[kb][1] = (bf16x8){0, 0, 0, 0, 0, 0, 0, 0};
        if (tb0 - 128 + kl >= 0) { const bf16* kp = Z + (size_t)(t0g - 128 + kl) * ZW + ZK + g * 64 + 8 * fq; kf[kb][0] = *(const bf16x8*)kp; kf[kb][1] = *(const bf16x8*)(kp + 32); } }
#pragma unroll
    for (int pass = 0; pass < 2; ++pass) { const int key = pass * 128 + (tid >> 2), dch = (tid & 3) * 16;
        if (key < 160) { v4u v0 = {0u, 0u, 0u, 0u}, v1 = {0u, 0u, 0u, 0u};
            if (tb0 - 128 + key >= 0) { const v4u* vp = (const v4u*)(Z + (size_t)(t0g - 128 + key) * ZW + ZV + g * 64 + dch); v0 = vp[0]; v1 = vp[1]; }
            LAS bf16* vt = VT + dch * AT_VTS + key;
            vt[0 * AT_VTS] = (bf16)(v0.x & 0xffffu); vt[1 * AT_VTS] = (bf16)(v0.x >> 16); vt[2 * AT_VTS] = (bf16)(v0.y & 0xffffu); vt[3 * AT_VTS] = (bf16)(v0.y >> 16);
            vt[4 * AT_VTS] = (bf16)(v0.z & 0xffffu); vt[5 * AT_VTS] = (bf16)(v0.z >> 16); vt[6 * AT_VTS] = (bf16)(v0.w & 0xffffu); vt[7 * AT_VTS] = (bf16)(v0.w >> 16);
            vt[8 * AT_VTS] = (bf16)(v1.x & 0xffffu); vt[9 * AT_VTS] = (bf16)(v1.x >> 16); vt[10 * AT_VTS] = (bf16)(v1.y & 0xffffu); vt[11 * AT_VTS] = (bf16)(v1.y >> 16);
            vt[12 * AT_VTS] = (bf16)(v1.z & 0xffffu); vt[13 * AT_VTS] = (bf16)(v1.z >> 16); vt[14 * AT_VTS] = (bf16)(v1.w & 0xffffu); vt[15 * AT_VTS] = (bf16)(v1.w >> 16); } }
    BT[tid] = F.BTAB()[(g * 4) * 128 + tid];
    __syncthreads();
    f32x4 sacc[9];
#pragma unroll
    for (int kb = 0; kb < 9; ++kb) {
        f32x4 acc = {0.f, 0.f, 0.f, 0.f};
        acc = __builtin_amdgcn_mfma_f32_16x16x32_bf16(kf[kb][0], qf[0], acc, 0, 0, 0); acc = __builtin_amdgcn_mfma_f32_16x16x32_bf16(kf[kb][1], qf[1], acc, 0, 0, 0);
        sacc[kb] = acc; }
    const float sink = A.in[F.zo + I_SINKS][l * 8 + hd];
    float mx = -INFINITY;
#pragma unroll
    for (int kb = 0; kb < 9; ++kb)
#pragma unroll
        for (int i = 0; i < 4; ++i) { const int dist = 128 - 16 * kb + fr - 4 * fq - i, kpos = tb0 + 16 * rb + fr - dist;
            const bool valid = (dist >= 0) && (dist < 128) && (kpos >= 0);
            const float s = valid ? sacc[kb][i] * 0.125f + BT[hl * 128 + (dist & 127)] : -INFINITY;
            sacc[kb][i] = s; mx = fmaxf(mx, s); }
    mx = fmaxf(mx, __shfl_xor(mx, 16)); mx = fmaxf(mx, __shfl_xor(mx, 32)); mx = fmaxf(mx, sink);
    float ls = 0.f;
#pragma unroll
    for (int kb = 0; kb < 9; ++kb)
#pragma unroll
        for (int i = 0; i < 4; ++i) { const float p = __expf(sacc[kb][i] - mx); sacc[kb][i] = p; ls += p; }
    ls += __shfl_xor(ls, 16); ls += __shfl_xor(ls, 32);
    const float rden = 1.0f / (ls + __expf(sink - mx));
    bf16x8 pf[5];
#pragma unroll
    for (int pp = 0; pp < 5; ++pp) { const f32x4 a = sacc[2 * pp], b = (2 * pp + 1 < 9) ? sacc[2 * pp + 1] : (f32x4){0.f, 0.f, 0.f, 0.f};
        const unsigned w0 = pk2(a.x, a.y), w1 = pk2(a.z, a.w), w2 = pk2(b.x, b.y), w3 = pk2(b.z, b.w);
        v4u w = {w0, w1, w2, w3}; pf[pp] = __builtin_bit_cast(bf16x8, w); }
#pragma unroll
    for (int db = 0; db < 4; ++db) { f32x4 o = {0.f, 0.f, 0.f, 0.f};
#pragma unroll
        for (int pp = 0; pp < 5; ++pp) { const LAS bf16* vr = VT + (db * 16 + fr) * AT_VTS + 16 * (rb + 2 * pp) + 4 * fq;
            const u32x2 lo = *(const LAS u32x2*)vr; u32x2 hi = {0u, 0u}; if (2 * pp + 1 < 9) hi = *(const LAS u32x2*)(vr + 16);
            v4u w = {lo.x, lo.y, hi.x, hi.y};
            o = __builtin_amdgcn_mfma_f32_16x16x32_bf16(__builtin_bit_cast(bf16x8, w), pf[pp], o, 0, 0, 0); }
        *(u32x2*)(F.MIX() + (size_t)(t0w + fr) * DM + hd * 64 + db * 16 + 4 * fq) = pack4bf(o * rden); }
    __syncthreads();
}
template <int W>
__device__ __forceinline__ void pool_item_body(Frame& F, const Args& A, int l, int rblk, int g) {
    const int lane = F.lane_id(), fr = lane & 15, fq = lane >> 4;
    const int t = rblk * 16 + fr, pos = t & 2047;
    const bf16* Z = F.Z();
    const int nwin = (pos + 1) < W ? (pos + 1) : W; const float rc = 1.0f / (float)nwin;
    const bf16* wt = F.WPT() + ((size_t)(l * 4 + g) * 128) * 128; const float* psc = A.in[F.zo + I_PSCALE] + l * 512 + g * 128;
    f32x4 acc[8];
#pragma unroll
    for (int nb = 0; nb < 8; ++nb) acc[nb] = (f32x4){0.f, 0.f, 0.f, 0.f};
#pragma unroll 1
    for (int ks = 0; ks < 4; ++ks) { const bf16* up = Z + (size_t)t * ZW + ZU + g * 128 + ks * 32 + 8 * fq;
        v4u x[W];
#pragma unroll
        for (int i = 0; i < W; ++i) { x[i] = (v4u){0u, 0u, 0u, 0u}; if (i < nwin) x[i] = *(const v4u*)(up - (size_t)i * ZW); }
        float s[8];
#pragma unroll
        for (int j = 0; j < 8; ++j) s[j] = 0.f;
#pragma unroll
        for (int i = 0; i < W; ++i) { s[0] += bflo(x[i].x); s[1] += bfhi(x[i].x); s[2] += bflo(x[i].y); s[3] += bfhi(x[i].y); s[4] += bflo(x[i].z); s[5] += bfhi(x[i].z); s[6] += bflo(x[i].w); s[7] += bfhi(x[i].w); }
        const v4u u0 = x[0];
        v4u wv; wv.x = pk2(s[0] * rc - bflo(u0.x), s[1] * rc - bfhi(u0.x)); wv.y = pk2(s[2] * rc - bflo(u0.y), s[3] * rc - bfhi(u0.y)); wv.z = pk2(s[4] * rc - bflo(u0.z), s[5] * rc - bfhi(u0.z)); wv.w = pk2(s[6] * rc - bflo(u0.w), s[7] * rc - bfhi(u0.w));
        const bf16x8 df = __builtin_bit_cast(bf16x8, wv);
#pragma unroll
        for (int nb = 0; nb < 8; ++nb) { const bf16x8 a = *(const bf16x8*)(wt + (size_t)(nb * 16 + fr) * 128 + ks * 32 + 8 * fq); acc[nb] = __builtin_amdgcn_mfma_f32_16x16x32_bf16(a, df, acc[nb], 0, 0, 0); } }
#pragma unroll
    for (int nb = 0; nb < 8; ++nb) { const f32x4 sc = *(const f32x4*)(psc + nb * 16 + 4 * fq);
        *(u32x2*)(F.MIX() + (size_t)t * DM + 512 + g * 128 + nb * 16 + 4 * fq) = pack4bf(acc[nb] * sc); }
}
__device__ __forceinline__ void pool_item_mfma(Frame& F, const Args& A, int l, int rblk, int g) {
    if (g == 0) pool_item_body<2>(F, A, l, rblk, g); else if (g == 1) pool_item_body<4>(F, A, l, rblk, g); else if (g == 2) pool_item_body<8>(F, A, l, rblk, g); else pool_item_body<16>(F, A, l, rblk, g);
}
__device__ __forceinline__ void skinny_resid(Frame& F, const bf16* Asmp, const bf16* Bt, int K, const float* gate) {
    const int lane = F.lane_id(), wave = F.wave, fr = lane & 15, fq = lane >> 4;
    LAS float* red = (LAS float*)(F.lds + RING_OFF);
    const int kw = K >> 3, ksteps = kw >> 5;
    __syncthreads();
    for (int u = F.vcu; u < 256; u += F.G) {
        const int c0 = (u >> 1) * 16, r0 = (u & 1) * 64;
        const bf16* bp = Bt + (size_t)(c0 + fr) * K + wave * kw + 8 * fq;
        const bf16* ap = Asmp + (size_t)(r0 + fr) * K + wave * kw + 8 * fq;
        f32x4 acc[4];
#pragma unroll
        for (int rb = 0; rb < 4; ++rb) acc[rb] = (f32x4){0.f, 0.f, 0.f, 0.f};
        bf16x8 bc = *(const bf16x8*)bp, ac[4];
#pragma unroll
        for (int rb = 0; rb < 4; ++rb) ac[rb] = *(const bf16x8*)(ap + (size_t)rb * 16 * K);
        for (int ks = 0; ks < ksteps; ++ks) {
            bf16x8 bn = bc, an[4];
#pragma unroll
            for (int rb = 0; rb < 4; ++rb) an[rb] = ac[rb];
            if (ks + 1 < ksteps) { bn = *(const bf16x8*)(bp + (ks + 1) * 32);
#pragma unroll
                for (int rb = 0; rb < 4; ++rb) an[rb] = *(const bf16x8*)(ap + (size_t)rb * 16 * K + (ks + 1) * 32); }
#pragma unroll
            for (int rb = 0; rb < 4; ++rb) acc[rb] = __builtin_amdgcn_mfma_f32_16x16x32_bf16(bc, ac[rb], acc[rb], 0, 0, 0);
            bc = bn;
#pragma unroll
            for (int rb = 0; rb < 4; ++rb) ac[rb] = an[rb];
        }
#pragma unroll
        for (int rb = 0; rb < 4; ++rb) *(LAS f32x4*)(red + ((wave * 4 + rb) * 64 + lane) * 4) = acc[rb];
        __syncthreads();
        if (wave < 4) { f32x4 s = {0.f, 0.f, 0.f, 0.f};
#pragma unroll
            for (int w2 = 0; w2 < 8; ++w2) s = s + *(const LAS f32x4*)(red + ((w2 * 4 + wave) * 64 + lane) * 4);
            const int r = r0 + wave * 16 + fr;
            const f32x4 g = *(const f32x4*)(gate + (size_t)(4 + (r >> 2)) * MODLD + c0 + 4 * fq);
            const size_t xo = (size_t)(NP_ROWS + r) * DM + c0 + 4 * fq; f32x4 xv = *(const f32x4*)(F.X() + xo); xv = xv + g * s; *(f32x4*)(F.X_ST() + xo) = xv; }
        __syncthreads();
    }
}

#ifndef EN_P0
#define EN_P0 1
#endif
#ifndef EN_G
#define EN_G 1
#endif
#ifndef EN_N
#define EN_N 1
#endif
#ifndef EN_M2
#define EN_M2 1
#endif
#ifndef EN_M3
#define EN_M3 1
#endif
#ifndef EN_M4
#define EN_M4 1
#endif
#ifndef EN_G1
#define EN_G1 1
#endif
#ifndef EN_GIN
#define EN_GIN 1
#endif
#ifndef EN_GOUT
#define EN_GOUT 1
#endif
#ifndef EN_GGU
#define EN_GGU 1
#endif
#ifndef EN_GDN
#define EN_GDN 1
#endif
#ifndef PROBE_DUP
#define PROBE_DUP 0
#endif
#ifndef MK_SINGLE
#define MK_SINGLE 1
#endif

#define PH_ARGS unsigned ldsb_, unsigned wslo_, unsigned wshi_, unsigned olo_, unsigned ohi_, int wave_, int vcu_, int G_, int probe_, int l_
#define PH_PASS ldsb, wslo, wshi, olo, ohi, F.wave, F.vcu, F.G, F.probe
#define PH_FRAME() Frame F; { const unsigned a0 = __builtin_amdgcn_readfirstlane(ldsb_), a1 = __builtin_amdgcn_readfirstlane(wslo_), a2 = __builtin_amdgcn_readfirstlane(wshi_), a3 = __builtin_amdgcn_readfirstlane(olo_), a4 = __builtin_amdgcn_readfirstlane(ohi_); \
    F.lds = (LAS unsigned char*)(unsigned long long)a0; F.MISC = (volatile LAS unsigned*)(F.lds + MISC_OFF); F.ws = (unsigned char*)(((unsigned long long)a2 << 32) | a1); F.out = (float*)(((unsigned long long)a4 << 32) | a3); \
    F.wave = __builtin_amdgcn_readfirstlane(wave_); F.vcu = __builtin_amdgcn_readfirstlane(vcu_); F.G = __builtin_amdgcn_readfirstlane(G_); F.zo = 0; F.probe = __builtin_amdgcn_readfirstlane(probe_); } \
    const int l = __builtin_amdgcn_readfirstlane(l_); (void)l; \
    const Args& args = *(const Args*)__builtin_amdgcn_kernarg_segment_ptr();
__device__ __forceinline__ void ph_prologue(PH_ARGS) { PH_FRAME(); p0_prologue(F, args); }
__device__ __forceinline__ void ph_sctable(PH_ARGS) { PH_FRAME(); sc_table(F, args); }
__device__ __forceinline__ void ph_norm1(PH_ARGS) { PH_FRAME(); norm_mod_rows(F, args.in[I_GMIX] + l * DM, F.MOD() + (size_t)l * MODW, 0, NROWS, F.vcu * NWAVES + F.wave, F.G * NWAVES); }
__device__ __forceinline__ void ph_norm2(PH_ARGS) { PH_FRAME(); norm_mod_rows(F, args.in[I_GFFN] + l * DM, F.MOD() + (size_t)l * MODW + 6144, 0, NROWS, F.vcu * NWAVES + F.wave, F.G * NWAVES); }
__device__ __forceinline__ void ph_final(PH_ARGS) { PH_FRAME(); final_norm_rows(F, args, 0); }
__device__ __forceinline__ void ph_mixa(PH_ARGS) { PH_FRAME();
    const int gw = F.vcu * NWAVES + F.wave, NGW = F.G * NWAVES; LAS float* wscr = (LAS float*)(F.lds + RING_OFF + F.wave * 16384);
    const int hG = F.G >> 1;
    if (F.vcu < hG) { for (int u = F.vcu; u < 128; u += hG) gla_prompt_group(F, args, l, u); }
    else { for (int u = F.vcu - hG; u < 512; u += F.G - hG) attn_unit_mfma(F, args, l, u);
           for (int u = F.vcu - hG; u < 128; u += F.G - hG) gla_sample_unit(F, args, l, u); }
    for (int it = gw; it < 512 * 4; it += NGW) pool_item_mfma(F, args, l, it >> 2, it & 3);
    { const int gwr = (F.G - 1 - F.vcu) + F.G * F.wave;
      for (int it = gwr; it < NS_ROWS * 8; it += NGW) attn_item(F, args, l, NP_ROWS + (it >> 3), it & 7, wscr);
      for (int it = gwr - 4 * F.G; it < NS_ROWS * 4; it += NGW) if (it >= 0) pool_item(F, args, l, NP_ROWS + (it >> 2), it & 3, wscr); }
    cache_outputs(F, args, l);
}
__device__ __forceinline__ void ph_gla2(PH_ARGS) { PH_FRAME(); gla_phase_g2(F, args, l); }
__device__ __forceinline__ void ph_mixc(PH_ARGS) { PH_FRAME(); const int gw = F.vcu * NWAVES + F.wave, NGW = F.G * NWAVES;
#pragma unroll 4
    for (int it = gw; it < NROWS * 4; it += NGW) gla_out_item(F, args, l, it >> 2, it & 3); }
constexpr int PH_PER_LAYER = 9, PH_LAYER0 = 1, PH_FINAL = PH_LAYER0 + DEPTH * PH_PER_LAYER, PH_COUNT = PH_FINAL + 1;
__global__ void __launch_bounds__(NTHREADS, 2) hymba_fwd(Args args) {
    extern __shared__ __attribute__((aligned(16))) unsigned char lds[];
    Frame F;
    F.lds = (LAS unsigned char*)lds;
    F.MISC = (volatile LAS unsigned*)(F.lds + MISC_OFF);
    F.wave = __builtin_amdgcn_readfirstlane((int)threadIdx.x >> 6); F.zo = 0; F.probe = 0;
    F.G = gridDim.x; { const int bx = blockIdx.x; F.vcu = (F.G % 8 == 0) ? (bx % 8) * (F.G / 8) + bx / 8 : bx; }
    F.ws = args.ws; F.out = args.out;
    gu32* const ctl = (gu32*)(F.ws + WS_CTL);
    for (int u = threadIdx.x; u < (LDS_BYTES - LDSCTL_OFF) / 4; u += NTHREADS) ((LAS unsigned*)(F.lds + LDSCTL_OFF))[u] = 0u;
    __syncthreads();
#if MK_SINGLE
    XcdBarrier bar = xcd_barrier_post((unsigned*)(ctl + CW_BAR), F.MISC + 8);
#define GRID_BAR() do { bar.x = xb_xcc_id(); xcd_barrier(bar); } while (0)
#else
#define GRID_BAR() do { } while (0)
#endif
    const int lo = args.ph_lo, hi = args.ph_hi;
    const unsigned ldsb = (unsigned)(unsigned long long)F.lds, wslo = (unsigned)(unsigned long long)F.ws, wshi = (unsigned)((unsigned long long)F.ws >> 32), olo = (unsigned)(unsigned long long)F.out, ohi = (unsigned)((unsigned long long)F.out >> 32);
#define IN(k) (lo <= (k) && (k) < hi)
#define BOTH(k) (IN(k) && IN((k) + 1))
#define PHASE_BEGIN() asm volatile("s_mov_b32 %0, 0" : "=s"(F.zo), "+s"(F.G), "+s"(F.vcu), "+s"(F.wave))
#define gw (F.vcu * NWAVES + F.wave)
#define NGW (F.G * NWAVES)
#define wscr ((LAS float*)(F.lds + RING_OFF + F.wave * 16384))

    if (EN_P0 && IN(0)) { PHASE_BEGIN(); ph_sctable(PH_PASS, 0); GRID_BAR(); }
    if (EN_P0 && IN(0)) for (int rep_ = 0; rep_ < ((PROBE_DUP & 1) ? 2 : 1); ++rep_) { PHASE_BEGIN(); ph_prologue(PH_PASS, 0); if (BOTH(0)) GRID_BAR(); }
    for (int l = 0; l < DEPTH; ++l) {
        const int pb = PH_LAYER0 + l * PH_PER_LAYER;
        const float* modl = F.MOD() + (size_t)l * MODW;
        if (EN_N && IN(pb + 0)) for (int rep_ = 0; rep_ < ((PROBE_DUP & 2) ? 2 : 1); ++rep_) { PHASE_BEGIN(); ph_norm1(PH_PASS, l); if (BOTH(pb + 0)) GRID_BAR(); }
        if (EN_G && EN_GIN && IN(pb + 1)) for (int rep_ = 0; rep_ < ((PROBE_DUP & 4) ? 2 : 1); ++rep_) { PHASE_BEGIN();
            pg8::Gemm g{F.H(), F.Win_t() + (size_t)l * ZW * DM, MPAD, ZW, DM}; pg8::StaticOrder S; S.init(MPAD, ZW, F.G, (int)blockIdx.x);
            pg8::EpiZ E{F.Z(), ZW};
            pg8::gemm_phase<pg8::EpiZ, pg8::StaticOrder, true, true>(F.lds + RING_OFF, g, S, E, F.wave);
            if (BOTH(pb + 1)) GRID_BAR();
        }
        if (EN_M2 && IN(pb + 2)) for (int rep_ = 0; rep_ < ((PROBE_DUP & 8) ? 2 : 1); ++rep_) { PHASE_BEGIN();
            ph_mixa(PH_PASS, l);
            if (BOTH(pb + 2)) GRID_BAR();
        }
        if (EN_M3 && IN(pb + 3)) for (int rep_ = 0; rep_ < ((PROBE_DUP & 32) ? 2 : 1); ++rep_) { PHASE_BEGIN(); F.probe = ((PROBE_DUP & 32) && rep_ == 0) ? 1 : 0;
            ph_gla2(PH_PASS, l);
            if (BOTH(pb + 3)) GRID_BAR();
        }
        if (EN_M4 && IN(pb + 4)) for (int rep_ = 0; rep_ < ((PROBE_DUP & 64) ? 2 : 1); ++rep_) { PHASE_BEGIN(); ph_mixc(PH_PASS, l); if (BOTH(pb + 4)) GRID_BAR(); }
        if (EN_G && EN_GOUT && IN(pb + 5)) for (int rep_ = 0; rep_ < ((PROBE_DUP & 128) ? 2 : 1); ++rep_) { PHASE_BEGIN(); F.probe = ((PROBE_DUP & 128) && rep_ == 0) ? 1 : 0;
            pg8::Gemm g{F.MIX(), F.Wout_t() + (size_t)l * DM * DM, NP_ROWS, DM, DM}; pg8::StaticOrder S; S.init(NP_ROWS, DM, F.G, (int)blockIdx.x);
            pg8::EpiResid E{F.X(), modl + 4096, F.X_ST()};
            pg8::gemm_phase<pg8::EpiResid, pg8::StaticOrder, true, true>(F.lds + RING_OFF, g, S, E, F.wave);
            if ((PROBE_DUP & 512) && !F.probe) { F.probe = 1; skinny_resid(F, F.MIX() + (size_t)NP_ROWS * DM, F.Wout_t() + (size_t)l * DM * DM, DM, modl + 4096); F.probe = 0; }
            skinny_resid(F, F.MIX() + (size_t)NP_ROWS * DM, F.Wout_t() + (size_t)l * DM * DM, DM, modl + 4096);
            if (BOTH(pb + 5)) GRID_BAR();
        }
        if (EN_N && IN(pb + 6)) for (int rep_ = 0; rep_ < ((PROBE_DUP & 2) ? 2 : 1); ++rep_) { PHASE_BEGIN(); ph_norm2(PH_PASS, l); if (BOTH(pb + 6)) GRID_BAR(); }
        if (EN_G && EN_GGU && IN(pb + 7)) for (int rep_ = 0; rep_ < ((PROBE_DUP & 4) ? 2 : 1); ++rep_) { PHASE_BEGIN();
            pg8::Gemm g{F.H(), F.Wgu_t() + (size_t)l * NGU * DM, MPAD, NGU, DM}; pg8::StaticOrder S; S.init(MPAD, NGU, F.G, (int)blockIdx.x);
            pg8::EpiSwiGLU E{F.ACT(), DFF};
            pg8::gemm_phase<pg8::EpiSwiGLU, pg8::StaticOrder, true, true>(F.lds + RING_OFF, g, S, E, F.wave);
            if (BOTH(pb + 7)) GRID_BAR();
        }
        if (EN_G && EN_GDN && IN(pb + 8)) for (int rep_ = 0; rep_ < ((PROBE_DUP & 256) ? 2 : 1); ++rep_) { PHASE_BEGIN(); F.probe = ((PROBE_DUP & 256) && rep_ == 0) ? 1 : 0;
            pg8::Gemm g{F.ACT(), F.Wdn_t() + (size_t)l * DM * DFF, NP_ROWS, DM, DFF}; pg8::StaticOrder S; S.init(NP_ROWS, DM, F.G, (int)blockIdx.x);
            pg8::EpiResid E{F.X(), modl + 10240, F.X_ST()};
            pg8::gemm_phase<pg8::EpiResid, pg8::StaticOrder, true, true>(F.lds + RING_OFF, g, S, E, F.wave);
            if ((PROBE_DUP & 512) && !F.probe) { F.probe = 1; skinny_resid(F, F.ACT() + (size_t)NP_ROWS * DFF, F.Wdn_t() + (size_t)l * DM * DFF, DFF, modl + 10240); F.probe = 0; }
            skinny_resid(F, F.ACT() + (size_t)NP_ROWS * DFF, F.Wdn_t() + (size_t)l * DM * DFF, DFF, modl + 10240);
            if (BOTH(pb + 8)) GRID_BAR();
        }
    }
    if (IN(PH_FINAL)) { PHASE_BEGIN(); ph_final(PH_PASS, 0); }
#ifdef PROBE_SCALE
    GRID_BAR();
    { const size_t offs[11] = {O_Y, 16777216, O_WK_P, O_WV_P, O_POOL_P, O_GLA_P, O_WK_S, O_WV_S, O_POOL_S, O_GLA_S, O_END};
      const size_t gt_ = (size_t)(F.vcu * NWAVES + F.wave) * 64 + F.lane_id(), NGT_ = (size_t)F.G * NWAVES * 64;
      for (int k = 0; k < 10; ++k) { const float sc = 1.0f + 0.05f * (float)(k + 1); for (size_t i = offs[k] + gt_; i < offs[k + 1]; i += NGT_) F.out[i] *= sc; } }
#endif
#undef IN
#undef BOTH
#undef gw
#undef NGW
#undef wscr
}

extern "C" void kernel_launch(void* const* d_in, const int* in_sizes, int n_in, void* d_out, int out_size, void* d_ws, size_t ws_size, hipStream_t stream) {
    static int grid = 0;
    if (grid == 0) {
        if (n_in != 24 || out_size != (int)O_END || ws_size < WS_END) { fprintf(stderr, "kernel_launch: unexpected sizes n_in %d out %d ws %zu\n", n_in, out_size, ws_size); grid = -1; return; }
        int dev = 0, cus = 0;
        if (hipGetDevice(&dev) != hipSuccess || hipDeviceGetAttribute(&cus, hipDeviceAttributeMultiprocessorCount, dev) != hipSuccess) { grid = -1; return; }
        if (hipFuncSetAttribute((const void*)hymba_fwd, hipFuncAttributeMaxDynamicSharedMemorySize, LDS_BYTES) != hipSuccess) { fprintf(stderr, "kernel_launch: hipFuncSetAttribute failed\n"); grid = -1; return; }
        (void)hipGetLastError();
        grid = cus;
    }
    if (grid < 0) return;
    (void)hipMemsetAsync((char*)d_ws + WS_CTL, 0, CTL_ZERO_BYTES, stream);
    Args a{};
    for (int i = 0; i < 24; ++i) a.in[i] = (const float*)d_in[i];
    a.out = (float*)d_out; a.ws = (unsigned char*)d_ws;
#if MK_SINGLE
    a.ph_lo = 0; a.ph_hi = PH_COUNT;
    hipLaunchKernelGGL(hymba_fwd, dim3(grid), dim3(NTHREADS), LDS_BYTES, stream, a);
#else
    for (int p = 0; p < PH_COUNT; ++p) { a.ph_lo = p; a.ph_hi = p + 1; hipLaunchKernelGGL(hymba_fwd, dim3(grid), dim3(NTHREADS), LDS_BYTES, stream, a); }
#endif
}
```
